# Optimizing an MI355X kernel written in HIP

```python
import math
import jax, jax.numpy as jnp
from jax import lax
import numpy as np

D_MODEL = 2048
BATCH = 8
SEQ = 2048
DEPTH = 1

N_META = 16
EPS = 1e-6
HEAD_DIM = 64
N_Q_HEADS = 16
N_KV_HEADS = 2
GROUP = N_Q_HEADS // N_KV_HEADS
WINDOW = 128
BLOCK = 128
Q_DIM = N_Q_HEADS * HEAD_DIM
KV_DIM = N_KV_HEADS * HEAD_DIM
LRU_WIDTH = 1024
LRU_BLOCKS = 16
LRU_BW = LRU_WIDTH // LRU_BLOCKS
CONV_W = 4
LRU_C = 8.0
IN_DIM = Q_DIM + 2 * KV_DIM + 2 * LRU_WIDTH
MIX_DIM = Q_DIM + LRU_WIDTH
PEER_HEADS = 8
N_KEYS = 128
N_EXPERTS = N_KEYS * N_KEYS
PEER_TOPK = 16
PEER_DK = 256
PEER_DK_HALF = PEER_DK // 2
PEER_CHUNK = 128

kernel_name = "hymba_swa_rglru_peer_block"


def rmsnorm(x, g):
    xf = x.astype(jnp.float32)
    y = xf * lax.rsqrt(jnp.mean(xf * xf, axis=-1, keepdims=True) + EPS)
    return (y * g.astype(jnp.float32)).astype(x.dtype)


def sink_softmax(s, mask, sink_b):
    s = jnp.where(mask, s, -1e30)
    sink = jnp.broadcast_to(sink_b, s.shape[:-1] + (1,))
    p = jax.nn.softmax(jnp.concatenate([s, sink], axis=-1), axis=-1)
    return p[..., :-1]


def window_attention(q, k, v, sinks):
    B, T, _ = q.shape
    S = T - N_META
    nb = S // BLOCK
    scale = HEAD_DIM ** -0.5
    q = q.reshape(B, T, N_KV_HEADS, GROUP, HEAD_DIM)
    k = k.reshape(B, T, N_KV_HEADS, HEAD_DIM)
    v = v.reshape(B, T, N_KV_HEADS, HEAD_DIM)
    sink_hg = sinks.astype(jnp.float32).reshape(N_KV_HEADS, GROUP)
    qm, qr = q[:, :N_META], q[:, N_META:]
    km, kr = k[:, :N_META], k[:, N_META:]
    vm, vr = v[:, :N_META], v[:, N_META:]

    s_m = jnp.einsum('bqhgd,bkhd->bhgqk', qm, km).astype(jnp.float32) * scale
    mask_m = jnp.tril(jnp.ones((N_META, N_META), bool))
    p_m = sink_softmax(s_m, mask_m, sink_hg[None, :, :, None, None])
    o_m = jnp.einsum('bhgqk,bkhd->bqhgd', p_m.astype(v.dtype), vm).reshape(B, N_META, Q_DIM)

    qb = qr.reshape(B, nb, BLOCK, N_KV_HEADS, GROUP, HEAD_DIM)
    kp = jnp.pad(kr, ((0, 0), (BLOCK, 0), (0, 0), (0, 0))).reshape(B, nb + 1, BLOCK, N_KV_HEADS, HEAD_DIM)
    vp = jnp.pad(vr, ((0, 0), (BLOCK, 0), (0, 0), (0, 0))).reshape(B, nb + 1, BLOCK, N_KV_HEADS, HEAD_DIM)
    k_meta = jnp.broadcast_to(km[:, None], (B, nb, N_META, N_KV_HEADS, HEAD_DIM))
    v_meta = jnp.broadcast_to(vm[:, None], (B, nb, N_META, N_KV_HEADS, HEAD_DIM))
    k_all = jnp.concatenate([k_meta, kp[:, :-1], kp[:, 1:]], axis=2)
    v_all = jnp.concatenate([v_meta, vp[:, :-1], vp[:, 1:]], axis=2)
    s_r = jnp.einsum('bnqhgd,bnkhd->bnhgqk', qb, k_all).astype(jnp.float32) * scale
    q_coord = jnp.arange(BLOCK)[:, None] + BLOCK
    k_coord = jnp.arange(2 * BLOCK)[None, :]
    dist = q_coord - k_coord
    band = (dist >= 0) & (dist < WINDOW)
    valid = (jnp.arange(nb)[:, None] > 0) | (k_coord >= BLOCK)
    mask_r = jnp.concatenate([jnp.ones((nb, BLOCK, N_META), bool),
                              band[None] & valid[:, None, :]], axis=-1)
    p_r = sink_softmax(s_r, mask_r[None, :, None, None], sink_hg[None, None, :, :, None, None])
    o_r = jnp.einsum('bnhgqk,bnkhd->bnqhgd', p_r.astype(v.dtype), v_all).reshape(B, S, Q_DIM)
    return jnp.concatenate([o_m, o_r], axis=1)


def rglru_branch(xb, gate, conv_w, conv_b, w_r, b_r, w_i, b_i, lam):
    B, T, W = xb.shape
    xp = jnp.pad(xb, ((0, 0), (CONV_W - 1, 0), (0, 0)))
    xc = conv_b
    for tap in range(CONV_W):
        xc = xc + conv_w[tap] * xp[:, tap:tap + T]
    xh = xc.reshape(B, T, LRU_BLOCKS, LRU_BW)
    r = jax.nn.sigmoid(jnp.einsum('btnc,ncd->btnd', xh, w_r) + b_r).reshape(B, T, W)
    i = jax.nn.sigmoid(jnp.einsum('btnc,ncd->btnd', xh, w_i) + b_i).reshape(B, T, W)
    log_a = LRU_C * r.astype(jnp.float32) * jax.nn.log_sigmoid(lam.astype(jnp.float32))
    a = jnp.exp(log_a)
    mult = jnp.sqrt(-jnp.expm1(2.0 * log_a))
    bx = mult * (i * xc).astype(jnp.float32)

    def combine(left, right):
        a_l, b_l = left
        a_r, b_r_ = right
        return a_l * a_r, a_r * b_l + b_r_

    _, h = lax.associative_scan(combine, (a, bx), axis=1)
    return (jax.nn.gelu(gate) * h.astype(xb.dtype))


def peer(x2d, w_q, sub_keys, u_tab, v_tab):
    n_tok, D = x2d.shape
    pad = (-n_tok) % PEER_CHUNK
    xp = jnp.pad(x2d, ((0, pad), (0, 0))).reshape(-1, PEER_CHUNK, D)

    def one_block(xc):
        q = (xc @ w_q).reshape(PEER_CHUNK, PEER_HEADS, 2, PEER_DK_HALF)
        s = jnp.einsum('chpd,hpkd->chpk', q, sub_keys).astype(jnp.float32)
        top_s, top_i = lax.top_k(s, PEER_TOPK)
        cand = top_s[:, :, 0, :, None] + top_s[:, :, 1, None, :]
        best_s, best_c = lax.top_k(cand.reshape(PEER_CHUNK, PEER_HEADS, PEER_TOPK * PEER_TOPK), PEER_TOPK)
        i1 = jnp.take_along_axis(top_i[:, :, 0], best_c // PEER_TOPK, axis=-1)
        i2 = jnp.take_along_axis(top_i[:, :, 1], best_c % PEER_TOPK, axis=-1)
        experts = i1 * N_KEYS + i2
        g = jax.nn.softmax(best_s, axis=-1)
        u = u_tab[experts]
        act = jax.nn.gelu(jnp.einsum('chkd,cd->chk', u, xc))
        v = v_tab[experts]
        return jnp.einsum('chk,chkd->cd', (g * act.astype(jnp.float32)).astype(v.dtype), v)

    out = lax.map(one_block, xp)
    return out.reshape(-1, D)[:n_tok]


def setup_inputs(seed: int = 0) -> dict:
    key = jax.random.key(seed)
    ks = jax.random.split(key, 24)
    f32 = jnp.float32

    def nrm(k, shape, scale):
        return jax.random.normal(k, shape, f32) * scale

    def gain(k, shape):
        return 1.0 + 0.02 * jax.random.normal(k, shape, f32)

    u_a = jax.random.uniform(ks[10], (DEPTH, LRU_WIDTH), f32, 0.9, 0.999)
    sig_l = u_a ** (1.0 / LRU_C)
    lru_lambda = jnp.log(sig_l) - jnp.log1p(-sig_l)
    return {
        "x": jax.random.normal(ks[0], (BATCH, SEQ, D_MODEL), f32),
        "meta_tokens": nrm(ks[1], (N_META, D_MODEL), 1.0),
        "norm_mix_g": gain(ks[2], (DEPTH, D_MODEL)),
        "w_in": nrm(ks[3], (DEPTH, D_MODEL, IN_DIM), D_MODEL ** -0.5),
        "b_in": nrm(ks[4], (DEPTH, IN_DIM), 0.02),
        "sinks": nrm(ks[5], (DEPTH, N_Q_HEADS), 0.5),
        "conv_w": nrm(ks[6], (DEPTH, CONV_W, LRU_WIDTH), CONV_W ** -0.5),
        "conv_b": nrm(ks[7], (DEPTH, LRU_WIDTH), 0.02),
        "w_r": nrm(ks[8], (DEPTH, LRU_BLOCKS, LRU_BW, LRU_BW), LRU_BW ** -0.5),
        "b_r": nrm(ks[9], (DEPTH, LRU_BLOCKS, LRU_BW), 0.02),
        "w_i": nrm(ks[11], (DEPTH, LRU_BLOCKS, LRU_BW, LRU_BW), LRU_BW ** -0.5),
        "b_i": nrm(ks[12], (DEPTH, LRU_BLOCKS, LRU_BW), 0.02),
        "lru_lambda": lru_lambda,
        "gn_attn_g": gain(ks[13], (DEPTH, Q_DIM)),
        "gn_lru_g": gain(ks[14], (DEPTH, LRU_WIDTH)),
        "w_out": nrm(ks[15], (DEPTH, MIX_DIM, D_MODEL), MIX_DIM ** -0.5),
        "norm_ffn_g": gain(ks[16], (DEPTH, D_MODEL)),
        "peer_wq": nrm(ks[17], (DEPTH, D_MODEL, PEER_HEADS * PEER_DK), D_MODEL ** -0.5),
        "peer_sub_keys": nrm(ks[18], (DEPTH, PEER_HEADS, 2, N_KEYS, PEER_DK_HALF), PEER_DK_HALF ** -0.5),
        "peer_u": nrm(ks[19], (DEPTH, N_EXPERTS, D_MODEL), D_MODEL ** -0.5),
        "peer_v": nrm(ks[20], (DEPTH, N_EXPERTS, D_MODEL), 0.5),
        "final_norm_g": gain(ks[21], (D_MODEL,)),
    }


def reference(x, meta_tokens, norm_mix_g, w_in, b_in, sinks, conv_w, conv_b, w_r, b_r, w_i, b_i,
              lru_lambda, gn_attn_g, gn_lru_g, w_out, norm_ffn_g, peer_wq, peer_sub_keys,
              peer_u, peer_v, final_norm_g):
    B = x.shape[0]
    meta = jnp.broadcast_to(meta_tokens[None].astype(x.dtype), (B, N_META, D_MODEL))
    h = jnp.concatenate([meta, x], axis=1)
    T = h.shape[1]
    split_at = [Q_DIM, Q_DIM + KV_DIM, Q_DIM + 2 * KV_DIM, Q_DIM + 2 * KV_DIM + LRU_WIDTH]
    for l in range(DEPTH):
        hn = rmsnorm(h, norm_mix_g[l])
        proj = hn @ w_in[l] + b_in[l]
        q, k, v, xb, gate = jnp.split(proj, split_at, axis=-1)
        o_attn = window_attention(q, k, v, sinks[l])
        o_lru = rglru_branch(xb, gate, conv_w[l], conv_b[l], w_r[l], b_r[l], w_i[l], b_i[l],
                             lru_lambda[l])
        mixed = jnp.concatenate([rmsnorm(o_attn, gn_attn_g[l]), rmsnorm(o_lru, gn_lru_g[l])], axis=-1)
        h = h + mixed @ w_out[l]
        hn = rmsnorm(h, norm_ffn_g[l]).reshape(B * T, D_MODEL)
        h = h + peer(hn, peer_wq[l], peer_sub_keys[l], peer_u[l], peer_v[l]).reshape(B, T, D_MODEL)
    y = rmsnorm(h, final_norm_g)
    return y[:, N_META:]
```

```cpp
#include <hip/hip_runtime.h>
#include <stdint.h>
#include <math.h>

#define D 2048
#define NB 8
#define SEQ 2048
#define NMETA 16
#define TT (SEQ + NMETA)
#define MR (NB * TT)
#define QD 1024
#define KVD 128
#define LW 1024
#define IND 3328
#define EPS 1e-6f

__device__ __forceinline__ float wave_sum(float v) {
#pragma unroll
    for (int o = 32; o > 0; o >>= 1) v += __shfl_xor(v, o);
    return v;
}
__device__ __forceinline__ float gelu_tanh(float x) {
    return 0.5f * x * (1.0f + tanhf(0.7978845608028654f * (x + 0.044715f * x * x * x)));
}
__device__ __forceinline__ const float* h_row(const float* x, const float* meta, int m) {
    const int b = m / TT, t = m % TT;
    return t < NMETA ? meta + (size_t)t * D : x + ((size_t)b * SEQ + (t - NMETA)) * D;
}

__global__ void __launch_bounds__(256) k_rms_row(const float* x, const float* meta, const float* src, const float* g, float* dst, int mode) {
    const int m = blockIdx.x, tid = threadIdx.x;
    const float* s = mode == 0 ? h_row(x, meta, m) : src + (size_t)m * D;
    __shared__ float red[4];
    float4 a = ((const float4*)s)[tid], b = ((const float4*)s)[tid + 256];
    float ss = a.x * a.x + a.y * a.y + a.z * a.z + a.w * a.w + b.x * b.x + b.y * b.y + b.z * b.z + b.w * b.w;
    ss = wave_sum(ss);
    if ((tid & 63) == 0) red[tid >> 6] = ss;
    __syncthreads();
    const float tot = red[0] + red[1] + red[2] + red[3];
    const float r = rsqrtf(tot * (1.0f / D) + EPS);
    float4 ga = ((const float4*)g)[tid], gb = ((const float4*)g)[tid + 256];
    float4 oa = {a.x * r * ga.x, a.y * r * ga.y, a.z * r * ga.z, a.w * r * ga.w};
    float4 ob = {b.x * r * gb.x, b.y * r * gb.y, b.z * r * gb.z, b.w * r * gb.w};
    ((float4*)(dst + (size_t)m * D))[tid] = oa;
    ((float4*)(dst + (size_t)m * D))[tid + 256] = ob;
}

template <int EPI>
__global__ void __launch_bounds__(256) k_sgemm(const float* A, const float* B, const float* bias, float* C, int M, int N, int K,
                                               const float* x, const float* meta) {
    __shared__ float As[16][64 + 4];
    __shared__ float Bs[16][64 + 4];
    const int tid = threadIdx.x, tx = tid & 15, ty = tid >> 4;
    const int row0 = blockIdx.y * 64, col0 = blockIdx.x * 64;
    float acc[4][4];
#pragma unroll
    for (int i = 0; i < 4; ++i)
#pragma unroll
        for (int j = 0; j < 4; ++j) acc[i][j] = 0.f;
    const int ar = tid >> 2, ak = (tid & 3) * 4;
    const int bk = tid >> 4, bc = (tid & 15) * 4;
    for (int k0 = 0; k0 < K; k0 += 16) {
        const float4 av = *(const float4*)(A + (size_t)(row0 + ar) * K + k0 + ak);
        const float4 bv = *(const float4*)(B + (size_t)(k0 + bk) * N + col0 + bc);
        __syncthreads();
        As[ak + 0][ar] = av.x; As[ak + 1][ar] = av.y; As[ak + 2][ar] = av.z; As[ak + 3][ar] = av.w;
        *(float4*)&Bs[bk][bc] = bv;
        __syncthreads();
#pragma unroll
        for (int k = 0; k < 16; ++k) {
            const float4 a4 = *(const float4*)&As[k][ty * 4];
            const float4 b4 = *(const float4*)&Bs[k][tx * 4];
            const float aa[4] = {a4.x, a4.y, a4.z, a4.w}, bb[4] = {b4.x, b4.y, b4.z, b4.w};
#pragma unroll
            for (int i = 0; i < 4; ++i)
#pragma unroll
                for (int j = 0; j < 4; ++j) acc[i][j] += aa[i] * bb[j];
        }
    }
#pragma unroll
    for (int i = 0; i < 4; ++i) {
        const int r = row0 + ty * 4 + i, c = col0 + tx * 4;
        float4 o = {acc[i][0], acc[i][1], acc[i][2], acc[i][3]};
        if (EPI == 0) { const float4 bb = *(const float4*)(bias + c); o.x += bb.x; o.y += bb.y; o.z += bb.z; o.w += bb.w; }
        if (EPI == 1) { const float4 hh = *(const float4*)(h_row(x, meta, r) + c); o.x += hh.x; o.y += hh.y; o.z += hh.z; o.w += hh.w; }
        *(float4*)(C + (size_t)r * N + c) = o;
    }
}

__global__ void __launch_bounds__(256) k_attn(const float* proj, const float* sinks, float* mixed) {
    const int tid = threadIdx.x, lane = tid & 63, w = tid >> 6;
    const int m = blockIdx.x >> 2, hq = (blockIdx.x & 3) * 4 + w, kvh = hq >> 3;
    const int b = m / TT, t = m % TT;
    __shared__ float qs[4][64];
    qs[w][lane] = proj[(size_t)m * IND + hq * 64 + lane];
    __syncthreads();
    int nmk, nreal, first;
    if (t < NMETA) { nmk = t + 1; nreal = 0; first = 0; }
    else { const int s = t - NMETA; nmk = NMETA; nreal = (s + 1 < 128) ? s + 1 : 128; first = s - nreal + 1; }
    const int nk = nmk + nreal;
    float sc0 = -1e30f, sc1 = -1e30f, sc2 = -1e30f;
#pragma unroll
    for (int j = 0; j < 3; ++j) {
        const int key = j * 64 + lane;
        float s = -1e30f;
        if (key < nk) {
            const int row = b * TT + (key < nmk ? key : NMETA + first + (key - nmk));
            const float* kp = proj + (size_t)row * IND + QD + kvh * 64;
            float a = 0.f;
            for (int d = 0; d < 64; ++d) a += qs[w][d] * kp[d];
            s = a * 0.125f;
        }
        if (j == 0) sc0 = s; else if (j == 1) sc1 = s; else sc2 = s;
    }
    const float sink = sinks[hq];
    float mx = fmaxf(fmaxf(sc0, sc1), fmaxf(sc2, sink));
#pragma unroll
    for (int o = 32; o > 0; o >>= 1) mx = fmaxf(mx, __shfl_xor(mx, o));
    float p0 = (lane < nk) ? expf(sc0 - mx) : 0.f;
    float p1 = (64 + lane < nk) ? expf(sc1 - mx) : 0.f;
    float p2 = (128 + lane < nk) ? expf(sc2 - mx) : 0.f;
    float den = wave_sum(p0 + p1 + p2) + expf(sink - mx);
    const float inv = 1.0f / den;
    float o = 0.f;
    for (int key = 0; key < nk; ++key) {
        const int j = key >> 6, src = key & 63;
        const float pv = j == 0 ? p0 : (j == 1 ? p1 : p2);
        const float p = __shfl(pv, src);
        const int row = b * TT + (key < nmk ? key : NMETA + first + (key - nmk));
        o += p * proj[(size_t)row * IND + QD + KVD + kvh * 64 + lane];
    }
    mixed[(size_t)m * D + hq * 64 + lane] = o * inv;
}

__global__ void __launch_bounds__(256) k_lru1(const float* proj, const float* conv_w, const float* conv_b, const float* w_r, const float* b_r,
                                              const float* w_i, const float* b_i, const float* lam, float* A, float* BX) {
    const int m = blockIdx.x, tid = threadIdx.x;
    const int t = m % TT;
    __shared__ float xc[LW];
#pragma unroll
    for (int q = 0; q < 4; ++q) {
        const int c = tid + q * 256;
        float v = conv_b[c];
#pragma unroll
        for (int tap = 0; tap < 4; ++tap) {
            const int tt = t + tap - 3;
            if (tt >= 0) v += conv_w[tap * LW + c] * proj[(size_t)(m + tap - 3) * IND + 1280 + c];
        }
        xc[c] = v;
    }
    __syncthreads();
#pragma unroll
    for (int q = 0; q < 4; ++q) {
        const int c = tid + q * 256, n = c >> 6, d = c & 63;
        float r = b_r[c], ii = b_i[c];
        for (int cc = 0; cc < 64; ++cc) {
            const float xv = xc[n * 64 + cc];
            r += xv * w_r[(n * 64 + cc) * 64 + d];
            ii += xv * w_i[(n * 64 + cc) * 64 + d];
        }
        r = 1.0f / (1.0f + expf(-r));
        ii = 1.0f / (1.0f + expf(-ii));
        const float ls = -log1pf(expf(-lam[c]));
        const float log_a = 8.0f * r * ls;
        const float a = expf(log_a);
        const float mult = sqrtf(-expm1f(2.0f * log_a));
        A[(size_t)m * LW + c] = a;
        BX[(size_t)m * LW + c] = mult * (ii * xc[c]);
    }
}
__global__ void __launch_bounds__(256) k_lru2(const float* proj, const float* A, const float* BX, float* mixed) {
    const int gid = blockIdx.x * 256 + threadIdx.x;
    const int b = gid / LW, c = gid % LW;
    float h = 0.f;
    for (int t = 0; t < TT; ++t) {
        const size_t m = (size_t)b * TT + t;
        h = A[m * LW + c] * h + BX[m * LW + c];
        const float gt = proj[m * IND + 2304 + c];
        mixed[m * D + QD + c] = gelu_tanh(gt) * h;
    }
}
__global__ void __launch_bounds__(256) k_gnorm(float* mixed, const float* ga, const float* gl) {
    const int m = blockIdx.x, tid = threadIdx.x;
    float* row = mixed + (size_t)m * D;
    __shared__ float red[4];
    const float4 a = ((const float4*)row)[tid];
    const float4 b = ((const float4*)row)[256 + tid];
    float sa = wave_sum(a.x * a.x + a.y * a.y + a.z * a.z + a.w * a.w);
    float sb = wave_sum(b.x * b.x + b.y * b.y + b.z * b.z + b.w * b.w);
    __shared__ float ra[4], rb[4];
    if ((tid & 63) == 0) { ra[tid >> 6] = sa; rb[tid >> 6] = sb; }
    __syncthreads();
    const float r1 = rsqrtf((ra[0] + ra[1] + ra[2] + ra[3]) * (1.0f / 1024) + EPS);
    const float r2 = rsqrtf((rb[0] + rb[1] + rb[2] + rb[3]) * (1.0f / 1024) + EPS);
    const float4 g1 = ((const float4*)ga)[tid], g2 = ((const float4*)gl)[tid];
    float4 oa = {a.x * r1 * g1.x, a.y * r1 * g1.y, a.z * r1 * g1.z, a.w * r1 * g1.w};
    float4 ob = {b.x * r2 * g2.x, b.y * r2 * g2.y, b.z * r2 * g2.z, b.w * r2 * g2.w};
    ((float4*)row)[tid] = oa;
    ((float4*)row)[256 + tid] = ob;
    (void)red;
}

__global__ void __launch_bounds__(256) k_retr(const float* qp, const float* keys, int* ids, float* gw) {
    const int tid = threadIdx.x, lane = tid & 63, w = tid >> 6;
    const int gwv = blockIdx.x * 4 + w;
    const int tok = gwv >> 3, h = gwv & 7;
    const int b = tok / SEQ, s = tok % SEQ, m = b * TT + NMETA + s;
    __shared__ float qs[4][256];
#pragma unroll
    for (int j = 0; j < 4; ++j) qs[w][j * 64 + lane] = qp[(size_t)m * D + h * 256 + j * 64 + lane];
    __syncthreads();
    float ts0 = 0.f, ts1 = 0.f; int ti0 = 0, ti1 = 0;
#pragma unroll
    for (int p = 0; p < 2; ++p) {
        const float* kb = keys + (size_t)((h * 2 + p) * 128) * 128;
        float v0 = 0.f, v1 = 0.f;
        for (int d = 0; d < 128; ++d) { const float q = qs[w][p * 128 + d]; v0 += q * kb[(size_t)lane * 128 + d]; v1 += q * kb[(size_t)(lane + 64) * 128 + d]; }
        float ts = 0.f; int ti = 0;
        for (int r = 0; r < 16; ++r) {
            float bv; int bi;
            if (v0 >= v1) { bv = v0; bi = lane; } else { bv = v1; bi = lane + 64; }
#pragma unroll
            for (int o = 32; o > 0; o >>= 1) {
                const float ov = __shfl_xor(bv, o); const int oi = __shfl_xor(bi, o);
                if (ov > bv || (ov == bv && oi < bi)) { bv = ov; bi = oi; }
            }
            if (lane == r) { ts = bv; ti = bi; }
            if (bi == lane) v0 = -INFINITY; else if (bi == lane + 64) v1 = -INFINITY;
        }
        if (p == 0) { ts0 = ts; ti0 = ti; } else { ts1 = ts; ti1 = ti; }
    }
    const float ai = __shfl(ts0, lane >> 2);
    float c0 = ai + __shfl(ts1, (lane & 3) * 4 + 0);
    float c1 = ai + __shfl(ts1, (lane & 3) * 4 + 1);
    float c2 = ai + __shfl(ts1, (lane & 3) * 4 + 2);
    float c3 = ai + __shfl(ts1, (lane & 3) * 4 + 3);
    float bs = 0.f; int bc = 0;
    for (int r = 0; r < 16; ++r) {
        float bv = c0; int bi = lane * 4;
        if (c1 > bv) { bv = c1; bi = lane * 4 + 1; }
        if (c2 > bv) { bv = c2; bi = lane * 4 + 2; }
        if (c3 > bv) { bv = c3; bi = lane * 4 + 3; }
#pragma unroll
        for (int o = 32; o > 0; o >>= 1) {
            const float ov = __shfl_xor(bv, o); const int oi = __shfl_xor(bi, o);
            if (ov > bv || (ov == bv && oi < bi)) { bv = ov; bi = oi; }
        }
        if (lane == r) { bs = bv; bc = bi; }
        if ((bi >> 2) == lane) { const int k = bi & 3; if (k == 0) c0 = -INFINITY; else if (k == 1) c1 = -INFINITY; else if (k == 2) c2 = -INFINITY; else c3 = -INFINITY; }
    }
    const int i1 = __shfl(ti0, bc >> 4), i2 = __shfl(ti1, bc & 15);
    const float mx = __shfl(bs, 0);
    float e = expf(bs - mx);
    float sum = e;
#pragma unroll
    for (int o = 8; o > 0; o >>= 1) sum += __shfl_xor(sum, o);
    if (lane < 16) { ids[(size_t)tok * 128 + h * 16 + lane] = i1 * 128 + i2; gw[(size_t)tok * 128 + h * 16 + lane] = e / sum; }
}

__global__ void __launch_bounds__(256) k_expert(const float* hn2, const float* h1, const int* ids, const float* gw, const float* U, const float* V,
                                                const float* fg, float* out) {
    const int tid = threadIdx.x, lane = tid & 63, w = tid >> 6;
    const int tok = blockIdx.x * 4 + w;
    const int b = tok / SEQ, s = tok % SEQ, m = b * TT + NMETA + s;
    float4 xv[8], acc[8];
#pragma unroll
    for (int j = 0; j < 8; ++j) { xv[j] = ((const float4*)(hn2 + (size_t)m * D))[j * 64 + lane]; acc[j] = make_float4(0.f, 0.f, 0.f, 0.f); }
    for (int p = 0; p < 128; ++p) {
        const int e = ids[(size_t)tok * 128 + p]; const float g = gw[(size_t)tok * 128 + p];
        const float4* ur = (const float4*)(U + (size_t)e * D);
        float d = 0.f;
#pragma unroll
        for (int j = 0; j < 8; ++j) { const float4 u = ur[j * 64 + lane]; d += u.x * xv[j].x + u.y * xv[j].y + u.z * xv[j].z + u.w * xv[j].w; }
        d = wave_sum(d);
        const float wgt = g * gelu_tanh(d);
        const float4* vr = (const float4*)(V + (size_t)e * D);
#pragma unroll
        for (int j = 0; j < 8; ++j) { const float4 v = vr[j * 64 + lane]; acc[j].x += wgt * v.x; acc[j].y += wgt * v.y; acc[j].z += wgt * v.z; acc[j].w += wgt * v.w; }
    }
    float ss = 0.f;
#pragma unroll
    for (int j = 0; j < 8; ++j) {
        const float4 hh = ((const float4*)(h1 + (size_t)m * D))[j * 64 + lane];
        acc[j].x += hh.x; acc[j].y += hh.y; acc[j].z += hh.z; acc[j].w += hh.w;
        ss += acc[j].x * acc[j].x + acc[j].y * acc[j].y + acc[j].z * acc[j].z + acc[j].w * acc[j].w;
    }
    ss = wave_sum(ss);
    const float r = rsqrtf(ss * (1.0f / D) + EPS);
#pragma unroll
    for (int j = 0; j < 8; ++j) {
        const float4 g4 = ((const float4*)fg)[j * 64 + lane];
        float4 o = {acc[j].x * r * g4.x, acc[j].y * r * g4.y, acc[j].z * r * g4.z, acc[j].w * r * g4.w};
        ((float4*)(out + (size_t)tok * D))[j * 64 + lane] = o;
    }
}

extern "C" void kernel_launch(void* const* d_in, const int* in_sizes, int n_in, void* d_out, int out_size, void* d_ws, size_t ws_size, hipStream_t stream) {
    const float* x = (const float*)d_in[0];
    const float* meta = (const float*)d_in[1];
    const float* norm_mix_g = (const float*)d_in[2];
    const float* w_in = (const float*)d_in[3];
    const float* b_in = (const float*)d_in[4];
    const float* sinks = (const float*)d_in[5];
    const float* conv_w = (const float*)d_in[6];
    const float* conv_b = (const float*)d_in[7];
    const float* w_r = (const float*)d_in[8];
    const float* b_r = (const float*)d_in[9];
    const float* w_i = (const float*)d_in[10];
    const float* b_i = (const float*)d_in[11];
    const float* lam = (const float*)d_in[12];
    const float* gn_attn_g = (const float*)d_in[13];
    const float* gn_lru_g = (const float*)d_in[14];
    const float* w_out = (const float*)d_in[15];
    const float* norm_ffn_g = (const float*)d_in[16];
    const float* peer_wq = (const float*)d_in[17];
    const float* sub_keys = (const float*)d_in[18];
    const float* peer_u = (const float*)d_in[19];
    const float* peer_v = (const float*)d_in[20];
    const float* final_g = (const float*)d_in[21];
    float* out = (float*)d_out;
    char* ws = (char*)d_ws;
    const size_t MiB = 1u << 20;
    float* hn = (float*)(ws + 0);
    float* proj = (float*)(ws + 130 * MiB);
    float* Aa = (float*)(ws + 340 * MiB);
    float* BX = (float*)(ws + 405 * MiB);
    int* ids = (int*)(ws + 470 * MiB);
    float* gw = (float*)(ws + 480 * MiB);
    float* mixed = hn;
    float* h1 = proj;
    float* hn2 = hn;
    float* qp = (float*)(ws + 260 * MiB);

    k_rms_row<<<MR, 256, 0, stream>>>(x, meta, nullptr, norm_mix_g, hn, 0);
    k_sgemm<0><<<dim3(IND / 64, MR / 64), 256, 0, stream>>>(hn, w_in, b_in, proj, MR, IND, D, x, meta);
    k_attn<<<MR * 4, 256, 0, stream>>>(proj, sinks, mixed);
    k_lru1<<<MR, 256, 0, stream>>>(proj, conv_w, conv_b, w_r, b_r, w_i, b_i, lam, Aa, BX);
    k_lru2<<<NB * LW / 256, 256, 0, stream>>>(proj, Aa, BX, mixed);
    k_gnorm<<<MR, 256, 0, stream>>>(mixed, gn_attn_g, gn_lru_g);
    k_sgemm<1><<<dim3(D / 64, MR / 64), 256, 0, stream>>>(mixed, w_out, nullptr, h1, MR, D, D, x, meta);
    k_rms_row<<<MR, 256, 0, stream>>>(x, meta, h1, norm_ffn_g, hn2, 1);
    k_sgemm<2><<<dim3(D / 64, MR / 64), 256, 0, stream>>>(hn2, peer_wq, nullptr, qp, MR, D, D, x, meta);
    k_retr<<<NB * SEQ * 8 / 4, 256, 0, stream>>>(qp, sub_keys, ids, gw);
    k_expert<<<NB * SEQ / 4, 256, 0, stream>>>(hn2, h1, ids, gw, peer_u, peer_v, final_g, out);
}
```

```cpp
#include <hip/hip_runtime.h>
#include <cstdio>
#include <cstdint>
#include <math.h>

#define D 2048
#define NB 8
#define SEQ 2048
#define NMETA 16
#define TT (SEQ + NMETA)
#define MR (NB * TT)
#define MREAL (NB * SEQ)
#define MPAD (MREAL + 256)
#define QD 1024
#define KVD 128
#define LW 1024
#define IND 3328
#define EPS 1e-6f
#define QSCALE (0.125f * 1.4426950408889634f)
#define GAS __attribute__((address_space(1)))
#define LAS __attribute__((address_space(3)))
namespace pg8 {
#define PG8_LAS __attribute__((address_space(3)))
typedef unsigned short bf16_t;
typedef short bf16x8 __attribute__((ext_vector_type(8)));
typedef float f32x4 __attribute__((ext_vector_type(4)));
typedef unsigned u32x4 __attribute__((ext_vector_type(4)));
constexpr int BM = 256, BK = 64, HALF = 128, HTB = HALF * BK * 2  , STAGE_BYTES = 8 * HTB, NXCD = 8, WGM = 8;

__host__ __device__ __forceinline__ int lds_byte(int r, int c) { const int st = (r >> 4) * 2 + (c >> 5), rr = r & 15, cc = c & 31, ob = rr * 64 + cc * 2; return st * 1024 + (ob ^ (((ob >> 9) & 1) << 5)); }
__host__ __device__ __forceinline__ void stage_rc(int b, int& R, int& C) { const int st = b / 1024, sb = b % 1024, swz = sb ^ (((sb >> 9) & 1) << 5); R = (st >> 1) * 16 + swz / 64; C = (st & 1) * 32 + (swz % 64) / 2; }
__host__ __device__ __forceinline__ int perm32(int rho) { const int n = rho >> 4, i = rho & 15; return 8 * (i >> 2) + 4 * n + (i & 3); }

struct Unit { int pm, pn; };
struct Gemm { const bf16_t* A; const bf16_t* Bt; int M, N, K; };

struct StaticOrder {
    int nM, nN, nwg, G, c;
    __host__ __device__ void init(int M, int N, int G_, int c_) { nM = M / BM; nN = N / BM; nwg = nM * nN; G = G_; c = c_; }
    __host__ __device__ bool next(int i, Unit& u) const {
        const long L = (long)i * G + c; if (L >= nwg) return false;
        int wgid = (int)L; { const int q = nwg / NXCD, r = nwg % NXCD, xcd = wgid % NXCD, off = wgid / NXCD; wgid = (xcd < r ? xcd * (q + 1) : r * (q + 1) + (xcd - r) * q) + off; }
        const int nig = WGM * nN, gid = wgid / nig, fm = gid * WGM, gsz = (nM - fm) < WGM ? (nM - fm) : WGM;
        u.pm = fm + ((wgid % nig) % gsz); u.pn = (wgid % nig) / gsz; return true;
    }
    __device__ __forceinline__ void a_ready(const Unit&) const {}
    __device__ __forceinline__ void done(const Unit&) const {}
};

__device__ __forceinline__ unsigned cvt_pk_bf16(float lo, float hi) { unsigned r; asm volatile("v_cvt_pk_bf16_f32 %0, %1, %2" : "=v"(r) : "v"(lo), "v"(hi)); return r; }
typedef unsigned u32x2 __attribute__((ext_vector_type(2)));
struct Order1 {
    int G, c;
    __device__ __forceinline__ bool next(int i, Unit& u) const {
        const int L = i * G + c; if (L >= 837) return false;
        if (L >= 832) { u.pm = 64; u.pn = 4 + (L - 832); return true; }
        const int nwg = 832, nN = 13;
        int wgid = L; { const int q = nwg / NXCD, xcd = wgid % NXCD, off = wgid / NXCD; wgid = xcd * q + off; }
        const int nig = WGM * nN, gid = wgid / nig, fm = gid * WGM;
        u.pm = fm + ((wgid % nig) % WGM); u.pn = (wgid % nig) / WGM; return true;
    }
    __device__ __forceinline__ void a_ready(const Unit&) const {}
    __device__ __forceinline__ void done(const Unit&) const {}
};
struct Order2 {
    int G, c;
    __device__ __forceinline__ bool next(int i, Unit& u) const {
        const int L = i * G + c; if (L >= 512) return false;
        const int nwg = 512, nN = 8;
        int wgid = L; { const int q = nwg / NXCD, xcd = wgid % NXCD, off = wgid / NXCD; wgid = xcd * q + off; }
        const int nig = WGM * nN, gid = wgid / nig, fm = gid * WGM;
        u.pm = fm + ((wgid % nig) % WGM); u.pn = (wgid % nig) / WGM; return true;
    }
    __device__ __forceinline__ void a_ready(const Unit&) const {}
    __device__ __forceinline__ void done(const Unit&) const {}
};

struct Epi1 {
    static constexpr bool PERM = true, AFTER_DRAIN = false, MIDK = false;
    bf16_t *Q, *KV, *XB, *GT; const float* rstd; const float* bias;
    __device__ __forceinline__ void midk(f32x4 (&acc)[2][2][4][2], const Unit& u, int wr, int wc, int fr, int fq) const {}
    __device__ __forceinline__ void operator()(const f32x4 (&acc)[2][2][4][2], const Unit& u, int wr, int wc, int fr, int fq) const {
        const int row0 = u.pm * BM + wr * 64 + fr;
        bf16_t* base; int ldc, colb; float sc = 1.f;
        if (u.pn < 4) { base = Q; ldc = 1024; colb = u.pn * BM; sc = QSCALE; }
        else if (u.pn == 4) { base = KV; ldc = 256; colb = 0; }
        else if (u.pn < 9) { base = XB; ldc = 1024; colb = (u.pn - 5) * BM; }
        else { base = GT; ldc = 1024; colb = (u.pn - 9) * BM; }
        const int col0 = colb + wc * 32 + 8 * fq, bcol0 = u.pn * BM + wc * 32 + 8 * fq;
        f32x4 bv[2][2];
#pragma unroll
        for (int bj = 0; bj < 2; ++bj)
#pragma unroll
            for (int n = 0; n < 2; ++n) bv[bj][n] = *(const f32x4*)(bias + bcol0 + bj * HALF + 4 * n);
#pragma unroll
        for (int ai = 0; ai < 2; ++ai)
#pragma unroll
            for (int m = 0; m < 4; ++m) {
                const int row = row0 + ai * HALF + m * 16; const float rs = rstd[row];
                bf16_t* rowp = base + (size_t)row * ldc + col0;
#pragma unroll
                for (int bj = 0; bj < 2; ++bj) {
                    f32x4 v0 = (acc[ai][bj][m][0] * rs + bv[bj][0]) * sc, v1 = (acc[ai][bj][m][1] * rs + bv[bj][1]) * sc;
                    u32x4 w; w.x = cvt_pk_bf16(v0[0], v0[1]); w.y = cvt_pk_bf16(v0[2], v0[3]); w.z = cvt_pk_bf16(v1[0], v1[1]); w.w = cvt_pk_bf16(v1[2], v1[3]);
                    *(u32x4*)(rowp + bj * HALF) = w; } }
    }
};
struct Epi2 {
    static constexpr bool PERM = true, AFTER_DRAIN = false, MIDK = true;
    bf16_t* H1; const float* x; float* SS2; const LAS float* tbl; int pm0;
    __device__ __forceinline__ void midk(f32x4 (&acc)[2][2][4][2], const Unit& u, int wr, int wc, int fr, int fq) const {
        const LAS float* t = tbl + (u.pm == pm0 ? 0 : 512);
#pragma unroll
        for (int ai = 0; ai < 2; ++ai)
#pragma unroll
            for (int m = 0; m < 4; ++m) { const float ra = t[(ai * HALF + wr * 64 + m * 16 + fr) * 2];
#pragma unroll
                for (int bj = 0; bj < 2; ++bj)
#pragma unroll
                    for (int n = 0; n < 2; ++n) acc[ai][bj][m][n] = acc[ai][bj][m][n] * ra; }
    }
    __device__ __forceinline__ void operator()(const f32x4 (&acc)[2][2][4][2], const Unit& u, int wr, int wc, int fr, int fq) const {
        const LAS float* t = tbl + (u.pm == pm0 ? 0 : 512);
        const int col0 = u.pn * BM + wc * 32 + 8 * fq;
#pragma unroll
        for (int ai = 0; ai < 2; ++ai)
#pragma unroll
            for (int m = 0; m < 4; ++m) {
                const int rl = ai * HALF + wr * 64 + m * 16 + fr; const size_t row = (size_t)u.pm * BM + rl; const float rs = t[rl * 2 + 1];
                float ss = 0.f;
#pragma unroll
                for (int bj = 0; bj < 2; ++bj) {
                    const f32x4 x0 = *(const f32x4*)(x + row * 2048 + col0 + bj * HALF), x1 = *(const f32x4*)(x + row * 2048 + col0 + bj * HALF + 4);
                    const f32x4 v0 = acc[ai][bj][m][0] * rs + x0, v1 = acc[ai][bj][m][1] * rs + x1;
                    ss += (v0[0] * v0[0] + v0[1] * v0[1]) + (v0[2] * v0[2] + v0[3] * v0[3]) + (v1[0] * v1[0] + v1[1] * v1[1]) + (v1[2] * v1[2] + v1[3] * v1[3]);
                    u32x4 w; w.x = cvt_pk_bf16(v0[0], v0[1]); w.y = cvt_pk_bf16(v0[2], v0[3]); w.z = cvt_pk_bf16(v1[0], v1[1]); w.w = cvt_pk_bf16(v1[2], v1[3]);
                    *(u32x4*)(H1 + row * 2048 + col0 + bj * HALF) = w; }
                ss += __shfl_xor(ss, 16); ss += __shfl_xor(ss, 32);
                if (fq == 0) SS2[row * 32 + u.pn * 4 + wc] = ss;
            }
    }
};
struct Epi3 {
    static constexpr bool PERM = true, AFTER_DRAIN = false, MIDK = false;
    bf16_t* O;
    __device__ __forceinline__ void midk(f32x4 (&acc)[2][2][4][2], const Unit& u, int wr, int wc, int fr, int fq) const {}
    __device__ __forceinline__ void operator()(const f32x4 (&acc)[2][2][4][2], const Unit& u, int wr, int wc, int fr, int fq) const {
        const int col0 = u.pn * BM + wc * 32 + 8 * fq;
#pragma unroll
        for (int ai = 0; ai < 2; ++ai)
#pragma unroll
            for (int m = 0; m < 4; ++m) { const size_t row = (size_t)u.pm * BM + ai * HALF + wr * 64 + m * 16 + fr;
#pragma unroll
                for (int bj = 0; bj < 2; ++bj) { const f32x4 v0 = acc[ai][bj][m][0], v1 = acc[ai][bj][m][1];
                    u32x4 w; w.x = cvt_pk_bf16(v0[0], v0[1]); w.y = cvt_pk_bf16(v0[2], v0[3]); w.z = cvt_pk_bf16(v1[0], v1[1]); w.w = cvt_pk_bf16(v1[2], v1[3]);
                    *(u32x4*)(O + row * 2048 + col0 + bj * HALF) = w; } }
    }
};
template <class Epi, class Sched, bool ALIGN_EPI = false, bool SP2 = false>
__device__ __forceinline__ void gemm_phase(PG8_LAS unsigned char* lds, const Gemm g, const Sched& S, const Epi& E) {
    const int tid = threadIdx.x, wid = __builtin_amdgcn_readfirstlane(tid >> 6), lane = tid & 63, wr = wid >> 2, wc = wid & 3, fr = lane & 15, fq = lane >> 4;
    const int K = g.K, nt = K / BK;
    unsigned voffA[2], voffB[2];
#pragma unroll
    for (int i = 0; i < 2; ++i) { int R, C; stage_rc(tid * 16 + i * 8192, R, C); const int Rb = Epi::PERM ? ((R & ~31) + perm32(R & 31)) : R;
        voffA[i] = (unsigned)(R * K + C) * 2u; voffB[i] = (unsigned)(Rb * K + C) * 2u; }
    const size_t kstep = (size_t)(BK * 2);
    const size_t hstep = (size_t)HALF * K * 2;
    const size_t tstep = 2 * hstep;
    const unsigned ldsw = (unsigned)wid * 1024u;
    const int aoff = lds_byte(wr * 64 + fr, fq * 8), boff = lds_byte(wc * 32 + fr, fq * 8);
#define PG8_SA(b, h) (((b) * 2 + (h)) * HTB)
#define PG8_SB(b, h) ((4 + (b) * 2 + (h)) * HTB)
#define PG8_STAGE(bufoff, gbase, voff) do { _Pragma("unroll") for (int _i = 0; _i < 2; ++_i) \
        __builtin_amdgcn_global_load_lds((const unsigned*)((const char*)(gbase) + (voff)[_i]), (PG8_LAS unsigned*)(lds + (bufoff) + ldsw + _i * 8192), 16, 0, 0); } while (0)
#define PG8_LDA(dst, b, h) do { _Pragma("unroll") for (int m = 0; m < 4; ++m) _Pragma("unroll") for (int k = 0; k < 2; ++k) dst[m][k] = *(const PG8_LAS bf16x8*)(lds + PG8_SA(b, h) + aoff + m * 2048 + k * 1024); } while (0)
#define PG8_LDB(dst, b, h) do { _Pragma("unroll") for (int n = 0; n < 2; ++n) _Pragma("unroll") for (int k = 0; k < 2; ++k) dst[n][k] = *(const PG8_LAS bf16x8*)(lds + PG8_SB(b, h) + boff + n * 2048 + k * 1024); } while (0)
#define PG8_MMA(ai, bj, At, Bt) do { __builtin_amdgcn_s_setprio(1); _Pragma("unroll") for (int m = 0; m < 4; ++m) _Pragma("unroll") for (int n = 0; n < 2; ++n) _Pragma("unroll") for (int k = 0; k < 2; ++k) \
        acc[ai][bj][m][n] = __builtin_amdgcn_mfma_f32_16x16x32_bf16(Bt[n][k], At[m][k], acc[ai][bj][m][n], 0, 0, 0); __builtin_amdgcn_s_setprio(0); } while (0)
#define PG8_WAIT_V(n) asm volatile("s_waitcnt vmcnt(" #n ")" ::: "memory")
#define PG8_WAIT_L(n) asm volatile("s_waitcnt lgkmcnt(" #n ")" ::: "memory")
#define PG8_BAR __builtin_amdgcn_s_barrier()
#define PG8_SCHED __builtin_amdgcn_sched_barrier(0)
    Unit cur, nxt; int ui = 0;
    if (!S.next(0, cur)) return;
    f32x4 acc[2][2][4][2];
#pragma unroll
    for (int a = 0; a < 2; ++a)
#pragma unroll
        for (int b = 0; b < 2; ++b)
#pragma unroll
            for (int m = 0; m < 4; ++m)
#pragma unroll
                for (int n = 0; n < 2; ++n) acc[a][b][m][n] = (f32x4){0.f, 0.f, 0.f, 0.f};
    bf16x8 At[4][2], B0[2][2], B1[2][2];
    const char* cA = (const char*)g.A + (size_t)cur.pm * tstep; const char* cB = (const char*)g.Bt + (size_t)cur.pn * tstep;
    S.a_ready(cur);
    if constexpr (SP2) {
        PG8_STAGE(PG8_SB(0, 0), cB, voffB); PG8_STAGE(PG8_SB(0, 1), cB + hstep, voffB); PG8_STAGE(PG8_SA(0, 0), cA, voffA); PG8_STAGE(PG8_SA(0, 1), cA + hstep, voffA);
        if (wr == 1) PG8_BAR;
        PG8_WAIT_V(2); PG8_BAR;
        PG8_STAGE(PG8_SB(1, 0), cB + kstep, voffB); PG8_STAGE(PG8_SA(1, 0), cA + kstep, voffA); PG8_STAGE(PG8_SB(1, 1), cB + hstep + kstep, voffB);
        PG8_WAIT_V(6); PG8_BAR;
    } else {
        PG8_STAGE(PG8_SB(0, 0), cB, voffB); PG8_STAGE(PG8_SA(0, 0), cA, voffA); PG8_STAGE(PG8_SB(0, 1), cB + hstep, voffB); PG8_STAGE(PG8_SA(0, 1), cA + hstep, voffA);
        if (wr == 1) PG8_BAR;
        PG8_WAIT_V(4); PG8_BAR;
        PG8_STAGE(PG8_SB(1, 0), cB + kstep, voffB); PG8_STAGE(PG8_SA(1, 0), cA + kstep, voffA); PG8_STAGE(PG8_SB(1, 1), cB + hstep + kstep, voffB);
        PG8_WAIT_V(6); PG8_BAR;
    }
    for (;;) {
        const bool has_next = S.next(ui + 1, nxt);
        const char* nA = has_next ? (const char*)g.A + (size_t)nxt.pm * tstep : cA; const char* nB = has_next ? (const char*)g.Bt + (size_t)nxt.pn * tstep : cB;
        for (int t = 0; t < nt; t += 2) {
            if constexpr (Epi::MIDK) { if (t == nt / 2) E.midk(acc, cur, wr, wc, fr, fq); }
            const bool last = (t == nt - 2);
            const char* a1 = cA + (size_t)(t + 1) * kstep;
            const char* a2 = last ? nA : cA + (size_t)(t + 2) * kstep; const char* b2 = last ? nB : cB + (size_t)(t + 2) * kstep;
            const char* a3 = a2 + kstep; const char* b3 = b2 + kstep;
            if (last && has_next) S.a_ready(nxt);
            if constexpr (SP2) {
            PG8_LDB(B0, 0, 0); PG8_LDB(B1, 0, 1); PG8_SCHED; PG8_LDA(At, 0, 0); PG8_STAGE(PG8_SA(1, 1), a1 + hstep, voffA);
            PG8_WAIT_V(8); PG8_WAIT_L(0); PG8_BAR; PG8_MMA(0, 0, At, B0); PG8_MMA(0, 1, At, B1); PG8_BAR; PG8_SCHED;
            PG8_LDA(At, 0, 1); PG8_STAGE(PG8_SB(0, 0), b2, voffB); PG8_STAGE(PG8_SB(0, 1), b2 + hstep, voffB); PG8_STAGE(PG8_SA(0, 0), a2, voffA);
            PG8_WAIT_V(8); PG8_WAIT_L(0); PG8_BAR; PG8_MMA(1, 0, At, B0); PG8_MMA(1, 1, At, B1); PG8_BAR; PG8_SCHED;
            PG8_LDB(B0, 1, 0); PG8_LDB(B1, 1, 1); PG8_SCHED; PG8_LDA(At, 1, 0); PG8_STAGE(PG8_SA(0, 1), a2 + hstep, voffA);
            PG8_WAIT_V(8); PG8_WAIT_L(0); PG8_BAR; PG8_MMA(0, 0, At, B0); PG8_MMA(0, 1, At, B1); PG8_BAR; PG8_SCHED;
            PG8_LDA(At, 1, 1); PG8_STAGE(PG8_SB(1, 0), b3, voffB); PG8_STAGE(PG8_SB(1, 1), b3 + hstep, voffB); PG8_STAGE(PG8_SA(1, 0), a3, voffA);
            PG8_WAIT_V(8); PG8_WAIT_L(0); PG8_BAR; PG8_MMA(1, 0, At, B0); PG8_MMA(1, 1, At, B1); PG8_BAR; PG8_SCHED;
            } else {
            PG8_LDB(B0, 0, 0); PG8_SCHED; PG8_LDA(At, 0, 0); PG8_STAGE(PG8_SA(1, 1), a1 + hstep, voffA);
            PG8_WAIT_L(8); PG8_BAR; PG8_WAIT_L(0); PG8_MMA(0, 0, At, B0); PG8_BAR; PG8_SCHED;
            PG8_LDB(B1, 0, 1); PG8_STAGE(PG8_SB(0, 0), b2, voffB);
            PG8_BAR; PG8_WAIT_L(0); PG8_MMA(0, 1, At, B1); PG8_BAR;
            PG8_LDA(At, 0, 1); PG8_STAGE(PG8_SA(0, 0), a2, voffA);
            PG8_BAR; PG8_WAIT_L(0); PG8_MMA(1, 0, At, B0); PG8_BAR; PG8_SCHED;
            PG8_STAGE(PG8_SB(0, 1), b2 + hstep, voffB);
            PG8_WAIT_V(6); PG8_BAR; PG8_MMA(1, 1, At, B1); PG8_BAR;
            PG8_LDB(B0, 1, 0); PG8_SCHED; PG8_LDA(At, 1, 0); PG8_STAGE(PG8_SA(0, 1), a2 + hstep, voffA);
            PG8_WAIT_L(8); PG8_BAR; PG8_WAIT_L(0); PG8_MMA(0, 0, At, B0); PG8_BAR; PG8_SCHED;
            PG8_LDB(B1, 1, 1); PG8_STAGE(PG8_SB(1, 0), b3, voffB);
            PG8_BAR; PG8_WAIT_L(0); PG8_MMA(0, 1, At, B1); PG8_BAR;
            PG8_LDA(At, 1, 1); PG8_STAGE(PG8_SA(1, 0), a3, voffA);
            PG8_BAR; PG8_WAIT_L(0); PG8_MMA(1, 0, At, B0); PG8_BAR; PG8_SCHED;
            PG8_STAGE(PG8_SB(1, 1), b3 + hstep, voffB);
            PG8_WAIT_V(6); PG8_BAR; PG8_MMA(1, 1, At, B1); PG8_BAR;
            }
        }
        if constexpr (ALIGN_EPI) { if (wr == 0) PG8_BAR; }
        if constexpr (!Epi::AFTER_DRAIN) { E(acc, cur, wr, wc, fr, fq); S.done(cur); }
        if (!has_next) break;
#pragma unroll
        for (int a = 0; a < 2; ++a)
#pragma unroll
            for (int b = 0; b < 2; ++b)
#pragma unroll
                for (int m = 0; m < 4; ++m)
#pragma unroll
                    for (int n = 0; n < 2; ++n) acc[a][b][m][n] = (f32x4){0.f, 0.f, 0.f, 0.f};
        cur = nxt; cA = nA; cB = nB; ++ui;
        if constexpr (ALIGN_EPI) { if (wr == 1) PG8_BAR; }
    }
    PG8_WAIT_V(0);
    if constexpr (!ALIGN_EPI) { if (wr == 0) PG8_BAR; }
    PG8_BAR;
    if constexpr (Epi::AFTER_DRAIN) { E.fused(acc, cur, wr, wc, fr, fq, lds, wid, lane); S.done(cur); }
#undef PG8_SA
#undef PG8_SB
#undef PG8_STAGE
#undef PG8_LDA
#undef PG8_LDB
#undef PG8_MMA
#undef PG8_WAIT_V
#undef PG8_WAIT_L
#undef PG8_BAR
#undef PG8_SCHED
}
}
#define XB_TMO      128
#define XB_XCNT(j)  (256  + 64 * (j))
#define XB_XSUB(j)  (1280 + 64 * (j))
#define XB_XGEN(j)  (2304 + 64 * (j))
#define XB_TOP      3328
#define XB_TOPGEN   3392
#define XCD_BAR_WORDS 3456
#define XB_SPIN_CAP (1u << 18)

__device__ __forceinline__ unsigned xb_ld(unsigned* p)              { return __hip_atomic_load(p, __ATOMIC_RELAXED, __HIP_MEMORY_SCOPE_AGENT); }
__device__ __forceinline__ unsigned xb_add(unsigned* p, unsigned v) { return __hip_atomic_fetch_add(p, v, __ATOMIC_RELAXED, __HIP_MEMORY_SCOPE_AGENT); }
__device__ __forceinline__ unsigned xb_xcc_id() { return (unsigned)__builtin_amdgcn_s_getreg((3 << 11) | 20) & 0xFu; }
#define XB_SPIN(cond, bar) do { unsigned _sp = 0; while (cond) { __builtin_amdgcn_s_sleep(1); \
    if ((++_sp & 255u) == 0u) { if (xb_ld(&(bar)[XB_TMO])) break; if (_sp > XB_SPIN_CAP) { atomicAdd(&(bar)[XB_TMO], 1u); break; } } } } while (0)

struct XcdBarrier {
    unsigned* bar; unsigned x;
    volatile LAS unsigned* st;
};

__device__ __forceinline__ XcdBarrier xcd_barrier_post(unsigned* bar, volatile LAS unsigned* st) {
    XcdBarrier b; b.bar = bar; b.x = xb_xcc_id(); b.st = st;
    if (threadIdx.x == 0) (void)xb_add(&bar[XB_XCNT(b.x)], 1u);
    return b;
}
__device__ __forceinline__ void xcd_barrier_complete(unsigned* bar, unsigned x, unsigned& nloc, unsigned& nx) {
    const unsigned G = gridDim.x * gridDim.y * gridDim.z;
    unsigned sum, cnt, mine, sp = 0u;
    for (;;) {
        sum = 0u; cnt = 0u; mine = 0u;
#pragma unroll
        for (unsigned j = 0; j < 16; ++j) { const unsigned c = xb_ld(&bar[XB_XCNT(j)]); sum += c; cnt += (c > 0u) ? 1u : 0u; mine = (j == x) ? c : mine; }
        if (sum == G) break;
        __builtin_amdgcn_s_sleep(1);
        if ((++sp & 255u) == 0u) { if (xb_ld(&bar[XB_TMO])) break; if (sp > XB_SPIN_CAP) { atomicAdd(&bar[XB_TMO], 1u); break; } }
    }
    nloc = mine > 0u ? mine : 1u; nx = cnt > 0u ? cnt : 1u;
}

__device__ __forceinline__ void xcd_barrier(const XcdBarrier& b) {
    asm volatile("s_waitcnt vmcnt(0)" ::: "memory");
    __syncthreads();
    if (threadIdx.x == 0) {
        unsigned* bar = b.bar;
        __builtin_amdgcn_s_waitcnt(0);
        unsigned nloc = b.st[0], nx = b.st[1];
        if (nloc == 0u) { xcd_barrier_complete(bar, b.x, nloc, nx); b.st[0] = nloc; b.st[1] = nx; }
        const unsigned old = xb_add(&bar[XB_XSUB(b.x)], 1u);
        const unsigned gen = old / nloc;
        if (old + 1u == (gen + 1u) * nloc) {
            __builtin_amdgcn_fence(__ATOMIC_RELEASE, "agent");
            asm volatile("s_waitcnt vmcnt(0)" ::: "memory");
            const unsigned og = xb_add(&bar[XB_TOP], 1u);
            const unsigned tg = og / nx;
            if (og + 1u == (tg + 1u) * nx) xb_add(&bar[XB_TOPGEN], 1u);
            else XB_SPIN(xb_ld(&bar[XB_TOPGEN]) == tg, bar);
            __builtin_amdgcn_fence(__ATOMIC_ACQUIRE, "agent");
            xb_add(&bar[XB_XGEN(b.x)], 1u);
            asm volatile("s_waitcnt vmcnt(0)" ::: "memory");
        } else {
            XB_SPIN(xb_ld(&bar[XB_XGEN(b.x)]) == gen, bar);
            __builtin_amdgcn_fence(__ATOMIC_ACQUIRE, "agent");
            asm volatile("s_waitcnt vmcnt(0)" ::: "memory");
        }
    }
    __syncthreads();
}

constexpr int NWAVES = 8;
constexpr size_t MiB = 1u << 20;
constexpr size_t WS_CTL = 0, CTL_ZERO_BYTES = 1 * MiB;
constexpr size_t WS_W1T = 2 * MiB;
constexpr size_t WS_W2T = 16 * MiB;
constexpr size_t WS_W3T = 24 * MiB;
constexpr size_t WS_SKB = 32 * MiB;
constexpr size_t WS_RSTD1 = 33 * MiB;
constexpr size_t WS_SSA = 34 * MiB;
constexpr size_t WS_SSL = 35 * MiB;
constexpr size_t WS_SS2 = 37 * MiB;
constexpr size_t WS_RSTD2 = 39 * MiB;
constexpr size_t WS_IDS = 40 * MiB;
constexpr size_t WS_GW = 48 * MiB;
constexpr size_t WS_UB = 64 * MiB;
constexpr size_t WS_VB = 128 * MiB;
constexpr size_t WS_A1 = 192 * MiB;
constexpr size_t WS_Q = 258 * MiB;
constexpr size_t WS_KV = 290 * MiB;
constexpr size_t WS_XB = 299 * MiB;
constexpr size_t WS_GT = 332 * MiB;
constexpr size_t WS_H1 = 364 * MiB;
constexpr size_t WS_END = 428 * MiB;
constexpr int CW_BAR = 4096;

constexpr int RING_OFF = 0, RING_BYTES = 131072;
constexpr int LDSCTL_OFF = RING_BYTES, MISC_OFF = LDSCTL_OFF + 320;
constexpr int LDS_BYTES = 147456;

typedef unsigned short bf16;
typedef unsigned v4u __attribute__((ext_vector_type(4)));
typedef float f32x4 __attribute__((ext_vector_type(4)));
typedef short bf16x8 __attribute__((ext_vector_type(8)));
typedef GAS unsigned gu32;
#define RLX_AGENT __ATOMIC_RELAXED, __HIP_MEMORY_SCOPE_AGENT
#define LDS_WAIT() asm volatile("s_waitcnt lgkmcnt(0)" ::: "memory")
#define VM_WAIT() asm volatile("s_waitcnt vmcnt(0)" ::: "memory")
__device__ __forceinline__ unsigned f2bf(float f) { unsigned u = __builtin_bit_cast(unsigned, f); return (u + 0x7fffu + ((u >> 16) & 1u)) >> 16; }
__device__ __forceinline__ unsigned pk2(float lo, float hi) { return f2bf(lo) | (f2bf(hi) << 16); }
__device__ __forceinline__ float bf2f(unsigned short b) { return __builtin_bit_cast(float, (unsigned)b << 16); }

namespace p2 {
typedef float f32x16 __attribute__((ext_vector_type(16)));
typedef unsigned u32x2 __attribute__((ext_vector_type(2)));
constexpr float LOG2E = 1.4426950408889634f;
constexpr float NEGBIG = -1e30f;
__device__ __forceinline__ int crow(int r, int hi) { return (r & 3) + 8 * (r >> 2) + 4 * hi; }
__device__ __forceinline__ unsigned cvtpk(float lo, float hi) { unsigned r; asm volatile("v_cvt_pk_bf16_f32 %0, %1, %2" : "=v"(r) : "v"(lo), "v"(hi)); return r; }
__device__ __forceinline__ float ex2(float x) { return __builtin_amdgcn_exp2f(x); }
__device__ __forceinline__ float rcp(float x) { return __builtin_amdgcn_rcpf(x); }
__device__ __forceinline__ float gelu_fast(float x) { return x * rcp(1.0f + ex2(-2.302208198f * x * (1.0f + 0.044715f * x * x))); }

constexpr int A_KS = 0, A_KSP = 144, A_VT = 288 * 144, A_VTP = 584, A_ST = A_VT + 64 * 584, A_END = A_ST + 8 * 4096;
__device__ __forceinline__ void attn_unit(LAS unsigned char* lds, int b, int qblk, int kvh, const bf16* QB, const bf16* KVB, const float* sinks, bf16* MIX, float* SSA, int tid) {
    const int lane = tid & 63, wave = __builtin_amdgcn_readfirstlane(tid >> 6), r = lane & 31, hi = lane >> 5;
    const int q0 = qblk * 128, hq = kvh * 8 + wave;
    for (int it = 0; it < 5; ++it) {
        const int cid = it * 512 + tid;
        if (cid < 288 * 8) {
            const int key = cid >> 3, ch = cid & 7;
            bool valid; size_t row = 0;
            if (key < 256) { const int pos = q0 - 128 + key; valid = pos >= 0; row = (size_t)b * SEQ + pos; }
            else if (key < 272) { valid = true; row = (size_t)MREAL + (key - 256); }
            else valid = false;
            v4u kv = {0u, 0u, 0u, 0u}, vv = {0u, 0u, 0u, 0u};
            if (valid) { kv = *(const GAS v4u*)(KVB + row * 256 + kvh * 64 + ch * 8); vv = *(const GAS v4u*)(KVB + row * 256 + 128 + kvh * 64 + ch * 8); }
            *(LAS v4u*)(lds + A_KS + key * A_KSP + ch * 16) = kv;
            LAS unsigned short* vt = (LAS unsigned short*)(lds + A_VT);
#pragma unroll
            for (int j = 0; j < 8; ++j) { const unsigned wv = vv[j >> 1]; vt[(ch * 8 + j) * (A_VTP / 2) + key] = (unsigned short)((j & 1) ? (wv >> 16) : (wv & 0xffffu)); }
        }
    }
    __syncthreads();
    const float sink2 = sinks[hq] * LOG2E;
    for (int qg = 0; qg < 4; ++qg) {
        const size_t mrow = (size_t)b * SEQ + q0 + 32 * qg + r;
        bf16x8 qf[4];
#pragma unroll
        for (int ks = 0; ks < 4; ++ks) qf[ks] = *(const GAS bf16x8*)(QB + mrow * 1024 + hq * 64 + ks * 16 + hi * 8);
        f32x16 s[6];
#pragma unroll
        for (int t = 0; t < 6; ++t) {
            const int kbase = t < 5 ? 32 * (qg + t) : 256;
            f32x16 acc = {0.f, 0.f, 0.f, 0.f, 0.f, 0.f, 0.f, 0.f, 0.f, 0.f, 0.f, 0.f, 0.f, 0.f, 0.f, 0.f};
#pragma unroll
            for (int ks = 0; ks < 4; ++ks) {
                const bf16x8 kf = *(const LAS bf16x8*)(lds + A_KS + (kbase + r) * A_KSP + ks * 32 + hi * 16);
                acc = __builtin_amdgcn_mfma_f32_32x32x16_bf16(kf, qf[ks], acc, 0, 0, 0);
            }
            s[t] = acc;
        }
        const bool blk0 = (qblk == 0);
#pragma unroll
        for (int reg = 0; reg < 16; ++reg) {
            const int j = crow(reg, hi);
            s[0][reg] = (j > r) ? s[0][reg] : NEGBIG;
            s[4][reg] = (j <= r) ? s[4][reg] : NEGBIG;
            s[5][reg] = (j < 16) ? s[5][reg] : NEGBIG;
        }
#pragma unroll
        for (int t = 0; t < 4; ++t) if (blk0 && (qg + t < 4)) {
#pragma unroll
            for (int reg = 0; reg < 16; ++reg) s[t][reg] = NEGBIG;
        }
        float m = sink2;
#pragma unroll
        for (int t = 0; t < 6; ++t)
#pragma unroll
            for (int reg = 0; reg < 16; ++reg) m = fmaxf(m, s[t][reg]);
        m = fmaxf(m, __shfl_xor(m, 32));
        float l = 0.f;
#pragma unroll
        for (int t = 0; t < 6; ++t)
#pragma unroll
            for (int reg = 0; reg < 16; ++reg) { const float p = ex2(s[t][reg] - m); s[t][reg] = p; l += p; }
        l += __shfl_xor(l, 32);
        l += ex2(sink2 - m);
        const float linv = 1.0f / l;
        f32x16 o0 = {0.f, 0.f, 0.f, 0.f, 0.f, 0.f, 0.f, 0.f, 0.f, 0.f, 0.f, 0.f, 0.f, 0.f, 0.f, 0.f}, o1 = o0;
#pragma unroll
        for (int t = 0; t < 6; ++t) {
            const int kbase = t < 5 ? 32 * (qg + t) : 256;
#pragma unroll
            for (int ss = 0; ss < 2; ++ss) {
                v4u pw; pw.x = cvtpk(s[t][8 * ss + 0], s[t][8 * ss + 1]); pw.y = cvtpk(s[t][8 * ss + 2], s[t][8 * ss + 3]);
                pw.z = cvtpk(s[t][8 * ss + 4], s[t][8 * ss + 5]); pw.w = cvtpk(s[t][8 * ss + 6], s[t][8 * ss + 7]);
                const bf16x8 pa = __builtin_bit_cast(bf16x8, pw);
                const int ko = (kbase + 16 * ss + 4 * hi) * 2;
                {   const u32x2 lo = *(const LAS u32x2*)(lds + A_VT + r * A_VTP + ko), h2 = *(const LAS u32x2*)(lds + A_VT + r * A_VTP + ko + 16);
                    v4u vw; vw.x = lo.x; vw.y = lo.y; vw.z = h2.x; vw.w = h2.y;
                    o0 = __builtin_amdgcn_mfma_f32_32x32x16_bf16(pa, __builtin_bit_cast(bf16x8, vw), o0, 0, 0, 0); }
                {   const u32x2 lo = *(const LAS u32x2*)(lds + A_VT + (32 + r) * A_VTP + ko), h2 = *(const LAS u32x2*)(lds + A_VT + (32 + r) * A_VTP + ko + 16);
                    v4u vw; vw.x = lo.x; vw.y = lo.y; vw.z = h2.x; vw.w = h2.y;
                    o1 = __builtin_amdgcn_mfma_f32_32x32x16_bf16(pa, __builtin_bit_cast(bf16x8, vw), o1, 0, 0, 0); }
            }
        }
        LAS unsigned short* stg = (LAS unsigned short*)(lds + A_ST + wave * 4096);
#pragma unroll
        for (int reg = 0; reg < 16; ++reg) {
            const int qr = crow(reg, hi); const float li = __shfl(linv, qr);
            stg[qr * 64 + r] = (unsigned short)f2bf(o0[reg] * li);
            stg[qr * 64 + 32 + r] = (unsigned short)f2bf(o1[reg] * li);
        }
        asm volatile("s_waitcnt lgkmcnt(0)" ::: "memory");
#pragma unroll
        for (int i = 0; i < 4; ++i) {
            const int row = i * 8 + (lane >> 3), ch = lane & 7;
            const v4u v = *(const LAS v4u*)(stg + row * 64 + ch * 8);
            float ss = 0.f;
#pragma unroll
            for (int k = 0; k < 4; ++k) { const float a = __builtin_bit_cast(float, v[k] << 16), c = __builtin_bit_cast(float, v[k] & 0xffff0000u); ss += a * a + c * c; }
            ss += __shfl_xor(ss, 1); ss += __shfl_xor(ss, 2); ss += __shfl_xor(ss, 4);
            const size_t orow = (size_t)b * SEQ + q0 + 32 * qg + row;
            *(GAS v4u*)(MIX + orow * D + hq * 64 + ch * 8) = v;
            if (ch == 0) SSA[orow * 16 + hq] = ss;
        }
        asm volatile("s_waitcnt lgkmcnt(0)" ::: "memory");
    }
    __syncthreads();
}

constexpr int L_XS = 0, L_XC = 33280, L_XCF = L_XC + 36864, L_GS = L_XCF + 32768, L_W = L_GS + 16384, L_CT = L_W + 9216, L_END = L_CT + 2048;
static_assert(L_END <= 131072, "lru lds");
struct LruP { const float *conv_w, *conv_b, *w_r, *b_r, *w_i, *b_i, *lam; };
__device__ __forceinline__ void lru_unit(LAS unsigned char* lds, int b, int nb, int cg, const bf16* XBB, const bf16* GTB, const LruP P, bf16* MIX, float* SSL, int tid) {
    const int lane = tid & 63, wave = __builtin_amdgcn_readfirstlane(tid >> 6), r = lane & 31, hi = lane >> 5;
    {
        LAS unsigned short* wt = (LAS unsigned short*)(lds + L_W);
#pragma unroll
        for (int i = 0; i < 4; ++i) {
            const int e = tid + 512 * i, c = e >> 5, dl = e & 31;
            const size_t gi = (size_t)(nb * 64 + c) * 64 + 32 * cg + dl;
            wt[dl * 72 + c] = (unsigned short)f2bf(P.w_r[gi]);
            wt[32 * 72 + dl * 72 + c] = (unsigned short)f2bf(P.w_i[gi]);
        }
    }
    const int cc = tid & 63, chc = nb * 64 + cc;
    const float cw0 = P.conv_w[0 * LW + chc], cw1 = P.conv_w[1 * LW + chc], cw2 = P.conv_w[2 * LW + chc], cw3 = P.conv_w[3 * LW + chc], cbv = P.conv_b[chc];
    const int chd = nb * 64 + 32 * cg + r;
    const float br = P.b_r[chd], bi = P.b_i[chd];
    const float ls8 = -8.0f * log1pf(expf(-P.lam[chd])) * LOG2E;
    float state = 0.f;
    for (int tile = 0; tile < 9; ++tile) {
        for (int it = 0; it < 5; ++it) {
            const int cid = it * 512 + tid;
            if (cid < 259 * 8) {
                const int j = cid >> 3, ch = cid & 7, t = j - 3;
                bool valid; size_t row = 0;
                if (tile == 0) { valid = (t >= 0 && t < NMETA); row = (size_t)MREAL + t; }
                else if (tile == 1 && t < 0) { valid = true; row = (size_t)MREAL + NMETA + t; }
                else { valid = true; row = (size_t)b * SEQ + 256 * (tile - 1) + t; }
                v4u v = {0u, 0u, 0u, 0u};
                if (valid) v = *(const GAS v4u*)(XBB + row * 1024 + nb * 64 + ch * 8);
                *(LAS v4u*)(lds + L_XS + j * 128 + ch * 16) = v;
            }
        }
        if (tile > 0) {
#pragma unroll
            for (int it = 0; it < 2; ++it) {
                const int cid = it * 512 + tid, t = cid >> 2, ch = cid & 3;
                const size_t row = (size_t)b * SEQ + 256 * (tile - 1) + t;
                *(LAS v4u*)(lds + L_GS + t * 64 + ch * 16) = *(const GAS v4u*)(GTB + row * 1024 + nb * 64 + 32 * cg + ch * 8);
            }
        }
        __syncthreads();
        {
            const LAS unsigned short* xs = (const LAS unsigned short*)(lds + L_XS);
            LAS unsigned short* xc = (LAS unsigned short*)(lds + L_XC);
            LAS float* xcf = (LAS float*)(lds + L_XCF);
            const int t0 = 32 * wave;
            float x0 = bf2f(xs[(t0 + 0) * 64 + cc]), x1 = bf2f(xs[(t0 + 1) * 64 + cc]), x2 = bf2f(xs[(t0 + 2) * 64 + cc]);
#pragma unroll 8
            for (int k = 0; k < 32; ++k) {
                const float x3 = bf2f(xs[(t0 + k + 3) * 64 + cc]);
                const float v = cbv + cw0 * x0 + cw1 * x1 + cw2 * x2 + cw3 * x3;
                xc[(t0 + k) * 72 + cc] = (unsigned short)f2bf(v);
                if ((cc >> 5) == cg) xcf[(t0 + k) * 32 + (cc & 31)] = v;
                x0 = x1; x1 = x2; x2 = x3;
            }
        }
        __syncthreads();
        f32x16 aR = {0.f, 0.f, 0.f, 0.f, 0.f, 0.f, 0.f, 0.f, 0.f, 0.f, 0.f, 0.f, 0.f, 0.f, 0.f, 0.f}, aI = aR;
#pragma unroll
        for (int ks = 0; ks < 4; ++ks) {
            const bf16x8 xa = *(const LAS bf16x8*)(lds + L_XC + (32 * wave + r) * 144 + ks * 32 + hi * 16);
            const bf16x8 wr_ = *(const LAS bf16x8*)(lds + L_W + r * 144 + ks * 32 + hi * 16);
            const bf16x8 wi_ = *(const LAS bf16x8*)(lds + L_W + 32 * 144 + r * 144 + ks * 32 + hi * 16);
            aR = __builtin_amdgcn_mfma_f32_32x32x16_bf16(xa, wr_, aR, 0, 0, 0);
            aI = __builtin_amdgcn_mfma_f32_32x32x16_bf16(xa, wi_, aI, 0, 0, 0);
        }
        float Av[16], Bv[16];
        {
            const LAS float* xcf = (const LAS float*)(lds + L_XCF);
#pragma unroll
            for (int reg = 0; reg < 16; ++reg) {
                const int t = 32 * wave + crow(reg, hi);
                const bool valid = (tile > 0) || (t < NMETA);
                const float rg = rcp(1.0f + ex2(-(aR[reg] + br) * LOG2E));
                const float ig = rcp(1.0f + ex2(-(aI[reg] + bi) * LOG2E));
                const float a = ex2(rg * ls8);
                const float mult = __builtin_amdgcn_sqrtf(fmaxf(1.0f - a * a, 0.f));
                const float bx = mult * ig * xcf[t * 32 + r];
                Av[reg] = valid ? a : 1.0f; Bv[reg] = valid ? bx : 0.0f;
            }
        }
#pragma unroll
        for (int g = 0; g < 4; ++g) {
#pragma unroll
            for (int k = 1; k < 4; ++k) { Bv[4 * g + k] = Av[4 * g + k] * Bv[4 * g + k - 1] + Bv[4 * g + k]; Av[4 * g + k] = Av[4 * g + k] * Av[4 * g + k - 1]; }
        }
        float myCz[4], myCp[4], PW, HW;
        {
            float cz = 0.f, cp = 1.f;
#pragma unroll
            for (int g = 0; g < 4; ++g) {
                const float mP = Av[4 * g + 3], mH = Bv[4 * g + 3];
                const float oP = __shfl_xor(mP, 32), oH = __shfl_xor(mH, 32);
                const float eP = hi ? oP : mP, eH = hi ? oH : mH, dP = hi ? mP : oP, dH = hi ? mH : oH;
                const float cz0 = cz, cp0 = cp;
                cz = eP * cz + eH; cp = cp * eP;
                myCz[g] = hi ? cz : cz0; myCp[g] = hi ? cp : cp0;
                cz = dP * cz + dH; cp = cp * dP;
            }
            PW = cp; HW = cz;
        }
        if (hi == 0) { LAS float* ct = (LAS float*)(lds + L_CT); ct[(wave * 32 + r) * 2] = PW; ct[(wave * 32 + r) * 2 + 1] = HW; }
        __syncthreads();
        float cin = 0.f;
        {
            const LAS float* ct = (const LAS float*)(lds + L_CT);
            float c = state;
#pragma unroll
            for (int w2 = 0; w2 < 8; ++w2) { if (w2 == wave) cin = c; c = ct[(w2 * 32 + r) * 2] * c + ct[(w2 * 32 + r) * 2 + 1]; }
            state = c;
        }
        if (tile > 0) {
            const LAS unsigned short* gs = (const LAS unsigned short*)(lds + L_GS);
            LAS unsigned short* os = (LAS unsigned short*)(lds + L_XS);
#pragma unroll
            for (int reg = 0; reg < 16; ++reg) {
                const int g = reg >> 2, t = 32 * wave + crow(reg, hi);
                const float h = Bv[reg] + Av[reg] * (myCz[g] + myCp[g] * cin);
                const float gt = bf2f(gs[t * 32 + r]);
                os[t * 32 + r] = (unsigned short)f2bf(gelu_fast(gt) * h);
            }
        }
        __syncthreads();
        if (tile > 0) {
#pragma unroll
            for (int it = 0; it < 2; ++it) {
                const int cid = it * 512 + tid, t = cid >> 2, ch = cid & 3;
                const v4u v = *(const LAS v4u*)(lds + L_XS + t * 64 + ch * 16);
                float ss = 0.f;
#pragma unroll
                for (int k = 0; k < 4; ++k) { const float a = __builtin_bit_cast(float, v[k] << 16), c = __builtin_bit_cast(float, v[k] & 0xffff0000u); ss += a * a + c * c; }
                ss += __shfl_xor(ss, 1); ss += __shfl_xor(ss, 2);
                const size_t row = (size_t)b * SEQ + 256 * (tile - 1) + t;
                *(GAS v4u*)(MIX + row * D + 1024 + nb * 64 + 32 * cg + ch * 8) = v;
                if (ch == 0) SSL[row * 32 + nb * 2 + cg] = ss;
            }
        }
        __syncthreads();
    }
}
}

namespace p5 {
typedef float f32x16 __attribute__((ext_vector_type(16)));
constexpr int KP = 272;
constexpr int R_KEYS = 0, R_IDX = 256 * KP, R_END = R_IDX + 8 * 1024;
__device__ __forceinline__ int crow(int r, int hi) { return (r & 3) + 8 * (r >> 2) + 4 * hi; }
__device__ __forceinline__ int med3i(int a, int b, int c) { int d; asm("v_med3_i32 %0, %1, %2, %3" : "=v"(d) : "v"(a), "v"(b), "v"(c)); return d; }
__device__ __forceinline__ int imax(int a, int b) { return a > b ? a : b; }
__device__ __forceinline__ int imin(int a, int b) { return a < b ? a : b; }
__device__ __forceinline__ int ordf(float f) { const int b = __builtin_bit_cast(int, f); return b ^ ((b >> 31) & 0x7fffffff); }
__device__ __forceinline__ float unordf(int o) { const int b = o ^ ((o >> 31) & 0x7fffffff); return __builtin_bit_cast(float, b); }
__device__ __forceinline__ void ins16(int (&L)[16], int v) {
#pragma unroll
    for (int k = 15; k >= 1; --k) L[k] = med3i(L[k - 1], L[k], v);
    L[0] = imax(L[0], v);
}
__device__ __forceinline__ void half_top16(const LAS unsigned char* keys, const bf16* qrow, int r, int hi, int (&T)[16]) {
    bf16x8 qf[8];
#pragma unroll
    for (int ks = 0; ks < 8; ++ks) qf[ks] = *(const GAS bf16x8*)(qrow + ks * 16 + hi * 8);
    int L[16];
#pragma unroll
    for (int k = 0; k < 16; ++k) L[k] = (int)0x80000000;
    const int h4 = 4 * hi;
#pragma unroll
    for (int kt = 0; kt < 4; ++kt) {
        f32x16 acc = {0.f, 0.f, 0.f, 0.f, 0.f, 0.f, 0.f, 0.f, 0.f, 0.f, 0.f, 0.f, 0.f, 0.f, 0.f, 0.f};
#pragma unroll
        for (int ks = 0; ks < 8; ++ks) {
            const bf16x8 kf = *(const LAS bf16x8*)(keys + (kt * 32 + r) * KP + ks * 32 + hi * 16);
            acc = __builtin_amdgcn_mfma_f32_32x32x16_bf16(kf, qf[ks], acc, 0, 0, 0);
        }
#pragma unroll
        for (int reg = 0; reg < 16; ++reg) {
            const int C = 127 - 32 * kt - (reg & 3) - 8 * (reg >> 2);
            const int key = ((ordf(acc[reg]) & (int)0xffffff80) | C) - h4;
            ins16(L, key);
        }
    }
    int M[16];
#pragma unroll
    for (int i = 0; i < 16; ++i) M[i] = imax(L[i], __shfl_xor(L[15 - i], 32));
#define P5_STAGE(st) _Pragma("unroll") for (int i = 0; i < 16; ++i) if ((i & (st)) == 0) { const int a = imax(M[i], M[i + (st)]), b = imin(M[i], M[i + (st)]); M[i] = a; M[i + (st)] = b; }
    P5_STAGE(8) P5_STAGE(4) P5_STAGE(2) P5_STAGE(1)
#undef P5_STAGE
#pragma unroll
    for (int i = 0; i < 16; ++i) T[i] = M[i];
}

__device__ __forceinline__ void retr_unit(LAS unsigned char* lds, int h, int tg, const bf16* QPB, const bf16* SKB, const float* SS2, int* IDS, float* GW, float* RSTD2, int tid) {
    const int lane = tid & 63, wave = __builtin_amdgcn_readfirstlane(tid >> 6), r = lane & 31, hi = lane >> 5;
#pragma unroll
    for (int it = 0; it < 8; ++it) {
        const int cid = it * 512 + tid, row = cid >> 4, ch = cid & 15;
        *(LAS v4u*)(lds + R_KEYS + row * KP + ch * 16) = *(const GAS v4u*)(SKB + ((size_t)h * 256 + row) * 128 + ch * 8);
    }
    __syncthreads();
    const size_t tok = (size_t)tg * 256 + wave * 32 + r;
    int TA[16], TB[16];
    half_top16(lds + R_KEYS, QPB + tok * D + h * 256, r, hi, TA);
    half_top16(lds + R_KEYS + 128 * KP, QPB + tok * D + h * 256 + 128, r, hi, TB);
    LAS unsigned char* sc = lds + R_IDX + wave * 1024 + r * 32;
    const int hm = -hi;
    {
        v4u w;
#pragma unroll
        for (int q = 0; q < 4; ++q) { unsigned x = 0;
#pragma unroll
            for (int k = 0; k < 4; ++k) { const int t = (TB[4 * q + k] & hm) | (TA[4 * q + k] & ~hm); x |= (unsigned)(127 - (t & 0x7f)) << (8 * k); }
            w[q] = x; }
        *(LAS v4u*)(sc + hi * 16) = w;
    }
    float sA[16], sB[16];
#pragma unroll
    for (int i = 0; i < 16; ++i) { sA[i] = unordf(TA[i] & (int)0xffffff80); sB[i] = unordf(TB[i] & (int)0xffffff80); }
    int L[16];
#pragma unroll
    for (int k = 0; k < 16; ++k) L[k] = (int)0x80000000;
#pragma unroll
    for (int i = 0; i < 16; ++i)
#pragma unroll
        for (int j = 0; j < 16; ++j) if ((i + 1) * (j + 1) <= 16) {
            const int key = (ordf(sA[i] + sB[j]) & (int)0xffffff00) | (255 - (i * 16 + j));
            ins16(L, key);
        }
    float ssq = 0.f;
#pragma unroll
    for (int k = 0; k < 8; ++k) { const f32x4 v = *(const GAS f32x4*)(SS2 + tok * 32 + 4 * k); ssq += (v.x + v.y) + (v.z + v.w); }
    const float rs = 1.0f / sqrtf(ssq * (1.0f / D) + EPS);
    if (h == 0 && hi == 0) RSTD2[tok] = rs;
    const float v0 = unordf(L[0] & (int)0xffffff00);
    asm volatile("s_waitcnt lgkmcnt(0)" ::: "memory");
    int ex[8]; float ew[8]; float esum = 0.f;
#pragma unroll
    for (int k = 0; k < 8; ++k) {
        const int t = (L[8 + k] & hm) | (L[k] & ~hm);
        const int c = 255 - (t & 0xff);
        const int ia = sc[c >> 4], ib = sc[16 + (c & 15)];
        ex[k] = ia * 128 + ib;
        const float e = __builtin_amdgcn_exp2f((unordf(t & (int)0xffffff00) - v0) * rs * 1.4426950408889634f);
        ew[k] = e; esum += e;
    }
    esum += __shfl_xor(esum, 32);
    const float inv = 1.0f / esum;
    int* ip = IDS + tok * 128 + h * 16 + hi * 8; float* gp = GW + tok * 128 + h * 16 + hi * 8;
    *(GAS v4u*)(ip) = (v4u){(unsigned)ex[0], (unsigned)ex[1], (unsigned)ex[2], (unsigned)ex[3]};
    *(GAS v4u*)(ip + 4) = (v4u){(unsigned)ex[4], (unsigned)ex[5], (unsigned)ex[6], (unsigned)ex[7]};
    *(GAS f32x4*)(gp) = (f32x4){ew[0] * inv, ew[1] * inv, ew[2] * inv, ew[3] * inv};
    *(GAS f32x4*)(gp + 4) = (f32x4){ew[4] * inv, ew[5] * inv, ew[6] * inv, ew[7] * inv};
    __syncthreads();
}
}

namespace p6 {
typedef __bf16 bf2 __attribute__((ext_vector_type(2)));
__device__ __forceinline__ float dot2(unsigned a, unsigned b, float c) { return __builtin_amdgcn_fdot2_f32_bf16(__builtin_bit_cast(bf2, a), __builtin_bit_cast(bf2, b), c, false); }
__device__ __forceinline__ float blo(unsigned w) { return __builtin_bit_cast(float, w << 16); }
__device__ __forceinline__ float bhi(unsigned w) { return __builtin_bit_cast(float, w & 0xffff0000u); }
__device__ __forceinline__ float gelu_fast(float x) { return x * __builtin_amdgcn_rcpf(1.0f + __builtin_amdgcn_exp2f(-2.302208198f * x * (1.0f + 0.044715f * x * x))); }

__device__ __forceinline__ void token(const bf16* H1B, const bf16* UB, const bf16* VB, const int* IDS, const float* GW, const float* RSTD2, const float* fg, float* out, size_t tok, int lane) {
    v4u x[4];
#pragma unroll
    for (int j = 0; j < 4; ++j) x[j] = *(const GAS v4u*)(H1B + tok * D + j * 512 + lane * 8);
    const int id0 = IDS[tok * 128 + lane], id1 = IDS[tok * 128 + 64 + lane];
    const float g0 = GW[tok * 128 + lane], g1 = GW[tok * 128 + 64 + lane];
    const float rs = RSTD2[tok];
    float acc[4][8];
#pragma unroll
    for (int j = 0; j < 4; ++j)
#pragma unroll
        for (int k = 0; k < 8; ++k) acc[j][k] = 0.f;
    v4u un[4], vn[4];
    {
        const int e = __builtin_amdgcn_readlane(id0, 0);
#pragma unroll
        for (int j = 0; j < 4; ++j) { un[j] = *(const GAS v4u*)(UB + (size_t)e * D + j * 512 + lane * 8); vn[j] = *(const GAS v4u*)(VB + (size_t)e * D + j * 512 + lane * 8); }
    }
    for (int p = 0; p < 128; ++p) {
        v4u u[4], v[4];
#pragma unroll
        for (int j = 0; j < 4; ++j) { u[j] = un[j]; v[j] = vn[j]; }
        const int pn = p + 1 < 128 ? p + 1 : 127;
        const int en = (pn < 64) ? __builtin_amdgcn_readlane(id0, pn & 63) : __builtin_amdgcn_readlane(id1, pn & 63);
#pragma unroll
        for (int j = 0; j < 4; ++j) { un[j] = *(const GAS v4u*)(UB + (size_t)en * D + j * 512 + lane * 8); vn[j] = *(const GAS v4u*)(VB + (size_t)en * D + j * 512 + lane * 8); }
        const float g = __builtin_bit_cast(float, (p < 64) ? __builtin_amdgcn_readlane(__builtin_bit_cast(int, g0), p & 63) : __builtin_amdgcn_readlane(__builtin_bit_cast(int, g1), p & 63));
        float d = 0.f;
#pragma unroll
        for (int j = 0; j < 4; ++j)
#pragma unroll
            for (int k = 0; k < 4; ++k) d = dot2(u[j][k], x[j][k], d);
#pragma unroll
        for (int o = 1; o < 64; o <<= 1) d += __shfl_xor(d, o);
        const float w = g * gelu_fast(d * rs);
#pragma unroll
        for (int j = 0; j < 4; ++j)
#pragma unroll
            for (int k = 0; k < 4; ++k) { acc[j][2 * k] += w * blo(v[j][k]); acc[j][2 * k + 1] += w * bhi(v[j][k]); }
    }
    float ss = 0.f;
#pragma unroll
    for (int j = 0; j < 4; ++j)
#pragma unroll
        for (int k = 0; k < 4; ++k) { acc[j][2 * k] += blo(x[j][k]); acc[j][2 * k + 1] += bhi(x[j][k]); ss += acc[j][2 * k] * acc[j][2 * k] + acc[j][2 * k + 1] * acc[j][2 * k + 1]; }
#pragma unroll
    for (int o = 1; o < 64; o <<= 1) ss += __shfl_xor(ss, o);
    const float rf = 1.0f / sqrtf(ss * (1.0f / D) + EPS);
#pragma unroll
    for (int j = 0; j < 4; ++j) {
        const f32x4 ga = *(const GAS f32x4*)(fg + j * 512 + lane * 8), gb = *(const GAS f32x4*)(fg + j * 512 + lane * 8 + 4);
        *(GAS f32x4*)(out + tok * D + j * 512 + lane * 8) = (f32x4){acc[j][0] * rf * ga.x, acc[j][1] * rf * ga.y, acc[j][2] * rf * ga.z, acc[j][3] * rf * ga.w};
        *(GAS f32x4*)(out + tok * D + j * 512 + lane * 8 + 4) = (f32x4){acc[j][4] * rf * gb.x, acc[j][5] * rf * gb.y, acc[j][6] * rf * gb.z, acc[j][7] * rf * gb.w};
    }
}
}

struct Frame {
    LAS unsigned char* lds;
    volatile LAS unsigned* MISC;
    gu32* ctl;
    int tid, lane, wave, vcu, G;
};
__device__ __forceinline__ float wave_sum(float v) {
#pragma unroll
    for (int o = 1; o < 64; o <<= 1) v += __shfl_xor(v, o);
    return v;
}
__device__ __forceinline__ void p0_transpose_item(const float* W, int K, int N, bf16* WT, const float* g0, const float* g1, int ksplit, LAS float* scr, int item, int lane) {
    const int nblk = N / 32, kb = item / nblk, nb = item % nblk, k0 = 64 * kb, n0 = 32 * nb;
#pragma unroll 8
    for (int i = 0; i < 32; ++i) { const int kk = 2 * i + (lane >> 5); const int kg = k0 + kk; const float gv = kg < ksplit ? g0[kg] : g1[kg - ksplit];
        scr[kk * 33 + (lane & 31)] = W[(size_t)kg * N + n0 + (lane & 31)] * gv; }
    LDS_WAIT(); asm volatile("" ::: "memory");
    const int c = lane & 7;
#pragma unroll
    for (int j = 0; j < 4; ++j) { const int n = (lane >> 3) + 8 * j; const LAS float* s = scr + (8 * c) * 33 + n;
        v4u o; o.x = pk2(s[0 * 33], s[1 * 33]); o.y = pk2(s[2 * 33], s[3 * 33]); o.z = pk2(s[4 * 33], s[5 * 33]); o.w = pk2(s[6 * 33], s[7 * 33]);
        *(GAS v4u*)(WT + (size_t)(n0 + n) * K + k0 + 8 * c) = o; }
    LDS_WAIT(); asm volatile("" ::: "memory");
}
__device__ __forceinline__ void p0_row(const float* xrow, bf16* orow, float* rstd_out, int lane) {
    const GAS f32x4* xr = (const GAS f32x4*)xrow + lane;
    f32x4 v[8]; float s = 0.f;
#pragma unroll
    for (int j = 0; j < 8; ++j) { v[j] = xr[64 * j]; s += (v[j].x * v[j].x + v[j].y * v[j].y) + (v[j].z * v[j].z + v[j].w * v[j].w); }
    s = wave_sum(s);
    GAS unsigned long long* o8 = (GAS unsigned long long*)orow + lane;
#pragma unroll
    for (int j = 0; j < 8; ++j) o8[64 * j] = (unsigned long long)pk2(v[j].x, v[j].y) | ((unsigned long long)pk2(v[j].z, v[j].w) << 32);
    if (lane == 0) *rstd_out = 1.0f / sqrtf(s * (1.0f / D) + EPS);
}
__device__ __forceinline__ void p0_cvt8(const float* src, bf16* dst, const float* gcol, size_t idx8) {
    const f32x4 a = *(const GAS f32x4*)(src + idx8 * 8), b = *(const GAS f32x4*)(src + idx8 * 8 + 4);
    f32x4 ga = {1.f, 1.f, 1.f, 1.f}, gb = {1.f, 1.f, 1.f, 1.f};
    if (gcol) { const int c = (int)((idx8 * 8) & (D - 1)); ga = *(const GAS f32x4*)(gcol + c); gb = *(const GAS f32x4*)(gcol + c + 4); }
    v4u o; o.x = pk2(a.x * ga.x, a.y * ga.y); o.y = pk2(a.z * ga.z, a.w * ga.w); o.z = pk2(b.x * gb.x, b.y * gb.y); o.w = pk2(b.z * gb.z, b.w * gb.w);
    *(GAS v4u*)(dst + idx8 * 8) = o;
}

struct Args { const float* in[22]; float* out; unsigned char* ws; int ph_lo, ph_hi; };

__global__ void __launch_bounds__(NWAVES * 64, 2) fwd(Args args) {
    extern __shared__ __attribute__((aligned(16))) unsigned char lds[];
    Frame F;
    F.lds = (LAS unsigned char*)lds;
    F.MISC = (volatile LAS unsigned*)(F.lds + MISC_OFF);
    F.tid = threadIdx.x; F.lane = F.tid & 63; F.wave = __builtin_amdgcn_readfirstlane(F.tid >> 6);
    F.G = gridDim.x; { const int bx = blockIdx.x; F.vcu = (F.G % 8 == 0) ? (bx % 8) * (F.G / 8) + bx / 8 : bx; }
    unsigned char* ws = args.ws;
    F.ctl = (gu32*)(ws + WS_CTL);
    for (int u = F.tid; u < (LDS_BYTES - LDSCTL_OFF) / 4; u += NWAVES * 64) ((LAS unsigned*)(F.lds + LDSCTL_OFF))[u] = 0u;
    __syncthreads();
    XcdBarrier bar = xcd_barrier_post((unsigned*)(F.ctl + CW_BAR), F.MISC + 8);
    const int lo = args.ph_lo, hi = args.ph_hi;
#define IN(k) (lo <= (k) && (k) < hi)
#define BOTH(k) (IN(k) && IN((k) + 1))

    const float* x = args.in[0]; const float* meta = args.in[1]; const float* norm_mix_g = args.in[2]; const float* w_in = args.in[3]; const float* b_in = args.in[4];
    const float* gn_attn_g = args.in[13]; const float* gn_lru_g = args.in[14]; const float* w_out = args.in[15]; const float* norm_ffn_g = args.in[16];
    const float* peer_wq = args.in[17]; const float* sub_keys = args.in[18]; const float* peer_u = args.in[19]; const float* peer_v = args.in[20];
    bf16* W1T = (bf16*)(ws + WS_W1T); bf16* W2T = (bf16*)(ws + WS_W2T); bf16* W3T = (bf16*)(ws + WS_W3T); bf16* SKB = (bf16*)(ws + WS_SKB);
    float* RSTD1 = (float*)(ws + WS_RSTD1);
    bf16* UB = (bf16*)(ws + WS_UB); bf16* VB = (bf16*)(ws + WS_VB); bf16* A1 = (bf16*)(ws + WS_A1);
    bf16* QB = (bf16*)(ws + WS_Q); bf16* KVB = (bf16*)(ws + WS_KV); bf16* XBB = (bf16*)(ws + WS_XB); bf16* GTB = (bf16*)(ws + WS_GT);

    if (IN(0)) {
        LAS float* scr = (LAS float*)(F.lds + RING_OFF + F.wave * 16384);
        const int gw = F.vcu * NWAVES + F.wave, NGW = F.G * NWAVES;
        constexpr int I_1 = (D / 64) * (IND / 32), I_2 = (D / 64) * (D / 32), I_3 = I_2;
        for (int it = gw; it < I_1 + I_2 + I_3; it += NGW) {
            int r = it;
            if (r < I_1) { p0_transpose_item(w_in, D, IND, W1T, norm_mix_g, norm_mix_g, D, scr, r, F.lane); continue; } r -= I_1;
            if (r < I_2) { p0_transpose_item(w_out, D, D, W2T, gn_attn_g, gn_lru_g, 1024, scr, r, F.lane); continue; } r -= I_2;
            p0_transpose_item(peer_wq, D, D, W3T, norm_ffn_g, norm_ffn_g, D, scr, r, F.lane);
        }
        for (int m = gw; m < MREAL + NMETA; m += NGW) {
            const float* src = m < MREAL ? x + (size_t)m * D : meta + (size_t)(m - MREAL) * D;
            p0_row(src, A1 + (size_t)m * D, RSTD1 + m, F.lane);
        }
        {
            const size_t gt = (size_t)gw * 64 + F.lane, NT = (size_t)NGW * 64;
            for (size_t i = gt; i < (size_t)(8 * 2 * 128 * 128) / 8; i += NT) p0_cvt8(sub_keys, SKB, nullptr, i);
            for (size_t i = gt; i < (size_t)16384 * D / 8; i += NT) p0_cvt8(peer_u, UB, norm_ffn_g, i);
            for (size_t i = gt; i < (size_t)16384 * D / 8; i += NT) p0_cvt8(peer_v, VB, nullptr, i);
        }
        if (BOTH(0)) xcd_barrier(bar);
    }
    if (IN(1)) {
        pg8::Gemm g{A1, W1T, MPAD, IND, D};
        pg8::Order1 S{F.G, (int)blockIdx.x};
        pg8::Epi1 E{QB, KVB, XBB, GTB, RSTD1, b_in};
        pg8::gemm_phase<pg8::Epi1, pg8::Order1, true, true>(F.lds + RING_OFF, g, S, E);
        if (BOTH(1)) xcd_barrier(bar);
    }
    if (IN(2)) {
        bf16* MIX = (bf16*)(ws + WS_A1); float* SSA = (float*)(ws + WS_SSA); float* SSL = (float*)(ws + WS_SSL);
        const p2::LruP LP{args.in[6], args.in[7], args.in[8], args.in[9], args.in[10], args.in[11], args.in[12]};
        for (int u = (int)blockIdx.x; u < 256; u += F.G) p2::lru_unit(F.lds + RING_OFF, u >> 5, (u >> 1) & 15, u & 1, XBB, GTB, LP, MIX, SSL, F.tid);
        for (int a = (int)blockIdx.x; a < 256; a += F.G) p2::attn_unit(F.lds + RING_OFF, a >> 5, (a >> 1) & 15, a & 1, QB, KVB, args.in[5], MIX, SSA, F.tid);
        if (BOTH(2)) xcd_barrier(bar);
    }
    if (IN(3)) {
        bf16* MIX = (bf16*)(ws + WS_A1); const float* SSA = (const float*)(ws + WS_SSA); const float* SSL = (const float*)(ws + WS_SSL);
        bf16* H1B = (bf16*)(ws + WS_H1); float* SS2 = (float*)(ws + WS_SS2);
        pg8::Order2 S{F.G, (int)blockIdx.x};
        LAS float* tbl = (LAS float*)(F.lds + LDSCTL_OFF + 1024);
        pg8::Unit u0{0, 0};
        for (int i = 0; i < 2; ++i) {
            pg8::Unit u; if (!S.next(i, u)) break; if (i == 0) u0 = u;
            if (F.tid < 256) {
                const size_t row = (size_t)u.pm * 256 + F.tid; float sa = 0.f, sl = 0.f;
#pragma unroll
                for (int k = 0; k < 4; ++k) { const f32x4 v = *(const GAS f32x4*)(SSA + row * 16 + 4 * k); sa += (v.x + v.y) + (v.z + v.w); }
#pragma unroll
                for (int k = 0; k < 8; ++k) { const f32x4 v = *(const GAS f32x4*)(SSL + row * 32 + 4 * k); sl += (v.x + v.y) + (v.z + v.w); }
                const float ra = 1.0f / sqrtf(sa * (1.0f / 1024) + EPS), rl = 1.0f / sqrtf(sl * (1.0f / 1024) + EPS);
                tbl[(i * 256 + F.tid) * 2] = ra / rl; tbl[(i * 256 + F.tid) * 2 + 1] = rl;
            }
        }
        __syncthreads();
        pg8::Gemm g{MIX, W2T, MREAL, D, D};
        pg8::Epi2 E{H1B, x, SS2, (const LAS float*)tbl, u0.pm};
        pg8::gemm_phase<pg8::Epi2, pg8::Order2, true, true>(F.lds + RING_OFF, g, S, E);
        if (BOTH(3)) xcd_barrier(bar);
    }
    if (IN(4)) {
        bf16* H1B = (bf16*)(ws + WS_H1); bf16* QPB = (bf16*)(ws + WS_A1);
        pg8::Order2 S{F.G, (int)blockIdx.x};
        pg8::Gemm g{H1B, W3T, MREAL, D, D};
        pg8::Epi3 E{QPB};
        pg8::gemm_phase<pg8::Epi3, pg8::Order2, true, true>(F.lds + RING_OFF, g, S, E);
        if (BOTH(4)) xcd_barrier(bar);
    }
    if (IN(5)) {
        const bf16* QPB = (const bf16*)(ws + WS_A1); const float* SS2 = (const float*)(ws + WS_SS2);
        int* IDS = (int*)(ws + WS_IDS); float* GW = (float*)(ws + WS_GW); float* RSTD2 = (float*)(ws + WS_RSTD2);
        for (int u = (int)blockIdx.x; u < 512; u += F.G) p5::retr_unit(F.lds + RING_OFF, u & 7, u >> 3, QPB, SKB, SS2, IDS, GW, RSTD2, F.tid);
        if (BOTH(5)) xcd_barrier(bar);
    }
    if (IN(6)) {
        const bf16* H1B = (const bf16*)(ws + WS_H1); const int* IDS = (const int*)(ws + WS_IDS); const float* GW = (const float*)(ws + WS_GW); const float* RSTD2 = (const float*)(ws + WS_RSTD2);
        const int gw = F.vcu * NWAVES + F.wave, NGW = F.G * NWAVES;
        for (int t = gw; t < MREAL; t += NGW) p6::token(H1B, UB, VB, IDS, GW, RSTD2, args.in[21], args.out, (size_t)t, F.lane);
    }
#undef IN
#undef BOTH
}

extern "C" void kernel_launch(void* const* d_in, const int* in_sizes, int n_in, void* d_out, int out_size, void* d_ws, size_t ws_size, hipStream_t stream) {
    static int grid = 0;
    if (grid == 0) {
        int dev = 0, cus = 0;
        if (hipGetDevice(&dev) != hipSuccess || hipDeviceGetAttribute(&cus, hipDeviceAttributeMultiprocessorCount, dev) != hipSuccess) { fprintf(stderr, "kernel_launch: device query failed\n"); grid = -1; return; }
        if (hipFuncSetAttribute((const void*)fwd, hipFuncAttributeMaxDynamicSharedMemorySize, LDS_BYTES) != hipSuccess) { fprintf(stderr, "kernel_launch: hipFuncSetAttribute failed\n"); grid = -1; return; }
        int per_cu = 0;
        if (hipOccupancyMaxActiveBlocksPerMultiprocessor(&per_cu, (const void*)fwd, NWAVES * 64, LDS_BYTES) != hipSuccess || per_cu < 1) fprintf(stderr, "kernel_launch: occupancy query says %d\n", per_cu);
        (void)hipGetLastError();
        grid = cus;
        if (ws_size < WS_END) { fprintf(stderr, "kernel_launch: ws too small %zu\n", ws_size); grid = -1; return; }
    }
    if (grid < 0) return;
    (void)hipMemsetAsync((char*)d_ws + WS_CTL, 0, CTL_ZERO_BYTES, stream);
    Args a{};
    for (int i = 0; i < 22; ++i) a.in[i] = (const float*)d_in[i];
    a.out = (float*)d_out; a.ws = (unsigned char*)d_ws; a.ph_lo = 0; a.ph_hi = 7;
    hipLaunchKernelGGL(fwd, dim3(grid), dim3(NWAVES * 64), LDS_BYTES, stream, a);
}
```

```cpp
#include <hip/hip_runtime.h>
#include <cstdio>
#include <cstdint>
#include <math.h>

#define D 2048
#define NB 8
#define SEQ 2048
#define NMETA 16
#define TT (SEQ + NMETA)
#define MR (NB * TT)
#define MREAL (NB * SEQ)
#define MPAD (MREAL + 256)
#define QD 1024
#define KVD 128
#define LW 1024
#define IND 3328
#define EPS 1e-6f
#define QSCALE (0.125f * 1.4426950408889634f)
#define GAS __attribute__((address_space(1)))
#define LAS __attribute__((address_space(3)))
namespace pg8 {
#define PG8_LAS __attribute__((address_space(3)))
typedef unsigned short bf16_t;
typedef short bf16x8 __attribute__((ext_vector_type(8)));
typedef float f32x4 __attribute__((ext_vector_type(4)));
typedef unsigned u32x4 __attribute__((ext_vector_type(4)));
constexpr int BM = 256, BK = 64, HALF = 128, HTB = HALF * BK * 2  , STAGE_BYTES = 8 * HTB, NXCD = 8, WGM = 8;

__host__ __device__ __forceinline__ int lds_byte(int r, int c) { const int st = (r >> 4) * 2 + (c >> 5), rr = r & 15, cc = c & 31, ob = rr * 64 + cc * 2; return st * 1024 + (ob ^ (((ob >> 9) & 1) << 5)); }
__host__ __device__ __forceinline__ void stage_rc(int b, int& R, int& C) { const int st = b / 1024, sb = b % 1024, swz = sb ^ (((sb >> 9) & 1) << 5); R = (st >> 1) * 16 + swz / 64; C = (st & 1) * 32 + (swz % 64) / 2; }
__host__ __device__ __forceinline__ int perm32(int rho) { const int n = rho >> 4, i = rho & 15; return 8 * (i >> 2) + 4 * n + (i & 3); }

struct Unit { int pm, pn; };
struct Gemm { const bf16_t* A; const bf16_t* Bt; int M, N, K; };

struct StaticOrder {
    int nM, nN, nwg, G, c;
    __host__ __device__ void init(int M, int N, int G_, int c_) { nM = M / BM; nN = N / BM; nwg = nM * nN; G = G_; c = c_; }
    __host__ __device__ bool next(int i, Unit& u) const {
        const long L = (long)i * G + c; if (L >= nwg) return false;
        int wgid = (int)L; { const int q = nwg / NXCD, r = nwg % NXCD, xcd = wgid % NXCD, off = wgid / NXCD; wgid = (xcd < r ? xcd * (q + 1) : r * (q + 1) + (xcd - r) * q) + off; }
        const int nig = WGM * nN, gid = wgid / nig, fm = gid * WGM, gsz = (nM - fm) < WGM ? (nM - fm) : WGM;
        u.pm = fm + ((wgid % nig) % gsz); u.pn = (wgid % nig) / gsz; return true;
    }
    __device__ __forceinline__ void a_ready(const Unit&) const {}
    __device__ __forceinline__ void done(const Unit&) const {}
};

__device__ __forceinline__ unsigned cvt_pk_bf16(float lo, float hi) { unsigned r; asm volatile("v_cvt_pk_bf16_f32 %0, %1, %2" : "=v"(r) : "v"(lo), "v"(hi)); return r; }
typedef unsigned u32x2 __attribute__((ext_vector_type(2)));
struct Order1 {
    int G, c;
    __device__ __forceinline__ bool next(int i, Unit& u) const {
        const int L = i * G + c; if (L >= 837) return false;
        if (L >= 832) { u.pm = 64; u.pn = 4 + (L - 832); return true; }
        const int nwg = 832, nN = 13;
        int wgid = L; { const int q = nwg / NXCD, xcd = wgid % NXCD, off = wgid / NXCD; wgid = xcd * q + off; }
        const int nig = WGM * nN, gid = wgid / nig, fm = gid * WGM;
        u.pm = fm + ((wgid % nig) % WGM); u.pn = (wgid % nig) / WGM; return true;
    }
    __device__ __forceinline__ void a_ready(const Unit&) const {}
    __device__ __forceinline__ void done(const Unit&) const {}
};
struct Order2 {
    int G, c;
    __device__ __forceinline__ bool next(int i, Unit& u) const {
        const int L = i * G + c; if (L >= 512) return false;
        const int nwg = 512, nN = 8;
        int wgid = L; { const int q = nwg / NXCD, xcd = wgid % NXCD, off = wgid / NXCD; wgid = xcd * q + off; }
        const int nig = WGM * nN, gid = wgid / nig, fm = gid * WGM;
        u.pm = fm + ((wgid % nig) % WGM); u.pn = (wgid % nig) / WGM; return true;
    }
    __device__ __forceinline__ void a_ready(const Unit&) const {}
    __device__ __forceinline__ void done(const Unit&) const {}
};

struct Epi1 {
    static constexpr bool PERM = true, AFTER_DRAIN = false, MIDK = false;
    bf16_t *Q, *KV, *XB, *GT; const float* rstd; const float* bias;
    __device__ __forceinline__ void midk(f32x4 (&acc)[2][2][4][2], const Unit& u, int wr, int wc, int fr, int fq) const {}
    __device__ __forceinline__ void operator()(const f32x4 (&acc)[2][2][4][2], const Unit& u, int wr, int wc, int fr, int fq) const {
        const int row0 = u.pm * BM + wr * 64 + fr;
        bf16_t* base; int ldc, colb; float sc = 1.f;
        if (u.pn < 4) { base = Q; ldc = 1024; colb = u.pn * BM; sc = QSCALE; }
        else if (u.pn == 4) { base = KV; ldc = 256; colb = 0; }
        else if (u.pn < 9) { base = XB; ldc = 1024; colb = (u.pn - 5) * BM; }
        else { base = GT; ldc = 1024; colb = (u.pn - 9) * BM; }
        const int col0 = colb + wc * 32 + 8 * fq, bcol0 = u.pn * BM + wc * 32 + 8 * fq;
        f32x4 bv[2][2];
#pragma unroll
        for (int bj = 0; bj < 2; ++bj)
#pragma unroll
            for (int n = 0; n < 2; ++n) bv[bj][n] = *(const f32x4*)(bias + bcol0 + bj * HALF + 4 * n);
#pragma unroll
        for (int ai = 0; ai < 2; ++ai)
#pragma unroll
            for (int m = 0; m < 4; ++m) {
                const int row = row0 + ai * HALF + m * 16; const float rs = rstd[row];
                bf16_t* rowp = base + (size_t)row * ldc + col0;
#pragma unroll
                for (int bj = 0; bj < 2; ++bj) {
                    f32x4 v0 = (acc[ai][bj][m][0] * rs + bv[bj][0]) * sc, v1 = (acc[ai][bj][m][1] * rs + bv[bj][1]) * sc;
                    u32x4 w; w.x = cvt_pk_bf16(v0[0], v0[1]); w.y = cvt_pk_bf16(v0[2], v0[3]); w.z = cvt_pk_bf16(v1[0], v1[1]); w.w = cvt_pk_bf16(v1[2], v1[3]);
                    *(u32x4*)(rowp + bj * HALF) = w; } }
    }
};
struct Epi2 {
    static constexpr bool PERM = true, AFTER_DRAIN = false, MIDK = true;
    bf16_t* H1; const float* x; float* SS2; const LAS float* tbl; int pm0;
    __device__ __forceinline__ void midk(f32x4 (&acc)[2][2][4][2], const Unit& u, int wr, int wc, int fr, int fq) const {
        const LAS float* t = tbl + (u.pm == pm0 ? 0 : 512);
#pragma unroll
        for (int ai = 0; ai < 2; ++ai)
#pragma unroll
            for (int m = 0; m < 4; ++m) { const float ra = t[(ai * HALF + wr * 64 + m * 16 + fr) * 2];
#pragma unroll
                for (int bj = 0; bj < 2; ++bj)
#pragma unroll
                    for (int n = 0; n < 2; ++n) acc[ai][bj][m][n] = acc[ai][bj][m][n] * ra; }
    }
    __device__ __forceinline__ void operator()(const f32x4 (&acc)[2][2][4][2], const Unit& u, int wr, int wc, int fr, int fq) const {
        const LAS float* t = tbl + (u.pm == pm0 ? 0 : 512);
        const int col0 = u.pn * BM + wc * 32 + 8 * fq;
#pragma unroll
        for (int ai = 0; ai < 2; ++ai)
#pragma unroll
            for (int m = 0; m < 4; ++m) {
                const int rl = ai * HALF + wr * 64 + m * 16 + fr; const size_t row = (size_t)u.pm * BM + rl; const float rs = t[rl * 2 + 1];
                float ss = 0.f;
#pragma unroll
                for (int bj = 0; bj < 2; ++bj) {
                    const f32x4 x0 = *(const f32x4*)(x + row * 2048 + col0 + bj * HALF), x1 = *(const f32x4*)(x + row * 2048 + col0 + bj * HALF + 4);
                    const f32x4 v0 = acc[ai][bj][m][0] * rs + x0, v1 = acc[ai][bj][m][1] * rs + x1;
                    ss += (v0[0] * v0[0] + v0[1] * v0[1]) + (v0[2] * v0[2] + v0[3] * v0[3]) + (v1[0] * v1[0] + v1[1] * v1[1]) + (v1[2] * v1[2] + v1[3] * v1[3]);
                    u32x4 w; w.x = cvt_pk_bf16(v0[0], v0[1]); w.y = cvt_pk_bf16(v0[2], v0[3]); w.z = cvt_pk_bf16(v1[0], v1[1]); w.w = cvt_pk_bf16(v1[2], v1[3]);
                    *(u32x4*)(H1 + row * 2048 + col0 + bj * HALF) = w; }
                ss += __shfl_xor(ss, 16); ss += __shfl_xor(ss, 32);
                if (fq == 0) SS2[row * 32 + u.pn * 4 + wc] = ss;
            }
    }
};
struct Epi3 {
    static constexpr bool PERM = true, AFTER_DRAIN = false, MIDK = false;
    bf16_t* O;
    __device__ __forceinline__ void midk(f32x4 (&acc)[2][2][4][2], const Unit& u, int wr, int wc, int fr, int fq) const {}
    __device__ __forceinline__ void operator()(const f32x4 (&acc)[2][2][4][2], const Unit& u, int wr, int wc, int fr, int fq) const {
        const int col0 = u.pn * BM + wc * 32 + 8 * fq;
#pragma unroll
        for (int ai = 0; ai < 2; ++ai)
#pragma unroll
            for (int m = 0; m < 4; ++m) { const size_t row = (size_t)u.pm * BM + ai * HALF + wr * 64 + m * 16 + fr;
#pragma unroll
                for (int bj = 0; bj < 2; ++bj) { const f32x4 v0 = acc[ai][bj][m][0], v1 = acc[ai][bj][m][1];
                    u32x4 w; w.x = cvt_pk_bf16(v0[0], v0[1]); w.y = cvt_pk_bf16(v0[2], v0[3]); w.z = cvt_pk_bf16(v1[0], v1[1]); w.w = cvt_pk_bf16(v1[2], v1[3]);
                    *(u32x4*)(O + row * 2048 + col0 + bj * HALF) = w; } }
    }
};
template <class Epi, class Sched, bool ALIGN_EPI = false, bool SP2 = false>
__device__ __forceinline__ void gemm_phase(PG8_LAS unsigned char* lds, const Gemm g, const Sched& S, const Epi& E) {
    const int tid = threadIdx.x, wid = __builtin_amdgcn_readfirstlane(tid >> 6), lane = tid & 63, wr = wid >> 2, wc = wid & 3, fr = lane & 15, fq = lane >> 4;
    const int K = g.K, nt = K / BK;
    unsigned voffA[2], voffB[2];
#pragma unroll
    for (int i = 0; i < 2; ++i) { int R, C; stage_rc(tid * 16 + i * 8192, R, C); const int Rb = Epi::PERM ? ((R & ~31) + perm32(R & 31)) : R;
        voffA[i] = (unsigned)(R * K + C) * 2u; voffB[i] = (unsigned)(Rb * K + C) * 2u; }
    const size_t kstep = (size_t)(BK * 2);
    const size_t hstep = (size_t)HALF * K * 2;
    const size_t tstep = 2 * hstep;
    const unsigned ldsw = (unsigned)wid * 1024u;
    const int aoff = lds_byte(wr * 64 + fr, fq * 8), boff = lds_byte(wc * 32 + fr, fq * 8);
#define PG8_SA(b, h) (((b) * 2 + (h)) * HTB)
#define PG8_SB(b, h) ((4 + (b) * 2 + (h)) * HTB)
#define PG8_STAGE(bufoff, gbase, voff) do { _Pragma("unroll") for (int _i = 0; _i < 2; ++_i) \
        __builtin_amdgcn_global_load_lds((const unsigned*)((const char*)(gbase) + (voff)[_i]), (PG8_LAS unsigned*)(lds + (bufoff) + ldsw + _i * 8192), 16, 0, 0); } while (0)
#define PG8_LDA(dst, b, h) do { _Pragma("unroll") for (int m = 0; m < 4; ++m) _Pragma("unroll") for (int k = 0; k < 2; ++k) dst[m][k] = *(const PG8_LAS bf16x8*)(lds + PG8_SA(b, h) + aoff + m * 2048 + k * 1024); } while (0)
#define PG8_LDB(dst, b, h) do { _Pragma("unroll") for (int n = 0; n < 2; ++n) _Pragma("unroll") for (int k = 0; k < 2; ++k) dst[n][k] = *(const PG8_LAS bf16x8*)(lds + PG8_SB(b, h) + boff + n * 2048 + k * 1024); } while (0)
#define PG8_MMA(ai, bj, At, Bt) do { __builtin_amdgcn_s_setprio(1); _Pragma("unroll") for (int m = 0; m < 4; ++m) _Pragma("unroll") for (int n = 0; n < 2; ++n) _Pragma("unroll") for (int k = 0; k < 2; ++k) \
        acc[ai][bj][m][n] = __builtin_amdgcn_mfma_f32_16x16x32_bf16(Bt[n][k], At[m][k], acc[ai][bj][m][n], 0, 0, 0); __builtin_amdgcn_s_setprio(0); } while (0)
#define PG8_WAIT_V(n) asm volatile("s_waitcnt vmcnt(" #n ")" ::: "memory")
#define PG8_WAIT_L(n) asm volatile("s_waitcnt lgkmcnt(" #n ")" ::: "memory")
#define PG8_BAR __builtin_amdgcn_s_barrier()
#define PG8_SCHED __builtin_amdgcn_sched_barrier(0)
    Unit cur, nxt; int ui = 0;
    if (!S.next(0, cur)) return;
    f32x4 acc[2][2][4][2];
#pragma unroll
    for (int a = 0; a < 2; ++a)
#pragma unroll
        for (int b = 0; b < 2; ++b)
#pragma unroll
            for (int m = 0; m < 4; ++m)
#pragma unroll
                for (int n = 0; n < 2; ++n) acc[a][b][m][n] = (f32x4){0.f, 0.f, 0.f, 0.f};
    bf16x8 At[4][2], B0[2][2], B1[2][2];
    const char* cA = (const char*)g.A + (size_t)cur.pm * tstep; const char* cB = (const char*)g.Bt + (size_t)cur.pn * tstep;
    S.a_ready(cur);
    if constexpr (SP2) {
        PG8_STAGE(PG8_SB(0, 0), cB, voffB); PG8_STAGE(PG8_SB(0, 1), cB + hstep, voffB); PG8_STAGE(PG8_SA(0, 0), cA, voffA); PG8_STAGE(PG8_SA(0, 1), cA + hstep, voffA);
        if (wr == 1) PG8_BAR;
        PG8_WAIT_V(2); PG8_BAR;
        PG8_STAGE(PG8_SB(1, 0), cB + kstep, voffB); PG8_STAGE(PG8_SA(1, 0), cA + kstep, voffA); PG8_STAGE(PG8_SB(1, 1), cB + hstep + kstep, voffB);
        PG8_WAIT_V(6); PG8_BAR;
    } else {
        PG8_STAGE(PG8_SB(0, 0), cB, voffB); PG8_STAGE(PG8_SA(0, 0), cA, voffA); PG8_STAGE(PG8_SB(0, 1), cB + hstep, voffB); PG8_STAGE(PG8_SA(0, 1), cA + hstep, voffA);
        if (wr == 1) PG8_BAR;
        PG8_WAIT_V(4); PG8_BAR;
        PG8_STAGE(PG8_SB(1, 0), cB + kstep, voffB); PG8_STAGE(PG8_SA(1, 0), cA + kstep, voffA); PG8_STAGE(PG8_SB(1, 1), cB + hstep + kstep, voffB);
        PG8_WAIT_V(6); PG8_BAR;
    }
    for (;;) {
        const bool has_next = S.next(ui + 1, nxt);
        const char* nA = has_next ? (const char*)g.A + (size_t)nxt.pm * tstep : cA; const char* nB = has_next ? (const char*)g.Bt + (size_t)nxt.pn * tstep : cB;
        for (int t = 0; t < nt; t += 2) {
            if constexpr (Epi::MIDK) { if (t == nt / 2) E.midk(acc, cur, wr, wc, fr, fq); }
            const bool last = (t == nt - 2);
            const char* a1 = cA + (size_t)(t + 1) * kstep;
            const char* a2 = last ? nA : cA + (size_t)(t + 2) * kstep; const char* b2 = last ? nB : cB + (size_t)(t + 2) * kstep;
            const char* a3 = a2 + kstep; const char* b3 = b2 + kstep;
            if (last && has_next) S.a_ready(nxt);
            if constexpr (SP2) {
            PG8_LDB(B0, 0, 0); PG8_LDB(B1, 0, 1); PG8_SCHED; PG8_LDA(At, 0, 0); PG8_STAGE(PG8_SA(1, 1), a1 + hstep, voffA);
            PG8_WAIT_V(8); PG8_WAIT_L(0); PG8_BAR; PG8_MMA(0, 0, At, B0); PG8_MMA(0, 1, At, B1); PG8_BAR; PG8_SCHED;
            PG8_LDA(At, 0, 1); PG8_STAGE(PG8_SB(0, 0), b2, voffB); PG8_STAGE(PG8_SB(0, 1), b2 + hstep, voffB); PG8_STAGE(PG8_SA(0, 0), a2, voffA);
            PG8_WAIT_V(8); PG8_WAIT_L(0); PG8_BAR; PG8_MMA(1, 0, At, B0); PG8_MMA(1, 1, At, B1); PG8_BAR; PG8_SCHED;
            PG8_LDB(B0, 1, 0); PG8_LDB(B1, 1, 1); PG8_SCHED; PG8_LDA(At, 1, 0); PG8_STAGE(PG8_SA(0, 1), a2 + hstep, voffA);
            PG8_WAIT_V(8); PG8_WAIT_L(0); PG8_BAR; PG8_MMA(0, 0, At, B0); PG8_MMA(0, 1, At, B1); PG8_BAR; PG8_SCHED;
            PG8_LDA(At, 1, 1); PG8_STAGE(PG8_SB(1, 0), b3, voffB); PG8_STAGE(PG8_SB(1, 1), b3 + hstep, voffB); PG8_STAGE(PG8_SA(1, 0), a3, voffA);
            PG8_WAIT_V(8); PG8_WAIT_L(0); PG8_BAR; PG8_MMA(1, 0, At, B0); PG8_MMA(1, 1, At, B1); PG8_BAR; PG8_SCHED;
            } else {
            PG8_LDB(B0, 0, 0); PG8_SCHED; PG8_LDA(At, 0, 0); PG8_STAGE(PG8_SA(1, 1), a1 + hstep, voffA);
            PG8_WAIT_L(8); PG8_BAR; PG8_WAIT_L(0); PG8_MMA(0, 0, At, B0); PG8_BAR; PG8_SCHED;
            PG8_LDB(B1, 0, 1); PG8_STAGE(PG8_SB(0, 0), b2, voffB);
            PG8_BAR; PG8_WAIT_L(0); PG8_MMA(0, 1, At, B1); PG8_BAR;
            PG8_LDA(At, 0, 1); PG8_STAGE(PG8_SA(0, 0), a2, voffA);
            PG8_BAR; PG8_WAIT_L(0); PG8_MMA(1, 0, At, B0); PG8_BAR; PG8_SCHED;
            PG8_STAGE(PG8_SB(0, 1), b2 + hstep, voffB);
            PG8_WAIT_V(6); PG8_BAR; PG8_MMA(1, 1, At, B1); PG8_BAR;
            PG8_LDB(B0, 1, 0); PG8_SCHED; PG8_LDA(At, 1, 0); PG8_STAGE(PG8_SA(0, 1), a2 + hstep, voffA);
            PG8_WAIT_L(8); PG8_BAR; PG8_WAIT_L(0); PG8_MMA(0, 0, At, B0); PG8_BAR; PG8_SCHED;
            PG8_LDB(B1, 1, 1); PG8_STAGE(PG8_SB(1, 0), b3, voffB);
            PG8_BAR; PG8_WAIT_L(0); PG8_MMA(0, 1, At, B1); PG8_BAR;
            PG8_LDA(At, 1, 1); PG8_STAGE(PG8_SA(1, 0), a3, voffA);
            PG8_BAR; PG8_WAIT_L(0); PG8_MMA(1, 0, At, B0); PG8_BAR; PG8_SCHED;
            PG8_STAGE(PG8_SB(1, 1), b3 + hstep, voffB);
            PG8_WAIT_V(6); PG8_BAR; PG8_MMA(1, 1, At, B1); PG8_BAR;
            }
        }
        if constexpr (ALIGN_EPI) { if (wr == 0) PG8_BAR; }
        if constexpr (!Epi::AFTER_DRAIN) { E(acc, cur, wr, wc, fr, fq); S.done(cur); }
        if (!has_next) break;
#pragma unroll
        for (int a = 0; a < 2; ++a)
#pragma unroll
            for (int b = 0; b < 2; ++b)
#pragma unroll
                for (int m = 0; m < 4; ++m)
#pragma unroll
                    for (int n = 0; n < 2; ++n) acc[a][b][m][n] = (f32x4){0.f, 0.f, 0.f, 0.f};
        cur = nxt; cA = nA; cB = nB; ++ui;
        if constexpr (ALIGN_EPI) { if (wr == 1) PG8_BAR; }
    }
    PG8_WAIT_V(0);
    if constexpr (!ALIGN_EPI) { if (wr == 0) PG8_BAR; }
    PG8_BAR;
    if constexpr (Epi::AFTER_DRAIN) { E.fused(acc, cur, wr, wc, fr, fq, lds, wid, lane); S.done(cur); }
#undef PG8_SA
#undef PG8_SB
#undef PG8_STAGE
#undef PG8_LDA
#undef PG8_LDB
#undef PG8_MMA
#undef PG8_WAIT_V
#undef PG8_WAIT_L
#undef PG8_BAR
#undef PG8_SCHED
}
}
#define XB_TMO      128
#define XB_XCNT(j)  (256  + 64 * (j))
#define XB_XSUB(j)  (1280 + 64 * (j))
#define XB_XGEN(j)  (2304 + 64 * (j))
#define XB_TOP      3328
#define XB_TOPGEN   3392
#define XCD_BAR_WORDS 3456
#define XB_SPIN_CAP (1u << 18)

__device__ __forceinline__ unsigned xb_ld(unsigned* p)              { return __hip_atomic_load(p, __ATOMIC_RELAXED, __HIP_MEMORY_SCOPE_AGENT); }
__device__ __forceinline__ unsigned xb_add(unsigned* p, unsigned v) { return __hip_atomic_fetch_add(p, v, __ATOMIC_RELAXED, __HIP_MEMORY_SCOPE_AGENT); }
__device__ __forceinline__ unsigned xb_xcc_id() { return (unsigned)__builtin_amdgcn_s_getreg((3 << 11) | 20) & 0xFu; }
#define XB_SPIN(cond, bar) do { unsigned _sp = 0; while (cond) { __builtin_amdgcn_s_sleep(1); \
    if ((++_sp & 255u) == 0u) { if (xb_ld(&(bar)[XB_TMO])) break; if (_sp > XB_SPIN_CAP) { atomicAdd(&(bar)[XB_TMO], 1u); break; } } } } while (0)

struct XcdBarrier {
    unsigned* bar; unsigned x;
    volatile LAS unsigned* st;
};

__device__ __forceinline__ XcdBarrier xcd_barrier_post(unsigned* bar, volatile LAS unsigned* st) {
    XcdBarrier b; b.bar = bar; b.x = xb_xcc_id(); b.st = st;
    if (threadIdx.x == 0) (void)xb_add(&bar[XB_XCNT(b.x)], 1u);
    return b;
}
__device__ __forceinline__ void xcd_barrier_complete(unsigned* bar, unsigned x, unsigned& nloc, unsigned& nx) {
    const unsigned G = gridDim.x * gridDim.y * gridDim.z;
    unsigned sum, cnt, mine, sp = 0u;
    for (;;) {
        sum = 0u; cnt = 0u; mine = 0u;
#pragma unroll
        for (unsigned j = 0; j < 16; ++j) { const unsigned c = xb_ld(&bar[XB_XCNT(j)]); sum += c; cnt += (c > 0u) ? 1u : 0u; mine = (j == x) ? c : mine; }
        if (sum == G) break;
        __builtin_amdgcn_s_sleep(1);
        if ((++sp & 255u) == 0u) { if (xb_ld(&bar[XB_TMO])) break; if (sp > XB_SPIN_CAP) { atomicAdd(&bar[XB_TMO], 1u); break; } }
    }
    nloc = mine > 0u ? mine : 1u; nx = cnt > 0u ? cnt : 1u;
}

__device__ __forceinline__ void xcd_barrier(const XcdBarrier& b) {
    asm volatile("s_waitcnt vmcnt(0)" ::: "memory");
    __syncthreads();
    if (threadIdx.x == 0) {
        unsigned* bar = b.bar;
        __builtin_amdgcn_s_waitcnt(0);
        unsigned nloc = b.st[0], nx = b.st[1];
        if (nloc == 0u) { xcd_barrier_complete(bar, b.x, nloc, nx); b.st[0] = nloc; b.st[1] = nx; }
        const unsigned old = xb_add(&bar[XB_XSUB(b.x)], 1u);
        const unsigned gen = old / nloc;
        if (old + 1u == (gen + 1u) * nloc) {
            __builtin_amdgcn_fence(__ATOMIC_RELEASE, "agent");
            asm volatile("s_waitcnt vmcnt(0)" ::: "memory");
            const unsigned og = xb_add(&bar[XB_TOP], 1u);
            const unsigned tg = og / nx;
            if (og + 1u == (tg + 1u) * nx) xb_add(&bar[XB_TOPGEN], 1u);
            else XB_SPIN(xb_ld(&bar[XB_TOPGEN]) == tg, bar);
            __builtin_amdgcn_fence(__ATOMIC_ACQUIRE, "agent");
            xb_add(&bar[XB_XGEN(b.x)], 1u);
            asm volatile("s_waitcnt vmcnt(0)" ::: "memory");
        } else {
            XB_SPIN(xb_ld(&bar[XB_XGEN(b.x)]) == gen, bar);
            __builtin_amdgcn_fence(__ATOMIC_ACQUIRE, "agent");
            asm volatile("s_waitcnt vmcnt(0)" ::: "memory");
        }
    }
    __syncthreads();
}

constexpr int NWAVES = 8;
constexpr size_t MiB = 1u << 20;
constexpr size_t WS_CTL = 0, CTL_ZERO_BYTES = 1 * MiB;
constexpr size_t WS_W1T = 2 * MiB;
constexpr size_t WS_W2T = 16 * MiB;
constexpr size_t WS_W3T = 24 * MiB;
constexpr size_t WS_SKB = 32 * MiB;
constexpr size_t WS_RSTD1 = 33 * MiB;
constexpr size_t WS_SSA = 34 * MiB;
constexpr size_t WS_SSL = 35 * MiB;
constexpr size_t WS_SS2 = 37 * MiB;
constexpr size_t WS_RSTD2 = 39 * MiB;
constexpr size_t WS_IDS = 40 * MiB;
constexpr size_t WS_GW = 48 * MiB;
constexpr size_t WS_UB = 64 * MiB;
constexpr size_t WS_VB = 128 * MiB;
constexpr size_t WS_A1 = 192 * MiB;
constexpr size_t WS_Q = 258 * MiB;
constexpr size_t WS_KV = 290 * MiB;
constexpr size_t WS_XB = 299 * MiB;
constexpr size_t WS_GT = 332 * MiB;
constexpr size_t WS_H1 = 364 * MiB;
constexpr size_t WS_PART = 192 * MiB;
constexpr size_t WS_W = 56 * MiB;
constexpr size_t WS_Z = 428 * MiB;
constexpr size_t WS_END = 492 * MiB;
constexpr int CW_BAR = 4096;

constexpr int RING_OFF = 0, RING_BYTES = 131072;
constexpr int LDSCTL_OFF = RING_BYTES, MISC_OFF = LDSCTL_OFF + 320;
constexpr int LDS_BYTES = 147456;

typedef unsigned short bf16;
typedef unsigned v4u __attribute__((ext_vector_type(4)));
typedef float f32x4 __attribute__((ext_vector_type(4)));
typedef short bf16x8 __attribute__((ext_vector_type(8)));
typedef GAS unsigned gu32;
#define RLX_AGENT __ATOMIC_RELAXED, __HIP_MEMORY_SCOPE_AGENT
#define LDS_WAIT() asm volatile("s_waitcnt lgkmcnt(0)" ::: "memory")
#define VM_WAIT() asm volatile("s_waitcnt vmcnt(0)" ::: "memory")
__device__ __forceinline__ unsigned f2bf(float f) { unsigned u = __builtin_bit_cast(unsigned, f); return (u + 0x7fffu + ((u >> 16) & 1u)) >> 16; }
__device__ __forceinline__ unsigned pk2(float lo, float hi) { return f2bf(lo) | (f2bf(hi) << 16); }
__device__ __forceinline__ float bf2f(unsigned short b) { return __builtin_bit_cast(float, (unsigned)b << 16); }

namespace p2 {
typedef float f32x16 __attribute__((ext_vector_type(16)));
typedef unsigned u32x2 __attribute__((ext_vector_type(2)));
constexpr float LOG2E = 1.4426950408889634f;
constexpr float NEGBIG = -1e30f;
__device__ __forceinline__ int crow(int r, int hi) { return (r & 3) + 8 * (r >> 2) + 4 * hi; }
__device__ __forceinline__ unsigned cvtpk(float lo, float hi) { unsigned r; asm volatile("v_cvt_pk_bf16_f32 %0, %1, %2" : "=v"(r) : "v"(lo), "v"(hi)); return r; }
__device__ __forceinline__ float ex2(float x) { return __builtin_amdgcn_exp2f(x); }
__device__ __forceinline__ float rcp(float x) { return __builtin_amdgcn_rcpf(x); }
__device__ __forceinline__ float gelu_fast(float x) { return x * rcp(1.0f + ex2(-2.302208198f * x * (1.0f + 0.044715f * x * x))); }

constexpr int A_KS = 0, A_KSP = 144, A_VT = 288 * 144, A_VTP = 584, A_ST = A_VT + 64 * 584, A_END = A_ST + 8 * 4096;
__device__ __forceinline__ void attn_unit(LAS unsigned char* lds, int b, int qblk, int kvh, const bf16* QB, const bf16* KVB, const float* sinks, bf16* MIX, float* SSA, int tid) {
    const int lane = tid & 63, wave = __builtin_amdgcn_readfirstlane(tid >> 6), r = lane & 31, hi = lane >> 5;
    const int q0 = qblk * 128, hq = kvh * 8 + wave;
    for (int it = 0; it < 5; ++it) {
        const int cid = it * 512 + tid;
        if (cid < 288 * 8) {
            const int key = cid >> 3, ch = cid & 7;
            bool valid; size_t row = 0;
            if (key < 256) { const int pos = q0 - 128 + key; valid = pos >= 0; row = (size_t)b * SEQ + pos; }
            else if (key < 272) { valid = true; row = (size_t)MREAL + (key - 256); }
            else valid = false;
            v4u kv = {0u, 0u, 0u, 0u}, vv = {0u, 0u, 0u, 0u};
            if (valid) { kv = *(const GAS v4u*)(KVB + row * 256 + kvh * 64 + ch * 8); vv = *(const GAS v4u*)(KVB + row * 256 + 128 + kvh * 64 + ch * 8); }
            *(LAS v4u*)(lds + A_KS + key * A_KSP + ch * 16) = kv;
            LAS unsigned short* vt = (LAS unsigned short*)(lds + A_VT);
#pragma unroll
            for (int j = 0; j < 8; ++j) { const unsigned wv = vv[j >> 1]; vt[(ch * 8 + j) * (A_VTP / 2) + key] = (unsigned short)((j & 1) ? (wv >> 16) : (wv & 0xffffu)); }
        }
    }
    __syncthreads();
    const float sink2 = sinks[hq] * LOG2E;
    for (int qg = 0; qg < 4; ++qg) {
        const size_t mrow = (size_t)b * SEQ + q0 + 32 * qg + r;
        bf16x8 qf[4];
#pragma unroll
        for (int ks = 0; ks < 4; ++ks) qf[ks] = *(const GAS bf16x8*)(QB + mrow * 1024 + hq * 64 + ks * 16 + hi * 8);
        f32x16 s[6];
#pragma unroll
        for (int t = 0; t < 6; ++t) {
            const int kbase = t < 5 ? 32 * (qg + t) : 256;
            f32x16 acc = {0.f, 0.f, 0.f, 0.f, 0.f, 0.f, 0.f, 0.f, 0.f, 0.f, 0.f, 0.f, 0.f, 0.f, 0.f, 0.f};
#pragma unroll
            for (int ks = 0; ks < 4; ++ks) {
                const bf16x8 kf = *(const LAS bf16x8*)(lds + A_KS + (kbase + r) * A_KSP + ks * 32 + hi * 16);
                acc = __builtin_amdgcn_mfma_f32_32x32x16_bf16(kf, qf[ks], acc, 0, 0, 0);
            }
            s[t] = acc;
        }
        const bool blk0 = (qblk == 0);
#pragma unroll
        for (int reg = 0; reg < 16; ++reg) {
            const int j = crow(reg, hi);
            s[0][reg] = (j > r) ? s[0][reg] : NEGBIG;
            s[4][reg] = (j <= r) ? s[4][reg] : NEGBIG;
            s[5][reg] = (j < 16) ? s[5][reg] : NEGBIG;
        }
#pragma unroll
        for (int t = 0; t < 4; ++t) if (blk0 && (qg + t < 4)) {
#pragma unroll
            for (int reg = 0; reg < 16; ++reg) s[t][reg] = NEGBIG;
        }
        float m = sink2;
#pragma unroll
        for (int t = 0; t < 6; ++t)
#pragma unroll
            for (int reg = 0; reg < 16; ++reg) m = fmaxf(m, s[t][reg]);
        m = fmaxf(m, __shfl_xor(m, 32));
        float l = 0.f;
#pragma unroll
        for (int t = 0; t < 6; ++t)
#pragma unroll
            for (int reg = 0; reg < 16; ++reg) { const float p = ex2(s[t][reg] - m); s[t][reg] = p; l += p; }
        l += __shfl_xor(l, 32);
        l += ex2(sink2 - m);
        const float linv = 1.0f / l;
        f32x16 o0 = {0.f, 0.f, 0.f, 0.f, 0.f, 0.f, 0.f, 0.f, 0.f, 0.f, 0.f, 0.f, 0.f, 0.f, 0.f, 0.f}, o1 = o0;
#pragma unroll
        for (int t = 0; t < 6; ++t) {
            const int kbase = t < 5 ? 32 * (qg + t) : 256;
#pragma unroll
            for (int ss = 0; ss < 2; ++ss) {
                v4u pw; pw.x = cvtpk(s[t][8 * ss + 0], s[t][8 * ss + 1]); pw.y = cvtpk(s[t][8 * ss + 2], s[t][8 * ss + 3]);
                pw.z = cvtpk(s[t][8 * ss + 4], s[t][8 * ss + 5]); pw.w = cvtpk(s[t][8 * ss + 6], s[t][8 * ss + 7]);
                const bf16x8 pa = __builtin_bit_cast(bf16x8, pw);
                const int ko = (kbase + 16 * ss + 4 * hi) * 2;
                {   const u32x2 lo = *(const LAS u32x2*)(lds + A_VT + r * A_VTP + ko), h2 = *(const LAS u32x2*)(lds + A_VT + r * A_VTP + ko + 16);
                    v4u vw; vw.x = lo.x; vw.y = lo.y; vw.z = h2.x; vw.w = h2.y;
                    o0 = __builtin_amdgcn_mfma_f32_32x32x16_bf16(pa, __builtin_bit_cast(bf16x8, vw), o0, 0, 0, 0); }
                {   const u32x2 lo = *(const LAS u32x2*)(lds + A_VT + (32 + r) * A_VTP + ko), h2 = *(const LAS u32x2*)(lds + A_VT + (32 + r) * A_VTP + ko + 16);
                    v4u vw; vw.x = lo.x; vw.y = lo.y; vw.z = h2.x; vw.w = h2.y;
                    o1 = __builtin_amdgcn_mfma_f32_32x32x16_bf16(pa, __builtin_bit_cast(bf16x8, vw), o1, 0, 0, 0); }
            }
        }
        LAS unsigned short* stg = (LAS unsigned short*)(lds + A_ST + wave * 4096);
#pragma unroll
        for (int reg = 0; reg < 16; ++reg) {
            const int qr = crow(reg, hi); const float li = __shfl(linv, qr);
            stg[qr * 64 + r] = (unsigned short)f2bf(o0[reg] * li);
            stg[qr * 64 + 32 + r] = (unsigned short)f2bf(o1[reg] * li);
        }
        asm volatile("s_waitcnt lgkmcnt(0)" ::: "memory");
#pragma unroll
        for (int i = 0; i < 4; ++i) {
            const int row = i * 8 + (lane >> 3), ch = lane & 7;
            const v4u v = *(const LAS v4u*)(stg + row * 64 + ch * 8);
            float ss = 0.f;
#pragma unroll
            for (int k = 0; k < 4; ++k) { const float a = __builtin_bit_cast(float, v[k] << 16), c = __builtin_bit_cast(float, v[k] & 0xffff0000u); ss += a * a + c * c; }
            ss += __shfl_xor(ss, 1); ss += __shfl_xor(ss, 2); ss += __shfl_xor(ss, 4);
            const size_t orow = (size_t)b * SEQ + q0 + 32 * qg + row;
            *(GAS v4u*)(MIX + orow * D + hq * 64 + ch * 8) = v;
            if (ch == 0) SSA[orow * 16 + hq] = ss;
        }
        asm volatile("s_waitcnt lgkmcnt(0)" ::: "memory");
    }
    __syncthreads();
}

constexpr int L_XS = 0, L_XC = 33280, L_XCF = L_XC + 36864, L_GS = L_XCF + 32768, L_W = L_GS + 16384, L_CT = L_W + 9216, L_END = L_CT + 2048;
static_assert(L_END <= 131072, "lru lds");
struct LruP { const float *conv_w, *conv_b, *w_r, *b_r, *w_i, *b_i, *lam; };
__device__ __forceinline__ void lru_unit(LAS unsigned char* lds, int b, int nb, int cg, const bf16* XBB, const bf16* GTB, const LruP P, bf16* MIX, float* SSL, int tid) {
    const int lane = tid & 63, wave = __builtin_amdgcn_readfirstlane(tid >> 6), r = lane & 31, hi = lane >> 5;
    {
        LAS unsigned short* wt = (LAS unsigned short*)(lds + L_W);
#pragma unroll
        for (int i = 0; i < 4; ++i) {
            const int e = tid + 512 * i, c = e >> 5, dl = e & 31;
            const size_t gi = (size_t)(nb * 64 + c) * 64 + 32 * cg + dl;
            wt[dl * 72 + c] = (unsigned short)f2bf(P.w_r[gi]);
            wt[32 * 72 + dl * 72 + c] = (unsigned short)f2bf(P.w_i[gi]);
        }
    }
    const int cc = tid & 63, chc = nb * 64 + cc;
    const float cw0 = P.conv_w[0 * LW + chc], cw1 = P.conv_w[1 * LW + chc], cw2 = P.conv_w[2 * LW + chc], cw3 = P.conv_w[3 * LW + chc], cbv = P.conv_b[chc];
    const int chd = nb * 64 + 32 * cg + r;
    const float br = P.b_r[chd], bi = P.b_i[chd];
    const float ls8 = -8.0f * log1pf(expf(-P.lam[chd])) * LOG2E;
    float state = 0.f;
    for (int tile = 0; tile < 9; ++tile) {
        for (int it = 0; it < 5; ++it) {
            const int cid = it * 512 + tid;
            if (cid < 259 * 8) {
                const int j = cid >> 3, ch = cid & 7, t = j - 3;
                bool valid; size_t row = 0;
                if (tile == 0) { valid = (t >= 0 && t < NMETA); row = (size_t)MREAL + t; }
                else if (tile == 1 && t < 0) { valid = true; row = (size_t)MREAL + NMETA + t; }
                else { valid = true; row = (size_t)b * SEQ + 256 * (tile - 1) + t; }
                v4u v = {0u, 0u, 0u, 0u};
                if (valid) v = *(const GAS v4u*)(XBB + row * 1024 + nb * 64 + ch * 8);
                *(LAS v4u*)(lds + L_XS + j * 128 + ch * 16) = v;
            }
        }
        if (tile > 0) {
#pragma unroll
            for (int it = 0; it < 2; ++it) {
                const int cid = it * 512 + tid, t = cid >> 2, ch = cid & 3;
                const size_t row = (size_t)b * SEQ + 256 * (tile - 1) + t;
                *(LAS v4u*)(lds + L_GS + t * 64 + ch * 16) = *(const GAS v4u*)(GTB + row * 1024 + nb * 64 + 32 * cg + ch * 8);
            }
        }
        __syncthreads();
        {
            const LAS unsigned short* xs = (const LAS unsigned short*)(lds + L_XS);
            LAS unsigned short* xc = (LAS unsigned short*)(lds + L_XC);
            LAS float* xcf = (LAS float*)(lds + L_XCF);
            const int t0 = 32 * wave;
            float x0 = bf2f(xs[(t0 + 0) * 64 + cc]), x1 = bf2f(xs[(t0 + 1) * 64 + cc]), x2 = bf2f(xs[(t0 + 2) * 64 + cc]);
#pragma unroll 8
            for (int k = 0; k < 32; ++k) {
                const float x3 = bf2f(xs[(t0 + k + 3) * 64 + cc]);
                const float v = cbv + cw0 * x0 + cw1 * x1 + cw2 * x2 + cw3 * x3;
                xc[(t0 + k) * 72 + cc] = (unsigned short)f2bf(v);
                if ((cc >> 5) == cg) xcf[(t0 + k) * 32 + (cc & 31)] = v;
                x0 = x1; x1 = x2; x2 = x3;
            }
        }
        __syncthreads();
        f32x16 aR = {0.f, 0.f, 0.f, 0.f, 0.f, 0.f, 0.f, 0.f, 0.f, 0.f, 0.f, 0.f, 0.f, 0.f, 0.f, 0.f}, aI = aR;
#pragma unroll
        for (int ks = 0; ks < 4; ++ks) {
            const bf16x8 xa = *(const LAS bf16x8*)(lds + L_XC + (32 * wave + r) * 144 + ks * 32 + hi * 16);
            const bf16x8 wr_ = *(const LAS bf16x8*)(lds + L_W + r * 144 + ks * 32 + hi * 16);
            const bf16x8 wi_ = *(const LAS bf16x8*)(lds + L_W + 32 * 144 + r * 144 + ks * 32 + hi * 16);
            aR = __builtin_amdgcn_mfma_f32_32x32x16_bf16(xa, wr_, aR, 0, 0, 0);
            aI = __builtin_amdgcn_mfma_f32_32x32x16_bf16(xa, wi_, aI, 0, 0, 0);
        }
        float Av[16], Bv[16];
        {
            const LAS float* xcf = (const LAS float*)(lds + L_XCF);
#pragma unroll
            for (int reg = 0; reg < 16; ++reg) {
                const int t = 32 * wave + crow(reg, hi);
                const bool valid = (tile > 0) || (t < NMETA);
                const float rg = rcp(1.0f + ex2(-(aR[reg] + br) * LOG2E));
                const float ig = rcp(1.0f + ex2(-(aI[reg] + bi) * LOG2E));
                const float a = ex2(rg * ls8);
                const float mult = __builtin_amdgcn_sqrtf(fmaxf(1.0f - a * a, 0.f));
                const float bx = mult * ig * xcf[t * 32 + r];
                Av[reg] = valid ? a : 1.0f; Bv[reg] = valid ? bx : 0.0f;
            }
        }
#pragma unroll
        for (int g = 0; g < 4; ++g) {
#pragma unroll
            for (int k = 1; k < 4; ++k) { Bv[4 * g + k] = Av[4 * g + k] * Bv[4 * g + k - 1] + Bv[4 * g + k]; Av[4 * g + k] = Av[4 * g + k] * Av[4 * g + k - 1]; }
        }
        float myCz[4], myCp[4], PW, HW;
        {
            float cz = 0.f, cp = 1.f;
#pragma unroll
            for (int g = 0; g < 4; ++g) {
                const float mP = Av[4 * g + 3], mH = Bv[4 * g + 3];
                const float oP = __shfl_xor(mP, 32), oH = __shfl_xor(mH, 32);
                const float eP = hi ? oP : mP, eH = hi ? oH : mH, dP = hi ? mP : oP, dH = hi ? mH : oH;
                const float cz0 = cz, cp0 = cp;
                cz = eP * cz + eH; cp = cp * eP;
                myCz[g] = hi ? cz : cz0; myCp[g] = hi ? cp : cp0;
                cz = dP * cz + dH; cp = cp * dP;
            }
            PW = cp; HW = cz;
        }
        if (hi == 0) { LAS float* ct = (LAS float*)(lds + L_CT); ct[(wave * 32 + r) * 2] = PW; ct[(wave * 32 + r) * 2 + 1] = HW; }
        __syncthreads();
        float cin = 0.f;
        {
            const LAS float* ct = (const LAS float*)(lds + L_CT);
            float c = state;
#pragma unroll
            for (int w2 = 0; w2 < 8; ++w2) { if (w2 == wave) cin = c; c = ct[(w2 * 32 + r) * 2] * c + ct[(w2 * 32 + r) * 2 + 1]; }
            state = c;
        }
        if (tile > 0) {
            const LAS unsigned short* gs = (const LAS unsigned short*)(lds + L_GS);
            LAS unsigned short* os = (LAS unsigned short*)(lds + L_XS);
#pragma unroll
            for (int reg = 0; reg < 16; ++reg) {
                const int g = reg >> 2, t = 32 * wave + crow(reg, hi);
                const float h = Bv[reg] + Av[reg] * (myCz[g] + myCp[g] * cin);
                const float gt = bf2f(gs[t * 32 + r]);
                os[t * 32 + r] = (unsigned short)f2bf(gelu_fast(gt) * h);
            }
        }
        __syncthreads();
        if (tile > 0) {
#pragma unroll
            for (int it = 0; it < 2; ++it) {
                const int cid = it * 512 + tid, t = cid >> 2, ch = cid & 3;
                const v4u v = *(const LAS v4u*)(lds + L_XS + t * 64 + ch * 16);
                float ss = 0.f;
#pragma unroll
                for (int k = 0; k < 4; ++k) { const float a = __builtin_bit_cast(float, v[k] << 16), c = __builtin_bit_cast(float, v[k] & 0xffff0000u); ss += a * a + c * c; }
                ss += __shfl_xor(ss, 1); ss += __shfl_xor(ss, 2);
                const size_t row = (size_t)b * SEQ + 256 * (tile - 1) + t;
                *(GAS v4u*)(MIX + row * D + 1024 + nb * 64 + 32 * cg + ch * 8) = v;
                if (ch == 0) SSL[row * 32 + nb * 2 + cg] = ss;
            }
        }
        __syncthreads();
    }
}
}

namespace p5 {
typedef float f32x16 __attribute__((ext_vector_type(16)));
constexpr int KP = 272;
constexpr int R_KEYS = 0, R_IDX = 256 * KP, R_END = R_IDX + 8 * 1024;
__device__ __forceinline__ int crow(int r, int hi) { return (r & 3) + 8 * (r >> 2) + 4 * hi; }
__device__ __forceinline__ int med3i(int a, int b, int c) { int d; asm("v_med3_i32 %0, %1, %2, %3" : "=v"(d) : "v"(a), "v"(b), "v"(c)); return d; }
__device__ __forceinline__ int imax(int a, int b) { return a > b ? a : b; }
__device__ __forceinline__ int imin(int a, int b) { return a < b ? a : b; }
__device__ __forceinline__ int ordf(float f) { const int b = __builtin_bit_cast(int, f); return b ^ ((b >> 31) & 0x7fffffff); }
__device__ __forceinline__ float unordf(int o) { const int b = o ^ ((o >> 31) & 0x7fffffff); return __builtin_bit_cast(float, b); }
__device__ __forceinline__ void ins16(int (&L)[16], int v) {
#pragma unroll
    for (int k = 15; k >= 1; --k) L[k] = med3i(L[k - 1], L[k], v);
    L[0] = imax(L[0], v);
}
__device__ __forceinline__ void half_top16(const LAS unsigned char* keys, const bf16* qrow, int r, int hi, int (&T)[16]) {
    bf16x8 qf[8];
#pragma unroll
    for (int ks = 0; ks < 8; ++ks) qf[ks] = *(const GAS bf16x8*)(qrow + ks * 16 + hi * 8);
    int L[16];
#pragma unroll
    for (int k = 0; k < 16; ++k) L[k] = (int)0x80000000;
    const int h4 = 4 * hi;
#pragma unroll
    for (int kt = 0; kt < 4; ++kt) {
        f32x16 acc = {0.f, 0.f, 0.f, 0.f, 0.f, 0.f, 0.f, 0.f, 0.f, 0.f, 0.f, 0.f, 0.f, 0.f, 0.f, 0.f};
#pragma unroll
        for (int ks = 0; ks < 8; ++ks) {
            const bf16x8 kf = *(const LAS bf16x8*)(keys + (kt * 32 + r) * KP + ks * 32 + hi * 16);
            acc = __builtin_amdgcn_mfma_f32_32x32x16_bf16(kf, qf[ks], acc, 0, 0, 0);
        }
#pragma unroll
        for (int reg = 0; reg < 16; ++reg) {
            const int C = 127 - 32 * kt - (reg & 3) - 8 * (reg >> 2);
            const int key = ((ordf(acc[reg]) & (int)0xffffff80) | C) - h4;
            ins16(L, key);
        }
    }
    int M[16];
#pragma unroll
    for (int i = 0; i < 16; ++i) M[i] = imax(L[i], __shfl_xor(L[15 - i], 32));
#define P5_STAGE(st) _Pragma("unroll") for (int i = 0; i < 16; ++i) if ((i & (st)) == 0) { const int a = imax(M[i], M[i + (st)]), b = imin(M[i], M[i + (st)]); M[i] = a; M[i + (st)] = b; }
    P5_STAGE(8) P5_STAGE(4) P5_STAGE(2) P5_STAGE(1)
#undef P5_STAGE
#pragma unroll
    for (int i = 0; i < 16; ++i) T[i] = M[i];
}

__device__ __forceinline__ void retr_unit(LAS unsigned char* lds, int h, int tg, const bf16* QPB, const bf16* SKB, const float* SS2, unsigned short* IDS, float* GW, float* RSTD2, int tid) {
    const int lane = tid & 63, wave = __builtin_amdgcn_readfirstlane(tid >> 6), r = lane & 31, hi = lane >> 5;
#pragma unroll
    for (int it = 0; it < 8; ++it) {
        const int cid = it * 512 + tid, row = cid >> 4, ch = cid & 15;
        *(LAS v4u*)(lds + R_KEYS + row * KP + ch * 16) = *(const GAS v4u*)(SKB + ((size_t)h * 256 + row) * 128 + ch * 8);
    }
    __syncthreads();
    const size_t tok = (size_t)tg * 256 + wave * 32 + r;
    int TA[16], TB[16];
    half_top16(lds + R_KEYS, QPB + tok * D + h * 256, r, hi, TA);
    half_top16(lds + R_KEYS + 128 * KP, QPB + tok * D + h * 256 + 128, r, hi, TB);
    LAS unsigned char* sc = lds + R_IDX + wave * 1024 + r * 32;
    const int hm = -hi;
    {
        v4u w;
#pragma unroll
        for (int q = 0; q < 4; ++q) { unsigned x = 0;
#pragma unroll
            for (int k = 0; k < 4; ++k) { const int t = (TB[4 * q + k] & hm) | (TA[4 * q + k] & ~hm); x |= (unsigned)(127 - (t & 0x7f)) << (8 * k); }
            w[q] = x; }
        *(LAS v4u*)(sc + hi * 16) = w;
    }
    float sA[16], sB[16];
#pragma unroll
    for (int i = 0; i < 16; ++i) { sA[i] = unordf(TA[i] & (int)0xffffff80); sB[i] = unordf(TB[i] & (int)0xffffff80); }
    int L[16];
#pragma unroll
    for (int k = 0; k < 16; ++k) L[k] = (int)0x80000000;
#pragma unroll
    for (int i = 0; i < 16; ++i)
#pragma unroll
        for (int j = 0; j < 16; ++j) if ((i + 1) * (j + 1) <= 16) {
            const int key = (ordf(sA[i] + sB[j]) & (int)0xffffff00) | (255 - (i * 16 + j));
            ins16(L, key);
        }
    float ssq = 0.f;
#pragma unroll
    for (int k = 0; k < 8; ++k) { const f32x4 v = *(const GAS f32x4*)(SS2 + tok * 32 + 4 * k); ssq += (v.x + v.y) + (v.z + v.w); }
    const float rs = 1.0f / sqrtf(ssq * (1.0f / D) + EPS);
    if (h == 0 && hi == 0) RSTD2[tok] = rs;
    const float v0 = unordf(L[0] & (int)0xffffff00);
    asm volatile("s_waitcnt lgkmcnt(0)" ::: "memory");
    int ex[8]; float ew[8]; float esum = 0.f;
#pragma unroll
    for (int k = 0; k < 8; ++k) {
        const int t = (L[8 + k] & hm) | (L[k] & ~hm);
        const int c = 255 - (t & 0xff);
        const int ia = sc[c >> 4], ib = sc[16 + (c & 15)];
        ex[k] = ia * 128 + ib;
        const float e = __builtin_amdgcn_exp2f((unordf(t & (int)0xffffff00) - v0) * rs * 1.4426950408889634f);
        ew[k] = e; esum += e;
    }
    esum += __shfl_xor(esum, 32);
    const float inv = 1.0f / esum;
    unsigned short* ip = IDS + tok * 128 + h * 16 + hi * 8; float* gp = GW + tok * 128 + h * 16 + hi * 8;
    *(GAS v4u*)(ip) = (v4u){(unsigned)ex[0] | ((unsigned)ex[1] << 16), (unsigned)ex[2] | ((unsigned)ex[3] << 16), (unsigned)ex[4] | ((unsigned)ex[5] << 16), (unsigned)ex[6] | ((unsigned)ex[7] << 16)};
    *(GAS f32x4*)(gp) = (f32x4){ew[0] * inv, ew[1] * inv, ew[2] * inv, ew[3] * inv};
    *(GAS f32x4*)(gp + 4) = (f32x4){ew[4] * inv, ew[5] * inv, ew[6] * inv, ew[7] * inv};
    __syncthreads();
}
}

namespace p6 {
typedef __bf16 bf2 __attribute__((ext_vector_type(2)));
__device__ __forceinline__ float dot2(unsigned a, unsigned b, float c) { return __builtin_amdgcn_fdot2_f32_bf16(__builtin_bit_cast(bf2, a), __builtin_bit_cast(bf2, b), c, false); }
__device__ __forceinline__ float blo(unsigned w) { return __builtin_bit_cast(float, w << 16); }
__device__ __forceinline__ float bhi(unsigned w) { return __builtin_bit_cast(float, w & 0xffff0000u); }
__device__ __forceinline__ float gelu_fast(float x) { return x * __builtin_amdgcn_rcpf(1.0f + __builtin_amdgcn_exp2f(-2.302208198f * x * (1.0f + 0.044715f * x * x))); }
__device__ __forceinline__ unsigned idw(const v4u& a, const v4u& b, int g) { const unsigned w = g < 8 ? a[(g & 7) >> 1] : b[(g & 7) >> 1]; return (g & 1) ? (w >> 16) : (w & 0xffffu); }

__device__ __forceinline__ void usweep(const bf16* H1B, const bf16* USL, const unsigned short* IDS, bf16* PART, int slot, int rank, int nrank, int wave, int lane) {
    const int ps = lane >> 3, ch = lane & 7;
    for (int rd = 0; rd < 4; ++rd) {
        const int sg = rd * 8 + slot;
        const bf16* tab = USL + (size_t)sg * 16384 * 64 + ch * 8;
        for (int t = rank * 8 + wave; t < MREAL; t += nrank * 8) {
            const v4u i0 = *(const GAS v4u*)(IDS + (size_t)t * 128 + ps * 16), i1 = *(const GAS v4u*)(IDS + (size_t)t * 128 + ps * 16 + 8);
            const v4u xv = *(const GAS v4u*)(H1B + (size_t)t * D + sg * 64 + ch * 8);
            float d[16];
#pragma unroll
            for (int g = 0; g < 16; ++g) {
                const v4u u = *(const GAS v4u*)(tab + (size_t)idw(i0, i1, g) * 64);
                float a = dot2(u[0], xv[0], 0.f); a = dot2(u[1], xv[1], a); a = dot2(u[2], xv[2], a); a = dot2(u[3], xv[3], a);
                d[g] = a;
            }
#pragma unroll
            for (int g = 0; g < 16; ++g) { d[g] += __shfl_xor(d[g], 1); d[g] += __shfl_xor(d[g], 2); d[g] += __shfl_xor(d[g], 4); }
            if (ch == 0) {
                v4u o0, o1;
                o0.x = pk2(d[0], d[1]); o0.y = pk2(d[2], d[3]); o0.z = pk2(d[4], d[5]); o0.w = pk2(d[6], d[7]);
                o1.x = pk2(d[8], d[9]); o1.y = pk2(d[10], d[11]); o1.z = pk2(d[12], d[13]); o1.w = pk2(d[14], d[15]);
                bf16* pp = PART + ((size_t)sg * MREAL + t) * 128 + ps * 16;
                *(GAS v4u*)(pp) = o0; *(GAS v4u*)(pp + 8) = o1;
            }
        }
    }
}
__device__ __forceinline__ void wreduce(const bf16* PART, const float* GW, const float* RSTD2, float* W, size_t gt, size_t NT) {
    for (size_t i8 = gt; i8 < (size_t)MREAL * 128 / 8; i8 += NT) {
        float s[8];
#pragma unroll
        for (int k = 0; k < 8; ++k) s[k] = 0.f;
#pragma unroll 8
        for (int sg = 0; sg < 32; ++sg) {
            const v4u p = *(const GAS v4u*)(PART + (size_t)sg * MREAL * 128 + i8 * 8);
#pragma unroll
            for (int k = 0; k < 4; ++k) { s[2 * k] += blo(p[k]); s[2 * k + 1] += bhi(p[k]); }
        }
        const float rs = RSTD2[i8 >> 4];
        const f32x4 g0 = *(const GAS f32x4*)(GW + i8 * 8), g1 = *(const GAS f32x4*)(GW + i8 * 8 + 4);
        *(GAS f32x4*)(W + i8 * 8) = (f32x4){g0.x * gelu_fast(rs * s[0]), g0.y * gelu_fast(rs * s[1]), g0.z * gelu_fast(rs * s[2]), g0.w * gelu_fast(rs * s[3])};
        *(GAS f32x4*)(W + i8 * 8 + 4) = (f32x4){g1.x * gelu_fast(rs * s[4]), g1.y * gelu_fast(rs * s[5]), g1.z * gelu_fast(rs * s[6]), g1.w * gelu_fast(rs * s[7])};
    }
}
__device__ __forceinline__ void vsweep(const bf16* H1B, const bf16* VSL, const unsigned short* IDS, const float* W, bf16* Z, float* SSF, int slot, int rank, int nrank, int wave, int lane) {
    const int ps = lane >> 3, ch = lane & 7;
    for (int rd = 0; rd < 4; ++rd) {
        const int sg = rd * 8 + slot;
        const bf16* tab = VSL + (size_t)sg * 16384 * 64 + ch * 8;
        for (int t = rank * 8 + wave; t < MREAL; t += nrank * 8) {
            const v4u i0 = *(const GAS v4u*)(IDS + (size_t)t * 128 + ps * 16), i1 = *(const GAS v4u*)(IDS + (size_t)t * 128 + ps * 16 + 8);
            f32x4 wv[4];
#pragma unroll
            for (int q = 0; q < 4; ++q) wv[q] = *(const GAS f32x4*)(W + (size_t)t * 128 + ps * 16 + 4 * q);
            float acc[8];
#pragma unroll
            for (int k = 0; k < 8; ++k) acc[k] = 0.f;
#pragma unroll
            for (int g = 0; g < 16; ++g) {
                const v4u v = *(const GAS v4u*)(tab + (size_t)idw(i0, i1, g) * 64);
                const float w = wv[g >> 2][g & 3];
#pragma unroll
                for (int k = 0; k < 4; ++k) { acc[2 * k] += w * blo(v[k]); acc[2 * k + 1] += w * bhi(v[k]); }
            }
#pragma unroll
            for (int k = 0; k < 8; ++k) { acc[k] += __shfl_xor(acc[k], 8); acc[k] += __shfl_xor(acc[k], 16); acc[k] += __shfl_xor(acc[k], 32); }
            const v4u xv = *(const GAS v4u*)(H1B + (size_t)t * D + sg * 64 + ch * 8);
            float ss = 0.f;
#pragma unroll
            for (int k = 0; k < 4; ++k) { acc[2 * k] += blo(xv[k]); acc[2 * k + 1] += bhi(xv[k]); ss += acc[2 * k] * acc[2 * k] + acc[2 * k + 1] * acc[2 * k + 1]; }
            ss += __shfl_xor(ss, 1); ss += __shfl_xor(ss, 2); ss += __shfl_xor(ss, 4);
            if (ps == 0) {
                v4u o; o.x = pk2(acc[0], acc[1]); o.y = pk2(acc[2], acc[3]); o.z = pk2(acc[4], acc[5]); o.w = pk2(acc[6], acc[7]);
                *(GAS v4u*)(Z + (size_t)t * D + sg * 64 + ch * 8) = o;
                if (ch == 0) SSF[(size_t)t * 32 + sg] = ss;
            }
        }
    }
}
__device__ __forceinline__ void final_row(const bf16* Z, const float* SSF, const float* fg, float* out, size_t tok, int lane) {
    v4u z[4];
#pragma unroll
    for (int j = 0; j < 4; ++j) z[j] = *(const GAS v4u*)(Z + tok * D + j * 512 + lane * 8);
    float ss = 0.f;
#pragma unroll
    for (int k = 0; k < 8; ++k) { const f32x4 v = *(const GAS f32x4*)(SSF + tok * 32 + 4 * k); ss += (v.x + v.y) + (v.z + v.w); }
    const float rf = 1.0f / sqrtf(ss * (1.0f / D) + EPS);
#pragma unroll
    for (int j = 0; j < 4; ++j) {
        const f32x4 ga = *(const GAS f32x4*)(fg + j * 512 + lane * 8), gb = *(const GAS f32x4*)(fg + j * 512 + lane * 8 + 4);
        *(GAS f32x4*)(out + tok * D + j * 512 + lane * 8) = (f32x4){blo(z[j][0]) * rf * ga.x, bhi(z[j][0]) * rf * ga.y, blo(z[j][1]) * rf * ga.z, bhi(z[j][1]) * rf * ga.w};
        *(GAS f32x4*)(out + tok * D + j * 512 + lane * 8 + 4) = (f32x4){blo(z[j][2]) * rf * gb.x, bhi(z[j][2]) * rf * gb.y, blo(z[j][3]) * rf * gb.z, bhi(z[j][3]) * rf * gb.w};
    }
}
}

struct Frame {
    LAS unsigned char* lds;
    volatile LAS unsigned* MISC;
    gu32* ctl;
    int tid, lane, wave, vcu, G;
};
__device__ __forceinline__ float wave_sum(float v) {
#pragma unroll
    for (int o = 1; o < 64; o <<= 1) v += __shfl_xor(v, o);
    return v;
}
__device__ __forceinline__ void p0_transpose_item(const float* W, int K, int N, bf16* WT, const float* g0, const float* g1, int ksplit, LAS float* scr, int item, int lane) {
    const int nblk = N / 32, kb = item / nblk, nb = item % nblk, k0 = 64 * kb, n0 = 32 * nb;
#pragma unroll 8
    for (int i = 0; i < 32; ++i) { const int kk = 2 * i + (lane >> 5); const int kg = k0 + kk; const float gv = kg < ksplit ? g0[kg] : g1[kg - ksplit];
        scr[kk * 33 + (lane & 31)] = W[(size_t)kg * N + n0 + (lane & 31)] * gv; }
    LDS_WAIT(); asm volatile("" ::: "memory");
    const int c = lane & 7;
#pragma unroll
    for (int j = 0; j < 4; ++j) { const int n = (lane >> 3) + 8 * j; const LAS float* s = scr + (8 * c) * 33 + n;
        v4u o; o.x = pk2(s[0 * 33], s[1 * 33]); o.y = pk2(s[2 * 33], s[3 * 33]); o.z = pk2(s[4 * 33], s[5 * 33]); o.w = pk2(s[6 * 33], s[7 * 33]);
        *(GAS v4u*)(WT + (size_t)(n0 + n) * K + k0 + 8 * c) = o; }
    LDS_WAIT(); asm volatile("" ::: "memory");
}
__device__ __forceinline__ void p0_row(const float* xrow, bf16* orow, float* rstd_out, int lane) {
    const GAS f32x4* xr = (const GAS f32x4*)xrow + lane;
    f32x4 v[8]; float s = 0.f;
#pragma unroll
    for (int j = 0; j < 8; ++j) { v[j] = xr[64 * j]; s += (v[j].x * v[j].x + v[j].y * v[j].y) + (v[j].z * v[j].z + v[j].w * v[j].w); }
    s = wave_sum(s);
    GAS unsigned long long* o8 = (GAS unsigned long long*)orow + lane;
#pragma unroll
    for (int j = 0; j < 8; ++j) o8[64 * j] = (unsigned long long)pk2(v[j].x, v[j].y) | ((unsigned long long)pk2(v[j].z, v[j].w) << 32);
    if (lane == 0) *rstd_out = 1.0f / sqrtf(s * (1.0f / D) + EPS);
}
__device__ __forceinline__ void p0_cvt8_sliced(const float* src, bf16* dst, const float* gcol, size_t idx8) {
    const f32x4 a = *(const GAS f32x4*)(src + idx8 * 8), b = *(const GAS f32x4*)(src + idx8 * 8 + 4);
    f32x4 ga = {1.f, 1.f, 1.f, 1.f}, gb = {1.f, 1.f, 1.f, 1.f};
    const int c = (int)((idx8 * 8) & (D - 1)); const size_t e = (idx8 * 8) >> 11;
    if (gcol) { ga = *(const GAS f32x4*)(gcol + c); gb = *(const GAS f32x4*)(gcol + c + 4); }
    v4u o; o.x = pk2(a.x * ga.x, a.y * ga.y); o.y = pk2(a.z * ga.z, a.w * ga.w); o.z = pk2(b.x * gb.x, b.y * gb.y); o.w = pk2(b.z * gb.z, b.w * gb.w);
    *(GAS v4u*)(dst + ((size_t)(c >> 6) * 16384 + e) * 64 + (c & 63)) = o;
}
__device__ __forceinline__ void p0_cvt8(const float* src, bf16* dst, const float* gcol, size_t idx8) {
    const f32x4 a = *(const GAS f32x4*)(src + idx8 * 8), b = *(const GAS f32x4*)(src + idx8 * 8 + 4);
    f32x4 ga = {1.f, 1.f, 1.f, 1.f}, gb = {1.f, 1.f, 1.f, 1.f};
    if (gcol) { const int c = (int)((idx8 * 8) & (D - 1)); ga = *(const GAS f32x4*)(gcol + c); gb = *(const GAS f32x4*)(gcol + c + 4); }
    v4u o; o.x = pk2(a.x * ga.x, a.y * ga.y); o.y = pk2(a.z * ga.z, a.w * ga.w); o.z = pk2(b.x * gb.x, b.y * gb.y); o.w = pk2(b.z * gb.z, b.w * gb.w);
    *(GAS v4u*)(dst + idx8 * 8) = o;
}

struct Args { const float* in[22]; float* out; unsigned char* ws; int ph_lo, ph_hi; };

__global__ void __launch_bounds__(NWAVES * 64, 2) fwd(Args args) {
    extern __shared__ __attribute__((aligned(16))) unsigned char lds[];
    Frame F;
    F.lds = (LAS unsigned char*)lds;
    F.MISC = (volatile LAS unsigned*)(F.lds + MISC_OFF);
    F.tid = threadIdx.x; F.lane = F.tid & 63; F.wave = __builtin_amdgcn_readfirstlane(F.tid >> 6);
    F.G = gridDim.x; { const int bx = blockIdx.x; F.vcu = (F.G % 8 == 0) ? (bx % 8) * (F.G / 8) + bx / 8 : bx; }
    unsigned char* ws = args.ws;
    F.ctl = (gu32*)(ws + WS_CTL);
    for (int u = F.tid; u < (LDS_BYTES - LDSCTL_OFF) / 4; u += NWAVES * 64) ((LAS unsigned*)(F.lds + LDSCTL_OFF))[u] = 0u;
    __syncthreads();
    XcdBarrier bar = xcd_barrier_post((unsigned*)(F.ctl + CW_BAR), F.MISC + 8);
    const int lo = args.ph_lo, hi = args.ph_hi;
#define IN(k) (lo <= (k) && (k) < hi)
#define BOTH(k) (IN(k) && IN((k) + 1))

    const float* x = args.in[0]; const float* meta = args.in[1]; const float* norm_mix_g = args.in[2]; const float* w_in = args.in[3]; const float* b_in = args.in[4];
    const float* gn_attn_g = args.in[13]; const float* gn_lru_g = args.in[14]; const float* w_out = args.in[15]; const float* norm_ffn_g = args.in[16];
    const float* peer_wq = args.in[17]; const float* sub_keys = args.in[18]; const float* peer_u = args.in[19]; const float* peer_v = args.in[20];
    bf16* W1T = (bf16*)(ws + WS_W1T); bf16* W2T = (bf16*)(ws + WS_W2T); bf16* W3T = (bf16*)(ws + WS_W3T); bf16* SKB = (bf16*)(ws + WS_SKB);
    float* RSTD1 = (float*)(ws + WS_RSTD1);
    bf16* UB = (bf16*)(ws + WS_UB); bf16* VB = (bf16*)(ws + WS_VB); bf16* A1 = (bf16*)(ws + WS_A1);
    bf16* QB = (bf16*)(ws + WS_Q); bf16* KVB = (bf16*)(ws + WS_KV); bf16* XBB = (bf16*)(ws + WS_XB); bf16* GTB = (bf16*)(ws + WS_GT);

    if (IN(0)) {
        LAS float* scr = (LAS float*)(F.lds + RING_OFF + F.wave * 16384);
        const int gw = F.vcu * NWAVES + F.wave, NGW = F.G * NWAVES;
        constexpr int I_1 = (D / 64) * (IND / 32), I_2 = (D / 64) * (D / 32), I_3 = I_2;
        for (int it = gw; it < I_1 + I_2 + I_3; it += NGW) {
            int r = it;
            if (r < I_1) { p0_transpose_item(w_in, D, IND, W1T, norm_mix_g, norm_mix_g, D, scr, r, F.lane); continue; } r -= I_1;
            if (r < I_2) { p0_transpose_item(w_out, D, D, W2T, gn_attn_g, gn_lru_g, 1024, scr, r, F.lane); continue; } r -= I_2;
            p0_transpose_item(peer_wq, D, D, W3T, norm_ffn_g, norm_ffn_g, D, scr, r, F.lane);
        }
        for (int m = gw; m < MREAL + NMETA; m += NGW) {
            const float* src = m < MREAL ? x + (size_t)m * D : meta + (size_t)(m - MREAL) * D;
            p0_row(src, A1 + (size_t)m * D, RSTD1 + m, F.lane);
        }
        {
            const size_t gt = (size_t)gw * 64 + F.lane, NT = (size_t)NGW * 64;
            for (size_t i = gt; i < (size_t)(8 * 2 * 128 * 128) / 8; i += NT) p0_cvt8(sub_keys, SKB, nullptr, i);
            for (size_t i = gt; i < (size_t)16384 * D / 8; i += NT) p0_cvt8_sliced(peer_u, UB, norm_ffn_g, i);
            for (size_t i = gt; i < (size_t)16384 * D / 8; i += NT) p0_cvt8_sliced(peer_v, VB, nullptr, i);
        }
        if (BOTH(0)) xcd_barrier(bar);
    }
    if (IN(1)) {
        pg8::Gemm g{A1, W1T, MPAD, IND, D};
        pg8::Order1 S{F.G, (int)blockIdx.x};
        pg8::Epi1 E{QB, KVB, XBB, GTB, RSTD1, b_in};
        pg8::gemm_phase<pg8::Epi1, pg8::Order1, true, true>(F.lds + RING_OFF, g, S, E);
        if (BOTH(1)) xcd_barrier(bar);
    }
    if (IN(2)) {
        bf16* MIX = (bf16*)(ws + WS_A1); float* SSA = (float*)(ws + WS_SSA); float* SSL = (float*)(ws + WS_SSL);
        const p2::LruP LP{args.in[6], args.in[7], args.in[8], args.in[9], args.in[10], args.in[11], args.in[12]};
        for (int u = (int)blockIdx.x; u < 256; u += F.G) p2::lru_unit(F.lds + RING_OFF, u >> 5, (u >> 1) & 15, u & 1, XBB, GTB, LP, MIX, SSL, F.tid);
        for (int a = (int)blockIdx.x; a < 256; a += F.G) p2::attn_unit(F.lds + RING_OFF, a >> 5, (a >> 1) & 15, a & 1, QB, KVB, args.in[5], MIX, SSA, F.tid);
        if (BOTH(2)) xcd_barrier(bar);
    }
    if (IN(3)) {
        bf16* MIX = (bf16*)(ws + WS_A1); const float* SSA = (const float*)(ws + WS_SSA); const float* SSL = (const float*)(ws + WS_SSL);
        bf16* H1B = (bf16*)(ws + WS_H1); float* SS2 = (float*)(ws + WS_SS2);
        pg8::Order2 S{F.G, (int)blockIdx.x};
        LAS float* tbl = (LAS float*)(F.lds + LDSCTL_OFF + 1024);
        pg8::Unit u0{0, 0};
        for (int i = 0; i < 2; ++i) {
            pg8::Unit u; if (!S.next(i, u)) break; if (i == 0) u0 = u;
            if (F.tid < 256) {
                const size_t row = (size_t)u.pm * 256 + F.tid; float sa = 0.f, sl = 0.f;
#pragma unroll
                for (int k = 0; k < 4; ++k) { const f32x4 v = *(const GAS f32x4*)(SSA + row * 16 + 4 * k); sa += (v.x + v.y) + (v.z + v.w); }
#pragma unroll
                for (int k = 0; k < 8; ++k) { const f32x4 v = *(const GAS f32x4*)(SSL + row * 32 + 4 * k); sl += (v.x + v.y) + (v.z + v.w); }
                const float ra = 1.0f / sqrtf(sa * (1.0f / 1024) + EPS), rl = 1.0f / sqrtf(sl * (1.0f / 1024) + EPS);
                tbl[(i * 256 + F.tid) * 2] = ra / rl; tbl[(i * 256 + F.tid) * 2 + 1] = rl;
            }
        }
        __syncthreads();
        pg8::Gemm g{MIX, W2T, MREAL, D, D};
        pg8::Epi2 E{H1B, x, SS2, (const LAS float*)tbl, u0.pm};
        pg8::gemm_phase<pg8::Epi2, pg8::Order2, true, true>(F.lds + RING_OFF, g, S, E);
        if (BOTH(3)) xcd_barrier(bar);
    }
    if (IN(4)) {
        bf16* H1B = (bf16*)(ws + WS_H1); bf16* QPB = (bf16*)(ws + WS_A1);
        pg8::Order2 S{F.G, (int)blockIdx.x};
        pg8::Gemm g{H1B, W3T, MREAL, D, D};
        pg8::Epi3 E{QPB};
        pg8::gemm_phase<pg8::Epi3, pg8::Order2, true, true>(F.lds + RING_OFF, g, S, E);
        if (BOTH(4)) xcd_barrier(bar);
    }
    if (IN(5)) {
        const bf16* QPB = (const bf16*)(ws + WS_A1); const float* SS2 = (const float*)(ws + WS_SS2);
        unsigned short* IDS = (unsigned short*)(ws + WS_IDS); float* GW = (float*)(ws + WS_GW); float* RSTD2 = (float*)(ws + WS_RSTD2);
        for (int u = (int)blockIdx.x; u < 512; u += F.G) p5::retr_unit(F.lds + RING_OFF, u & 7, u >> 3, QPB, SKB, SS2, IDS, GW, RSTD2, F.tid);
        if (BOTH(5)) xcd_barrier(bar);
    }
    {
        const bf16* H1B = (const bf16*)(ws + WS_H1); const unsigned short* IDS = (const unsigned short*)(ws + WS_IDS); const float* GW = (const float*)(ws + WS_GW);
        const float* RSTD2 = (const float*)(ws + WS_RSTD2); bf16* PART = (bf16*)(ws + WS_PART); float* WB = (float*)(ws + WS_W); bf16* ZB = (bf16*)(ws + WS_Z); float* SSF = (float*)(ws + WS_SSL);
        const int slot = (int)blockIdx.x & 7, rank = (int)blockIdx.x >> 3, nrank = (F.G - slot + 7) >> 3;
        const int gw = F.vcu * NWAVES + F.wave, NGW = F.G * NWAVES;
        if (IN(6)) { p6::usweep(H1B, UB, IDS, PART, slot, rank, nrank, F.wave, F.lane); if (BOTH(6)) xcd_barrier(bar); }
        if (IN(7)) { p6::wreduce(PART, GW, RSTD2, WB, (size_t)gw * 64 + F.lane, (size_t)NGW * 64); if (BOTH(7)) xcd_barrier(bar); }
        if (IN(8)) { p6::vsweep(H1B, VB, IDS, WB, ZB, SSF, slot, rank, nrank, F.wave, F.lane); if (BOTH(8)) xcd_barrier(bar); }
        if (IN(9)) { for (int t = gw; t < MREAL; t += NGW) p6::final_row(ZB, SSF, args.in[21], args.out, (size_t)t, F.lane); }
    }
#undef IN
#undef BOTH
}

extern "C" void kernel_launch(void* const* d_in, const int* in_sizes, int n_in, void* d_out, int out_size, void* d_ws, size_t ws_size, hipStream_t stream) {
    static int grid = 0;
    if (grid == 0) {
        int dev = 0, cus = 0;
        if (hipGetDevice(&dev) != hipSuccess || hipDeviceGetAttribute(&cus, hipDeviceAttributeMultiprocessorCount, dev) != hipSuccess) { fprintf(stderr, "kernel_launch: device query failed\n"); grid = -1; return; }
        if (hipFuncSetAttribute((const void*)fwd, hipFuncAttributeMaxDynamicSharedMemorySize, LDS_BYTES) != hipSuccess) { fprintf(stderr, "kernel_launch: hipFuncSetAttribute failed\n"); grid = -1; return; }
        int per_cu = 0;
        if (hipOccupancyMaxActiveBlocksPerMultiprocessor(&per_cu, (const void*)fwd, NWAVES * 64, LDS_BYTES) != hipSuccess || per_cu < 1) fprintf(stderr, "kernel_launch: occupancy query says %d\n", per_cu);
        (void)hipGetLastError();
        grid = cus;
        if (ws_size < WS_END) { fprintf(stderr, "kernel_launch: ws too small %zu\n", ws_size); grid = -1; return; }
    }
    if (grid < 0) return;
    (void)hipMemsetAsync((char*)d_ws + WS_CTL, 0, CTL_ZERO_BYTES, stream);
    Args a{};
    for (int i = 0; i < 22; ++i) a.in[i] = (const float*)d_in[i];
    a.out = (float*)d_out; a.ws = (unsigned char*)d_ws; a.ph_lo = 0; a.ph_hi = 10;
    hipLaunchKernelGGL(fwd, dim3(grid), dim3(NWAVES * 64), LDS_BYTES, stream, a);
}
```

```cpp
#include <hip/hip_runtime.h>
#include <cstdio>
#include <cstdint>
#include <math.h>

#define D 2048
#define NB 8
#define SEQ 2048
#define NMETA 16
#define TT (SEQ + NMETA)
#define MR (NB * TT)
#define MREAL (NB * SEQ)
#define MPAD (MREAL + 256)
#define QD 1024
#define KVD 128
#define LW 1024
#define IND 3328
#define EPS 1e-6f
#define QSCALE (0.125f * 1.4426950408889634f)
#define GAS __attribute__((address_space(1)))
#define LAS __attribute__((address_space(3)))
namespace pg8 {
#define PG8_LAS __attribute__((address_space(3)))
typedef unsigned short bf16_t;
typedef short bf16x8 __attribute__((ext_vector_type(8)));
typedef float f32x4 __attribute__((ext_vector_type(4)));
typedef unsigned u32x4 __attribute__((ext_vector_type(4)));
constexpr int BM = 256, BK = 64, HALF = 128, HTB = HALF * BK * 2  , STAGE_BYTES = 8 * HTB, NXCD = 8, WGM = 8;

__host__ __device__ __forceinline__ int lds_byte(int r, int c) { const int st = (r >> 4) * 2 + (c >> 5), rr = r & 15, cc = c & 31, ob = rr * 64 + cc * 2; return st * 1024 + (ob ^ (((ob >> 9) & 1) << 5)); }
__host__ __device__ __forceinline__ void stage_rc(int b, int& R, int& C) { const int st = b / 1024, sb = b % 1024, swz = sb ^ (((sb >> 9) & 1) << 5); R = (st >> 1) * 16 + swz / 64; C = (st & 1) * 32 + (swz % 64) / 2; }
__host__ __device__ __forceinline__ int perm32(int rho) { const int n = rho >> 4, i = rho & 15; return 8 * (i >> 2) + 4 * n + (i & 3); }

struct Unit { int pm, pn; };
struct Gemm { const bf16_t* A; const bf16_t* Bt; int M, N, K; };

struct StaticOrder {
    int nM, nN, nwg, G, c;
    __host__ __device__ void init(int M, int N, int G_, int c_) { nM = M / BM; nN = N / BM; nwg = nM * nN; G = G_; c = c_; }
    __host__ __device__ bool next(int i, Unit& u) const {
        const long L = (long)i * G + c; if (L >= nwg) return false;
        int wgid = (int)L; { const int q = nwg / NXCD, r = nwg % NXCD, xcd = wgid % NXCD, off = wgid / NXCD; wgid = (xcd < r ? xcd * (q + 1) : r * (q + 1) + (xcd - r) * q) + off; }
        const int nig = WGM * nN, gid = wgid / nig, fm = gid * WGM, gsz = (nM - fm) < WGM ? (nM - fm) : WGM;
        u.pm = fm + ((wgid % nig) % gsz); u.pn = (wgid % nig) / gsz; return true;
    }
    __device__ __forceinline__ void a_ready(const Unit&) const {}
    __device__ __forceinline__ void done(const Unit&) const {}
};

__device__ __forceinline__ unsigned cvt_pk_bf16(float lo, float hi) { unsigned r; asm volatile("v_cvt_pk_bf16_f32 %0, %1, %2" : "=v"(r) : "v"(lo), "v"(hi)); return r; }
typedef unsigned u32x2 __attribute__((ext_vector_type(2)));
struct Order1 {
    int G, c;
    __device__ __forceinline__ bool next(int i, Unit& u) const {
        const int L = i * G + c; if (L >= 837) return false;
        if (L >= 832) { u.pm = 64; u.pn = 4 + (L - 832); return true; }
        const int nwg = 832, nN = 13;
        int wgid = L; { const int q = nwg / NXCD, xcd = wgid % NXCD, off = wgid / NXCD; wgid = xcd * q + off; }
        const int nig = WGM * nN, gid = wgid / nig, fm = gid * WGM;
        u.pm = fm + ((wgid % nig) % WGM); u.pn = (wgid % nig) / WGM; return true;
    }
    __device__ __forceinline__ void a_ready(const Unit&) const {}
    __device__ __forceinline__ void done(const Unit&) const {}
};
struct Order2 {
    int G, c;
    __device__ __forceinline__ bool next(int i, Unit& u) const {
        const int L = i * G + c; if (L >= 512) return false;
        const int nwg = 512, nN = 8;
        int wgid = L; { const int q = nwg / NXCD, xcd = wgid % NXCD, off = wgid / NXCD; wgid = xcd * q + off; }
        const int nig = WGM * nN, gid = wgid / nig, fm = gid * WGM;
        u.pm = fm + ((wgid % nig) % WGM); u.pn = (wgid % nig) / WGM; return true;
    }
    __device__ __forceinline__ void a_ready(const Unit&) const {}
    __device__ __forceinline__ void done(const Unit&) const {}
};

struct Epi1 {
    static constexpr bool PERM = true, AFTER_DRAIN = false, MIDK = false;
    bf16_t *Q, *KV, *XB, *GT; const float* rstd; const float* bias;
    __device__ __forceinline__ void midk(f32x4 (&acc)[2][2][4][2], const Unit& u, int wr, int wc, int fr, int fq) const {}
    __device__ __forceinline__ void operator()(const f32x4 (&acc)[2][2][4][2], const Unit& u, int wr, int wc, int fr, int fq) const {
        const int row0 = u.pm * BM + wr * 64 + fr;
        bf16_t* base; int ldc, colb; float sc = 1.f;
        if (u.pn < 4) { base = Q; ldc = 1024; colb = u.pn * BM; sc = QSCALE; }
        else if (u.pn == 4) { base = KV; ldc = 256; colb = 0; }
        else if (u.pn < 9) { base = XB; ldc = 1024; colb = (u.pn - 5) * BM; }
        else { base = GT; ldc = 1024; colb = (u.pn - 9) * BM; }
        const int col0 = colb + wc * 32 + 8 * fq, bcol0 = u.pn * BM + wc * 32 + 8 * fq;
        f32x4 bv[2][2];
#pragma unroll
        for (int bj = 0; bj < 2; ++bj)
#pragma unroll
            for (int n = 0; n < 2; ++n) bv[bj][n] = *(const f32x4*)(bias + bcol0 + bj * HALF + 4 * n);
#pragma unroll
        for (int ai = 0; ai < 2; ++ai)
#pragma unroll
            for (int m = 0; m < 4; ++m) {
                const int row = row0 + ai * HALF + m * 16; const float rs = rstd[row];
                bf16_t* rowp = base + (size_t)row * ldc + col0;
#pragma unroll
                for (int bj = 0; bj < 2; ++bj) {
                    f32x4 v0 = (acc[ai][bj][m][0] * rs + bv[bj][0]) * sc, v1 = (acc[ai][bj][m][1] * rs + bv[bj][1]) * sc;
                    u32x4 w; w.x = cvt_pk_bf16(v0[0], v0[1]); w.y = cvt_pk_bf16(v0[2], v0[3]); w.z = cvt_pk_bf16(v1[0], v1[1]); w.w = cvt_pk_bf16(v1[2], v1[3]);
                    *(u32x4*)(rowp + bj * HALF) = w; } }
    }
};
struct Epi2 {
    static constexpr bool PERM = true, AFTER_DRAIN = false, MIDK = true;
    bf16_t* H1; const float* x; float* SS2; const LAS float* tbl; int pm0;
    __device__ __forceinline__ void midk(f32x4 (&acc)[2][2][4][2], const Unit& u, int wr, int wc, int fr, int fq) const {
        const LAS float* t = tbl + (u.pm == pm0 ? 0 : 512);
#pragma unroll
        for (int ai = 0; ai < 2; ++ai)
#pragma unroll
            for (int m = 0; m < 4; ++m) { const float ra = t[(ai * HALF + wr * 64 + m * 16 + fr) * 2];
#pragma unroll
                for (int bj = 0; bj < 2; ++bj)
#pragma unroll
                    for (int n = 0; n < 2; ++n) acc[ai][bj][m][n] = acc[ai][bj][m][n] * ra; }
    }
    __device__ __forceinline__ void operator()(const f32x4 (&acc)[2][2][4][2], const Unit& u, int wr, int wc, int fr, int fq) const {
        const LAS float* t = tbl + (u.pm == pm0 ? 0 : 512);
        const int col0 = u.pn * BM + wc * 32 + 8 * fq;
#pragma unroll
        for (int ai = 0; ai < 2; ++ai)
#pragma unroll
            for (int m = 0; m < 4; ++m) {
                const int rl = ai * HALF + wr * 64 + m * 16 + fr; const size_t row = (size_t)u.pm * BM + rl; const float rs = t[rl * 2 + 1];
                float ss = 0.f;
#pragma unroll
                for (int bj = 0; bj < 2; ++bj) {
                    const f32x4 x0 = *(const f32x4*)(x + row * 2048 + col0 + bj * HALF), x1 = *(const f32x4*)(x + row * 2048 + col0 + bj * HALF + 4);
                    const f32x4 v0 = acc[ai][bj][m][0] * rs + x0, v1 = acc[ai][bj][m][1] * rs + x1;
                    ss += (v0[0] * v0[0] + v0[1] * v0[1]) + (v0[2] * v0[2] + v0[3] * v0[3]) + (v1[0] * v1[0] + v1[1] * v1[1]) + (v1[2] * v1[2] + v1[3] * v1[3]);
                    u32x4 w; w.x = cvt_pk_bf16(v0[0], v0[1]); w.y = cvt_pk_bf16(v0[2], v0[3]); w.z = cvt_pk_bf16(v1[0], v1[1]); w.w = cvt_pk_bf16(v1[2], v1[3]);
                    *(u32x4*)(H1 + row * 2048 + col0 + bj * HALF) = w; }
                ss += __shfl_xor(ss, 16); ss += __shfl_xor(ss, 32);
                if (fq == 0) SS2[row * 32 + u.pn * 4 + wc] = ss;
            }
    }
};
struct Epi3 {
    static constexpr bool PERM = true, AFTER_DRAIN = false, MIDK = false;
    bf16_t* O;
    __device__ __forceinline__ void midk(f32x4 (&acc)[2][2][4][2], const Unit& u, int wr, int wc, int fr, int fq) const {}
    __device__ __forceinline__ void operator()(const f32x4 (&acc)[2][2][4][2], const Unit& u, int wr, int wc, int fr, int fq) const {
        const int col0 = u.pn * BM + wc * 32 + 8 * fq;
#pragma unroll
        for (int ai = 0; ai < 2; ++ai)
#pragma unroll
            for (int m = 0; m < 4; ++m) { const size_t row = (size_t)u.pm * BM + ai * HALF + wr * 64 + m * 16 + fr;
#pragma unroll
                for (int bj = 0; bj < 2; ++bj) { const f32x4 v0 = acc[ai][bj][m][0], v1 = acc[ai][bj][m][1];
                    u32x4 w; w.x = cvt_pk_bf16(v0[0], v0[1]); w.y = cvt_pk_bf16(v0[2], v0[3]); w.z = cvt_pk_bf16(v1[0], v1[1]); w.w = cvt_pk_bf16(v1[2], v1[3]);
                    *(u32x4*)(O + row * 2048 + col0 + bj * HALF) = w; } }
    }
};
template <class Epi, class Sched, bool ALIGN_EPI = false, bool SP2 = false>
__device__ __forceinline__ void gemm_phase(PG8_LAS unsigned char* lds, const Gemm g, const Sched& S, const Epi& E) {
    const int tid = threadIdx.x, wid = __builtin_amdgcn_readfirstlane(tid >> 6), lane = tid & 63, wr = wid >> 2, wc = wid & 3, fr = lane & 15, fq = lane >> 4;
    const int K = g.K, nt = K / BK;
    unsigned voffA[2], voffB[2];
#pragma unroll
    for (int i = 0; i < 2; ++i) { int R, C; stage_rc(tid * 16 + i * 8192, R, C); const int Rb = Epi::PERM ? ((R & ~31) + perm32(R & 31)) : R;
        voffA[i] = (unsigned)(R * K + C) * 2u; voffB[i] = (unsigned)(Rb * K + C) * 2u; }
    const size_t kstep = (size_t)(BK * 2);
    const size_t hstep = (size_t)HALF * K * 2;
    const size_t tstep = 2 * hstep;
    const unsigned ldsw = (unsigned)wid * 1024u;
    const int aoff = lds_byte(wr * 64 + fr, fq * 8), boff = lds_byte(wc * 32 + fr, fq * 8);
#define PG8_SA(b, h) (((b) * 2 + (h)) * HTB)
#define PG8_SB(b, h) ((4 + (b) * 2 + (h)) * HTB)
#define PG8_STAGE(bufoff, gbase, voff) do { _Pragma("unroll") for (int _i = 0; _i < 2; ++_i) \
        __builtin_amdgcn_global_load_lds((const unsigned*)((const char*)(gbase) + (voff)[_i]), (PG8_LAS unsigned*)(lds + (bufoff) + ldsw + _i * 8192), 16, 0, 0); } while (0)
#define PG8_LDA(dst, b, h) do { _Pragma("unroll") for (int m = 0; m < 4; ++m) _Pragma("unroll") for (int k = 0; k < 2; ++k) dst[m][k] = *(const PG8_LAS bf16x8*)(lds + PG8_SA(b, h) + aoff + m * 2048 + k * 1024); } while (0)
#define PG8_LDB(dst, b, h) do { _Pragma("unroll") for (int n = 0; n < 2; ++n) _Pragma("unroll") for (int k = 0; k < 2; ++k) dst[n][k] = *(const PG8_LAS bf16x8*)(lds + PG8_SB(b, h) + boff + n * 2048 + k * 1024); } while (0)
#define PG8_MMA(ai, bj, At, Bt) do { __builtin_amdgcn_s_setprio(1); _Pragma("unroll") for (int m = 0; m < 4; ++m) _Pragma("unroll") for (int n = 0; n < 2; ++n) _Pragma("unroll") for (int k = 0; k < 2; ++k) \
        acc[ai][bj][m][n] = __builtin_amdgcn_mfma_f32_16x16x32_bf16(Bt[n][k], At[m][k], acc[ai][bj][m][n], 0, 0, 0); __builtin_amdgcn_s_setprio(0); } while (0)
#define PG8_WAIT_V(n) asm volatile("s_waitcnt vmcnt(" #n ")" ::: "memory")
#define PG8_WAIT_L(n) asm volatile("s_waitcnt lgkmcnt(" #n ")" ::: "memory")
#define PG8_BAR __builtin_amdgcn_s_barrier()
#define PG8_SCHED __builtin_amdgcn_sched_barrier(0)
    Unit cur, nxt; int ui = 0;
    if (!S.next(0, cur)) return;
    f32x4 acc[2][2][4][2];
#pragma unroll
    for (int a = 0; a < 2; ++a)
#pragma unroll
        for (int b = 0; b < 2; ++b)
#pragma unroll
            for (int m = 0; m < 4; ++m)
#pragma unroll
                for (int n = 0; n < 2; ++n) acc[a][b][m][n] = (f32x4){0.f, 0.f, 0.f, 0.f};
    bf16x8 At[4][2], B0[2][2], B1[2][2];
    const char* cA = (const char*)g.A + (size_t)cur.pm * tstep; const char* cB = (const char*)g.Bt + (size_t)cur.pn * tstep;
    S.a_ready(cur);
    if constexpr (SP2) {
        PG8_STAGE(PG8_SB(0, 0), cB, voffB); PG8_STAGE(PG8_SB(0, 1), cB + hstep, voffB); PG8_STAGE(PG8_SA(0, 0), cA, voffA); PG8_STAGE(PG8_SA(0, 1), cA + hstep, voffA);
        if (wr == 1) PG8_BAR;
        PG8_WAIT_V(2); PG8_BAR;
        PG8_STAGE(PG8_SB(1, 0), cB + kstep, voffB); PG8_STAGE(PG8_SA(1, 0), cA + kstep, voffA); PG8_STAGE(PG8_SB(1, 1), cB + hstep + kstep, voffB);
        PG8_WAIT_V(6); PG8_BAR;
    } else {
        PG8_STAGE(PG8_SB(0, 0), cB, voffB); PG8_STAGE(PG8_SA(0, 0), cA, voffA); PG8_STAGE(PG8_SB(0, 1), cB + hstep, voffB); PG8_STAGE(PG8_SA(0, 1), cA + hstep, voffA);
        if (wr == 1) PG8_BAR;
        PG8_WAIT_V(4); PG8_BAR;
        PG8_STAGE(PG8_SB(1, 0), cB + kstep, voffB); PG8_STAGE(PG8_SA(1, 0), cA + kstep, voffA); PG8_STAGE(PG8_SB(1, 1), cB + hstep + kstep, voffB);
        PG8_WAIT_V(6); PG8_BAR;
    }
    for (;;) {
        const bool has_next = S.next(ui + 1, nxt);
        const char* nA = has_next ? (const char*)g.A + (size_t)nxt.pm * tstep : cA; const char* nB = has_next ? (const char*)g.Bt + (size_t)nxt.pn * tstep : cB;
        for (int t = 0; t < nt; t += 2) {
            if constexpr (Epi::MIDK) { if (t == nt / 2) E.midk(acc, cur, wr, wc, fr, fq); }
            const bool last = (t == nt - 2);
            const char* a1 = cA + (size_t)(t + 1) * kstep;
            const char* a2 = last ? nA : cA + (size_t)(t + 2) * kstep; const char* b2 = last ? nB : cB + (size_t)(t + 2) * kstep;
            const char* a3 = a2 + kstep; const char* b3 = b2 + kstep;
            if (last && has_next) S.a_ready(nxt);
            if constexpr (SP2) {
            PG8_LDB(B0, 0, 0); PG8_LDB(B1, 0, 1); PG8_SCHED; PG8_LDA(At, 0, 0); PG8_STAGE(PG8_SA(1, 1), a1 + hstep, voffA);
            PG8_WAIT_V(8); PG8_WAIT_L(0); PG8_BAR; PG8_MMA(0, 0, At, B0); PG8_MMA(0, 1, At, B1); PG8_BAR; PG8_SCHED;
            PG8_LDA(At, 0, 1); PG8_STAGE(PG8_SB(0, 0), b2, voffB); PG8_STAGE(PG8_SB(0, 1), b2 + hstep, voffB); PG8_STAGE(PG8_SA(0, 0), a2, voffA);
            PG8_WAIT_V(8); PG8_WAIT_L(0); PG8_BAR; PG8_MMA(1, 0, At, B0); PG8_MMA(1, 1, At, B1); PG8_BAR; PG8_SCHED;
            PG8_LDB(B0, 1, 0); PG8_LDB(B1, 1, 1); PG8_SCHED; PG8_LDA(At, 1, 0); PG8_STAGE(PG8_SA(0, 1), a2 + hstep, voffA);
            PG8_WAIT_V(8); PG8_WAIT_L(0); PG8_BAR; PG8_MMA(0, 0, At, B0); PG8_MMA(0, 1, At, B1); PG8_BAR; PG8_SCHED;
            PG8_LDA(At, 1, 1); PG8_STAGE(PG8_SB(1, 0), b3, voffB); PG8_STAGE(PG8_SB(1, 1), b3 + hstep, voffB); PG8_STAGE(PG8_SA(1, 0), a3, voffA);
            PG8_WAIT_V(8); PG8_WAIT_L(0); PG8_BAR; PG8_MMA(1, 0, At, B0); PG8_MMA(1, 1, At, B1); PG8_BAR; PG8_SCHED;
            } else {
            PG8_LDB(B0, 0, 0); PG8_SCHED; PG8_LDA(At, 0, 0); PG8_STAGE(PG8_SA(1, 1), a1 + hstep, voffA);
            PG8_WAIT_L(8); PG8_BAR; PG8_WAIT_L(0); PG8_MMA(0, 0, At, B0); PG8_BAR; PG8_SCHED;
            PG8_LDB(B1, 0, 1); PG8_STAGE(PG8_SB(0, 0), b2, voffB);
            PG8_BAR; PG8_WAIT_L(0); PG8_MMA(0, 1, At, B1); PG8_BAR;
            PG8_LDA(At, 0, 1); PG8_STAGE(PG8_SA(0, 0), a2, voffA);
            PG8_BAR; PG8_WAIT_L(0); PG8_MMA(1, 0, At, B0); PG8_BAR; PG8_SCHED;
            PG8_STAGE(PG8_SB(0, 1), b2 + hstep, voffB);
            PG8_WAIT_V(6); PG8_BAR; PG8_MMA(1, 1, At, B1); PG8_BAR;
            PG8_LDB(B0, 1, 0); PG8_SCHED; PG8_LDA(At, 1, 0); PG8_STAGE(PG8_SA(0, 1), a2 + hstep, voffA);
            PG8_WAIT_L(8); PG8_BAR; PG8_WAIT_L(0); PG8_MMA(0, 0, At, B0); PG8_BAR; PG8_SCHED;
            PG8_LDB(B1, 1, 1); PG8_STAGE(PG8_SB(1, 0), b3, voffB);
            PG8_BAR; PG8_WAIT_L(0); PG8_MMA(0, 1, At, B1); PG8_BAR;
            PG8_LDA(At, 1, 1); PG8_STAGE(PG8_SA(1, 0), a3, voffA);
            PG8_BAR; PG8_WAIT_L(0); PG8_MMA(1, 0, At, B0); PG8_BAR; PG8_SCHED;
            PG8_STAGE(PG8_SB(1, 1), b3 + hstep, voffB);
            PG8_WAIT_V(6); PG8_BAR; PG8_MMA(1, 1, At, B1); PG8_BAR;
            }
        }
        if constexpr (ALIGN_EPI) { if (wr == 0) PG8_BAR; }
        if constexpr (!Epi::AFTER_DRAIN) { E(acc, cur, wr, wc, fr, fq); S.done(cur); }
        if (!has_next) break;
#pragma unroll
        for (int a = 0; a < 2; ++a)
#pragma unroll
            for (int b = 0; b < 2; ++b)
#pragma unroll
                for (int m = 0; m < 4; ++m)
#pragma unroll
                    for (int n = 0; n < 2; ++n) acc[a][b][m][n] = (f32x4){0.f, 0.f, 0.f, 0.f};
        cur = nxt; cA = nA; cB = nB; ++ui;
        if constexpr (ALIGN_EPI) { if (wr == 1) PG8_BAR; }
    }
    PG8_WAIT_V(0);
    if constexpr (!ALIGN_EPI) { if (wr == 0) PG8_BAR; }
    PG8_BAR;
    if constexpr (Epi::AFTER_DRAIN) { E.fused(acc, cur, wr, wc, fr, fq, lds, wid, lane); S.done(cur); }
#undef PG8_SA
#undef PG8_SB
#undef PG8_STAGE
#undef PG8_LDA
#undef PG8_LDB
#undef PG8_MMA
#undef PG8_WAIT_V
#undef PG8_WAIT_L
#undef PG8_BAR
#undef PG8_SCHED
}
}
#define XB_TMO      128
#define XB_XCNT(j)  (256  + 64 * (j))
#define XB_XSUB(j)  (1280 + 64 * (j))
#define XB_XGEN(j)  (2304 + 64 * (j))
#define XB_TOP      3328
#define XB_TOPGEN   3392
#define XCD_BAR_WORDS 3456
#define XB_SPIN_CAP (1u << 18)

__device__ __forceinline__ unsigned xb_ld(unsigned* p)              { return __hip_atomic_load(p, __ATOMIC_RELAXED, __HIP_MEMORY_SCOPE_AGENT); }
__device__ __forceinline__ unsigned xb_add(unsigned* p, unsigned v) { return __hip_atomic_fetch_add(p, v, __ATOMIC_RELAXED, __HIP_MEMORY_SCOPE_AGENT); }
__device__ __forceinline__ unsigned xb_xcc_id() { return (unsigned)__builtin_amdgcn_s_getreg((3 << 11) | 20) & 0xFu; }
#define XB_SPIN(cond, bar) do { unsigned _sp = 0; while (cond) { __builtin_amdgcn_s_sleep(1); \
    if ((++_sp & 255u) == 0u) { if (xb_ld(&(bar)[XB_TMO])) break; if (_sp > XB_SPIN_CAP) { atomicAdd(&(bar)[XB_TMO], 1u); break; } } } } while (0)

struct XcdBarrier {
    unsigned* bar; unsigned x;
    volatile LAS unsigned* st;
};

__device__ __forceinline__ XcdBarrier xcd_barrier_post(unsigned* bar, volatile LAS unsigned* st) {
    XcdBarrier b; b.bar = bar; b.x = xb_xcc_id(); b.st = st;
    if (threadIdx.x == 0) (void)xb_add(&bar[XB_XCNT(b.x)], 1u);
    return b;
}
__device__ __forceinline__ void xcd_barrier_complete(unsigned* bar, unsigned x, unsigned& nloc, unsigned& nx) {
    const unsigned G = gridDim.x * gridDim.y * gridDim.z;
    unsigned sum, cnt, mine, sp = 0u;
    for (;;) {
        sum = 0u; cnt = 0u; mine = 0u;
#pragma unroll
        for (unsigned j = 0; j < 16; ++j) { const unsigned c = xb_ld(&bar[XB_XCNT(j)]); sum += c; cnt += (c > 0u) ? 1u : 0u; mine = (j == x) ? c : mine; }
        if (sum == G) break;
        __builtin_amdgcn_s_sleep(1);
        if ((++sp & 255u) == 0u) { if (xb_ld(&bar[XB_TMO])) break; if (sp > XB_SPIN_CAP) { atomicAdd(&bar[XB_TMO], 1u); break; } }
    }
    nloc = mine > 0u ? mine : 1u; nx = cnt > 0u ? cnt : 1u;
}

__device__ __forceinline__ void xcd_barrier(const XcdBarrier& b) {
    asm volatile("s_waitcnt vmcnt(0)" ::: "memory");
    __syncthreads();
    if (threadIdx.x == 0) {
        unsigned* bar = b.bar;
        __builtin_amdgcn_s_waitcnt(0);
        unsigned nloc = b.st[0], nx = b.st[1];
        if (nloc == 0u) { xcd_barrier_complete(bar, b.x, nloc, nx); b.st[0] = nloc; b.st[1] = nx; }
        const unsigned old = xb_add(&bar[XB_XSUB(b.x)], 1u);
        const unsigned gen = old / nloc;
        if (old + 1u == (gen + 1u) * nloc) {
            __builtin_amdgcn_fence(__ATOMIC_RELEASE, "agent");
            asm volatile("s_waitcnt vmcnt(0)" ::: "memory");
            const unsigned og = xb_add(&bar[XB_TOP], 1u);
            const unsigned tg = og / nx;
            if (og + 1u == (tg + 1u) * nx) xb_add(&bar[XB_TOPGEN], 1u);
            else XB_SPIN(xb_ld(&bar[XB_TOPGEN]) == tg, bar);
            __builtin_amdgcn_fence(__ATOMIC_ACQUIRE, "agent");
            xb_add(&bar[XB_XGEN(b.x)], 1u);
            asm volatile("s_waitcnt vmcnt(0)" ::: "memory");
        } else {
            XB_SPIN(xb_ld(&bar[XB_XGEN(b.x)]) == gen, bar);
            __builtin_amdgcn_fence(__ATOMIC_ACQUIRE, "agent");
            asm volatile("s_waitcnt vmcnt(0)" ::: "memory");
        }
    }
    __syncthreads();
}

constexpr int NWAVES = 8;
constexpr size_t MiB = 1u << 20;
constexpr size_t WS_CTL = 0, CTL_ZERO_BYTES = 1 * MiB;
constexpr size_t WS_W1T = 2 * MiB;
constexpr size_t WS_W2T = 16 * MiB;
constexpr size_t WS_W3T = 24 * MiB;
constexpr size_t WS_SKB = 32 * MiB;
constexpr size_t WS_RSTD1 = 33 * MiB;
constexpr size_t WS_SSA = 34 * MiB;
constexpr size_t WS_SSL = 35 * MiB;
constexpr size_t WS_SS2 = 37 * MiB;
constexpr size_t WS_RSTD2 = 39 * MiB;
constexpr size_t WS_IDS = 40 * MiB;
constexpr size_t WS_GW = 48 * MiB;
constexpr size_t WS_U8 = 64 * MiB;
constexpr size_t WS_V8 = 96 * MiB;
constexpr size_t WS_X8 = 128 * MiB;
constexpr size_t WS_SX = 160 * MiB;
constexpr size_t WS_SCU = 162 * MiB;
constexpr size_t WS_SCV = 163 * MiB;
constexpr size_t WS_WSUM = 164 * MiB;
constexpr size_t WS_A1 = 192 * MiB;
constexpr size_t WS_Q = 258 * MiB;
constexpr size_t WS_KV = 290 * MiB;
constexpr size_t WS_XB = 299 * MiB;
constexpr size_t WS_GT = 332 * MiB;
constexpr size_t WS_H1 = 364 * MiB;
constexpr size_t WS_PART = 192 * MiB;
constexpr size_t WS_W = 56 * MiB;
constexpr size_t WS_Z = 428 * MiB;
constexpr size_t WS_END = 492 * MiB;
constexpr int CW_BAR = 4096;

constexpr int RING_OFF = 0, RING_BYTES = 131072;
constexpr int LDSCTL_OFF = RING_BYTES, MISC_OFF = LDSCTL_OFF + 320;
constexpr int LDS_BYTES = 147456;

typedef unsigned short bf16;
typedef unsigned v4u __attribute__((ext_vector_type(4)));
typedef float f32x4 __attribute__((ext_vector_type(4)));
typedef short bf16x8 __attribute__((ext_vector_type(8)));
typedef GAS unsigned gu32;
#define RLX_AGENT __ATOMIC_RELAXED, __HIP_MEMORY_SCOPE_AGENT
#define LDS_WAIT() asm volatile("s_waitcnt lgkmcnt(0)" ::: "memory")
#define VM_WAIT() asm volatile("s_waitcnt vmcnt(0)" ::: "memory")
__device__ __forceinline__ unsigned f2bf(float f) { unsigned u = __builtin_bit_cast(unsigned, f); return (u + 0x7fffu + ((u >> 16) & 1u)) >> 16; }
__device__ __forceinline__ unsigned pk2(float lo, float hi) { return f2bf(lo) | (f2bf(hi) << 16); }
__device__ __forceinline__ float bf2f(unsigned short b) { return __builtin_bit_cast(float, (unsigned)b << 16); }

namespace p2 {
typedef float f32x16 __attribute__((ext_vector_type(16)));
typedef unsigned u32x2 __attribute__((ext_vector_type(2)));
constexpr float LOG2E = 1.4426950408889634f;
constexpr float NEGBIG = -1e30f;
__device__ __forceinline__ int crow(int r, int hi) { return (r & 3) + 8 * (r >> 2) + 4 * hi; }
__device__ __forceinline__ unsigned cvtpk(float lo, float hi) { unsigned r; asm volatile("v_cvt_pk_bf16_f32 %0, %1, %2" : "=v"(r) : "v"(lo), "v"(hi)); return r; }
__device__ __forceinline__ float ex2(float x) { return __builtin_amdgcn_exp2f(x); }
__device__ __forceinline__ float rcp(float x) { return __builtin_amdgcn_rcpf(x); }
__device__ __forceinline__ float gelu_fast(float x) { return x * rcp(1.0f + ex2(-2.302208198f * x * (1.0f + 0.044715f * x * x))); }

constexpr int A_KS = 0, A_KSP = 144, A_VT = 288 * 144, A_VTP = 584, A_ST = A_VT + 64 * 584, A_END = A_ST + 8 * 4096;
__device__ __forceinline__ void attn_unit(LAS unsigned char* lds, int b, int qblk, int kvh, const bf16* QB, const bf16* KVB, const float* sinks, bf16* MIX, float* SSA, int tid) {
    const int lane = tid & 63, wave = __builtin_amdgcn_readfirstlane(tid >> 6), r = lane & 31, hi = lane >> 5;
    const int q0 = qblk * 128, hq = kvh * 8 + wave;
    for (int it = 0; it < 5; ++it) {
        const int cid = it * 512 + tid;
        if (cid < 288 * 8) {
            const int key = cid >> 3, ch = cid & 7;
            bool valid; size_t row = 0;
            if (key < 256) { const int pos = q0 - 128 + key; valid = pos >= 0; row = (size_t)b * SEQ + pos; }
            else if (key < 272) { valid = true; row = (size_t)MREAL + (key - 256); }
            else valid = false;
            v4u kv = {0u, 0u, 0u, 0u}, vv = {0u, 0u, 0u, 0u};
            if (valid) { kv = *(const GAS v4u*)(KVB + row * 256 + kvh * 64 + ch * 8); vv = *(const GAS v4u*)(KVB + row * 256 + 128 + kvh * 64 + ch * 8); }
            *(LAS v4u*)(lds + A_KS + key * A_KSP + ch * 16) = kv;
            LAS unsigned short* vt = (LAS unsigned short*)(lds + A_VT);
#pragma unroll
            for (int j = 0; j < 8; ++j) { const unsigned wv = vv[j >> 1]; vt[(ch * 8 + j) * (A_VTP / 2) + key] = (unsigned short)((j & 1) ? (wv >> 16) : (wv & 0xffffu)); }
        }
    }
    __syncthreads();
    const float sink2 = sinks[hq] * LOG2E;
    for (int qg = 0; qg < 4; ++qg) {
        const size_t mrow = (size_t)b * SEQ + q0 + 32 * qg + r;
        bf16x8 qf[4];
#pragma unroll
        for (int ks = 0; ks < 4; ++ks) qf[ks] = *(const GAS bf16x8*)(QB + mrow * 1024 + hq * 64 + ks * 16 + hi * 8);
        f32x16 s[6];
#pragma unroll
        for (int t = 0; t < 6; ++t) {
            const int kbase = t < 5 ? 32 * (qg + t) : 256;
            f32x16 acc = {0.f, 0.f, 0.f, 0.f, 0.f, 0.f, 0.f, 0.f, 0.f, 0.f, 0.f, 0.f, 0.f, 0.f, 0.f, 0.f};
#pragma unroll
            for (int ks = 0; ks < 4; ++ks) {
                const bf16x8 kf = *(const LAS bf16x8*)(lds + A_KS + (kbase + r) * A_KSP + ks * 32 + hi * 16);
                acc = __builtin_amdgcn_mfma_f32_32x32x16_bf16(kf, qf[ks], acc, 0, 0, 0);
            }
            s[t] = acc;
        }
        const bool blk0 = (qblk == 0);
#pragma unroll
        for (int reg = 0; reg < 16; ++reg) {
            const int j = crow(reg, hi);
            s[0][reg] = (j > r) ? s[0][reg] : NEGBIG;
            s[4][reg] = (j <= r) ? s[4][reg] : NEGBIG;
            s[5][reg] = (j < 16) ? s[5][reg] : NEGBIG;
        }
#pragma unroll
        for (int t = 0; t < 4; ++t) if (blk0 && (qg + t < 4)) {
#pragma unroll
            for (int reg = 0; reg < 16; ++reg) s[t][reg] = NEGBIG;
        }
        float m = sink2;
#pragma unroll
        for (int t = 0; t < 6; ++t)
#pragma unroll
            for (int reg = 0; reg < 16; ++reg) m = fmaxf(m, s[t][reg]);
        m = fmaxf(m, __shfl_xor(m, 32));
        float l = 0.f;
#pragma unroll
        for (int t = 0; t < 6; ++t)
#pragma unroll
            for (int reg = 0; reg < 16; ++reg) { const float p = ex2(s[t][reg] - m); s[t][reg] = p; l += p; }
        l += __shfl_xor(l, 32);
        l += ex2(sink2 - m);
        const float linv = 1.0f / l;
        f32x16 o0 = {0.f, 0.f, 0.f, 0.f, 0.f, 0.f, 0.f, 0.f, 0.f, 0.f, 0.f, 0.f, 0.f, 0.f, 0.f, 0.f}, o1 = o0;
#pragma unroll
        for (int t = 0; t < 6; ++t) {
            const int kbase = t < 5 ? 32 * (qg + t) : 256;
#pragma unroll
            for (int ss = 0; ss < 2; ++ss) {
                v4u pw; pw.x = cvtpk(s[t][8 * ss + 0], s[t][8 * ss + 1]); pw.y = cvtpk(s[t][8 * ss + 2], s[t][8 * ss + 3]);
                pw.z = cvtpk(s[t][8 * ss + 4], s[t][8 * ss + 5]); pw.w = cvtpk(s[t][8 * ss + 6], s[t][8 * ss + 7]);
                const bf16x8 pa = __builtin_bit_cast(bf16x8, pw);
                const int ko = (kbase + 16 * ss + 4 * hi) * 2;
                {   const u32x2 lo = *(const LAS u32x2*)(lds + A_VT + r * A_VTP + ko), h2 = *(const LAS u32x2*)(lds + A_VT + r * A_VTP + ko + 16);
                    v4u vw; vw.x = lo.x; vw.y = lo.y; vw.z = h2.x; vw.w = h2.y;
                    o0 = __builtin_amdgcn_mfma_f32_32x32x16_bf16(pa, __builtin_bit_cast(bf16x8, vw), o0, 0, 0, 0); }
                {   const u32x2 lo = *(const LAS u32x2*)(lds + A_VT + (32 + r) * A_VTP + ko), h2 = *(const LAS u32x2*)(lds + A_VT + (32 + r) * A_VTP + ko + 16);
                    v4u vw; vw.x = lo.x; vw.y = lo.y; vw.z = h2.x; vw.w = h2.y;
                    o1 = __builtin_amdgcn_mfma_f32_32x32x16_bf16(pa, __builtin_bit_cast(bf16x8, vw), o1, 0, 0, 0); }
            }
        }
        LAS unsigned short* stg = (LAS unsigned short*)(lds + A_ST + wave * 4096);
#pragma unroll
        for (int reg = 0; reg < 16; ++reg) {
            const int qr = crow(reg, hi); const float li = __shfl(linv, qr);
            stg[qr * 64 + r] = (unsigned short)f2bf(o0[reg] * li);
            stg[qr * 64 + 32 + r] = (unsigned short)f2bf(o1[reg] * li);
        }
        asm volatile("s_waitcnt lgkmcnt(0)" ::: "memory");
#pragma unroll
        for (int i = 0; i < 4; ++i) {
            const int row = i * 8 + (lane >> 3), ch = lane & 7;
            const v4u v = *(const LAS v4u*)(stg + row * 64 + ch * 8);
            float ss = 0.f;
#pragma unroll
            for (int k = 0; k < 4; ++k) { const float a = __builtin_bit_cast(float, v[k] << 16), c = __builtin_bit_cast(float, v[k] & 0xffff0000u); ss += a * a + c * c; }
            ss += __shfl_xor(ss, 1); ss += __shfl_xor(ss, 2); ss += __shfl_xor(ss, 4);
            const size_t orow = (size_t)b * SEQ + q0 + 32 * qg + row;
            *(GAS v4u*)(MIX + orow * D + hq * 64 + ch * 8) = v;
            if (ch == 0) SSA[orow * 16 + hq] = ss;
        }
        asm volatile("s_waitcnt lgkmcnt(0)" ::: "memory");
    }
    __syncthreads();
}

constexpr int L_XS = 0, L_XC = 33280, L_XCF = L_XC + 36864, L_GS = L_XCF + 32768, L_W = L_GS + 16384, L_CT = L_W + 9216, L_END = L_CT + 2048;
static_assert(L_END <= 131072, "lru lds");
struct LruP { const float *conv_w, *conv_b, *w_r, *b_r, *w_i, *b_i, *lam; };
__device__ __forceinline__ void lru_unit(LAS unsigned char* lds, int b, int nb, int cg, const bf16* XBB, const bf16* GTB, const LruP P, bf16* MIX, float* SSL, int tid) {
    const int lane = tid & 63, wave = __builtin_amdgcn_readfirstlane(tid >> 6), r = lane & 31, hi = lane >> 5;
    {
        LAS unsigned short* wt = (LAS unsigned short*)(lds + L_W);
#pragma unroll
        for (int i = 0; i < 4; ++i) {
            const int e = tid + 512 * i, c = e >> 5, dl = e & 31;
            const size_t gi = (size_t)(nb * 64 + c) * 64 + 32 * cg + dl;
            wt[dl * 72 + c] = (unsigned short)f2bf(P.w_r[gi]);
            wt[32 * 72 + dl * 72 + c] = (unsigned short)f2bf(P.w_i[gi]);
        }
    }
    const int cc = tid & 63, chc = nb * 64 + cc;
    const float cw0 = P.conv_w[0 * LW + chc], cw1 = P.conv_w[1 * LW + chc], cw2 = P.conv_w[2 * LW + chc], cw3 = P.conv_w[3 * LW + chc], cbv = P.conv_b[chc];
    const int chd = nb * 64 + 32 * cg + r;
    const float br = P.b_r[chd], bi = P.b_i[chd];
    const float ls8 = -8.0f * log1pf(expf(-P.lam[chd])) * LOG2E;
    float state = 0.f;
    for (int tile = 0; tile < 9; ++tile) {
        for (int it = 0; it < 5; ++it) {
            const int cid = it * 512 + tid;
            if (cid < 259 * 8) {
                const int j = cid >> 3, ch = cid & 7, t = j - 3;
                bool valid; size_t row = 0;
                if (tile == 0) { valid = (t >= 0 && t < NMETA); row = (size_t)MREAL + t; }
                else if (tile == 1 && t < 0) { valid = true; row = (size_t)MREAL + NMETA + t; }
                else { valid = true; row = (size_t)b * SEQ + 256 * (tile - 1) + t; }
                v4u v = {0u, 0u, 0u, 0u};
                if (valid) v = *(const GAS v4u*)(XBB + row * 1024 + nb * 64 + ch * 8);
                *(LAS v4u*)(lds + L_XS + j * 128 + ch * 16) = v;
            }
        }
        if (tile > 0) {
#pragma unroll
            for (int it = 0; it < 2; ++it) {
                const int cid = it * 512 + tid, t = cid >> 2, ch = cid & 3;
                const size_t row = (size_t)b * SEQ + 256 * (tile - 1) + t;
                *(LAS v4u*)(lds + L_GS + t * 64 + ch * 16) = *(const GAS v4u*)(GTB + row * 1024 + nb * 64 + 32 * cg + ch * 8);
            }
        }
        __syncthreads();
        {
            const LAS unsigned short* xs = (const LAS unsigned short*)(lds + L_XS);
            LAS unsigned short* xc = (LAS unsigned short*)(lds + L_XC);
            LAS float* xcf = (LAS float*)(lds + L_XCF);
            const int t0 = 32 * wave;
            float x0 = bf2f(xs[(t0 + 0) * 64 + cc]), x1 = bf2f(xs[(t0 + 1) * 64 + cc]), x2 = bf2f(xs[(t0 + 2) * 64 + cc]);
#pragma unroll 8
            for (int k = 0; k < 32; ++k) {
                const float x3 = bf2f(xs[(t0 + k + 3) * 64 + cc]);
                const float v = cbv + cw0 * x0 + cw1 * x1 + cw2 * x2 + cw3 * x3;
                xc[(t0 + k) * 72 + cc] = (unsigned short)f2bf(v);
                if ((cc >> 5) == cg) xcf[(t0 + k) * 32 + (cc & 31)] = v;
                x0 = x1; x1 = x2; x2 = x3;
            }
        }
        __syncthreads();
        f32x16 aR = {0.f, 0.f, 0.f, 0.f, 0.f, 0.f, 0.f, 0.f, 0.f, 0.f, 0.f, 0.f, 0.f, 0.f, 0.f, 0.f}, aI = aR;
#pragma unroll
        for (int ks = 0; ks < 4; ++ks) {
            const bf16x8 xa = *(const LAS bf16x8*)(lds + L_XC + (32 * wave + r) * 144 + ks * 32 + hi * 16);
            const bf16x8 wr_ = *(const LAS bf16x8*)(lds + L_W + r * 144 + ks * 32 + hi * 16);
            const bf16x8 wi_ = *(const LAS bf16x8*)(lds + L_W + 32 * 144 + r * 144 + ks * 32 + hi * 16);
            aR = __builtin_amdgcn_mfma_f32_32x32x16_bf16(xa, wr_, aR, 0, 0, 0);
            aI = __builtin_amdgcn_mfma_f32_32x32x16_bf16(xa, wi_, aI, 0, 0, 0);
        }
        float Av[16], Bv[16];
        {
            const LAS float* xcf = (const LAS float*)(lds + L_XCF);
#pragma unroll
            for (int reg = 0; reg < 16; ++reg) {
                const int t = 32 * wave + crow(reg, hi);
                const bool valid = (tile > 0) || (t < NMETA);
                const float rg = rcp(1.0f + ex2(-(aR[reg] + br) * LOG2E));
                const float ig = rcp(1.0f + ex2(-(aI[reg] + bi) * LOG2E));
                const float a = ex2(rg * ls8);
                const float mult = __builtin_amdgcn_sqrtf(fmaxf(1.0f - a * a, 0.f));
                const float bx = mult * ig * xcf[t * 32 + r];
                Av[reg] = valid ? a : 1.0f; Bv[reg] = valid ? bx : 0.0f;
            }
        }
#pragma unroll
        for (int g = 0; g < 4; ++g) {
#pragma unroll
            for (int k = 1; k < 4; ++k) { Bv[4 * g + k] = Av[4 * g + k] * Bv[4 * g + k - 1] + Bv[4 * g + k]; Av[4 * g + k] = Av[4 * g + k] * Av[4 * g + k - 1]; }
        }
        float myCz[4], myCp[4], PW, HW;
        {
            float cz = 0.f, cp = 1.f;
#pragma unroll
            for (int g = 0; g < 4; ++g) {
                const float mP = Av[4 * g + 3], mH = Bv[4 * g + 3];
                const float oP = __shfl_xor(mP, 32), oH = __shfl_xor(mH, 32);
                const float eP = hi ? oP : mP, eH = hi ? oH : mH, dP = hi ? mP : oP, dH = hi ? mH : oH;
                const float cz0 = cz, cp0 = cp;
                cz = eP * cz + eH; cp = cp * eP;
                myCz[g] = hi ? cz : cz0; myCp[g] = hi ? cp : cp0;
                cz = dP * cz + dH; cp = cp * dP;
            }
            PW = cp; HW = cz;
        }
        if (hi == 0) { LAS float* ct = (LAS float*)(lds + L_CT); ct[(wave * 32 + r) * 2] = PW; ct[(wave * 32 + r) * 2 + 1] = HW; }
        __syncthreads();
        float cin = 0.f;
        {
            const LAS float* ct = (const LAS float*)(lds + L_CT);
            float c = state;
#pragma unroll
            for (int w2 = 0; w2 < 8; ++w2) { if (w2 == wave) cin = c; c = ct[(w2 * 32 + r) * 2] * c + ct[(w2 * 32 + r) * 2 + 1]; }
            state = c;
        }
        if (tile > 0) {
            const LAS unsigned short* gs = (const LAS unsigned short*)(lds + L_GS);
            LAS unsigned short* os = (LAS unsigned short*)(lds + L_XS);
#pragma unroll
            for (int reg = 0; reg < 16; ++reg) {
                const int g = reg >> 2, t = 32 * wave + crow(reg, hi);
                const float h = Bv[reg] + Av[reg] * (myCz[g] + myCp[g] * cin);
                const float gt = bf2f(gs[t * 32 + r]);
                os[t * 32 + r] = (unsigned short)f2bf(gelu_fast(gt) * h);
            }
        }
        __syncthreads();
        if (tile > 0) {
#pragma unroll
            for (int it = 0; it < 2; ++it) {
                const int cid = it * 512 + tid, t = cid >> 2, ch = cid & 3;
                const v4u v = *(const LAS v4u*)(lds + L_XS + t * 64 + ch * 16);
                float ss = 0.f;
#pragma unroll
                for (int k = 0; k < 4; ++k) { const float a = __builtin_bit_cast(float, v[k] << 16), c = __builtin_bit_cast(float, v[k] & 0xffff0000u); ss += a * a + c * c; }
                ss += __shfl_xor(ss, 1); ss += __shfl_xor(ss, 2);
                const size_t row = (size_t)b * SEQ + 256 * (tile - 1) + t;
                *(GAS v4u*)(MIX + row * D + 1024 + nb * 64 + 32 * cg + ch * 8) = v;
                if (ch == 0) SSL[row * 32 + nb * 2 + cg] = ss;
            }
        }
        __syncthreads();
    }
}
}

namespace p5 {
typedef float f32x16 __attribute__((ext_vector_type(16)));
constexpr int KP = 272;
constexpr int R_KEYS = 0, R_IDX = 256 * KP, R_END = R_IDX + 8 * 1024;
__device__ __forceinline__ int crow(int r, int hi) { return (r & 3) + 8 * (r >> 2) + 4 * hi; }
__device__ __forceinline__ int med3i(int a, int b, int c) { int d; asm("v_med3_i32 %0, %1, %2, %3" : "=v"(d) : "v"(a), "v"(b), "v"(c)); return d; }
__device__ __forceinline__ int imax(int a, int b) { return a > b ? a : b; }
__device__ __forceinline__ int imin(int a, int b) { return a < b ? a : b; }
__device__ __forceinline__ int ordf(float f) { const int b = __builtin_bit_cast(int, f); return b ^ ((b >> 31) & 0x7fffffff); }
__device__ __forceinline__ float unordf(int o) { const int b = o ^ ((o >> 31) & 0x7fffffff); return __builtin_bit_cast(float, b); }
__device__ __forceinline__ void ins16(int (&L)[16], int v) {
#pragma unroll
    for (int k = 15; k >= 1; --k) L[k] = med3i(L[k - 1], L[k], v);
    L[0] = imax(L[0], v);
}
__device__ __forceinline__ void half_top16(const LAS unsigned char* keys, const bf16* qrow, int r, int hi, int (&T)[16]) {
    bf16x8 qf[8];
#pragma unroll
    for (int ks = 0; ks < 8; ++ks) qf[ks] = *(const GAS bf16x8*)(qrow + ks * 16 + hi * 8);
    int L[16];
#pragma unroll
    for (int k = 0; k < 16; ++k) L[k] = (int)0x80000000;
    const int h4 = 4 * hi;
#pragma unroll
    for (int kt = 0; kt < 4; ++kt) {
        f32x16 acc = {0.f, 0.f, 0.f, 0.f, 0.f, 0.f, 0.f, 0.f, 0.f, 0.f, 0.f, 0.f, 0.f, 0.f, 0.f, 0.f};
#pragma unroll
        for (int ks = 0; ks < 8; ++ks) {
            const bf16x8 kf = *(const LAS bf16x8*)(keys + (kt * 32 + r) * KP + ks * 32 + hi * 16);
            acc = __builtin_amdgcn_mfma_f32_32x32x16_bf16(kf, qf[ks], acc, 0, 0, 0);
        }
#pragma unroll
        for (int reg = 0; reg < 16; ++reg) {
            const int C = 127 - 32 * kt - (reg & 3) - 8 * (reg >> 2);
            const int key = ((ordf(acc[reg]) & (int)0xffffff80) | C) - h4;
            ins16(L, key);
        }
    }
    int M[16];
#pragma unroll
    for (int i = 0; i < 16; ++i) M[i] = imax(L[i], __shfl_xor(L[15 - i], 32));
#define P5_STAGE(st) _Pragma("unroll") for (int i = 0; i < 16; ++i) if ((i & (st)) == 0) { const int a = imax(M[i], M[i + (st)]), b = imin(M[i], M[i + (st)]); M[i] = a; M[i + (st)] = b; }
    P5_STAGE(8) P5_STAGE(4) P5_STAGE(2) P5_STAGE(1)
#undef P5_STAGE
#pragma unroll
    for (int i = 0; i < 16; ++i) T[i] = M[i];
}

__device__ __forceinline__ void retr_unit(LAS unsigned char* lds, int h, int tg, const bf16* QPB, const bf16* SKB, const float* SS2, unsigned short* IDS, float* GW, float* RSTD2, int tid) {
    const int lane = tid & 63, wave = __builtin_amdgcn_readfirstlane(tid >> 6), r = lane & 31, hi = lane >> 5;
#pragma unroll
    for (int it = 0; it < 8; ++it) {
        const int cid = it * 512 + tid, row = cid >> 4, ch = cid & 15;
        *(LAS v4u*)(lds + R_KEYS + row * KP + ch * 16) = *(const GAS v4u*)(SKB + ((size_t)h * 256 + row) * 128 + ch * 8);
    }
    __syncthreads();
    const size_t tok = (size_t)tg * 256 + wave * 32 + r;
    int TA[16], TB[16];
    half_top16(lds + R_KEYS, QPB + tok * D + h * 256, r, hi, TA);
    half_top16(lds + R_KEYS + 128 * KP, QPB + tok * D + h * 256 + 128, r, hi, TB);
    LAS unsigned char* sc = lds + R_IDX + wave * 1024 + r * 32;
    const int hm = -hi;
    {
        v4u w;
#pragma unroll
        for (int q = 0; q < 4; ++q) { unsigned x = 0;
#pragma unroll
            for (int k = 0; k < 4; ++k) { const int t = (TB[4 * q + k] & hm) | (TA[4 * q + k] & ~hm); x |= (unsigned)(127 - (t & 0x7f)) << (8 * k); }
            w[q] = x; }
        *(LAS v4u*)(sc + hi * 16) = w;
    }
    float sA[16], sB[16];
#pragma unroll
    for (int i = 0; i < 16; ++i) { sA[i] = unordf(TA[i] & (int)0xffffff80); sB[i] = unordf(TB[i] & (int)0xffffff80); }
    int L[16];
#pragma unroll
    for (int k = 0; k < 16; ++k) L[k] = (int)0x80000000;
#pragma unroll
    for (int i = 0; i < 16; ++i)
#pragma unroll
        for (int j = 0; j < 16; ++j) if ((i + 1) * (j + 1) <= 16) {
            const int key = (ordf(sA[i] + sB[j]) & (int)0xffffff00) | (255 - (i * 16 + j));
            ins16(L, key);
        }
    float ssq = 0.f;
#pragma unroll
    for (int k = 0; k < 8; ++k) { const f32x4 v = *(const GAS f32x4*)(SS2 + tok * 32 + 4 * k); ssq += (v.x + v.y) + (v.z + v.w); }
    const float rs = 1.0f / sqrtf(ssq * (1.0f / D) + EPS);
    if (h == 0 && hi == 0) RSTD2[tok] = rs;
    const float v0 = unordf(L[0] & (int)0xffffff00);
    asm volatile("s_waitcnt lgkmcnt(0)" ::: "memory");
    int ex[8]; float ew[8]; float esum = 0.f;
#pragma unroll
    for (int k = 0; k < 8; ++k) {
        const int t = (L[8 + k] & hm) | (L[k] & ~hm);
        const int c = 255 - (t & 0xff);
        const int ia = sc[c >> 4], ib = sc[16 + (c & 15)];
        ex[k] = ia * 128 + ib;
        const float e = __builtin_amdgcn_exp2f((unordf(t & (int)0xffffff00) - v0) * rs * 1.4426950408889634f);
        ew[k] = e; esum += e;
    }
    esum += __shfl_xor(esum, 32);
    const float inv = 1.0f / esum;
    unsigned short* ip = IDS + tok * 128 + h * 16 + hi * 8; float* gp = GW + tok * 128 + h * 16 + hi * 8;
    *(GAS v4u*)(ip) = (v4u){(unsigned)ex[0] | ((unsigned)ex[1] << 16), (unsigned)ex[2] | ((unsigned)ex[3] << 16), (unsigned)ex[4] | ((unsigned)ex[5] << 16), (unsigned)ex[6] | ((unsigned)ex[7] << 16)};
    *(GAS f32x4*)(gp) = (f32x4){ew[0] * inv, ew[1] * inv, ew[2] * inv, ew[3] * inv};
    *(GAS f32x4*)(gp + 4) = (f32x4){ew[4] * inv, ew[5] * inv, ew[6] * inv, ew[7] * inv};
    __syncthreads();
}
}

namespace p6 {
__device__ __forceinline__ float blo(unsigned w) { return __builtin_bit_cast(float, w << 16); }
__device__ __forceinline__ float bhi(unsigned w) { return __builtin_bit_cast(float, w & 0xffff0000u); }
__device__ __forceinline__ float gelu_fast(float x) { return x * __builtin_amdgcn_rcpf(1.0f + __builtin_amdgcn_exp2f(-2.302208198f * x * (1.0f + 0.044715f * x * x))); }
__device__ __forceinline__ unsigned idw(const v4u& a, const v4u& b, int g) { const unsigned w = g < 8 ? a[(g & 7) >> 1] : b[(g & 7) >> 1]; return (g & 1) ? (w >> 16) : (w & 0xffffu); }
__device__ __forceinline__ float wave_max(float v) {
#pragma unroll
    for (int o = 1; o < 64; o <<= 1) v = fmaxf(v, __shfl_xor(v, o));
    return v;
}
__device__ __forceinline__ unsigned q4(float a, float b, float c, float d, float inv, int bias) {
    const int qa = (int)rintf(a * inv) + bias, qb = (int)rintf(b * inv) + bias, qc = (int)rintf(c * inv) + bias, qd = (int)rintf(d * inv) + bias;
    return (unsigned)(qa & 0xff) | ((unsigned)(qb & 0xff) << 8) | ((unsigned)(qc & 0xff) << 16) | ((unsigned)(qd & 0xff) << 24);
}
__device__ __forceinline__ void qrow(const float* src, const float* gcol, unsigned char* dst, float* scale_out, size_t e, int lane, int bias) {
    f32x4 v[8]; float am = 0.f;
#pragma unroll
    for (int j = 0; j < 8; ++j) {
        v[j] = *(const GAS f32x4*)(src + e * D + j * 256 + lane * 4);
        if (gcol) { const f32x4 g = *(const GAS f32x4*)(gcol + j * 256 + lane * 4); v[j] = v[j] * g; }
        am = fmaxf(am, fmaxf(fmaxf(fabsf(v[j].x), fabsf(v[j].y)), fmaxf(fabsf(v[j].z), fabsf(v[j].w))));
    }
    am = wave_max(am);
    const float inv = am > 0.f ? 127.0f / am : 0.f;
#pragma unroll
    for (int j = 0; j < 8; ++j)
        *(GAS unsigned*)(dst + ((size_t)(2 * j + (lane >> 5)) * 16384 + e) * 128 + (lane & 31) * 4) = q4(v[j].x, v[j].y, v[j].z, v[j].w, inv, bias);
    if (lane == 0) scale_out[e] = am * (1.0f / 127.0f);
}
__device__ __forceinline__ void qx_row(const bf16* H1B, unsigned char* X8, float* SX, size_t tok, int lane) {
#pragma unroll
    for (int j = 0; j < 4; ++j) {
        const v4u x = *(const GAS v4u*)(H1B + tok * D + j * 512 + lane * 8);
        float f[8]; float am = 0.f;
#pragma unroll
        for (int k = 0; k < 4; ++k) { f[2 * k] = blo(x[k]); f[2 * k + 1] = bhi(x[k]); am = fmaxf(am, fmaxf(fabsf(f[2 * k]), fabsf(f[2 * k + 1]))); }
        am = fmaxf(am, __shfl_xor(am, 1)); am = fmaxf(am, __shfl_xor(am, 2)); am = fmaxf(am, __shfl_xor(am, 4)); am = fmaxf(am, __shfl_xor(am, 8));
        const float inv = am > 0.f ? 127.0f / am : 0.f;
        typedef unsigned u32x2v __attribute__((ext_vector_type(2)));
        u32x2v o; o.x = q4(f[0], f[1], f[2], f[3], inv, 0); o.y = q4(f[4], f[5], f[6], f[7], inv, 0);
        *(GAS u32x2v*)(X8 + tok * D + j * 512 + lane * 8) = o;
        if ((lane & 15) == 0) SX[tok * 16 + 4 * j + (lane >> 4)] = am * (1.0f / 127.0f);
    }
}

__device__ __forceinline__ void usweep(const unsigned char* X8, const float* SX, const unsigned char* U8, const unsigned short* IDS, bf16* PART, int slot, int rank, int nrank, int wave, int lane) {
    const int ps = lane >> 3, ch = lane & 7;
    for (int rd = 0; rd < 2; ++rd) {
        const int sg = rd * 8 + slot;
        const unsigned char* tab = U8 + (size_t)sg * 16384 * 128 + ch * 16;
        for (int t = rank * 8 + wave; t < MREAL; t += nrank * 8) {
            const v4u i0 = *(const GAS v4u*)(IDS + (size_t)t * 128 + ps * 16), i1 = *(const GAS v4u*)(IDS + (size_t)t * 128 + ps * 16 + 8);
            const v4u xv = *(const GAS v4u*)(X8 + (size_t)t * D + sg * 128 + ch * 16);
            const float sx = SX[(size_t)t * 16 + sg];
            int d[16];
#pragma unroll
            for (int g = 0; g < 16; ++g) {
                const v4u u = *(const GAS v4u*)(tab + (size_t)idw(i0, i1, g) * 128);
                int a = __builtin_amdgcn_sdot4((int)u[0], (int)xv[0], 0, false); a = __builtin_amdgcn_sdot4((int)u[1], (int)xv[1], a, false);
                a = __builtin_amdgcn_sdot4((int)u[2], (int)xv[2], a, false); a = __builtin_amdgcn_sdot4((int)u[3], (int)xv[3], a, false);
                d[g] = a;
            }
#pragma unroll
            for (int g = 0; g < 16; ++g) { d[g] += __shfl_xor(d[g], 1); d[g] += __shfl_xor(d[g], 2); d[g] += __shfl_xor(d[g], 4); }
            if (ch == 0) {
                v4u o0, o1;
                o0.x = pk2((float)d[0] * sx, (float)d[1] * sx); o0.y = pk2((float)d[2] * sx, (float)d[3] * sx); o0.z = pk2((float)d[4] * sx, (float)d[5] * sx); o0.w = pk2((float)d[6] * sx, (float)d[7] * sx);
                o1.x = pk2((float)d[8] * sx, (float)d[9] * sx); o1.y = pk2((float)d[10] * sx, (float)d[11] * sx); o1.z = pk2((float)d[12] * sx, (float)d[13] * sx); o1.w = pk2((float)d[14] * sx, (float)d[15] * sx);
                bf16* pp = PART + ((size_t)sg * MREAL + t) * 128 + ps * 16;
                *(GAS v4u*)(pp) = o0; *(GAS v4u*)(pp + 8) = o1;
            }
        }
    }
}
__device__ __forceinline__ void wreduce(const bf16* PART, const float* GW, const float* RSTD2, const unsigned short* IDS, const float* SCU, const float* SCV, float* W, float* WSUM, size_t gt, size_t NT) {
    for (size_t i8 = gt; i8 < (size_t)MREAL * 128 / 8; i8 += NT) {
        float s[8];
#pragma unroll
        for (int k = 0; k < 8; ++k) s[k] = 0.f;
#pragma unroll 8
        for (int sg = 0; sg < 16; ++sg) {
            const v4u p = *(const GAS v4u*)(PART + (size_t)sg * MREAL * 128 + i8 * 8);
#pragma unroll
            for (int k = 0; k < 4; ++k) { s[2 * k] += blo(p[k]); s[2 * k + 1] += bhi(p[k]); }
        }
        const float rs = RSTD2[i8 >> 4];
        const v4u idv = *(const GAS v4u*)(IDS + i8 * 8);
        const f32x4 g0 = *(const GAS f32x4*)(GW + i8 * 8), g1 = *(const GAS f32x4*)(GW + i8 * 8 + 4);
        float w[8]; float tot = 0.f;
#pragma unroll
        for (int k = 0; k < 8; ++k) {
            const unsigned e = (k & 1) ? (idv[k >> 1] >> 16) : (idv[k >> 1] & 0xffffu);
            const float g = k < 4 ? g0[k & 3] : g1[k & 3];
            w[k] = g * gelu_fast(rs * SCU[e] * s[k]) * SCV[e]; tot += w[k];
        }
        *(GAS f32x4*)(W + i8 * 8) = (f32x4){w[0], w[1], w[2], w[3]};
        *(GAS f32x4*)(W + i8 * 8 + 4) = (f32x4){w[4], w[5], w[6], w[7]};
        tot += __shfl_xor(tot, 1); tot += __shfl_xor(tot, 2); tot += __shfl_xor(tot, 4); tot += __shfl_xor(tot, 8);
        if ((i8 & 15) == 0) WSUM[i8 >> 4] = 128.0f * tot;
    }
}
__device__ __forceinline__ void vsweep(const bf16* H1B, const unsigned char* V8, const unsigned short* IDS, const float* W, const float* WSUM, bf16* Z, float* SSF, int slot, int rank, int nrank, int wave, int lane) {
    const int ps = lane >> 3, ch = lane & 7;
    for (int rd = 0; rd < 2; ++rd) {
        const int sg = rd * 8 + slot;
        const unsigned char* tab = V8 + (size_t)sg * 16384 * 128 + ch * 16;
        for (int t = rank * 8 + wave; t < MREAL; t += nrank * 8) {
            const v4u i0 = *(const GAS v4u*)(IDS + (size_t)t * 128 + ps * 16), i1 = *(const GAS v4u*)(IDS + (size_t)t * 128 + ps * 16 + 8);
            f32x4 wv[4];
#pragma unroll
            for (int q = 0; q < 4; ++q) wv[q] = *(const GAS f32x4*)(W + (size_t)t * 128 + ps * 16 + 4 * q);
            const float wsum = WSUM[t];
            float acc[16];
#pragma unroll
            for (int k = 0; k < 16; ++k) acc[k] = 0.f;
#pragma unroll
            for (int g = 0; g < 16; ++g) {
                const v4u v = *(const GAS v4u*)(tab + (size_t)idw(i0, i1, g) * 128);
                const float w = wv[g >> 2][g & 3];
#pragma unroll
                for (int k = 0; k < 4; ++k) {
                    acc[4 * k + 0] += w * (float)(v[k] & 0xffu); acc[4 * k + 1] += w * (float)((v[k] >> 8) & 0xffu);
                    acc[4 * k + 2] += w * (float)((v[k] >> 16) & 0xffu); acc[4 * k + 3] += w * (float)(v[k] >> 24);
                }
            }
#pragma unroll
            for (int k = 0; k < 16; ++k) { acc[k] += __shfl_xor(acc[k], 8); acc[k] += __shfl_xor(acc[k], 16); acc[k] += __shfl_xor(acc[k], 32); }
            const v4u x0 = *(const GAS v4u*)(H1B + (size_t)t * D + sg * 128 + ch * 16), x1 = *(const GAS v4u*)(H1B + (size_t)t * D + sg * 128 + ch * 16 + 8);
            float ss = 0.f;
#pragma unroll
            for (int k = 0; k < 4; ++k) {
                acc[2 * k] += blo(x0[k]) - wsum; acc[2 * k + 1] += bhi(x0[k]) - wsum; acc[8 + 2 * k] += blo(x1[k]) - wsum; acc[8 + 2 * k + 1] += bhi(x1[k]) - wsum;
                ss += acc[2 * k] * acc[2 * k] + acc[2 * k + 1] * acc[2 * k + 1] + acc[8 + 2 * k] * acc[8 + 2 * k] + acc[8 + 2 * k + 1] * acc[8 + 2 * k + 1];
            }
            ss += __shfl_xor(ss, 1); ss += __shfl_xor(ss, 2); ss += __shfl_xor(ss, 4);
            if (ps == 0) {
                v4u o0, o1;
                o0.x = pk2(acc[0], acc[1]); o0.y = pk2(acc[2], acc[3]); o0.z = pk2(acc[4], acc[5]); o0.w = pk2(acc[6], acc[7]);
                o1.x = pk2(acc[8], acc[9]); o1.y = pk2(acc[10], acc[11]); o1.z = pk2(acc[12], acc[13]); o1.w = pk2(acc[14], acc[15]);
                *(GAS v4u*)(Z + (size_t)t * D + sg * 128 + ch * 16) = o0; *(GAS v4u*)(Z + (size_t)t * D + sg * 128 + ch * 16 + 8) = o1;
                if (ch == 0) SSF[(size_t)t * 16 + sg] = ss;
            }
        }
    }
}
__device__ __forceinline__ void final_row(const bf16* Z, const float* SSF, const float* fg, float* out, size_t tok, int lane) {
    v4u z[4];
#pragma unroll
    for (int j = 0; j < 4; ++j) z[j] = *(const GAS v4u*)(Z + tok * D + j * 512 + lane * 8);
    float ss = 0.f;
#pragma unroll
    for (int k = 0; k < 4; ++k) { const f32x4 v = *(const GAS f32x4*)(SSF + tok * 16 + 4 * k); ss += (v.x + v.y) + (v.z + v.w); }
    const float rf = 1.0f / sqrtf(ss * (1.0f / D) + EPS);
#pragma unroll
    for (int j = 0; j < 4; ++j) {
        const f32x4 ga = *(const GAS f32x4*)(fg + j * 512 + lane * 8), gb = *(const GAS f32x4*)(fg + j * 512 + lane * 8 + 4);
        *(GAS f32x4*)(out + tok * D + j * 512 + lane * 8) = (f32x4){blo(z[j][0]) * rf * ga.x, bhi(z[j][0]) * rf * ga.y, blo(z[j][1]) * rf * ga.z, bhi(z[j][1]) * rf * ga.w};
        *(GAS f32x4*)(out + tok * D + j * 512 + lane * 8 + 4) = (f32x4){blo(z[j][2]) * rf * gb.x, bhi(z[j][2]) * rf * gb.y, blo(z[j][3]) * rf * gb.z, bhi(z[j][3]) * rf * gb.w};
    }
}
}

struct Frame {
    LAS unsigned char* lds;
    volatile LAS unsigned* MISC;
    gu32* ctl;
    int tid, lane, wave, vcu, G;
};
__device__ __forceinline__ float wave_sum(float v) {
#pragma unroll
    for (int o = 1; o < 64; o <<= 1) v += __shfl_xor(v, o);
    return v;
}
__device__ __forceinline__ void p0_transpose_item(const float* W, int K, int N, bf16* WT, const float* g0, const float* g1, int ksplit, LAS float* scr, int item, int lane) {
    const int nblk = N / 32, kb = item / nblk, nb = item % nblk, k0 = 64 * kb, n0 = 32 * nb;
#pragma unroll 8
    for (int i = 0; i < 32; ++i) { const int kk = 2 * i + (lane >> 5); const int kg = k0 + kk; const float gv = kg < ksplit ? g0[kg] : g1[kg - ksplit];
        scr[kk * 33 + (lane & 31)] = W[(size_t)kg * N + n0 + (lane & 31)] * gv; }
    LDS_WAIT(); asm volatile("" ::: "memory");
    const int c = lane & 7;
#pragma unroll
    for (int j = 0; j < 4; ++j) { const int n = (lane >> 3) + 8 * j; const LAS float* s = scr + (8 * c) * 33 + n;
        v4u o; o.x = pk2(s[0 * 33], s[1 * 33]); o.y = pk2(s[2 * 33], s[3 * 33]); o.z = pk2(s[4 * 33], s[5 * 33]); o.w = pk2(s[6 * 33], s[7 * 33]);
        *(GAS v4u*)(WT + (size_t)(n0 + n) * K + k0 + 8 * c) = o; }
    LDS_WAIT(); asm volatile("" ::: "memory");
}
__device__ __forceinline__ void p0_row(const float* xrow, bf16* orow, float* rstd_out, int lane) {
    const GAS f32x4* xr = (const GAS f32x4*)xrow + lane;
    f32x4 v[8]; float s = 0.f;
#pragma unroll
    for (int j = 0; j < 8; ++j) { v[j] = xr[64 * j]; s += (v[j].x * v[j].x + v[j].y * v[j].y) + (v[j].z * v[j].z + v[j].w * v[j].w); }
    s = wave_sum(s);
    GAS unsigned long long* o8 = (GAS unsigned long long*)orow + lane;
#pragma unroll
    for (int j = 0; j < 8; ++j) o8[64 * j] = (unsigned long long)pk2(v[j].x, v[j].y) | ((unsigned long long)pk2(v[j].z, v[j].w) << 32);
    if (lane == 0) *rstd_out = 1.0f / sqrtf(s * (1.0f / D) + EPS);
}
__device__ __forceinline__ void p0_cvt8_sliced(const float* src, bf16* dst, const float* gcol, size_t idx8) {
    const f32x4 a = *(const GAS f32x4*)(src + idx8 * 8), b = *(const GAS f32x4*)(src + idx8 * 8 + 4);
    f32x4 ga = {1.f, 1.f, 1.f, 1.f}, gb = {1.f, 1.f, 1.f, 1.f};
    const int c = (int)((idx8 * 8) & (D - 1)); const size_t e = (idx8 * 8) >> 11;
    if (gcol) { ga = *(const GAS f32x4*)(gcol + c); gb = *(const GAS f32x4*)(gcol + c + 4); }
    v4u o; o.x = pk2(a.x * ga.x, a.y * ga.y); o.y = pk2(a.z * ga.z, a.w * ga.w); o.z = pk2(b.x * gb.x, b.y * gb.y); o.w = pk2(b.z * gb.z, b.w * gb.w);
    *(GAS v4u*)(dst + ((size_t)(c >> 6) * 16384 + e) * 64 + (c & 63)) = o;
}
__device__ __forceinline__ void p0_cvt8(const float* src, bf16* dst, const float* gcol, size_t idx8) {
    const f32x4 a = *(const GAS f32x4*)(src + idx8 * 8), b = *(const GAS f32x4*)(src + idx8 * 8 + 4);
    f32x4 ga = {1.f, 1.f, 1.f, 1.f}, gb = {1.f, 1.f, 1.f, 1.f};
    if (gcol) { const int c = (int)((idx8 * 8) & (D - 1)); ga = *(const GAS f32x4*)(gcol + c); gb = *(const GAS f32x4*)(gcol + c + 4); }
    v4u o; o.x = pk2(a.x * ga.x, a.y * ga.y); o.y = pk2(a.z * ga.z, a.w * ga.w); o.z = pk2(b.x * gb.x, b.y * gb.y); o.w = pk2(b.z * gb.z, b.w * gb.w);
    *(GAS v4u*)(dst + idx8 * 8) = o;
}

struct Args { const float* in[22]; float* out; unsigned char* ws; int ph_lo, ph_hi, rep_mask, pad; };

__global__ void __launch_bounds__(NWAVES * 64, 2) fwd(Args args) {
    extern __shared__ __attribute__((aligned(16))) unsigned char lds[];
    Frame F;
    F.lds = (LAS unsigned char*)lds;
    F.MISC = (volatile LAS unsigned*)(F.lds + MISC_OFF);
    F.tid = threadIdx.x; F.lane = F.tid & 63; F.wave = __builtin_amdgcn_readfirstlane(F.tid >> 6);
    F.G = gridDim.x; { const int bx = blockIdx.x; F.vcu = (F.G % 8 == 0) ? (bx % 8) * (F.G / 8) + bx / 8 : bx; }
    unsigned char* ws = args.ws;
    F.ctl = (gu32*)(ws + WS_CTL);
    for (int u = F.tid; u < (LDS_BYTES - LDSCTL_OFF) / 4; u += NWAVES * 64) ((LAS unsigned*)(F.lds + LDSCTL_OFF))[u] = 0u;
    __syncthreads();
    XcdBarrier bar = xcd_barrier_post((unsigned*)(F.ctl + CW_BAR), F.MISC + 8);
    const int lo = args.ph_lo, hi = args.ph_hi;
#define IN(k) (lo <= (k) && (k) < hi)
#define BOTH(k) (IN(k) && IN((k) + 1))
#ifndef PROBE_PH
#define PROBE_PH (-1)
#endif
#define REP(k) for (int rep_ = 0; rep_ < ((k) == PROBE_PH ? 2 : 1); ++rep_)

    const float* x = args.in[0]; const float* meta = args.in[1]; const float* norm_mix_g = args.in[2]; const float* w_in = args.in[3]; const float* b_in = args.in[4];
    const float* gn_attn_g = args.in[13]; const float* gn_lru_g = args.in[14]; const float* w_out = args.in[15]; const float* norm_ffn_g = args.in[16];
    const float* peer_wq = args.in[17]; const float* sub_keys = args.in[18]; const float* peer_u = args.in[19]; const float* peer_v = args.in[20];
    bf16* W1T = (bf16*)(ws + WS_W1T); bf16* W2T = (bf16*)(ws + WS_W2T); bf16* W3T = (bf16*)(ws + WS_W3T); bf16* SKB = (bf16*)(ws + WS_SKB);
    float* RSTD1 = (float*)(ws + WS_RSTD1);
    unsigned char* U8 = ws + WS_U8; unsigned char* V8 = ws + WS_V8; unsigned char* X8 = ws + WS_X8; float* SX = (float*)(ws + WS_SX); float* SCU = (float*)(ws + WS_SCU); float* SCV = (float*)(ws + WS_SCV); float* WSUM = (float*)(ws + WS_WSUM);
    bf16* A1 = (bf16*)(ws + WS_A1);
    bf16* QB = (bf16*)(ws + WS_Q); bf16* KVB = (bf16*)(ws + WS_KV); bf16* XBB = (bf16*)(ws + WS_XB); bf16* GTB = (bf16*)(ws + WS_GT);

    if (IN(0)) { REP(0) {
        LAS float* scr = (LAS float*)(F.lds + RING_OFF + F.wave * 16384);
        const int gw = F.vcu * NWAVES + F.wave, NGW = F.G * NWAVES;
        constexpr int I_1 = (D / 64) * (IND / 32), I_2 = (D / 64) * (D / 32), I_3 = I_2;
        for (int it = gw; it < I_1 + I_2 + I_3; it += NGW) {
            int r = it;
            if (r < I_1) { p0_transpose_item(w_in, D, IND, W1T, norm_mix_g, norm_mix_g, D, scr, r, F.lane); continue; } r -= I_1;
            if (r < I_2) { p0_transpose_item(w_out, D, D, W2T, gn_attn_g, gn_lru_g, 1024, scr, r, F.lane); continue; } r -= I_2;
            p0_transpose_item(peer_wq, D, D, W3T, norm_ffn_g, norm_ffn_g, D, scr, r, F.lane);
        }
        for (int m = gw; m < MREAL + NMETA; m += NGW) {
            const float* src = m < MREAL ? x + (size_t)m * D : meta + (size_t)(m - MREAL) * D;
            p0_row(src, A1 + (size_t)m * D, RSTD1 + m, F.lane);
        }
        {
            const size_t gt = (size_t)gw * 64 + F.lane, NT = (size_t)NGW * 64;
            for (size_t i = gt; i < (size_t)(8 * 2 * 128 * 128) / 8; i += NT) p0_cvt8(sub_keys, SKB, nullptr, i);
            for (int e = gw; e < 16384; e += NGW) { p6::qrow(peer_u, norm_ffn_g, U8, SCU, (size_t)e, F.lane, 0); p6::qrow(peer_v, nullptr, V8, SCV, (size_t)e, F.lane, 128); }
        } }
        if (BOTH(0)) xcd_barrier(bar);
    }
    if (IN(1)) {
        pg8::Gemm g{A1, W1T, MPAD, IND, D};
        pg8::Order1 S{F.G, (int)blockIdx.x};
        pg8::Epi1 E{QB, KVB, XBB, GTB, RSTD1, b_in};
        REP(1) pg8::gemm_phase<pg8::Epi1, pg8::Order1, true, true>(F.lds + RING_OFF, g, S, E);
        if (BOTH(1)) xcd_barrier(bar);
    }
    if (IN(2)) {
        bf16* MIX = (bf16*)(ws + WS_A1); float* SSA = (float*)(ws + WS_SSA); float* SSL = (float*)(ws + WS_SSL);
        const p2::LruP LP{args.in[6], args.in[7], args.in[8], args.in[9], args.in[10], args.in[11], args.in[12]};
        REP(2) {
        for (int u = (int)blockIdx.x; u < 256; u += F.G) p2::lru_unit(F.lds + RING_OFF, u >> 5, (u >> 1) & 15, u & 1, XBB, GTB, LP, MIX, SSL, F.tid);
        for (int a = (int)blockIdx.x; a < 256; a += F.G) p2::attn_unit(F.lds + RING_OFF, a >> 5, (a >> 1) & 15, a & 1, QB, KVB, args.in[5], MIX, SSA, F.tid);
        }
        if (BOTH(2)) xcd_barrier(bar);
    }
    if (IN(3)) {
        bf16* MIX = (bf16*)(ws + WS_A1); const float* SSA = (const float*)(ws + WS_SSA); const float* SSL = (const float*)(ws + WS_SSL);
        bf16* H1B = (bf16*)(ws + WS_H1); float* SS2 = (float*)(ws + WS_SS2);
        pg8::Order2 S{F.G, (int)blockIdx.x};
        LAS float* tbl = (LAS float*)(F.lds + LDSCTL_OFF + 1024);
        pg8::Unit u0{0, 0};
        for (int i = 0; i < 2; ++i) {
            pg8::Unit u; if (!S.next(i, u)) break; if (i == 0) u0 = u;
            if (F.tid < 256) {
                const size_t row = (size_t)u.pm * 256 + F.tid; float sa = 0.f, sl = 0.f;
#pragma unroll
                for (int k = 0; k < 4; ++k) { const f32x4 v = *(const GAS f32x4*)(SSA + row * 16 + 4 * k); sa += (v.x + v.y) + (v.z + v.w); }
#pragma unroll
                for (int k = 0; k < 8; ++k) { const f32x4 v = *(const GAS f32x4*)(SSL + row * 32 + 4 * k); sl += (v.x + v.y) + (v.z + v.w); }
                const float ra = 1.0f / sqrtf(sa * (1.0f / 1024) + EPS), rl = 1.0f / sqrtf(sl * (1.0f / 1024) + EPS);
                tbl[(i * 256 + F.tid) * 2] = ra / rl; tbl[(i * 256 + F.tid) * 2 + 1] = rl;
            }
        }
        __syncthreads();
        pg8::Gemm g{MIX, W2T, MREAL, D, D};
        pg8::Epi2 E{H1B, x, SS2, (const LAS float*)tbl, u0.pm};
        REP(3) pg8::gemm_phase<pg8::Epi2, pg8::Order2, true, true>(F.lds + RING_OFF, g, S, E);
        if (BOTH(3)) xcd_barrier(bar);
    }
    if (IN(4)) {
        bf16* H1B = (bf16*)(ws + WS_H1); bf16* QPB = (bf16*)(ws + WS_A1);
        pg8::Order2 S{F.G, (int)blockIdx.x};
        pg8::Gemm g{H1B, W3T, MREAL, D, D};
        pg8::Epi3 E{QPB};
        REP(4) pg8::gemm_phase<pg8::Epi3, pg8::Order2, true, true>(F.lds + RING_OFF, g, S, E);
        if (BOTH(4)) xcd_barrier(bar);
    }
    if (IN(5)) {
        const bf16* QPB = (const bf16*)(ws + WS_A1); const float* SS2 = (const float*)(ws + WS_SS2);
        unsigned short* IDS = (unsigned short*)(ws + WS_IDS); float* GW = (float*)(ws + WS_GW); float* RSTD2 = (float*)(ws + WS_RSTD2);
        const bf16* H1B = (const bf16*)(ws + WS_H1);
        REP(5) for (int u = (int)blockIdx.x; u < 512; u += F.G) {
            p5::retr_unit(F.lds + RING_OFF, u & 7, u >> 3, QPB, SKB, SS2, IDS, GW, RSTD2, F.tid);
            for (int tt = (u & 7); tt < 32; tt += 8) p6::qx_row(H1B, X8, SX, (size_t)(u >> 3) * 256 + F.wave * 32 + tt, F.lane);
        }
        if (BOTH(5)) xcd_barrier(bar);
    }
    {
        const bf16* H1B = (const bf16*)(ws + WS_H1); const unsigned short* IDS = (const unsigned short*)(ws + WS_IDS); const float* GW = (const float*)(ws + WS_GW);
        const float* RSTD2 = (const float*)(ws + WS_RSTD2); bf16* PART = (bf16*)(ws + WS_PART); float* WB = (float*)(ws + WS_W); bf16* ZB = (bf16*)(ws + WS_Z); float* SSF = (float*)(ws + WS_SSL);
        const int slot = (int)blockIdx.x & 7, rank = (int)blockIdx.x >> 3, nrank = (F.G - slot + 7) >> 3;
        const int gw = F.vcu * NWAVES + F.wave, NGW = F.G * NWAVES;
        if (IN(6)) { REP(6) p6::usweep(X8, SX, U8, IDS, PART, slot, rank, nrank, F.wave, F.lane); if (BOTH(6)) xcd_barrier(bar); }
        if (IN(7)) { REP(7) p6::wreduce(PART, GW, RSTD2, IDS, SCU, SCV, WB, WSUM, (size_t)gw * 64 + F.lane, (size_t)NGW * 64); if (BOTH(7)) xcd_barrier(bar); }
        if (IN(8)) { REP(8) p6::vsweep(H1B, V8, IDS, WB, WSUM, ZB, SSF, slot, rank, nrank, F.wave, F.lane); if (BOTH(8)) xcd_barrier(bar); }
        if (IN(9)) { REP(9) for (int t = gw; t < MREAL; t += NGW) p6::final_row(ZB, SSF, args.in[21], args.out, (size_t)t, F.lane); }
    }
#undef IN
#undef BOTH
}

extern "C" void kernel_launch(void* const* d_in, const int* in_sizes, int n_in, void* d_out, int out_size, void* d_ws, size_t ws_size, hipStream_t stream) {
    static int grid = 0;
    if (grid == 0) {
        int dev = 0, cus = 0;
        if (hipGetDevice(&dev) != hipSuccess || hipDeviceGetAttribute(&cus, hipDeviceAttributeMultiprocessorCount, dev) != hipSuccess) { fprintf(stderr, "kernel_launch: device query failed\n"); grid = -1; return; }
        if (hipFuncSetAttribute((const void*)fwd, hipFuncAttributeMaxDynamicSharedMemorySize, LDS_BYTES) != hipSuccess) { fprintf(stderr, "kernel_launch: hipFuncSetAttribute failed\n"); grid = -1; return; }
        int per_cu = 0;
        if (hipOccupancyMaxActiveBlocksPerMultiprocessor(&per_cu, (const void*)fwd, NWAVES * 64, LDS_BYTES) != hipSuccess || per_cu < 1) fprintf(stderr, "kernel_launch: occupancy query says %d\n", per_cu);
        (void)hipGetLastError();
        grid = cus;
        if (ws_size < WS_END) { fprintf(stderr, "kernel_launch: ws too small %zu\n", ws_size); grid = -1; return; }
    }
    if (grid < 0) return;
    (void)hipMemsetAsync((char*)d_ws + WS_CTL, 0, CTL_ZERO_BYTES, stream);
    Args a{};
    for (int i = 0; i < 22; ++i) a.in[i] = (const float*)d_in[i];
    a.out = (float*)d_out; a.ws = (unsigned char*)d_ws; a.ph_lo = 0; a.ph_hi = 10;
    hipLaunchKernelGGL(fwd, dim3(grid), dim3(NWAVES * 64), LDS_BYTES, stream, a);
}
```

```cpp
#include <hip/hip_runtime.h>
#include <cstdio>
#include <cstdint>
#include <math.h>

#define D 2048
#define NB 8
#define SEQ 2048
#define NMETA 16
#define TT (SEQ + NMETA)
#define MR (NB * TT)
#define MREAL (NB * SEQ)
#define MPAD (MREAL + 256)
#define QD 1024
#define KVD 128
#define LW 1024
#define IND 3328
#define EPS 1e-6f
#define QSCALE (0.125f * 1.4426950408889634f)
#define GAS __attribute__((address_space(1)))
#define LAS __attribute__((address_space(3)))
namespace pg8 {
#define PG8_LAS __attribute__((address_space(3)))
typedef unsigned short bf16_t;
typedef short bf16x8 __attribute__((ext_vector_type(8)));
typedef float f32x4 __attribute__((ext_vector_type(4)));
typedef unsigned u32x4 __attribute__((ext_vector_type(4)));
constexpr int BM = 256, BK = 64, HALF = 128, HTB = HALF * BK * 2  , STAGE_BYTES = 8 * HTB, NXCD = 8, WGM = 8;

__host__ __device__ __forceinline__ int lds_byte(int r, int c) { const int st = (r >> 4) * 2 + (c >> 5), rr = r & 15, cc = c & 31, ob = rr * 64 + cc * 2; return st * 1024 + (ob ^ (((ob >> 9) & 1) << 5)); }
__host__ __device__ __forceinline__ void stage_rc(int b, int& R, int& C) { const int st = b / 1024, sb = b % 1024, swz = sb ^ (((sb >> 9) & 1) << 5); R = (st >> 1) * 16 + swz / 64; C = (st & 1) * 32 + (swz % 64) / 2; }
__host__ __device__ __forceinline__ int perm32(int rho) { const int n = rho >> 4, i = rho & 15; return 8 * (i >> 2) + 4 * n + (i & 3); }

struct Unit { int pm, pn; };
struct Gemm { const bf16_t* A; const bf16_t* Bt; int M, N, K; };

struct StaticOrder {
    int nM, nN, nwg, G, c;
    __host__ __device__ void init(int M, int N, int G_, int c_) { nM = M / BM; nN = N / BM; nwg = nM * nN; G = G_; c = c_; }
    __host__ __device__ bool next(int i, Unit& u) const {
        const long L = (long)i * G + c; if (L >= nwg) return false;
        int wgid = (int)L; { const int q = nwg / NXCD, r = nwg % NXCD, xcd = wgid % NXCD, off = wgid / NXCD; wgid = (xcd < r ? xcd * (q + 1) : r * (q + 1) + (xcd - r) * q) + off; }
        const int nig = WGM * nN, gid = wgid / nig, fm = gid * WGM, gsz = (nM - fm) < WGM ? (nM - fm) : WGM;
        u.pm = fm + ((wgid % nig) % gsz); u.pn = (wgid % nig) / gsz; return true;
    }
    __device__ __forceinline__ void a_ready(const Unit&) const {}
    __device__ __forceinline__ void done(const Unit&) const {}
};

__device__ __forceinline__ unsigned cvt_pk_bf16(float lo, float hi) { unsigned r; asm volatile("v_cvt_pk_bf16_f32 %0, %1, %2" : "=v"(r) : "v"(lo), "v"(hi)); return r; }
typedef unsigned u32x2 __attribute__((ext_vector_type(2)));
struct Order1 {
    int G, c;
    __device__ __forceinline__ bool next(int i, Unit& u) const {
        const int L = i * G + c; if (L >= 837) return false;
        if (L >= 832) { u.pm = 64; u.pn = 4 + (L - 832); return true; }
        const int nwg = 832, nN = 13;
        int wgid = L; { const int q = nwg / NXCD, xcd = wgid % NXCD, off = wgid / NXCD; wgid = xcd * q + off; }
        const int nig = WGM * nN, gid = wgid / nig, fm = gid * WGM;
        u.pm = fm + ((wgid % nig) % WGM); u.pn = (wgid % nig) / WGM; return true;
    }
    __device__ __forceinline__ void a_ready(const Unit&) const {}
    __device__ __forceinline__ void done(const Unit&) const {}
};
struct Order2 {
    int G, c;
    __device__ __forceinline__ bool next(int i, Unit& u) const {
        const int L = i * G + c; if (L >= 512) return false;
        const int nwg = 512, nN = 8;
        int wgid = L; { const int q = nwg / NXCD, xcd = wgid % NXCD, off = wgid / NXCD; wgid = xcd * q + off; }
        const int nig = WGM * nN, gid = wgid / nig, fm = gid * WGM;
        u.pm = fm + ((wgid % nig) % WGM); u.pn = (wgid % nig) / WGM; return true;
    }
    __device__ __forceinline__ void a_ready(const Unit&) const {}
    __device__ __forceinline__ void done(const Unit&) const {}
};

struct Epi1 {
    static constexpr bool PERM = true, AFTER_DRAIN = false, MIDK = false;
    bf16_t *Q, *KV, *XB, *GT; const float* rstd; const float* bias;
    __device__ __forceinline__ void midk(f32x4 (&acc)[2][2][4][2], const Unit& u, int wr, int wc, int fr, int fq) const {}
    __device__ __forceinline__ void operator()(const f32x4 (&acc)[2][2][4][2], const Unit& u, int wr, int wc, int fr, int fq) const {
        const int row0 = u.pm * BM + wr * 64 + fr;
        bf16_t* base; int ldc, colb; float sc = 1.f;
        if (u.pn < 4) { base = Q; ldc = 1024; colb = u.pn * BM; sc = QSCALE; }
        else if (u.pn == 4) { base = KV; ldc = 256; colb = 0; }
        else if (u.pn < 9) { base = XB; ldc = 1024; colb = (u.pn - 5) * BM; }
        else { base = GT; ldc = 1024; colb = (u.pn - 9) * BM; }
        const int col0 = colb + wc * 32 + 8 * fq, bcol0 = u.pn * BM + wc * 32 + 8 * fq;
        f32x4 bv[2][2];
#pragma unroll
        for (int bj = 0; bj < 2; ++bj)
#pragma unroll
            for (int n = 0; n < 2; ++n) bv[bj][n] = *(const f32x4*)(bias + bcol0 + bj * HALF + 4 * n);
#pragma unroll
        for (int ai = 0; ai < 2; ++ai)
#pragma unroll
            for (int m = 0; m < 4; ++m) {
                const int row = row0 + ai * HALF + m * 16; const float rs = rstd[row];
                bf16_t* rowp = base + (size_t)row * ldc + col0;
#pragma unroll
                for (int bj = 0; bj < 2; ++bj) {
                    f32x4 v0 = (acc[ai][bj][m][0] * rs + bv[bj][0]) * sc, v1 = (acc[ai][bj][m][1] * rs + bv[bj][1]) * sc;
                    u32x4 w; w.x = cvt_pk_bf16(v0[0], v0[1]); w.y = cvt_pk_bf16(v0[2], v0[3]); w.z = cvt_pk_bf16(v1[0], v1[1]); w.w = cvt_pk_bf16(v1[2], v1[3]);
                    *(u32x4*)(rowp + bj * HALF) = w; } }
    }
};
struct Epi2 {
    static constexpr bool PERM = true, AFTER_DRAIN = false, MIDK = true;
    bf16_t* H1; const float* x; float* SS2; const LAS float* tbl; int pm0;
    __device__ __forceinline__ void midk(f32x4 (&acc)[2][2][4][2], const Unit& u, int wr, int wc, int fr, int fq) const {
        const LAS float* t = tbl + (u.pm == pm0 ? 0 : 512);
#pragma unroll
        for (int ai = 0; ai < 2; ++ai)
#pragma unroll
            for (int m = 0; m < 4; ++m) { const float ra = t[(ai * HALF + wr * 64 + m * 16 + fr) * 2];
#pragma unroll
                for (int bj = 0; bj < 2; ++bj)
#pragma unroll
                    for (int n = 0; n < 2; ++n) acc[ai][bj][m][n] = acc[ai][bj][m][n] * ra; }
    }
    __device__ __forceinline__ void operator()(const f32x4 (&acc)[2][2][4][2], const Unit& u, int wr, int wc, int fr, int fq) const {
        const LAS float* t = tbl + (u.pm == pm0 ? 0 : 512);
        const int col0 = u.pn * BM + wc * 32 + 8 * fq;
#pragma unroll
        for (int ai = 0; ai < 2; ++ai)
#pragma unroll
            for (int m = 0; m < 4; ++m) {
                const int rl = ai * HALF + wr * 64 + m * 16 + fr; const size_t row = (size_t)u.pm * BM + rl; const float rs = t[rl * 2 + 1];
                float ss = 0.f;
#pragma unroll
                for (int bj = 0; bj < 2; ++bj) {
                    const f32x4 x0 = *(const f32x4*)(x + row * 2048 + col0 + bj * HALF), x1 = *(const f32x4*)(x + row * 2048 + col0 + bj * HALF + 4);
                    const f32x4 v0 = acc[ai][bj][m][0] * rs + x0, v1 = acc[ai][bj][m][1] * rs + x1;
                    ss += (v0[0] * v0[0] + v0[1] * v0[1]) + (v0[2] * v0[2] + v0[3] * v0[3]) + (v1[0] * v1[0] + v1[1] * v1[1]) + (v1[2] * v1[2] + v1[3] * v1[3]);
                    u32x4 w; w.x = cvt_pk_bf16(v0[0], v0[1]); w.y = cvt_pk_bf16(v0[2], v0[3]); w.z = cvt_pk_bf16(v1[0], v1[1]); w.w = cvt_pk_bf16(v1[2], v1[3]);
                    *(u32x4*)(H1 + row * 2048 + col0 + bj * HALF) = w; }
                ss += __shfl_xor(ss, 16); ss += __shfl_xor(ss, 32);
                if (fq == 0) SS2[row * 32 + u.pn * 4 + wc] = ss;
            }
    }
};
struct Epi3 {
    static constexpr bool PERM = true, AFTER_DRAIN = false, MIDK = false;
    bf16_t* O;
    __device__ __forceinline__ void midk(f32x4 (&acc)[2][2][4][2], const Unit& u, int wr, int wc, int fr, int fq) const {}
    __device__ __forceinline__ void operator()(const f32x4 (&acc)[2][2][4][2], const Unit& u, int wr, int wc, int fr, int fq) const {
        const int col0 = u.pn * BM + wc * 32 + 8 * fq;
#pragma unroll
        for (int ai = 0; ai < 2; ++ai)
#pragma unroll
            for (int m = 0; m < 4; ++m) { const size_t row = (size_t)u.pm * BM + ai * HALF + wr * 64 + m * 16 + fr;
#pragma unroll
                for (int bj = 0; bj < 2; ++bj) { const f32x4 v0 = acc[ai][bj][m][0], v1 = acc[ai][bj][m][1];
                    u32x4 w; w.x = cvt_pk_bf16(v0[0], v0[1]); w.y = cvt_pk_bf16(v0[2], v0[3]); w.z = cvt_pk_bf16(v1[0], v1[1]); w.w = cvt_pk_bf16(v1[2], v1[3]);
                    *(u32x4*)(O + row * 2048 + col0 + bj * HALF) = w; } }
    }
};
template <class Epi, class Sched, bool ALIGN_EPI = false, bool SP2 = false>
__device__ __forceinline__ void gemm_phase(PG8_LAS unsigned char* lds, const Gemm g, const Sched& S, const Epi& E) {
    const int tid = threadIdx.x, wid = __builtin_amdgcn_readfirstlane(tid >> 6), lane = tid & 63, wr = wid >> 2, wc = wid & 3, fr = lane & 15, fq = lane >> 4;
    const int K = g.K, nt = K / BK;
    unsigned voffA[2], voffB[2];
#pragma unroll
    for (int i = 0; i < 2; ++i) { int R, C; stage_rc(tid * 16 + i * 8192, R, C); const int Rb = Epi::PERM ? ((R & ~31) + perm32(R & 31)) : R;
        voffA[i] = (unsigned)(R * K + C) * 2u; voffB[i] = (unsigned)(Rb * K + C) * 2u; }
    const size_t kstep = (size_t)(BK * 2);
    const size_t hstep = (size_t)HALF * K * 2;
    const size_t tstep = 2 * hstep;
    const unsigned ldsw = (unsigned)wid * 1024u;
    const int aoff = lds_byte(wr * 64 + fr, fq * 8), boff = lds_byte(wc * 32 + fr, fq * 8);
#define PG8_SA(b, h) (((b) * 2 + (h)) * HTB)
#define PG8_SB(b, h) ((4 + (b) * 2 + (h)) * HTB)
#define PG8_STAGE(bufoff, gbase, voff) do { _Pragma("unroll") for (int _i = 0; _i < 2; ++_i) \
        __builtin_amdgcn_global_load_lds((const unsigned*)((const char*)(gbase) + (voff)[_i]), (PG8_LAS unsigned*)(lds + (bufoff) + ldsw + _i * 8192), 16, 0, 0); } while (0)
#define PG8_LDA(dst, b, h) do { _Pragma("unroll") for (int m = 0; m < 4; ++m) _Pragma("unroll") for (int k = 0; k < 2; ++k) dst[m][k] = *(const PG8_LAS bf16x8*)(lds + PG8_SA(b, h) + aoff + m * 2048 + k * 1024); } while (0)
#define PG8_LDB(dst, b, h) do { _Pragma("unroll") for (int n = 0; n < 2; ++n) _Pragma("unroll") for (int k = 0; k < 2; ++k) dst[n][k] = *(const PG8_LAS bf16x8*)(lds + PG8_SB(b, h) + boff + n * 2048 + k * 1024); } while (0)
#define PG8_MMA(ai, bj, At, Bt) do { __builtin_amdgcn_s_setprio(1); _Pragma("unroll") for (int m = 0; m < 4; ++m) _Pragma("unroll") for (int n = 0; n < 2; ++n) _Pragma("unroll") for (int k = 0; k < 2; ++k) \
        acc[ai][bj][m][n] = __builtin_amdgcn_mfma_f32_16x16x32_bf16(Bt[n][k], At[m][k], acc[ai][bj][m][n], 0, 0, 0); __builtin_amdgcn_s_setprio(0); } while (0)
#define PG8_WAIT_V(n) asm volatile("s_waitcnt vmcnt(" #n ")" ::: "memory")
#define PG8_WAIT_L(n) asm volatile("s_waitcnt lgkmcnt(" #n ")" ::: "memory")
#define PG8_BAR __builtin_amdgcn_s_barrier()
#define PG8_SCHED __builtin_amdgcn_sched_barrier(0)
    Unit cur, nxt; int ui = 0;
    if (!S.next(0, cur)) return;
    f32x4 acc[2][2][4][2];
#pragma unroll
    for (int a = 0; a < 2; ++a)
#pragma unroll
        for (int b = 0; b < 2; ++b)
#pragma unroll
            for (int m = 0; m < 4; ++m)
#pragma unroll
                for (int n = 0; n < 2; ++n) acc[a][b][m][n] = (f32x4){0.f, 0.f, 0.f, 0.f};
    bf16x8 At[4][2], B0[2][2], B1[2][2];
    const char* cA = (const char*)g.A + (size_t)cur.pm * tstep; const char* cB = (const char*)g.Bt + (size_t)cur.pn * tstep;
    S.a_ready(cur);
    if constexpr (SP2) {
        PG8_STAGE(PG8_SB(0, 0), cB, voffB); PG8_STAGE(PG8_SB(0, 1), cB + hstep, voffB); PG8_STAGE(PG8_SA(0, 0), cA, voffA); PG8_STAGE(PG8_SA(0, 1), cA + hstep, voffA);
        if (wr == 1) PG8_BAR;
        PG8_WAIT_V(2); PG8_BAR;
        PG8_STAGE(PG8_SB(1, 0), cB + kstep, voffB); PG8_STAGE(PG8_SA(1, 0), cA + kstep, voffA); PG8_STAGE(PG8_SB(1, 1), cB + hstep + kstep, voffB);
        PG8_WAIT_V(6); PG8_BAR;
    } else {
        PG8_STAGE(PG8_SB(0, 0), cB, voffB); PG8_STAGE(PG8_SA(0, 0), cA, voffA); PG8_STAGE(PG8_SB(0, 1), cB + hstep, voffB); PG8_STAGE(PG8_SA(0, 1), cA + hstep, voffA);
        if (wr == 1) PG8_BAR;
        PG8_WAIT_V(4); PG8_BAR;
        PG8_STAGE(PG8_SB(1, 0), cB + kstep, voffB); PG8_STAGE(PG8_SA(1, 0), cA + kstep, voffA); PG8_STAGE(PG8_SB(1, 1), cB + hstep + kstep, voffB);
        PG8_WAIT_V(6); PG8_BAR;
    }
    for (;;) {
        const bool has_next = S.next(ui + 1, nxt);
        const char* nA = has_next ? (const char*)g.A + (size_t)nxt.pm * tstep : cA; const char* nB = has_next ? (const char*)g.Bt + (size_t)nxt.pn * tstep : cB;
        for (int t = 0; t < nt; t += 2) {
            if constexpr (Epi::MIDK) { if (t == nt / 2) E.midk(acc, cur, wr, wc, fr, fq); }
            const bool last = (t == nt - 2);
            const char* a1 = cA + (size_t)(t + 1) * kstep;
            const char* a2 = last ? nA : cA + (size_t)(t + 2) * kstep; const char* b2 = last ? nB : cB + (size_t)(t + 2) * kstep;
            const char* a3 = a2 + kstep; const char* b3 = b2 + kstep;
            if (last && has_next) S.a_ready(nxt);
            if constexpr (SP2) {
            PG8_LDB(B0, 0, 0); PG8_LDB(B1, 0, 1); PG8_SCHED; PG8_LDA(At, 0, 0); PG8_STAGE(PG8_SA(1, 1), a1 + hstep, voffA);
            PG8_WAIT_V(8); PG8_WAIT_L(0); PG8_BAR; PG8_MMA(0, 0, At, B0); PG8_MMA(0, 1, At, B1); PG8_BAR; PG8_SCHED;
            PG8_LDA(At, 0, 1); PG8_STAGE(PG8_SB(0, 0), b2, voffB); PG8_STAGE(PG8_SB(0, 1), b2 + hstep, voffB); PG8_STAGE(PG8_SA(0, 0), a2, voffA);
            PG8_WAIT_V(8); PG8_WAIT_L(0); PG8_BAR; PG8_MMA(1, 0, At, B0); PG8_MMA(1, 1, At, B1); PG8_BAR; PG8_SCHED;
            PG8_LDB(B0, 1, 0); PG8_LDB(B1, 1, 1); PG8_SCHED; PG8_LDA(At, 1, 0); PG8_STAGE(PG8_SA(0, 1), a2 + hstep, voffA);
            PG8_WAIT_V(8); PG8_WAIT_L(0); PG8_BAR; PG8_MMA(0, 0, At, B0); PG8_MMA(0, 1, At, B1); PG8_BAR; PG8_SCHED;
            PG8_LDA(At, 1, 1); PG8_STAGE(PG8_SB(1, 0), b3, voffB); PG8_STAGE(PG8_SB(1, 1), b3 + hstep, voffB); PG8_STAGE(PG8_SA(1, 0), a3, voffA);
            PG8_WAIT_V(8); PG8_WAIT_L(0); PG8_BAR; PG8_MMA(1, 0, At, B0); PG8_MMA(1, 1, At, B1); PG8_BAR; PG8_SCHED;
            } else {
            PG8_LDB(B0, 0, 0); PG8_SCHED; PG8_LDA(At, 0, 0); PG8_STAGE(PG8_SA(1, 1), a1 + hstep, voffA);
            PG8_WAIT_L(8); PG8_BAR; PG8_WAIT_L(0); PG8_MMA(0, 0, At, B0); PG8_BAR; PG8_SCHED;
            PG8_LDB(B1, 0, 1); PG8_STAGE(PG8_SB(0, 0), b2, voffB);
            PG8_BAR; PG8_WAIT_L(0); PG8_MMA(0, 1, At, B1); PG8_BAR;
            PG8_LDA(At, 0, 1); PG8_STAGE(PG8_SA(0, 0), a2, voffA);
            PG8_BAR; PG8_WAIT_L(0); PG8_MMA(1, 0, At, B0); PG8_BAR; PG8_SCHED;
            PG8_STAGE(PG8_SB(0, 1), b2 + hstep, voffB);
            PG8_WAIT_V(6); PG8_BAR; PG8_MMA(1, 1, At, B1); PG8_BAR;
            PG8_LDB(B0, 1, 0); PG8_SCHED; PG8_LDA(At, 1, 0); PG8_STAGE(PG8_SA(0, 1), a2 + hstep, voffA);
            PG8_WAIT_L(8); PG8_BAR; PG8_WAIT_L(0); PG8_MMA(0, 0, At, B0); PG8_BAR; PG8_SCHED;
            PG8_LDB(B1, 1, 1); PG8_STAGE(PG8_SB(1, 0), b3, voffB);
            PG8_BAR; PG8_WAIT_L(0); PG8_MMA(0, 1, At, B1); PG8_BAR;
            PG8_LDA(At, 1, 1); PG8_STAGE(PG8_SA(1, 0), a3, voffA);
            PG8_BAR; PG8_WAIT_L(0); PG8_MMA(1, 0, At, B0); PG8_BAR; PG8_SCHED;
            PG8_STAGE(PG8_SB(1, 1), b3 + hstep, voffB);
            PG8_WAIT_V(6); PG8_BAR; PG8_MMA(1, 1, At, B1); PG8_BAR;
            }
        }
        if constexpr (ALIGN_EPI) { if (wr == 0) PG8_BAR; }
        if constexpr (!Epi::AFTER_DRAIN) { E(acc, cur, wr, wc, fr, fq); S.done(cur); }
        if (!has_next) break;
#pragma unroll
        for (int a = 0; a < 2; ++a)
#pragma unroll
            for (int b = 0; b < 2; ++b)
#pragma unroll
                for (int m = 0; m < 4; ++m)
#pragma unroll
                    for (int n = 0; n < 2; ++n) acc[a][b][m][n] = (f32x4){0.f, 0.f, 0.f, 0.f};
        cur = nxt; cA = nA; cB = nB; ++ui;
        if constexpr (ALIGN_EPI) { if (wr == 1) PG8_BAR; }
    }
    PG8_WAIT_V(0);
    if constexpr (!ALIGN_EPI) { if (wr == 0) PG8_BAR; }
    PG8_BAR;
    if constexpr (Epi::AFTER_DRAIN) { E.fused(acc, cur, wr, wc, fr, fq, lds, wid, lane); S.done(cur); }
#undef PG8_SA
#undef PG8_SB
#undef PG8_STAGE
#undef PG8_LDA
#undef PG8_LDB
#undef PG8_MMA
#undef PG8_WAIT_V
#undef PG8_WAIT_L
#undef PG8_BAR
#undef PG8_SCHED
}
}
#define XB_TMO      128
#define XB_XCNT(j)  (256  + 64 * (j))
#define XB_XSUB(j)  (1280 + 64 * (j))
#define XB_XGEN(j)  (2304 + 64 * (j))
#define XB_TOP      3328
#define XB_TOPGEN   3392
#define XCD_BAR_WORDS 3456
#define XB_SPIN_CAP (1u << 18)

__device__ __forceinline__ unsigned xb_ld(unsigned* p)              { return __hip_atomic_load(p, __ATOMIC_RELAXED, __HIP_MEMORY_SCOPE_AGENT); }
__device__ __forceinline__ unsigned xb_add(unsigned* p, unsigned v) { return __hip_atomic_fetch_add(p, v, __ATOMIC_RELAXED, __HIP_MEMORY_SCOPE_AGENT); }
__device__ __forceinline__ unsigned xb_xcc_id() { return (unsigned)__builtin_amdgcn_s_getreg((3 << 11) | 20) & 0xFu; }
#define XB_SPIN(cond, bar) do { unsigned _sp = 0; while (cond) { __builtin_amdgcn_s_sleep(1); \
    if ((++_sp & 255u) == 0u) { if (xb_ld(&(bar)[XB_TMO])) break; if (_sp > XB_SPIN_CAP) { atomicAdd(&(bar)[XB_TMO], 1u); break; } } } } while (0)

struct XcdBarrier {
    unsigned* bar; unsigned x;
    volatile LAS unsigned* st;
};

__device__ __forceinline__ XcdBarrier xcd_barrier_post(unsigned* bar, volatile LAS unsigned* st) {
    XcdBarrier b; b.bar = bar; b.x = xb_xcc_id(); b.st = st;
    if (threadIdx.x == 0) (void)xb_add(&bar[XB_XCNT(b.x)], 1u);
    return b;
}
__device__ __forceinline__ void xcd_barrier_complete(unsigned* bar, unsigned x, unsigned& nloc, unsigned& nx) {
    const unsigned G = gridDim.x * gridDim.y * gridDim.z;
    unsigned sum, cnt, mine, sp = 0u;
    for (;;) {
        sum = 0u; cnt = 0u; mine = 0u;
#pragma unroll
        for (unsigned j = 0; j < 16; ++j) { const unsigned c = xb_ld(&bar[XB_XCNT(j)]); sum += c; cnt += (c > 0u) ? 1u : 0u; mine = (j == x) ? c : mine; }
        if (sum == G) break;
        __builtin_amdgcn_s_sleep(1);
        if ((++sp & 255u) == 0u) { if (xb_ld(&bar[XB_TMO])) break; if (sp > XB_SPIN_CAP) { atomicAdd(&bar[XB_TMO], 1u); break; } }
    }
    nloc = mine > 0u ? mine : 1u; nx = cnt > 0u ? cnt : 1u;
}

__device__ __forceinline__ void xcd_barrier(const XcdBarrier& b) {
    asm volatile("s_waitcnt vmcnt(0)" ::: "memory");
    __syncthreads();
    if (threadIdx.x == 0) {
        unsigned* bar = b.bar;
        __builtin_amdgcn_s_waitcnt(0);
        unsigned nloc = b.st[0], nx = b.st[1];
        if (nloc == 0u) { xcd_barrier_complete(bar, b.x, nloc, nx); b.st[0] = nloc; b.st[1] = nx; }
        const unsigned old = xb_add(&bar[XB_XSUB(b.x)], 1u);
        const unsigned gen = old / nloc;
        if (old + 1u == (gen + 1u) * nloc) {
            __builtin_amdgcn_fence(__ATOMIC_RELEASE, "agent");
            asm volatile("s_waitcnt vmcnt(0)" ::: "memory");
            const unsigned og = xb_add(&bar[XB_TOP], 1u);
            const unsigned tg = og / nx;
            if (og + 1u == (tg + 1u) * nx) xb_add(&bar[XB_TOPGEN], 1u);
            else XB_SPIN(xb_ld(&bar[XB_TOPGEN]) == tg, bar);
            __builtin_amdgcn_fence(__ATOMIC_ACQUIRE, "agent");
            xb_add(&bar[XB_XGEN(b.x)], 1u);
            asm volatile("s_waitcnt vmcnt(0)" ::: "memory");
        } else {
            XB_SPIN(xb_ld(&bar[XB_XGEN(b.x)]) == gen, bar);
            __builtin_amdgcn_fence(__ATOMIC_ACQUIRE, "agent");
            asm volatile("s_waitcnt vmcnt(0)" ::: "memory");
        }
    }
    __syncthreads();
}

constexpr int NWAVES = 8;
constexpr size_t MiB = 1u << 20;
constexpr size_t WS_CTL = 0, CTL_ZERO_BYTES = 1 * MiB;
constexpr size_t WS_W1T = 2 * MiB;
constexpr size_t WS_W2T = 16 * MiB;
constexpr size_t WS_W3T = 24 * MiB;
constexpr size_t WS_SKB = 32 * MiB;
constexpr size_t WS_RSTD1 = 33 * MiB;
constexpr size_t WS_SSA = 34 * MiB;
constexpr size_t WS_SSL = 35 * MiB;
constexpr size_t WS_SS2 = 37 * MiB;
constexpr size_t WS_RSTD2 = 39 * MiB;
constexpr size_t WS_IDS = 40 * MiB;
constexpr size_t WS_GW = 48 * MiB;
constexpr size_t WS_U8 = 64 * MiB;
constexpr size_t WS_V8 = 96 * MiB;
constexpr size_t WS_X8 = 128 * MiB;
constexpr size_t WS_SX = 160 * MiB;
constexpr size_t WS_SCU = 162 * MiB;
constexpr size_t WS_SCV = 163 * MiB;
constexpr size_t WS_WSUM = 164 * MiB;
constexpr size_t WS_A1 = 192 * MiB;
constexpr size_t WS_Q = 258 * MiB;
constexpr size_t WS_KV = 290 * MiB;
constexpr size_t WS_XB = 299 * MiB;
constexpr size_t WS_GT = 332 * MiB;
constexpr size_t WS_H1 = 364 * MiB;
constexpr size_t WS_PART = 192 * MiB;
constexpr size_t WS_W = 56 * MiB;
constexpr size_t WS_Z = 428 * MiB;
constexpr size_t WS_END = 492 * MiB;
constexpr int CW_BAR = 4096;

constexpr int RING_OFF = 0, RING_BYTES = 131072;
constexpr int LDSCTL_OFF = RING_BYTES, MISC_OFF = LDSCTL_OFF + 320;
constexpr int LDS_BYTES = 147456;

typedef unsigned short bf16;
typedef unsigned v4u __attribute__((ext_vector_type(4)));
typedef float f32x4 __attribute__((ext_vector_type(4)));
typedef short bf16x8 __attribute__((ext_vector_type(8)));
typedef GAS unsigned gu32;
#define RLX_AGENT __ATOMIC_RELAXED, __HIP_MEMORY_SCOPE_AGENT
#define LDS_WAIT() asm volatile("s_waitcnt lgkmcnt(0)" ::: "memory")
#define VM_WAIT() asm volatile("s_waitcnt vmcnt(0)" ::: "memory")
__device__ __forceinline__ unsigned f2bf(float f) { unsigned u = __builtin_bit_cast(unsigned, f); return (u + 0x7fffu + ((u >> 16) & 1u)) >> 16; }
__device__ __forceinline__ unsigned pk2(float lo, float hi) { return f2bf(lo) | (f2bf(hi) << 16); }
__device__ __forceinline__ float bf2f(unsigned short b) { return __builtin_bit_cast(float, (unsigned)b << 16); }

namespace p2 {
typedef float f32x16 __attribute__((ext_vector_type(16)));
typedef unsigned u32x2 __attribute__((ext_vector_type(2)));
constexpr float LOG2E = 1.4426950408889634f;
constexpr float NEGBIG = -1e30f;
__device__ __forceinline__ int crow(int r, int hi) { return (r & 3) + 8 * (r >> 2) + 4 * hi; }
__device__ __forceinline__ unsigned cvtpk(float lo, float hi) { unsigned r; asm volatile("v_cvt_pk_bf16_f32 %0, %1, %2" : "=v"(r) : "v"(lo), "v"(hi)); return r; }
__device__ __forceinline__ float ex2(float x) { return __builtin_amdgcn_exp2f(x); }
__device__ __forceinline__ float rcp(float x) { return __builtin_amdgcn_rcpf(x); }
__device__ __forceinline__ float gelu_fast(float x) { return x * rcp(1.0f + ex2(-2.302208198f * x * (1.0f + 0.044715f * x * x))); }

constexpr int A_KS = 0, A_KSP = 144, A_VT = 288 * 144, A_VTP = 584, A_ST = A_VT + 64 * 584, A_END = A_ST + 8 * 4096;
__device__ __forceinline__ void attn_unit(LAS unsigned char* lds, int b, int qblk, int kvh, const bf16* QB, const bf16* KVB, const float* sinks, bf16* MIX, float* SSA, int tid) {
    const int lane = tid & 63, wave = __builtin_amdgcn_readfirstlane(tid >> 6), r = lane & 31, hi = lane >> 5;
    const int q0 = qblk * 128, hq = kvh * 8 + wave;
    for (int it = 0; it < 5; ++it) {
        const int cid = it * 512 + tid;
        if (cid < 288 * 8) {
            const int key = cid >> 3, ch = cid & 7;
            bool valid; size_t row = 0;
            if (key < 256) { const int pos = q0 - 128 + key; valid = pos >= 0; row = (size_t)b * SEQ + pos; }
            else if (key < 272) { valid = true; row = (size_t)MREAL + (key - 256); }
            else valid = false;
            v4u kv = {0u, 0u, 0u, 0u}, vv = {0u, 0u, 0u, 0u};
            if (valid) { kv = *(const GAS v4u*)(KVB + row * 256 + kvh * 64 + ch * 8); vv = *(const GAS v4u*)(KVB + row * 256 + 128 + kvh * 64 + ch * 8); }
            *(LAS v4u*)(lds + A_KS + key * A_KSP + ch * 16) = kv;
            LAS unsigned short* vt = (LAS unsigned short*)(lds + A_VT);
#pragma unroll
            for (int j = 0; j < 8; ++j) { const unsigned wv = vv[j >> 1]; vt[(ch * 8 + j) * (A_VTP / 2) + key] = (unsigned short)((j & 1) ? (wv >> 16) : (wv & 0xffffu)); }
        }
    }
    __syncthreads();
    const float sink2 = sinks[hq] * LOG2E;
    for (int qg = 0; qg < 4; ++qg) {
        const size_t mrow = (size_t)b * SEQ + q0 + 32 * qg + r;
        bf16x8 qf[4];
#pragma unroll
        for (int ks = 0; ks < 4; ++ks) qf[ks] = *(const GAS bf16x8*)(QB + mrow * 1024 + hq * 64 + ks * 16 + hi * 8);
        f32x16 s[6];
#pragma unroll
        for (int t = 0; t < 6; ++t) {
            const int kbase = t < 5 ? 32 * (qg + t) : 256;
            f32x16 acc = {0.f, 0.f, 0.f, 0.f, 0.f, 0.f, 0.f, 0.f, 0.f, 0.f, 0.f, 0.f, 0.f, 0.f, 0.f, 0.f};
#pragma unroll
            for (int ks = 0; ks < 4; ++ks) {
                const bf16x8 kf = *(const LAS bf16x8*)(lds + A_KS + (kbase + r) * A_KSP + ks * 32 + hi * 16);
                acc = __builtin_amdgcn_mfma_f32_32x32x16_bf16(kf, qf[ks], acc, 0, 0, 0);
            }
            s[t] = acc;
        }
        const bool blk0 = (qblk == 0);
#pragma unroll
        for (int reg = 0; reg < 16; ++reg) {
            const int j = crow(reg, hi);
            s[0][reg] = (j > r) ? s[0][reg] : NEGBIG;
            s[4][reg] = (j <= r) ? s[4][reg] : NEGBIG;
            s[5][reg] = (j < 16) ? s[5][reg] : NEGBIG;
        }
#pragma unroll
        for (int t = 0; t < 4; ++t) if (blk0 && (qg + t < 4)) {
#pragma unroll
            for (int reg = 0; reg < 16; ++reg) s[t][reg] = NEGBIG;
        }
        float m = sink2;
#pragma unroll
        for (int t = 0; t < 6; ++t)
#pragma unroll
            for (int reg = 0; reg < 16; ++reg) m = fmaxf(m, s[t][reg]);
        m = fmaxf(m, __shfl_xor(m, 32));
        float l = 0.f;
#pragma unroll
        for (int t = 0; t < 6; ++t)
#pragma unroll
            for (int reg = 0; reg < 16; ++reg) { const float p = ex2(s[t][reg] - m); s[t][reg] = p; l += p; }
        l += __shfl_xor(l, 32);
        l += ex2(sink2 - m);
        const float linv = 1.0f / l;
        f32x16 o0 = {0.f, 0.f, 0.f, 0.f, 0.f, 0.f, 0.f, 0.f, 0.f, 0.f, 0.f, 0.f, 0.f, 0.f, 0.f, 0.f}, o1 = o0;
#pragma unroll
        for (int t = 0; t < 6; ++t) {
            const int kbase = t < 5 ? 32 * (qg + t) : 256;
#pragma unroll
            for (int ss = 0; ss < 2; ++ss) {
                v4u pw; pw.x = cvtpk(s[t][8 * ss + 0], s[t][8 * ss + 1]); pw.y = cvtpk(s[t][8 * ss + 2], s[t][8 * ss + 3]);
                pw.z = cvtpk(s[t][8 * ss + 4], s[t][8 * ss + 5]); pw.w = cvtpk(s[t][8 * ss + 6], s[t][8 * ss + 7]);
                const bf16x8 pa = __builtin_bit_cast(bf16x8, pw);
                const int ko = (kbase + 16 * ss + 4 * hi) * 2;
                {   const u32x2 lo = *(const LAS u32x2*)(lds + A_VT + r * A_VTP + ko), h2 = *(const LAS u32x2*)(lds + A_VT + r * A_VTP + ko + 16);
                    v4u vw; vw.x = lo.x; vw.y = lo.y; vw.z = h2.x; vw.w = h2.y;
                    o0 = __builtin_amdgcn_mfma_f32_32x32x16_bf16(pa, __builtin_bit_cast(bf16x8, vw), o0, 0, 0, 0); }
                {   const u32x2 lo = *(const LAS u32x2*)(lds + A_VT + (32 + r) * A_VTP + ko), h2 = *(const LAS u32x2*)(lds + A_VT + (32 + r) * A_VTP + ko + 16);
                    v4u vw; vw.x = lo.x; vw.y = lo.y; vw.z = h2.x; vw.w = h2.y;
                    o1 = __builtin_amdgcn_mfma_f32_32x32x16_bf16(pa, __builtin_bit_cast(bf16x8, vw), o1, 0, 0, 0); }
            }
        }
        LAS unsigned short* stg = (LAS unsigned short*)(lds + A_ST + wave * 4096);
#pragma unroll
        for (int reg = 0; reg < 16; ++reg) {
            const int qr = crow(reg, hi); const float li = __shfl(linv, qr);
            stg[qr * 64 + r] = (unsigned short)f2bf(o0[reg] * li);
            stg[qr * 64 + 32 + r] = (unsigned short)f2bf(o1[reg] * li);
        }
        asm volatile("s_waitcnt lgkmcnt(0)" ::: "memory");
#pragma unroll
        for (int i = 0; i < 4; ++i) {
            const int row = i * 8 + (lane >> 3), ch = lane & 7;
            const v4u v = *(const LAS v4u*)(stg + row * 64 + ch * 8);
            float ss = 0.f;
#pragma unroll
            for (int k = 0; k < 4; ++k) { const float a = __builtin_bit_cast(float, v[k] << 16), c = __builtin_bit_cast(float, v[k] & 0xffff0000u); ss += a * a + c * c; }
            ss += __shfl_xor(ss, 1); ss += __shfl_xor(ss, 2); ss += __shfl_xor(ss, 4);
            const size_t orow = (size_t)b * SEQ + q0 + 32 * qg + row;
            *(GAS v4u*)(MIX + orow * D + hq * 64 + ch * 8) = v;
            if (ch == 0) SSA[orow * 16 + hq] = ss;
        }
        asm volatile("s_waitcnt lgkmcnt(0)" ::: "memory");
    }
    __syncthreads();
}

constexpr int L_XS = 0, L_XC = 33280, L_XCF = L_XC + 36864, L_GS = L_XCF + 32768, L_W = L_GS + 16384, L_CT = L_W + 9216, L_END = L_CT + 2048;
static_assert(L_END <= 131072, "lru lds");
struct LruP { const float *conv_w, *conv_b, *w_r, *b_r, *w_i, *b_i, *lam; };
__device__ __forceinline__ void lru_unit(LAS unsigned char* lds, int b, int nb, int cg, const bf16* XBB, const bf16* GTB, const LruP P, bf16* MIX, float* SSL, int tid) {
    const int lane = tid & 63, wave = __builtin_amdgcn_readfirstlane(tid >> 6), r = lane & 31, hi = lane >> 5;
    {
        LAS unsigned short* wt = (LAS unsigned short*)(lds + L_W);
#pragma unroll
        for (int i = 0; i < 4; ++i) {
            const int e = tid + 512 * i, c = e >> 5, dl = e & 31;
            const size_t gi = (size_t)(nb * 64 + c) * 64 + 32 * cg + dl;
            wt[dl * 72 + c] = (unsigned short)f2bf(P.w_r[gi]);
            wt[32 * 72 + dl * 72 + c] = (unsigned short)f2bf(P.w_i[gi]);
        }
    }
    const int cc = tid & 63, chc = nb * 64 + cc;
    const float cw0 = P.conv_w[0 * LW + chc], cw1 = P.conv_w[1 * LW + chc], cw2 = P.conv_w[2 * LW + chc], cw3 = P.conv_w[3 * LW + chc], cbv = P.conv_b[chc];
    const int chd = nb * 64 + 32 * cg + r;
    const float br = P.b_r[chd], bi = P.b_i[chd];
    const float ls8 = -8.0f * log1pf(expf(-P.lam[chd])) * LOG2E;
    float state = 0.f;
    for (int tile = 0; tile < 9; ++tile) {
        for (int it = 0; it < 5; ++it) {
            const int cid = it * 512 + tid;
            if (cid < 259 * 8) {
                const int j = cid >> 3, ch = cid & 7, t = j - 3;
                bool valid; size_t row = 0;
                if (tile == 0) { valid = (t >= 0 && t < NMETA); row = (size_t)MREAL + t; }
                else if (tile == 1 && t < 0) { valid = true; row = (size_t)MREAL + NMETA + t; }
                else { valid = true; row = (size_t)b * SEQ + 256 * (tile - 1) + t; }
                v4u v = {0u, 0u, 0u, 0u};
                if (valid) v = *(const GAS v4u*)(XBB + row * 1024 + nb * 64 + ch * 8);
                *(LAS v4u*)(lds + L_XS + j * 128 + ch * 16) = v;
            }
        }
        if (tile > 0) {
#pragma unroll
            for (int it = 0; it < 2; ++it) {
                const int cid = it * 512 + tid, t = cid >> 2, ch = cid & 3;
                const size_t row = (size_t)b * SEQ + 256 * (tile - 1) + t;
                *(LAS v4u*)(lds + L_GS + t * 64 + ch * 16) = *(const GAS v4u*)(GTB + row * 1024 + nb * 64 + 32 * cg + ch * 8);
            }
        }
        __syncthreads();
        {
            const LAS unsigned short* xs = (const LAS unsigned short*)(lds + L_XS);
            LAS unsigned short* xc = (LAS unsigned short*)(lds + L_XC);
            LAS float* xcf = (LAS float*)(lds + L_XCF);
            const int t0 = 32 * wave;
            float x0 = bf2f(xs[(t0 + 0) * 64 + cc]), x1 = bf2f(xs[(t0 + 1) * 64 + cc]), x2 = bf2f(xs[(t0 + 2) * 64 + cc]);
#pragma unroll 8
            for (int k = 0; k < 32; ++k) {
                const float x3 = bf2f(xs[(t0 + k + 3) * 64 + cc]);
                const float v = cbv + cw0 * x0 + cw1 * x1 + cw2 * x2 + cw3 * x3;
                xc[(t0 + k) * 72 + cc] = (unsigned short)f2bf(v);
                if ((cc >> 5) == cg) xcf[(t0 + k) * 32 + (cc & 31)] = v;
                x0 = x1; x1 = x2; x2 = x3;
            }
        }
        __syncthreads();
        f32x16 aR = {0.f, 0.f, 0.f, 0.f, 0.f, 0.f, 0.f, 0.f, 0.f, 0.f, 0.f, 0.f, 0.f, 0.f, 0.f, 0.f}, aI = aR;
#pragma unroll
        for (int ks = 0; ks < 4; ++ks) {
            const bf16x8 xa = *(const LAS bf16x8*)(lds + L_XC + (32 * wave + r) * 144 + ks * 32 + hi * 16);
            const bf16x8 wr_ = *(const LAS bf16x8*)(lds + L_W + r * 144 + ks * 32 + hi * 16);
            const bf16x8 wi_ = *(const LAS bf16x8*)(lds + L_W + 32 * 144 + r * 144 + ks * 32 + hi * 16);
            aR = __builtin_amdgcn_mfma_f32_32x32x16_bf16(xa, wr_, aR, 0, 0, 0);
            aI = __builtin_amdgcn_mfma_f32_32x32x16_bf16(xa, wi_, aI, 0, 0, 0);
        }
        float Av[16], Bv[16];
        {
            const LAS float* xcf = (const LAS float*)(lds + L_XCF);
#pragma unroll
            for (int reg = 0; reg < 16; ++reg) {
                const int t = 32 * wave + crow(reg, hi);
                const bool valid = (tile > 0) || (t < NMETA);
                const float rg = rcp(1.0f + ex2(-(aR[reg] + br) * LOG2E));
                const float ig = rcp(1.0f + ex2(-(aI[reg] + bi) * LOG2E));
                const float a = ex2(rg * ls8);
                const float mult = __builtin_amdgcn_sqrtf(fmaxf(1.0f - a * a, 0.f));
                const float bx = mult * ig * xcf[t * 32 + r];
                Av[reg] = valid ? a : 1.0f; Bv[reg] = valid ? bx : 0.0f;
            }
        }
#pragma unroll
        for (int g = 0; g < 4; ++g) {
#pragma unroll
            for (int k = 1; k < 4; ++k) { Bv[4 * g + k] = Av[4 * g + k] * Bv[4 * g + k - 1] + Bv[4 * g + k]; Av[4 * g + k] = Av[4 * g + k] * Av[4 * g + k - 1]; }
        }
        float myCz[4], myCp[4], PW, HW;
        {
            float cz = 0.f, cp = 1.f;
#pragma unroll
            for (int g = 0; g < 4; ++g) {
                const float mP = Av[4 * g + 3], mH = Bv[4 * g + 3];
                const float oP = __shfl_xor(mP, 32), oH = __shfl_xor(mH, 32);
                const float eP = hi ? oP : mP, eH = hi ? oH : mH, dP = hi ? mP : oP, dH = hi ? mH : oH;
                const float cz0 = cz, cp0 = cp;
                cz = eP * cz + eH; cp = cp * eP;
                myCz[g] = hi ? cz : cz0; myCp[g] = hi ? cp : cp0;
                cz = dP * cz + dH; cp = cp * dP;
            }
            PW = cp; HW = cz;
        }
        if (hi == 0) { LAS float* ct = (LAS float*)(lds + L_CT); ct[(wave * 32 + r) * 2] = PW; ct[(wave * 32 + r) * 2 + 1] = HW; }
        __syncthreads();
        float cin = 0.f;
        {
            const LAS float* ct = (const LAS float*)(lds + L_CT);
            float c = state;
#pragma unroll
            for (int w2 = 0; w2 < 8; ++w2) { if (w2 == wave) cin = c; c = ct[(w2 * 32 + r) * 2] * c + ct[(w2 * 32 + r) * 2 + 1]; }
            state = c;
        }
        if (tile > 0) {
            const LAS unsigned short* gs = (const LAS unsigned short*)(lds + L_GS);
            LAS unsigned short* os = (LAS unsigned short*)(lds + L_XS);
#pragma unroll
            for (int reg = 0; reg < 16; ++reg) {
                const int g = reg >> 2, t = 32 * wave + crow(reg, hi);
                const float h = Bv[reg] + Av[reg] * (myCz[g] + myCp[g] * cin);
                const float gt = bf2f(gs[t * 32 + r]);
                os[t * 32 + r] = (unsigned short)f2bf(gelu_fast(gt) * h);
            }
        }
        __syncthreads();
        if (tile > 0) {
#pragma unroll
            for (int it = 0; it < 2; ++it) {
                const int cid = it * 512 + tid, t = cid >> 2, ch = cid & 3;
                const v4u v = *(const LAS v4u*)(lds + L_XS + t * 64 + ch * 16);
                float ss = 0.f;
#pragma unroll
                for (int k = 0; k < 4; ++k) { const float a = __builtin_bit_cast(float, v[k] << 16), c = __builtin_bit_cast(float, v[k] & 0xffff0000u); ss += a * a + c * c; }
                ss += __shfl_xor(ss, 1); ss += __shfl_xor(ss, 2);
                const size_t row = (size_t)b * SEQ + 256 * (tile - 1) + t;
                *(GAS v4u*)(MIX + row * D + 1024 + nb * 64 + 32 * cg + ch * 8) = v;
                if (ch == 0) SSL[row * 32 + nb * 2 + cg] = ss;
            }
        }
        __syncthreads();
    }
}
}

namespace p5 {
typedef float f32x16 __attribute__((ext_vector_type(16)));
constexpr int KP = 272;
constexpr int R_KEYS = 0, R_IDX = 256 * KP, R_END = R_IDX + 8 * 1024;
__device__ __forceinline__ int crow(int r, int hi) { return (r & 3) + 8 * (r >> 2) + 4 * hi; }
__device__ __forceinline__ int med3i(int a, int b, int c) { int d; asm("v_med3_i32 %0, %1, %2, %3" : "=v"(d) : "v"(a), "v"(b), "v"(c)); return d; }
__device__ __forceinline__ int imax(int a, int b) { return a > b ? a : b; }
__device__ __forceinline__ int imin(int a, int b) { return a < b ? a : b; }
__device__ __forceinline__ int ordf(float f) { const int b = __builtin_bit_cast(int, f); return b ^ ((b >> 31) & 0x7fffffff); }
__device__ __forceinline__ float unordf(int o) { const int b = o ^ ((o >> 31) & 0x7fffffff); return __builtin_bit_cast(float, b); }
__device__ __forceinline__ void ins16(int (&L)[16], int v) {
#pragma unroll
    for (int k = 15; k >= 1; --k) L[k] = med3i(L[k - 1], L[k], v);
    L[0] = imax(L[0], v);
}
__device__ __forceinline__ void half_top16(const LAS unsigned char* keys, const bf16* qrow, int r, int hi, int (&T)[16]) {
    bf16x8 qf[8];
#pragma unroll
    for (int ks = 0; ks < 8; ++ks) qf[ks] = *(const GAS bf16x8*)(qrow + ks * 16 + hi * 8);
    int L[16];
#pragma unroll
    for (int k = 0; k < 16; ++k) L[k] = (int)0x80000000;
    const int h4 = 4 * hi;
#pragma unroll
    for (int kt = 0; kt < 4; ++kt) {
        f32x16 acc = {0.f, 0.f, 0.f, 0.f, 0.f, 0.f, 0.f, 0.f, 0.f, 0.f, 0.f, 0.f, 0.f, 0.f, 0.f, 0.f};
#pragma unroll
        for (int ks = 0; ks < 8; ++ks) {
            const bf16x8 kf = *(const LAS bf16x8*)(keys + (kt * 32 + r) * KP + ks * 32 + hi * 16);
            acc = __builtin_amdgcn_mfma_f32_32x32x16_bf16(kf, qf[ks], acc, 0, 0, 0);
        }
#pragma unroll
        for (int reg = 0; reg < 16; ++reg) {
            const int C = 127 - 32 * kt - (reg & 3) - 8 * (reg >> 2);
            const int key = ((ordf(acc[reg]) & (int)0xffffff80) | C) - h4;
            ins16(L, key);
        }
    }
    int M[16];
#pragma unroll
    for (int i = 0; i < 16; ++i) M[i] = imax(L[i], __shfl_xor(L[15 - i], 32));
#define P5_STAGE(st) _Pragma("unroll") for (int i = 0; i < 16; ++i) if ((i & (st)) == 0) { const int a = imax(M[i], M[i + (st)]), b = imin(M[i], M[i + (st)]); M[i] = a; M[i + (st)] = b; }
    P5_STAGE(8) P5_STAGE(4) P5_STAGE(2) P5_STAGE(1)
#undef P5_STAGE
#pragma unroll
    for (int i = 0; i < 16; ++i) T[i] = M[i];
}

__device__ __forceinline__ void retr_unit(LAS unsigned char* lds, int h, int tg, const bf16* QPB, const bf16* SKB, const float* SS2, unsigned short* IDS, float* GW, float* RSTD2, int tid) {
    const int lane = tid & 63, wave = __builtin_amdgcn_readfirstlane(tid >> 6), r = lane & 31, hi = lane >> 5;
#pragma unroll
    for (int it = 0; it < 8; ++it) {
        const int cid = it * 512 + tid, row = cid >> 4, ch = cid & 15;
        *(LAS v4u*)(lds + R_KEYS + row * KP + ch * 16) = *(const GAS v4u*)(SKB + ((size_t)h * 256 + row) * 128 + ch * 8);
    }
    __syncthreads();
    const size_t tok = (size_t)tg * 256 + wave * 32 + r;
    int TA[16], TB[16];
    half_top16(lds + R_KEYS, QPB + tok * D + h * 256, r, hi, TA);
    half_top16(lds + R_KEYS + 128 * KP, QPB + tok * D + h * 256 + 128, r, hi, TB);
    LAS unsigned char* sc = lds + R_IDX + wave * 1024 + r * 32;
    const int hm = -hi;
    {
        v4u w;
#pragma unroll
        for (int q = 0; q < 4; ++q) { unsigned x = 0;
#pragma unroll
            for (int k = 0; k < 4; ++k) { const int t = (TB[4 * q + k] & hm) | (TA[4 * q + k] & ~hm); x |= (unsigned)(127 - (t & 0x7f)) << (8 * k); }
            w[q] = x; }
        *(LAS v4u*)(sc + hi * 16) = w;
    }
    float sA[16], sB[16];
#pragma unroll
    for (int i = 0; i < 16; ++i) { sA[i] = unordf(TA[i] & (int)0xffffff80); sB[i] = unordf(TB[i] & (int)0xffffff80); }
    int L[16];
#pragma unroll
    for (int k = 0; k < 16; ++k) L[k] = (int)0x80000000;
#pragma unroll
    for (int i = 0; i < 16; ++i)
#pragma unroll
        for (int j = 0; j < 16; ++j) if ((i + 1) * (j + 1) <= 16) {
            const int key = (ordf(sA[i] + sB[j]) & (int)0xffffff00) | (255 - (i * 16 + j));
            ins16(L, key);
        }
    float ssq = 0.f;
#pragma unroll
    for (int k = 0; k < 8; ++k) { const f32x4 v = *(const GAS f32x4*)(SS2 + tok * 32 + 4 * k); ssq += (v.x + v.y) + (v.z + v.w); }
    const float rs = 1.0f / sqrtf(ssq * (1.0f / D) + EPS);
    if (h == 0 && hi == 0) RSTD2[tok] = rs;
    const float v0 = unordf(L[0] & (int)0xffffff00);
    asm volatile("s_waitcnt lgkmcnt(0)" ::: "memory");
    int ex[8]; float ew[8]; float esum = 0.f;
#pragma unroll
    for (int k = 0; k < 8; ++k) {
        const int t = (L[8 + k] & hm) | (L[k] & ~hm);
        const int c = 255 - (t & 0xff);
        const int ia = sc[c >> 4], ib = sc[16 + (c & 15)];
        ex[k] = ia * 128 + ib;
        const float e = __builtin_amdgcn_exp2f((unordf(t & (int)0xffffff00) - v0) * rs * 1.4426950408889634f);
        ew[k] = e; esum += e;
    }
    esum += __shfl_xor(esum, 32);
    const float inv = 1.0f / esum;
    unsigned short* ip = IDS + tok * 128 + h * 16 + hi * 8; float* gp = GW + tok * 128 + h * 16 + hi * 8;
    *(GAS v4u*)(ip) = (v4u){(unsigned)ex[0] | ((unsigned)ex[1] << 16), (unsigned)ex[2] | ((unsigned)ex[3] << 16), (unsigned)ex[4] | ((unsigned)ex[5] << 16), (unsigned)ex[6] | ((unsigned)ex[7] << 16)};
    *(GAS f32x4*)(gp) = (f32x4){ew[0] * inv, ew[1] * inv, ew[2] * inv, ew[3] * inv};
    *(GAS f32x4*)(gp + 4) = (f32x4){ew[4] * inv, ew[5] * inv, ew[6] * inv, ew[7] * inv};
    __syncthreads();
}
}

namespace p6 {
__device__ __forceinline__ float blo(unsigned w) { return __builtin_bit_cast(float, w << 16); }
__device__ __forceinline__ float bhi(unsigned w) { return __builtin_bit_cast(float, w & 0xffff0000u); }
__device__ __forceinline__ float gelu_fast(float x) { return x * __builtin_amdgcn_rcpf(1.0f + __builtin_amdgcn_exp2f(-2.302208198f * x * (1.0f + 0.044715f * x * x))); }
__device__ __forceinline__ unsigned idw(const v4u& a, const v4u& b, int g) { const unsigned w = g < 8 ? a[(g & 7) >> 1] : b[(g & 7) >> 1]; return (g & 1) ? (w >> 16) : (w & 0xffffu); }
__device__ __forceinline__ float wave_max(float v) {
#pragma unroll
    for (int o = 1; o < 64; o <<= 1) v = fmaxf(v, __shfl_xor(v, o));
    return v;
}
__device__ __forceinline__ unsigned q4(float a, float b, float c, float d, float inv, int bias) {
    const int qa = (int)rintf(a * inv) + bias, qb = (int)rintf(b * inv) + bias, qc = (int)rintf(c * inv) + bias, qd = (int)rintf(d * inv) + bias;
    return (unsigned)(qa & 0xff) | ((unsigned)(qb & 0xff) << 8) | ((unsigned)(qc & 0xff) << 16) | ((unsigned)(qd & 0xff) << 24);
}
__device__ __forceinline__ void qrow(const float* src, const float* gcol, unsigned char* dst, float* scale_out, size_t e, int lane, int bias) {
    f32x4 v[8]; float am = 0.f;
#pragma unroll
    for (int j = 0; j < 8; ++j) {
        v[j] = *(const GAS f32x4*)(src + e * D + j * 256 + lane * 4);
        if (gcol) { const f32x4 g = *(const GAS f32x4*)(gcol + j * 256 + lane * 4); v[j] = v[j] * g; }
        am = fmaxf(am, fmaxf(fmaxf(fabsf(v[j].x), fabsf(v[j].y)), fmaxf(fabsf(v[j].z), fabsf(v[j].w))));
    }
    am = wave_max(am);
    const float inv = am > 0.f ? 127.0f / am : 0.f;
#pragma unroll
    for (int j = 0; j < 8; ++j)
        *(GAS unsigned*)(dst + ((size_t)(2 * j + (lane >> 5)) * 16384 + e) * 128 + (lane & 31) * 4) = q4(v[j].x, v[j].y, v[j].z, v[j].w, inv, bias);
    if (lane == 0) scale_out[e] = am * (1.0f / 127.0f);
}
__device__ __forceinline__ void qx_row(const bf16* H1B, unsigned char* X8, float* SX, size_t tok, int lane) {
#pragma unroll
    for (int j = 0; j < 4; ++j) {
        const v4u x = *(const GAS v4u*)(H1B + tok * D + j * 512 + lane * 8);
        float f[8]; float am = 0.f;
#pragma unroll
        for (int k = 0; k < 4; ++k) { f[2 * k] = blo(x[k]); f[2 * k + 1] = bhi(x[k]); am = fmaxf(am, fmaxf(fabsf(f[2 * k]), fabsf(f[2 * k + 1]))); }
        am = fmaxf(am, __shfl_xor(am, 1)); am = fmaxf(am, __shfl_xor(am, 2)); am = fmaxf(am, __shfl_xor(am, 4)); am = fmaxf(am, __shfl_xor(am, 8));
        const float inv = am > 0.f ? 127.0f / am : 0.f;
        typedef unsigned u32x2v __attribute__((ext_vector_type(2)));
        u32x2v o; o.x = q4(f[0], f[1], f[2], f[3], inv, 0); o.y = q4(f[4], f[5], f[6], f[7], inv, 0);
        *(GAS u32x2v*)(X8 + tok * D + j * 512 + lane * 8) = o;
        if ((lane & 15) == 0) SX[tok * 16 + 4 * j + (lane >> 4)] = am * (1.0f / 127.0f);
    }
}

typedef int i32x16 __attribute__((ext_vector_type(16)));
typedef float f32x16v __attribute__((ext_vector_type(16)));
__device__ __forceinline__ int seli(int m, int a, int b) { return (a & m) | (b & ~m); }
__device__ __forceinline__ float self(int m, float a, float b) { return __builtin_bit_cast(float, seli(m, __builtin_bit_cast(int, a), __builtin_bit_cast(int, b))); }
__device__ __forceinline__ void usweep(const unsigned char* X8, const float* SX, const unsigned char* U8, const unsigned short* IDS, bf16* PART, int slot, int rank, int nrank, int wave, int lane) {
    const int ps = lane >> 3, ch = lane & 7;
    const int first = rank * 8 + wave, stride = nrank * 8;
    const int n = first < MREAL ? (MREAL - first + stride - 1) / stride : 0, NQ = 2 * n;
    if (NQ == 0) return;
    const int m4 = -((lane >> 2) & 1), m2 = -((lane >> 1) & 1), m1 = -(lane & 1);
#define U_LOAD(q_, I0, I1, XV, SX_, T_, SG_) do { const int qq_ = (q_) < NQ ? (q_) : NQ - 1; const int rd_ = qq_ >= n ? 1 : 0; T_ = first + (qq_ - rd_ * n) * stride; SG_ = rd_ * 8 + slot; \
        I0 = *(const GAS v4u*)(IDS + (size_t)T_ * 128 + ps * 16); I1 = *(const GAS v4u*)(IDS + (size_t)T_ * 128 + ps * 16 + 8); \
        XV = *(const GAS v4u*)(X8 + (size_t)T_ * D + SG_ * 128 + ch * 16); SX_ = SX[(size_t)T_ * 16 + SG_]; } while (0)
#define U_ISSUE(BUF, I0, I1, SG_) do { const unsigned char* tab_ = U8 + (size_t)(SG_) * 16384 * 128 + ch * 16; \
        _Pragma("unroll") for (int g = 0; g < 16; ++g) BUF[g] = *(const GAS v4u*)(tab_ + (size_t)idw(I0, I1, g) * 128); } while (0)
#define U_FINISH(BUF, XV, SX_, T_, SG_) do { i32x16 d; \
        _Pragma("unroll") for (int g = 0; g < 16; ++g) { int a_ = __builtin_amdgcn_sdot4((int)BUF[g][0], (int)XV[0], 0, false); a_ = __builtin_amdgcn_sdot4((int)BUF[g][1], (int)XV[1], a_, false); \
            a_ = __builtin_amdgcn_sdot4((int)BUF[g][2], (int)XV[2], a_, false); a_ = __builtin_amdgcn_sdot4((int)BUF[g][3], (int)XV[3], a_, false); d[g] = a_; } \
        int r8[8], r4[4], r2[2]; \
        _Pragma("unroll") for (int k = 0; k < 8; ++k) r8[k] = seli(m4, d[8 + k], d[k]) + __shfl_xor(seli(m4, d[k], d[8 + k]), 4); \
        _Pragma("unroll") for (int k = 0; k < 4; ++k) r4[k] = seli(m2, r8[4 + k], r8[k]) + __shfl_xor(seli(m2, r8[k], r8[4 + k]), 2); \
        _Pragma("unroll") for (int k = 0; k < 2; ++k) r2[k] = seli(m1, r4[2 + k], r4[k]) + __shfl_xor(seli(m1, r4[k], r4[2 + k]), 1); \
        *(GAS unsigned*)(PART + ((size_t)(SG_) * MREAL + T_) * 128 + ps * 16 + 2 * ch) = pk2((float)r2[0] * SX_, (float)r2[1] * SX_); } while (0)
    v4u bufA[16], bufB[16];
    v4u a0, a1, ax, b0, b1, bx, c0, c1, cx; float as, bs, cs; int at, bt, ct, ag, bg, cg;
    U_LOAD(0, a0, a1, ax, as, at, ag); U_LOAD(1, b0, b1, bx, bs, bt, bg);
    U_ISSUE(bufA, a0, a1, ag);
    for (int q = 0; q < NQ; q += 2) {
        U_ISSUE(bufB, b0, b1, bg);
        U_LOAD(q + 2, c0, c1, cx, cs, ct, cg);
        U_FINISH(bufA, ax, as, at, ag);
        U_ISSUE(bufA, c0, c1, cg);
        U_LOAD(q + 3, a0, a1, ax, as, at, ag);
        U_FINISH(bufB, bx, bs, bt, bg);
        { const v4u t0 = a0, t1 = a1, tx = ax; const float ts = as; const int tt = at, tg = ag;
          a0 = c0; a1 = c1; ax = cx; as = cs; at = ct; ag = cg; b0 = t0; b1 = t1; bx = tx; bs = ts; bt = tt; bg = tg; }
    }
#undef U_LOAD
#undef U_ISSUE
#undef U_FINISH
}
__device__ __forceinline__ void wreduce(const bf16* PART, const float* GW, const float* RSTD2, const unsigned short* IDS, const float* SCU, const float* SCV, float* W, float* WSUM, size_t gt, size_t NT) {
    for (size_t i8 = gt; i8 < (size_t)MREAL * 128 / 8; i8 += NT) {
        float s[8];
#pragma unroll
        for (int k = 0; k < 8; ++k) s[k] = 0.f;
#pragma unroll 8
        for (int sg = 0; sg < 16; ++sg) {
            const v4u p = *(const GAS v4u*)(PART + (size_t)sg * MREAL * 128 + i8 * 8);
#pragma unroll
            for (int k = 0; k < 4; ++k) { s[2 * k] += blo(p[k]); s[2 * k + 1] += bhi(p[k]); }
        }
        const float rs = RSTD2[i8 >> 4];
        const v4u idv = *(const GAS v4u*)(IDS + i8 * 8);
        const f32x4 g0 = *(const GAS f32x4*)(GW + i8 * 8), g1 = *(const GAS f32x4*)(GW + i8 * 8 + 4);
        float w[8]; float tot = 0.f;
#pragma unroll
        for (int k = 0; k < 8; ++k) {
            const unsigned e = (k & 1) ? (idv[k >> 1] >> 16) : (idv[k >> 1] & 0xffffu);
            const float g = k < 4 ? g0[k & 3] : g1[k & 3];
            w[k] = g * gelu_fast(rs * SCU[e] * s[k]) * SCV[e]; tot += w[k];
        }
        *(GAS f32x4*)(W + i8 * 8) = (f32x4){w[0], w[1], w[2], w[3]};
        *(GAS f32x4*)(W + i8 * 8 + 4) = (f32x4){w[4], w[5], w[6], w[7]};
        tot += __shfl_xor(tot, 1); tot += __shfl_xor(tot, 2); tot += __shfl_xor(tot, 4); tot += __shfl_xor(tot, 8);
        if ((i8 & 15) == 0) WSUM[i8 >> 4] = 128.0f * tot;
    }
}
__device__ __forceinline__ void vsweep(const bf16* H1B, const unsigned char* V8, const unsigned short* IDS, const float* W, const float* WSUM, bf16* Z, float* SSF, int slot, int rank, int nrank, int wave, int lane) {
    const int ps = lane >> 3, ch = lane & 7;
    const int first = rank * 8 + wave, stride = nrank * 8;
    const int n = first < MREAL ? (MREAL - first + stride - 1) / stride : 0, NQ = 2 * n;
    if (NQ == 0) return;
    const int m32 = -((lane >> 5) & 1), m16 = -((lane >> 4) & 1), m8 = -((lane >> 3) & 1);
#define V_LOAD(q_, I0, I1, T_, SG_) do { const int qq_ = (q_) < NQ ? (q_) : NQ - 1; const int rd_ = qq_ >= n ? 1 : 0; T_ = first + (qq_ - rd_ * n) * stride; SG_ = rd_ * 8 + slot; \
        I0 = *(const GAS v4u*)(IDS + (size_t)T_ * 128 + ps * 16); I1 = *(const GAS v4u*)(IDS + (size_t)T_ * 128 + ps * 16 + 8); } while (0)
#define V_ISSUE(BUF, WV, I0, I1, T_, SG_) do { const unsigned char* tab_ = V8 + (size_t)(SG_) * 16384 * 128 + ch * 16; \
        _Pragma("unroll") for (int g = 0; g < 16; ++g) BUF[g] = *(const GAS v4u*)(tab_ + (size_t)idw(I0, I1, g) * 128); \
        _Pragma("unroll") for (int q4_ = 0; q4_ < 4; ++q4_) WV[q4_] = *(const GAS f32x4*)(W + (size_t)T_ * 128 + ps * 16 + 4 * q4_); } while (0)
#define V_FINISH(BUF, WV, T_, SG_) do { f32x16v acc = {0.f, 0.f, 0.f, 0.f, 0.f, 0.f, 0.f, 0.f, 0.f, 0.f, 0.f, 0.f, 0.f, 0.f, 0.f, 0.f}; \
        const unsigned hx_ = *(const GAS unsigned*)(H1B + (size_t)T_ * D + (SG_) * 128 + ch * 16 + 2 * ps); const float wsum_ = WSUM[T_]; \
        _Pragma("unroll") for (int g = 0; g < 16; ++g) { const float w_ = WV[g >> 2][g & 3]; \
            _Pragma("unroll") for (int k = 0; k < 4; ++k) { const unsigned vv_ = BUF[g][k]; \
                acc[4 * k + 0] += w_ * (float)(vv_ & 0xffu); acc[4 * k + 1] += w_ * (float)((vv_ >> 8) & 0xffu); acc[4 * k + 2] += w_ * (float)((vv_ >> 16) & 0xffu); acc[4 * k + 3] += w_ * (float)(vv_ >> 24); } } \
        float r8[8], r4[4], r2[2]; \
        _Pragma("unroll") for (int k = 0; k < 8; ++k) r8[k] = self(m32, acc[8 + k], acc[k]) + __shfl_xor(self(m32, acc[k], acc[8 + k]), 32); \
        _Pragma("unroll") for (int k = 0; k < 4; ++k) r4[k] = self(m16, r8[4 + k], r8[k]) + __shfl_xor(self(m16, r8[k], r8[4 + k]), 16); \
        _Pragma("unroll") for (int k = 0; k < 2; ++k) r2[k] = self(m8, r4[2 + k], r4[k]) + __shfl_xor(self(m8, r4[k], r4[2 + k]), 8); \
        const float z0_ = r2[0] + blo(hx_) - wsum_, z1_ = r2[1] + bhi(hx_) - wsum_; \
        *(GAS unsigned*)(Z + (size_t)T_ * D + (SG_) * 128 + ch * 16 + 2 * ps) = pk2(z0_, z1_); \
        float ss_ = z0_ * z0_ + z1_ * z1_; \
        _Pragma("unroll") for (int o = 1; o < 64; o <<= 1) ss_ += __shfl_xor(ss_, o); \
        if (lane == 0) SSF[(size_t)T_ * 16 + (SG_)] = ss_; } while (0)
    v4u bufA[16], bufB[16]; f32x4 wA[4], wB[4];
    v4u a0, a1, b0, b1, c0, c1; int at, bt, ct, ag, bg, cg;
    V_LOAD(0, a0, a1, at, ag); V_LOAD(1, b0, b1, bt, bg);
    V_ISSUE(bufA, wA, a0, a1, at, ag);
    for (int q = 0; q < NQ; q += 2) {
        V_ISSUE(bufB, wB, b0, b1, bt, bg);
        V_LOAD(q + 2, c0, c1, ct, cg);
        V_FINISH(bufA, wA, at, ag);
        V_ISSUE(bufA, wA, c0, c1, ct, cg);
        V_LOAD(q + 3, a0, a1, at, ag);
        V_FINISH(bufB, wB, bt, bg);
        { const v4u t0 = a0, t1 = a1; const int tt = at, tg = ag; a0 = c0; a1 = c1; at = ct; ag = cg; b0 = t0; b1 = t1; bt = tt; bg = tg; }
    }
#undef V_LOAD
#undef V_ISSUE
#undef V_FINISH
}
__device__ __forceinline__ void final_row(const bf16* Z, const float* SSF, const float* fg, float* out, size_t tok, int lane) {
    v4u z[4];
#pragma unroll
    for (int j = 0; j < 4; ++j) z[j] = *(const GAS v4u*)(Z + tok * D + j * 512 + lane * 8);
    float ss = 0.f;
#pragma unroll
    for (int k = 0; k < 4; ++k) { const f32x4 v = *(const GAS f32x4*)(SSF + tok * 16 + 4 * k); ss += (v.x + v.y) + (v.z + v.w); }
    const float rf = 1.0f / sqrtf(ss * (1.0f / D) + EPS);
#pragma unroll
    for (int j = 0; j < 4; ++j) {
        const f32x4 ga = *(const GAS f32x4*)(fg + j * 512 + lane * 8), gb = *(const GAS f32x4*)(fg + j * 512 + lane * 8 + 4);
        *(GAS f32x4*)(out + tok * D + j * 512 + lane * 8) = (f32x4){blo(z[j][0]) * rf * ga.x, bhi(z[j][0]) * rf * ga.y, blo(z[j][1]) * rf * ga.z, bhi(z[j][1]) * rf * ga.w};
        *(GAS f32x4*)(out + tok * D + j * 512 + lane * 8 + 4) = (f32x4){blo(z[j][2]) * rf * gb.x, bhi(z[j][2]) * rf * gb.y, blo(z[j][3]) * rf * gb.z, bhi(z[j][3]) * rf * gb.w};
    }
}
}

struct Frame {
    LAS unsigned char* lds;
    volatile LAS unsigned* MISC;
    gu32* ctl;
    int tid, lane, wave, vcu, G;
};
__device__ __forceinline__ float wave_sum(float v) {
#pragma unroll
    for (int o = 1; o < 64; o <<= 1) v += __shfl_xor(v, o);
    return v;
}
__device__ __forceinline__ void p0_transpose_item(const float* W, int K, int N, bf16* WT, const float* g0, const float* g1, int ksplit, LAS float* scr, int item, int lane) {
    const int nblk = N / 32, kb = item / nblk, nb = item % nblk, k0 = 64 * kb, n0 = 32 * nb;
#pragma unroll 8
    for (int i = 0; i < 32; ++i) { const int kk = 2 * i + (lane >> 5); const int kg = k0 + kk; const float gv = kg < ksplit ? g0[kg] : g1[kg - ksplit];
        scr[kk * 33 + (lane & 31)] = W[(size_t)kg * N + n0 + (lane & 31)] * gv; }
    LDS_WAIT(); asm volatile("" ::: "memory");
    const int c = lane & 7;
#pragma unroll
    for (int j = 0; j < 4; ++j) { const int n = (lane >> 3) + 8 * j; const LAS float* s = scr + (8 * c) * 33 + n;
        v4u o; o.x = pk2(s[0 * 33], s[1 * 33]); o.y = pk2(s[2 * 33], s[3 * 33]); o.z = pk2(s[4 * 33], s[5 * 33]); o.w = pk2(s[6 * 33], s[7 * 33]);
        *(GAS v4u*)(WT + (size_t)(n0 + n) * K + k0 + 8 * c) = o; }
    LDS_WAIT(); asm volatile("" ::: "memory");
}
__device__ __forceinline__ void p0_row(const float* xrow, bf16* orow, float* rstd_out, int lane) {
    const GAS f32x4* xr = (const GAS f32x4*)xrow + lane;
    f32x4 v[8]; float s = 0.f;
#pragma unroll
    for (int j = 0; j < 8; ++j) { v[j] = xr[64 * j]; s += (v[j].x * v[j].x + v[j].y * v[j].y) + (v[j].z * v[j].z + v[j].w * v[j].w); }
    s = wave_sum(s);
    GAS unsigned long long* o8 = (GAS unsigned long long*)orow + lane;
#pragma unroll
    for (int j = 0; j < 8; ++j) o8[64 * j] = (unsigned long long)pk2(v[j].x, v[j].y) | ((unsigned long long)pk2(v[j].z, v[j].w) << 32);
    if (lane == 0) *rstd_out = 1.0f / sqrtf(s * (1.0f / D) + EPS);
}
__device__ __forceinline__ void p0_cvt8_sliced(const float* src, bf16* dst, const float* gcol, size_t idx8) {
    const f32x4 a = *(const GAS f32x4*)(src + idx8 * 8), b = *(const GAS f32x4*)(src + idx8 * 8 + 4);
    f32x4 ga = {1.f, 1.f, 1.f, 1.f}, gb = {1.f, 1.f, 1.f, 1.f};
    const int c = (int)((idx8 * 8) & (D - 1)); const size_t e = (idx8 * 8) >> 11;
    if (gcol) { ga = *(const GAS f32x4*)(gcol + c); gb = *(const GAS f32x4*)(gcol + c + 4); }
    v4u o; o.x = pk2(a.x * ga.x, a.y * ga.y); o.y = pk2(a.z * ga.z, a.w * ga.w); o.z = pk2(b.x * gb.x, b.y * gb.y); o.w = pk2(b.z * gb.z, b.w * gb.w);
    *(GAS v4u*)(dst + ((size_t)(c >> 6) * 16384 + e) * 64 + (c & 63)) = o;
}
__device__ __forceinline__ void p0_cvt8(const float* src, bf16* dst, const float* gcol, size_t idx8) {
    const f32x4 a = *(const GAS f32x4*)(src + idx8 * 8), b = *(const GAS f32x4*)(src + idx8 * 8 + 4);
    f32x4 ga = {1.f, 1.f, 1.f, 1.f}, gb = {1.f, 1.f, 1.f, 1.f};
    if (gcol) { const int c = (int)((idx8 * 8) & (D - 1)); ga = *(const GAS f32x4*)(gcol + c); gb = *(const GAS f32x4*)(gcol + c + 4); }
    v4u o; o.x = pk2(a.x * ga.x, a.y * ga.y); o.y = pk2(a.z * ga.z, a.w * ga.w); o.z = pk2(b.x * gb.x, b.y * gb.y); o.w = pk2(b.z * gb.z, b.w * gb.w);
    *(GAS v4u*)(dst + idx8 * 8) = o;
}

struct Args { const float* in[22]; float* out; unsigned char* ws; int ph_lo, ph_hi, rep_mask, pad; };

__global__ void __launch_bounds__(NWAVES * 64, 2) fwd(Args args) {
    extern __shared__ __attribute__((aligned(16))) unsigned char lds[];
    Frame F;
    F.lds = (LAS unsigned char*)lds;
    F.MISC = (volatile LAS unsigned*)(F.lds + MISC_OFF);
    F.tid = threadIdx.x; F.lane = F.tid & 63; F.wave = __builtin_amdgcn_readfirstlane(F.tid >> 6);
    F.G = gridDim.x; { const int bx = blockIdx.x; F.vcu = (F.G % 8 == 0) ? (bx % 8) * (F.G / 8) + bx / 8 : bx; }
    unsigned char* ws = args.ws;
    F.ctl = (gu32*)(ws + WS_CTL);
    for (int u = F.tid; u < (LDS_BYTES - LDSCTL_OFF) / 4; u += NWAVES * 64) ((LAS unsigned*)(F.lds + LDSCTL_OFF))[u] = 0u;
    __syncthreads();
    XcdBarrier bar = xcd_barrier_post((unsigned*)(F.ctl + CW_BAR), F.MISC + 8);
    const int lo = args.ph_lo, hi = args.ph_hi;
#define IN(k) (lo <= (k) && (k) < hi)
#define BOTH(k) (IN(k) && IN((k) + 1))
#ifndef PROBE_PH
#define PROBE_PH (-1)
#endif
#define REP(k) for (int rep_ = 0; rep_ < ((k) == PROBE_PH ? 2 : 1); ++rep_)

    const float* x = args.in[0]; const float* meta = args.in[1]; const float* norm_mix_g = args.in[2]; const float* w_in = args.in[3]; const float* b_in = args.in[4];
    const float* gn_attn_g = args.in[13]; const float* gn_lru_g = args.in[14]; const float* w_out = args.in[15]; const float* norm_ffn_g = args.in[16];
    const float* peer_wq = args.in[17]; const float* sub_keys = args.in[18]; const float* peer_u = args.in[19]; const float* peer_v = args.in[20];
    bf16* W1T = (bf16*)(ws + WS_W1T); bf16* W2T = (bf16*)(ws + WS_W2T); bf16* W3T = (bf16*)(ws + WS_W3T); bf16* SKB = (bf16*)(ws + WS_SKB);
    float* RSTD1 = (float*)(ws + WS_RSTD1);
    unsigned char* U8 = ws + WS_U8; unsigned char* V8 = ws + WS_V8; unsigned char* X8 = ws + WS_X8; float* SX = (float*)(ws + WS_SX); float* SCU = (float*)(ws + WS_SCU); float* SCV = (float*)(ws + WS_SCV); float* WSUM = (float*)(ws + WS_WSUM);
    bf16* A1 = (bf16*)(ws + WS_A1);
    bf16* QB = (bf16*)(ws + WS_Q); bf16* KVB = (bf16*)(ws + WS_KV); bf16* XBB = (bf16*)(ws + WS_XB); bf16* GTB = (bf16*)(ws + WS_GT);

    if (IN(0)) { REP(0) {
        LAS float* scr = (LAS float*)(F.lds + RING_OFF + F.wave * 16384);
        const int gw = F.vcu * NWAVES + F.wave, NGW = F.G * NWAVES;
        constexpr int I_1 = (D / 64) * (IND / 32), I_2 = (D / 64) * (D / 32), I_3 = I_2;
        for (int it = gw; it < I_1 + I_2 + I_3; it += NGW) {
            int r = it;
            if (r < I_1) { p0_transpose_item(w_in, D, IND, W1T, norm_mix_g, norm_mix_g, D, scr, r, F.lane); continue; } r -= I_1;
            if (r < I_2) { p0_transpose_item(w_out, D, D, W2T, gn_attn_g, gn_lru_g, 1024, scr, r, F.lane); continue; } r -= I_2;
            p0_transpose_item(peer_wq, D, D, W3T, norm_ffn_g, norm_ffn_g, D, scr, r, F.lane);
        }
        for (int m = gw; m < MREAL + NMETA; m += NGW) {
            const float* src = m < MREAL ? x + (size_t)m * D : meta + (size_t)(m - MREAL) * D;
            p0_row(src, A1 + (size_t)m * D, RSTD1 + m, F.lane);
        }
        {
            const size_t gt = (size_t)gw * 64 + F.lane, NT = (size_t)NGW * 64;
            for (size_t i = gt; i < (size_t)(8 * 2 * 128 * 128) / 8; i += NT) p0_cvt8(sub_keys, SKB, nullptr, i);
            for (int e = gw; e < 16384; e += NGW) { p6::qrow(peer_u, norm_ffn_g, U8, SCU, (size_t)e, F.lane, 0); p6::qrow(peer_v, nullptr, V8, SCV, (size_t)e, F.lane, 128); }
        } }
        if (BOTH(0)) xcd_barrier(bar);
    }
    if (IN(1)) {
        pg8::Gemm g{A1, W1T, MPAD, IND, D};
        pg8::Order1 S{F.G, (int)blockIdx.x};
        pg8::Epi1 E{QB, KVB, XBB, GTB, RSTD1, b_in};
        REP(1) pg8::gemm_phase<pg8::Epi1, pg8::Order1, true, true>(F.lds + RING_OFF, g, S, E);
        if (BOTH(1)) xcd_barrier(bar);
    }
    if (IN(2)) {
        bf16* MIX = (bf16*)(ws + WS_A1); float* SSA = (float*)(ws + WS_SSA); float* SSL = (float*)(ws + WS_SSL);
        const p2::LruP LP{args.in[6], args.in[7], args.in[8], args.in[9], args.in[10], args.in[11], args.in[12]};
        {
        REP(20) for (int u = (int)blockIdx.x; u < 256; u += F.G) p2::lru_unit(F.lds + RING_OFF, u >> 5, (u >> 1) & 15, u & 1, XBB, GTB, LP, MIX, SSL, F.tid);
        REP(21) for (int a = (int)blockIdx.x; a < 256; a += F.G) p2::attn_unit(F.lds + RING_OFF, a >> 5, (a >> 1) & 15, a & 1, QB, KVB, args.in[5], MIX, SSA, F.tid);
        }
        if (BOTH(2)) xcd_barrier(bar);
    }
    if (IN(3)) {
        bf16* MIX = (bf16*)(ws + WS_A1); const float* SSA = (const float*)(ws + WS_SSA); const float* SSL = (const float*)(ws + WS_SSL);
        bf16* H1B = (bf16*)(ws + WS_H1); float* SS2 = (float*)(ws + WS_SS2);
        pg8::Order2 S{F.G, (int)blockIdx.x};
        LAS float* tbl = (LAS float*)(F.lds + LDSCTL_OFF + 1024);
        pg8::Unit u0{0, 0};
        for (int i = 0; i < 2; ++i) {
            pg8::Unit u; if (!S.next(i, u)) break; if (i == 0) u0 = u;
            if (F.tid < 256) {
                const size_t row = (size_t)u.pm * 256 + F.tid; float sa = 0.f, sl = 0.f;
#pragma unroll
                for (int k = 0; k < 4; ++k) { const f32x4 v = *(const GAS f32x4*)(SSA + row * 16 + 4 * k); sa += (v.x + v.y) + (v.z + v.w); }
#pragma unroll
                for (int k = 0; k < 8; ++k) { const f32x4 v = *(const GAS f32x4*)(SSL + row * 32 + 4 * k); sl += (v.x + v.y) + (v.z + v.w); }
                const float ra = 1.0f / sqrtf(sa * (1.0f / 1024) + EPS), rl = 1.0f / sqrtf(sl * (1.0f / 1024) + EPS);
                tbl[(i * 256 + F.tid) * 2] = ra / rl; tbl[(i * 256 + F.tid) * 2 + 1] = rl;
            }
        }
        __syncthreads();
        pg8::Gemm g{MIX, W2T, MREAL, D, D};
        pg8::Epi2 E{H1B, x, SS2, (const LAS float*)tbl, u0.pm};
        REP(3) pg8::gemm_phase<pg8::Epi2, pg8::Order2, true, true>(F.lds + RING_OFF, g, S, E);
        if (BOTH(3)) xcd_barrier(bar);
    }
    if (IN(4)) {
        bf16* H1B = (bf16*)(ws + WS_H1); bf16* QPB = (bf16*)(ws + WS_A1);
        pg8::Order2 S{F.G, (int)blockIdx.x};
        pg8::Gemm g{H1B, W3T, MREAL, D, D};
        pg8::Epi3 E{QPB};
        REP(4) pg8::gemm_phase<pg8::Epi3, pg8::Order2, true, true>(F.lds + RING_OFF, g, S, E);
        if (BOTH(4)) xcd_barrier(bar);
    }
    if (IN(5)) {
        const bf16* QPB = (const bf16*)(ws + WS_A1); const float* SS2 = (const float*)(ws + WS_SS2);
        unsigned short* IDS = (unsigned short*)(ws + WS_IDS); float* GW = (float*)(ws + WS_GW); float* RSTD2 = (float*)(ws + WS_RSTD2);
        const bf16* H1B = (const bf16*)(ws + WS_H1);
        REP(5) for (int u = (int)blockIdx.x; u < 512; u += F.G) {
            p5::retr_unit(F.lds + RING_OFF, u & 7, u >> 3, QPB, SKB, SS2, IDS, GW, RSTD2, F.tid);
            for (int tt = (u & 7); tt < 32; tt += 8) p6::qx_row(H1B, X8, SX, (size_t)(u >> 3) * 256 + F.wave * 32 + tt, F.lane);
        }
        if (BOTH(5)) xcd_barrier(bar);
    }
    {
        const bf16* H1B = (const bf16*)(ws + WS_H1); const unsigned short* IDS = (const unsigned short*)(ws + WS_IDS); const float* GW = (const float*)(ws + WS_GW);
        const float* RSTD2 = (const float*)(ws + WS_RSTD2); bf16* PART = (bf16*)(ws + WS_PART); float* WB = (float*)(ws + WS_W); bf16* ZB = (bf16*)(ws + WS_Z); float* SSF = (float*)(ws + WS_SSL);
        const int slot = (int)blockIdx.x & 7, rank = (int)blockIdx.x >> 3, nrank = (F.G - slot + 7) >> 3;
        const int gw = F.vcu * NWAVES + F.wave, NGW = F.G * NWAVES;
        if (IN(6)) { REP(6) p6::usweep(X8, SX, U8, IDS, PART, slot, rank, nrank, F.wave, F.lane); if (BOTH(6)) xcd_barrier(bar); }
        if (IN(7)) { REP(7) p6::wreduce(PART, GW, RSTD2, IDS, SCU, SCV, WB, WSUM, (size_t)gw * 64 + F.lane, (size_t)NGW * 64); if (BOTH(7)) xcd_barrier(bar); }
        if (IN(8)) { REP(8) p6::vsweep(H1B, V8, IDS, WB, WSUM, ZB, SSF, slot, rank, nrank, F.wave, F.lane); if (BOTH(8)) xcd_barrier(bar); }
        if (IN(9)) { REP(9) for (int t = gw; t < MREAL; t += NGW) p6::final_row(ZB, SSF, args.in[21], args.out, (size_t)t, F.lane); }
    }
#undef IN
#undef BOTH
}

extern "C" void kernel_launch(void* const* d_in, const int* in_sizes, int n_in, void* d_out, int out_size, void* d_ws, size_t ws_size, hipStream_t stream) {
    static int grid = 0;
    if (grid == 0) {
        int dev = 0, cus = 0;
        if (hipGetDevice(&dev) != hipSuccess || hipDeviceGetAttribute(&cus, hipDeviceAttributeMultiprocessorCount, dev) != hipSuccess) { fprintf(stderr, "kernel_launch: device query failed\n"); grid = -1; return; }
        if (hipFuncSetAttribute((const void*)fwd, hipFuncAttributeMaxDynamicSharedMemorySize, LDS_BYTES) != hipSuccess) { fprintf(stderr, "kernel_launch: hipFuncSetAttribute failed\n"); grid = -1; return; }
        int per_cu = 0;
        if (hipOccupancyMaxActiveBlocksPerMultiprocessor(&per_cu, (const void*)fwd, NWAVES * 64, LDS_BYTES) != hipSuccess || per_cu < 1) fprintf(stderr, "kernel_launch: occupancy query says %d\n", per_cu);
        (void)hipGetLastError();
        grid = cus;
        if (ws_size < WS_END) { fprintf(stderr, "kernel_launch: ws too small %zu\n", ws_size); grid = -1; return; }
    }
    if (grid < 0) return;
    (void)hipMemsetAsync((char*)d_ws + WS_CTL, 0, CTL_ZERO_BYTES, stream);
    Args a{};
    for (int i = 0; i < 22; ++i) a.in[i] = (const float*)d_in[i];
    a.out = (float*)d_out; a.ws = (unsigned char*)d_ws; a.ph_lo = 0; a.ph_hi = 10;
    hipLaunchKernelGGL(fwd, dim3(grid), dim3(NWAVES * 64), LDS_BYTES, stream, a);
}
```

```cpp
#include <hip/hip_runtime.h>
#include <cstdio>
#include <cstdint>
#include <math.h>

#define D 2048
#define NB 8
#define SEQ 2048
#define NMETA 16
#define TT (SEQ + NMETA)
#define MR (NB * TT)
#define MREAL (NB * SEQ)
#define MPAD (MREAL + 256)
#define QD 1024
#define KVD 128
#define LW 1024
#define IND 3328
#define EPS 1e-6f
#define QSCALE (0.125f * 1.4426950408889634f)
#define GAS __attribute__((address_space(1)))
#define LAS __attribute__((address_space(3)))
namespace pg8 {
#define PG8_LAS __attribute__((address_space(3)))
typedef unsigned short bf16_t;
typedef short bf16x8 __attribute__((ext_vector_type(8)));
typedef float f32x4 __attribute__((ext_vector_type(4)));
typedef unsigned u32x4 __attribute__((ext_vector_type(4)));
constexpr int BM = 256, BK = 64, HALF = 128, HTB = HALF * BK * 2  , STAGE_BYTES = 8 * HTB, NXCD = 8, WGM = 8;

__host__ __device__ __forceinline__ int lds_byte(int r, int c) { const int st = (r >> 4) * 2 + (c >> 5), rr = r & 15, cc = c & 31, ob = rr * 64 + cc * 2; return st * 1024 + (ob ^ (((ob >> 9) & 1) << 5)); }
__host__ __device__ __forceinline__ void stage_rc(int b, int& R, int& C) { const int st = b / 1024, sb = b % 1024, swz = sb ^ (((sb >> 9) & 1) << 5); R = (st >> 1) * 16 + swz / 64; C = (st & 1) * 32 + (swz % 64) / 2; }
__host__ __device__ __forceinline__ int perm32(int rho) { const int n = rho >> 4, i = rho & 15; return 8 * (i >> 2) + 4 * n + (i & 3); }

struct Unit { int pm, pn; };
struct Gemm { const bf16_t* A; const bf16_t* Bt; int M, N, K; };

struct StaticOrder {
    int nM, nN, nwg, G, c;
    __host__ __device__ void init(int M, int N, int G_, int c_) { nM = M / BM; nN = N / BM; nwg = nM * nN; G = G_; c = c_; }
    __host__ __device__ bool next(int i, Unit& u) const {
        const long L = (long)i * G + c; if (L >= nwg) return false;
        int wgid = (int)L; { const int q = nwg / NXCD, r = nwg % NXCD, xcd = wgid % NXCD, off = wgid / NXCD; wgid = (xcd < r ? xcd * (q + 1) : r * (q + 1) + (xcd - r) * q) + off; }
        const int nig = WGM * nN, gid = wgid / nig, fm = gid * WGM, gsz = (nM - fm) < WGM ? (nM - fm) : WGM;
        u.pm = fm + ((wgid % nig) % gsz); u.pn = (wgid % nig) / gsz; return true;
    }
    __device__ __forceinline__ void a_ready(const Unit&) const {}
    __device__ __forceinline__ void done(const Unit&) const {}
};

__device__ __forceinline__ unsigned cvt_pk_bf16(float lo, float hi) { unsigned r; asm volatile("v_cvt_pk_bf16_f32 %0, %1, %2" : "=v"(r) : "v"(lo), "v"(hi)); return r; }
typedef unsigned u32x2 __attribute__((ext_vector_type(2)));
struct Order1 {
    int G, c;
    __device__ __forceinline__ bool next(int i, Unit& u) const {
        const int L = i * G + c; if (L >= 837) return false;
        if (L >= 832) { u.pm = 64; u.pn = 4 + (L - 832); return true; }
        const int nwg = 832, nN = 13;
        int wgid = L; { const int q = nwg / NXCD, xcd = wgid % NXCD, off = wgid / NXCD; wgid = xcd * q + off; }
        const int nig = WGM * nN, gid = wgid / nig, fm = gid * WGM;
        u.pm = fm + ((wgid % nig) % WGM); u.pn = (wgid % nig) / WGM; return true;
    }
    __device__ __forceinline__ void a_ready(const Unit&) const {}
    __device__ __forceinline__ void done(const Unit&) const {}
};
struct Order2 {
    int G, c;
    __device__ __forceinline__ bool next(int i, Unit& u) const {
        const int L = i * G + c; if (L >= 512) return false;
        const int nwg = 512, nN = 8;
        int wgid = L; { const int q = nwg / NXCD, xcd = wgid % NXCD, off = wgid / NXCD; wgid = xcd * q + off; }
        const int nig = WGM * nN, gid = wgid / nig, fm = gid * WGM;
        u.pm = fm + ((wgid % nig) % WGM); u.pn = (wgid % nig) / WGM; return true;
    }
    __device__ __forceinline__ void a_ready(const Unit&) const {}
    __device__ __forceinline__ void done(const Unit&) const {}
};

struct Epi1 {
    static constexpr bool PERM = true, AFTER_DRAIN = false, MIDK = false;
    bf16_t *Q, *KV, *XB, *GT; const float* rstd; const float* bias;
    __device__ __forceinline__ void midk(f32x4 (&acc)[2][2][4][2], const Unit& u, int wr, int wc, int fr, int fq) const {}
    __device__ __forceinline__ void operator()(const f32x4 (&acc)[2][2][4][2], const Unit& u, int wr, int wc, int fr, int fq) const {
        const int row0 = u.pm * BM + wr * 64 + fr;
        bf16_t* base; int ldc, colb; float sc = 1.f;
        if (u.pn < 4) { base = Q; ldc = 1024; colb = u.pn * BM; sc = QSCALE; }
        else if (u.pn == 4) { base = KV; ldc = 256; colb = 0; }
        else if (u.pn < 9) { base = XB; ldc = 1024; colb = (u.pn - 5) * BM; }
        else { base = GT; ldc = 1024; colb = (u.pn - 9) * BM; }
        const int col0 = colb + wc * 32 + 8 * fq, bcol0 = u.pn * BM + wc * 32 + 8 * fq;
        f32x4 bv[2][2];
#pragma unroll
        for (int bj = 0; bj < 2; ++bj)
#pragma unroll
            for (int n = 0; n < 2; ++n) bv[bj][n] = *(const f32x4*)(bias + bcol0 + bj * HALF + 4 * n);
#pragma unroll
        for (int ai = 0; ai < 2; ++ai)
#pragma unroll
            for (int m = 0; m < 4; ++m) {
                const int row = row0 + ai * HALF + m * 16; const float rs = rstd[row];
                bf16_t* rowp = base + (size_t)row * ldc + col0;
#pragma unroll
                for (int bj = 0; bj < 2; ++bj) {
                    f32x4 v0 = (acc[ai][bj][m][0] * rs + bv[bj][0]) * sc, v1 = (acc[ai][bj][m][1] * rs + bv[bj][1]) * sc;
                    u32x4 w; w.x = cvt_pk_bf16(v0[0], v0[1]); w.y = cvt_pk_bf16(v0[2], v0[3]); w.z = cvt_pk_bf16(v1[0], v1[1]); w.w = cvt_pk_bf16(v1[2], v1[3]);
                    *(u32x4*)(rowp + bj * HALF) = w; } }
    }
};
struct Epi2 {
    static constexpr bool PERM = true, AFTER_DRAIN = false, MIDK = true;
    bf16_t* H1; const float* x; float* SS2; const LAS float* tbl; int pm0;
    __device__ __forceinline__ void midk(f32x4 (&acc)[2][2][4][2], const Unit& u, int wr, int wc, int fr, int fq) const {
        const LAS float* t = tbl + (u.pm == pm0 ? 0 : 512);
#pragma unroll
        for (int ai = 0; ai < 2; ++ai)
#pragma unroll
            for (int m = 0; m < 4; ++m) { const float ra = t[(ai * HALF + wr * 64 + m * 16 + fr) * 2];
#pragma unroll
                for (int bj = 0; bj < 2; ++bj)
#pragma unroll
                    for (int n = 0; n < 2; ++n) acc[ai][bj][m][n] = acc[ai][bj][m][n] * ra; }
    }
    __device__ __forceinline__ void operator()(const f32x4 (&acc)[2][2][4][2], const Unit& u, int wr, int wc, int fr, int fq) const {
        const LAS float* t = tbl + (u.pm == pm0 ? 0 : 512);
        const int col0 = u.pn * BM + wc * 32 + 8 * fq;
#pragma unroll
        for (int ai = 0; ai < 2; ++ai)
#pragma unroll
            for (int m = 0; m < 4; ++m) {
                const int rl = ai * HALF + wr * 64 + m * 16 + fr; const size_t row = (size_t)u.pm * BM + rl; const float rs = t[rl * 2 + 1];
                float ss = 0.f;
#pragma unroll
                for (int bj = 0; bj < 2; ++bj) {
                    const f32x4 x0 = *(const f32x4*)(x + row * 2048 + col0 + bj * HALF), x1 = *(const f32x4*)(x + row * 2048 + col0 + bj * HALF + 4);
                    const f32x4 v0 = acc[ai][bj][m][0] * rs + x0, v1 = acc[ai][bj][m][1] * rs + x1;
                    ss += (v0[0] * v0[0] + v0[1] * v0[1]) + (v0[2] * v0[2] + v0[3] * v0[3]) + (v1[0] * v1[0] + v1[1] * v1[1]) + (v1[2] * v1[2] + v1[3] * v1[3]);
                    u32x4 w; w.x = cvt_pk_bf16(v0[0], v0[1]); w.y = cvt_pk_bf16(v0[2], v0[3]); w.z = cvt_pk_bf16(v1[0], v1[1]); w.w = cvt_pk_bf16(v1[2], v1[3]);
                    *(u32x4*)(H1 + row * 2048 + col0 + bj * HALF) = w; }
                ss += __shfl_xor(ss, 16); ss += __shfl_xor(ss, 32);
                if (fq == 0) SS2[row * 32 + u.pn * 4 + wc] = ss;
            }
    }
};
struct Epi3 {
    static constexpr bool PERM = true, AFTER_DRAIN = false, MIDK = false;
    bf16_t* O;
    __device__ __forceinline__ void midk(f32x4 (&acc)[2][2][4][2], const Unit& u, int wr, int wc, int fr, int fq) const {}
    __device__ __forceinline__ void operator()(const f32x4 (&acc)[2][2][4][2], const Unit& u, int wr, int wc, int fr, int fq) const {
        const int col0 = u.pn * BM + wc * 32 + 8 * fq;
#pragma unroll
        for (int ai = 0; ai < 2; ++ai)
#pragma unroll
            for (int m = 0; m < 4; ++m) { const size_t row = (size_t)u.pm * BM + ai * HALF + wr * 64 + m * 16 + fr;
#pragma unroll
                for (int bj = 0; bj < 2; ++bj) { const f32x4 v0 = acc[ai][bj][m][0], v1 = acc[ai][bj][m][1];
                    u32x4 w; w.x = cvt_pk_bf16(v0[0], v0[1]); w.y = cvt_pk_bf16(v0[2], v0[3]); w.z = cvt_pk_bf16(v1[0], v1[1]); w.w = cvt_pk_bf16(v1[2], v1[3]);
                    *(u32x4*)(O + row * 2048 + col0 + bj * HALF) = w; } }
    }
};
template <class Epi, class Sched, bool ALIGN_EPI = false, bool SP2 = false>
__device__ __forceinline__ void gemm_phase(PG8_LAS unsigned char* lds, const Gemm g, const Sched& S, const Epi& E) {
    const int tid = threadIdx.x, wid = __builtin_amdgcn_readfirstlane(tid >> 6), lane = tid & 63, wr = wid >> 2, wc = wid & 3, fr = lane & 15, fq = lane >> 4;
    const int K = g.K, nt = K / BK;
    unsigned voffA[2], voffB[2];
#pragma unroll
    for (int i = 0; i < 2; ++i) { int R, C; stage_rc(tid * 16 + i * 8192, R, C); const int Rb = Epi::PERM ? ((R & ~31) + perm32(R & 31)) : R;
        voffA[i] = (unsigned)(R * K + C) * 2u; voffB[i] = (unsigned)(Rb * K + C) * 2u; }
    const size_t kstep = (size_t)(BK * 2);
    const size_t hstep = (size_t)HALF * K * 2;
    const size_t tstep = 2 * hstep;
    const unsigned ldsw = (unsigned)wid * 1024u;
    const int aoff = lds_byte(wr * 64 + fr, fq * 8), boff = lds_byte(wc * 32 + fr, fq * 8);
#define PG8_SA(b, h) (((b) * 2 + (h)) * HTB)
#define PG8_SB(b, h) ((4 + (b) * 2 + (h)) * HTB)
#define PG8_STAGE(bufoff, gbase, voff) do { _Pragma("unroll") for (int _i = 0; _i < 2; ++_i) \
        __builtin_amdgcn_global_load_lds((const unsigned*)((const char*)(gbase) + (voff)[_i]), (PG8_LAS unsigned*)(lds + (bufoff) + ldsw + _i * 8192), 16, 0, 0); } while (0)
#define PG8_LDA(dst, b, h) do { _Pragma("unroll") for (int m = 0; m < 4; ++m) _Pragma("unroll") for (int k = 0; k < 2; ++k) dst[m][k] = *(const PG8_LAS bf16x8*)(lds + PG8_SA(b, h) + aoff + m * 2048 + k * 1024); } while (0)
#define PG8_LDB(dst, b, h) do { _Pragma("unroll") for (int n = 0; n < 2; ++n) _Pragma("unroll") for (int k = 0; k < 2; ++k) dst[n][k] = *(const PG8_LAS bf16x8*)(lds + PG8_SB(b, h) + boff + n * 2048 + k * 1024); } while (0)
#define PG8_MMA(ai, bj, At, Bt) do { __builtin_amdgcn_s_setprio(1); _Pragma("unroll") for (int m = 0; m < 4; ++m) _Pragma("unroll") for (int n = 0; n < 2; ++n) _Pragma("unroll") for (int k = 0; k < 2; ++k) \
        acc[ai][bj][m][n] = __builtin_amdgcn_mfma_f32_16x16x32_bf16(Bt[n][k], At[m][k], acc[ai][bj][m][n], 0, 0, 0); __builtin_amdgcn_s_setprio(0); } while (0)
#define PG8_WAIT_V(n) asm volatile("s_waitcnt vmcnt(" #n ")" ::: "memory")
#define PG8_WAIT_L(n) asm volatile("s_waitcnt lgkmcnt(" #n ")" ::: "memory")
#define PG8_BAR __builtin_amdgcn_s_barrier()
#define PG8_SCHED __builtin_amdgcn_sched_barrier(0)
    Unit cur, nxt; int ui = 0;
    if (!S.next(0, cur)) return;
    f32x4 acc[2][2][4][2];
#pragma unroll
    for (int a = 0; a < 2; ++a)
#pragma unroll
        for (int b = 0; b < 2; ++b)
#pragma unroll
            for (int m = 0; m < 4; ++m)
#pragma unroll
                for (int n = 0; n < 2; ++n) acc[a][b][m][n] = (f32x4){0.f, 0.f, 0.f, 0.f};
    bf16x8 At[4][2], B0[2][2], B1[2][2];
    const char* cA = (const char*)g.A + (size_t)cur.pm * tstep; const char* cB = (const char*)g.Bt + (size_t)cur.pn * tstep;
    S.a_ready(cur);
    if constexpr (SP2) {
        PG8_STAGE(PG8_SB(0, 0), cB, voffB); PG8_STAGE(PG8_SB(0, 1), cB + hstep, voffB); PG8_STAGE(PG8_SA(0, 0), cA, voffA); PG8_STAGE(PG8_SA(0, 1), cA + hstep, voffA);
        if (wr == 1) PG8_BAR;
        PG8_WAIT_V(2); PG8_BAR;
        PG8_STAGE(PG8_SB(1, 0), cB + kstep, voffB); PG8_STAGE(PG8_SA(1, 0), cA + kstep, voffA); PG8_STAGE(PG8_SB(1, 1), cB + hstep + kstep, voffB);
        PG8_WAIT_V(6); PG8_BAR;
    } else {
        PG8_STAGE(PG8_SB(0, 0), cB, voffB); PG8_STAGE(PG8_SA(0, 0), cA, voffA); PG8_STAGE(PG8_SB(0, 1), cB + hstep, voffB); PG8_STAGE(PG8_SA(0, 1), cA + hstep, voffA);
        if (wr == 1) PG8_BAR;
        PG8_WAIT_V(4); PG8_BAR;
        PG8_STAGE(PG8_SB(1, 0), cB + kstep, voffB); PG8_STAGE(PG8_SA(1, 0), cA + kstep, voffA); PG8_STAGE(PG8_SB(1, 1), cB + hstep + kstep, voffB);
        PG8_WAIT_V(6); PG8_BAR;
    }
    for (;;) {
        const bool has_next = S.next(ui + 1, nxt);
        const char* nA = has_next ? (const char*)g.A + (size_t)nxt.pm * tstep : cA; const char* nB = has_next ? (const char*)g.Bt + (size_t)nxt.pn * tstep : cB;
        for (int t = 0; t < nt; t += 2) {
            if constexpr (Epi::MIDK) { if (t == nt / 2) E.midk(acc, cur, wr, wc, fr, fq); }
            const bool last = (t == nt - 2);
            const char* a1 = cA + (size_t)(t + 1) * kstep;
            const char* a2 = last ? nA : cA + (size_t)(t + 2) * kstep; const char* b2 = last ? nB : cB + (size_t)(t + 2) * kstep;
            const char* a3 = a2 + kstep; const char* b3 = b2 + kstep;
            if (last && has_next) S.a_ready(nxt);
            if constexpr (SP2) {
            PG8_LDB(B0, 0, 0); PG8_LDB(B1, 0, 1); PG8_SCHED; PG8_LDA(At, 0, 0); PG8_STAGE(PG8_SA(1, 1), a1 + hstep, voffA);
            PG8_WAIT_V(8); PG8_WAIT_L(0); PG8_BAR; PG8_MMA(0, 0, At, B0); PG8_MMA(0, 1, At, B1); PG8_BAR; PG8_SCHED;
            PG8_LDA(At, 0, 1); PG8_STAGE(PG8_SB(0, 0), b2, voffB); PG8_STAGE(PG8_SB(0, 1), b2 + hstep, voffB); PG8_STAGE(PG8_SA(0, 0), a2, voffA);
            PG8_WAIT_V(8); PG8_WAIT_L(0); PG8_BAR; PG8_MMA(1, 0, At, B0); PG8_MMA(1, 1, At, B1); PG8_BAR; PG8_SCHED;
            PG8_LDB(B0, 1, 0); PG8_LDB(B1, 1, 1); PG8_SCHED; PG8_LDA(At, 1, 0); PG8_STAGE(PG8_SA(0, 1), a2 + hstep, voffA);
            PG8_WAIT_V(8); PG8_WAIT_L(0); PG8_BAR; PG8_MMA(0, 0, At, B0); PG8_MMA(0, 1, At, B1); PG8_BAR; PG8_SCHED;
            PG8_LDA(At, 1, 1); PG8_STAGE(PG8_SB(1, 0), b3, voffB); PG8_STAGE(PG8_SB(1, 1), b3 + hstep, voffB); PG8_STAGE(PG8_SA(1, 0), a3, voffA);
            PG8_WAIT_V(8); PG8_WAIT_L(0); PG8_BAR; PG8_MMA(1, 0, At, B0); PG8_MMA(1, 1, At, B1); PG8_BAR; PG8_SCHED;
            } else {
            PG8_LDB(B0, 0, 0); PG8_SCHED; PG8_LDA(At, 0, 0); PG8_STAGE(PG8_SA(1, 1), a1 + hstep, voffA);
            PG8_WAIT_L(8); PG8_BAR; PG8_WAIT_L(0); PG8_MMA(0, 0, At, B0); PG8_BAR; PG8_SCHED;
            PG8_LDB(B1, 0, 1); PG8_STAGE(PG8_SB(0, 0), b2, voffB);
            PG8_BAR; PG8_WAIT_L(0); PG8_MMA(0, 1, At, B1); PG8_BAR;
            PG8_LDA(At, 0, 1); PG8_STAGE(PG8_SA(0, 0), a2, voffA);
            PG8_BAR; PG8_WAIT_L(0); PG8_MMA(1, 0, At, B0); PG8_BAR; PG8_SCHED;
            PG8_STAGE(PG8_SB(0, 1), b2 + hstep, voffB);
            PG8_WAIT_V(6); PG8_BAR; PG8_MMA(1, 1, At, B1); PG8_BAR;
            PG8_LDB(B0, 1, 0); PG8_SCHED; PG8_LDA(At, 1, 0); PG8_STAGE(PG8_SA(0, 1), a2 + hstep, voffA);
            PG8_WAIT_L(8); PG8_BAR; PG8_WAIT_L(0); PG8_MMA(0, 0, At, B0); PG8_BAR; PG8_SCHED;
            PG8_LDB(B1, 1, 1); PG8_STAGE(PG8_SB(1, 0), b3, voffB);
            PG8_BAR; PG8_WAIT_L(0); PG8_MMA(0, 1, At, B1); PG8_BAR;
            PG8_LDA(At, 1, 1); PG8_STAGE(PG8_SA(1, 0), a3, voffA);
            PG8_BAR; PG8_WAIT_L(0); PG8_MMA(1, 0, At, B0); PG8_BAR; PG8_SCHED;
            PG8_STAGE(PG8_SB(1, 1), b3 + hstep, voffB);
            PG8_WAIT_V(6); PG8_BAR; PG8_MMA(1, 1, At, B1); PG8_BAR;
            }
        }
        if constexpr (ALIGN_EPI) { if (wr == 0) PG8_BAR; }
        if constexpr (!Epi::AFTER_DRAIN) { E(acc, cur, wr, wc, fr, fq); S.done(cur); }
        if (!has_next) break;
#pragma unroll
        for (int a = 0; a < 2; ++a)
#pragma unroll
            for (int b = 0; b < 2; ++b)
#pragma unroll
                for (int m = 0; m < 4; ++m)
#pragma unroll
                    for (int n = 0; n < 2; ++n) acc[a][b][m][n] = (f32x4){0.f, 0.f, 0.f, 0.f};
        cur = nxt; cA = nA; cB = nB; ++ui;
        if constexpr (ALIGN_EPI) { if (wr == 1) PG8_BAR; }
    }
    PG8_WAIT_V(0);
    if constexpr (!ALIGN_EPI) { if (wr == 0) PG8_BAR; }
    PG8_BAR;
    if constexpr (Epi::AFTER_DRAIN) { E.fused(acc, cur, wr, wc, fr, fq, lds, wid, lane); S.done(cur); }
#undef PG8_SA
#undef PG8_SB
#undef PG8_STAGE
#undef PG8_LDA
#undef PG8_LDB
#undef PG8_MMA
#undef PG8_WAIT_V
#undef PG8_WAIT_L
#undef PG8_BAR
#undef PG8_SCHED
}
}
#define XB_TMO      128
#define XB_XCNT(j)  (256  + 64 * (j))
#define XB_XSUB(j)  (1280 + 64 * (j))
#define XB_XGEN(j)  (2304 + 64 * (j))
#define XB_TOP      3328
#define XB_TOPGEN   3392
#define XCD_BAR_WORDS 3456
#define XB_SPIN_CAP (1u << 18)

__device__ __forceinline__ unsigned xb_ld(unsigned* p)              { return __hip_atomic_load(p, __ATOMIC_RELAXED, __HIP_MEMORY_SCOPE_AGENT); }
__device__ __forceinline__ unsigned xb_add(unsigned* p, unsigned v) { return __hip_atomic_fetch_add(p, v, __ATOMIC_RELAXED, __HIP_MEMORY_SCOPE_AGENT); }
__device__ __forceinline__ unsigned xb_xcc_id() { return (unsigned)__builtin_amdgcn_s_getreg((3 << 11) | 20) & 0xFu; }
#define XB_SPIN(cond, bar) do { unsigned _sp = 0; while (cond) { __builtin_amdgcn_s_sleep(1); \
    if ((++_sp & 255u) == 0u) { if (xb_ld(&(bar)[XB_TMO])) break; if (_sp > XB_SPIN_CAP) { atomicAdd(&(bar)[XB_TMO], 1u); break; } } } } while (0)

struct XcdBarrier {
    unsigned* bar; unsigned x;
    volatile LAS unsigned* st;
};

__device__ __forceinline__ XcdBarrier xcd_barrier_post(unsigned* bar, volatile LAS unsigned* st) {
    XcdBarrier b; b.bar = bar; b.x = xb_xcc_id(); b.st = st;
    if (threadIdx.x == 0) (void)xb_add(&bar[XB_XCNT(b.x)], 1u);
    return b;
}
__device__ __forceinline__ void xcd_barrier_complete(unsigned* bar, unsigned x, unsigned& nloc, unsigned& nx) {
    const unsigned G = gridDim.x * gridDim.y * gridDim.z;
    unsigned sum, cnt, mine, sp = 0u;
    for (;;) {
        sum = 0u; cnt = 0u; mine = 0u;
#pragma unroll
        for (unsigned j = 0; j < 16; ++j) { const unsigned c = xb_ld(&bar[XB_XCNT(j)]); sum += c; cnt += (c > 0u) ? 1u : 0u; mine = (j == x) ? c : mine; }
        if (sum == G) break;
        __builtin_amdgcn_s_sleep(1);
        if ((++sp & 255u) == 0u) { if (xb_ld(&bar[XB_TMO])) break; if (sp > XB_SPIN_CAP) { atomicAdd(&bar[XB_TMO], 1u); break; } }
    }
    nloc = mine > 0u ? mine : 1u; nx = cnt > 0u ? cnt : 1u;
}

__device__ __forceinline__ void xcd_barrier(const XcdBarrier& b) {
    asm volatile("s_waitcnt vmcnt(0)" ::: "memory");
    __syncthreads();
    if (threadIdx.x == 0) {
        unsigned* bar = b.bar;
        __builtin_amdgcn_s_waitcnt(0);
        unsigned nloc = b.st[0], nx = b.st[1];
        if (nloc == 0u) { xcd_barrier_complete(bar, b.x, nloc, nx); b.st[0] = nloc; b.st[1] = nx; }
        const unsigned old = xb_add(&bar[XB_XSUB(b.x)], 1u);
        const unsigned gen = old / nloc;
        if (old + 1u == (gen + 1u) * nloc) {
            __builtin_amdgcn_fence(__ATOMIC_RELEASE, "agent");
            asm volatile("s_waitcnt vmcnt(0)" ::: "memory");
            const unsigned og = xb_add(&bar[XB_TOP], 1u);
            const unsigned tg = og / nx;
            if (og + 1u == (tg + 1u) * nx) xb_add(&bar[XB_TOPGEN], 1u);
            else XB_SPIN(xb_ld(&bar[XB_TOPGEN]) == tg, bar);
            __builtin_amdgcn_fence(__ATOMIC_ACQUIRE, "agent");
            xb_add(&bar[XB_XGEN(b.x)], 1u);
            asm volatile("s_waitcnt vmcnt(0)" ::: "memory");
        } else {
            XB_SPIN(xb_ld(&bar[XB_XGEN(b.x)]) == gen, bar);
            __builtin_amdgcn_fence(__ATOMIC_ACQUIRE, "agent");
            asm volatile("s_waitcnt vmcnt(0)" ::: "memory");
        }
    }
    __syncthreads();
}

constexpr int NWAVES = 8;
constexpr size_t MiB = 1u << 20;
constexpr size_t WS_CTL = 0, CTL_ZERO_BYTES = 1 * MiB;
constexpr size_t WS_W1T = 2 * MiB;
constexpr size_t WS_W2T = 16 * MiB;
constexpr size_t WS_W3T = 24 * MiB;
constexpr size_t WS_SKB = 32 * MiB;
constexpr size_t WS_RSTD1 = 33 * MiB;
constexpr size_t WS_SSA = 34 * MiB;
constexpr size_t WS_SSL = 35 * MiB;
constexpr size_t WS_SS2 = 37 * MiB;
constexpr size_t WS_RSTD2 = 39 * MiB;
constexpr size_t WS_IDS = 40 * MiB;
constexpr size_t WS_GW = 48 * MiB;
constexpr size_t WS_U8 = 64 * MiB;
constexpr size_t WS_V8 = 96 * MiB;
constexpr size_t WS_X8 = 128 * MiB;
constexpr size_t WS_SX = 160 * MiB;
constexpr size_t WS_SCU = 162 * MiB;
constexpr size_t WS_SCV = 163 * MiB;
constexpr size_t WS_WSUM = 164 * MiB;
constexpr size_t WS_A1 = 192 * MiB;
constexpr size_t WS_Q = 258 * MiB;
constexpr size_t WS_KV = 290 * MiB;
constexpr size_t WS_XB = 299 * MiB;
constexpr size_t WS_GT = 332 * MiB;
constexpr size_t WS_H1 = 364 * MiB;
constexpr size_t WS_PART = 192 * MiB;
constexpr size_t WS_W = 56 * MiB;
constexpr size_t WS_Z = 428 * MiB;
constexpr size_t WS_END = 492 * MiB;
constexpr int CW_QROW = 2048;
constexpr int CW_BAR = 4096;

constexpr int RING_OFF = 0, RING_BYTES = 131072;
constexpr int LDSCTL_OFF = RING_BYTES, MISC_OFF = LDSCTL_OFF + 320;
constexpr int LDS_BYTES = 147456;

typedef unsigned short bf16;
typedef unsigned v4u __attribute__((ext_vector_type(4)));
typedef float f32x4 __attribute__((ext_vector_type(4)));
typedef short bf16x8 __attribute__((ext_vector_type(8)));
typedef GAS unsigned gu32;
#define RLX_AGENT __ATOMIC_RELAXED, __HIP_MEMORY_SCOPE_AGENT
#define LDS_WAIT() asm volatile("s_waitcnt lgkmcnt(0)" ::: "memory")
#define VM_WAIT() asm volatile("s_waitcnt vmcnt(0)" ::: "memory")
__device__ __forceinline__ unsigned f2bf(float f) { unsigned u = __builtin_bit_cast(unsigned, f); return (u + 0x7fffu + ((u >> 16) & 1u)) >> 16; }
__device__ __forceinline__ unsigned pk2(float lo, float hi) { return f2bf(lo) | (f2bf(hi) << 16); }
__device__ __forceinline__ float bf2f(unsigned short b) { return __builtin_bit_cast(float, (unsigned)b << 16); }

namespace p2 {
typedef float f32x16 __attribute__((ext_vector_type(16)));
typedef unsigned u32x2 __attribute__((ext_vector_type(2)));
constexpr float LOG2E = 1.4426950408889634f;
constexpr float NEGBIG = -1e30f;
__device__ __forceinline__ int crow(int r, int hi) { return (r & 3) + 8 * (r >> 2) + 4 * hi; }
__device__ __forceinline__ unsigned cvtpk(float lo, float hi) { unsigned r; asm volatile("v_cvt_pk_bf16_f32 %0, %1, %2" : "=v"(r) : "v"(lo), "v"(hi)); return r; }
__device__ __forceinline__ float ex2(float x) { return __builtin_amdgcn_exp2f(x); }
__device__ __forceinline__ float rcp(float x) { return __builtin_amdgcn_rcpf(x); }
__device__ __forceinline__ float gelu_fast(float x) { return x * rcp(1.0f + ex2(-2.302208198f * x * (1.0f + 0.044715f * x * x))); }

constexpr int A_KS = 0, A_KSP = 144, A_VT = 288 * 144, A_VTP = 584, A_ST = A_VT + 64 * 584, A_END = A_ST + 8 * 4096;
__device__ __forceinline__ void attn_unit(LAS unsigned char* lds, int b, int qblk, int kvh, const bf16* QB, const bf16* KVB, const float* sinks, bf16* MIX, float* SSA, int tid) {
    const int lane = tid & 63, wave = __builtin_amdgcn_readfirstlane(tid >> 6), r = lane & 31, hi = lane >> 5;
    const int q0 = qblk * 128, hq = kvh * 8 + wave;
    for (int it = 0; it < 5; ++it) {
        const int cid = it * 512 + tid;
        if (cid < 288 * 8) {
            const int key = cid >> 3, ch = cid & 7;
            bool valid; size_t row = 0;
            if (key < 256) { const int pos = q0 - 128 + key; valid = pos >= 0; row = (size_t)b * SEQ + pos; }
            else if (key < 272) { valid = true; row = (size_t)MREAL + (key - 256); }
            else valid = false;
            v4u kv = {0u, 0u, 0u, 0u}, vv = {0u, 0u, 0u, 0u};
            if (valid) { kv = *(const GAS v4u*)(KVB + row * 256 + kvh * 64 + ch * 8); vv = *(const GAS v4u*)(KVB + row * 256 + 128 + kvh * 64 + ch * 8); }
            *(LAS v4u*)(lds + A_KS + key * A_KSP + ch * 16) = kv;
            LAS unsigned short* vt = (LAS unsigned short*)(lds + A_VT);
#pragma unroll
            for (int j = 0; j < 8; ++j) { const unsigned wv = vv[j >> 1]; vt[(ch * 8 + j) * (A_VTP / 2) + key] = (unsigned short)((j & 1) ? (wv >> 16) : (wv & 0xffffu)); }
        }
    }
    __syncthreads();
    const float sink2 = sinks[hq] * LOG2E;
    for (int qg = 0; qg < 4; ++qg) {
        const size_t mrow = (size_t)b * SEQ + q0 + 32 * qg + r;
        bf16x8 qf[4];
#pragma unroll
        for (int ks = 0; ks < 4; ++ks) qf[ks] = *(const GAS bf16x8*)(QB + mrow * 1024 + hq * 64 + ks * 16 + hi * 8);
        f32x16 s[6];
#pragma unroll
        for (int t = 0; t < 6; ++t) {
            const int kbase = t < 5 ? 32 * (qg + t) : 256;
            f32x16 acc = {0.f, 0.f, 0.f, 0.f, 0.f, 0.f, 0.f, 0.f, 0.f, 0.f, 0.f, 0.f, 0.f, 0.f, 0.f, 0.f};
#pragma unroll
            for (int ks = 0; ks < 4; ++ks) {
                const bf16x8 kf = *(const LAS bf16x8*)(lds + A_KS + (kbase + r) * A_KSP + ks * 32 + hi * 16);
                acc = __builtin_amdgcn_mfma_f32_32x32x16_bf16(kf, qf[ks], acc, 0, 0, 0);
            }
            s[t] = acc;
        }
        const bool blk0 = (qblk == 0);
#pragma unroll
        for (int reg = 0; reg < 16; ++reg) {
            const int j = crow(reg, hi);
            s[0][reg] = (j > r) ? s[0][reg] : NEGBIG;
            s[4][reg] = (j <= r) ? s[4][reg] : NEGBIG;
            s[5][reg] = (j < 16) ? s[5][reg] : NEGBIG;
        }
#pragma unroll
        for (int t = 0; t < 4; ++t) if (blk0 && (qg + t < 4)) {
#pragma unroll
            for (int reg = 0; reg < 16; ++reg) s[t][reg] = NEGBIG;
        }
        float m = sink2;
#pragma unroll
        for (int t = 0; t < 6; ++t)
#pragma unroll
            for (int reg = 0; reg < 16; ++reg) m = fmaxf(m, s[t][reg]);
        m = fmaxf(m, __shfl_xor(m, 32));
        float l = 0.f;
#pragma unroll
        for (int t = 0; t < 6; ++t)
#pragma unroll
            for (int reg = 0; reg < 16; ++reg) { const float p = ex2(s[t][reg] - m); s[t][reg] = p; l += p; }
        l += __shfl_xor(l, 32);
        l += ex2(sink2 - m);
        const float linv = 1.0f / l;
        f32x16 o0 = {0.f, 0.f, 0.f, 0.f, 0.f, 0.f, 0.f, 0.f, 0.f, 0.f, 0.f, 0.f, 0.f, 0.f, 0.f, 0.f}, o1 = o0;
#pragma unroll
        for (int t = 0; t < 6; ++t) {
            const int kbase = t < 5 ? 32 * (qg + t) : 256;
#pragma unroll
            for (int ss = 0; ss < 2; ++ss) {
                v4u pw; pw.x = cvtpk(s[t][8 * ss + 0], s[t][8 * ss + 1]); pw.y = cvtpk(s[t][8 * ss + 2], s[t][8 * ss + 3]);
                pw.z = cvtpk(s[t][8 * ss + 4], s[t][8 * ss + 5]); pw.w = cvtpk(s[t][8 * ss + 6], s[t][8 * ss + 7]);
                const bf16x8 pa = __builtin_bit_cast(bf16x8, pw);
                const int ko = (kbase + 16 * ss + 4 * hi) * 2;
                {   const u32x2 lo = *(const LAS u32x2*)(lds + A_VT + r * A_VTP + ko), h2 = *(const LAS u32x2*)(lds + A_VT + r * A_VTP + ko + 16);
                    v4u vw; vw.x = lo.x; vw.y = lo.y; vw.z = h2.x; vw.w = h2.y;
                    o0 = __builtin_amdgcn_mfma_f32_32x32x16_bf16(pa, __builtin_bit_cast(bf16x8, vw), o0, 0, 0, 0); }
                {   const u32x2 lo = *(const LAS u32x2*)(lds + A_VT + (32 + r) * A_VTP + ko), h2 = *(const LAS u32x2*)(lds + A_VT + (32 + r) * A_VTP + ko + 16);
                    v4u vw; vw.x = lo.x; vw.y = lo.y; vw.z = h2.x; vw.w = h2.y;
                    o1 = __builtin_amdgcn_mfma_f32_32x32x16_bf16(pa, __builtin_bit_cast(bf16x8, vw), o1, 0, 0, 0); }
            }
        }
        LAS unsigned short* stg = (LAS unsigned short*)(lds + A_ST + wave * 4096);
#pragma unroll
        for (int reg = 0; reg < 16; ++reg) {
            const int qr = crow(reg, hi); const float li = __shfl(linv, qr);
            stg[qr * 64 + r] = (unsigned short)f2bf(o0[reg] * li);
            stg[qr * 64 + 32 + r] = (unsigned short)f2bf(o1[reg] * li);
        }
        asm volatile("s_waitcnt lgkmcnt(0)" ::: "memory");
#pragma unroll
        for (int i = 0; i < 4; ++i) {
            const int row = i * 8 + (lane >> 3), ch = lane & 7;
            const v4u v = *(const LAS v4u*)(stg + row * 64 + ch * 8);
            float ss = 0.f;
#pragma unroll
            for (int k = 0; k < 4; ++k) { const float a = __builtin_bit_cast(float, v[k] << 16), c = __builtin_bit_cast(float, v[k] & 0xffff0000u); ss += a * a + c * c; }
            ss += __shfl_xor(ss, 1); ss += __shfl_xor(ss, 2); ss += __shfl_xor(ss, 4);
            const size_t orow = (size_t)b * SEQ + q0 + 32 * qg + row;
            *(GAS v4u*)(MIX + orow * D + hq * 64 + ch * 8) = v;
            if (ch == 0) SSA[orow * 16 + hq] = ss;
        }
        asm volatile("s_waitcnt lgkmcnt(0)" ::: "memory");
    }
    __syncthreads();
}

constexpr int L_XS = 0, L_XC = 33280, L_XCF = L_XC + 36864, L_GS = L_XCF + 32768, L_W = L_GS + 16384, L_CT = L_W + 9216, L_END = L_CT + 2048;
static_assert(L_END <= 131072, "lru lds");
struct LruP { const float *conv_w, *conv_b, *w_r, *b_r, *w_i, *b_i, *lam; };
__device__ __forceinline__ void lru_unit(LAS unsigned char* lds, int b, int nb, int cg, const bf16* XBB, const bf16* GTB, const LruP P, bf16* MIX, float* SSL, int tid) {
    const int lane = tid & 63, wave = __builtin_amdgcn_readfirstlane(tid >> 6), r = lane & 31, hi = lane >> 5;
    {
        LAS unsigned short* wt = (LAS unsigned short*)(lds + L_W);
#pragma unroll
        for (int i = 0; i < 4; ++i) {
            const int e = tid + 512 * i, c = e >> 5, dl = e & 31;
            const size_t gi = (size_t)(nb * 64 + c) * 64 + 32 * cg + dl;
            wt[dl * 72 + c] = (unsigned short)f2bf(P.w_r[gi]);
            wt[32 * 72 + dl * 72 + c] = (unsigned short)f2bf(P.w_i[gi]);
        }
    }
    const int cc = tid & 63, chc = nb * 64 + cc;
    const float cw0 = P.conv_w[0 * LW + chc], cw1 = P.conv_w[1 * LW + chc], cw2 = P.conv_w[2 * LW + chc], cw3 = P.conv_w[3 * LW + chc], cbv = P.conv_b[chc];
    const int chd = nb * 64 + 32 * cg + r;
    const float br = P.b_r[chd], bi = P.b_i[chd];
    const float ls8 = -8.0f * log1pf(expf(-P.lam[chd])) * LOG2E;
    float state = 0.f;
    for (int tile = 0; tile < 9; ++tile) {
        for (int it = 0; it < 5; ++it) {
            const int cid = it * 512 + tid;
            if (cid < 259 * 8) {
                const int j = cid >> 3, ch = cid & 7, t = j - 3;
                bool valid; size_t row = 0;
                if (tile == 0) { valid = (t >= 0 && t < NMETA); row = (size_t)MREAL + t; }
                else if (tile == 1 && t < 0) { valid = true; row = (size_t)MREAL + NMETA + t; }
                else { valid = true; row = (size_t)b * SEQ + 256 * (tile - 1) + t; }
                v4u v = {0u, 0u, 0u, 0u};
                if (valid) v = *(const GAS v4u*)(XBB + row * 1024 + nb * 64 + ch * 8);
                *(LAS v4u*)(lds + L_XS + j * 128 + ch * 16) = v;
            }
        }
        if (tile > 0) {
#pragma unroll
            for (int it = 0; it < 2; ++it) {
                const int cid = it * 512 + tid, t = cid >> 2, ch = cid & 3;
                const size_t row = (size_t)b * SEQ + 256 * (tile - 1) + t;
                *(LAS v4u*)(lds + L_GS + t * 64 + ch * 16) = *(const GAS v4u*)(GTB + row * 1024 + nb * 64 + 32 * cg + ch * 8);
            }
        }
        __syncthreads();
        {
            const LAS unsigned short* xs = (const LAS unsigned short*)(lds + L_XS);
            LAS unsigned short* xc = (LAS unsigned short*)(lds + L_XC);
            LAS float* xcf = (LAS float*)(lds + L_XCF);
            const int t0 = 32 * wave;
            float x0 = bf2f(xs[(t0 + 0) * 64 + cc]), x1 = bf2f(xs[(t0 + 1) * 64 + cc]), x2 = bf2f(xs[(t0 + 2) * 64 + cc]);
#pragma unroll 8
            for (int k = 0; k < 32; ++k) {
                const float x3 = bf2f(xs[(t0 + k + 3) * 64 + cc]);
                const float v = cbv + cw0 * x0 + cw1 * x1 + cw2 * x2 + cw3 * x3;
                xc[(t0 + k) * 72 + cc] = (unsigned short)f2bf(v);
                if ((cc >> 5) == cg) xcf[(t0 + k) * 32 + (cc & 31)] = v;
                x0 = x1; x1 = x2; x2 = x3;
            }
        }
        __syncthreads();
        f32x16 aR = {0.f, 0.f, 0.f, 0.f, 0.f, 0.f, 0.f, 0.f, 0.f, 0.f, 0.f, 0.f, 0.f, 0.f, 0.f, 0.f}, aI = aR;
#pragma unroll
        for (int ks = 0; ks < 4; ++ks) {
            const bf16x8 xa = *(const LAS bf16x8*)(lds + L_XC + (32 * wave + r) * 144 + ks * 32 + hi * 16);
            const bf16x8 wr_ = *(const LAS bf16x8*)(lds + L_W + r * 144 + ks * 32 + hi * 16);
            const bf16x8 wi_ = *(const LAS bf16x8*)(lds + L_W + 32 * 144 + r * 144 + ks * 32 + hi * 16);
            aR = __builtin_amdgcn_mfma_f32_32x32x16_bf16(xa, wr_, aR, 0, 0, 0);
            aI = __builtin_amdgcn_mfma_f32_32x32x16_bf16(xa, wi_, aI, 0, 0, 0);
        }
        float Av[16], Bv[16];
        {
            const LAS float* xcf = (const LAS float*)(lds + L_XCF);
#pragma unroll
            for (int reg = 0; reg < 16; ++reg) {
                const int t = 32 * wave + crow(reg, hi);
                const bool valid = (tile > 0) || (t < NMETA);
                const float rg = rcp(1.0f + ex2(-(aR[reg] + br) * LOG2E));
                const float ig = rcp(1.0f + ex2(-(aI[reg] + bi) * LOG2E));
                const float a = ex2(rg * ls8);
                const float mult = __builtin_amdgcn_sqrtf(fmaxf(1.0f - a * a, 0.f));
                const float bx = mult * ig * xcf[t * 32 + r];
                Av[reg] = valid ? a : 1.0f; Bv[reg] = valid ? bx : 0.0f;
            }
        }
#pragma unroll
        for (int g = 0; g < 4; ++g) {
#pragma unroll
            for (int k = 1; k < 4; ++k) { Bv[4 * g + k] = Av[4 * g + k] * Bv[4 * g + k - 1] + Bv[4 * g + k]; Av[4 * g + k] = Av[4 * g + k] * Av[4 * g + k - 1]; }
        }
        float myCz[4], myCp[4], PW, HW;
        {
            float cz = 0.f, cp = 1.f;
#pragma unroll
            for (int g = 0; g < 4; ++g) {
                const float mP = Av[4 * g + 3], mH = Bv[4 * g + 3];
                const float oP = __shfl_xor(mP, 32), oH = __shfl_xor(mH, 32);
                const float eP = hi ? oP : mP, eH = hi ? oH : mH, dP = hi ? mP : oP, dH = hi ? mH : oH;
                const float cz0 = cz, cp0 = cp;
                cz = eP * cz + eH; cp = cp * eP;
                myCz[g] = hi ? cz : cz0; myCp[g] = hi ? cp : cp0;
                cz = dP * cz + dH; cp = cp * dP;
            }
            PW = cp; HW = cz;
        }
        if (hi == 0) { LAS float* ct = (LAS float*)(lds + L_CT); ct[(wave * 32 + r) * 2] = PW; ct[(wave * 32 + r) * 2 + 1] = HW; }
        __syncthreads();
        float cin = 0.f;
        {
            const LAS float* ct = (const LAS float*)(lds + L_CT);
            float c = state;
#pragma unroll
            for (int w2 = 0; w2 < 8; ++w2) { if (w2 == wave) cin = c; c = ct[(w2 * 32 + r) * 2] * c + ct[(w2 * 32 + r) * 2 + 1]; }
            state = c;
        }
        if (tile > 0) {
            const LAS unsigned short* gs = (const LAS unsigned short*)(lds + L_GS);
            LAS unsigned short* os = (LAS unsigned short*)(lds + L_XS);
#pragma unroll
            for (int reg = 0; reg < 16; ++reg) {
                const int g = reg >> 2, t = 32 * wave + crow(reg, hi);
                const float h = Bv[reg] + Av[reg] * (myCz[g] + myCp[g] * cin);
                const float gt = bf2f(gs[t * 32 + r]);
                os[t * 32 + r] = (unsigned short)f2bf(gelu_fast(gt) * h);
            }
        }
        __syncthreads();
        if (tile > 0) {
#pragma unroll
            for (int it = 0; it < 2; ++it) {
                const int cid = it * 512 + tid, t = cid >> 2, ch = cid & 3;
                const v4u v = *(const LAS v4u*)(lds + L_XS + t * 64 + ch * 16);
                float ss = 0.f;
#pragma unroll
                for (int k = 0; k < 4; ++k) { const float a = __builtin_bit_cast(float, v[k] << 16), c = __builtin_bit_cast(float, v[k] & 0xffff0000u); ss += a * a + c * c; }
                ss += __shfl_xor(ss, 1); ss += __shfl_xor(ss, 2);
                const size_t row = (size_t)b * SEQ + 256 * (tile - 1) + t;
                *(GAS v4u*)(MIX + row * D + 1024 + nb * 64 + 32 * cg + ch * 8) = v;
                if (ch == 0) SSL[row * 32 + nb * 2 + cg] = ss;
            }
        }
        __syncthreads();
    }
}
}

namespace p5 {
typedef float f32x16 __attribute__((ext_vector_type(16)));
constexpr int KP = 272;
constexpr int R_KEYS = 0, R_IDX = 256 * KP, R_END = R_IDX + 8 * 1024;
__device__ __forceinline__ int crow(int r, int hi) { return (r & 3) + 8 * (r >> 2) + 4 * hi; }
__device__ __forceinline__ float fkey(float s, int mask, int payload) { return __builtin_bit_cast(float, (__builtin_bit_cast(int, s) & mask) | payload); }
__device__ __forceinline__ int fbits(float f) { return __builtin_bit_cast(int, f); }
__device__ __forceinline__ float fval(float f, int mask) { return __builtin_bit_cast(float, __builtin_bit_cast(int, f) & mask); }
__device__ __forceinline__ void ins16(float (&L)[16], float v) {
#pragma unroll
    for (int k = 15; k >= 1; --k) L[k] = __builtin_amdgcn_fmed3f(L[k - 1], L[k], v);
    L[0] = fmaxf(L[0], v);
}
__device__ __forceinline__ void half_top16(const LAS unsigned char* keys, const bf16x8 (&qf)[8], int r, int hi, float (&T)[16]) {
    float L[16];
#pragma unroll
    for (int k = 0; k < 16; ++k) L[k] = -INFINITY;
    const int h4 = 4 * hi;
#pragma unroll
    for (int kt = 0; kt < 4; ++kt) {
        f32x16 acc = {0.f, 0.f, 0.f, 0.f, 0.f, 0.f, 0.f, 0.f, 0.f, 0.f, 0.f, 0.f, 0.f, 0.f, 0.f, 0.f};
#pragma unroll
        for (int ks = 0; ks < 8; ++ks) {
            const bf16x8 kf = *(const LAS bf16x8*)(keys + (kt * 32 + r) * KP + ks * 32 + hi * 16);
            acc = __builtin_amdgcn_mfma_f32_32x32x16_bf16(kf, qf[ks], acc, 0, 0, 0);
        }
#pragma unroll
        for (int reg = 0; reg < 16; ++reg) {
            const int C = 127 - 32 * kt - (reg & 3) - 8 * (reg >> 2);
            ins16(L, fkey(acc[reg], (int)0xffffff80, C - h4));
        }
    }
    float M[16];
#pragma unroll
    for (int i = 0; i < 16; ++i) M[i] = fmaxf(L[i], __shfl_xor(L[15 - i], 32));
#define P5_STAGE(st) _Pragma("unroll") for (int i = 0; i < 16; ++i) if ((i & (st)) == 0) { const float a = fmaxf(M[i], M[i + (st)]), b = fminf(M[i], M[i + (st)]); M[i] = a; M[i + (st)] = b; }
    P5_STAGE(8) P5_STAGE(4) P5_STAGE(2) P5_STAGE(1)
#undef P5_STAGE
#pragma unroll
    for (int i = 0; i < 16; ++i) T[i] = M[i];
}

__device__ __forceinline__ void retr_unit(LAS unsigned char* lds, int h, int tg, const bf16* QPB, const bf16* SKB, unsigned short* IDS, float* GW, const float* RSTD2, int tid) {
    const int lane = tid & 63, wave = __builtin_amdgcn_readfirstlane(tid >> 6), r = lane & 31, hi = lane >> 5;
#pragma unroll
    for (int it = 0; it < 8; ++it) {
        const int cid = it * 512 + tid, row = cid >> 4, ch = cid & 15;
        *(LAS v4u*)(lds + R_KEYS + row * KP + ch * 16) = *(const GAS v4u*)(SKB + ((size_t)h * 256 + row) * 128 + ch * 8);
    }
    const size_t tok = (size_t)tg * 256 + wave * 32 + r;
    bf16x8 qa[8], qb[8];
#pragma unroll
    for (int ks = 0; ks < 8; ++ks) { qa[ks] = *(const GAS bf16x8*)(QPB + tok * D + h * 256 + ks * 16 + hi * 8); qb[ks] = *(const GAS bf16x8*)(QPB + tok * D + h * 256 + 128 + ks * 16 + hi * 8); }
    const float rs = RSTD2[tok];
    __syncthreads();
    float TA[16], TB[16];
    half_top16(lds + R_KEYS, qa, r, hi, TA);
    half_top16(lds + R_KEYS + 128 * KP, qb, r, hi, TB);
    LAS unsigned char* sc = lds + R_IDX + wave * 1024 + r * 32;
    const int hm = -hi;
    {
        v4u w;
#pragma unroll
        for (int q = 0; q < 4; ++q) { unsigned x = 0;
#pragma unroll
            for (int k = 0; k < 4; ++k) { const int t = (fbits(TB[4 * q + k]) & hm) | (fbits(TA[4 * q + k]) & ~hm); x |= (unsigned)(127 - (t & 0x7f)) << (8 * k); }
            w[q] = x; }
        *(LAS v4u*)(sc + hi * 16) = w;
    }
    float sA[16], sB[16];
#pragma unroll
    for (int i = 0; i < 16; ++i) { sA[i] = fval(TA[i], (int)0xffffff80); sB[i] = fval(TB[i], (int)0xffffff80); }
    float L[16];
#pragma unroll
    for (int k = 0; k < 16; ++k) L[k] = -INFINITY;
#pragma unroll
    for (int i = 0; i < 16; ++i)
#pragma unroll
        for (int j = 0; j < 16; ++j) if ((i + 1) * (j + 1) <= 16) {
            ins16(L, fkey(sA[i] + sB[j], (int)0xffffff00, 255 - (i * 16 + j)));
        }
    const float v0 = fval(L[0], (int)0xffffff00);
    asm volatile("s_waitcnt lgkmcnt(0)" ::: "memory");
    int ex[8]; float ew[8]; float esum = 0.f;
#pragma unroll
    for (int k = 0; k < 8; ++k) {
        const int t = (fbits(L[8 + k]) & hm) | (fbits(L[k]) & ~hm);
        const int c = 255 - (t & 0xff);
        const int ia = sc[c >> 4], ib = sc[16 + (c & 15)];
        ex[k] = ia * 128 + ib;
        const float e = __builtin_amdgcn_exp2f((__builtin_bit_cast(float, t & (int)0xffffff00) - v0) * rs * 1.4426950408889634f);
        ew[k] = e; esum += e;
    }
    esum += __shfl_xor(esum, 32);
    const float inv = 1.0f / esum;
    unsigned short* ip = IDS + tok * 128 + h * 16 + hi * 8; float* gp = GW + tok * 128 + h * 16 + hi * 8;
    *(GAS v4u*)(ip) = (v4u){(unsigned)ex[0] | ((unsigned)ex[1] << 16), (unsigned)ex[2] | ((unsigned)ex[3] << 16), (unsigned)ex[4] | ((unsigned)ex[5] << 16), (unsigned)ex[6] | ((unsigned)ex[7] << 16)};
    *(GAS f32x4*)(gp) = (f32x4){ew[0] * inv, ew[1] * inv, ew[2] * inv, ew[3] * inv};
    *(GAS f32x4*)(gp + 4) = (f32x4){ew[4] * inv, ew[5] * inv, ew[6] * inv, ew[7] * inv};
    __syncthreads();
}
}

namespace p6 {
__device__ __forceinline__ float blo(unsigned w) { return __builtin_bit_cast(float, w << 16); }
__device__ __forceinline__ float bhi(unsigned w) { return __builtin_bit_cast(float, w & 0xffff0000u); }
__device__ __forceinline__ float gelu_fast(float x) { return x * __builtin_amdgcn_rcpf(1.0f + __builtin_amdgcn_exp2f(-2.302208198f * x * (1.0f + 0.044715f * x * x))); }
__device__ __forceinline__ unsigned idw(const v4u& a, const v4u& b, int g) { const unsigned w = g < 8 ? a[(g & 7) >> 1] : b[(g & 7) >> 1]; return (g & 1) ? (w >> 16) : (w & 0xffffu); }
__device__ __forceinline__ float wave_max(float v) {
#pragma unroll
    for (int o = 1; o < 64; o <<= 1) v = fmaxf(v, __shfl_xor(v, o));
    return v;
}
__device__ __forceinline__ unsigned q4(float a, float b, float c, float d, float inv, int bias) {
    const int qa = (int)rintf(a * inv) + bias, qb = (int)rintf(b * inv) + bias, qc = (int)rintf(c * inv) + bias, qd = (int)rintf(d * inv) + bias;
    return (unsigned)(qa & 0xff) | ((unsigned)(qb & 0xff) << 8) | ((unsigned)(qc & 0xff) << 16) | ((unsigned)(qd & 0xff) << 24);
}
__device__ __forceinline__ void qrow_load(f32x4 (&v)[8], const float* src, size_t e, int lane) {
#pragma unroll
    for (int j = 0; j < 8; ++j) v[j] = __builtin_nontemporal_load((const GAS f32x4*)(src + e * D + j * 256 + lane * 4));
}
__device__ __forceinline__ void qrow_finish(f32x4 (&v)[8], const float* gcol, unsigned char* dst, float* scale_out, size_t e, int lane) {
    float am = 0.f;
#pragma unroll
    for (int j = 0; j < 8; ++j) {
        if (gcol) { const f32x4 g = *(const GAS f32x4*)(gcol + j * 256 + lane * 4); v[j] = v[j] * g; }
        am = fmaxf(am, fmaxf(fmaxf(fabsf(v[j].x), fabsf(v[j].y)), fmaxf(fabsf(v[j].z), fabsf(v[j].w))));
    }
    am = wave_max(am);
    const float inv = am > 0.f ? 127.0f / am : 0.f;
#pragma unroll
    for (int j = 0; j < 8; ++j)
        *(GAS unsigned*)(dst + ((size_t)(2 * j + (lane >> 5)) * 16384 + e) * 128 + (lane & 31) * 4) = q4(v[j].x, v[j].y, v[j].z, v[j].w, inv, 0);
    if (lane == 0) scale_out[e] = am * (1.0f / 127.0f);
}
__device__ __forceinline__ void qx_load(v4u (&x)[4], const bf16* H1B, size_t tok, int lane) {
#pragma unroll
    for (int j = 0; j < 4; ++j) x[j] = *(const GAS v4u*)(H1B + tok * D + j * 512 + lane * 8);
}
__device__ __forceinline__ void qx_finish(const v4u (&x)[4], unsigned char* X8, float* SX, size_t tok, int lane) {
#pragma unroll
    for (int j = 0; j < 4; ++j) {
        float f[8]; float am = 0.f;
#pragma unroll
        for (int k = 0; k < 4; ++k) { f[2 * k] = blo(x[j][k]); f[2 * k + 1] = bhi(x[j][k]); am = fmaxf(am, fmaxf(fabsf(f[2 * k]), fabsf(f[2 * k + 1]))); }
        am = fmaxf(am, __shfl_xor(am, 1)); am = fmaxf(am, __shfl_xor(am, 2)); am = fmaxf(am, __shfl_xor(am, 4)); am = fmaxf(am, __shfl_xor(am, 8));
        const float inv = am > 0.f ? 127.0f / am : 0.f;
        typedef unsigned u32x2v __attribute__((ext_vector_type(2)));
        u32x2v o; o.x = q4(f[0], f[1], f[2], f[3], inv, 0); o.y = q4(f[4], f[5], f[6], f[7], inv, 0);
        *(GAS u32x2v*)(X8 + tok * D + j * 512 + lane * 8) = o;
        if ((lane & 15) == 0) SX[tok * 16 + 4 * j + (lane >> 4)] = am * (1.0f / 127.0f);
    }
}

typedef int i32x16 __attribute__((ext_vector_type(16)));
typedef float f32x16v __attribute__((ext_vector_type(16)));
__device__ __forceinline__ int seli(int m, int a, int b) { return (a & m) | (b & ~m); }
__device__ __forceinline__ float self(int m, float a, float b) { return __builtin_bit_cast(float, seli(m, __builtin_bit_cast(int, a), __builtin_bit_cast(int, b))); }
__device__ __forceinline__ void usweep(const unsigned char* X8, const float* SX, const unsigned char* U8, const unsigned short* IDS, bf16* PART, int slot, int rank, int nrank, int wave, int lane) {
    const int ps = lane >> 3, ch = lane & 7;
    const int first = rank * 8 + wave, stride = nrank * 8;
    const int n = first < MREAL ? (MREAL - first + stride - 1) / stride : 0, NQ = 2 * n;
    if (NQ == 0) return;
    const int m4 = -((lane >> 2) & 1), m2 = -((lane >> 1) & 1), m1 = -(lane & 1);
#define U_LOAD(q_, I0, I1, XV, SX_, T_, SG_) do { const int qq_ = (q_) < NQ ? (q_) : NQ - 1; const int rd_ = qq_ >= n ? 1 : 0; T_ = first + (qq_ - rd_ * n) * stride; SG_ = rd_ * 8 + slot; \
        I0 = *(const GAS v4u*)(IDS + (size_t)T_ * 128 + ps * 16); I1 = *(const GAS v4u*)(IDS + (size_t)T_ * 128 + ps * 16 + 8); \
        XV = *(const GAS v4u*)(X8 + (size_t)T_ * D + SG_ * 128 + ch * 16); SX_ = SX[(size_t)T_ * 16 + SG_]; } while (0)
#define U_ISSUE(BUF, I0, I1, SG_) do { const unsigned char* tab_ = U8 + (size_t)(SG_) * 16384 * 128 + ch * 16; \
        _Pragma("unroll") for (int g = 0; g < 16; ++g) BUF[g] = *(const GAS v4u*)(tab_ + (size_t)idw(I0, I1, g) * 128); } while (0)
#define U_FINISH(BUF, XV, SX_, T_, SG_) do { i32x16 d; \
        _Pragma("unroll") for (int g = 0; g < 16; ++g) { int a_ = __builtin_amdgcn_sdot4((int)BUF[g][0], (int)XV[0], 0, false); a_ = __builtin_amdgcn_sdot4((int)BUF[g][1], (int)XV[1], a_, false); \
            a_ = __builtin_amdgcn_sdot4((int)BUF[g][2], (int)XV[2], a_, false); a_ = __builtin_amdgcn_sdot4((int)BUF[g][3], (int)XV[3], a_, false); d[g] = a_; } \
        int r8[8], r4[4], r2[2]; \
        _Pragma("unroll") for (int k = 0; k < 8; ++k) r8[k] = seli(m4, d[8 + k], d[k]) + __shfl_xor(seli(m4, d[k], d[8 + k]), 4); \
        _Pragma("unroll") for (int k = 0; k < 4; ++k) r4[k] = seli(m2, r8[4 + k], r8[k]) + __shfl_xor(seli(m2, r8[k], r8[4 + k]), 2); \
        _Pragma("unroll") for (int k = 0; k < 2; ++k) r2[k] = seli(m1, r4[2 + k], r4[k]) + __shfl_xor(seli(m1, r4[k], r4[2 + k]), 1); \
        *(GAS unsigned*)(PART + ((size_t)(SG_) * MREAL + T_) * 128 + ps * 16 + 2 * ch) = pk2((float)r2[0] * SX_, (float)r2[1] * SX_); } while (0)
    v4u bufA[16], bufB[16];
    v4u a0, a1, ax, b0, b1, bx, c0, c1, cx; float as, bs, cs; int at, bt, ct, ag, bg, cg;
    U_LOAD(0, a0, a1, ax, as, at, ag); U_LOAD(1, b0, b1, bx, bs, bt, bg);
    U_ISSUE(bufA, a0, a1, ag);
    for (int q = 0; q < NQ; q += 2) {
        U_ISSUE(bufB, b0, b1, bg);
        U_LOAD(q + 2, c0, c1, cx, cs, ct, cg);
        U_FINISH(bufA, ax, as, at, ag);
        U_ISSUE(bufA, c0, c1, cg);
        U_LOAD(q + 3, a0, a1, ax, as, at, ag);
        U_FINISH(bufB, bx, bs, bt, bg);
        { const v4u t0 = a0, t1 = a1, tx = ax; const float ts = as; const int tt = at, tg = ag;
          a0 = c0; a1 = c1; ax = cx; as = cs; at = ct; ag = cg; b0 = t0; b1 = t1; bx = tx; bs = ts; bt = tt; bg = tg; }
    }
#undef U_LOAD
#undef U_ISSUE
#undef U_FINISH
}
__device__ __forceinline__ void wreduce(const bf16* PART, const float* GW, const float* RSTD2, const unsigned short* IDS, const float* SCU, const float* SCV, unsigned char* W8, float* WS8, size_t gt, size_t NT) {
    for (size_t i8 = gt; i8 < (size_t)MREAL * 128 / 8; i8 += NT) {
        float s[8];
#pragma unroll
        for (int k = 0; k < 8; ++k) s[k] = 0.f;
#pragma unroll 8
        for (int sg = 0; sg < 16; ++sg) {
            const v4u p = *(const GAS v4u*)(PART + (size_t)sg * MREAL * 128 + i8 * 8);
#pragma unroll
            for (int k = 0; k < 4; ++k) { s[2 * k] += blo(p[k]); s[2 * k + 1] += bhi(p[k]); }
        }
        const float rs = RSTD2[i8 >> 4];
        const v4u idv = *(const GAS v4u*)(IDS + i8 * 8);
        const f32x4 g0 = *(const GAS f32x4*)(GW + i8 * 8), g1 = *(const GAS f32x4*)(GW + i8 * 8 + 4);
        float w[8]; float am = 0.f;
#pragma unroll
        for (int k = 0; k < 8; ++k) {
            const unsigned e = (k & 1) ? (idv[k >> 1] >> 16) : (idv[k >> 1] & 0xffffu);
            const float g = k < 4 ? g0[k & 3] : g1[k & 3];
            w[k] = g * gelu_fast(rs * SCU[e] * s[k]) * SCV[e]; am = fmaxf(am, fabsf(w[k]));
        }
        am = fmaxf(am, __shfl_xor(am, 1));
        const float inv = am > 0.f ? 127.0f / am : 0.f;
        typedef unsigned u32x2v __attribute__((ext_vector_type(2)));
        u32x2v o; o.x = q4(w[0], w[1], w[2], w[3], inv, 0); o.y = q4(w[4], w[5], w[6], w[7], inv, 0);
        *(GAS u32x2v*)(W8 + i8 * 8) = o;
        if ((i8 & 1) == 0) WS8[i8 >> 1] = am * (1.0f / 127.0f);
    }
}
__device__ __forceinline__ void vsweep(const bf16* H1B, const unsigned char* V8, const unsigned short* IDS, const unsigned char* W8, const float* WS8, bf16* Z, float* SSF, int slot, int rank, int nrank, int wave, int lane) {
    const int ps = lane >> 3, ch = lane & 7;
    const int first = rank * 8 + wave, stride = nrank * 8;
    const int n = first < MREAL ? (MREAL - first + stride - 1) / stride : 0, NQ = 2 * n;
    if (NQ == 0) return;
    const int m32 = -((lane >> 5) & 1), m16 = -((lane >> 4) & 1), m8 = -((lane >> 3) & 1);
#define V_LOAD(q_, I0, I1, T_, SG_) do { const int qq_ = (q_) < NQ ? (q_) : NQ - 1; const int rd_ = qq_ >= n ? 1 : 0; T_ = first + (qq_ - rd_ * n) * stride; SG_ = rd_ * 8 + slot; \
        I0 = *(const GAS v4u*)(IDS + (size_t)T_ * 128 + ps * 16); I1 = *(const GAS v4u*)(IDS + (size_t)T_ * 128 + ps * 16 + 8); } while (0)
#define V_ISSUE(BUF, WQ, WSC, I0, I1, T_, SG_) do { const unsigned char* tab_ = V8 + (size_t)(SG_) * 16384 * 128 + ch * 16; \
        _Pragma("unroll") for (int g = 0; g < 16; ++g) BUF[g] = *(const GAS v4u*)(tab_ + (size_t)idw(I0, I1, g) * 128); \
        WQ = *(const GAS v4u*)(W8 + (size_t)T_ * 128 + ps * 16); WSC = WS8[(size_t)T_ * 8 + ps]; } while (0)
#define V_FINISH(BUF, WQ, WSC, T_, SG_) do { i32x16 acc = {0, 0, 0, 0, 0, 0, 0, 0, 0, 0, 0, 0, 0, 0, 0, 0}; \
        const unsigned hx_ = *(const GAS unsigned*)(H1B + (size_t)T_ * D + (SG_) * 128 + ch * 16 + 2 * ps); \
        _Pragma("unroll") for (int j = 0; j < 4; ++j) { const int wq_ = (int)WQ[j]; \
            _Pragma("unroll") for (int k = 0; k < 4; ++k) { \
                const unsigned d0_ = BUF[4 * j][k], d1_ = BUF[4 * j + 1][k], d2_ = BUF[4 * j + 2][k], d3_ = BUF[4 * j + 3][k]; \
                const unsigned p0_ = __builtin_amdgcn_perm(d1_, d0_, 0x05010400u), p1_ = __builtin_amdgcn_perm(d1_, d0_, 0x07030602u); \
                const unsigned q0_ = __builtin_amdgcn_perm(d3_, d2_, 0x05010400u), q1_ = __builtin_amdgcn_perm(d3_, d2_, 0x07030602u); \
                acc[4 * k + 0] = __builtin_amdgcn_sdot4((int)__builtin_amdgcn_perm(q0_, p0_, 0x05040100u), wq_, acc[4 * k + 0], false); \
                acc[4 * k + 1] = __builtin_amdgcn_sdot4((int)__builtin_amdgcn_perm(q0_, p0_, 0x07060302u), wq_, acc[4 * k + 1], false); \
                acc[4 * k + 2] = __builtin_amdgcn_sdot4((int)__builtin_amdgcn_perm(q1_, p1_, 0x05040100u), wq_, acc[4 * k + 2], false); \
                acc[4 * k + 3] = __builtin_amdgcn_sdot4((int)__builtin_amdgcn_perm(q1_, p1_, 0x07060302u), wq_, acc[4 * k + 3], false); } } \
        float fa[16]; \
        _Pragma("unroll") for (int k = 0; k < 16; ++k) fa[k] = (float)acc[k] * WSC; \
        float r8[8], r4[4], r2[2]; \
        _Pragma("unroll") for (int k = 0; k < 8; ++k) r8[k] = self(m32, fa[8 + k], fa[k]) + __shfl_xor(self(m32, fa[k], fa[8 + k]), 32); \
        _Pragma("unroll") for (int k = 0; k < 4; ++k) r4[k] = self(m16, r8[4 + k], r8[k]) + __shfl_xor(self(m16, r8[k], r8[4 + k]), 16); \
        _Pragma("unroll") for (int k = 0; k < 2; ++k) r2[k] = self(m8, r4[2 + k], r4[k]) + __shfl_xor(self(m8, r4[k], r4[2 + k]), 8); \
        const float z0_ = r2[0] + blo(hx_), z1_ = r2[1] + bhi(hx_); \
        *(GAS unsigned*)(Z + (size_t)T_ * D + (SG_) * 128 + ch * 16 + 2 * ps) = pk2(z0_, z1_); \
        float ss_ = z0_ * z0_ + z1_ * z1_; \
        _Pragma("unroll") for (int o = 1; o < 64; o <<= 1) ss_ += __shfl_xor(ss_, o); \
        if (lane == 0) SSF[(size_t)T_ * 16 + (SG_)] = ss_; } while (0)
    v4u bufA[16], bufB[16]; v4u wA, wB; float sA, sB;
    v4u a0, a1, b0, b1, c0, c1; int at, bt, ct, ag, bg, cg;
    V_LOAD(0, a0, a1, at, ag); V_LOAD(1, b0, b1, bt, bg);
    V_ISSUE(bufA, wA, sA, a0, a1, at, ag);
    for (int q = 0; q < NQ; q += 2) {
        V_ISSUE(bufB, wB, sB, b0, b1, bt, bg);
        V_LOAD(q + 2, c0, c1, ct, cg);
        V_FINISH(bufA, wA, sA, at, ag);
        V_ISSUE(bufA, wA, sA, c0, c1, ct, cg);
        V_LOAD(q + 3, a0, a1, at, ag);
        V_FINISH(bufB, wB, sB, bt, bg);
        { const v4u t0 = a0, t1 = a1; const int tt = at, tg = ag; a0 = c0; a1 = c1; at = ct; ag = cg; b0 = t0; b1 = t1; bt = tt; bg = tg; }
    }
#undef V_LOAD
#undef V_ISSUE
#undef V_FINISH
}
__device__ __forceinline__ void final_row(const bf16* Z, const float* SSF, const float* fg, float* out, size_t tok, int lane) {
    v4u z[4];
#pragma unroll
    for (int j = 0; j < 4; ++j) z[j] = *(const GAS v4u*)(Z + tok * D + j * 512 + lane * 8);
    float ss = 0.f;
#pragma unroll
    for (int k = 0; k < 4; ++k) { const f32x4 v = *(const GAS f32x4*)(SSF + tok * 16 + 4 * k); ss += (v.x + v.y) + (v.z + v.w); }
    const float rf = 1.0f / sqrtf(ss * (1.0f / D) + EPS);
#pragma unroll
    for (int j = 0; j < 4; ++j) {
        const f32x4 ga = *(const GAS f32x4*)(fg + j * 512 + lane * 8), gb = *(const GAS f32x4*)(fg + j * 512 + lane * 8 + 4);
        *(GAS f32x4*)(out + tok * D + j * 512 + lane * 8) = (f32x4){blo(z[j][0]) * rf * ga.x, bhi(z[j][0]) * rf * ga.y, blo(z[j][1]) * rf * ga.z, bhi(z[j][1]) * rf * ga.w};
        *(GAS f32x4*)(out + tok * D + j * 512 + lane * 8 + 4) = (f32x4){blo(z[j][2]) * rf * gb.x, bhi(z[j][2]) * rf * gb.y, blo(z[j][3]) * rf * gb.z, bhi(z[j][3]) * rf * gb.w};
    }
}
}

struct Frame {
    LAS unsigned char* lds;
    volatile LAS unsigned* MISC;
    gu32* ctl;
    int tid, lane, wave, vcu, G;
};
__device__ __forceinline__ float wave_sum(float v) {
#pragma unroll
    for (int o = 1; o < 64; o <<= 1) v += __shfl_xor(v, o);
    return v;
}
__device__ __forceinline__ void p0_transpose_item(const float* W, int K, int N, bf16* WT, const float* g0, const float* g1, int ksplit, LAS float* scr, int item, int lane) {
    const int nblk = N / 32, kb = item / nblk, nb = item % nblk, k0 = 64 * kb, n0 = 32 * nb;
#pragma unroll 16
    for (int i = 0; i < 32; ++i) { const int kk = 2 * i + (lane >> 5); const int kg = k0 + kk; const float gv = kg < ksplit ? g0[kg] : g1[kg - ksplit];
        scr[kk * 33 + (lane & 31)] = W[(size_t)kg * N + n0 + (lane & 31)] * gv; }
    LDS_WAIT(); asm volatile("" ::: "memory");
    const int c = lane & 7;
#pragma unroll
    for (int j = 0; j < 4; ++j) { const int n = (lane >> 3) + 8 * j; const LAS float* s = scr + (8 * c) * 33 + n;
        v4u o; o.x = pk2(s[0 * 33], s[1 * 33]); o.y = pk2(s[2 * 33], s[3 * 33]); o.z = pk2(s[4 * 33], s[5 * 33]); o.w = pk2(s[6 * 33], s[7 * 33]);
        *(GAS v4u*)(WT + (size_t)(n0 + n) * K + k0 + 8 * c) = o; }
    LDS_WAIT(); asm volatile("" ::: "memory");
}
__device__ __forceinline__ void p0_row_load(f32x4 (&v)[8], const float* xrow, int lane) {
    const GAS f32x4* xr = (const GAS f32x4*)xrow + lane;
#pragma unroll
    for (int j = 0; j < 8; ++j) v[j] = __builtin_nontemporal_load(xr + 64 * j);
}
__device__ __forceinline__ void p0_row_finish(const f32x4 (&v)[8], bf16* orow, float* rstd_out, int lane) {
    float s = 0.f;
#pragma unroll
    for (int j = 0; j < 8; ++j) s += (v[j].x * v[j].x + v[j].y * v[j].y) + (v[j].z * v[j].z + v[j].w * v[j].w);
    s = wave_sum(s);
    GAS unsigned long long* o8 = (GAS unsigned long long*)orow + lane;
#pragma unroll
    for (int j = 0; j < 8; ++j) o8[64 * j] = (unsigned long long)pk2(v[j].x, v[j].y) | ((unsigned long long)pk2(v[j].z, v[j].w) << 32);
    if (lane == 0) *rstd_out = 1.0f / sqrtf(s * (1.0f / D) + EPS);
}
__device__ __forceinline__ void p0_cvt8_sliced(const float* src, bf16* dst, const float* gcol, size_t idx8) {
    const f32x4 a = *(const GAS f32x4*)(src + idx8 * 8), b = *(const GAS f32x4*)(src + idx8 * 8 + 4);
    f32x4 ga = {1.f, 1.f, 1.f, 1.f}, gb = {1.f, 1.f, 1.f, 1.f};
    const int c = (int)((idx8 * 8) & (D - 1)); const size_t e = (idx8 * 8) >> 11;
    if (gcol) { ga = *(const GAS f32x4*)(gcol + c); gb = *(const GAS f32x4*)(gcol + c + 4); }
    v4u o; o.x = pk2(a.x * ga.x, a.y * ga.y); o.y = pk2(a.z * ga.z, a.w * ga.w); o.z = pk2(b.x * gb.x, b.y * gb.y); o.w = pk2(b.z * gb.z, b.w * gb.w);
    *(GAS v4u*)(dst + ((size_t)(c >> 6) * 16384 + e) * 64 + (c & 63)) = o;
}
__device__ __forceinline__ void p0_cvt8(const float* src, bf16* dst, const float* gcol, size_t idx8) {
    const f32x4 a = *(const GAS f32x4*)(src + idx8 * 8), b = *(const GAS f32x4*)(src + idx8 * 8 + 4);
    f32x4 ga = {1.f, 1.f, 1.f, 1.f}, gb = {1.f, 1.f, 1.f, 1.f};
    if (gcol) { const int c = (int)((idx8 * 8) & (D - 1)); ga = *(const GAS f32x4*)(gcol + c); gb = *(const GAS f32x4*)(gcol + c + 4); }
    v4u o; o.x = pk2(a.x * ga.x, a.y * ga.y); o.y = pk2(a.z * ga.z, a.w * ga.w); o.z = pk2(b.x * gb.x, b.y * gb.y); o.w = pk2(b.z * gb.z, b.w * gb.w);
    *(GAS v4u*)(dst + idx8 * 8) = o;
}

struct Args { const float* in[22]; float* out; unsigned char* ws; int ph_lo, ph_hi, rep_mask, pad; };

__global__ void __launch_bounds__(NWAVES * 64, 2) fwd(Args args) {
    extern __shared__ __attribute__((aligned(16))) unsigned char lds[];
    Frame F;
    F.lds = (LAS unsigned char*)lds;
    F.MISC = (volatile LAS unsigned*)(F.lds + MISC_OFF);
    F.tid = threadIdx.x; F.lane = F.tid & 63; F.wave = __builtin_amdgcn_readfirstlane(F.tid >> 6);
    F.G = gridDim.x; { const int bx = blockIdx.x; F.vcu = (F.G % 8 == 0) ? (bx % 8) * (F.G / 8) + bx / 8 : bx; }
    unsigned char* ws = args.ws;
    F.ctl = (gu32*)(ws + WS_CTL);
    for (int u = F.tid; u < (LDS_BYTES - LDSCTL_OFF) / 4; u += NWAVES * 64) ((LAS unsigned*)(F.lds + LDSCTL_OFF))[u] = 0u;
    __syncthreads();
    XcdBarrier bar = xcd_barrier_post((unsigned*)(F.ctl + CW_BAR), F.MISC + 8);
    const int lo = args.ph_lo, hi = args.ph_hi;
#define IN(k) (lo <= (k) && (k) < hi)
#define BOTH(k) (IN(k) && IN((k) + 1))
#ifndef PROBE_PH
#define PROBE_PH (-1)
#endif
#define REP(k) for (int rep_ = 0; rep_ < ((k) == PROBE_PH ? 2 : 1); ++rep_)

    const float* x = args.in[0]; const float* meta = args.in[1]; const float* norm_mix_g = args.in[2]; const float* w_in = args.in[3]; const float* b_in = args.in[4];
    const float* gn_attn_g = args.in[13]; const float* gn_lru_g = args.in[14]; const float* w_out = args.in[15]; const float* norm_ffn_g = args.in[16];
    const float* peer_wq = args.in[17]; const float* sub_keys = args.in[18]; const float* peer_u = args.in[19]; const float* peer_v = args.in[20];
    bf16* W1T = (bf16*)(ws + WS_W1T); bf16* W2T = (bf16*)(ws + WS_W2T); bf16* W3T = (bf16*)(ws + WS_W3T); bf16* SKB = (bf16*)(ws + WS_SKB);
    float* RSTD1 = (float*)(ws + WS_RSTD1);
    unsigned char* U8 = ws + WS_U8; unsigned char* V8 = ws + WS_V8; unsigned char* X8 = ws + WS_X8; float* SX = (float*)(ws + WS_SX); float* SCU = (float*)(ws + WS_SCU); float* SCV = (float*)(ws + WS_SCV);
    bf16* A1 = (bf16*)(ws + WS_A1);
    bf16* QB = (bf16*)(ws + WS_Q); bf16* KVB = (bf16*)(ws + WS_KV); bf16* XBB = (bf16*)(ws + WS_XB); bf16* GTB = (bf16*)(ws + WS_GT);

    if (IN(0)) { REP(0) {
        LAS float* scr = (LAS float*)(F.lds + RING_OFF + F.wave * 16384);
        const int gw = F.vcu * NWAVES + F.wave, NGW = F.G * NWAVES;
        constexpr int I_1 = (D / 64) * (IND / 32), I_2 = (D / 64) * (D / 32), I_3 = I_2;
        for (int it = gw; it < I_1 + I_2 + I_3; it += NGW) {
            int r = it;
            if (r < I_1) { p0_transpose_item(w_in, D, IND, W1T, norm_mix_g, norm_mix_g, D, scr, r, F.lane); continue; } r -= I_1;
            if (r < I_2) { p0_transpose_item(w_out, D, D, W2T, gn_attn_g, gn_lru_g, 1024, scr, r, F.lane); continue; } r -= I_2;
            p0_transpose_item(peer_wq, D, D, W3T, norm_ffn_g, norm_ffn_g, D, scr, r, F.lane);
        }
        {
            f32x4 cur[8], nxt[8];
            if (gw < MREAL + NMETA) p0_row_load(cur, gw < MREAL ? x + (size_t)gw * D : meta + (size_t)(gw - MREAL) * D, F.lane);
            for (int m = gw; m < MREAL + NMETA; m += NGW) {
                const int mn = m + NGW;
                if (mn < MREAL + NMETA) p0_row_load(nxt, mn < MREAL ? x + (size_t)mn * D : meta + (size_t)(mn - MREAL) * D, F.lane);
                p0_row_finish(cur, A1 + (size_t)m * D, RSTD1 + m, F.lane);
#pragma unroll
                for (int j = 0; j < 8; ++j) cur[j] = nxt[j];
            }
        }
        {
            const size_t gt = (size_t)gw * 64 + F.lane, NT = (size_t)NGW * 64;
            for (size_t i = gt; i < (size_t)(8 * 2 * 128 * 128) / 8; i += NT) p0_cvt8(sub_keys, SKB, nullptr, i);
            {
                f32x4 cur[8], nxt[8];
                if (gw < 32768) p6::qrow_load(cur, gw < 16384 ? peer_u : peer_v, (size_t)(gw & 16383), F.lane);
                for (int rj = gw; rj < 32768; rj += NGW) {
                    const int rn = rj + NGW;
                    if (rn < 32768) p6::qrow_load(nxt, rn < 16384 ? peer_u : peer_v, (size_t)(rn & 16383), F.lane);
                    if (rj < 16384) p6::qrow_finish(cur, norm_ffn_g, U8, SCU, (size_t)rj, F.lane); else p6::qrow_finish(cur, nullptr, V8, SCV, (size_t)(rj - 16384), F.lane);
#pragma unroll
                    for (int j = 0; j < 8; ++j) cur[j] = nxt[j];
                }
            }
        } }
        if (BOTH(0)) xcd_barrier(bar);
    }
    if (IN(1)) {
        pg8::Gemm g{A1, W1T, MPAD, IND, D};
        pg8::Order1 S{F.G, (int)blockIdx.x};
        pg8::Epi1 E{QB, KVB, XBB, GTB, RSTD1, b_in};
        REP(1) pg8::gemm_phase<pg8::Epi1, pg8::Order1, true, true>(F.lds + RING_OFF, g, S, E);
        if (BOTH(1)) xcd_barrier(bar);
    }
    if (IN(2)) {
        bf16* MIX = (bf16*)(ws + WS_A1); float* SSA = (float*)(ws + WS_SSA); float* SSL = (float*)(ws + WS_SSL);
        const p2::LruP LP{args.in[6], args.in[7], args.in[8], args.in[9], args.in[10], args.in[11], args.in[12]};
        {
        REP(20) for (int u = (int)blockIdx.x; u < 256; u += F.G) p2::lru_unit(F.lds + RING_OFF, u >> 5, (u >> 1) & 15, u & 1, XBB, GTB, LP, MIX, SSL, F.tid);
        REP(21) for (int a = (int)blockIdx.x; a < 256; a += F.G) p2::attn_unit(F.lds + RING_OFF, a >> 5, (a >> 1) & 15, a & 1, QB, KVB, args.in[5], MIX, SSA, F.tid);
        }
        if (BOTH(2)) xcd_barrier(bar);
    }
    if (IN(3)) {
        bf16* MIX = (bf16*)(ws + WS_A1); const float* SSA = (const float*)(ws + WS_SSA); const float* SSL = (const float*)(ws + WS_SSL);
        bf16* H1B = (bf16*)(ws + WS_H1); float* SS2 = (float*)(ws + WS_SS2);
        pg8::Order2 S{F.G, (int)blockIdx.x};
        LAS float* tbl = (LAS float*)(F.lds + LDSCTL_OFF + 1024);
        pg8::Unit u0{0, 0};
        for (int i = 0; i < 2; ++i) {
            pg8::Unit u; if (!S.next(i, u)) break; if (i == 0) u0 = u;
            if (F.tid < 256) {
                const size_t row = (size_t)u.pm * 256 + F.tid; float sa = 0.f, sl = 0.f;
#pragma unroll
                for (int k = 0; k < 4; ++k) { const f32x4 v = *(const GAS f32x4*)(SSA + row * 16 + 4 * k); sa += (v.x + v.y) + (v.z + v.w); }
#pragma unroll
                for (int k = 0; k < 8; ++k) { const f32x4 v = *(const GAS f32x4*)(SSL + row * 32 + 4 * k); sl += (v.x + v.y) + (v.z + v.w); }
                const float ra = 1.0f / sqrtf(sa * (1.0f / 1024) + EPS), rl = 1.0f / sqrtf(sl * (1.0f / 1024) + EPS);
                tbl[(i * 256 + F.tid) * 2] = ra / rl; tbl[(i * 256 + F.tid) * 2 + 1] = rl;
            }
        }
        __syncthreads();
        pg8::Gemm g{MIX, W2T, MREAL, D, D};
        pg8::Epi2 E{H1B, x, SS2, (const LAS float*)tbl, u0.pm};
        REP(3) pg8::gemm_phase<pg8::Epi2, pg8::Order2, true, true>(F.lds + RING_OFF, g, S, E);
        if (BOTH(3)) xcd_barrier(bar);
    }
    if (IN(4)) {
        bf16* H1B = (bf16*)(ws + WS_H1); bf16* QPB = (bf16*)(ws + WS_A1);
        pg8::Order2 S{F.G, (int)blockIdx.x};
        {
            const float* SS2 = (const float*)(ws + WS_SS2); float* RSTD2 = (float*)(ws + WS_RSTD2);
            pg8::Unit u; if (S.next(0, u) && F.tid < 256) {
                const size_t row = (size_t)u.pm * 256 + F.tid; float ssq = 0.f;
#pragma unroll
                for (int k = 0; k < 8; ++k) { const f32x4 v = *(const GAS f32x4*)(SS2 + row * 32 + 4 * k); ssq += (v.x + v.y) + (v.z + v.w); }
                RSTD2[row] = 1.0f / sqrtf(ssq * (1.0f / D) + EPS);
            }
        }
        pg8::Gemm g{H1B, W3T, MREAL, D, D};
        pg8::Epi3 E{QPB};
        REP(4) pg8::gemm_phase<pg8::Epi3, pg8::Order2, true, true>(F.lds + RING_OFF, g, S, E);
        if (BOTH(4)) xcd_barrier(bar);
    }
    if (IN(5)) {
        const bf16* QPB = (const bf16*)(ws + WS_A1);
        unsigned short* IDS = (unsigned short*)(ws + WS_IDS); float* GW = (float*)(ws + WS_GW); float* RSTD2 = (float*)(ws + WS_RSTD2);
        const bf16* H1B = (const bf16*)(ws + WS_H1);
        REP(5) for (int u = (int)blockIdx.x; u < 512; u += F.G) {
            v4u xq[4][4]; const size_t tb = (size_t)(u >> 3) * 256 + F.wave * 32 + (u & 7);
#pragma unroll
            for (int k = 0; k < 4; ++k) p6::qx_load(xq[k], H1B, tb + 8 * k, F.lane);
            p5::retr_unit(F.lds + RING_OFF, u & 7, u >> 3, QPB, SKB, IDS, GW, RSTD2, F.tid);
#pragma unroll
            for (int k = 0; k < 4; ++k) p6::qx_finish(xq[k], X8, SX, tb + 8 * k, F.lane);
        }
        if (BOTH(5)) xcd_barrier(bar);
    }
    {
        const bf16* H1B = (const bf16*)(ws + WS_H1); const unsigned short* IDS = (const unsigned short*)(ws + WS_IDS); const float* GW = (const float*)(ws + WS_GW);
        const float* RSTD2 = (const float*)(ws + WS_RSTD2); bf16* PART = (bf16*)(ws + WS_PART); unsigned char* W8 = ws + WS_W; float* WS8 = (float*)(ws + WS_WSUM); bf16* ZB = (bf16*)(ws + WS_Z); float* SSF = (float*)(ws + WS_SSL);
        const int slot = (int)blockIdx.x & 7, rank = (int)blockIdx.x >> 3, nrank = (F.G - slot + 7) >> 3;
        const int gw = F.vcu * NWAVES + F.wave, NGW = F.G * NWAVES;
        if (IN(6)) { REP(6) p6::usweep(X8, SX, U8, IDS, PART, slot, rank, nrank, F.wave, F.lane); if (BOTH(6)) xcd_barrier(bar); }
        if (IN(7)) { REP(7) p6::wreduce(PART, GW, RSTD2, IDS, SCU, SCV, W8, WS8, (size_t)gw * 64 + F.lane, (size_t)NGW * 64); if (BOTH(7)) xcd_barrier(bar); }
        if (IN(8)) { REP(8) p6::vsweep(H1B, V8, IDS, W8, WS8, ZB, SSF, slot, rank, nrank, F.wave, F.lane); if (BOTH(8)) xcd_barrier(bar); }
        if (PROBE_PH == 30) { for (int k = 0; k < 16; ++k) xcd_barrier(bar); }
        if (IN(9)) { REP(9) for (int t = gw; t < MREAL; t += NGW) p6::final_row(ZB, SSF, args.in[21], args.out, (size_t)t, F.lane); }
    }
#undef IN
#undef BOTH
}

extern "C" void kernel_launch(void* const* d_in, const int* in_sizes, int n_in, void* d_out, int out_size, void* d_ws, size_t ws_size, hipStream_t stream) {
    static int grid = 0;
    if (grid == 0) {
        int dev = 0, cus = 0;
        if (hipGetDevice(&dev) != hipSuccess || hipDeviceGetAttribute(&cus, hipDeviceAttributeMultiprocessorCount, dev) != hipSuccess) { fprintf(stderr, "kernel_launch: device query failed\n"); grid = -1; return; }
        if (hipFuncSetAttribute((const void*)fwd, hipFuncAttributeMaxDynamicSharedMemorySize, LDS_BYTES) != hipSuccess) { fprintf(stderr, "kernel_launch: hipFuncSetAttribute failed\n"); grid = -1; return; }
        int per_cu = 0;
        if (hipOccupancyMaxActiveBlocksPerMultiprocessor(&per_cu, (const void*)fwd, NWAVES * 64, LDS_BYTES) != hipSuccess || per_cu < 1) fprintf(stderr, "kernel_launch: occupancy query says %d\n", per_cu);
        (void)hipGetLastError();
        grid = cus;
        if (ws_size < WS_END) { fprintf(stderr, "kernel_launch: ws too small %zu\n", ws_size); grid = -1; return; }
    }
    if (grid < 0) return;
    (void)hipMemsetAsync((char*)d_ws + WS_CTL, 0, CTL_ZERO_BYTES, stream);
    Args a{};
    for (int i = 0; i < 22; ++i) a.in[i] = (const float*)d_in[i];
    a.out = (float*)d_out; a.ws = (unsigned char*)d_ws; a.ph_lo = 0; a.ph_hi = 10;
    hipLaunchKernelGGL(fwd, dim3(grid), dim3(NWAVES * 64), LDS_BYTES, stream, a);
}
```

```cpp
#include <hip/hip_runtime.h>
#include <cstdio>
#include <cstdint>
#include <math.h>

#define D 2048
#define NB 8
#define SEQ 2048
#define NMETA 16
#define TT (SEQ + NMETA)
#define MR (NB * TT)
#define MREAL (NB * SEQ)
#define MPAD (MREAL + 256)
#define QD 1024
#define KVD 128
#define LW 1024
#define IND 3328
#define EPS 1e-6f
#define QSCALE (0.125f * 1.4426950408889634f)
#define GAS __attribute__((address_space(1)))
#define LAS __attribute__((address_space(3)))
namespace pg8 {
#define PG8_LAS __attribute__((address_space(3)))
typedef unsigned short bf16_t;
typedef short bf16x8 __attribute__((ext_vector_type(8)));
typedef float f32x4 __attribute__((ext_vector_type(4)));
typedef unsigned u32x4 __attribute__((ext_vector_type(4)));
constexpr int BM = 256, BK = 64, HALF = 128, HTB = HALF * BK * 2  , STAGE_BYTES = 8 * HTB, NXCD = 8, WGM = 8;

__host__ __device__ __forceinline__ int lds_byte(int r, int c) { const int st = (r >> 4) * 2 + (c >> 5), rr = r & 15, cc = c & 31, ob = rr * 64 + cc * 2; return st * 1024 + (ob ^ (((ob >> 9) & 1) << 5)); }
__host__ __device__ __forceinline__ void stage_rc(int b, int& R, int& C) { const int st = b / 1024, sb = b % 1024, swz = sb ^ (((sb >> 9) & 1) << 5); R = (st >> 1) * 16 + swz / 64; C = (st & 1) * 32 + (swz % 64) / 2; }
__host__ __device__ __forceinline__ int perm32(int rho) { const int n = rho >> 4, i = rho & 15; return 8 * (i >> 2) + 4 * n + (i & 3); }

struct Unit { int pm, pn; };
struct Gemm { const bf16_t* A; const bf16_t* Bt; int M, N, K; };

struct StaticOrder {
    int nM, nN, nwg, G, c;
    __host__ __device__ void init(int M, int N, int G_, int c_) { nM = M / BM; nN = N / BM; nwg = nM * nN; G = G_; c = c_; }
    __host__ __device__ bool next(int i, Unit& u) const {
        const long L = (long)i * G + c; if (L >= nwg) return false;
        int wgid = (int)L; { const int q = nwg / NXCD, r = nwg % NXCD, xcd = wgid % NXCD, off = wgid / NXCD; wgid = (xcd < r ? xcd * (q + 1) : r * (q + 1) + (xcd - r) * q) + off; }
        const int nig = WGM * nN, gid = wgid / nig, fm = gid * WGM, gsz = (nM - fm) < WGM ? (nM - fm) : WGM;
        u.pm = fm + ((wgid % nig) % gsz); u.pn = (wgid % nig) / gsz; return true;
    }
    __device__ __forceinline__ void a_ready(const Unit&) const {}
    __device__ __forceinline__ void done(const Unit&) const {}
};

__device__ __forceinline__ unsigned cvt_pk_bf16(float lo, float hi) { unsigned r; asm volatile("v_cvt_pk_bf16_f32 %0, %1, %2" : "=v"(r) : "v"(lo), "v"(hi)); return r; }
typedef unsigned u32x2 __attribute__((ext_vector_type(2)));
struct Order1 {
    int G, c;
    __device__ __forceinline__ bool next(int i, Unit& u) const {
        const int L = i * G + c; if (L >= 837) return false;
        if (L >= 832) { u.pm = 64; u.pn = 4 + (L - 832); return true; }
        const int nwg = 832, nN = 13;
        int wgid = L; { const int q = nwg / NXCD, xcd = wgid % NXCD, off = wgid / NXCD; wgid = xcd * q + off; }
        const int nig = WGM * nN, gid = wgid / nig, fm = gid * WGM;
        u.pm = fm + ((wgid % nig) % WGM); u.pn = (wgid % nig) / WGM; return true;
    }
    __device__ __forceinline__ void a_ready(const Unit&) const {}
    __device__ __forceinline__ void done(const Unit&) const {}
};
struct Order2 {
    int G, c;
    __device__ __forceinline__ bool next(int i, Unit& u) const {
        const int L = i * G + c; if (L >= 512) return false;
        const int nwg = 512, nN = 8;
        int wgid = L; { const int q = nwg / NXCD, xcd = wgid % NXCD, off = wgid / NXCD; wgid = xcd * q + off; }
        const int nig = WGM * nN, gid = wgid / nig, fm = gid * WGM;
        u.pm = fm + ((wgid % nig) % WGM); u.pn = (wgid % nig) / WGM; return true;
    }
    __device__ __forceinline__ void a_ready(const Unit&) const {}
    __device__ __forceinline__ void done(const Unit&) const {}
};

struct Epi1 {
    static constexpr bool PERM = true, AFTER_DRAIN = false, MIDK = false;
    bf16_t *Q, *KV, *XB, *GT; const float* rstd; const float* bias;
    __device__ __forceinline__ void midk(f32x4 (&acc)[2][2][4][2], const Unit& u, int wr, int wc, int fr, int fq) const {}
    __device__ __forceinline__ void operator()(const f32x4 (&acc)[2][2][4][2], const Unit& u, int wr, int wc, int fr, int fq) const {
        const int row0 = u.pm * BM + wr * 64 + fr;
        bf16_t* base; int ldc, colb; float sc = 1.f;
        if (u.pn < 4) { base = Q; ldc = 1024; colb = u.pn * BM; sc = QSCALE; }
        else if (u.pn == 4) { base = KV; ldc = 256; colb = 0; }
        else if (u.pn < 9) { base = XB; ldc = 1024; colb = (u.pn - 5) * BM; }
        else { base = GT; ldc = 1024; colb = (u.pn - 9) * BM; }
        const int col0 = colb + wc * 32 + 8 * fq, bcol0 = u.pn * BM + wc * 32 + 8 * fq;
        f32x4 bv[2][2];
#pragma unroll
        for (int bj = 0; bj < 2; ++bj)
#pragma unroll
            for (int n = 0; n < 2; ++n) bv[bj][n] = *(const f32x4*)(bias + bcol0 + bj * HALF + 4 * n);
#pragma unroll
        for (int ai = 0; ai < 2; ++ai)
#pragma unroll
            for (int m = 0; m < 4; ++m) {
                const int row = row0 + ai * HALF + m * 16; const float rs = rstd[row];
                bf16_t* rowp = base + (size_t)row * ldc + col0;
#pragma unroll
                for (int bj = 0; bj < 2; ++bj) {
                    f32x4 v0 = (acc[ai][bj][m][0] * rs + bv[bj][0]) * sc, v1 = (acc[ai][bj][m][1] * rs + bv[bj][1]) * sc;
                    u32x4 w; w.x = cvt_pk_bf16(v0[0], v0[1]); w.y = cvt_pk_bf16(v0[2], v0[3]); w.z = cvt_pk_bf16(v1[0], v1[1]); w.w = cvt_pk_bf16(v1[2], v1[3]);
                    *(u32x4*)(rowp + bj * HALF) = w; } }
    }
};
struct Epi2 {
    static constexpr bool PERM = true, AFTER_DRAIN = false, MIDK = true;
    bf16_t* H1; const float* x; float* SS2; const LAS float* tbl; int pm0;
    __device__ __forceinline__ void midk(f32x4 (&acc)[2][2][4][2], const Unit& u, int wr, int wc, int fr, int fq) const {
        const LAS float* t = tbl + (u.pm == pm0 ? 0 : 512);
#pragma unroll
        for (int ai = 0; ai < 2; ++ai)
#pragma unroll
            for (int m = 0; m < 4; ++m) { const float ra = t[(ai * HALF + wr * 64 + m * 16 + fr) * 2];
#pragma unroll
                for (int bj = 0; bj < 2; ++bj)
#pragma unroll
                    for (int n = 0; n < 2; ++n) acc[ai][bj][m][n] = acc[ai][bj][m][n] * ra; }
    }
    __device__ __forceinline__ void operator()(const f32x4 (&acc)[2][2][4][2], const Unit& u, int wr, int wc, int fr, int fq) const {
        const LAS float* t = tbl + (u.pm == pm0 ? 0 : 512);
        const int col0 = u.pn * BM + wc * 32 + 8 * fq;
#pragma unroll
        for (int ai = 0; ai < 2; ++ai)
#pragma unroll
            for (int m = 0; m < 4; ++m) {
                const int rl = ai * HALF + wr * 64 + m * 16 + fr; const size_t row = (size_t)u.pm * BM + rl; const float rs = t[rl * 2 + 1];
                float ss = 0.f;
#pragma unroll
                for (int bj = 0; bj < 2; ++bj) {
                    const f32x4 x0 = *(const f32x4*)(x + row * 2048 + col0 + bj * HALF), x1 = *(const f32x4*)(x + row * 2048 + col0 + bj * HALF + 4);
                    const f32x4 v0 = acc[ai][bj][m][0] * rs + x0, v1 = acc[ai][bj][m][1] * rs + x1;
                    ss += (v0[0] * v0[0] + v0[1] * v0[1]) + (v0[2] * v0[2] + v0[3] * v0[3]) + (v1[0] * v1[0] + v1[1] * v1[1]) + (v1[2] * v1[2] + v1[3] * v1[3]);
                    u32x4 w; w.x = cvt_pk_bf16(v0[0], v0[1]); w.y = cvt_pk_bf16(v0[2], v0[3]); w.z = cvt_pk_bf16(v1[0], v1[1]); w.w = cvt_pk_bf16(v1[2], v1[3]);
                    *(u32x4*)(H1 + row * 2048 + col0 + bj * HALF) = w; }
                ss += __shfl_xor(ss, 16); ss += __shfl_xor(ss, 32);
                if (fq == 0) SS2[row * 32 + u.pn * 4 + wc] = ss;
            }
    }
};
struct Epi3 {
    static constexpr bool PERM = true, AFTER_DRAIN = false, MIDK = false;
    bf16_t* O;
    __device__ __forceinline__ void midk(f32x4 (&acc)[2][2][4][2], const Unit& u, int wr, int wc, int fr, int fq) const {}
    __device__ __forceinline__ void operator()(const f32x4 (&acc)[2][2][4][2], const Unit& u, int wr, int wc, int fr, int fq) const {
        const int col0 = u.pn * BM + wc * 32 + 8 * fq;
#pragma unroll
        for (int ai = 0; ai < 2; ++ai)
#pragma unroll
            for (int m = 0; m < 4; ++m) { const size_t row = (size_t)u.pm * BM + ai * HALF + wr * 64 + m * 16 + fr;
#pragma unroll
                for (int bj = 0; bj < 2; ++bj) { const f32x4 v0 = acc[ai][bj][m][0], v1 = acc[ai][bj][m][1];
                    u32x4 w; w.x = cvt_pk_bf16(v0[0], v0[1]); w.y = cvt_pk_bf16(v0[2], v0[3]); w.z = cvt_pk_bf16(v1[0], v1[1]); w.w = cvt_pk_bf16(v1[2], v1[3]);
                    *(u32x4*)(O + row * 2048 + col0 + bj * HALF) = w; } }
    }
};
template <class Epi, class Sched, bool ALIGN_EPI = false, bool SP2 = false>
__device__ __forceinline__ void gemm_phase(PG8_LAS unsigned char* lds, const Gemm g, const Sched& S, const Epi& E) {
    const int tid = threadIdx.x, wid = __builtin_amdgcn_readfirstlane(tid >> 6), lane = tid & 63, wr = wid >> 2, wc = wid & 3, fr = lane & 15, fq = lane >> 4;
    const int K = g.K, nt = K / BK;
    unsigned voffA[2], voffB[2];
#pragma unroll
    for (int i = 0; i < 2; ++i) { int R, C; stage_rc(tid * 16 + i * 8192, R, C); const int Rb = Epi::PERM ? ((R & ~31) + perm32(R & 31)) : R;
        voffA[i] = (unsigned)(R * K + C) * 2u; voffB[i] = (unsigned)(Rb * K + C) * 2u; }
    const size_t kstep = (size_t)(BK * 2);
    const size_t hstep = (size_t)HALF * K * 2;
    const size_t tstep = 2 * hstep;
    const unsigned ldsw = (unsigned)wid * 1024u;
    const int aoff = lds_byte(wr * 64 + fr, fq * 8), boff = lds_byte(wc * 32 + fr, fq * 8);
#define PG8_SA(b, h) (((b) * 2 + (h)) * HTB)
#define PG8_SB(b, h) ((4 + (b) * 2 + (h)) * HTB)
#define PG8_STAGE(bufoff, gbase, voff) do { _Pragma("unroll") for (int _i = 0; _i < 2; ++_i) \
        __builtin_amdgcn_global_load_lds((const unsigned*)((const char*)(gbase) + (voff)[_i]), (PG8_LAS unsigned*)(lds + (bufoff) + ldsw + _i * 8192), 16, 0, 0); } while (0)
#define PG8_LDA(dst, b, h) do { _Pragma("unroll") for (int m = 0; m < 4; ++m) _Pragma("unroll") for (int k = 0; k < 2; ++k) dst[m][k] = *(const PG8_LAS bf16x8*)(lds + PG8_SA(b, h) + aoff + m * 2048 + k * 1024); } while (0)
#define PG8_LDB(dst, b, h) do { _Pragma("unroll") for (int n = 0; n < 2; ++n) _Pragma("unroll") for (int k = 0; k < 2; ++k) dst[n][k] = *(const PG8_LAS bf16x8*)(lds + PG8_SB(b, h) + boff + n * 2048 + k * 1024); } while (0)
#define PG8_MMA(ai, bj, At, Bt) do { __builtin_amdgcn_s_setprio(1); _Pragma("unroll") for (int m = 0; m < 4; ++m) _Pragma("unroll") for (int n = 0; n < 2; ++n) _Pragma("unroll") for (int k = 0; k < 2; ++k) \
        acc[ai][bj][m][n] = __builtin_amdgcn_mfma_f32_16x16x32_bf16(Bt[n][k], At[m][k], acc[ai][bj][m][n], 0, 0, 0); __builtin_amdgcn_s_setprio(0); } while (0)
#define PG8_WAIT_V(n) asm volatile("s_waitcnt vmcnt(" #n ")" ::: "memory")
#define PG8_WAIT_L(n) asm volatile("s_waitcnt lgkmcnt(" #n ")" ::: "memory")
#define PG8_BAR __builtin_amdgcn_s_barrier()
#define PG8_SCHED __builtin_amdgcn_sched_barrier(0)
    Unit cur, nxt; int ui = 0;
    if (!S.next(0, cur)) return;
    f32x4 acc[2][2][4][2];
#pragma unroll
    for (int a = 0; a < 2; ++a)
#pragma unroll
        for (int b = 0; b < 2; ++b)
#pragma unroll
            for (int m = 0; m < 4; ++m)
#pragma unroll
                for (int n = 0; n < 2; ++n) acc[a][b][m][n] = (f32x4){0.f, 0.f, 0.f, 0.f};
    bf16x8 At[4][2], B0[2][2], B1[2][2];
    const char* cA = (const char*)g.A + (size_t)cur.pm * tstep; const char* cB = (const char*)g.Bt + (size_t)cur.pn * tstep;
    S.a_ready(cur);
    if constexpr (SP2) {
        PG8_STAGE(PG8_SB(0, 0), cB, voffB); PG8_STAGE(PG8_SB(0, 1), cB + hstep, voffB); PG8_STAGE(PG8_SA(0, 0), cA, voffA); PG8_STAGE(PG8_SA(0, 1), cA + hstep, voffA);
        if (wr == 1) PG8_BAR;
        PG8_WAIT_V(2); PG8_BAR;
        PG8_STAGE(PG8_SB(1, 0), cB + kstep, voffB); PG8_STAGE(PG8_SA(1, 0), cA + kstep, voffA); PG8_STAGE(PG8_SB(1, 1), cB + hstep + kstep, voffB);
        PG8_WAIT_V(6); PG8_BAR;
    } else {
        PG8_STAGE(PG8_SB(0, 0), cB, voffB); PG8_STAGE(PG8_SA(0, 0), cA, voffA); PG8_STAGE(PG8_SB(0, 1), cB + hstep, voffB); PG8_STAGE(PG8_SA(0, 1), cA + hstep, voffA);
        if (wr == 1) PG8_BAR;
        PG8_WAIT_V(4); PG8_BAR;
        PG8_STAGE(PG8_SB(1, 0), cB + kstep, voffB); PG8_STAGE(PG8_SA(1, 0), cA + kstep, voffA); PG8_STAGE(PG8_SB(1, 1), cB + hstep + kstep, voffB);
        PG8_WAIT_V(6); PG8_BAR;
    }
    for (;;) {
        const bool has_next = S.next(ui + 1, nxt);
        const char* nA = has_next ? (const char*)g.A + (size_t)nxt.pm * tstep : cA; const char* nB = has_next ? (const char*)g.Bt + (size_t)nxt.pn * tstep : cB;
        for (int t = 0; t < nt; t += 2) {
            if constexpr (Epi::MIDK) { if (t == nt / 2) E.midk(acc, cur, wr, wc, fr, fq); }
            const bool last = (t == nt - 2);
            const char* a1 = cA + (size_t)(t + 1) * kstep;
            const char* a2 = last ? nA : cA + (size_t)(t + 2) * kstep; const char* b2 = last ? nB : cB + (size_t)(t + 2) * kstep;
            const char* a3 = a2 + kstep; const char* b3 = b2 + kstep;
            if (last && has_next) S.a_ready(nxt);
            if constexpr (SP2) {
            PG8_LDB(B0, 0, 0); PG8_LDB(B1, 0, 1); PG8_SCHED; PG8_LDA(At, 0, 0); PG8_STAGE(PG8_SA(1, 1), a1 + hstep, voffA);
            PG8_WAIT_V(8); PG8_WAIT_L(0); PG8_BAR; PG8_MMA(0, 0, At, B0); PG8_MMA(0, 1, At, B1); PG8_BAR; PG8_SCHED;
            PG8_LDA(At, 0, 1); PG8_STAGE(PG8_SB(0, 0), b2, voffB); PG8_STAGE(PG8_SB(0, 1), b2 + hstep, voffB); PG8_STAGE(PG8_SA(0, 0), a2, voffA);
            PG8_WAIT_V(8); PG8_WAIT_L(0); PG8_BAR; PG8_MMA(1, 0, At, B0); PG8_MMA(1, 1, At, B1); PG8_BAR; PG8_SCHED;
            PG8_LDB(B0, 1, 0); PG8_LDB(B1, 1, 1); PG8_SCHED; PG8_LDA(At, 1, 0); PG8_STAGE(PG8_SA(0, 1), a2 + hstep, voffA);
            PG8_WAIT_V(8); PG8_WAIT_L(0); PG8_BAR; PG8_MMA(0, 0, At, B0); PG8_MMA(0, 1, At, B1); PG8_BAR; PG8_SCHED;
            PG8_LDA(At, 1, 1); PG8_STAGE(PG8_SB(1, 0), b3, voffB); PG8_STAGE(PG8_SB(1, 1), b3 + hstep, voffB); PG8_STAGE(PG8_SA(1, 0), a3, voffA);
            PG8_WAIT_V(8); PG8_WAIT_L(0); PG8_BAR; PG8_MMA(1, 0, At, B0); PG8_MMA(1, 1, At, B1); PG8_BAR; PG8_SCHED;
            } else {
            PG8_LDB(B0, 0, 0); PG8_SCHED; PG8_LDA(At, 0, 0); PG8_STAGE(PG8_SA(1, 1), a1 + hstep, voffA);
            PG8_WAIT_L(8); PG8_BAR; PG8_WAIT_L(0); PG8_MMA(0, 0, At, B0); PG8_BAR; PG8_SCHED;
            PG8_LDB(B1, 0, 1); PG8_STAGE(PG8_SB(0, 0), b2, voffB);
            PG8_BAR; PG8_WAIT_L(0); PG8_MMA(0, 1, At, B1); PG8_BAR;
            PG8_LDA(At, 0, 1); PG8_STAGE(PG8_SA(0, 0), a2, voffA);
            PG8_BAR; PG8_WAIT_L(0); PG8_MMA(1, 0, At, B0); PG8_BAR; PG8_SCHED;
            PG8_STAGE(PG8_SB(0, 1), b2 + hstep, voffB);
            PG8_WAIT_V(6); PG8_BAR; PG8_MMA(1, 1, At, B1); PG8_BAR;
            PG8_LDB(B0, 1, 0); PG8_SCHED; PG8_LDA(At, 1, 0); PG8_STAGE(PG8_SA(0, 1), a2 + hstep, voffA);
            PG8_WAIT_L(8); PG8_BAR; PG8_WAIT_L(0); PG8_MMA(0, 0, At, B0); PG8_BAR; PG8_SCHED;
            PG8_LDB(B1, 1, 1); PG8_STAGE(PG8_SB(1, 0), b3, voffB);
            PG8_BAR; PG8_WAIT_L(0); PG8_MMA(0, 1, At, B1); PG8_BAR;
            PG8_LDA(At, 1, 1); PG8_STAGE(PG8_SA(1, 0), a3, voffA);
            PG8_BAR; PG8_WAIT_L(0); PG8_MMA(1, 0, At, B0); PG8_BAR; PG8_SCHED;
            PG8_STAGE(PG8_SB(1, 1), b3 + hstep, voffB);
            PG8_WAIT_V(6); PG8_BAR; PG8_MMA(1, 1, At, B1); PG8_BAR;
            }
        }
        if constexpr (ALIGN_EPI) { if (wr == 0) PG8_BAR; }
        if constexpr (!Epi::AFTER_DRAIN) { E(acc, cur, wr, wc, fr, fq); S.done(cur); }
        if (!has_next) break;
#pragma unroll
        for (int a = 0; a < 2; ++a)
#pragma unroll
            for (int b = 0; b < 2; ++b)
#pragma unroll
                for (int m = 0; m < 4; ++m)
#pragma unroll
                    for (int n = 0; n < 2; ++n) acc[a][b][m][n] = (f32x4){0.f, 0.f, 0.f, 0.f};
        cur = nxt; cA = nA; cB = nB; ++ui;
        if constexpr (ALIGN_EPI) { if (wr == 1) PG8_BAR; }
    }
    PG8_WAIT_V(0);
    if constexpr (!ALIGN_EPI) { if (wr == 0) PG8_BAR; }
    PG8_BAR;
    if constexpr (Epi::AFTER_DRAIN) { E.fused(acc, cur, wr, wc, fr, fq, lds, wid, lane); S.done(cur); }
#undef PG8_SA
#undef PG8_SB
#undef PG8_STAGE
#undef PG8_LDA
#undef PG8_LDB
#undef PG8_MMA
#undef PG8_WAIT_V
#undef PG8_WAIT_L
#undef PG8_BAR
#undef PG8_SCHED
}
}
#define XB_TMO      128
#define XB_XCNT(j)  (256  + 64 * (j))
#define XB_XSUB(j)  (1280 + 64 * (j))
#define XB_XGEN(j)  (2304 + 64 * (j))
#define XB_TOP      3328
#define XB_TOPGEN   3392
#define XCD_BAR_WORDS 3456
#define XB_SPIN_CAP (1u << 18)

__device__ __forceinline__ unsigned xb_ld(unsigned* p)              { return __hip_atomic_load(p, __ATOMIC_RELAXED, __HIP_MEMORY_SCOPE_AGENT); }
__device__ __forceinline__ unsigned xb_add(unsigned* p, unsigned v) { return __hip_atomic_fetch_add(p, v, __ATOMIC_RELAXED, __HIP_MEMORY_SCOPE_AGENT); }
__device__ __forceinline__ unsigned xb_xcc_id() { return (unsigned)__builtin_amdgcn_s_getreg((3 << 11) | 20) & 0xFu; }
#define XB_SPIN(cond, bar) do { unsigned _sp = 0; while (cond) { __builtin_amdgcn_s_sleep(1); \
    if ((++_sp & 255u) == 0u) { if (xb_ld(&(bar)[XB_TMO])) break; if (_sp > XB_SPIN_CAP) { atomicAdd(&(bar)[XB_TMO], 1u); break; } } } } while (0)

struct XcdBarrier {
    unsigned* bar; unsigned x;
    volatile LAS unsigned* st;
};

__device__ __forceinline__ XcdBarrier xcd_barrier_post(unsigned* bar, volatile LAS unsigned* st) {
    XcdBarrier b; b.bar = bar; b.x = xb_xcc_id(); b.st = st;
    if (threadIdx.x == 0) (void)xb_add(&bar[XB_XCNT(b.x)], 1u);
    return b;
}
__device__ __forceinline__ void xcd_barrier_complete(unsigned* bar, unsigned x, unsigned& nloc, unsigned& nx) {
    const unsigned G = gridDim.x * gridDim.y * gridDim.z;
    unsigned sum, cnt, mine, sp = 0u;
    for (;;) {
        sum = 0u; cnt = 0u; mine = 0u;
#pragma unroll
        for (unsigned j = 0; j < 16; ++j) { const unsigned c = xb_ld(&bar[XB_XCNT(j)]); sum += c; cnt += (c > 0u) ? 1u : 0u; mine = (j == x) ? c : mine; }
        if (sum == G) break;
        __builtin_amdgcn_s_sleep(1);
        if ((++sp & 255u) == 0u) { if (xb_ld(&bar[XB_TMO])) break; if (sp > XB_SPIN_CAP) { atomicAdd(&bar[XB_TMO], 1u); break; } }
    }
    nloc = mine > 0u ? mine : 1u; nx = cnt > 0u ? cnt : 1u;
}

__device__ __forceinline__ void xcd_barrier(const XcdBarrier& b) {
    asm volatile("s_waitcnt vmcnt(0)" ::: "memory");
    __syncthreads();
    if (threadIdx.x == 0) {
        unsigned* bar = b.bar;
        __builtin_amdgcn_s_waitcnt(0);
        unsigned nloc = b.st[0], nx = b.st[1];
        if (nloc == 0u) { xcd_barrier_complete(bar, b.x, nloc, nx); b.st[0] = nloc; b.st[1] = nx; }
        const unsigned old = xb_add(&bar[XB_XSUB(b.x)], 1u);
        const unsigned gen = old / nloc;
        if (old + 1u == (gen + 1u) * nloc) {
            __builtin_amdgcn_fence(__ATOMIC_RELEASE, "agent");
            asm volatile("s_waitcnt vmcnt(0)" ::: "memory");
            const unsigned og = xb_add(&bar[XB_TOP], 1u);
            const unsigned tg = og / nx;
            if (og + 1u == (tg + 1u) * nx) xb_add(&bar[XB_TOPGEN], 1u);
            else XB_SPIN(xb_ld(&bar[XB_TOPGEN]) == tg, bar);
            __builtin_amdgcn_fence(__ATOMIC_ACQUIRE, "agent");
            xb_add(&bar[XB_XGEN(b.x)], 1u);
            asm volatile("s_waitcnt vmcnt(0)" ::: "memory");
        } else {
            XB_SPIN(xb_ld(&bar[XB_XGEN(b.x)]) == gen, bar);
            __builtin_amdgcn_fence(__ATOMIC_ACQUIRE, "agent");
            asm volatile("s_waitcnt vmcnt(0)" ::: "memory");
        }
    }
    __syncthreads();
}

constexpr int NWAVES = 8;
constexpr size_t MiB = 1u << 20;
constexpr size_t WS_CTL = 0, CTL_ZERO_BYTES = 1 * MiB;
constexpr size_t WS_W1T = 2 * MiB;
constexpr size_t WS_W2T = 16 * MiB;
constexpr size_t WS_W3T = 24 * MiB;
constexpr size_t WS_SKB = 32 * MiB;
constexpr size_t WS_RSTD1 = 33 * MiB;
constexpr size_t WS_SSA = 34 * MiB;
constexpr size_t WS_SSL = 35 * MiB;
constexpr size_t WS_SS2 = 37 * MiB;
constexpr size_t WS_RSTD2 = 39 * MiB;
constexpr size_t WS_IDS = 40 * MiB;
constexpr size_t WS_GW = 48 * MiB;
constexpr size_t WS_U8 = 64 * MiB;
constexpr size_t WS_V8 = 96 * MiB;
constexpr size_t WS_X8 = 128 * MiB;
constexpr size_t WS_SX = 160 * MiB;
constexpr size_t WS_SCU = 162 * MiB;
constexpr size_t WS_SCV = 163 * MiB;
constexpr size_t WS_WSUM = 164 * MiB;
constexpr size_t WS_A1 = 192 * MiB;
constexpr size_t WS_Q = 258 * MiB;
constexpr size_t WS_KV = 290 * MiB;
constexpr size_t WS_XB = 299 * MiB;
constexpr size_t WS_GT = 332 * MiB;
constexpr size_t WS_H1 = 364 * MiB;
constexpr size_t WS_PART = 192 * MiB;
constexpr size_t WS_W = 56 * MiB;
constexpr size_t WS_Z = 428 * MiB;
constexpr size_t WS_END = 492 * MiB;
constexpr int CW_QROW = 2048;
constexpr int CW_BAR = 4096;

constexpr int RING_OFF = 0, RING_BYTES = 131072;
constexpr int LDSCTL_OFF = RING_BYTES, MISC_OFF = LDSCTL_OFF + 320;
constexpr int LDS_BYTES = 147456;

typedef unsigned short bf16;
typedef unsigned v4u __attribute__((ext_vector_type(4)));
typedef float f32x4 __attribute__((ext_vector_type(4)));
typedef short bf16x8 __attribute__((ext_vector_type(8)));
typedef GAS unsigned gu32;
#define RLX_AGENT __ATOMIC_RELAXED, __HIP_MEMORY_SCOPE_AGENT
#define LDS_WAIT() asm volatile("s_waitcnt lgkmcnt(0)" ::: "memory")
#define VM_WAIT() asm volatile("s_waitcnt vmcnt(0)" ::: "memory")
__device__ __forceinline__ unsigned f2bf(float f) { unsigned u = __builtin_bit_cast(unsigned, f); return (u + 0x7fffu + ((u >> 16) & 1u)) >> 16; }
__device__ __forceinline__ unsigned pk2(float lo, float hi) { return f2bf(lo) | (f2bf(hi) << 16); }
__device__ __forceinline__ float bf2f(unsigned short b) { return __builtin_bit_cast(float, (unsigned)b << 16); }

namespace p2 {
typedef float f32x16 __attribute__((ext_vector_type(16)));
typedef unsigned u32x2 __attribute__((ext_vector_type(2)));
constexpr float LOG2E = 1.4426950408889634f;
constexpr float NEGBIG = -1e30f;
__device__ __forceinline__ int crow(int r, int hi) { return (r & 3) + 8 * (r >> 2) + 4 * hi; }
__device__ __forceinline__ unsigned cvtpk(float lo, float hi) { unsigned r; asm volatile("v_cvt_pk_bf16_f32 %0, %1, %2" : "=v"(r) : "v"(lo), "v"(hi)); return r; }
__device__ __forceinline__ float ex2(float x) { return __builtin_amdgcn_exp2f(x); }
__device__ __forceinline__ float rcp(float x) { return __builtin_amdgcn_rcpf(x); }
__device__ __forceinline__ float gelu_fast(float x) { return x * rcp(1.0f + ex2(-2.302208198f * x * (1.0f + 0.044715f * x * x))); }

constexpr int A_KS = 0, A_KSP = 144, A_VT = 288 * 144, A_VTP = 584, A_ST = A_VT + 64 * 584, A_END = A_ST + 8 * 4096;
__device__ __forceinline__ void attn_unit(LAS unsigned char* lds, int b, int qblk, int kvh, const bf16* QB, const bf16* KVB, const float* sinks, bf16* MIX, float* SSA, int tid) {
    const int lane = tid & 63, wave = __builtin_amdgcn_readfirstlane(tid >> 6), r = lane & 31, hi = lane >> 5;
    const int q0 = qblk * 128, hq = kvh * 8 + wave;
    for (int it = 0; it < 5; ++it) {
        const int cid = it * 512 + tid;
        if (cid < 288 * 8) {
            const int key = cid >> 3, ch = cid & 7;
            bool valid; size_t row = 0;
            if (key < 256) { const int pos = q0 - 128 + key; valid = pos >= 0; row = (size_t)b * SEQ + pos; }
            else if (key < 272) { valid = true; row = (size_t)MREAL + (key - 256); }
            else valid = false;
            v4u kv = {0u, 0u, 0u, 0u}, vv = {0u, 0u, 0u, 0u};
            if (valid) { kv = *(const GAS v4u*)(KVB + row * 256 + kvh * 64 + ch * 8); vv = *(const GAS v4u*)(KVB + row * 256 + 128 + kvh * 64 + ch * 8); }
            *(LAS v4u*)(lds + A_KS + key * A_KSP + ch * 16) = kv;
            LAS unsigned short* vt = (LAS unsigned short*)(lds + A_VT);
#pragma unroll
            for (int j = 0; j < 8; ++j) { const unsigned wv = vv[j >> 1]; vt[(ch * 8 + j) * (A_VTP / 2) + key] = (unsigned short)((j & 1) ? (wv >> 16) : (wv & 0xffffu)); }
        }
    }
    __syncthreads();
    const float sink2 = sinks[hq] * LOG2E;
    for (int qg = 0; qg < 4; ++qg) {
        const size_t mrow = (size_t)b * SEQ + q0 + 32 * qg + r;
        bf16x8 qf[4];
#pragma unroll
        for (int ks = 0; ks < 4; ++ks) qf[ks] = *(const GAS bf16x8*)(QB + mrow * 1024 + hq * 64 + ks * 16 + hi * 8);
        f32x16 s[6];
#pragma unroll
        for (int t = 0; t < 6; ++t) {
            const int kbase = t < 5 ? 32 * (qg + t) : 256;
            f32x16 acc = {0.f, 0.f, 0.f, 0.f, 0.f, 0.f, 0.f, 0.f, 0.f, 0.f, 0.f, 0.f, 0.f, 0.f, 0.f, 0.f};
#pragma unroll
            for (int ks = 0; ks < 4; ++ks) {
                const bf16x8 kf = *(const LAS bf16x8*)(lds + A_KS + (kbase + r) * A_KSP + ks * 32 + hi * 16);
                acc = __builtin_amdgcn_mfma_f32_32x32x16_bf16(kf, qf[ks], acc, 0, 0, 0);
            }
            s[t] = acc;
        }
        const bool blk0 = (qblk == 0);
#pragma unroll
        for (int reg = 0; reg < 16; ++reg) {
            const int j = crow(reg, hi);
            s[0][reg] = (j > r) ? s[0][reg] : NEGBIG;
            s[4][reg] = (j <= r) ? s[4][reg] : NEGBIG;
            s[5][reg] = (j < 16) ? s[5][reg] : NEGBIG;
        }
#pragma unroll
        for (int t = 0; t < 4; ++t) if (blk0 && (qg + t < 4)) {
#pragma unroll
            for (int reg = 0; reg < 16; ++reg) s[t][reg] = NEGBIG;
        }
        float m = sink2;
#pragma unroll
        for (int t = 0; t < 6; ++t)
#pragma unroll
            for (int reg = 0; reg < 16; ++reg) m = fmaxf(m, s[t][reg]);
        m = fmaxf(m, __shfl_xor(m, 32));
        float l = 0.f;
#pragma unroll
        for (int t = 0; t < 6; ++t)
#pragma unroll
            for (int reg = 0; reg < 16; ++reg) { const float p = ex2(s[t][reg] - m); s[t][reg] = p; l += p; }
        l += __shfl_xor(l, 32);
        l += ex2(sink2 - m);
        const float linv = 1.0f / l;
        f32x16 o0 = {0.f, 0.f, 0.f, 0.f, 0.f, 0.f, 0.f, 0.f, 0.f, 0.f, 0.f, 0.f, 0.f, 0.f, 0.f, 0.f}, o1 = o0;
#pragma unroll
        for (int t = 0; t < 6; ++t) {
            const int kbase = t < 5 ? 32 * (qg + t) : 256;
#pragma unroll
            for (int ss = 0; ss < 2; ++ss) {
                v4u pw; pw.x = cvtpk(s[t][8 * ss + 0], s[t][8 * ss + 1]); pw.y = cvtpk(s[t][8 * ss + 2], s[t][8 * ss + 3]);
                pw.z = cvtpk(s[t][8 * ss + 4], s[t][8 * ss + 5]); pw.w = cvtpk(s[t][8 * ss + 6], s[t][8 * ss + 7]);
                const bf16x8 pa = __builtin_bit_cast(bf16x8, pw);
                const int ko = (kbase + 16 * ss + 4 * hi) * 2;
                {   const u32x2 lo = *(const LAS u32x2*)(lds + A_VT + r * A_VTP + ko), h2 = *(const LAS u32x2*)(lds + A_VT + r * A_VTP + ko + 16);
                    v4u vw; vw.x = lo.x; vw.y = lo.y; vw.z = h2.x; vw.w = h2.y;
                    o0 = __builtin_amdgcn_mfma_f32_32x32x16_bf16(pa, __builtin_bit_cast(bf16x8, vw), o0, 0, 0, 0); }
                {   const u32x2 lo = *(const LAS u32x2*)(lds + A_VT + (32 + r) * A_VTP + ko), h2 = *(const LAS u32x2*)(lds + A_VT + (32 + r) * A_VTP + ko + 16);
                    v4u vw; vw.x = lo.x; vw.y = lo.y; vw.z = h2.x; vw.w = h2.y;
                    o1 = __builtin_amdgcn_mfma_f32_32x32x16_bf16(pa, __builtin_bit_cast(bf16x8, vw), o1, 0, 0, 0); }
            }
        }
        LAS unsigned short* stg = (LAS unsigned short*)(lds + A_ST + wave * 4096);
#pragma unroll
        for (int reg = 0; reg < 16; ++reg) {
            const int qr = crow(reg, hi); const float li = __shfl(linv, qr);
            stg[qr * 64 + r] = (unsigned short)f2bf(o0[reg] * li);
            stg[qr * 64 + 32 + r] = (unsigned short)f2bf(o1[reg] * li);
        }
        asm volatile("s_waitcnt lgkmcnt(0)" ::: "memory");
#pragma unroll
        for (int i = 0; i < 4; ++i) {
            const int row = i * 8 + (lane >> 3), ch = lane & 7;
            const v4u v = *(const LAS v4u*)(stg + row * 64 + ch * 8);
            float ss = 0.f;
#pragma unroll
            for (int k = 0; k < 4; ++k) { const float a = __builtin_bit_cast(float, v[k] << 16), c = __builtin_bit_cast(float, v[k] & 0xffff0000u); ss += a * a + c * c; }
            ss += __shfl_xor(ss, 1); ss += __shfl_xor(ss, 2); ss += __shfl_xor(ss, 4);
            const size_t orow = (size_t)b * SEQ + q0 + 32 * qg + row;
            *(GAS v4u*)(MIX + orow * D + hq * 64 + ch * 8) = v;
            if (ch == 0) SSA[orow * 16 + hq] = ss;
        }
        asm volatile("s_waitcnt lgkmcnt(0)" ::: "memory");
    }
    __syncthreads();
}

constexpr int L_XS = 0, L_XC = 33280, L_XCF = L_XC + 36864, L_GS = L_XCF + 32768, L_W = L_GS + 16384, L_CT = L_W + 9216, L_END = L_CT + 2048;
static_assert(L_END <= 131072, "lru lds");
struct LruP { const float *conv_w, *conv_b, *w_r, *b_r, *w_i, *b_i, *lam; };
__device__ __forceinline__ void lru_unit(LAS unsigned char* lds, int b, int nb, int cg, const bf16* XBB, const bf16* GTB, const LruP P, bf16* MIX, float* SSL, int tid) {
    const int lane = tid & 63, wave = __builtin_amdgcn_readfirstlane(tid >> 6), r = lane & 31, hi = lane >> 5;
    {
        LAS unsigned short* wt = (LAS unsigned short*)(lds + L_W);
#pragma unroll
        for (int i = 0; i < 4; ++i) {
            const int e = tid + 512 * i, c = e >> 5, dl = e & 31;
            const size_t gi = (size_t)(nb * 64 + c) * 64 + 32 * cg + dl;
            wt[dl * 72 + c] = (unsigned short)f2bf(P.w_r[gi]);
            wt[32 * 72 + dl * 72 + c] = (unsigned short)f2bf(P.w_i[gi]);
        }
    }
    const int cc = tid & 63, chc = nb * 64 + cc;
    const float cw0 = P.conv_w[0 * LW + chc], cw1 = P.conv_w[1 * LW + chc], cw2 = P.conv_w[2 * LW + chc], cw3 = P.conv_w[3 * LW + chc], cbv = P.conv_b[chc];
    const int chd = nb * 64 + 32 * cg + r;
    const float br = P.b_r[chd], bi = P.b_i[chd];
    const float ls8 = -8.0f * log1pf(expf(-P.lam[chd])) * LOG2E;
    float state = 0.f;
    for (int tile = 0; tile < 9; ++tile) {
        for (int it = 0; it < 5; ++it) {
            const int cid = it * 512 + tid;
            if (cid < 259 * 8) {
                const int j = cid >> 3, ch = cid & 7, t = j - 3;
                bool valid; size_t row = 0;
                if (tile == 0) { valid = (t >= 0 && t < NMETA); row = (size_t)MREAL + t; }
                else if (tile == 1 && t < 0) { valid = true; row = (size_t)MREAL + NMETA + t; }
                else { valid = true; row = (size_t)b * SEQ + 256 * (tile - 1) + t; }
                v4u v = {0u, 0u, 0u, 0u};
                if (valid) v = *(const GAS v4u*)(XBB + row * 1024 + nb * 64 + ch * 8);
                *(LAS v4u*)(lds + L_XS + j * 128 + ch * 16) = v;
            }
        }
        if (tile > 0) {
#pragma unroll
            for (int it = 0; it < 2; ++it) {
                const int cid = it * 512 + tid, t = cid >> 2, ch = cid & 3;
                const size_t row = (size_t)b * SEQ + 256 * (tile - 1) + t;
                *(LAS v4u*)(lds + L_GS + t * 64 + ch * 16) = *(const GAS v4u*)(GTB + row * 1024 + nb * 64 + 32 * cg + ch * 8);
            }
        }
        __syncthreads();
        {
            const LAS unsigned short* xs = (const LAS unsigned short*)(lds + L_XS);
            LAS unsigned short* xc = (LAS unsigned short*)(lds + L_XC);
            LAS float* xcf = (LAS float*)(lds + L_XCF);
            const int t0 = 32 * wave;
            float x0 = bf2f(xs[(t0 + 0) * 64 + cc]), x1 = bf2f(xs[(t0 + 1) * 64 + cc]), x2 = bf2f(xs[(t0 + 2) * 64 + cc]);
#pragma unroll 8
            for (int k = 0; k < 32; ++k) {
                const float x3 = bf2f(xs[(t0 + k + 3) * 64 + cc]);
                const float v = cbv + cw0 * x0 + cw1 * x1 + cw2 * x2 + cw3 * x3;
                xc[(t0 + k) * 72 + cc] = (unsigned short)f2bf(v);
                if ((cc >> 5) == cg) xcf[(t0 + k) * 32 + (cc & 31)] = v;
                x0 = x1; x1 = x2; x2 = x3;
            }
        }
        __syncthreads();
        f32x16 aR = {0.f, 0.f, 0.f, 0.f, 0.f, 0.f, 0.f, 0.f, 0.f, 0.f, 0.f, 0.f, 0.f, 0.f, 0.f, 0.f}, aI = aR;
#pragma unroll
        for (int ks = 0; ks < 4; ++ks) {
            const bf16x8 xa = *(const LAS bf16x8*)(lds + L_XC + (32 * wave + r) * 144 + ks * 32 + hi * 16);
            const bf16x8 wr_ = *(const LAS bf16x8*)(lds + L_W + r * 144 + ks * 32 + hi * 16);
            const bf16x8 wi_ = *(const LAS bf16x8*)(lds + L_W + 32 * 144 + r * 144 + ks * 32 + hi * 16);
            aR = __builtin_amdgcn_mfma_f32_32x32x16_bf16(xa, wr_, aR, 0, 0, 0);
            aI = __builtin_amdgcn_mfma_f32_32x32x16_bf16(xa, wi_, aI, 0, 0, 0);
        }
        float Av[16], Bv[16];
        {
            const LAS float* xcf = (const LAS float*)(lds + L_XCF);
#pragma unroll
            for (int reg = 0; reg < 16; ++reg) {
                const int t = 32 * wave + crow(reg, hi);
                const bool valid = (tile > 0) || (t < NMETA);
                const float rg = rcp(1.0f + ex2(-(aR[reg] + br) * LOG2E));
                const float ig = rcp(1.0f + ex2(-(aI[reg] + bi) * LOG2E));
                const float a = ex2(rg * ls8);
                const float mult = __builtin_amdgcn_sqrtf(fmaxf(1.0f - a * a, 0.f));
                const float bx = mult * ig * xcf[t * 32 + r];
                Av[reg] = valid ? a : 1.0f; Bv[reg] = valid ? bx : 0.0f;
            }
        }
#pragma unroll
        for (int g = 0; g < 4; ++g) {
#pragma unroll
            for (int k = 1; k < 4; ++k) { Bv[4 * g + k] = Av[4 * g + k] * Bv[4 * g + k - 1] + Bv[4 * g + k]; Av[4 * g + k] = Av[4 * g + k] * Av[4 * g + k - 1]; }
        }
        float myCz[4], myCp[4], PW, HW;
        {
            float cz = 0.f, cp = 1.f;
#pragma unroll
            for (int g = 0; g < 4; ++g) {
                const float mP = Av[4 * g + 3], mH = Bv[4 * g + 3];
                const float oP = __shfl_xor(mP, 32), oH = __shfl_xor(mH, 32);
                const float eP = hi ? oP : mP, eH = hi ? oH : mH, dP = hi ? mP : oP, dH = hi ? mH : oH;
                const float cz0 = cz, cp0 = cp;
                cz = eP * cz + eH; cp = cp * eP;
                myCz[g] = hi ? cz : cz0; myCp[g] = hi ? cp : cp0;
                cz = dP * cz + dH; cp = cp * dP;
            }
            PW = cp; HW = cz;
        }
        if (hi == 0) { LAS float* ct = (LAS float*)(lds + L_CT); ct[(wave * 32 + r) * 2] = PW; ct[(wave * 32 + r) * 2 + 1] = HW; }
        __syncthreads();
        float cin = 0.f;
        {
            const LAS float* ct = (const LAS float*)(lds + L_CT);
            float c = state;
#pragma unroll
            for (int w2 = 0; w2 < 8; ++w2) { if (w2 == wave) cin = c; c = ct[(w2 * 32 + r) * 2] * c + ct[(w2 * 32 + r) * 2 + 1]; }
            state = c;
        }
        if (tile > 0) {
            const LAS unsigned short* gs = (const LAS unsigned short*)(lds + L_GS);
            LAS unsigned short* os = (LAS unsigned short*)(lds + L_XS);
#pragma unroll
            for (int reg = 0; reg < 16; ++reg) {
                const int g = reg >> 2, t = 32 * wave + crow(reg, hi);
                const float h = Bv[reg] + Av[reg] * (myCz[g] + myCp[g] * cin);
                const float gt = bf2f(gs[t * 32 + r]);
                os[t * 32 + r] = (unsigned short)f2bf(gelu_fast(gt) * h);
            }
        }
        __syncthreads();
        if (tile > 0) {
#pragma unroll
            for (int it = 0; it < 2; ++it) {
                const int cid = it * 512 + tid, t = cid >> 2, ch = cid & 3;
                const v4u v = *(const LAS v4u*)(lds + L_XS + t * 64 + ch * 16);
                float ss = 0.f;
#pragma unroll
                for (int k = 0; k < 4; ++k) { const float a = __builtin_bit_cast(float, v[k] << 16), c = __builtin_bit_cast(float, v[k] & 0xffff0000u); ss += a * a + c * c; }
                ss += __shfl_xor(ss, 1); ss += __shfl_xor(ss, 2);
                const size_t row = (size_t)b * SEQ + 256 * (tile - 1) + t;
                *(GAS v4u*)(MIX + row * D + 1024 + nb * 64 + 32 * cg + ch * 8) = v;
                if (ch == 0) SSL[row * 32 + nb * 2 + cg] = ss;
            }
        }
        __syncthreads();
    }
}
}

namespace p5 {
typedef float f32x16 __attribute__((ext_vector_type(16)));
constexpr int KP = 272;
constexpr int R_KEYS = 0, R_IDX = 256 * KP, R_END = R_IDX + 8 * 1024;
__device__ __forceinline__ int crow(int r, int hi) { return (r & 3) + 8 * (r >> 2) + 4 * hi; }
__device__ __forceinline__ float fkey(float s, int mask, int payload) { return __builtin_bit_cast(float, (__builtin_bit_cast(int, s) & mask) | payload); }
__device__ __forceinline__ int fbits(float f) { return __builtin_bit_cast(int, f); }
__device__ __forceinline__ float fval(float f, int mask) { return __builtin_bit_cast(float, __builtin_bit_cast(int, f) & mask); }
__device__ __forceinline__ void ins16(float (&L)[16], float v) {
#pragma unroll
    for (int k = 15; k >= 1; --k) L[k] = __builtin_amdgcn_fmed3f(L[k - 1], L[k], v);
    L[0] = fmaxf(L[0], v);
}
__device__ __forceinline__ void half_top16(const LAS unsigned char* keys, const bf16x8 (&qf)[8], int r, int hi, float (&T)[16]) {
    float L[16];
#pragma unroll
    for (int k = 0; k < 16; ++k) L[k] = -INFINITY;
    const int h4 = 4 * hi;
#pragma unroll
    for (int kt = 0; kt < 4; ++kt) {
        f32x16 acc = {0.f, 0.f, 0.f, 0.f, 0.f, 0.f, 0.f, 0.f, 0.f, 0.f, 0.f, 0.f, 0.f, 0.f, 0.f, 0.f};
#pragma unroll
        for (int ks = 0; ks < 8; ++ks) {
            const bf16x8 kf = *(const LAS bf16x8*)(keys + (kt * 32 + r) * KP + ks * 32 + hi * 16);
            acc = __builtin_amdgcn_mfma_f32_32x32x16_bf16(kf, qf[ks], acc, 0, 0, 0);
        }
#pragma unroll
        for (int reg = 0; reg < 16; ++reg) {
            const int C = 127 - 32 * kt - (reg & 3) - 8 * (reg >> 2);
            ins16(L, fkey(acc[reg], (int)0xffffff80, C - h4));
        }
    }
    float M[16];
#pragma unroll
    for (int i = 0; i < 16; ++i) M[i] = fmaxf(L[i], __shfl_xor(L[15 - i], 32));
#define P5_STAGE(st) _Pragma("unroll") for (int i = 0; i < 16; ++i) if ((i & (st)) == 0) { const float a = fmaxf(M[i], M[i + (st)]), b = fminf(M[i], M[i + (st)]); M[i] = a; M[i + (st)] = b; }
    P5_STAGE(8) P5_STAGE(4) P5_STAGE(2) P5_STAGE(1)
#undef P5_STAGE
#pragma unroll
    for (int i = 0; i < 16; ++i) T[i] = M[i];
}

__device__ __forceinline__ void retr_unit(LAS unsigned char* lds, int h, int tg, const bf16* QPB, const bf16* SKB, unsigned short* IDS, float* GW, const float* RSTD2, int tid) {
    const int lane = tid & 63, wave = __builtin_amdgcn_readfirstlane(tid >> 6), r = lane & 31, hi = lane >> 5;
#pragma unroll
    for (int it = 0; it < 8; ++it) {
        const int cid = it * 512 + tid, row = cid >> 4, ch = cid & 15;
        *(LAS v4u*)(lds + R_KEYS + row * KP + ch * 16) = *(const GAS v4u*)(SKB + ((size_t)h * 256 + row) * 128 + ch * 8);
    }
    const size_t tok = (size_t)tg * 256 + wave * 32 + r;
    bf16x8 qa[8], qb[8];
#pragma unroll
    for (int ks = 0; ks < 8; ++ks) { qa[ks] = *(const GAS bf16x8*)(QPB + tok * D + h * 256 + ks * 16 + hi * 8); qb[ks] = *(const GAS bf16x8*)(QPB + tok * D + h * 256 + 128 + ks * 16 + hi * 8); }
    const float rs = RSTD2[tok];
    __syncthreads();
    float TA[16], TB[16];
    half_top16(lds + R_KEYS, qa, r, hi, TA);
    half_top16(lds + R_KEYS + 128 * KP, qb, r, hi, TB);
    LAS unsigned char* sc = lds + R_IDX + wave * 1024 + r * 32;
    const int hm = -hi;
    {
        v4u w;
#pragma unroll
        for (int q = 0; q < 4; ++q) { unsigned x = 0;
#pragma unroll
            for (int k = 0; k < 4; ++k) { const int t = (fbits(TB[4 * q + k]) & hm) | (fbits(TA[4 * q + k]) & ~hm); x |= (unsigned)(127 - (t & 0x7f)) << (8 * k); }
            w[q] = x; }
        *(LAS v4u*)(sc + hi * 16) = w;
    }
    float sA[16], sB[16];
#pragma unroll
    for (int i = 0; i < 16; ++i) { sA[i] = fval(TA[i], (int)0xffffff80); sB[i] = fval(TB[i], (int)0xffffff80); }
    float L[16];
#pragma unroll
    for (int k = 0; k < 16; ++k) L[k] = -INFINITY;
#pragma unroll
    for (int i = 0; i < 16; ++i)
#pragma unroll
        for (int j = 0; j < 16; ++j) if ((i + 1) * (j + 1) <= 16) {
            ins16(L, fkey(sA[i] + sB[j], (int)0xffffff00, 255 - (i * 16 + j)));
        }
    const float v0 = fval(L[0], (int)0xffffff00);
    asm volatile("s_waitcnt lgkmcnt(0)" ::: "memory");
    int ex[8]; float ew[8]; float esum = 0.f;
#pragma unroll
    for (int k = 0; k < 8; ++k) {
        const int t = (fbits(L[8 + k]) & hm) | (fbits(L[k]) & ~hm);
        const int c = 255 - (t & 0xff);
        const int ia = sc[c >> 4], ib = sc[16 + (c & 15)];
        ex[k] = ia * 128 + ib;
        const float e = __builtin_amdgcn_exp2f((__builtin_bit_cast(float, t & (int)0xffffff00) - v0) * rs * 1.4426950408889634f);
        ew[k] = e; esum += e;
    }
    esum += __shfl_xor(esum, 32);
    const float inv = 1.0f / esum;
    unsigned short* ip = IDS + tok * 128 + h * 16 + hi * 8; float* gp = GW + tok * 128 + h * 16 + hi * 8;
    *(GAS v4u*)(ip) = (v4u){(unsigned)ex[0] | ((unsigned)ex[1] << 16), (unsigned)ex[2] | ((unsigned)ex[3] << 16), (unsigned)ex[4] | ((unsigned)ex[5] << 16), (unsigned)ex[6] | ((unsigned)ex[7] << 16)};
    *(GAS f32x4*)(gp) = (f32x4){ew[0] * inv, ew[1] * inv, ew[2] * inv, ew[3] * inv};
    *(GAS f32x4*)(gp + 4) = (f32x4){ew[4] * inv, ew[5] * inv, ew[6] * inv, ew[7] * inv};
    __syncthreads();
}
}

namespace p6 {
__device__ __forceinline__ float blo(unsigned w) { return __builtin_bit_cast(float, w << 16); }
__device__ __forceinline__ float bhi(unsigned w) { return __builtin_bit_cast(float, w & 0xffff0000u); }
__device__ __forceinline__ float gelu_fast(float x) { return x * __builtin_amdgcn_rcpf(1.0f + __builtin_amdgcn_exp2f(-2.302208198f * x * (1.0f + 0.044715f * x * x))); }
__device__ __forceinline__ unsigned idw(const v4u& a, const v4u& b, int g) { const unsigned w = g < 8 ? a[(g & 7) >> 1] : b[(g & 7) >> 1]; return (g & 1) ? (w >> 16) : (w & 0xffffu); }
__device__ __forceinline__ float wave_max(float v) {
#pragma unroll
    for (int o = 1; o < 64; o <<= 1) v = fmaxf(v, __shfl_xor(v, o));
    return v;
}
__device__ __forceinline__ unsigned q4(float a, float b, float c, float d, float inv, int bias) {
    const int qa = (int)rintf(a * inv) + bias, qb = (int)rintf(b * inv) + bias, qc = (int)rintf(c * inv) + bias, qd = (int)rintf(d * inv) + bias;
    return (unsigned)(qa & 0xff) | ((unsigned)(qb & 0xff) << 8) | ((unsigned)(qc & 0xff) << 16) | ((unsigned)(qd & 0xff) << 24);
}
__device__ __forceinline__ void qrow_load(f32x4 (&v)[8], const float* src, size_t e, int lane) {
#pragma unroll
    for (int j = 0; j < 8; ++j) v[j] = __builtin_nontemporal_load((const GAS f32x4*)(src + e * D + j * 256 + lane * 4));
}
__device__ __forceinline__ void qrow_finish(f32x4 (&v)[8], const float* gcol, unsigned char* dst, float* scale_out, size_t e, int lane) {
    float am = 0.f;
#pragma unroll
    for (int j = 0; j < 8; ++j) {
        if (gcol) { const f32x4 g = *(const GAS f32x4*)(gcol + j * 256 + lane * 4); v[j] = v[j] * g; }
        am = fmaxf(am, fmaxf(fmaxf(fabsf(v[j].x), fabsf(v[j].y)), fmaxf(fabsf(v[j].z), fabsf(v[j].w))));
    }
    am = wave_max(am);
    const float inv = am > 0.f ? 127.0f / am : 0.f;
#pragma unroll
    for (int j = 0; j < 8; ++j)
        *(GAS unsigned*)(dst + ((size_t)(2 * j + (lane >> 5)) * 16384 + e) * 128 + (lane & 31) * 4) = q4(v[j].x, v[j].y, v[j].z, v[j].w, inv, 0);
    if (lane == 0) scale_out[e] = am * (1.0f / 127.0f);
}
__device__ __forceinline__ void qx_load(v4u (&x)[4], const bf16* H1B, size_t tok, int lane) {
#pragma unroll
    for (int j = 0; j < 4; ++j) x[j] = *(const GAS v4u*)(H1B + tok * D + j * 512 + lane * 8);
}
__device__ __forceinline__ void qx_finish(const v4u (&x)[4], unsigned char* X8, float* SX, size_t tok, int lane) {
#pragma unroll
    for (int j = 0; j < 4; ++j) {
        float f[8]; float am = 0.f;
#pragma unroll
        for (int k = 0; k < 4; ++k) { f[2 * k] = blo(x[j][k]); f[2 * k + 1] = bhi(x[j][k]); am = fmaxf(am, fmaxf(fabsf(f[2 * k]), fabsf(f[2 * k + 1]))); }
        am = fmaxf(am, __shfl_xor(am, 1)); am = fmaxf(am, __shfl_xor(am, 2)); am = fmaxf(am, __shfl_xor(am, 4)); am = fmaxf(am, __shfl_xor(am, 8));
        const float inv = am > 0.f ? 127.0f / am : 0.f;
        typedef unsigned u32x2v __attribute__((ext_vector_type(2)));
        u32x2v o; o.x = q4(f[0], f[1], f[2], f[3], inv, 0); o.y = q4(f[4], f[5], f[6], f[7], inv, 0);
        *(GAS u32x2v*)(X8 + tok * D + j * 512 + lane * 8) = o;
        if ((lane & 15) == 0) SX[tok * 16 + 4 * j + (lane >> 4)] = am * (1.0f / 127.0f);
    }
}

typedef int i32x16 __attribute__((ext_vector_type(16)));
typedef float f32x16v __attribute__((ext_vector_type(16)));
__device__ __forceinline__ int seli(int m, int a, int b) { return (a & m) | (b & ~m); }
__device__ __forceinline__ float self(int m, float a, float b) { return __builtin_bit_cast(float, seli(m, __builtin_bit_cast(int, a), __builtin_bit_cast(int, b))); }
__device__ __forceinline__ void usweep(const unsigned char* X8, const float* SX, const unsigned char* U8, const unsigned short* IDS, bf16* PART, int slot, int rank, int nrank, int wave, int lane) {
    const int ps = lane >> 3, ch = lane & 7;
    const int first = rank * 8 + wave, stride = nrank * 8;
    const int n = first < MREAL ? (MREAL - first + stride - 1) / stride : 0, NQ = 2 * n;
    if (NQ == 0) return;
    const int m4 = -((lane >> 2) & 1), m2 = -((lane >> 1) & 1), m1 = -(lane & 1);
#define U_LOAD(q_, I0, I1, XV, SX_, T_, SG_) do { const int qq_ = (q_) < NQ ? (q_) : NQ - 1; const int rd_ = qq_ >= n ? 1 : 0; T_ = first + (qq_ - rd_ * n) * stride; SG_ = rd_ * 8 + slot; \
        I0 = *(const GAS v4u*)(IDS + (size_t)T_ * 128 + ps * 16); I1 = *(const GAS v4u*)(IDS + (size_t)T_ * 128 + ps * 16 + 8); \
        XV = *(const GAS v4u*)(X8 + (size_t)T_ * D + SG_ * 128 + ch * 16); SX_ = SX[(size_t)T_ * 16 + SG_]; } while (0)
#define U_ISSUE(BUF, I0, I1, SG_) do { const unsigned char* tab_ = U8 + (size_t)(SG_) * 16384 * 128 + ch * 16; \
        _Pragma("unroll") for (int g = 0; g < 16; ++g) BUF[g] = *(const GAS v4u*)(tab_ + (size_t)idw(I0, I1, g) * 128); } while (0)
#define U_FINISH(BUF, XV, SX_, T_, SG_) do { i32x16 d; \
        _Pragma("unroll") for (int g = 0; g < 16; ++g) { int a_ = __builtin_amdgcn_sdot4((int)BUF[g][0], (int)XV[0], 0, false); a_ = __builtin_amdgcn_sdot4((int)BUF[g][1], (int)XV[1], a_, false); \
            a_ = __builtin_amdgcn_sdot4((int)BUF[g][2], (int)XV[2], a_, false); a_ = __builtin_amdgcn_sdot4((int)BUF[g][3], (int)XV[3], a_, false); d[g] = a_; } \
        int r8[8], r4[4], r2[2]; \
        _Pragma("unroll") for (int k = 0; k < 8; ++k) r8[k] = seli(m4, d[8 + k], d[k]) + __shfl_xor(seli(m4, d[k], d[8 + k]), 4); \
        _Pragma("unroll") for (int k = 0; k < 4; ++k) r4[k] = seli(m2, r8[4 + k], r8[k]) + __shfl_xor(seli(m2, r8[k], r8[4 + k]), 2); \
        _Pragma("unroll") for (int k = 0; k < 2; ++k) r2[k] = seli(m1, r4[2 + k], r4[k]) + __shfl_xor(seli(m1, r4[k], r4[2 + k]), 1); \
        *(GAS unsigned*)(PART + ((size_t)(SG_) * MREAL + T_) * 128 + ps * 16 + 2 * ch) = pk2((float)r2[0] * SX_, (float)r2[1] * SX_); } while (0)
    v4u bufA[16], bufB[16];
    v4u a0, a1, ax, b0, b1, bx, c0, c1, cx; float as, bs, cs; int at, bt, ct, ag, bg, cg;
    U_LOAD(0, a0, a1, ax, as, at, ag); U_LOAD(1, b0, b1, bx, bs, bt, bg);
    U_ISSUE(bufA, a0, a1, ag);
    for (int q = 0; q < NQ; q += 2) {
        U_ISSUE(bufB, b0, b1, bg);
        U_LOAD(q + 2, c0, c1, cx, cs, ct, cg);
        U_FINISH(bufA, ax, as, at, ag);
        U_ISSUE(bufA, c0, c1, cg);
        U_LOAD(q + 3, a0, a1, ax, as, at, ag);
        U_FINISH(bufB, bx, bs, bt, bg);
        { const v4u t0 = a0, t1 = a1, tx = ax; const float ts = as; const int tt = at, tg = ag;
          a0 = c0; a1 = c1; ax = cx; as = cs; at = ct; ag = cg; b0 = t0; b1 = t1; bx = tx; bs = ts; bt = tt; bg = tg; }
    }
#undef U_LOAD
#undef U_ISSUE
#undef U_FINISH
}
__device__ __forceinline__ void wreduce(const bf16* PART, const float* GW, const float* RSTD2, const unsigned short* IDS, const float* SCU, const float* SCV, unsigned char* W8, float* WS8, size_t gt, size_t NT) {
    for (size_t i8 = gt; i8 < (size_t)MREAL * 128 / 8; i8 += NT) {
        float s[8];
#pragma unroll
        for (int k = 0; k < 8; ++k) s[k] = 0.f;
#pragma unroll 8
        for (int sg = 0; sg < 16; ++sg) {
            const v4u p = *(const GAS v4u*)(PART + (size_t)sg * MREAL * 128 + i8 * 8);
#pragma unroll
            for (int k = 0; k < 4; ++k) { s[2 * k] += blo(p[k]); s[2 * k + 1] += bhi(p[k]); }
        }
        const float rs = RSTD2[i8 >> 4];
        const v4u idv = *(const GAS v4u*)(IDS + i8 * 8);
        const f32x4 g0 = *(const GAS f32x4*)(GW + i8 * 8), g1 = *(const GAS f32x4*)(GW + i8 * 8 + 4);
        float w[8]; float am = 0.f;
#pragma unroll
        for (int k = 0; k < 8; ++k) {
            const unsigned e = (k & 1) ? (idv[k >> 1] >> 16) : (idv[k >> 1] & 0xffffu);
            const float g = k < 4 ? g0[k & 3] : g1[k & 3];
            w[k] = g * gelu_fast(rs * SCU[e] * s[k]) * SCV[e]; am = fmaxf(am, fabsf(w[k]));
        }
        am = fmaxf(am, __shfl_xor(am, 1));
        const float inv = am > 0.f ? 127.0f / am : 0.f;
        typedef unsigned u32x2v __attribute__((ext_vector_type(2)));
        u32x2v o; o.x = q4(w[0], w[1], w[2], w[3], inv, 0); o.y = q4(w[4], w[5], w[6], w[7], inv, 0);
        *(GAS u32x2v*)(W8 + i8 * 8) = o;
        if ((i8 & 1) == 0) WS8[i8 >> 1] = am * (1.0f / 127.0f);
    }
}
__device__ __forceinline__ void vsweep(const bf16* H1B, const unsigned char* V8, const unsigned short* IDS, const unsigned char* W8, const float* WS8, bf16* Z, float* SSF, int slot, int rank, int nrank, int wave, int lane) {
    const int ps = lane >> 3, ch = lane & 7;
    const int first = rank * 8 + wave, stride = nrank * 8;
    const int n = first < MREAL ? (MREAL - first + stride - 1) / stride : 0, NQ = 2 * n;
    if (NQ == 0) return;
    const int m32 = -((lane >> 5) & 1), m16 = -((lane >> 4) & 1), m8 = -((lane >> 3) & 1);
#define V_LOAD(q_, I0, I1, T_, SG_) do { const int qq_ = (q_) < NQ ? (q_) : NQ - 1; const int rd_ = qq_ >= n ? 1 : 0; T_ = first + (qq_ - rd_ * n) * stride; SG_ = rd_ * 8 + slot; \
        I0 = *(const GAS v4u*)(IDS + (size_t)T_ * 128 + ps * 16); I1 = *(const GAS v4u*)(IDS + (size_t)T_ * 128 + ps * 16 + 8); } while (0)
#define V_ISSUE(BUF, WQ, WSC, I0, I1, T_, SG_) do { const unsigned char* tab_ = V8 + (size_t)(SG_) * 16384 * 128 + ch * 16; \
        _Pragma("unroll") for (int g = 0; g < 16; ++g) BUF[g] = *(const GAS v4u*)(tab_ + (size_t)idw(I0, I1, g) * 128); \
        WQ = *(const GAS v4u*)(W8 + (size_t)T_ * 128 + ps * 16); WSC = WS8[(size_t)T_ * 8 + ps]; } while (0)
#define V_FINISH(BUF, WQ, WSC, T_, SG_) do { i32x16 acc = {0, 0, 0, 0, 0, 0, 0, 0, 0, 0, 0, 0, 0, 0, 0, 0}; \
        const unsigned hx_ = *(const GAS unsigned*)(H1B + (size_t)T_ * D + (SG_) * 128 + ch * 16 + 2 * ps); \
        _Pragma("unroll") for (int j = 0; j < 4; ++j) { const int wq_ = (int)WQ[j]; \
            _Pragma("unroll") for (int k = 0; k < 4; ++k) { \
                const unsigned d0_ = BUF[4 * j][k], d1_ = BUF[4 * j + 1][k], d2_ = BUF[4 * j + 2][k], d3_ = BUF[4 * j + 3][k]; \
                const unsigned p0_ = __builtin_amdgcn_perm(d1_, d0_, 0x05010400u), p1_ = __builtin_amdgcn_perm(d1_, d0_, 0x07030602u); \
                const unsigned q0_ = __builtin_amdgcn_perm(d3_, d2_, 0x05010400u), q1_ = __builtin_amdgcn_perm(d3_, d2_, 0x07030602u); \
                acc[4 * k + 0] = __builtin_amdgcn_sdot4((int)__builtin_amdgcn_perm(q0_, p0_, 0x05040100u), wq_, acc[4 * k + 0], false); \
                acc[4 * k + 1] = __builtin_amdgcn_sdot4((int)__builtin_amdgcn_perm(q0_, p0_, 0x07060302u), wq_, acc[4 * k + 1], false); \
                acc[4 * k + 2] = __builtin_amdgcn_sdot4((int)__builtin_amdgcn_perm(q1_, p1_, 0x05040100u), wq_, acc[4 * k + 2], false); \
                acc[4 * k + 3] = __builtin_amdgcn_sdot4((int)__builtin_amdgcn_perm(q1_, p1_, 0x07060302u), wq_, acc[4 * k + 3], false); } } \
        float fa[16]; \
        _Pragma("unroll") for (int k = 0; k < 16; ++k) fa[k] = (float)acc[k] * WSC; \
        float r8[8], r4[4], r2[2]; \
        _Pragma("unroll") for (int k = 0; k < 8; ++k) r8[k] = self(m32, fa[8 + k], fa[k]) + __shfl_xor(self(m32, fa[k], fa[8 + k]), 32); \
        _Pragma("unroll") for (int k = 0; k < 4; ++k) r4[k] = self(m16, r8[4 + k], r8[k]) + __shfl_xor(self(m16, r8[k], r8[4 + k]), 16); \
        _Pragma("unroll") for (int k = 0; k < 2; ++k) r2[k] = self(m8, r4[2 + k], r4[k]) + __shfl_xor(self(m8, r4[k], r4[2 + k]), 8); \
        const float z0_ = r2[0] + blo(hx_), z1_ = r2[1] + bhi(hx_); \
        *(GAS unsigned*)(Z + (size_t)T_ * D + (SG_) * 128 + ch * 16 + 2 * ps) = pk2(z0_, z1_); \
        float ss_ = z0_ * z0_ + z1_ * z1_; \
        _Pragma("unroll") for (int o = 1; o < 64; o <<= 1) ss_ += __shfl_xor(ss_, o); \
        if (lane == 0) SSF[(size_t)T_ * 16 + (SG_)] = ss_; } while (0)
    v4u bufA[16], bufB[16]; v4u wA, wB; float sA, sB;
    v4u a0, a1, b0, b1, c0, c1; int at, bt, ct, ag, bg, cg;
    V_LOAD(0, a0, a1, at, ag); V_LOAD(1, b0, b1, bt, bg);
    V_ISSUE(bufA, wA, sA, a0, a1, at, ag);
    for (int q = 0; q < NQ; q += 2) {
        V_ISSUE(bufB, wB, sB, b0, b1, bt, bg);
        V_LOAD(q + 2, c0, c1, ct, cg);
        V_FINISH(bufA, wA, sA, at, ag);
        V_ISSUE(bufA, wA, sA, c0, c1, ct, cg);
        V_LOAD(q + 3, a0, a1, at, ag);
        V_FINISH(bufB, wB, sB, bt, bg);
        { const v4u t0 = a0, t1 = a1; const int tt = at, tg = ag; a0 = c0; a1 = c1; at = ct; ag = cg; b0 = t0; b1 = t1; bt = tt; bg = tg; }
    }
#undef V_LOAD
#undef V_ISSUE
#undef V_FINISH
}
__device__ __forceinline__ void final_row(const bf16* Z, const float* SSF, const float* fg, float* out, size_t tok, int lane) {
    v4u z[4];
#pragma unroll
    for (int j = 0; j < 4; ++j) z[j] = *(const GAS v4u*)(Z + tok * D + j * 512 + lane * 8);
    float ss = 0.f;
#pragma unroll
    for (int k = 0; k < 4; ++k) { const f32x4 v = *(const GAS f32x4*)(SSF + tok * 16 + 4 * k); ss += (v.x + v.y) + (v.z + v.w); }
    const float rf = 1.0f / sqrtf(ss * (1.0f / D) + EPS);
#pragma unroll
    for (int j = 0; j < 4; ++j) {
        const f32x4 ga = *(const GAS f32x4*)(fg + j * 512 + lane * 8), gb = *(const GAS f32x4*)(fg + j * 512 + lane * 8 + 4);
        *(GAS f32x4*)(out + tok * D + j * 512 + lane * 8) = (f32x4){blo(z[j][0]) * rf * ga.x, bhi(z[j][0]) * rf * ga.y, blo(z[j][1]) * rf * ga.z, bhi(z[j][1]) * rf * ga.w};
        *(GAS f32x4*)(out + tok * D + j * 512 + lane * 8 + 4) = (f32x4){blo(z[j][2]) * rf * gb.x, bhi(z[j][2]) * rf * gb.y, blo(z[j][3]) * rf * gb.z, bhi(z[j][3]) * rf * gb.w};
    }
}
}

struct Frame {
    LAS unsigned char* lds;
    volatile LAS unsigned* MISC;
    gu32* ctl;
    int tid, lane, wave, vcu, G;
};
__device__ __forceinline__ float wave_sum(float v) {
#pragma unroll
    for (int o = 1; o < 64; o <<= 1) v += __shfl_xor(v, o);
    return v;
}
__device__ __forceinline__ void p0_transpose_item(const float* W, int K, int N, bf16* WT, const float* g0, const float* g1, int ksplit, LAS float* scr, int item, int lane) {
    const int nblk = N / 32, kb = item / nblk, nb = item % nblk, k0 = 64 * kb, n0 = 32 * nb;
#pragma unroll 16
    for (int i = 0; i < 32; ++i) { const int kk = 2 * i + (lane >> 5); const int kg = k0 + kk; const float gv = kg < ksplit ? g0[kg] : g1[kg - ksplit];
        scr[kk * 33 + (lane & 31)] = W[(size_t)kg * N + n0 + (lane & 31)] * gv; }
    LDS_WAIT(); asm volatile("" ::: "memory");
    const int c = lane & 7;
#pragma unroll
    for (int j = 0; j < 4; ++j) { const int n = (lane >> 3) + 8 * j; const LAS float* s = scr + (8 * c) * 33 + n;
        v4u o; o.x = pk2(s[0 * 33], s[1 * 33]); o.y = pk2(s[2 * 33], s[3 * 33]); o.z = pk2(s[4 * 33], s[5 * 33]); o.w = pk2(s[6 * 33], s[7 * 33]);
        *(GAS v4u*)(WT + (size_t)(n0 + n) * K + k0 + 8 * c) = o; }
    LDS_WAIT(); asm volatile("" ::: "memory");
}
__device__ __forceinline__ void p0_row_load(f32x4 (&v)[8], const float* xrow, int lane) {
    const GAS f32x4* xr = (const GAS f32x4*)xrow + lane;
#pragma unroll
    for (int j = 0; j < 8; ++j) v[j] = __builtin_nontemporal_load(xr + 64 * j);
}
__device__ __forceinline__ void p0_row_finish(const f32x4 (&v)[8], bf16* orow, float* rstd_out, int lane) {
    float s = 0.f;
#pragma unroll
    for (int j = 0; j < 8; ++j) s += (v[j].x * v[j].x + v[j].y * v[j].y) + (v[j].z * v[j].z + v[j].w * v[j].w);
    s = wave_sum(s);
    GAS unsigned long long* o8 = (GAS unsigned long long*)orow + lane;
#pragma unroll
    for (int j = 0; j < 8; ++j) o8[64 * j] = (unsigned long long)pk2(v[j].x, v[j].y) | ((unsigned long long)pk2(v[j].z, v[j].w) << 32);
    if (lane == 0) *rstd_out = 1.0f / sqrtf(s * (1.0f / D) + EPS);
}
__device__ __forceinline__ void p0_cvt8_sliced(const float* src, bf16* dst, const float* gcol, size_t idx8) {
    const f32x4 a = *(const GAS f32x4*)(src + idx8 * 8), b = *(const GAS f32x4*)(src + idx8 * 8 + 4);
    f32x4 ga = {1.f, 1.f, 1.f, 1.f}, gb = {1.f, 1.f, 1.f, 1.f};
    const int c = (int)((idx8 * 8) & (D - 1)); const size_t e = (idx8 * 8) >> 11;
    if (gcol) { ga = *(const GAS f32x4*)(gcol + c); gb = *(const GAS f32x4*)(gcol + c + 4); }
    v4u o; o.x = pk2(a.x * ga.x, a.y * ga.y); o.y = pk2(a.z * ga.z, a.w * ga.w); o.z = pk2(b.x * gb.x, b.y * gb.y); o.w = pk2(b.z * gb.z, b.w * gb.w);
    *(GAS v4u*)(dst + ((size_t)(c >> 6) * 16384 + e) * 64 + (c & 63)) = o;
}
__device__ __forceinline__ void p0_cvt8(const float* src, bf16* dst, const float* gcol, size_t idx8) {
    const f32x4 a = *(const GAS f32x4*)(src + idx8 * 8), b = *(const GAS f32x4*)(src + idx8 * 8 + 4);
    f32x4 ga = {1.f, 1.f, 1.f, 1.f}, gb = {1.f, 1.f, 1.f, 1.f};
    if (gcol) { const int c = (int)((idx8 * 8) & (D - 1)); ga = *(const GAS f32x4*)(gcol + c); gb = *(const GAS f32x4*)(gcol + c + 4); }
    v4u o; o.x = pk2(a.x * ga.x, a.y * ga.y); o.y = pk2(a.z * ga.z, a.w * ga.w); o.z = pk2(b.x * gb.x, b.y * gb.y); o.w = pk2(b.z * gb.z, b.w * gb.w);
    *(GAS v4u*)(dst + idx8 * 8) = o;
}

struct Args { const float* in[22]; float* out; unsigned char* ws; int ph_lo, ph_hi, rep_mask, pad; };

__global__ void __launch_bounds__(NWAVES * 64, 2) fwd(Args args) {
    extern __shared__ __attribute__((aligned(16))) unsigned char lds[];
    Frame F;
    F.lds = (LAS unsigned char*)lds;
    F.MISC = (volatile LAS unsigned*)(F.lds + MISC_OFF);
    F.tid = threadIdx.x; F.lane = F.tid & 63; F.wave = __builtin_amdgcn_readfirstlane(F.tid >> 6);
    F.G = gridDim.x; { const int bx = blockIdx.x; F.vcu = (F.G % 8 == 0) ? (bx % 8) * (F.G / 8) + bx / 8 : bx; }
    unsigned char* ws = args.ws;
    F.ctl = (gu32*)(ws + WS_CTL);
    for (int u = F.tid; u < (LDS_BYTES - LDSCTL_OFF) / 4; u += NWAVES * 64) ((LAS unsigned*)(F.lds + LDSCTL_OFF))[u] = 0u;
    __syncthreads();
    XcdBarrier bar = xcd_barrier_post((unsigned*)(F.ctl + CW_BAR), F.MISC + 8);
    const int lo = args.ph_lo, hi = args.ph_hi;
#define IN(k) (lo <= (k) && (k) < hi)
#define BOTH(k) (IN(k) && IN((k) + 1))
#ifndef PROBE_PH
#define PROBE_PH (-1)
#endif
#define REP(k) for (int rep_ = 0; rep_ < ((k) == PROBE_PH ? 2 : 1); ++rep_)

    const float* x = args.in[0]; const float* meta = args.in[1]; const float* norm_mix_g = args.in[2]; const float* w_in = args.in[3]; const float* b_in = args.in[4];
    const float* gn_attn_g = args.in[13]; const float* gn_lru_g = args.in[14]; const float* w_out = args.in[15]; const float* norm_ffn_g = args.in[16];
    const float* peer_wq = args.in[17]; const float* sub_keys = args.in[18]; const float* peer_u = args.in[19]; const float* peer_v = args.in[20];
    bf16* W1T = (bf16*)(ws + WS_W1T); bf16* W2T = (bf16*)(ws + WS_W2T); bf16* W3T = (bf16*)(ws + WS_W3T); bf16* SKB = (bf16*)(ws + WS_SKB);
    float* RSTD1 = (float*)(ws + WS_RSTD1);
    unsigned char* U8 = ws + WS_U8; unsigned char* V8 = ws + WS_V8; unsigned char* X8 = ws + WS_X8; float* SX = (float*)(ws + WS_SX); float* SCU = (float*)(ws + WS_SCU); float* SCV = (float*)(ws + WS_SCV);
    bf16* A1 = (bf16*)(ws + WS_A1);
    bf16* QB = (bf16*)(ws + WS_Q); bf16* KVB = (bf16*)(ws + WS_KV); bf16* XBB = (bf16*)(ws + WS_XB); bf16* GTB = (bf16*)(ws + WS_GT);

    if (IN(0)) { REP(0) {
        LAS float* scr = (LAS float*)(F.lds + RING_OFF + F.wave * 16384);
        const int gw = F.vcu * NWAVES + F.wave, NGW = F.G * NWAVES;
        constexpr int I_1 = (D / 64) * (IND / 32), I_2 = (D / 64) * (D / 32), I_3 = I_2;
        for (int it = gw; it < I_1 + I_2 + I_3; it += NGW) {
            int r = it;
            if (r < I_1) { p0_transpose_item(w_in, D, IND, W1T, norm_mix_g, norm_mix_g, D, scr, r, F.lane); continue; } r -= I_1;
            if (r < I_2) { p0_transpose_item(w_out, D, D, W2T, gn_attn_g, gn_lru_g, 1024, scr, r, F.lane); continue; } r -= I_2;
            p0_transpose_item(peer_wq, D, D, W3T, norm_ffn_g, norm_ffn_g, D, scr, r, F.lane);
        }
        {
            f32x4 cur[8], nxt[8];
            if (gw < MREAL + NMETA) p0_row_load(cur, gw < MREAL ? x + (size_t)gw * D : meta + (size_t)(gw - MREAL) * D, F.lane);
            for (int m = gw; m < MREAL + NMETA; m += NGW) {
                const int mn = m + NGW;
                if (mn < MREAL + NMETA) p0_row_load(nxt, mn < MREAL ? x + (size_t)mn * D : meta + (size_t)(mn - MREAL) * D, F.lane);
                p0_row_finish(cur, A1 + (size_t)m * D, RSTD1 + m, F.lane);
#pragma unroll
                for (int j = 0; j < 8; ++j) cur[j] = nxt[j];
            }
        }
        {
            const size_t gt = (size_t)gw * 64 + F.lane, NT = (size_t)NGW * 64;
            for (size_t i = gt; i < (size_t)(8 * 2 * 128 * 128) / 8; i += NT) p0_cvt8(sub_keys, SKB, nullptr, i);
            {
                f32x4 cur[8], nxt[8];
                constexpr int QV0 = 6144;
                if (QV0 + gw < 16384) p6::qrow_load(cur, peer_v, (size_t)(QV0 + gw), F.lane);
                for (int rj = QV0 + gw; rj < 16384; rj += NGW) {
                    const int rn = rj + NGW;
                    if (rn < 16384) p6::qrow_load(nxt, peer_v, (size_t)rn, F.lane);
                    p6::qrow_finish(cur, nullptr, V8, SCV, (size_t)rj, F.lane);
#pragma unroll
                    for (int j = 0; j < 8; ++j) cur[j] = nxt[j];
                }
            }
        } }
        if (BOTH(0)) xcd_barrier(bar);
    }
    if (IN(1)) {
        pg8::Gemm g{A1, W1T, MPAD, IND, D};
        pg8::Order1 S{F.G, (int)blockIdx.x};
        pg8::Epi1 E{QB, KVB, XBB, GTB, RSTD1, b_in};
        REP(1) pg8::gemm_phase<pg8::Epi1, pg8::Order1, true, true>(F.lds + RING_OFF, g, S, E);
        {
            volatile LAS int* qb = (volatile LAS int*)(F.lds + LDSCTL_OFF + 512);
            for (;;) {
                __syncthreads();
                if (F.tid == 0) qb[0] = (int)__hip_atomic_fetch_add((unsigned*)(F.ctl + CW_QROW), 32u, __ATOMIC_RELAXED, __HIP_MEMORY_SCOPE_AGENT);
                __syncthreads();
                const int base = qb[0];
                if (base >= 16384 + 6144) break;
                f32x4 r0[8], r1[8], r2[8], r3[8];
                const bool isu = base < 16384;
                const float* src = isu ? peer_u : peer_v; const float* gc = isu ? norm_ffn_g : nullptr; unsigned char* dst = isu ? U8 : V8; float* sc = isu ? SCU : SCV;
                const size_t e0 = (size_t)(isu ? base : base - 16384) + F.wave * 4;
                p6::qrow_load(r0, src, e0, F.lane); p6::qrow_load(r1, src, e0 + 1, F.lane); p6::qrow_load(r2, src, e0 + 2, F.lane); p6::qrow_load(r3, src, e0 + 3, F.lane);
                p6::qrow_finish(r0, gc, dst, sc, e0, F.lane); p6::qrow_finish(r1, gc, dst, sc, e0 + 1, F.lane);
                p6::qrow_finish(r2, gc, dst, sc, e0 + 2, F.lane); p6::qrow_finish(r3, gc, dst, sc, e0 + 3, F.lane);
            }
        }
        if (BOTH(1)) xcd_barrier(bar);
    }
    if (IN(2)) {
        bf16* MIX = (bf16*)(ws + WS_A1); float* SSA = (float*)(ws + WS_SSA); float* SSL = (float*)(ws + WS_SSL);
        const p2::LruP LP{args.in[6], args.in[7], args.in[8], args.in[9], args.in[10], args.in[11], args.in[12]};
        {
        REP(20) for (int u = (int)blockIdx.x; u < 256; u += F.G) p2::lru_unit(F.lds + RING_OFF, u >> 5, (u >> 1) & 15, u & 1, XBB, GTB, LP, MIX, SSL, F.tid);
        REP(21) for (int a = (int)blockIdx.x; a < 256; a += F.G) p2::attn_unit(F.lds + RING_OFF, a >> 5, (a >> 1) & 15, a & 1, QB, KVB, args.in[5], MIX, SSA, F.tid);
        }
        if (BOTH(2)) xcd_barrier(bar);
    }
    if (IN(3)) {
        bf16* MIX = (bf16*)(ws + WS_A1); const float* SSA = (const float*)(ws + WS_SSA); const float* SSL = (const float*)(ws + WS_SSL);
        bf16* H1B = (bf16*)(ws + WS_H1); float* SS2 = (float*)(ws + WS_SS2);
        pg8::Order2 S{F.G, (int)blockIdx.x};
        LAS float* tbl = (LAS float*)(F.lds + LDSCTL_OFF + 1024);
        pg8::Unit u0{0, 0};
        for (int i = 0; i < 2; ++i) {
            pg8::Unit u; if (!S.next(i, u)) break; if (i == 0) u0 = u;
            if (F.tid < 256) {
                const size_t row = (size_t)u.pm * 256 + F.tid; float sa = 0.f, sl = 0.f;
#pragma unroll
                for (int k = 0; k < 4; ++k) { const f32x4 v = *(const GAS f32x4*)(SSA + row * 16 + 4 * k); sa += (v.x + v.y) + (v.z + v.w); }
#pragma unroll
                for (int k = 0; k < 8; ++k) { const f32x4 v = *(const GAS f32x4*)(SSL + row * 32 + 4 * k); sl += (v.x + v.y) + (v.z + v.w); }
                const float ra = 1.0f / sqrtf(sa * (1.0f / 1024) + EPS), rl = 1.0f / sqrtf(sl * (1.0f / 1024) + EPS);
                tbl[(i * 256 + F.tid) * 2] = ra / rl; tbl[(i * 256 + F.tid) * 2 + 1] = rl;
            }
        }
        __syncthreads();
        pg8::Gemm g{MIX, W2T, MREAL, D, D};
        pg8::Epi2 E{H1B, x, SS2, (const LAS float*)tbl, u0.pm};
        REP(3) pg8::gemm_phase<pg8::Epi2, pg8::Order2, true, true>(F.lds + RING_OFF, g, S, E);
        if (BOTH(3)) xcd_barrier(bar);
    }
    if (IN(4)) {
        bf16* H1B = (bf16*)(ws + WS_H1); bf16* QPB = (bf16*)(ws + WS_A1);
        pg8::Order2 S{F.G, (int)blockIdx.x};
        {
            const float* SS2 = (const float*)(ws + WS_SS2); float* RSTD2 = (float*)(ws + WS_RSTD2);
            pg8::Unit u; if (S.next(0, u) && F.tid < 256) {
                const size_t row = (size_t)u.pm * 256 + F.tid; float ssq = 0.f;
#pragma unroll
                for (int k = 0; k < 8; ++k) { const f32x4 v = *(const GAS f32x4*)(SS2 + row * 32 + 4 * k); ssq += (v.x + v.y) + (v.z + v.w); }
                RSTD2[row] = 1.0f / sqrtf(ssq * (1.0f / D) + EPS);
            }
        }
        pg8::Gemm g{H1B, W3T, MREAL, D, D};
        pg8::Epi3 E{QPB};
        REP(4) pg8::gemm_phase<pg8::Epi3, pg8::Order2, true, true>(F.lds + RING_OFF, g, S, E);
        if (BOTH(4)) xcd_barrier(bar);
    }
    if (IN(5)) {
        const bf16* QPB = (const bf16*)(ws + WS_A1);
        unsigned short* IDS = (unsigned short*)(ws + WS_IDS); float* GW = (float*)(ws + WS_GW); float* RSTD2 = (float*)(ws + WS_RSTD2);
        const bf16* H1B = (const bf16*)(ws + WS_H1);
        REP(5) for (int u = (int)blockIdx.x; u < 512; u += F.G) {
            v4u xq[4][4]; const size_t tb = (size_t)(u >> 3) * 256 + F.wave * 32 + (u & 7);
#pragma unroll
            for (int k = 0; k < 4; ++k) p6::qx_load(xq[k], H1B, tb + 8 * k, F.lane);
            p5::retr_unit(F.lds + RING_OFF, u & 7, u >> 3, QPB, SKB, IDS, GW, RSTD2, F.tid);
#pragma unroll
            for (int k = 0; k < 4; ++k) p6::qx_finish(xq[k], X8, SX, tb + 8 * k, F.lane);
        }
        if (BOTH(5)) xcd_barrier(bar);
    }
    {
        const bf16* H1B = (const bf16*)(ws + WS_H1); const unsigned short* IDS = (const unsigned short*)(ws + WS_IDS); const float* GW = (const float*)(ws + WS_GW);
        const float* RSTD2 = (const float*)(ws + WS_RSTD2); bf16* PART = (bf16*)(ws + WS_PART); unsigned char* W8 = ws + WS_W; float* WS8 = (float*)(ws + WS_WSUM); bf16* ZB = (bf16*)(ws + WS_Z); float* SSF = (float*)(ws + WS_SSL);
        const int slot = (int)blockIdx.x & 7, rank = (int)blockIdx.x >> 3, nrank = (F.G - slot + 7) >> 3;
        const int gw = F.vcu * NWAVES + F.wave, NGW = F.G * NWAVES;
        if (IN(6)) { REP(6) p6::usweep(X8, SX, U8, IDS, PART, slot, rank, nrank, F.wave, F.lane); if (BOTH(6)) xcd_barrier(bar); }
        if (IN(7)) { REP(7) p6::wreduce(PART, GW, RSTD2, IDS, SCU, SCV, W8, WS8, (size_t)gw * 64 + F.lane, (size_t)NGW * 64); if (BOTH(7)) xcd_barrier(bar); }
        if (IN(8)) { REP(8) p6::vsweep(H1B, V8, IDS, W8, WS8, ZB, SSF, slot, rank, nrank, F.wave, F.lane); if (BOTH(8)) xcd_barrier(bar); }
        if (PROBE_PH == 30) { for (int k = 0; k < 16; ++k) xcd_barrier(bar); }
        if (IN(9)) { REP(9) for (int t = gw; t < MREAL; t += NGW) p6::final_row(ZB, SSF, args.in[21], args.out, (size_t)t, F.lane); }
    }
#undef IN
#undef BOTH
}

extern "C" void kernel_launch(void* const* d_in, const int* in_sizes, int n_in, void* d_out, int out_size, void* d_ws, size_t ws_size, hipStream_t stream) {
    static int grid = 0;
    if (grid == 0) {
        int dev = 0, cus = 0;
        if (hipGetDevice(&dev) != hipSuccess || hipDeviceGetAttribute(&cus, hipDeviceAttributeMultiprocessorCount, dev) != hipSuccess) { fprintf(stderr, "kernel_launch: device query failed\n"); grid = -1; return; }
        if (hipFuncSetAttribute((const void*)fwd, hipFuncAttributeMaxDynamicSharedMemorySize, LDS_BYTES) != hipSuccess) { fprintf(stderr, "kernel_launch: hipFuncSetAttribute failed\n"); grid = -1; return; }
        int per_cu = 0;
        if (hipOccupancyMaxActiveBlocksPerMultiprocessor(&per_cu, (const void*)fwd, NWAVES * 64, LDS_BYTES) != hipSuccess || per_cu < 1) fprintf(stderr, "kernel_launch: occupancy query says %d\n", per_cu);
        (void)hipGetLastError();
        grid = cus;
        if (ws_size < WS_END) { fprintf(stderr, "kernel_launch: ws too small %zu\n", ws_size); grid = -1; return; }
    }
    if (grid < 0) return;
    (void)hipMemsetAsync((char*)d_ws + WS_CTL, 0, CTL_ZERO_BYTES, stream);
    Args a{};
    for (int i = 0; i < 22; ++i) a.in[i] = (const float*)d_in[i];
    a.out = (float*)d_out; a.ws = (unsigned char*)d_ws; a.ph_lo = 0; a.ph_hi = 10;
    hipLaunchKernelGGL(fwd, dim3(grid), dim3(NWAVES * 64), LDS_BYTES, stream, a);
}
```

```cpp
#include <hip/hip_runtime.h>
#include <cstdio>
#include <cstdint>
#include <math.h>

#define D 2048
#define NB 8
#define SEQ 2048
#define NMETA 16
#define TT (SEQ + NMETA)
#define MR (NB * TT)
#define MREAL (NB * SEQ)
#define MPAD (MREAL + 256)
#define QD 1024
#define KVD 128
#define LW 1024
#define IND 3328
#define EPS 1e-6f
#define QSCALE (0.125f * 1.4426950408889634f)
#define GAS __attribute__((address_space(1)))
#define LAS __attribute__((address_space(3)))
namespace pg8 {
#define PG8_LAS __attribute__((address_space(3)))
typedef unsigned short bf16_t;
typedef short bf16x8 __attribute__((ext_vector_type(8)));
typedef float f32x4 __attribute__((ext_vector_type(4)));
typedef unsigned u32x4 __attribute__((ext_vector_type(4)));
constexpr int BM = 256, BK = 64, HALF = 128, HTB = HALF * BK * 2  , STAGE_BYTES = 8 * HTB, NXCD = 8, WGM = 8;

__host__ __device__ __forceinline__ int lds_byte(int r, int c) { const int st = (r >> 4) * 2 + (c >> 5), rr = r & 15, cc = c & 31, ob = rr * 64 + cc * 2; return st * 1024 + (ob ^ (((ob >> 9) & 1) << 5)); }
__host__ __device__ __forceinline__ void stage_rc(int b, int& R, int& C) { const int st = b / 1024, sb = b % 1024, swz = sb ^ (((sb >> 9) & 1) << 5); R = (st >> 1) * 16 + swz / 64; C = (st & 1) * 32 + (swz % 64) / 2; }
__host__ __device__ __forceinline__ int perm32(int rho) { const int n = rho >> 4, i = rho & 15; return 8 * (i >> 2) + 4 * n + (i & 3); }

struct Unit { int pm, pn; };
struct Gemm { const bf16_t* A; const bf16_t* Bt; int M, N, K; };

struct StaticOrder {
    int nM, nN, nwg, G, c;
    __host__ __device__ void init(int M, int N, int G_, int c_) { nM = M / BM; nN = N / BM; nwg = nM * nN; G = G_; c = c_; }
    __host__ __device__ bool next(int i, Unit& u) const {
        const long L = (long)i * G + c; if (L >= nwg) return false;
        int wgid = (int)L; { const int q = nwg / NXCD, r = nwg % NXCD, xcd = wgid % NXCD, off = wgid / NXCD; wgid = (xcd < r ? xcd * (q + 1) : r * (q + 1) + (xcd - r) * q) + off; }
        const int nig = WGM * nN, gid = wgid / nig, fm = gid * WGM, gsz = (nM - fm) < WGM ? (nM - fm) : WGM;
        u.pm = fm + ((wgid % nig) % gsz); u.pn = (wgid % nig) / gsz; return true;
    }
    __device__ __forceinline__ void a_ready(const Unit&) const {}
    __device__ __forceinline__ void done(const Unit&) const {}
};

__device__ __forceinline__ unsigned cvt_pk_bf16(float lo, float hi) { unsigned r; asm volatile("v_cvt_pk_bf16_f32 %0, %1, %2" : "=v"(r) : "v"(lo), "v"(hi)); return r; }
typedef unsigned u32x2 __attribute__((ext_vector_type(2)));
struct Order1 {
    int G, c;
    __device__ __forceinline__ bool next(int i, Unit& u) const {
        const int L = i * G + c; if (L >= 837) return false;
        if (L >= 832) { u.pm = 64; u.pn = 4 + (L - 832); return true; }
        const int nwg = 832, nN = 13;
        int wgid = L; { const int q = nwg / NXCD, xcd = wgid % NXCD, off = wgid / NXCD; wgid = xcd * q + off; }
        const int nig = WGM * nN, gid = wgid / nig, fm = gid * WGM;
        u.pm = fm + ((wgid % nig) % WGM); u.pn = (wgid % nig) / WGM; return true;
    }
    __device__ __forceinline__ void a_ready(const Unit&) const {}
    __device__ __forceinline__ void done(const Unit&) const {}
};
struct Order2 {
    int G, c;
    __device__ __forceinline__ bool next(int i, Unit& u) const {
        const int L = i * G + c; if (L >= 512) return false;
        const int nwg = 512, nN = 8;
        int wgid = L; { const int q = nwg / NXCD, xcd = wgid % NXCD, off = wgid / NXCD; wgid = xcd * q + off; }
        const int nig = WGM * nN, gid = wgid / nig, fm = gid * WGM;
        u.pm = fm + ((wgid % nig) % WGM); u.pn = (wgid % nig) / WGM; return true;
    }
    __device__ __forceinline__ void a_ready(const Unit&) const {}
    __device__ __forceinline__ void done(const Unit&) const {}
};

struct Epi1 {
    static constexpr bool PERM = true, AFTER_DRAIN = false, MIDK = false;
    bf16_t *Q, *KV, *XB, *GT; const float* rstd; const float* bias;
    __device__ __forceinline__ void midk(f32x4 (&acc)[2][2][4][2], const Unit& u, int wr, int wc, int fr, int fq) const {}
    __device__ __forceinline__ void operator()(const f32x4 (&acc)[2][2][4][2], const Unit& u, int wr, int wc, int fr, int fq) const {
        const int row0 = u.pm * BM + wr * 64 + fr;
        bf16_t* base; int ldc, colb; float sc = 1.f;
        if (u.pn < 4) { base = Q; ldc = 1024; colb = u.pn * BM; sc = QSCALE; }
        else if (u.pn == 4) { base = KV; ldc = 256; colb = 0; }
        else if (u.pn < 9) { base = XB; ldc = 1024; colb = (u.pn - 5) * BM; }
        else { base = GT; ldc = 1024; colb = (u.pn - 9) * BM; }
        const int col0 = colb + wc * 32 + 8 * fq, bcol0 = u.pn * BM + wc * 32 + 8 * fq;
        f32x4 bv[2][2];
#pragma unroll
        for (int bj = 0; bj < 2; ++bj)
#pragma unroll
            for (int n = 0; n < 2; ++n) bv[bj][n] = *(const f32x4*)(bias + bcol0 + bj * HALF + 4 * n);
#pragma unroll
        for (int ai = 0; ai < 2; ++ai)
#pragma unroll
            for (int m = 0; m < 4; ++m) {
                const int row = row0 + ai * HALF + m * 16; const float rs = rstd[row];
                bf16_t* rowp = base + (size_t)row * ldc + col0;
#pragma unroll
                for (int bj = 0; bj < 2; ++bj) {
                    f32x4 v0 = (acc[ai][bj][m][0] * rs + bv[bj][0]) * sc, v1 = (acc[ai][bj][m][1] * rs + bv[bj][1]) * sc;
                    u32x4 w; w.x = cvt_pk_bf16(v0[0], v0[1]); w.y = cvt_pk_bf16(v0[2], v0[3]); w.z = cvt_pk_bf16(v1[0], v1[1]); w.w = cvt_pk_bf16(v1[2], v1[3]);
                    *(u32x4*)(rowp + bj * HALF) = w; } }
    }
};
struct Epi2 {
    static constexpr bool PERM = true, AFTER_DRAIN = false, MIDK = true;
    bf16_t* H1; const float* x; float* SS2; const LAS float* tbl; int pm0;
    __device__ __forceinline__ void midk(f32x4 (&acc)[2][2][4][2], const Unit& u, int wr, int wc, int fr, int fq) const {
        const LAS float* t = tbl + (u.pm == pm0 ? 0 : 512);
#pragma unroll
        for (int ai = 0; ai < 2; ++ai)
#pragma unroll
            for (int m = 0; m < 4; ++m) { const float ra = t[(ai * HALF + wr * 64 + m * 16 + fr) * 2];
#pragma unroll
                for (int bj = 0; bj < 2; ++bj)
#pragma unroll
                    for (int n = 0; n < 2; ++n) acc[ai][bj][m][n] = acc[ai][bj][m][n] * ra; }
    }
    __device__ __forceinline__ void operator()(const f32x4 (&acc)[2][2][4][2], const Unit& u, int wr, int wc, int fr, int fq) const {
        const LAS float* t = tbl + (u.pm == pm0 ? 0 : 512);
        const int col0 = u.pn * BM + wc * 32 + 8 * fq;
#pragma unroll
        for (int ai = 0; ai < 2; ++ai)
#pragma unroll
            for (int m = 0; m < 4; ++m) {
                const int rl = ai * HALF + wr * 64 + m * 16 + fr; const size_t row = (size_t)u.pm * BM + rl; const float rs = t[rl * 2 + 1];
                float ss = 0.f;
#pragma unroll
                for (int bj = 0; bj < 2; ++bj) {
                    const f32x4 x0 = *(const f32x4*)(x + row * 2048 + col0 + bj * HALF), x1 = *(const f32x4*)(x + row * 2048 + col0 + bj * HALF + 4);
                    const f32x4 v0 = acc[ai][bj][m][0] * rs + x0, v1 = acc[ai][bj][m][1] * rs + x1;
                    ss += (v0[0] * v0[0] + v0[1] * v0[1]) + (v0[2] * v0[2] + v0[3] * v0[3]) + (v1[0] * v1[0] + v1[1] * v1[1]) + (v1[2] * v1[2] + v1[3] * v1[3]);
                    u32x4 w; w.x = cvt_pk_bf16(v0[0], v0[1]); w.y = cvt_pk_bf16(v0[2], v0[3]); w.z = cvt_pk_bf16(v1[0], v1[1]); w.w = cvt_pk_bf16(v1[2], v1[3]);
                    *(u32x4*)(H1 + row * 2048 + col0 + bj * HALF) = w; }
                ss += __shfl_xor(ss, 16); ss += __shfl_xor(ss, 32);
                if (fq == 0) SS2[row * 32 + u.pn * 4 + wc] = ss;
            }
    }
};
struct Epi3 {
    static constexpr bool PERM = true, AFTER_DRAIN = false, MIDK = false;
    bf16_t* O;
    __device__ __forceinline__ void midk(f32x4 (&acc)[2][2][4][2], const Unit& u, int wr, int wc, int fr, int fq) const {}
    __device__ __forceinline__ void operator()(const f32x4 (&acc)[2][2][4][2], const Unit& u, int wr, int wc, int fr, int fq) const {
        const int col0 = u.pn * BM + wc * 32 + 8 * fq;
#pragma unroll
        for (int ai = 0; ai < 2; ++ai)
#pragma unroll
            for (int m = 0; m < 4; ++m) { const size_t row = (size_t)u.pm * BM + ai * HALF + wr * 64 + m * 16 + fr;
#pragma unroll
                for (int bj = 0; bj < 2; ++bj) { const f32x4 v0 = acc[ai][bj][m][0], v1 = acc[ai][bj][m][1];
                    u32x4 w; w.x = cvt_pk_bf16(v0[0], v0[1]); w.y = cvt_pk_bf16(v0[2], v0[3]); w.z = cvt_pk_bf16(v1[0], v1[1]); w.w = cvt_pk_bf16(v1[2], v1[3]);
                    *(u32x4*)(O + row * 2048 + col0 + bj * HALF) = w; } }
    }
};
template <class Epi, class Sched, bool ALIGN_EPI = false, bool SP2 = false>
__device__ __forceinline__ void gemm_phase(PG8_LAS unsigned char* lds, const Gemm g, const Sched& S, const Epi& E) {
    const int tid = threadIdx.x, wid = __builtin_amdgcn_readfirstlane(tid >> 6), lane = tid & 63, wr = wid >> 2, wc = wid & 3, fr = lane & 15, fq = lane >> 4;
    const int K = g.K, nt = K / BK;
    unsigned voffA[2], voffB[2];
#pragma unroll
    for (int i = 0; i < 2; ++i) { int R, C; stage_rc(tid * 16 + i * 8192, R, C); const int Rb = Epi::PERM ? ((R & ~31) + perm32(R & 31)) : R;
        voffA[i] = (unsigned)(R * K + C) * 2u; voffB[i] = (unsigned)(Rb * K + C) * 2u; }
    const size_t kstep = (size_t)(BK * 2);
    const size_t hstep = (size_t)HALF * K * 2;
    const size_t tstep = 2 * hstep;
    const unsigned ldsw = (unsigned)wid * 1024u;
    const int aoff = lds_byte(wr * 64 + fr, fq * 8), boff = lds_byte(wc * 32 + fr, fq * 8);
#define PG8_SA(b, h) (((b) * 2 + (h)) * HTB)
#define PG8_SB(b, h) ((4 + (b) * 2 + (h)) * HTB)
#define PG8_STAGE(bufoff, gbase, voff) do { _Pragma("unroll") for (int _i = 0; _i < 2; ++_i) \
        __builtin_amdgcn_global_load_lds((const unsigned*)((const char*)(gbase) + (voff)[_i]), (PG8_LAS unsigned*)(lds + (bufoff) + ldsw + _i * 8192), 16, 0, 0); } while (0)
#define PG8_LDA(dst, b, h) do { _Pragma("unroll") for (int m = 0; m < 4; ++m) _Pragma("unroll") for (int k = 0; k < 2; ++k) dst[m][k] = *(const PG8_LAS bf16x8*)(lds + PG8_SA(b, h) + aoff + m * 2048 + k * 1024); } while (0)
#define PG8_LDB(dst, b, h) do { _Pragma("unroll") for (int n = 0; n < 2; ++n) _Pragma("unroll") for (int k = 0; k < 2; ++k) dst[n][k] = *(const PG8_LAS bf16x8*)(lds + PG8_SB(b, h) + boff + n * 2048 + k * 1024); } while (0)
#define PG8_MMA(ai, bj, At, Bt) do { __builtin_amdgcn_s_setprio(1); _Pragma("unroll") for (int m = 0; m < 4; ++m) _Pragma("unroll") for (int n = 0; n < 2; ++n) _Pragma("unroll") for (int k = 0; k < 2; ++k) \
        acc[ai][bj][m][n] = __builtin_amdgcn_mfma_f32_16x16x32_bf16(Bt[n][k], At[m][k], acc[ai][bj][m][n], 0, 0, 0); __builtin_amdgcn_s_setprio(0); } while (0)
#define PG8_WAIT_V(n) asm volatile("s_waitcnt vmcnt(" #n ")" ::: "memory")
#define PG8_WAIT_L(n) asm volatile("s_waitcnt lgkmcnt(" #n ")" ::: "memory")
#define PG8_BAR __builtin_amdgcn_s_barrier()
#define PG8_SCHED __builtin_amdgcn_sched_barrier(0)
    Unit cur, nxt; int ui = 0;
    if (!S.next(0, cur)) return;
    f32x4 acc[2][2][4][2];
#pragma unroll
    for (int a = 0; a < 2; ++a)
#pragma unroll
        for (int b = 0; b < 2; ++b)
#pragma unroll
            for (int m = 0; m < 4; ++m)
#pragma unroll
                for (int n = 0; n < 2; ++n) acc[a][b][m][n] = (f32x4){0.f, 0.f, 0.f, 0.f};
    bf16x8 At[4][2], B0[2][2], B1[2][2];
    const char* cA = (const char*)g.A + (size_t)cur.pm * tstep; const char* cB = (const char*)g.Bt + (size_t)cur.pn * tstep;
    S.a_ready(cur);
    if constexpr (SP2) {
        PG8_STAGE(PG8_SB(0, 0), cB, voffB); PG8_STAGE(PG8_SB(0, 1), cB + hstep, voffB); PG8_STAGE(PG8_SA(0, 0), cA, voffA); PG8_STAGE(PG8_SA(0, 1), cA + hstep, voffA);
        if (wr == 1) PG8_BAR;
        PG8_WAIT_V(2); PG8_BAR;
        PG8_STAGE(PG8_SB(1, 0), cB + kstep, voffB); PG8_STAGE(PG8_SA(1, 0), cA + kstep, voffA); PG8_STAGE(PG8_SB(1, 1), cB + hstep + kstep, voffB);
        PG8_WAIT_V(6); PG8_BAR;
    } else {
        PG8_STAGE(PG8_SB(0, 0), cB, voffB); PG8_STAGE(PG8_SA(0, 0), cA, voffA); PG8_STAGE(PG8_SB(0, 1), cB + hstep, voffB); PG8_STAGE(PG8_SA(0, 1), cA + hstep, voffA);
        if (wr == 1) PG8_BAR;
        PG8_WAIT_V(4); PG8_BAR;
        PG8_STAGE(PG8_SB(1, 0), cB + kstep, voffB); PG8_STAGE(PG8_SA(1, 0), cA + kstep, voffA); PG8_STAGE(PG8_SB(1, 1), cB + hstep + kstep, voffB);
        PG8_WAIT_V(6); PG8_BAR;
    }
    for (;;) {
        const bool has_next = S.next(ui + 1, nxt);
        const char* nA = has_next ? (const char*)g.A + (size_t)nxt.pm * tstep : cA; const char* nB = has_next ? (const char*)g.Bt + (size_t)nxt.pn * tstep : cB;
        for (int t = 0; t < nt; t += 2) {
            if constexpr (Epi::MIDK) { if (t == nt / 2) E.midk(acc, cur, wr, wc, fr, fq); }
            const bool last = (t == nt - 2);
            const char* a1 = cA + (size_t)(t + 1) * kstep;
            const char* a2 = last ? nA : cA + (size_t)(t + 2) * kstep; const char* b2 = last ? nB : cB + (size_t)(t + 2) * kstep;
            const char* a3 = a2 + kstep; const char* b3 = b2 + kstep;
            if (last && has_next) S.a_ready(nxt);
            if constexpr (SP2) {
            PG8_LDB(B0, 0, 0); PG8_LDB(B1, 0, 1); PG8_SCHED; PG8_LDA(At, 0, 0); PG8_STAGE(PG8_SA(1, 1), a1 + hstep, voffA);
            PG8_WAIT_V(8); PG8_WAIT_L(0); PG8_BAR; PG8_MMA(0, 0, At, B0); PG8_MMA(0, 1, At, B1); PG8_BAR; PG8_SCHED;
            PG8_LDA(At, 0, 1); PG8_STAGE(PG8_SB(0, 0), b2, voffB); PG8_STAGE(PG8_SB(0, 1), b2 + hstep, voffB); PG8_STAGE(PG8_SA(0, 0), a2, voffA);
            PG8_WAIT_V(8); PG8_WAIT_L(0); PG8_BAR; PG8_MMA(1, 0, At, B0); PG8_MMA(1, 1, At, B1); PG8_BAR; PG8_SCHED;
            PG8_LDB(B0, 1, 0); PG8_LDB(B1, 1, 1); PG8_SCHED; PG8_LDA(At, 1, 0); PG8_STAGE(PG8_SA(0, 1), a2 + hstep, voffA);
            PG8_WAIT_V(8); PG8_WAIT_L(0); PG8_BAR; PG8_MMA(0, 0, At, B0); PG8_MMA(0, 1, At, B1); PG8_BAR; PG8_SCHED;
            PG8_LDA(At, 1, 1); PG8_STAGE(PG8_SB(1, 0), b3, voffB); PG8_STAGE(PG8_SB(1, 1), b3 + hstep, voffB); PG8_STAGE(PG8_SA(1, 0), a3, voffA);
            PG8_WAIT_V(8); PG8_WAIT_L(0); PG8_BAR; PG8_MMA(1, 0, At, B0); PG8_MMA(1, 1, At, B1); PG8_BAR; PG8_SCHED;
            } else {
            PG8_LDB(B0, 0, 0); PG8_SCHED; PG8_LDA(At, 0, 0); PG8_STAGE(PG8_SA(1, 1), a1 + hstep, voffA);
            PG8_WAIT_L(8); PG8_BAR; PG8_WAIT_L(0); PG8_MMA(0, 0, At, B0); PG8_BAR; PG8_SCHED;
            PG8_LDB(B1, 0, 1); PG8_STAGE(PG8_SB(0, 0), b2, voffB);
            PG8_BAR; PG8_WAIT_L(0); PG8_MMA(0, 1, At, B1); PG8_BAR;
            PG8_LDA(At, 0, 1); PG8_STAGE(PG8_SA(0, 0), a2, voffA);
            PG8_BAR; PG8_WAIT_L(0); PG8_MMA(1, 0, At, B0); PG8_BAR; PG8_SCHED;
            PG8_STAGE(PG8_SB(0, 1), b2 + hstep, voffB);
            PG8_WAIT_V(6); PG8_BAR; PG8_MMA(1, 1, At, B1); PG8_BAR;
            PG8_LDB(B0, 1, 0); PG8_SCHED; PG8_LDA(At, 1, 0); PG8_STAGE(PG8_SA(0, 1), a2 + hstep, voffA);
            PG8_WAIT_L(8); PG8_BAR; PG8_WAIT_L(0); PG8_MMA(0, 0, At, B0); PG8_BAR; PG8_SCHED;
            PG8_LDB(B1, 1, 1); PG8_STAGE(PG8_SB(1, 0), b3, voffB);
            PG8_BAR; PG8_WAIT_L(0); PG8_MMA(0, 1, At, B1); PG8_BAR;
            PG8_LDA(At, 1, 1); PG8_STAGE(PG8_SA(1, 0), a3, voffA);
            PG8_BAR; PG8_WAIT_L(0); PG8_MMA(1, 0, At, B0); PG8_BAR; PG8_SCHED;
            PG8_STAGE(PG8_SB(1, 1), b3 + hstep, voffB);
            PG8_WAIT_V(6); PG8_BAR; PG8_MMA(1, 1, At, B1); PG8_BAR;
            }
        }
        if constexpr (ALIGN_EPI) { if (wr == 0) PG8_BAR; }
        if constexpr (!Epi::AFTER_DRAIN) { E(acc, cur, wr, wc, fr, fq); S.done(cur); }
        if (!has_next) break;
#pragma unroll
        for (int a = 0; a < 2; ++a)
#pragma unroll
            for (int b = 0; b < 2; ++b)
#pragma unroll
                for (int m = 0; m < 4; ++m)
#pragma unroll
                    for (int n = 0; n < 2; ++n) acc[a][b][m][n] = (f32x4){0.f, 0.f, 0.f, 0.f};
        cur = nxt; cA = nA; cB = nB; ++ui;
        if constexpr (ALIGN_EPI) { if (wr == 1) PG8_BAR; }
    }
    PG8_WAIT_V(0);
    if constexpr (!ALIGN_EPI) { if (wr == 0) PG8_BAR; }
    PG8_BAR;
    if constexpr (Epi::AFTER_DRAIN) { E.fused(acc, cur, wr, wc, fr, fq, lds, wid, lane); S.done(cur); }
#undef PG8_SA
#undef PG8_SB
#undef PG8_STAGE
#undef PG8_LDA
#undef PG8_LDB
#undef PG8_MMA
#undef PG8_WAIT_V
#undef PG8_WAIT_L
#undef PG8_BAR
#undef PG8_SCHED
}
}
#define XB_TMO      128
#define XB_XCNT(j)  (256  + 64 * (j))
#define XB_XSUB(j)  (1280 + 64 * (j))
#define XB_XGEN(j)  (2304 + 64 * (j))
#define XB_TOP      3328
#define XB_TOPGEN   3392
#define XCD_BAR_WORDS 3456
#define XB_SPIN_CAP (1u << 18)

__device__ __forceinline__ unsigned xb_ld(unsigned* p)              { return __hip_atomic_load(p, __ATOMIC_RELAXED, __HIP_MEMORY_SCOPE_AGENT); }
__device__ __forceinline__ unsigned xb_add(unsigned* p, unsigned v) { return __hip_atomic_fetch_add(p, v, __ATOMIC_RELAXED, __HIP_MEMORY_SCOPE_AGENT); }
__device__ __forceinline__ unsigned xb_xcc_id() { return (unsigned)__builtin_amdgcn_s_getreg((3 << 11) | 20) & 0xFu; }
#define XB_SPIN(cond, bar) do { unsigned _sp = 0; while (cond) { __builtin_amdgcn_s_sleep(1); \
    if ((++_sp & 255u) == 0u) { if (xb_ld(&(bar)[XB_TMO])) break; if (_sp > XB_SPIN_CAP) { atomicAdd(&(bar)[XB_TMO], 1u); break; } } } } while (0)

struct XcdBarrier {
    unsigned* bar; unsigned x;
    volatile LAS unsigned* st;
};

__device__ __forceinline__ XcdBarrier xcd_barrier_post(unsigned* bar, volatile LAS unsigned* st) {
    XcdBarrier b; b.bar = bar; b.x = xb_xcc_id(); b.st = st;
    if (threadIdx.x == 0) (void)xb_add(&bar[XB_XCNT(b.x)], 1u);
    return b;
}
__device__ __forceinline__ void xcd_barrier_complete(unsigned* bar, unsigned x, unsigned& nloc, unsigned& nx) {
    const unsigned G = gridDim.x * gridDim.y * gridDim.z;
    unsigned sum, cnt, mine, sp = 0u;
    for (;;) {
        sum = 0u; cnt = 0u; mine = 0u;
#pragma unroll
        for (unsigned j = 0; j < 16; ++j) { const unsigned c = xb_ld(&bar[XB_XCNT(j)]); sum += c; cnt += (c > 0u) ? 1u : 0u; mine = (j == x) ? c : mine; }
        if (sum == G) break;
        __builtin_amdgcn_s_sleep(1);
        if ((++sp & 255u) == 0u) { if (xb_ld(&bar[XB_TMO])) break; if (sp > XB_SPIN_CAP) { atomicAdd(&bar[XB_TMO], 1u); break; } }
    }
    nloc = mine > 0u ? mine : 1u; nx = cnt > 0u ? cnt : 1u;
}

__device__ __forceinline__ void xcd_barrier(const XcdBarrier& b) {
    asm volatile("s_waitcnt vmcnt(0)" ::: "memory");
    __syncthreads();
    if (threadIdx.x == 0) {
        unsigned* bar = b.bar;
        __builtin_amdgcn_s_waitcnt(0);
        unsigned nloc = b.st[0], nx = b.st[1];
        if (nloc == 0u) { xcd_barrier_complete(bar, b.x, nloc, nx); b.st[0] = nloc; b.st[1] = nx; }
        const unsigned old = xb_add(&bar[XB_XSUB(b.x)], 1u);
        const unsigned gen = old / nloc;
        if (old + 1u == (gen + 1u) * nloc) {
            __builtin_amdgcn_fence(__ATOMIC_RELEASE, "agent");
            asm volatile("s_waitcnt vmcnt(0)" ::: "memory");
            const unsigned og = xb_add(&bar[XB_TOP], 1u);
            const unsigned tg = og / nx;
            if (og + 1u == (tg + 1u) * nx) xb_add(&bar[XB_TOPGEN], 1u);
            else XB_SPIN(xb_ld(&bar[XB_TOPGEN]) == tg, bar);
            __builtin_amdgcn_fence(__ATOMIC_ACQUIRE, "agent");
            xb_add(&bar[XB_XGEN(b.x)], 1u);
            asm volatile("s_waitcnt vmcnt(0)" ::: "memory");
        } else {
            XB_SPIN(xb_ld(&bar[XB_XGEN(b.x)]) == gen, bar);
            __builtin_amdgcn_fence(__ATOMIC_ACQUIRE, "agent");
            asm volatile("s_waitcnt vmcnt(0)" ::: "memory");
        }
    }
    __syncthreads();
}

constexpr int NWAVES = 8;
constexpr size_t MiB = 1u << 20;
constexpr size_t WS_CTL = 0, CTL_ZERO_BYTES = 1 * MiB;
constexpr size_t WS_W1T = 2 * MiB;
constexpr size_t WS_W2T = 16 * MiB;
constexpr size_t WS_W3T = 24 * MiB;
constexpr size_t WS_SKB = 32 * MiB;
constexpr size_t WS_RSTD1 = 33 * MiB;
constexpr size_t WS_SSA = 34 * MiB;
constexpr size_t WS_SSL = 35 * MiB;
constexpr size_t WS_SS2 = 37 * MiB;
constexpr size_t WS_RSTD2 = 39 * MiB;
constexpr size_t WS_IDS = 40 * MiB;
constexpr size_t WS_GW = 48 * MiB;
constexpr size_t WS_U8 = 64 * MiB;
constexpr size_t WS_V8 = 96 * MiB;
constexpr size_t WS_X8 = 128 * MiB;
constexpr size_t WS_SX = 160 * MiB;
constexpr size_t WS_SCU = 162 * MiB;
constexpr size_t WS_SCV = 163 * MiB;
constexpr size_t WS_WSUM = 164 * MiB;
constexpr size_t WS_A1 = 192 * MiB;
constexpr size_t WS_Q = 258 * MiB;
constexpr size_t WS_KV = 290 * MiB;
constexpr size_t WS_XB = 299 * MiB;
constexpr size_t WS_GT = 332 * MiB;
constexpr size_t WS_H1 = 364 * MiB;
constexpr size_t WS_PART = 192 * MiB;
constexpr size_t WS_W = 56 * MiB;
constexpr size_t WS_Z = 428 * MiB;
constexpr size_t WS_END = 492 * MiB;
constexpr int CW_QROW = 2048;
constexpr int CW_BAR = 4096;

constexpr int RING_OFF = 0, RING_BYTES = 131072;
constexpr int LDSCTL_OFF = RING_BYTES, MISC_OFF = LDSCTL_OFF + 320;
constexpr int LDS_BYTES = 147456;

typedef unsigned short bf16;
typedef unsigned v4u __attribute__((ext_vector_type(4)));
typedef float f32x4 __attribute__((ext_vector_type(4)));
typedef short bf16x8 __attribute__((ext_vector_type(8)));
typedef GAS unsigned gu32;
#define RLX_AGENT __ATOMIC_RELAXED, __HIP_MEMORY_SCOPE_AGENT
#define LDS_WAIT() asm volatile("s_waitcnt lgkmcnt(0)" ::: "memory")
#define VM_WAIT() asm volatile("s_waitcnt vmcnt(0)" ::: "memory")
__device__ __forceinline__ unsigned f2bf(float f) { unsigned u = __builtin_bit_cast(unsigned, f); return (u + 0x7fffu + ((u >> 16) & 1u)) >> 16; }
__device__ __forceinline__ unsigned pk2(float lo, float hi) { return f2bf(lo) | (f2bf(hi) << 16); }
__device__ __forceinline__ float bf2f(unsigned short b) { return __builtin_bit_cast(float, (unsigned)b << 16); }

namespace p2 {
typedef float f32x16 __attribute__((ext_vector_type(16)));
typedef unsigned u32x2 __attribute__((ext_vector_type(2)));
constexpr float LOG2E = 1.4426950408889634f;
constexpr float NEGBIG = -1e30f;
__device__ __forceinline__ int crow(int r, int hi) { return (r & 3) + 8 * (r >> 2) + 4 * hi; }
__device__ __forceinline__ unsigned cvtpk(float lo, float hi) { unsigned r; asm volatile("v_cvt_pk_bf16_f32 %0, %1, %2" : "=v"(r) : "v"(lo), "v"(hi)); return r; }
__device__ __forceinline__ float ex2(float x) { return __builtin_amdgcn_exp2f(x); }
__device__ __forceinline__ float rcp(float x) { return __builtin_amdgcn_rcpf(x); }
__device__ __forceinline__ float gelu_fast(float x) { return x * rcp(1.0f + ex2(-2.302208198f * x * (1.0f + 0.044715f * x * x))); }

constexpr int A_KS = 0, A_KSP = 144, A_VT = 288 * 144, A_VTP = 584, A_ST = A_VT + 64 * 584, A_END = A_ST + 8 * 4096;
__device__ __forceinline__ void attn_unit(LAS unsigned char* lds, int b, int qblk, int kvh, const bf16* QB, const bf16* KVB, const float* sinks, bf16* MIX, float* SSA, int tid) {
    const int lane = tid & 63, wave = __builtin_amdgcn_readfirstlane(tid >> 6), r = lane & 31, hi = lane >> 5;
    const int q0 = qblk * 128, hq = kvh * 8 + wave;
    for (int it = 0; it < 5; ++it) {
        const int cid = it * 512 + tid;
        if (cid < 288 * 8) {
            const int key = cid >> 3, ch = cid & 7;
            bool valid; size_t row = 0;
            if (key < 256) { const int pos = q0 - 128 + key; valid = pos >= 0; row = (size_t)b * SEQ + pos; }
            else if (key < 272) { valid = true; row = (size_t)MREAL + (key - 256); }
            else valid = false;
            v4u kv = {0u, 0u, 0u, 0u}, vv = {0u, 0u, 0u, 0u};
            if (valid) { kv = *(const GAS v4u*)(KVB + row * 256 + kvh * 64 + ch * 8); vv = *(const GAS v4u*)(KVB + row * 256 + 128 + kvh * 64 + ch * 8); }
            *(LAS v4u*)(lds + A_KS + key * A_KSP + ch * 16) = kv;
            LAS unsigned short* vt = (LAS unsigned short*)(lds + A_VT);
#pragma unroll
            for (int j = 0; j < 8; ++j) { const unsigned wv = vv[j >> 1]; vt[(ch * 8 + j) * (A_VTP / 2) + key] = (unsigned short)((j & 1) ? (wv >> 16) : (wv & 0xffffu)); }
        }
    }
    __syncthreads();
    const float sink2 = sinks[hq] * LOG2E;
    for (int qg = 0; qg < 4; ++qg) {
        const size_t mrow = (size_t)b * SEQ + q0 + 32 * qg + r;
        bf16x8 qf[4];
#pragma unroll
        for (int ks = 0; ks < 4; ++ks) qf[ks] = *(const GAS bf16x8*)(QB + mrow * 1024 + hq * 64 + ks * 16 + hi * 8);
        f32x16 s[6];
#pragma unroll
        for (int t = 0; t < 6; ++t) {
            const int kbase = t < 5 ? 32 * (qg + t) : 256;
            f32x16 acc = {0.f, 0.f, 0.f, 0.f, 0.f, 0.f, 0.f, 0.f, 0.f, 0.f, 0.f, 0.f, 0.f, 0.f, 0.f, 0.f};
#pragma unroll
            for (int ks = 0; ks < 4; ++ks) {
                const bf16x8 kf = *(const LAS bf16x8*)(lds + A_KS + (kbase + r) * A_KSP + ks * 32 + hi * 16);
                acc = __builtin_amdgcn_mfma_f32_32x32x16_bf16(kf, qf[ks], acc, 0, 0, 0);
            }
            s[t] = acc;
        }
        const bool blk0 = (qblk == 0);
#pragma unroll
        for (int reg = 0; reg < 16; ++reg) {
            const int j = crow(reg, hi);
            s[0][reg] = (j > r) ? s[0][reg] : NEGBIG;
            s[4][reg] = (j <= r) ? s[4][reg] : NEGBIG;
            s[5][reg] = (j < 16) ? s[5][reg] : NEGBIG;
        }
#pragma unroll
        for (int t = 0; t < 4; ++t) if (blk0 && (qg + t < 4)) {
#pragma unroll
            for (int reg = 0; reg < 16; ++reg) s[t][reg] = NEGBIG;
        }
        float m = sink2;
#pragma unroll
        for (int t = 0; t < 6; ++t)
#pragma unroll
            for (int reg = 0; reg < 16; ++reg) m = fmaxf(m, s[t][reg]);
        m = fmaxf(m, __shfl_xor(m, 32));
        float l = 0.f;
#pragma unroll
        for (int t = 0; t < 6; ++t)
#pragma unroll
            for (int reg = 0; reg < 16; ++reg) { const float p = ex2(s[t][reg] - m); s[t][reg] = p; l += p; }
        l += __shfl_xor(l, 32);
        l += ex2(sink2 - m);
        const float linv = 1.0f / l;
        f32x16 o0 = {0.f, 0.f, 0.f, 0.f, 0.f, 0.f, 0.f, 0.f, 0.f, 0.f, 0.f, 0.f, 0.f, 0.f, 0.f, 0.f}, o1 = o0;
#pragma unroll
        for (int t = 0; t < 6; ++t) {
            const int kbase = t < 5 ? 32 * (qg + t) : 256;
#pragma unroll
            for (int ss = 0; ss < 2; ++ss) {
                v4u pw; pw.x = cvtpk(s[t][8 * ss + 0], s[t][8 * ss + 1]); pw.y = cvtpk(s[t][8 * ss + 2], s[t][8 * ss + 3]);
                pw.z = cvtpk(s[t][8 * ss + 4], s[t][8 * ss + 5]); pw.w = cvtpk(s[t][8 * ss + 6], s[t][8 * ss + 7]);
                const bf16x8 pa = __builtin_bit_cast(bf16x8, pw);
                const int ko = (kbase + 16 * ss + 4 * hi) * 2;
                {   const u32x2 lo = *(const LAS u32x2*)(lds + A_VT + r * A_VTP + ko), h2 = *(const LAS u32x2*)(lds + A_VT + r * A_VTP + ko + 16);
                    v4u vw; vw.x = lo.x; vw.y = lo.y; vw.z = h2.x; vw.w = h2.y;
                    o0 = __builtin_amdgcn_mfma_f32_32x32x16_bf16(pa, __builtin_bit_cast(bf16x8, vw), o0, 0, 0, 0); }
                {   const u32x2 lo = *(const LAS u32x2*)(lds + A_VT + (32 + r) * A_VTP + ko), h2 = *(const LAS u32x2*)(lds + A_VT + (32 + r) * A_VTP + ko + 16);
                    v4u vw; vw.x = lo.x; vw.y = lo.y; vw.z = h2.x; vw.w = h2.y;
                    o1 = __builtin_amdgcn_mfma_f32_32x32x16_bf16(pa, __builtin_bit_cast(bf16x8, vw), o1, 0, 0, 0); }
            }
        }
        LAS unsigned short* stg = (LAS unsigned short*)(lds + A_ST + wave * 4096);
#pragma unroll
        for (int reg = 0; reg < 16; ++reg) {
            const int qr = crow(reg, hi); const float li = __shfl(linv, qr);
            stg[qr * 64 + r] = (unsigned short)f2bf(o0[reg] * li);
            stg[qr * 64 + 32 + r] = (unsigned short)f2bf(o1[reg] * li);
        }
        asm volatile("s_waitcnt lgkmcnt(0)" ::: "memory");
#pragma unroll
        for (int i = 0; i < 4; ++i) {
            const int row = i * 8 + (lane >> 3), ch = lane & 7;
            const v4u v = *(const LAS v4u*)(stg + row * 64 + ch * 8);
            float ss = 0.f;
#pragma unroll
            for (int k = 0; k < 4; ++k) { const float a = __builtin_bit_cast(float, v[k] << 16), c = __builtin_bit_cast(float, v[k] & 0xffff0000u); ss += a * a + c * c; }
            ss += __shfl_xor(ss, 1); ss += __shfl_xor(ss, 2); ss += __shfl_xor(ss, 4);
            const size_t orow = (size_t)b * SEQ + q0 + 32 * qg + row;
            *(GAS v4u*)(MIX + orow * D + hq * 64 + ch * 8) = v;
            if (ch == 0) SSA[orow * 16 + hq] = ss;
        }
        asm volatile("s_waitcnt lgkmcnt(0)" ::: "memory");
    }
    __syncthreads();
}

constexpr int LW_XS = 0, LW_GS = 4608, LW_XC = LW_GS + 2048, LW_XCF = LW_XC + 4608, LW_BYTES = LW_XCF + 4096 + 128;
constexpr int L_CT = 8 * LW_BYTES, L_END = L_CT + 2 * 2048;
static_assert(L_END <= 131072, "lru lds");
struct LruP { const float *conv_w, *conv_b, *w_r, *b_r, *w_i, *b_i, *lam; };
__device__ __forceinline__ void lru_unit(LAS unsigned char* lds, LAS unsigned char* ldsw  , int b, int nb, int cg, const bf16* XBB, const bf16* GTB, const LruP P, bf16* MIX, float* SSL, int tid) {
    const int lane = tid & 63, wave = __builtin_amdgcn_readfirstlane(tid >> 6), r = lane & 31, hi = lane >> 5;
    LAS unsigned char* lw = lds + wave * LW_BYTES;
    {
        LAS unsigned short* wt = (LAS unsigned short*)ldsw;
#pragma unroll
        for (int i = 0; i < 4; ++i) {
            const int e = tid + 512 * i, c = e >> 5, dl = e & 31;
            const size_t gi = (size_t)(nb * 64 + c) * 64 + 32 * cg + dl;
            wt[dl * 72 + c] = (unsigned short)f2bf(P.w_r[gi]);
            wt[32 * 72 + dl * 72 + c] = (unsigned short)f2bf(P.w_i[gi]);
        }
    }
    const int cc = lane, chc = nb * 64 + cc;
    const float cw0 = P.conv_w[0 * LW + chc], cw1 = P.conv_w[1 * LW + chc], cw2 = P.conv_w[2 * LW + chc], cw3 = P.conv_w[3 * LW + chc], cbv = P.conv_b[chc];
    const int chd = nb * 64 + 32 * cg + r;
    const float br = P.b_r[chd], bi = P.b_i[chd];
    const float ls8 = -8.0f * log1pf(expf(-P.lam[chd])) * LOG2E;
    float state = 0.f;
    v4u px[5], pg[2];
#define LRU_PREFETCH(tl) do { \
        _Pragma("unroll") for (int it = 0; it < 5; ++it) { const int cid = it * 64 + lane; px[it] = (v4u){0u, 0u, 0u, 0u}; \
            if (cid < 35 * 8) { const int j = cid >> 3, ch = cid & 7, t = 32 * wave + j - 3; bool valid; size_t row = 0; \
                if ((tl) == 0) { valid = (t >= 0 && t < NMETA); row = (size_t)MREAL + t; } \
                else if ((tl) == 1 && t < 0) { valid = true; row = (size_t)MREAL + NMETA + t; } \
                else { valid = true; row = (size_t)b * SEQ + 256 * ((tl) - 1) + t; } \
                if (valid) px[it] = *(const GAS v4u*)(XBB + row * 1024 + nb * 64 + ch * 8); } } \
        if ((tl) > 0) { _Pragma("unroll") for (int it = 0; it < 2; ++it) { const int cid = it * 64 + lane, t = 32 * wave + (cid >> 2), ch = cid & 3; \
            pg[it] = *(const GAS v4u*)(GTB + ((size_t)b * SEQ + 256 * ((tl) - 1) + t) * 1024 + nb * 64 + 32 * cg + ch * 8); } } } while (0)
    LRU_PREFETCH(0);
    __syncthreads();
    for (int tile = 0; tile < 9; ++tile) {
#pragma unroll
        for (int it = 0; it < 5; ++it) { const int cid = it * 64 + lane; if (cid < 35 * 8) *(LAS v4u*)(lw + LW_XS + (cid >> 3) * 128 + (cid & 7) * 16) = px[it]; }
        if (tile > 0) {
#pragma unroll
            for (int it = 0; it < 2; ++it) { const int cid = it * 64 + lane; *(LAS v4u*)(lw + LW_GS + (cid >> 2) * 64 + (cid & 3) * 16) = pg[it]; }
        }
        asm volatile("s_waitcnt lgkmcnt(0)" ::: "memory");
        if (tile + 1 < 9) LRU_PREFETCH(tile + 1);
        {
            const LAS unsigned short* xs = (const LAS unsigned short*)(lw + LW_XS);
            LAS unsigned short* xc = (LAS unsigned short*)(lw + LW_XC);
            LAS float* xcf = (LAS float*)(lw + LW_XCF);
            const bool own = (cc >> 5) == cg; const int xoff = own ? (cc & 31) : 32 * 32 + (cc & 31);
            float x0 = bf2f(xs[0 * 64 + cc]), x1 = bf2f(xs[1 * 64 + cc]), x2 = bf2f(xs[2 * 64 + cc]);
#pragma unroll 8
            for (int k = 0; k < 32; ++k) {
                const float x3 = bf2f(xs[(k + 3) * 64 + cc]);
                const float v = cbv + cw0 * x0 + cw1 * x1 + cw2 * x2 + cw3 * x3;
                xc[k * 72 + cc] = (unsigned short)cvtpk(v, v);
                xcf[(own ? k * 32 : 0) + xoff] = v;
                x0 = x1; x1 = x2; x2 = x3;
            }
        }
        asm volatile("s_waitcnt lgkmcnt(0)" ::: "memory");
        f32x16 aR = {0.f, 0.f, 0.f, 0.f, 0.f, 0.f, 0.f, 0.f, 0.f, 0.f, 0.f, 0.f, 0.f, 0.f, 0.f, 0.f}, aI = aR;
#pragma unroll
        for (int ks = 0; ks < 4; ++ks) {
            const bf16x8 xa = *(const LAS bf16x8*)(lw + LW_XC + r * 144 + ks * 32 + hi * 16);
            const bf16x8 wr_ = *(const LAS bf16x8*)(ldsw + r * 144 + ks * 32 + hi * 16);
            const bf16x8 wi_ = *(const LAS bf16x8*)(ldsw + 32 * 144 + r * 144 + ks * 32 + hi * 16);
            aR = __builtin_amdgcn_mfma_f32_32x32x16_bf16(xa, wr_, aR, 0, 0, 0);
            aI = __builtin_amdgcn_mfma_f32_32x32x16_bf16(xa, wi_, aI, 0, 0, 0);
        }
        float Av[16], Bv[16];
        {
            const LAS float* xcf = (const LAS float*)(lw + LW_XCF);
#pragma unroll
            for (int reg = 0; reg < 16; ++reg) {
                const int tl = crow(reg, hi), t = 32 * wave + tl;
                const bool valid = (tile > 0) || (t < NMETA);
                const float rg = rcp(1.0f + ex2(-(aR[reg] + br) * LOG2E));
                const float ig = rcp(1.0f + ex2(-(aI[reg] + bi) * LOG2E));
                const float a = ex2(rg * ls8);
                const float mult = __builtin_amdgcn_sqrtf(fmaxf(1.0f - a * a, 0.f));
                const float bx = mult * ig * xcf[tl * 32 + r];
                Av[reg] = valid ? a : 1.0f; Bv[reg] = valid ? bx : 0.0f;
            }
        }
#pragma unroll
        for (int g = 0; g < 4; ++g) {
#pragma unroll
            for (int k = 1; k < 4; ++k) { Bv[4 * g + k] = Av[4 * g + k] * Bv[4 * g + k - 1] + Bv[4 * g + k]; Av[4 * g + k] = Av[4 * g + k] * Av[4 * g + k - 1]; }
        }
        float myCz[4], myCp[4], PW, HW;
        {
            float cz = 0.f, cp = 1.f;
#pragma unroll
            for (int g = 0; g < 4; ++g) {
                const float mP = Av[4 * g + 3], mH = Bv[4 * g + 3];
                const float oP = __shfl_xor(mP, 32), oH = __shfl_xor(mH, 32);
                const float eP = hi ? oP : mP, eH = hi ? oH : mH, dP = hi ? mP : oP, dH = hi ? mH : oH;
                const float cz0 = cz, cp0 = cp;
                cz = eP * cz + eH; cp = cp * eP;
                myCz[g] = hi ? cz : cz0; myCp[g] = hi ? cp : cp0;
                cz = dP * cz + dH; cp = cp * dP;
            }
            PW = cp; HW = cz;
        }
        LAS float* ct = (LAS float*)(lds + L_CT + (tile & 1) * 2048);
        if (hi == 0) { ct[(wave * 32 + r) * 2] = PW; ct[(wave * 32 + r) * 2 + 1] = HW; }
        __syncthreads();
        float cin = 0.f;
        {
            float c = state;
#pragma unroll
            for (int w2 = 0; w2 < 8; ++w2) { if (w2 == wave) cin = c; c = ct[(w2 * 32 + r) * 2] * c + ct[(w2 * 32 + r) * 2 + 1]; }
            state = c;
        }
        if (tile > 0) {
            const LAS unsigned short* gs = (const LAS unsigned short*)(lw + LW_GS);
            LAS unsigned short* os = (LAS unsigned short*)(lw + LW_XS);
#pragma unroll
            for (int reg = 0; reg < 16; ++reg) {
                const int g = reg >> 2, tl = crow(reg, hi);
                const float h = Bv[reg] + Av[reg] * (myCz[g] + myCp[g] * cin);
                const float gt = bf2f(gs[tl * 32 + r]);
                { const float ov = gelu_fast(gt) * h; os[tl * 32 + r] = (unsigned short)cvtpk(ov, ov); }
            }
            asm volatile("s_waitcnt lgkmcnt(0)" ::: "memory");
#pragma unroll
            for (int it = 0; it < 2; ++it) {
                const int cid = it * 64 + lane, tl = cid >> 2, ch = cid & 3;
                const v4u v = *(const LAS v4u*)(lw + LW_XS + tl * 64 + ch * 16);
                float ss = 0.f;
#pragma unroll
                for (int k = 0; k < 4; ++k) { const float a = __builtin_bit_cast(float, v[k] << 16), c = __builtin_bit_cast(float, v[k] & 0xffff0000u); ss += a * a + c * c; }
                ss += __shfl_xor(ss, 1); ss += __shfl_xor(ss, 2);
                const size_t row = (size_t)b * SEQ + 256 * (tile - 1) + 32 * wave + tl;
                *(GAS v4u*)(MIX + row * D + 1024 + nb * 64 + 32 * cg + ch * 8) = v;
                if (ch == 0) SSL[row * 32 + nb * 2 + cg] = ss;
            }
            asm volatile("s_waitcnt lgkmcnt(0)" ::: "memory");
        }
    }
#undef LRU_PREFETCH
    __syncthreads();
}
}

namespace p5 {
typedef float f32x16 __attribute__((ext_vector_type(16)));
constexpr int KP = 272;
constexpr int R_KEYS = 0, R_IDX = 256 * KP, R_END = R_IDX + 8 * 1024;
__device__ __forceinline__ int crow(int r, int hi) { return (r & 3) + 8 * (r >> 2) + 4 * hi; }
__device__ __forceinline__ float fkey(float s, int mask, int payload) { return __builtin_bit_cast(float, (__builtin_bit_cast(int, s) & mask) | payload); }
__device__ __forceinline__ int fbits(float f) { return __builtin_bit_cast(int, f); }
__device__ __forceinline__ float fval(float f, int mask) { return __builtin_bit_cast(float, __builtin_bit_cast(int, f) & mask); }
__device__ __forceinline__ void ins16(float (&L)[16], float v) {
#pragma unroll
    for (int k = 15; k >= 1; --k) L[k] = __builtin_amdgcn_fmed3f(L[k - 1], L[k], v);
    L[0] = fmaxf(L[0], v);
}
__device__ __forceinline__ void half_top16(const LAS unsigned char* keys, const bf16x8 (&qf)[8], int r, int hi, float (&T)[16]) {
    float L[16];
#pragma unroll
    for (int k = 0; k < 16; ++k) L[k] = -INFINITY;
    const int h4 = 4 * hi;
#pragma unroll
    for (int kt = 0; kt < 4; ++kt) {
        f32x16 acc = {0.f, 0.f, 0.f, 0.f, 0.f, 0.f, 0.f, 0.f, 0.f, 0.f, 0.f, 0.f, 0.f, 0.f, 0.f, 0.f};
#pragma unroll
        for (int ks = 0; ks < 8; ++ks) {
            const bf16x8 kf = *(const LAS bf16x8*)(keys + (kt * 32 + r) * KP + ks * 32 + hi * 16);
            acc = __builtin_amdgcn_mfma_f32_32x32x16_bf16(kf, qf[ks], acc, 0, 0, 0);
        }
#pragma unroll
        for (int reg = 0; reg < 16; ++reg) {
            const int C = 127 - 32 * kt - (reg & 3) - 8 * (reg >> 2);
            ins16(L, fkey(acc[reg], (int)0xffffff80, C - h4));
        }
    }
    float M[16];
#pragma unroll
    for (int i = 0; i < 16; ++i) M[i] = fmaxf(L[i], __shfl_xor(L[15 - i], 32));
#define P5_STAGE(st) _Pragma("unroll") for (int i = 0; i < 16; ++i) if ((i & (st)) == 0) { const float a = fmaxf(M[i], M[i + (st)]), b = fminf(M[i], M[i + (st)]); M[i] = a; M[i + (st)] = b; }
    P5_STAGE(8) P5_STAGE(4) P5_STAGE(2) P5_STAGE(1)
#undef P5_STAGE
#pragma unroll
    for (int i = 0; i < 16; ++i) T[i] = M[i];
}

__device__ __forceinline__ void retr_unit(LAS unsigned char* lds, int h, int tg, const bf16* QPB, const bf16* SKB, unsigned short* IDS, float* GW, const float* RSTD2, int tid) {
    const int lane = tid & 63, wave = __builtin_amdgcn_readfirstlane(tid >> 6), r = lane & 31, hi = lane >> 5;
#pragma unroll
    for (int it = 0; it < 8; ++it) {
        const int cid = it * 512 + tid, row = cid >> 4, ch = cid & 15;
        *(LAS v4u*)(lds + R_KEYS + row * KP + ch * 16) = *(const GAS v4u*)(SKB + ((size_t)h * 256 + row) * 128 + ch * 8);
    }
    const size_t tok = (size_t)tg * 256 + wave * 32 + r;
    bf16x8 qa[8], qb[8];
#pragma unroll
    for (int ks = 0; ks < 8; ++ks) { qa[ks] = *(const GAS bf16x8*)(QPB + tok * D + h * 256 + ks * 16 + hi * 8); qb[ks] = *(const GAS bf16x8*)(QPB + tok * D + h * 256 + 128 + ks * 16 + hi * 8); }
    const float rs = RSTD2[tok];
    __syncthreads();
    float TA[16], TB[16];
    half_top16(lds + R_KEYS, qa, r, hi, TA);
    half_top16(lds + R_KEYS + 128 * KP, qb, r, hi, TB);
    LAS unsigned char* sc = lds + R_IDX + wave * 1024 + r * 32;
    const int hm = -hi;
    {
        v4u w;
#pragma unroll
        for (int q = 0; q < 4; ++q) { unsigned x = 0;
#pragma unroll
            for (int k = 0; k < 4; ++k) { const int t = (fbits(TB[4 * q + k]) & hm) | (fbits(TA[4 * q + k]) & ~hm); x |= (unsigned)(127 - (t & 0x7f)) << (8 * k); }
            w[q] = x; }
        *(LAS v4u*)(sc + hi * 16) = w;
    }
    float sA[16], sB[16];
#pragma unroll
    for (int i = 0; i < 16; ++i) { sA[i] = fval(TA[i], (int)0xffffff80); sB[i] = fval(TB[i], (int)0xffffff80); }
    float L[16];
#pragma unroll
    for (int k = 0; k < 16; ++k) L[k] = -INFINITY;
#pragma unroll
    for (int i = 0; i < 16; ++i)
#pragma unroll
        for (int j = 0; j < 16; ++j) if ((i + 1) * (j + 1) <= 16) {
            ins16(L, fkey(sA[i] + sB[j], (int)0xffffff00, 255 - (i * 16 + j)));
        }
    const float v0 = fval(L[0], (int)0xffffff00);
    asm volatile("s_waitcnt lgkmcnt(0)" ::: "memory");
    int ex[8]; float ew[8]; float esum = 0.f;
#pragma unroll
    for (int k = 0; k < 8; ++k) {
        const int t = (fbits(L[8 + k]) & hm) | (fbits(L[k]) & ~hm);
        const int c = 255 - (t & 0xff);
        const int ia = sc[c >> 4], ib = sc[16 + (c & 15)];
        ex[k] = ia * 128 + ib;
        const float e = __builtin_amdgcn_exp2f((__builtin_bit_cast(float, t & (int)0xffffff00) - v0) * rs * 1.4426950408889634f);
        ew[k] = e; esum += e;
    }
    esum += __shfl_xor(esum, 32);
    const float inv = 1.0f / esum;
    unsigned short* ip = IDS + tok * 128 + h * 16 + hi * 8; float* gp = GW + tok * 128 + h * 16 + hi * 8;
    *(GAS v4u*)(ip) = (v4u){(unsigned)ex[0] | ((unsigned)ex[1] << 16), (unsigned)ex[2] | ((unsigned)ex[3] << 16), (unsigned)ex[4] | ((unsigned)ex[5] << 16), (unsigned)ex[6] | ((unsigned)ex[7] << 16)};
    *(GAS f32x4*)(gp) = (f32x4){ew[0] * inv, ew[1] * inv, ew[2] * inv, ew[3] * inv};
    *(GAS f32x4*)(gp + 4) = (f32x4){ew[4] * inv, ew[5] * inv, ew[6] * inv, ew[7] * inv};
    __syncthreads();
}
}

namespace p6 {
__device__ __forceinline__ float blo(unsigned w) { return __builtin_bit_cast(float, w << 16); }
__device__ __forceinline__ float bhi(unsigned w) { return __builtin_bit_cast(float, w & 0xffff0000u); }
__device__ __forceinline__ float gelu_fast(float x) { return x * __builtin_amdgcn_rcpf(1.0f + __builtin_amdgcn_exp2f(-2.302208198f * x * (1.0f + 0.044715f * x * x))); }
__device__ __forceinline__ unsigned idw(const v4u& a, const v4u& b, int g) { const unsigned w = g < 8 ? a[(g & 7) >> 1] : b[(g & 7) >> 1]; return (g & 1) ? (w >> 16) : (w & 0xffffu); }
__device__ __forceinline__ float wave_max(float v) {
#pragma unroll
    for (int o = 1; o < 64; o <<= 1) v = fmaxf(v, __shfl_xor(v, o));
    return v;
}
__device__ __forceinline__ unsigned q4(float a, float b, float c, float d, float inv, int bias) {
    const int qa = (int)rintf(a * inv) + bias, qb = (int)rintf(b * inv) + bias, qc = (int)rintf(c * inv) + bias, qd = (int)rintf(d * inv) + bias;
    return (unsigned)(qa & 0xff) | ((unsigned)(qb & 0xff) << 8) | ((unsigned)(qc & 0xff) << 16) | ((unsigned)(qd & 0xff) << 24);
}
__device__ __forceinline__ void qrow_load(f32x4 (&v)[8], const float* src, size_t e, int lane) {
#pragma unroll
    for (int j = 0; j < 8; ++j) v[j] = __builtin_nontemporal_load((const GAS f32x4*)(src + e * D + j * 256 + lane * 4));
}
__device__ __forceinline__ void qrow_finish(f32x4 (&v)[8], const float* gcol, unsigned char* dst, float* scale_out, size_t e, int lane) {
    float am = 0.f;
#pragma unroll
    for (int j = 0; j < 8; ++j) {
        if (gcol) { const f32x4 g = *(const GAS f32x4*)(gcol + j * 256 + lane * 4); v[j] = v[j] * g; }
        am = fmaxf(am, fmaxf(fmaxf(fabsf(v[j].x), fabsf(v[j].y)), fmaxf(fabsf(v[j].z), fabsf(v[j].w))));
    }
    am = wave_max(am);
    const float inv = am > 0.f ? 127.0f / am : 0.f;
#pragma unroll
    for (int j = 0; j < 8; ++j)
        *(GAS unsigned*)(dst + ((size_t)(2 * j + (lane >> 5)) * 16384 + e) * 128 + (lane & 31) * 4) = q4(v[j].x, v[j].y, v[j].z, v[j].w, inv, 0);
    if (lane == 0) scale_out[e] = am * (1.0f / 127.0f);
}
__device__ __forceinline__ void qx_load(v4u (&x)[4], const bf16* H1B, size_t tok, int lane) {
#pragma unroll
    for (int j = 0; j < 4; ++j) x[j] = *(const GAS v4u*)(H1B + tok * D + j * 512 + lane * 8);
}
__device__ __forceinline__ void qx_finish(const v4u (&x)[4], unsigned char* X8, float* SX, size_t tok, int lane) {
#pragma unroll
    for (int j = 0; j < 4; ++j) {
        float f[8]; float am = 0.f;
#pragma unroll
        for (int k = 0; k < 4; ++k) { f[2 * k] = blo(x[j][k]); f[2 * k + 1] = bhi(x[j][k]); am = fmaxf(am, fmaxf(fabsf(f[2 * k]), fabsf(f[2 * k + 1]))); }
        am = fmaxf(am, __shfl_xor(am, 1)); am = fmaxf(am, __shfl_xor(am, 2)); am = fmaxf(am, __shfl_xor(am, 4)); am = fmaxf(am, __shfl_xor(am, 8));
        const float inv = am > 0.f ? 127.0f / am : 0.f;
        typedef unsigned u32x2v __attribute__((ext_vector_type(2)));
        u32x2v o; o.x = q4(f[0], f[1], f[2], f[3], inv, 0); o.y = q4(f[4], f[5], f[6], f[7], inv, 0);
        *(GAS u32x2v*)(X8 + tok * D + j * 512 + lane * 8) = o;
        if ((lane & 15) == 0) SX[tok * 16 + 4 * j + (lane >> 4)] = am * (1.0f / 127.0f);
    }
}

typedef int i32x16 __attribute__((ext_vector_type(16)));
typedef float f32x16v __attribute__((ext_vector_type(16)));
__device__ __forceinline__ int seli(int m, int a, int b) { return (a & m) | (b & ~m); }
__device__ __forceinline__ float self(int m, float a, float b) { return __builtin_bit_cast(float, seli(m, __builtin_bit_cast(int, a), __builtin_bit_cast(int, b))); }
__device__ __forceinline__ void usweep(const unsigned char* X8, const float* SX, const unsigned char* U8, const unsigned short* IDS, bf16* PART, int slot, int rank, int nrank, int wave, int lane) {
    const int ps = lane >> 3, ch = lane & 7;
    const int first = rank * 8 + wave, stride = nrank * 8;
    const int n = first < MREAL ? (MREAL - first + stride - 1) / stride : 0, NQ = 2 * n;
    if (NQ == 0) return;
    const int m4 = -((lane >> 2) & 1), m2 = -((lane >> 1) & 1), m1 = -(lane & 1);
#define U_LOAD(q_, I0, I1, XV, SX_, T_, SG_) do { const int qq_ = (q_) < NQ ? (q_) : NQ - 1; const int rd_ = qq_ >= n ? 1 : 0; T_ = first + (qq_ - rd_ * n) * stride; SG_ = rd_ * 8 + slot; \
        I0 = *(const GAS v4u*)(IDS + (size_t)T_ * 128 + ps * 16); I1 = *(const GAS v4u*)(IDS + (size_t)T_ * 128 + ps * 16 + 8); \
        XV = *(const GAS v4u*)(X8 + (size_t)T_ * D + SG_ * 128 + ch * 16); SX_ = SX[(size_t)T_ * 16 + SG_]; } while (0)
#define U_ISSUE(BUF, I0, I1, SG_) do { const unsigned char* tab_ = U8 + (size_t)(SG_) * 16384 * 128 + ch * 16; \
        _Pragma("unroll") for (int g = 0; g < 16; ++g) BUF[g] = *(const GAS v4u*)(tab_ + (size_t)idw(I0, I1, g) * 128); } while (0)
#define U_FINISH(BUF, XV, SX_, T_, SG_) do { i32x16 d; \
        _Pragma("unroll") for (int g = 0; g < 16; ++g) { int a_ = __builtin_amdgcn_sdot4((int)BUF[g][0], (int)XV[0], 0, false); a_ = __builtin_amdgcn_sdot4((int)BUF[g][1], (int)XV[1], a_, false); \
            a_ = __builtin_amdgcn_sdot4((int)BUF[g][2], (int)XV[2], a_, false); a_ = __builtin_amdgcn_sdot4((int)BUF[g][3], (int)XV[3], a_, false); d[g] = a_; } \
        int r8[8], r4[4], r2[2]; \
        _Pragma("unroll") for (int k = 0; k < 8; ++k) r8[k] = seli(m4, d[8 + k], d[k]) + __shfl_xor(seli(m4, d[k], d[8 + k]), 4); \
        _Pragma("unroll") for (int k = 0; k < 4; ++k) r4[k] = seli(m2, r8[4 + k], r8[k]) + __shfl_xor(seli(m2, r8[k], r8[4 + k]), 2); \
        _Pragma("unroll") for (int k = 0; k < 2; ++k) r2[k] = seli(m1, r4[2 + k], r4[k]) + __shfl_xor(seli(m1, r4[k], r4[2 + k]), 1); \
        *(GAS unsigned*)(PART + ((size_t)(SG_) * MREAL + T_) * 128 + ps * 16 + 2 * ch) = pk2((float)r2[0] * SX_, (float)r2[1] * SX_); } while (0)
    v4u bufA[16], bufB[16];
    v4u a0, a1, ax, b0, b1, bx, c0, c1, cx; float as, bs, cs; int at, bt, ct, ag, bg, cg;
    U_LOAD(0, a0, a1, ax, as, at, ag); U_LOAD(1, b0, b1, bx, bs, bt, bg);
    U_ISSUE(bufA, a0, a1, ag);
    for (int q = 0; q < NQ; q += 2) {
        U_ISSUE(bufB, b0, b1, bg);
        U_LOAD(q + 2, c0, c1, cx, cs, ct, cg);
        U_FINISH(bufA, ax, as, at, ag);
        U_ISSUE(bufA, c0, c1, cg);
        U_LOAD(q + 3, a0, a1, ax, as, at, ag);
        U_FINISH(bufB, bx, bs, bt, bg);
        { const v4u t0 = a0, t1 = a1, tx = ax; const float ts = as; const int tt = at, tg = ag;
          a0 = c0; a1 = c1; ax = cx; as = cs; at = ct; ag = cg; b0 = t0; b1 = t1; bx = tx; bs = ts; bt = tt; bg = tg; }
    }
#undef U_LOAD
#undef U_ISSUE
#undef U_FINISH
}
__device__ __forceinline__ void wreduce(const bf16* PART, const float* GW, const float* RSTD2, const unsigned short* IDS, const float* SCU, const float* SCV, unsigned char* W8, float* WS8, size_t gt, size_t NT) {
    for (size_t i8 = gt; i8 < (size_t)MREAL * 128 / 8; i8 += NT) {
        float s[8];
#pragma unroll
        for (int k = 0; k < 8; ++k) s[k] = 0.f;
#pragma unroll 8
        for (int sg = 0; sg < 16; ++sg) {
            const v4u p = *(const GAS v4u*)(PART + (size_t)sg * MREAL * 128 + i8 * 8);
#pragma unroll
            for (int k = 0; k < 4; ++k) { s[2 * k] += blo(p[k]); s[2 * k + 1] += bhi(p[k]); }
        }
        const float rs = RSTD2[i8 >> 4];
        const v4u idv = *(const GAS v4u*)(IDS + i8 * 8);
        const f32x4 g0 = *(const GAS f32x4*)(GW + i8 * 8), g1 = *(const GAS f32x4*)(GW + i8 * 8 + 4);
        float w[8]; float am = 0.f;
#pragma unroll
        for (int k = 0; k < 8; ++k) {
            const unsigned e = (k & 1) ? (idv[k >> 1] >> 16) : (idv[k >> 1] & 0xffffu);
            const float g = k < 4 ? g0[k & 3] : g1[k & 3];
            w[k] = g * gelu_fast(rs * SCU[e] * s[k]) * SCV[e]; am = fmaxf(am, fabsf(w[k]));
        }
        am = fmaxf(am, __shfl_xor(am, 1));
        const float inv = am > 0.f ? 127.0f / am : 0.f;
        typedef unsigned u32x2v __attribute__((ext_vector_type(2)));
        u32x2v o; o.x = q4(w[0], w[1], w[2], w[3], inv, 0); o.y = q4(w[4], w[5], w[6], w[7], inv, 0);
        *(GAS u32x2v*)(W8 + i8 * 8) = o;
        if ((i8 & 1) == 0) WS8[i8 >> 1] = am * (1.0f / 127.0f);
    }
}
__device__ __forceinline__ void vsweep(const bf16* H1B, const unsigned char* V8, const unsigned short* IDS, const unsigned char* W8, const float* WS8, bf16* Z, float* SSF, int slot, int rank, int nrank, int wave, int lane) {
    const int ps = lane >> 3, ch = lane & 7;
    const int first = rank * 8 + wave, stride = nrank * 8;
    const int n = first < MREAL ? (MREAL - first + stride - 1) / stride : 0, NQ = 2 * n;
    if (NQ == 0) return;
    const int m32 = -((lane >> 5) & 1), m16 = -((lane >> 4) & 1), m8 = -((lane >> 3) & 1);
#define V_LOAD(q_, I0, I1, T_, SG_) do { const int qq_ = (q_) < NQ ? (q_) : NQ - 1; const int rd_ = qq_ >= n ? 1 : 0; T_ = first + (qq_ - rd_ * n) * stride; SG_ = rd_ * 8 + slot; \
        I0 = *(const GAS v4u*)(IDS + (size_t)T_ * 128 + ps * 16); I1 = *(const GAS v4u*)(IDS + (size_t)T_ * 128 + ps * 16 + 8); } while (0)
#define V_ISSUE(BUF, WQ, WSC, I0, I1, T_, SG_) do { const unsigned char* tab_ = V8 + (size_t)(SG_) * 16384 * 128 + ch * 16; \
        _Pragma("unroll") for (int g = 0; g < 16; ++g) BUF[g] = *(const GAS v4u*)(tab_ + (size_t)idw(I0, I1, g) * 128); \
        WQ = *(const GAS v4u*)(W8 + (size_t)T_ * 128 + ps * 16); WSC = WS8[(size_t)T_ * 8 + ps]; } while (0)
#define V_FINISH(BUF, WQ, WSC, T_, SG_) do { i32x16 acc = {0, 0, 0, 0, 0, 0, 0, 0, 0, 0, 0, 0, 0, 0, 0, 0}; \
        const unsigned hx_ = *(const GAS unsigned*)(H1B + (size_t)T_ * D + (SG_) * 128 + ch * 16 + 2 * ps); \
        _Pragma("unroll") for (int j = 0; j < 4; ++j) { const int wq_ = (int)WQ[j]; \
            _Pragma("unroll") for (int k = 0; k < 4; ++k) { \
                const unsigned d0_ = BUF[4 * j][k], d1_ = BUF[4 * j + 1][k], d2_ = BUF[4 * j + 2][k], d3_ = BUF[4 * j + 3][k]; \
                const unsigned p0_ = __builtin_amdgcn_perm(d1_, d0_, 0x05010400u), p1_ = __builtin_amdgcn_perm(d1_, d0_, 0x07030602u); \
                const unsigned q0_ = __builtin_amdgcn_perm(d3_, d2_, 0x05010400u), q1_ = __builtin_amdgcn_perm(d3_, d2_, 0x07030602u); \
                acc[4 * k + 0] = __builtin_amdgcn_sdot4((int)__builtin_amdgcn_perm(q0_, p0_, 0x05040100u), wq_, acc[4 * k + 0], false); \
                acc[4 * k + 1] = __builtin_amdgcn_sdot4((int)__builtin_amdgcn_perm(q0_, p0_, 0x07060302u), wq_, acc[4 * k + 1], false); \
                acc[4 * k + 2] = __builtin_amdgcn_sdot4((int)__builtin_amdgcn_perm(q1_, p1_, 0x05040100u), wq_, acc[4 * k + 2], false); \
                acc[4 * k + 3] = __builtin_amdgcn_sdot4((int)__builtin_amdgcn_perm(q1_, p1_, 0x07060302u), wq_, acc[4 * k + 3], false); } } \
        float fa[16]; \
        _Pragma("unroll") for (int k = 0; k < 16; ++k) fa[k] = (float)acc[k] * WSC; \
        float r8[8], r4[4], r2[2]; \
        _Pragma("unroll") for (int k = 0; k < 8; ++k) r8[k] = self(m32, fa[8 + k], fa[k]) + __shfl_xor(self(m32, fa[k], fa[8 + k]), 32); \
        _Pragma("unroll") for (int k = 0; k < 4; ++k) r4[k] = self(m16, r8[4 + k], r8[k]) + __shfl_xor(self(m16, r8[k], r8[4 + k]), 16); \
        _Pragma("unroll") for (int k = 0; k < 2; ++k) r2[k] = self(m8, r4[2 + k], r4[k]) + __shfl_xor(self(m8, r4[k], r4[2 + k]), 8); \
        const float z0_ = r2[0] + blo(hx_), z1_ = r2[1] + bhi(hx_); \
        *(GAS unsigned*)(Z + (size_t)T_ * D + (SG_) * 128 + ch * 16 + 2 * ps) = pk2(z0_, z1_); \
        float ss_ = z0_ * z0_ + z1_ * z1_; \
        _Pragma("unroll") for (int o = 1; o < 64; o <<= 1) ss_ += __shfl_xor(ss_, o); \
        if (lane == 0) SSF[(size_t)T_ * 16 + (SG_)] = ss_; } while (0)
    v4u bufA[16], bufB[16]; v4u wA, wB; float sA, sB;
    v4u a0, a1, b0, b1, c0, c1; int at, bt, ct, ag, bg, cg;
    V_LOAD(0, a0, a1, at, ag); V_LOAD(1, b0, b1, bt, bg);
    V_ISSUE(bufA, wA, sA, a0, a1, at, ag);
    for (int q = 0; q < NQ; q += 2) {
        V_ISSUE(bufB, wB, sB, b0, b1, bt, bg);
        V_LOAD(q + 2, c0, c1, ct, cg);
        V_FINISH(bufA, wA, sA, at, ag);
        V_ISSUE(bufA, wA, sA, c0, c1, ct, cg);
        V_LOAD(q + 3, a0, a1, at, ag);
        V_FINISH(bufB, wB, sB, bt, bg);
        { const v4u t0 = a0, t1 = a1; const int tt = at, tg = ag; a0 = c0; a1 = c1; at = ct; ag = cg; b0 = t0; b1 = t1; bt = tt; bg = tg; }
    }
#undef V_LOAD
#undef V_ISSUE
#undef V_FINISH
}
__device__ __forceinline__ void final_row(const bf16* Z, const float* SSF, const float* fg, float* out, size_t tok, int lane) {
    v4u z[4];
#pragma unroll
    for (int j = 0; j < 4; ++j) z[j] = *(const GAS v4u*)(Z + tok * D + j * 512 + lane * 8);
    float ss = 0.f;
#pragma unroll
    for (int k = 0; k < 4; ++k) { const f32x4 v = *(const GAS f32x4*)(SSF + tok * 16 + 4 * k); ss += (v.x + v.y) + (v.z + v.w); }
    const float rf = 1.0f / sqrtf(ss * (1.0f / D) + EPS);
#pragma unroll
    for (int j = 0; j < 4; ++j) {
        const f32x4 ga = *(const GAS f32x4*)(fg + j * 512 + lane * 8), gb = *(const GAS f32x4*)(fg + j * 512 + lane * 8 + 4);
        *(GAS f32x4*)(out + tok * D + j * 512 + lane * 8) = (f32x4){blo(z[j][0]) * rf * ga.x, bhi(z[j][0]) * rf * ga.y, blo(z[j][1]) * rf * ga.z, bhi(z[j][1]) * rf * ga.w};
        *(GAS f32x4*)(out + tok * D + j * 512 + lane * 8 + 4) = (f32x4){blo(z[j][2]) * rf * gb.x, bhi(z[j][2]) * rf * gb.y, blo(z[j][3]) * rf * gb.z, bhi(z[j][3]) * rf * gb.w};
    }
}
}

struct Frame {
    LAS unsigned char* lds;
    volatile LAS unsigned* MISC;
    gu32* ctl;
    int tid, lane, wave, vcu, G;
};
__device__ __forceinline__ float wave_sum(float v) {
#pragma unroll
    for (int o = 1; o < 64; o <<= 1) v += __shfl_xor(v, o);
    return v;
}
__device__ __forceinline__ void p0_transpose_item(const float* W, int K, int N, bf16* WT, const float* g0, const float* g1, int ksplit, LAS float* scr, int item, int lane) {
    const int nblk = N / 32, kb = item / nblk, nb = item % nblk, k0 = 64 * kb, n0 = 32 * nb;
#pragma unroll 16
    for (int i = 0; i < 32; ++i) { const int kk = 2 * i + (lane >> 5); const int kg = k0 + kk; const float gv = kg < ksplit ? g0[kg] : g1[kg - ksplit];
        scr[kk * 33 + (lane & 31)] = W[(size_t)kg * N + n0 + (lane & 31)] * gv; }
    LDS_WAIT(); asm volatile("" ::: "memory");
    const int c = lane & 7;
#pragma unroll
    for (int j = 0; j < 4; ++j) { const int n = (lane >> 3) + 8 * j; const LAS float* s = scr + (8 * c) * 33 + n;
        v4u o; o.x = pk2(s[0 * 33], s[1 * 33]); o.y = pk2(s[2 * 33], s[3 * 33]); o.z = pk2(s[4 * 33], s[5 * 33]); o.w = pk2(s[6 * 33], s[7 * 33]);
        *(GAS v4u*)(WT + (size_t)(n0 + n) * K + k0 + 8 * c) = o; }
    LDS_WAIT(); asm volatile("" ::: "memory");
}
__device__ __forceinline__ void p0_row_load(f32x4 (&v)[8], const float* xrow, int lane) {
    const GAS f32x4* xr = (const GAS f32x4*)xrow + lane;
#pragma unroll
    for (int j = 0; j < 8; ++j) v[j] = __builtin_nontemporal_load(xr + 64 * j);
}
__device__ __forceinline__ void p0_row_finish(const f32x4 (&v)[8], bf16* orow, float* rstd_out, int lane) {
    float s = 0.f;
#pragma unroll
    for (int j = 0; j < 8; ++j) s += (v[j].x * v[j].x + v[j].y * v[j].y) + (v[j].z * v[j].z + v[j].w * v[j].w);
    s = wave_sum(s);
    GAS unsigned long long* o8 = (GAS unsigned long long*)orow + lane;
#pragma unroll
    for (int j = 0; j < 8; ++j) o8[64 * j] = (unsigned long long)pk2(v[j].x, v[j].y) | ((unsigned long long)pk2(v[j].z, v[j].w) << 32);
    if (lane == 0) *rstd_out = 1.0f / sqrtf(s * (1.0f / D) + EPS);
}
__device__ __forceinline__ void p0_cvt8_sliced(const float* src, bf16* dst, const float* gcol, size_t idx8) {
    const f32x4 a = *(const GAS f32x4*)(src + idx8 * 8), b = *(const GAS f32x4*)(src + idx8 * 8 + 4);
    f32x4 ga = {1.f, 1.f, 1.f, 1.f}, gb = {1.f, 1.f, 1.f, 1.f};
    const int c = (int)((idx8 * 8) & (D - 1)); const size_t e = (idx8 * 8) >> 11;
    if (gcol) { ga = *(const GAS f32x4*)(gcol + c); gb = *(const GAS f32x4*)(gcol + c + 4); }
    v4u o; o.x = pk2(a.x * ga.x, a.y * ga.y); o.y = pk2(a.z * ga.z, a.w * ga.w); o.z = pk2(b.x * gb.x, b.y * gb.y); o.w = pk2(b.z * gb.z, b.w * gb.w);
    *(GAS v4u*)(dst + ((size_t)(c >> 6) * 16384 + e) * 64 + (c & 63)) = o;
}
__device__ __forceinline__ void p0_cvt8(const float* src, bf16* dst, const float* gcol, size_t idx8) {
    const f32x4 a = *(const GAS f32x4*)(src + idx8 * 8), b = *(const GAS f32x4*)(src + idx8 * 8 + 4);
    f32x4 ga = {1.f, 1.f, 1.f, 1.f}, gb = {1.f, 1.f, 1.f, 1.f};
    if (gcol) { const int c = (int)((idx8 * 8) & (D - 1)); ga = *(const GAS f32x4*)(gcol + c); gb = *(const GAS f32x4*)(gcol + c + 4); }
    v4u o; o.x = pk2(a.x * ga.x, a.y * ga.y); o.y = pk2(a.z * ga.z, a.w * ga.w); o.z = pk2(b.x * gb.x, b.y * gb.y); o.w = pk2(b.z * gb.z, b.w * gb.w);
    *(GAS v4u*)(dst + idx8 * 8) = o;
}

struct Args { const float* in[22]; float* out; unsigned char* ws; int ph_lo, ph_hi, rep_mask, pad; };

__global__ void __launch_bounds__(NWAVES * 64, 2) fwd(Args args) {
    extern __shared__ __attribute__((aligned(16))) unsigned char lds[];
    Frame F;
    F.lds = (LAS unsigned char*)lds;
    F.MISC = (volatile LAS unsigned*)(F.lds + MISC_OFF);
    F.tid = threadIdx.x; F.lane = F.tid & 63; F.wave = __builtin_amdgcn_readfirstlane(F.tid >> 6);
    F.G = gridDim.x; { const int bx = blockIdx.x; F.vcu = (F.G % 8 == 0) ? (bx % 8) * (F.G / 8) + bx / 8 : bx; }
    unsigned char* ws = args.ws;
    F.ctl = (gu32*)(ws + WS_CTL);
    for (int u = F.tid; u < (LDS_BYTES - LDSCTL_OFF) / 4; u += NWAVES * 64) ((LAS unsigned*)(F.lds + LDSCTL_OFF))[u] = 0u;
    __syncthreads();
    XcdBarrier bar = xcd_barrier_post((unsigned*)(F.ctl + CW_BAR), F.MISC + 8);
    const int lo = args.ph_lo, hi = args.ph_hi;
#define IN(k) (lo <= (k) && (k) < hi)
#define BOTH(k) (IN(k) && IN((k) + 1))
#ifndef PROBE_PH
#define PROBE_PH (-1)
#endif
#define REP(k) for (int rep_ = 0; rep_ < ((k) == PROBE_PH ? 2 : 1); ++rep_)

    const float* x = args.in[0]; const float* meta = args.in[1]; const float* norm_mix_g = args.in[2]; const float* w_in = args.in[3]; const float* b_in = args.in[4];
    const float* gn_attn_g = args.in[13]; const float* gn_lru_g = args.in[14]; const float* w_out = args.in[15]; const float* norm_ffn_g = args.in[16];
    const float* peer_wq = args.in[17]; const float* sub_keys = args.in[18]; const float* peer_u = args.in[19]; const float* peer_v = args.in[20];
    bf16* W1T = (bf16*)(ws + WS_W1T); bf16* W2T = (bf16*)(ws + WS_W2T); bf16* W3T = (bf16*)(ws + WS_W3T); bf16* SKB = (bf16*)(ws + WS_SKB);
    float* RSTD1 = (float*)(ws + WS_RSTD1);
    unsigned char* U8 = ws + WS_U8; unsigned char* V8 = ws + WS_V8; unsigned char* X8 = ws + WS_X8; float* SX = (float*)(ws + WS_SX); float* SCU = (float*)(ws + WS_SCU); float* SCV = (float*)(ws + WS_SCV);
    bf16* A1 = (bf16*)(ws + WS_A1);
    bf16* QB = (bf16*)(ws + WS_Q); bf16* KVB = (bf16*)(ws + WS_KV); bf16* XBB = (bf16*)(ws + WS_XB); bf16* GTB = (bf16*)(ws + WS_GT);

    if (IN(0)) { REP(0) {
        LAS float* scr = (LAS float*)(F.lds + RING_OFF + F.wave * 16384);
        const int gw = F.vcu * NWAVES + F.wave, NGW = F.G * NWAVES;
        constexpr int I_1 = (D / 64) * (IND / 32), I_2 = (D / 64) * (D / 32), I_3 = I_2;
        for (int it = gw; it < I_1 + I_2 + I_3; it += NGW) {
            int r = it;
            if (r < I_1) { p0_transpose_item(w_in, D, IND, W1T, norm_mix_g, norm_mix_g, D, scr, r, F.lane); continue; } r -= I_1;
            if (r < I_2) { p0_transpose_item(w_out, D, D, W2T, gn_attn_g, gn_lru_g, 1024, scr, r, F.lane); continue; } r -= I_2;
            p0_transpose_item(peer_wq, D, D, W3T, norm_ffn_g, norm_ffn_g, D, scr, r, F.lane);
        }
        {
            f32x4 cur[8], nxt[8];
            if (gw < MREAL + NMETA) p0_row_load(cur, gw < MREAL ? x + (size_t)gw * D : meta + (size_t)(gw - MREAL) * D, F.lane);
            for (int m = gw; m < MREAL + NMETA; m += NGW) {
                const int mn = m + NGW;
                if (mn < MREAL + NMETA) p0_row_load(nxt, mn < MREAL ? x + (size_t)mn * D : meta + (size_t)(mn - MREAL) * D, F.lane);
                p0_row_finish(cur, A1 + (size_t)m * D, RSTD1 + m, F.lane);
#pragma unroll
                for (int j = 0; j < 8; ++j) cur[j] = nxt[j];
            }
        }
        {
            const size_t gt = (size_t)gw * 64 + F.lane, NT = (size_t)NGW * 64;
            for (size_t i = gt; i < (size_t)(8 * 2 * 128 * 128) / 8; i += NT) p0_cvt8(sub_keys, SKB, nullptr, i);
            {
                f32x4 cur[8], nxt[8];
                constexpr int QV0 = 6144;
                if (QV0 + gw < 16384) p6::qrow_load(cur, peer_v, (size_t)(QV0 + gw), F.lane);
                for (int rj = QV0 + gw; rj < 16384; rj += NGW) {
                    const int rn = rj + NGW;
                    if (rn < 16384) p6::qrow_load(nxt, peer_v, (size_t)rn, F.lane);
                    p6::qrow_finish(cur, nullptr, V8, SCV, (size_t)rj, F.lane);
#pragma unroll
                    for (int j = 0; j < 8; ++j) cur[j] = nxt[j];
                }
            }
        } }
        if (BOTH(0)) xcd_barrier(bar);
    }
    if (IN(1)) {
        pg8::Gemm g{A1, W1T, MPAD, IND, D};
        pg8::Order1 S{F.G, (int)blockIdx.x};
        pg8::Epi1 E{QB, KVB, XBB, GTB, RSTD1, b_in};
        REP(1) pg8::gemm_phase<pg8::Epi1, pg8::Order1, true, true>(F.lds + RING_OFF, g, S, E);
        {
            volatile LAS int* qb = (volatile LAS int*)(F.lds + LDSCTL_OFF + 512);
            for (;;) {
                __syncthreads();
                if (F.tid == 0) qb[0] = (int)__hip_atomic_fetch_add((unsigned*)(F.ctl + CW_QROW), 32u, __ATOMIC_RELAXED, __HIP_MEMORY_SCOPE_AGENT);
                __syncthreads();
                const int base = qb[0];
                if (base >= 16384 + 6144) break;
                f32x4 r0[8], r1[8], r2[8], r3[8];
                const bool isu = base < 16384;
                const float* src = isu ? peer_u : peer_v; const float* gc = isu ? norm_ffn_g : nullptr; unsigned char* dst = isu ? U8 : V8; float* sc = isu ? SCU : SCV;
                const size_t e0 = (size_t)(isu ? base : base - 16384) + F.wave * 4;
                p6::qrow_load(r0, src, e0, F.lane); p6::qrow_load(r1, src, e0 + 1, F.lane); p6::qrow_load(r2, src, e0 + 2, F.lane); p6::qrow_load(r3, src, e0 + 3, F.lane);
                p6::qrow_finish(r0, gc, dst, sc, e0, F.lane); p6::qrow_finish(r1, gc, dst, sc, e0 + 1, F.lane);
                p6::qrow_finish(r2, gc, dst, sc, e0 + 2, F.lane); p6::qrow_finish(r3, gc, dst, sc, e0 + 3, F.lane);
            }
        }
        if (BOTH(1)) xcd_barrier(bar);
    }
    if (IN(2)) {
        bf16* MIX = (bf16*)(ws + WS_A1); float* SSA = (float*)(ws + WS_SSA); float* SSL = (float*)(ws + WS_SSL);
        const p2::LruP LP{args.in[6], args.in[7], args.in[8], args.in[9], args.in[10], args.in[11], args.in[12]};
        {
        REP(20) for (int u = (int)blockIdx.x; u < 256; u += F.G) p2::lru_unit(F.lds + RING_OFF, F.lds + LDSCTL_OFF + 5120, u >> 5, (u >> 1) & 15, u & 1, XBB, GTB, LP, MIX, SSL, F.tid);
        REP(21) for (int a = (int)blockIdx.x; a < 256; a += F.G) p2::attn_unit(F.lds + RING_OFF, a >> 5, (a >> 1) & 15, a & 1, QB, KVB, args.in[5], MIX, SSA, F.tid);
        }
        if (BOTH(2)) xcd_barrier(bar);
    }
    if (IN(3)) {
        bf16* MIX = (bf16*)(ws + WS_A1); const float* SSA = (const float*)(ws + WS_SSA); const float* SSL = (const float*)(ws + WS_SSL);
        bf16* H1B = (bf16*)(ws + WS_H1); float* SS2 = (float*)(ws + WS_SS2);
        pg8::Order2 S{F.G, (int)blockIdx.x};
        LAS float* tbl = (LAS float*)(F.lds + LDSCTL_OFF + 1024);
        pg8::Unit u0{0, 0};
        for (int i = 0; i < 2; ++i) {
            pg8::Unit u; if (!S.next(i, u)) break; if (i == 0) u0 = u;
            if (F.tid < 256) {
                const size_t row = (size_t)u.pm * 256 + F.tid; float sa = 0.f, sl = 0.f;
#pragma unroll
                for (int k = 0; k < 4; ++k) { const f32x4 v = *(const GAS f32x4*)(SSA + row * 16 + 4 * k); sa += (v.x + v.y) + (v.z + v.w); }
#pragma unroll
                for (int k = 0; k < 8; ++k) { const f32x4 v = *(const GAS f32x4*)(SSL + row * 32 + 4 * k); sl += (v.x + v.y) + (v.z + v.w); }
                const float ra = 1.0f / sqrtf(sa * (1.0f / 1024) + EPS), rl = 1.0f / sqrtf(sl * (1.0f / 1024) + EPS);
                tbl[(i * 256 + F.tid) * 2] = ra / rl; tbl[(i * 256 + F.tid) * 2 + 1] = rl;
            }
        }
        __syncthreads();
        pg8::Gemm g{MIX, W2T, MREAL, D, D};
        pg8::Epi2 E{H1B, x, SS2, (const LAS float*)tbl, u0.pm};
        REP(3) pg8::gemm_phase<pg8::Epi2, pg8::Order2, true, true>(F.lds + RING_OFF, g, S, E);
        if (BOTH(3)) xcd_barrier(bar);
    }
    if (IN(4)) {
        bf16* H1B = (bf16*)(ws + WS_H1); bf16* QPB = (bf16*)(ws + WS_A1);
        pg8::Order2 S{F.G, (int)blockIdx.x};
        {
            const float* SS2 = (const float*)(ws + WS_SS2); float* RSTD2 = (float*)(ws + WS_RSTD2);
            pg8::Unit u; if (S.next(0, u) && F.tid < 256) {
                const size_t row = (size_t)u.pm * 256 + F.tid; float ssq = 0.f;
#pragma unroll
                for (int k = 0; k < 8; ++k) { const f32x4 v = *(const GAS f32x4*)(SS2 + row * 32 + 4 * k); ssq += (v.x + v.y) + (v.z + v.w); }
                RSTD2[row] = 1.0f / sqrtf(ssq * (1.0f / D) + EPS);
            }
        }
        pg8::Gemm g{H1B, W3T, MREAL, D, D};
        pg8::Epi3 E{QPB};
        REP(4) pg8::gemm_phase<pg8::Epi3, pg8::Order2, true, true>(F.lds + RING_OFF, g, S, E);
        if (BOTH(4)) xcd_barrier(bar);
    }
    if (IN(5)) {
        const bf16* QPB = (const bf16*)(ws + WS_A1);
        unsigned short* IDS = (unsigned short*)(ws + WS_IDS); float* GW = (float*)(ws + WS_GW); float* RSTD2 = (float*)(ws + WS_RSTD2);
        const bf16* H1B = (const bf16*)(ws + WS_H1);
        REP(5) for (int u = (int)blockIdx.x; u < 512; u += F.G) {
            v4u xq[4][4]; const size_t tb = (size_t)(u >> 3) * 256 + F.wave * 32 + (u & 7);
#pragma unroll
            for (int k = 0; k < 4; ++k) p6::qx_load(xq[k], H1B, tb + 8 * k, F.lane);
            p5::retr_unit(F.lds + RING_OFF, u & 7, u >> 3, QPB, SKB, IDS, GW, RSTD2, F.tid);
#pragma unroll
            for (int k = 0; k < 4; ++k) p6::qx_finish(xq[k], X8, SX, tb + 8 * k, F.lane);
        }
        if (BOTH(5)) xcd_barrier(bar);
    }
    {
        const bf16* H1B = (const bf16*)(ws + WS_H1); const unsigned short* IDS = (const unsigned short*)(ws + WS_IDS); const float* GW = (const float*)(ws + WS_GW);
        const float* RSTD2 = (const float*)(ws + WS_RSTD2); bf16* PART = (bf16*)(ws + WS_PART); unsigned char* W8 = ws + WS_W; float* WS8 = (float*)(ws + WS_WSUM); bf16* ZB = (bf16*)(ws + WS_Z); float* SSF = (float*)(ws + WS_SSL);
        const int slot = (int)blockIdx.x & 7, rank = (int)blockIdx.x >> 3, nrank = (F.G - slot + 7) >> 3;
        const int gw = F.vcu * NWAVES + F.wave, NGW = F.G * NWAVES;
        if (IN(6)) { REP(6) p6::usweep(X8, SX, U8, IDS, PART, slot, rank, nrank, F.wave, F.lane); if (BOTH(6)) xcd_barrier(bar); }
        if (IN(7)) { REP(7) p6::wreduce(PART, GW, RSTD2, IDS, SCU, SCV, W8, WS8, (size_t)gw * 64 + F.lane, (size_t)NGW * 64); if (BOTH(7)) xcd_barrier(bar); }
        if (IN(8)) { REP(8) p6::vsweep(H1B, V8, IDS, W8, WS8, ZB, SSF, slot, rank, nrank, F.wave, F.lane); if (BOTH(8)) xcd_barrier(bar); }
        if (PROBE_PH == 30) { for (int k = 0; k < 16; ++k) xcd_barrier(bar); }
        if (IN(9)) { REP(9) for (int t = gw; t < MREAL; t += NGW) p6::final_row(ZB, SSF, args.in[21], args.out, (size_t)t, F.lane); }
    }
#undef IN
#undef BOTH
}

extern "C" void kernel_launch(void* const* d_in, const int* in_sizes, int n_in, void* d_out, int out_size, void* d_ws, size_t ws_size, hipStream_t stream) {
    static int grid = 0;
    if (grid == 0) {
        int dev = 0, cus = 0;
        if (hipGetDevice(&dev) != hipSuccess || hipDeviceGetAttribute(&cus, hipDeviceAttributeMultiprocessorCount, dev) != hipSuccess) { fprintf(stderr, "kernel_launch: device query failed\n"); grid = -1; return; }
        if (hipFuncSetAttribute((const void*)fwd, hipFuncAttributeMaxDynamicSharedMemorySize, LDS_BYTES) != hipSuccess) { fprintf(stderr, "kernel_launch: hipFuncSetAttribute failed\n"); grid = -1; return; }
        int per_cu = 0;
        if (hipOccupancyMaxActiveBlocksPerMultiprocessor(&per_cu, (const void*)fwd, NWAVES * 64, LDS_BYTES) != hipSuccess || per_cu < 1) fprintf(stderr, "kernel_launch: occupancy query says %d\n", per_cu);
        (void)hipGetLastError();
        grid = cus;
        if (ws_size < WS_END) { fprintf(stderr, "kernel_launch: ws too small %zu\n", ws_size); grid = -1; return; }
    }
    if (grid < 0) return;
    (void)hipMemsetAsync((char*)d_ws + WS_CTL, 0, CTL_ZERO_BYTES, stream);
    Args a{};
    for (int i = 0; i < 22; ++i) a.in[i] = (const float*)d_in[i];
    a.out = (float*)d_out; a.ws = (unsigned char*)d_ws; a.ph_lo = 0; a.ph_hi = 10;
    hipLaunchKernelGGL(fwd, dim3(grid), dim3(NWAVES * 64), LDS_BYTES, stream, a);
}
```

```cpp
#include <hip/hip_runtime.h>
#include <cstdio>
#include <cstdint>
#include <math.h>

#define D 2048
#define NB 8
#define SEQ 2048
#define NMETA 16
#define TT (SEQ + NMETA)
#define MR (NB * TT)
#define MREAL (NB * SEQ)
#define MPAD (MREAL + 256)
#define QD 1024
#define KVD 128
#define LW 1024
#define IND 3328
#define EPS 1e-6f
#define QSCALE (0.125f * 1.4426950408889634f)
#define GAS __attribute__((address_space(1)))
#define LAS __attribute__((address_space(3)))

#define DPP_I(x, ctrl) __builtin_amdgcn_update_dpp(0, (x), (ctrl), 0xf, 0xf, true)
__device__ __forceinline__ int dpp_x1(int x) { return DPP_I(x, 0xB1); }
__device__ __forceinline__ int dpp_x2(int x) { return DPP_I(x, 0x4E); }
__device__ __forceinline__ int dpp_hm(int x) { return DPP_I(x, 0x141); }
__device__ __forceinline__ int dpp_rm(int x) { return DPP_I(x, 0x140); }
__device__ __forceinline__ int dpp_r8(int x) { return DPP_I(x, 0x128); }
__device__ __forceinline__ float fdpp_x1(float x) { return __builtin_bit_cast(float, dpp_x1(__builtin_bit_cast(int, x))); }
__device__ __forceinline__ float fdpp_x2(float x) { return __builtin_bit_cast(float, dpp_x2(__builtin_bit_cast(int, x))); }
__device__ __forceinline__ float fdpp_hm(float x) { return __builtin_bit_cast(float, dpp_hm(__builtin_bit_cast(int, x))); }
__device__ __forceinline__ float fdpp_rm(float x) { return __builtin_bit_cast(float, dpp_rm(__builtin_bit_cast(int, x))); }
__device__ __forceinline__ float max16(float v) { v = fmaxf(v, fdpp_x1(v)); v = fmaxf(v, fdpp_x2(v)); v = fmaxf(v, fdpp_hm(v)); return fmaxf(v, fdpp_rm(v)); }
__device__ __forceinline__ float sum64(float v) {
    v += fdpp_x1(v); v += fdpp_x2(v); v += fdpp_hm(v); v += fdpp_rm(v);
    return (__builtin_bit_cast(float, __builtin_amdgcn_readlane(__builtin_bit_cast(int, v), 0)) + __builtin_bit_cast(float, __builtin_amdgcn_readlane(__builtin_bit_cast(int, v), 16)))
         + (__builtin_bit_cast(float, __builtin_amdgcn_readlane(__builtin_bit_cast(int, v), 32)) + __builtin_bit_cast(float, __builtin_amdgcn_readlane(__builtin_bit_cast(int, v), 48)));
}
__device__ __forceinline__ float max64(float v) {
    v = max16(v);
    return fmaxf(fmaxf(__builtin_bit_cast(float, __builtin_amdgcn_readlane(__builtin_bit_cast(int, v), 0)), __builtin_bit_cast(float, __builtin_amdgcn_readlane(__builtin_bit_cast(int, v), 16))),
                 fmaxf(__builtin_bit_cast(float, __builtin_amdgcn_readlane(__builtin_bit_cast(int, v), 32)), __builtin_bit_cast(float, __builtin_amdgcn_readlane(__builtin_bit_cast(int, v), 48))));
}
__device__ __forceinline__ float sum8(float v) { v += fdpp_x1(v); v += fdpp_x2(v); return v + fdpp_hm(v); }
__device__ __forceinline__ float sum4(float v) { v += fdpp_x1(v); return v + fdpp_x2(v); }
__device__ __forceinline__ float sum_x32(float v) { return v + __shfl_xor(v, 32); }
__device__ __forceinline__ float max_x32(float v) { return fmaxf(v, __shfl_xor(v, 32)); }
__device__ __forceinline__ float sum_x16(float v) { return v + __shfl_xor(v, 16); }
namespace pg8 {
#define PG8_LAS __attribute__((address_space(3)))
typedef unsigned short bf16_t;
typedef short bf16x8 __attribute__((ext_vector_type(8)));
typedef float f32x4 __attribute__((ext_vector_type(4)));
typedef unsigned u32x4 __attribute__((ext_vector_type(4)));
constexpr int BM = 256, BK = 64, HALF = 128, HTB = HALF * BK * 2  , STAGE_BYTES = 8 * HTB, NXCD = 8, WGM = 8;

__host__ __device__ __forceinline__ int lds_byte(int r, int c) { const int st = (r >> 4) * 2 + (c >> 5), rr = r & 15, cc = c & 31, ob = rr * 64 + cc * 2; return st * 1024 + (ob ^ (((ob >> 9) & 1) << 5)); }
__host__ __device__ __forceinline__ void stage_rc(int b, int& R, int& C) { const int st = b / 1024, sb = b % 1024, swz = sb ^ (((sb >> 9) & 1) << 5); R = (st >> 1) * 16 + swz / 64; C = (st & 1) * 32 + (swz % 64) / 2; }
__host__ __device__ __forceinline__ int perm32(int rho) { const int n = rho >> 4, i = rho & 15; return 8 * (i >> 2) + 4 * n + (i & 3); }

struct Unit { int pm, pn; };
struct Gemm { const bf16_t* A; const bf16_t* Bt; int M, N, K; };

struct StaticOrder {
    int nM, nN, nwg, G, c;
    __host__ __device__ void init(int M, int N, int G_, int c_) { nM = M / BM; nN = N / BM; nwg = nM * nN; G = G_; c = c_; }
    __host__ __device__ bool next(int i, Unit& u) const {
        const long L = (long)i * G + c; if (L >= nwg) return false;
        int wgid = (int)L; { const int q = nwg / NXCD, r = nwg % NXCD, xcd = wgid % NXCD, off = wgid / NXCD; wgid = (xcd < r ? xcd * (q + 1) : r * (q + 1) + (xcd - r) * q) + off; }
        const int nig = WGM * nN, gid = wgid / nig, fm = gid * WGM, gsz = (nM - fm) < WGM ? (nM - fm) : WGM;
        u.pm = fm + ((wgid % nig) % gsz); u.pn = (wgid % nig) / gsz; return true;
    }
    __device__ __forceinline__ void a_ready(const Unit&) const {}
    __device__ __forceinline__ void done(const Unit&) const {}
};

__device__ __forceinline__ unsigned cvt_pk_bf16(float lo, float hi) { unsigned r; asm volatile("v_cvt_pk_bf16_f32 %0, %1, %2" : "=v"(r) : "v"(lo), "v"(hi)); return r; }
typedef unsigned u32x2 __attribute__((ext_vector_type(2)));
struct Order1 {
    int G, c;
    __device__ __forceinline__ bool next(int i, Unit& u) const {
        const int L = i * G + c; if (L >= 837) return false;
        if (L >= 832) { u.pm = 64; u.pn = 4 + (L - 832); return true; }
        const int nwg = 832, nN = 13;
        int wgid = L; { const int q = nwg / NXCD, xcd = wgid % NXCD, off = wgid / NXCD; wgid = xcd * q + off; }
        const int nig = WGM * nN, gid = wgid / nig, fm = gid * WGM;
        u.pm = fm + ((wgid % nig) % WGM); u.pn = (wgid % nig) / WGM; return true;
    }
    __device__ __forceinline__ void a_ready(const Unit&) const {}
    __device__ __forceinline__ void done(const Unit&) const {}
};
struct Order2 {
    int G, c;
    __device__ __forceinline__ bool next(int i, Unit& u) const {
        const int L = i * G + c; if (L >= 512) return false;
        const int nwg = 512, nN = 8;
        int wgid = L; { const int q = nwg / NXCD, xcd = wgid % NXCD, off = wgid / NXCD; wgid = xcd * q + off; }
        const int nig = WGM * nN, gid = wgid / nig, fm = gid * WGM;
        u.pm = fm + ((wgid % nig) % WGM); u.pn = (wgid % nig) / WGM; return true;
    }
    __device__ __forceinline__ void a_ready(const Unit&) const {}
    __device__ __forceinline__ void done(const Unit&) const {}
};

struct Epi1 {
    static constexpr bool PERM = true, AFTER_DRAIN = false, MIDK = false;
    bf16_t *Q, *KV, *XB, *GT; const float* rstd; const float* bias;
    __device__ __forceinline__ void midk(f32x4 (&acc)[2][2][4][2], const Unit& u, int wr, int wc, int fr, int fq) const {}
    __device__ __forceinline__ void operator()(const f32x4 (&acc)[2][2][4][2], const Unit& u, int wr, int wc, int fr, int fq) const {
        const int row0 = u.pm * BM + wr * 64 + fr;
        bf16_t* base; int ldc, colb; float sc = 1.f;
        if (u.pn < 4) { base = Q; ldc = 1024; colb = u.pn * BM; sc = QSCALE; }
        else if (u.pn == 4) { base = KV; ldc = 256; colb = 0; }
        else if (u.pn < 9) { base = XB; ldc = 1024; colb = (u.pn - 5) * BM; }
        else { base = GT; ldc = 1024; colb = (u.pn - 9) * BM; }
        const int col0 = colb + wc * 32 + 8 * fq, bcol0 = u.pn * BM + wc * 32 + 8 * fq;
        f32x4 bv[2][2];
#pragma unroll
        for (int bj = 0; bj < 2; ++bj)
#pragma unroll
            for (int n = 0; n < 2; ++n) bv[bj][n] = *(const f32x4*)(bias + bcol0 + bj * HALF + 4 * n);
#pragma unroll
        for (int ai = 0; ai < 2; ++ai)
#pragma unroll
            for (int m = 0; m < 4; ++m) {
                const int row = row0 + ai * HALF + m * 16; const float rs = rstd[row];
                bf16_t* rowp = base + (size_t)row * ldc + col0;
#pragma unroll
                for (int bj = 0; bj < 2; ++bj) {
                    f32x4 v0 = (acc[ai][bj][m][0] * rs + bv[bj][0]) * sc, v1 = (acc[ai][bj][m][1] * rs + bv[bj][1]) * sc;
                    u32x4 w; w.x = cvt_pk_bf16(v0[0], v0[1]); w.y = cvt_pk_bf16(v0[2], v0[3]); w.z = cvt_pk_bf16(v1[0], v1[1]); w.w = cvt_pk_bf16(v1[2], v1[3]);
                    *(u32x4*)(rowp + bj * HALF) = w; } }
    }
};
struct Epi2 {
    static constexpr bool PERM = true, AFTER_DRAIN = false, MIDK = true;
    bf16_t* H1; const float* x; float* SS2; const LAS float* tbl; int pm0;
    __device__ __forceinline__ void midk(f32x4 (&acc)[2][2][4][2], const Unit& u, int wr, int wc, int fr, int fq) const {
        const LAS float* t = tbl + (u.pm == pm0 ? 0 : 512);
#pragma unroll
        for (int ai = 0; ai < 2; ++ai)
#pragma unroll
            for (int m = 0; m < 4; ++m) { const float ra = t[(ai * HALF + wr * 64 + m * 16 + fr) * 2];
#pragma unroll
                for (int bj = 0; bj < 2; ++bj)
#pragma unroll
                    for (int n = 0; n < 2; ++n) acc[ai][bj][m][n] = acc[ai][bj][m][n] * ra; }
    }
    __device__ __forceinline__ void operator()(const f32x4 (&acc)[2][2][4][2], const Unit& u, int wr, int wc, int fr, int fq) const {
        const LAS float* t = tbl + (u.pm == pm0 ? 0 : 512);
        const int col0 = u.pn * BM + wc * 32 + 8 * fq;
#pragma unroll
        for (int ai = 0; ai < 2; ++ai)
#pragma unroll
            for (int m = 0; m < 4; ++m) {
                const int rl = ai * HALF + wr * 64 + m * 16 + fr; const size_t row = (size_t)u.pm * BM + rl; const float rs = t[rl * 2 + 1];
                float ss = 0.f;
#pragma unroll
                for (int bj = 0; bj < 2; ++bj) {
                    const f32x4 x0 = *(const f32x4*)(x + row * 2048 + col0 + bj * HALF), x1 = *(const f32x4*)(x + row * 2048 + col0 + bj * HALF + 4);
                    const f32x4 v0 = acc[ai][bj][m][0] * rs + x0, v1 = acc[ai][bj][m][1] * rs + x1;
                    ss += (v0[0] * v0[0] + v0[1] * v0[1]) + (v0[2] * v0[2] + v0[3] * v0[3]) + (v1[0] * v1[0] + v1[1] * v1[1]) + (v1[2] * v1[2] + v1[3] * v1[3]);
                    u32x4 w; w.x = cvt_pk_bf16(v0[0], v0[1]); w.y = cvt_pk_bf16(v0[2], v0[3]); w.z = cvt_pk_bf16(v1[0], v1[1]); w.w = cvt_pk_bf16(v1[2], v1[3]);
                    *(u32x4*)(H1 + row * 2048 + col0 + bj * HALF) = w; }
                ss = sum_x32(sum_x16(ss));
                if (fq == 0) SS2[row * 32 + u.pn * 4 + wc] = ss;
            }
    }
};
struct Epi3 {
    static constexpr bool PERM = true, AFTER_DRAIN = false, MIDK = false;
    bf16_t* O;
    __device__ __forceinline__ void midk(f32x4 (&acc)[2][2][4][2], const Unit& u, int wr, int wc, int fr, int fq) const {}
    __device__ __forceinline__ void operator()(const f32x4 (&acc)[2][2][4][2], const Unit& u, int wr, int wc, int fr, int fq) const {
        const int col0 = u.pn * BM + wc * 32 + 8 * fq;
#pragma unroll
        for (int ai = 0; ai < 2; ++ai)
#pragma unroll
            for (int m = 0; m < 4; ++m) { const size_t row = (size_t)u.pm * BM + ai * HALF + wr * 64 + m * 16 + fr;
#pragma unroll
                for (int bj = 0; bj < 2; ++bj) { const f32x4 v0 = acc[ai][bj][m][0], v1 = acc[ai][bj][m][1];
                    u32x4 w; w.x = cvt_pk_bf16(v0[0], v0[1]); w.y = cvt_pk_bf16(v0[2], v0[3]); w.z = cvt_pk_bf16(v1[0], v1[1]); w.w = cvt_pk_bf16(v1[2], v1[3]);
                    *(u32x4*)(O + row * 2048 + col0 + bj * HALF) = w; } }
    }
};
template <class Epi, class Sched, bool ALIGN_EPI = false, bool SP2 = false>
__device__ __forceinline__ void gemm_phase(PG8_LAS unsigned char* lds, const Gemm g, const Sched& S, const Epi& E) {
    const int tid = threadIdx.x, wid = __builtin_amdgcn_readfirstlane(tid >> 6), lane = tid & 63, wr = wid >> 2, wc = wid & 3, fr = lane & 15, fq = lane >> 4;
    const int K = g.K, nt = K / BK;
    unsigned voffA[2], voffB[2];
#pragma unroll
    for (int i = 0; i < 2; ++i) { int R, C; stage_rc(tid * 16 + i * 8192, R, C); const int Rb = Epi::PERM ? ((R & ~31) + perm32(R & 31)) : R;
        voffA[i] = (unsigned)(R * K + C) * 2u; voffB[i] = (unsigned)(Rb * K + C) * 2u; }
    const size_t kstep = (size_t)(BK * 2);
    const size_t hstep = (size_t)HALF * K * 2;
    const size_t tstep = 2 * hstep;
    const unsigned ldsw = (unsigned)wid * 1024u;
    const int aoff = lds_byte(wr * 64 + fr, fq * 8), boff = lds_byte(wc * 32 + fr, fq * 8);
#define PG8_SA(b, h) (((b) * 2 + (h)) * HTB)
#define PG8_SB(b, h) ((4 + (b) * 2 + (h)) * HTB)
#define PG8_STAGE(bufoff, gbase, voff) do { _Pragma("unroll") for (int _i = 0; _i < 2; ++_i) \
        __builtin_amdgcn_global_load_lds((const unsigned*)((const char*)(gbase) + (voff)[_i]), (PG8_LAS unsigned*)(lds + (bufoff) + ldsw + _i * 8192), 16, 0, 0); } while (0)
#define PG8_LDA(dst, b, h) do { _Pragma("unroll") for (int m = 0; m < 4; ++m) _Pragma("unroll") for (int k = 0; k < 2; ++k) dst[m][k] = *(const PG8_LAS bf16x8*)(lds + PG8_SA(b, h) + aoff + m * 2048 + k * 1024); } while (0)
#define PG8_LDB(dst, b, h) do { _Pragma("unroll") for (int n = 0; n < 2; ++n) _Pragma("unroll") for (int k = 0; k < 2; ++k) dst[n][k] = *(const PG8_LAS bf16x8*)(lds + PG8_SB(b, h) + boff + n * 2048 + k * 1024); } while (0)
#define PG8_MMA(ai, bj, At, Bt) do { __builtin_amdgcn_s_setprio(1); _Pragma("unroll") for (int m = 0; m < 4; ++m) _Pragma("unroll") for (int n = 0; n < 2; ++n) _Pragma("unroll") for (int k = 0; k < 2; ++k) \
        acc[ai][bj][m][n] = __builtin_amdgcn_mfma_f32_16x16x32_bf16(Bt[n][k], At[m][k], acc[ai][bj][m][n], 0, 0, 0); __builtin_amdgcn_s_setprio(0); } while (0)
#define PG8_WAIT_V(n) asm volatile("s_waitcnt vmcnt(" #n ")" ::: "memory")
#define PG8_WAIT_L(n) asm volatile("s_waitcnt lgkmcnt(" #n ")" ::: "memory")
#define PG8_BAR __builtin_amdgcn_s_barrier()
#define PG8_SCHED __builtin_amdgcn_sched_barrier(0)
    Unit cur, nxt; int ui = 0;
    if (!S.next(0, cur)) return;
    f32x4 acc[2][2][4][2];
#pragma unroll
    for (int a = 0; a < 2; ++a)
#pragma unroll
        for (int b = 0; b < 2; ++b)
#pragma unroll
            for (int m = 0; m < 4; ++m)
#pragma unroll
                for (int n = 0; n < 2; ++n) acc[a][b][m][n] = (f32x4){0.f, 0.f, 0.f, 0.f};
    bf16x8 At[4][2], B0[2][2], B1[2][2];
    const char* cA = (const char*)g.A + (size_t)cur.pm * tstep; const char* cB = (const char*)g.Bt + (size_t)cur.pn * tstep;
    S.a_ready(cur);
    if constexpr (SP2) {
        PG8_STAGE(PG8_SB(0, 0), cB, voffB); PG8_STAGE(PG8_SB(0, 1), cB + hstep, voffB); PG8_STAGE(PG8_SA(0, 0), cA, voffA); PG8_STAGE(PG8_SA(0, 1), cA + hstep, voffA);
        if (wr == 1) PG8_BAR;
        PG8_WAIT_V(2); PG8_BAR;
        PG8_STAGE(PG8_SB(1, 0), cB + kstep, voffB); PG8_STAGE(PG8_SA(1, 0), cA + kstep, voffA); PG8_STAGE(PG8_SB(1, 1), cB + hstep + kstep, voffB);
        PG8_WAIT_V(6); PG8_BAR;
    } else {
        PG8_STAGE(PG8_SB(0, 0), cB, voffB); PG8_STAGE(PG8_SA(0, 0), cA, voffA); PG8_STAGE(PG8_SB(0, 1), cB + hstep, voffB); PG8_STAGE(PG8_SA(0, 1), cA + hstep, voffA);
        if (wr == 1) PG8_BAR;
        PG8_WAIT_V(4); PG8_BAR;
        PG8_STAGE(PG8_SB(1, 0), cB + kstep, voffB); PG8_STAGE(PG8_SA(1, 0), cA + kstep, voffA); PG8_STAGE(PG8_SB(1, 1), cB + hstep + kstep, voffB);
        PG8_WAIT_V(6); PG8_BAR;
    }
    for (;;) {
        const bool has_next = S.next(ui + 1, nxt);
        const char* nA = has_next ? (const char*)g.A + (size_t)nxt.pm * tstep : cA; const char* nB = has_next ? (const char*)g.Bt + (size_t)nxt.pn * tstep : cB;
        for (int t = 0; t < nt; t += 2) {
            if constexpr (Epi::MIDK) { if (t == nt / 2) E.midk(acc, cur, wr, wc, fr, fq); }
            const bool last = (t == nt - 2);
            const char* a1 = cA + (size_t)(t + 1) * kstep;
            const char* a2 = last ? nA : cA + (size_t)(t + 2) * kstep; const char* b2 = last ? nB : cB + (size_t)(t + 2) * kstep;
            const char* a3 = a2 + kstep; const char* b3 = b2 + kstep;
            if (last && has_next) S.a_ready(nxt);
            if constexpr (SP2) {
            PG8_LDB(B0, 0, 0); PG8_LDB(B1, 0, 1); PG8_SCHED; PG8_LDA(At, 0, 0); PG8_STAGE(PG8_SA(1, 1), a1 + hstep, voffA);
            PG8_WAIT_V(8); PG8_WAIT_L(0); PG8_BAR; PG8_MMA(0, 0, At, B0); PG8_MMA(0, 1, At, B1); PG8_BAR; PG8_SCHED;
            PG8_LDA(At, 0, 1); PG8_STAGE(PG8_SB(0, 0), b2, voffB); PG8_STAGE(PG8_SB(0, 1), b2 + hstep, voffB); PG8_STAGE(PG8_SA(0, 0), a2, voffA);
            PG8_WAIT_V(8); PG8_WAIT_L(0); PG8_BAR; PG8_MMA(1, 0, At, B0); PG8_MMA(1, 1, At, B1); PG8_BAR; PG8_SCHED;
            PG8_LDB(B0, 1, 0); PG8_LDB(B1, 1, 1); PG8_SCHED; PG8_LDA(At, 1, 0); PG8_STAGE(PG8_SA(0, 1), a2 + hstep, voffA);
            PG8_WAIT_V(8); PG8_WAIT_L(0); PG8_BAR; PG8_MMA(0, 0, At, B0); PG8_MMA(0, 1, At, B1); PG8_BAR; PG8_SCHED;
            PG8_LDA(At, 1, 1); PG8_STAGE(PG8_SB(1, 0), b3, voffB); PG8_STAGE(PG8_SB(1, 1), b3 + hstep, voffB); PG8_STAGE(PG8_SA(1, 0), a3, voffA);
            PG8_WAIT_V(8); PG8_WAIT_L(0); PG8_BAR; PG8_MMA(1, 0, At, B0); PG8_MMA(1, 1, At, B1); PG8_BAR; PG8_SCHED;
            } else {
            PG8_LDB(B0, 0, 0); PG8_SCHED; PG8_LDA(At, 0, 0); PG8_STAGE(PG8_SA(1, 1), a1 + hstep, voffA);
            PG8_WAIT_L(8); PG8_BAR; PG8_WAIT_L(0); PG8_MMA(0, 0, At, B0); PG8_BAR; PG8_SCHED;
            PG8_LDB(B1, 0, 1); PG8_STAGE(PG8_SB(0, 0), b2, voffB);
            PG8_BAR; PG8_WAIT_L(0); PG8_MMA(0, 1, At, B1); PG8_BAR;
            PG8_LDA(At, 0, 1); PG8_STAGE(PG8_SA(0, 0), a2, voffA);
            PG8_BAR; PG8_WAIT_L(0); PG8_MMA(1, 0, At, B0); PG8_BAR; PG8_SCHED;
            PG8_STAGE(PG8_SB(0, 1), b2 + hstep, voffB);
            PG8_WAIT_V(6); PG8_BAR; PG8_MMA(1, 1, At, B1); PG8_BAR;
            PG8_LDB(B0, 1, 0); PG8_SCHED; PG8_LDA(At, 1, 0); PG8_STAGE(PG8_SA(0, 1), a2 + hstep, voffA);
            PG8_WAIT_L(8); PG8_BAR; PG8_WAIT_L(0); PG8_MMA(0, 0, At, B0); PG8_BAR; PG8_SCHED;
            PG8_LDB(B1, 1, 1); PG8_STAGE(PG8_SB(1, 0), b3, voffB);
            PG8_BAR; PG8_WAIT_L(0); PG8_MMA(0, 1, At, B1); PG8_BAR;
            PG8_LDA(At, 1, 1); PG8_STAGE(PG8_SA(1, 0), a3, voffA);
            PG8_BAR; PG8_WAIT_L(0); PG8_MMA(1, 0, At, B0); PG8_BAR; PG8_SCHED;
            PG8_STAGE(PG8_SB(1, 1), b3 + hstep, voffB);
            PG8_WAIT_V(6); PG8_BAR; PG8_MMA(1, 1, At, B1); PG8_BAR;
            }
        }
        if constexpr (ALIGN_EPI) { if (wr == 0) PG8_BAR; }
        if constexpr (!Epi::AFTER_DRAIN) { E(acc, cur, wr, wc, fr, fq); S.done(cur); }
        if (!has_next) break;
#pragma unroll
        for (int a = 0; a < 2; ++a)
#pragma unroll
            for (int b = 0; b < 2; ++b)
#pragma unroll
                for (int m = 0; m < 4; ++m)
#pragma unroll
                    for (int n = 0; n < 2; ++n) acc[a][b][m][n] = (f32x4){0.f, 0.f, 0.f, 0.f};
        cur = nxt; cA = nA; cB = nB; ++ui;
        if constexpr (ALIGN_EPI) { if (wr == 1) PG8_BAR; }
    }
    PG8_WAIT_V(0);
    if constexpr (!ALIGN_EPI) { if (wr == 0) PG8_BAR; }
    PG8_BAR;
    if constexpr (Epi::AFTER_DRAIN) { E.fused(acc, cur, wr, wc, fr, fq, lds, wid, lane); S.done(cur); }
#undef PG8_SA
#undef PG8_SB
#undef PG8_STAGE
#undef PG8_LDA
#undef PG8_LDB
#undef PG8_MMA
#undef PG8_WAIT_V
#undef PG8_WAIT_L
#undef PG8_BAR
#undef PG8_SCHED
}
}
#define XB_TMO      128
#define XB_XCNT(j)  (256  + 64 * (j))
#define XB_XSUB(j)  (1280 + 64 * (j))
#define XB_XGEN(j)  (2304 + 64 * (j))
#define XB_TOP      3328
#define XB_TOPGEN   3392
#define XCD_BAR_WORDS 3456
#define XB_SPIN_CAP (1u << 18)

__device__ __forceinline__ unsigned xb_ld(unsigned* p)              { return __hip_atomic_load(p, __ATOMIC_RELAXED, __HIP_MEMORY_SCOPE_AGENT); }
__device__ __forceinline__ unsigned xb_add(unsigned* p, unsigned v) { return __hip_atomic_fetch_add(p, v, __ATOMIC_RELAXED, __HIP_MEMORY_SCOPE_AGENT); }
__device__ __forceinline__ unsigned xb_xcc_id() { return (unsigned)__builtin_amdgcn_s_getreg((3 << 11) | 20) & 0xFu; }
#define XB_SPIN(cond, bar) do { unsigned _sp = 0; while (cond) { __builtin_amdgcn_s_sleep(1); \
    if ((++_sp & 255u) == 0u) { if (xb_ld(&(bar)[XB_TMO])) break; if (_sp > XB_SPIN_CAP) { atomicAdd(&(bar)[XB_TMO], 1u); break; } } } } while (0)

struct XcdBarrier {
    unsigned* bar; unsigned x;
    volatile LAS unsigned* st;
};

__device__ __forceinline__ XcdBarrier xcd_barrier_post(unsigned* bar, volatile LAS unsigned* st) {
    XcdBarrier b; b.bar = bar; b.x = xb_xcc_id(); b.st = st;
    if (threadIdx.x == 0) (void)xb_add(&bar[XB_XCNT(b.x)], 1u);
    return b;
}
__device__ __forceinline__ void xcd_barrier_complete(unsigned* bar, unsigned x, unsigned& nloc, unsigned& nx) {
    const unsigned G = gridDim.x * gridDim.y * gridDim.z;
    unsigned sum, cnt, mine, sp = 0u;
    for (;;) {
        sum = 0u; cnt = 0u; mine = 0u;
#pragma unroll
        for (unsigned j = 0; j < 16; ++j) { const unsigned c = xb_ld(&bar[XB_XCNT(j)]); sum += c; cnt += (c > 0u) ? 1u : 0u; mine = (j == x) ? c : mine; }
        if (sum == G) break;
        __builtin_amdgcn_s_sleep(1);
        if ((++sp & 255u) == 0u) { if (xb_ld(&bar[XB_TMO])) break; if (sp > XB_SPIN_CAP) { atomicAdd(&bar[XB_TMO], 1u); break; } }
    }
    nloc = mine > 0u ? mine : 1u; nx = cnt > 0u ? cnt : 1u;
}

__device__ __forceinline__ void xcd_barrier(const XcdBarrier& b) {
    asm volatile("s_waitcnt vmcnt(0)" ::: "memory");
    __syncthreads();
    if (threadIdx.x == 0) {
        unsigned* bar = b.bar;
        __builtin_amdgcn_s_waitcnt(0);
        unsigned nloc = b.st[0], nx = b.st[1];
        if (nloc == 0u) { xcd_barrier_complete(bar, b.x, nloc, nx); b.st[0] = nloc; b.st[1] = nx; }
        const unsigned old = xb_add(&bar[XB_XSUB(b.x)], 1u);
        const unsigned gen = old / nloc;
        if (old + 1u == (gen + 1u) * nloc) {
            __builtin_amdgcn_fence(__ATOMIC_RELEASE, "agent");
            asm volatile("s_waitcnt vmcnt(0)" ::: "memory");
            const unsigned og = xb_add(&bar[XB_TOP], 1u);
            const unsigned tg = og / nx;
            if (og + 1u == (tg + 1u) * nx) xb_add(&bar[XB_TOPGEN], 1u);
            else XB_SPIN(xb_ld(&bar[XB_TOPGEN]) == tg, bar);
            __builtin_amdgcn_fence(__ATOMIC_ACQUIRE, "agent");
            xb_add(&bar[XB_XGEN(b.x)], 1u);
            asm volatile("s_waitcnt vmcnt(0)" ::: "memory");
        } else {
            XB_SPIN(xb_ld(&bar[XB_XGEN(b.x)]) == gen, bar);
            __builtin_amdgcn_fence(__ATOMIC_ACQUIRE, "agent");
            asm volatile("s_waitcnt vmcnt(0)" ::: "memory");
        }
    }
    __syncthreads();
}

constexpr int NWAVES = 8;
constexpr size_t MiB = 1u << 20;
constexpr size_t WS_CTL = 0, CTL_ZERO_BYTES = 1 * MiB;
constexpr size_t WS_W1T = 2 * MiB;
constexpr size_t WS_W2T = 16 * MiB;
constexpr size_t WS_W3T = 24 * MiB;
constexpr size_t WS_SKB = 32 * MiB;
constexpr size_t WS_RSTD1 = 33 * MiB;
constexpr size_t WS_SSA = 34 * MiB;
constexpr size_t WS_SSL = 35 * MiB;
constexpr size_t WS_SS2 = 37 * MiB;
constexpr size_t WS_RSTD2 = 39 * MiB;
constexpr size_t WS_IDS = 40 * MiB;
constexpr size_t WS_GW = 48 * MiB;
constexpr size_t WS_U8 = 64 * MiB;
constexpr size_t WS_V8 = 96 * MiB;
constexpr size_t WS_X8 = 128 * MiB;
constexpr size_t WS_SX = 160 * MiB;
constexpr size_t WS_SCU = 162 * MiB;
constexpr size_t WS_SCV = 163 * MiB;
constexpr size_t WS_WSUM = 164 * MiB;
constexpr size_t WS_A1 = 192 * MiB;
constexpr size_t WS_Q = 258 * MiB;
constexpr size_t WS_KV = 290 * MiB;
constexpr size_t WS_XB = 299 * MiB;
constexpr size_t WS_GT = 332 * MiB;
constexpr size_t WS_H1 = 364 * MiB;
constexpr size_t WS_PART = 192 * MiB;
constexpr size_t WS_W = 56 * MiB;
constexpr size_t WS_Z = 428 * MiB;
constexpr size_t WS_END = 492 * MiB;
constexpr int CW_QROW = 2048;
constexpr int CW_BAR = 4096;

constexpr int RING_OFF = 0, RING_BYTES = 131072;
constexpr int LDSCTL_OFF = RING_BYTES, MISC_OFF = LDSCTL_OFF + 320;
constexpr int LDS_BYTES = 147456;

typedef unsigned short bf16;
typedef unsigned v4u __attribute__((ext_vector_type(4)));
typedef float f32x4 __attribute__((ext_vector_type(4)));
typedef short bf16x8 __attribute__((ext_vector_type(8)));
typedef GAS unsigned gu32;
#define RLX_AGENT __ATOMIC_RELAXED, __HIP_MEMORY_SCOPE_AGENT
#define LDS_WAIT() asm volatile("s_waitcnt lgkmcnt(0)" ::: "memory")
#define VM_WAIT() asm volatile("s_waitcnt vmcnt(0)" ::: "memory")
__device__ __forceinline__ unsigned f2bf(float f) { unsigned u = __builtin_bit_cast(unsigned, f); return (u + 0x7fffu + ((u >> 16) & 1u)) >> 16; }
__device__ __forceinline__ unsigned pk2(float lo, float hi) { return f2bf(lo) | (f2bf(hi) << 16); }
__device__ __forceinline__ float bf2f(unsigned short b) { return __builtin_bit_cast(float, (unsigned)b << 16); }


namespace p2 {
typedef float f32x16 __attribute__((ext_vector_type(16)));
typedef unsigned u32x2 __attribute__((ext_vector_type(2)));
constexpr float LOG2E = 1.4426950408889634f;
constexpr float NEGBIG = -1e30f;
__device__ __forceinline__ int crow(int r, int hi) { return (r & 3) + 8 * (r >> 2) + 4 * hi; }
__device__ __forceinline__ unsigned cvtpk(float lo, float hi) { unsigned r; asm volatile("v_cvt_pk_bf16_f32 %0, %1, %2" : "=v"(r) : "v"(lo), "v"(hi)); return r; }
__device__ __forceinline__ float ex2(float x) { return __builtin_amdgcn_exp2f(x); }
__device__ __forceinline__ float rcp(float x) { return __builtin_amdgcn_rcpf(x); }
__device__ __forceinline__ float gelu_fast(float x) { return x * rcp(1.0f + ex2(-2.302208198f * x * (1.0f + 0.044715f * x * x))); }

constexpr int A_KS = 0, A_KSP = 144, A_VT = 288 * 144, A_VTP = 584, A_ST = A_VT + 64 * 584, A_END = A_ST + 8 * 4096;
__device__ __forceinline__ void attn_unit(LAS unsigned char* lds, int b, int qblk, int kvh, const bf16* QB, const bf16* KVB, const float* sinks, bf16* MIX, float* SSA, int tid) {
    const int lane = tid & 63, wave = __builtin_amdgcn_readfirstlane(tid >> 6), r = lane & 31, hi = lane >> 5;
    const int q0 = qblk * 128, hq = kvh * 8 + wave;
    for (int it = 0; it < 5; ++it) {
        const int cid = it * 512 + tid;
        if (cid < 288 * 8) {
            const int key = cid >> 3, ch = cid & 7;
            bool valid; size_t row = 0;
            if (key < 256) { const int pos = q0 - 128 + key; valid = pos >= 0; row = (size_t)b * SEQ + pos; }
            else if (key < 272) { valid = true; row = (size_t)MREAL + (key - 256); }
            else valid = false;
            v4u kv = {0u, 0u, 0u, 0u}, vv = {0u, 0u, 0u, 0u};
            if (valid) { kv = *(const GAS v4u*)(KVB + row * 256 + kvh * 64 + ch * 8); vv = *(const GAS v4u*)(KVB + row * 256 + 128 + kvh * 64 + ch * 8); }
            *(LAS v4u*)(lds + A_KS + key * A_KSP + ch * 16) = kv;
            LAS unsigned short* vt = (LAS unsigned short*)(lds + A_VT);
#pragma unroll
            for (int j = 0; j < 8; ++j) { const unsigned wv = vv[j >> 1]; vt[(ch * 8 + j) * (A_VTP / 2) + key] = (unsigned short)((j & 1) ? (wv >> 16) : (wv & 0xffffu)); }
        }
    }
    __syncthreads();
    const float sink2 = sinks[hq] * LOG2E;
    for (int qg = 0; qg < 4; ++qg) {
        const size_t mrow = (size_t)b * SEQ + q0 + 32 * qg + r;
        bf16x8 qf[4];
#pragma unroll
        for (int ks = 0; ks < 4; ++ks) qf[ks] = *(const GAS bf16x8*)(QB + mrow * 1024 + hq * 64 + ks * 16 + hi * 8);
        f32x16 s[6];
#pragma unroll
        for (int t = 0; t < 6; ++t) {
            const int kbase = t < 5 ? 32 * (qg + t) : 256;
            f32x16 acc = {0.f, 0.f, 0.f, 0.f, 0.f, 0.f, 0.f, 0.f, 0.f, 0.f, 0.f, 0.f, 0.f, 0.f, 0.f, 0.f};
#pragma unroll
            for (int ks = 0; ks < 4; ++ks) {
                const bf16x8 kf = *(const LAS bf16x8*)(lds + A_KS + (kbase + r) * A_KSP + ks * 32 + hi * 16);
                acc = __builtin_amdgcn_mfma_f32_32x32x16_bf16(kf, qf[ks], acc, 0, 0, 0);
            }
            s[t] = acc;
        }
        const bool blk0 = (qblk == 0);
#pragma unroll
        for (int reg = 0; reg < 16; ++reg) {
            const int j = crow(reg, hi);
            s[0][reg] = (j > r) ? s[0][reg] : NEGBIG;
            s[4][reg] = (j <= r) ? s[4][reg] : NEGBIG;
            s[5][reg] = (j < 16) ? s[5][reg] : NEGBIG;
        }
#pragma unroll
        for (int t = 0; t < 4; ++t) if (blk0 && (qg + t < 4)) {
#pragma unroll
            for (int reg = 0; reg < 16; ++reg) s[t][reg] = NEGBIG;
        }
        float m = sink2;
#pragma unroll
        for (int t = 0; t < 6; ++t)
#pragma unroll
            for (int reg = 0; reg < 16; ++reg) m = fmaxf(m, s[t][reg]);
        m = max_x32(m);
        float l = 0.f;
#pragma unroll
        for (int t = 0; t < 6; ++t)
#pragma unroll
            for (int reg = 0; reg < 16; ++reg) { const float p = ex2(s[t][reg] - m); s[t][reg] = p; l += p; }
        l = sum_x32(l);
        l += ex2(sink2 - m);
        const float linv = 1.0f / l;
        f32x16 o0 = {0.f, 0.f, 0.f, 0.f, 0.f, 0.f, 0.f, 0.f, 0.f, 0.f, 0.f, 0.f, 0.f, 0.f, 0.f, 0.f}, o1 = o0;
#pragma unroll
        for (int t = 0; t < 6; ++t) {
            const int kbase = t < 5 ? 32 * (qg + t) : 256;
#pragma unroll
            for (int ss = 0; ss < 2; ++ss) {
                v4u pw; pw.x = cvtpk(s[t][8 * ss + 0], s[t][8 * ss + 1]); pw.y = cvtpk(s[t][8 * ss + 2], s[t][8 * ss + 3]);
                pw.z = cvtpk(s[t][8 * ss + 4], s[t][8 * ss + 5]); pw.w = cvtpk(s[t][8 * ss + 6], s[t][8 * ss + 7]);
                const bf16x8 pa = __builtin_bit_cast(bf16x8, pw);
                const int ko = (kbase + 16 * ss + 4 * hi) * 2;
                {   const u32x2 lo = *(const LAS u32x2*)(lds + A_VT + r * A_VTP + ko), h2 = *(const LAS u32x2*)(lds + A_VT + r * A_VTP + ko + 16);
                    v4u vw; vw.x = lo.x; vw.y = lo.y; vw.z = h2.x; vw.w = h2.y;
                    o0 = __builtin_amdgcn_mfma_f32_32x32x16_bf16(pa, __builtin_bit_cast(bf16x8, vw), o0, 0, 0, 0); }
                {   const u32x2 lo = *(const LAS u32x2*)(lds + A_VT + (32 + r) * A_VTP + ko), h2 = *(const LAS u32x2*)(lds + A_VT + (32 + r) * A_VTP + ko + 16);
                    v4u vw; vw.x = lo.x; vw.y = lo.y; vw.z = h2.x; vw.w = h2.y;
                    o1 = __builtin_amdgcn_mfma_f32_32x32x16_bf16(pa, __builtin_bit_cast(bf16x8, vw), o1, 0, 0, 0); }
            }
        }
        LAS unsigned short* stg = (LAS unsigned short*)(lds + A_ST + wave * 4096);
#pragma unroll
        for (int reg = 0; reg < 16; ++reg) {
            const int qr = crow(reg, hi); const float li = __shfl(linv, qr);
            stg[qr * 64 + r] = (unsigned short)f2bf(o0[reg] * li);
            stg[qr * 64 + 32 + r] = (unsigned short)f2bf(o1[reg] * li);
        }
        asm volatile("s_waitcnt lgkmcnt(0)" ::: "memory");
#pragma unroll
        for (int i = 0; i < 4; ++i) {
            const int row = i * 8 + (lane >> 3), ch = lane & 7;
            const v4u v = *(const LAS v4u*)(stg + row * 64 + ch * 8);
            float ss = 0.f;
#pragma unroll
            for (int k = 0; k < 4; ++k) { const float a = __builtin_bit_cast(float, v[k] << 16), c = __builtin_bit_cast(float, v[k] & 0xffff0000u); ss += a * a + c * c; }
            ss = sum8(ss);
            const size_t orow = (size_t)b * SEQ + q0 + 32 * qg + row;
            *(GAS v4u*)(MIX + orow * D + hq * 64 + ch * 8) = v;
            if (ch == 0) SSA[orow * 16 + hq] = ss;
        }
        asm volatile("s_waitcnt lgkmcnt(0)" ::: "memory");
    }
    __syncthreads();
}

constexpr int LW_XS = 0, LW_GS = 4608, LW_XC = LW_GS + 2048, LW_XCF = LW_XC + 4608, LW_BYTES = LW_XCF + 4096 + 128;
constexpr int L_CT = 8 * LW_BYTES, L_END = L_CT + 2 * 2048;
static_assert(L_END <= 131072, "lru lds");
struct LruP { const float *conv_w, *conv_b, *w_r, *b_r, *w_i, *b_i, *lam; };
__device__ __forceinline__ void lru_unit(LAS unsigned char* lds, LAS unsigned char* ldsw  , int b, int nb, int cg, const bf16* XBB, const bf16* GTB, const LruP P, bf16* MIX, float* SSL, int tid) {
    const int lane = tid & 63, wave = __builtin_amdgcn_readfirstlane(tid >> 6), r = lane & 31, hi = lane >> 5;
    LAS unsigned char* lw = lds + wave * LW_BYTES;
    {
        LAS unsigned short* wt = (LAS unsigned short*)ldsw;
#pragma unroll
        for (int i = 0; i < 4; ++i) {
            const int e = tid + 512 * i, c = e >> 5, dl = e & 31;
            const size_t gi = (size_t)(nb * 64 + c) * 64 + 32 * cg + dl;
            wt[dl * 72 + c] = (unsigned short)f2bf(P.w_r[gi]);
            wt[32 * 72 + dl * 72 + c] = (unsigned short)f2bf(P.w_i[gi]);
        }
    }
    const int cc = lane, chc = nb * 64 + cc;
    const float cw0 = P.conv_w[0 * LW + chc], cw1 = P.conv_w[1 * LW + chc], cw2 = P.conv_w[2 * LW + chc], cw3 = P.conv_w[3 * LW + chc], cbv = P.conv_b[chc];
    const int chd = nb * 64 + 32 * cg + r;
    const float br = P.b_r[chd], bi = P.b_i[chd];
    const float ls8 = -8.0f * log1pf(expf(-P.lam[chd])) * LOG2E;
    float state = 0.f;
    v4u px[5], pg[2];
#define LRU_PREFETCH(tl) do { \
        _Pragma("unroll") for (int it = 0; it < 5; ++it) { const int cid = it * 64 + lane; px[it] = (v4u){0u, 0u, 0u, 0u}; \
            if (cid < 35 * 8) { const int j = cid >> 3, ch = cid & 7, t = 32 * wave + j - 3; bool valid; size_t row = 0; \
                if ((tl) == 0) { valid = (t >= 0 && t < NMETA); row = (size_t)MREAL + t; } \
                else if ((tl) == 1 && t < 0) { valid = true; row = (size_t)MREAL + NMETA + t; } \
                else { valid = true; row = (size_t)b * SEQ + 256 * ((tl) - 1) + t; } \
                if (valid) px[it] = *(const GAS v4u*)(XBB + row * 1024 + nb * 64 + ch * 8); } } \
        if ((tl) > 0) { _Pragma("unroll") for (int it = 0; it < 2; ++it) { const int cid = it * 64 + lane, t = 32 * wave + (cid >> 2), ch = cid & 3; \
            pg[it] = *(const GAS v4u*)(GTB + ((size_t)b * SEQ + 256 * ((tl) - 1) + t) * 1024 + nb * 64 + 32 * cg + ch * 8); } } } while (0)
    LRU_PREFETCH(0);
    __syncthreads();
    for (int tile = 0; tile < 9; ++tile) {
#pragma unroll
        for (int it = 0; it < 5; ++it) { const int cid = it * 64 + lane; if (cid < 35 * 8) *(LAS v4u*)(lw + LW_XS + (cid >> 3) * 128 + (cid & 7) * 16) = px[it]; }
        if (tile > 0) {
#pragma unroll
            for (int it = 0; it < 2; ++it) { const int cid = it * 64 + lane; *(LAS v4u*)(lw + LW_GS + (cid >> 2) * 64 + (cid & 3) * 16) = pg[it]; }
        }
        asm volatile("s_waitcnt lgkmcnt(0)" ::: "memory");
        if (tile + 1 < 9) LRU_PREFETCH(tile + 1);
        {
            const LAS unsigned short* xs = (const LAS unsigned short*)(lw + LW_XS);
            LAS unsigned short* xc = (LAS unsigned short*)(lw + LW_XC);
            LAS float* xcf = (LAS float*)(lw + LW_XCF);
            const bool own = (cc >> 5) == cg; const int xoff = own ? (cc & 31) : 32 * 32 + (cc & 31);
            float x0 = bf2f(xs[0 * 64 + cc]), x1 = bf2f(xs[1 * 64 + cc]), x2 = bf2f(xs[2 * 64 + cc]);
#pragma unroll 8
            for (int k = 0; k < 32; ++k) {
                const float x3 = bf2f(xs[(k + 3) * 64 + cc]);
                const float v = cbv + cw0 * x0 + cw1 * x1 + cw2 * x2 + cw3 * x3;
                xc[k * 72 + cc] = (unsigned short)cvtpk(v, v);
                xcf[(own ? k * 32 : 0) + xoff] = v;
                x0 = x1; x1 = x2; x2 = x3;
            }
        }
        asm volatile("s_waitcnt lgkmcnt(0)" ::: "memory");
        f32x16 aR = {0.f, 0.f, 0.f, 0.f, 0.f, 0.f, 0.f, 0.f, 0.f, 0.f, 0.f, 0.f, 0.f, 0.f, 0.f, 0.f}, aI = aR;
#pragma unroll
        for (int ks = 0; ks < 4; ++ks) {
            const bf16x8 xa = *(const LAS bf16x8*)(lw + LW_XC + r * 144 + ks * 32 + hi * 16);
            const bf16x8 wr_ = *(const LAS bf16x8*)(ldsw + r * 144 + ks * 32 + hi * 16);
            const bf16x8 wi_ = *(const LAS bf16x8*)(ldsw + 32 * 144 + r * 144 + ks * 32 + hi * 16);
            aR = __builtin_amdgcn_mfma_f32_32x32x16_bf16(xa, wr_, aR, 0, 0, 0);
            aI = __builtin_amdgcn_mfma_f32_32x32x16_bf16(xa, wi_, aI, 0, 0, 0);
        }
        float Av[16], Bv[16];
        {
            const LAS float* xcf = (const LAS float*)(lw + LW_XCF);
#pragma unroll
            for (int reg = 0; reg < 16; ++reg) {
                const int tl = crow(reg, hi), t = 32 * wave + tl;
                const bool valid = (tile > 0) || (t < NMETA);
                const float rg = rcp(1.0f + ex2(-(aR[reg] + br) * LOG2E));
                const float ig = rcp(1.0f + ex2(-(aI[reg] + bi) * LOG2E));
                const float a = ex2(rg * ls8);
                const float mult = __builtin_amdgcn_sqrtf(fmaxf(1.0f - a * a, 0.f));
                const float bx = mult * ig * xcf[tl * 32 + r];
                Av[reg] = valid ? a : 1.0f; Bv[reg] = valid ? bx : 0.0f;
            }
        }
#pragma unroll
        for (int g = 0; g < 4; ++g) {
#pragma unroll
            for (int k = 1; k < 4; ++k) { Bv[4 * g + k] = Av[4 * g + k] * Bv[4 * g + k - 1] + Bv[4 * g + k]; Av[4 * g + k] = Av[4 * g + k] * Av[4 * g + k - 1]; }
        }
        float myCz[4], myCp[4], PW, HW;
        {
            float cz = 0.f, cp = 1.f;
#pragma unroll
            for (int g = 0; g < 4; ++g) {
                const float mP = Av[4 * g + 3], mH = Bv[4 * g + 3];
                const float oP = __shfl_xor(mP, 32), oH = __shfl_xor(mH, 32);
                const float eP = hi ? oP : mP, eH = hi ? oH : mH, dP = hi ? mP : oP, dH = hi ? mH : oH;
                const float cz0 = cz, cp0 = cp;
                cz = eP * cz + eH; cp = cp * eP;
                myCz[g] = hi ? cz : cz0; myCp[g] = hi ? cp : cp0;
                cz = dP * cz + dH; cp = cp * dP;
            }
            PW = cp; HW = cz;
        }
        LAS float* ct = (LAS float*)(lds + L_CT + (tile & 1) * 2048);
        if (hi == 0) { ct[(wave * 32 + r) * 2] = PW; ct[(wave * 32 + r) * 2 + 1] = HW; }
        __syncthreads();
        float cin = 0.f;
        {
            float c = state;
#pragma unroll
            for (int w2 = 0; w2 < 8; ++w2) { if (w2 == wave) cin = c; c = ct[(w2 * 32 + r) * 2] * c + ct[(w2 * 32 + r) * 2 + 1]; }
            state = c;
        }
        if (tile > 0) {
            const LAS unsigned short* gs = (const LAS unsigned short*)(lw + LW_GS);
            LAS unsigned short* os = (LAS unsigned short*)(lw + LW_XS);
#pragma unroll
            for (int reg = 0; reg < 16; ++reg) {
                const int g = reg >> 2, tl = crow(reg, hi);
                const float h = Bv[reg] + Av[reg] * (myCz[g] + myCp[g] * cin);
                const float gt = bf2f(gs[tl * 32 + r]);
                { const float ov = gelu_fast(gt) * h; os[tl * 32 + r] = (unsigned short)cvtpk(ov, ov); }
            }
            asm volatile("s_waitcnt lgkmcnt(0)" ::: "memory");
#pragma unroll
            for (int it = 0; it < 2; ++it) {
                const int cid = it * 64 + lane, tl = cid >> 2, ch = cid & 3;
                const v4u v = *(const LAS v4u*)(lw + LW_XS + tl * 64 + ch * 16);
                float ss = 0.f;
#pragma unroll
                for (int k = 0; k < 4; ++k) { const float a = __builtin_bit_cast(float, v[k] << 16), c = __builtin_bit_cast(float, v[k] & 0xffff0000u); ss += a * a + c * c; }
                ss = sum4(ss);
                const size_t row = (size_t)b * SEQ + 256 * (tile - 1) + 32 * wave + tl;
                *(GAS v4u*)(MIX + row * D + 1024 + nb * 64 + 32 * cg + ch * 8) = v;
                if (ch == 0) SSL[row * 32 + nb * 2 + cg] = ss;
            }
            asm volatile("s_waitcnt lgkmcnt(0)" ::: "memory");
        }
    }
#undef LRU_PREFETCH
    __syncthreads();
}
}

namespace p5 {
typedef float f32x16 __attribute__((ext_vector_type(16)));
constexpr int KP = 272;
constexpr int R_KEYS = 0, R_IDX = 256 * KP, R_END = R_IDX + 8 * 1024;
__device__ __forceinline__ int crow(int r, int hi) { return (r & 3) + 8 * (r >> 2) + 4 * hi; }
__device__ __forceinline__ float fkey(float s, int mask, int payload) { return __builtin_bit_cast(float, (__builtin_bit_cast(int, s) & mask) | payload); }
__device__ __forceinline__ int fbits(float f) { return __builtin_bit_cast(int, f); }
__device__ __forceinline__ float fval(float f, int mask) { return __builtin_bit_cast(float, __builtin_bit_cast(int, f) & mask); }
__device__ __forceinline__ void ins16(float (&L)[16], float v) {
#pragma unroll
    for (int k = 15; k >= 1; --k) L[k] = __builtin_amdgcn_fmed3f(L[k - 1], L[k], v);
    L[0] = fmaxf(L[0], v);
}
__device__ __forceinline__ void half_top16(const LAS unsigned char* keys, const bf16x8 (&qf)[8], int r, int hi, float (&T)[16]) {
    float L[16];
#pragma unroll
    for (int k = 0; k < 16; ++k) L[k] = -INFINITY;
    const int h4 = 4 * hi;
#pragma unroll
    for (int kt = 0; kt < 4; ++kt) {
        f32x16 acc = {0.f, 0.f, 0.f, 0.f, 0.f, 0.f, 0.f, 0.f, 0.f, 0.f, 0.f, 0.f, 0.f, 0.f, 0.f, 0.f};
#pragma unroll
        for (int ks = 0; ks < 8; ++ks) {
            const bf16x8 kf = *(const LAS bf16x8*)(keys + (kt * 32 + r) * KP + ks * 32 + hi * 16);
            acc = __builtin_amdgcn_mfma_f32_32x32x16_bf16(kf, qf[ks], acc, 0, 0, 0);
        }
#pragma unroll
        for (int reg = 0; reg < 16; ++reg) {
            const int C = 127 - 32 * kt - (reg & 3) - 8 * (reg >> 2);
            ins16(L, fkey(acc[reg], (int)0xffffff80, C - h4));
        }
    }
    float M[16];
#pragma unroll
    for (int i = 0; i < 16; ++i) M[i] = fmaxf(L[i], __shfl_xor(L[15 - i], 32));
#define P5_STAGE(st) _Pragma("unroll") for (int i = 0; i < 16; ++i) if ((i & (st)) == 0) { const float a = fmaxf(M[i], M[i + (st)]), b = fminf(M[i], M[i + (st)]); M[i] = a; M[i + (st)] = b; }
    P5_STAGE(8) P5_STAGE(4) P5_STAGE(2) P5_STAGE(1)
#undef P5_STAGE
#pragma unroll
    for (int i = 0; i < 16; ++i) T[i] = M[i];
}

__device__ __forceinline__ void retr_unit(LAS unsigned char* lds, int h, int tg, const bf16* QPB, const bf16* SKB, unsigned short* IDS, float* GW, const float* RSTD2, int tid) {
    const int lane = tid & 63, wave = __builtin_amdgcn_readfirstlane(tid >> 6), r = lane & 31, hi = lane >> 5;
#pragma unroll
    for (int it = 0; it < 8; ++it) {
        const int cid = it * 512 + tid, row = cid >> 4, ch = cid & 15;
        *(LAS v4u*)(lds + R_KEYS + row * KP + ch * 16) = *(const GAS v4u*)(SKB + ((size_t)h * 256 + row) * 128 + ch * 8);
    }
    const size_t tok = (size_t)tg * 256 + wave * 32 + r;
    bf16x8 qa[8], qb[8];
#pragma unroll
    for (int ks = 0; ks < 8; ++ks) { qa[ks] = *(const GAS bf16x8*)(QPB + tok * D + h * 256 + ks * 16 + hi * 8); qb[ks] = *(const GAS bf16x8*)(QPB + tok * D + h * 256 + 128 + ks * 16 + hi * 8); }
    const float rs = RSTD2[tok];
    __syncthreads();
    float TA[16], TB[16];
    half_top16(lds + R_KEYS, qa, r, hi, TA);
    half_top16(lds + R_KEYS + 128 * KP, qb, r, hi, TB);
    LAS unsigned char* sc = lds + R_IDX + wave * 1024 + r * 32;
    const int hm = -hi;
    {
        v4u w;
#pragma unroll
        for (int q = 0; q < 4; ++q) { unsigned x = 0;
#pragma unroll
            for (int k = 0; k < 4; ++k) { const int t = (fbits(TB[4 * q + k]) & hm) | (fbits(TA[4 * q + k]) & ~hm); x |= (unsigned)(127 - (t & 0x7f)) << (8 * k); }
            w[q] = x; }
        *(LAS v4u*)(sc + hi * 16) = w;
    }
    float sA[16], sB[16];
#pragma unroll
    for (int i = 0; i < 16; ++i) { sA[i] = fval(TA[i], (int)0xffffff80); sB[i] = fval(TB[i], (int)0xffffff80); }
    float L[16];
#pragma unroll
    for (int k = 0; k < 16; ++k) L[k] = -INFINITY;
#pragma unroll
    for (int i = 0; i < 16; ++i)
#pragma unroll
        for (int j = 0; j < 16; ++j) if ((i + 1) * (j + 1) <= 16) {
            ins16(L, fkey(sA[i] + sB[j], (int)0xffffff00, 255 - (i * 16 + j)));
        }
    const float v0 = fval(L[0], (int)0xffffff00);
    asm volatile("s_waitcnt lgkmcnt(0)" ::: "memory");
    int ex[8]; float ew[8]; float esum = 0.f;
#pragma unroll
    for (int k = 0; k < 8; ++k) {
        const int t = (fbits(L[8 + k]) & hm) | (fbits(L[k]) & ~hm);
        const int c = 255 - (t & 0xff);
        const int ia = sc[c >> 4], ib = sc[16 + (c & 15)];
        ex[k] = ia * 128 + ib;
        const float e = __builtin_amdgcn_exp2f((__builtin_bit_cast(float, t & (int)0xffffff00) - v0) * rs * 1.4426950408889634f);
        ew[k] = e; esum += e;
    }
    esum = sum_x32(esum);
    const float inv = 1.0f / esum;
    unsigned short* ip = IDS + tok * 128 + h * 16 + hi * 8; float* gp = GW + tok * 128 + h * 16 + hi * 8;
    *(GAS v4u*)(ip) = (v4u){(unsigned)ex[0] | ((unsigned)ex[1] << 16), (unsigned)ex[2] | ((unsigned)ex[3] << 16), (unsigned)ex[4] | ((unsigned)ex[5] << 16), (unsigned)ex[6] | ((unsigned)ex[7] << 16)};
    *(GAS f32x4*)(gp) = (f32x4){ew[0] * inv, ew[1] * inv, ew[2] * inv, ew[3] * inv};
    *(GAS f32x4*)(gp + 4) = (f32x4){ew[4] * inv, ew[5] * inv, ew[6] * inv, ew[7] * inv};
    __syncthreads();
}
}

namespace p6 {
__device__ __forceinline__ float blo(unsigned w) { return __builtin_bit_cast(float, w << 16); }
__device__ __forceinline__ float bhi(unsigned w) { return __builtin_bit_cast(float, w & 0xffff0000u); }
__device__ __forceinline__ float gelu_fast(float x) { return x * __builtin_amdgcn_rcpf(1.0f + __builtin_amdgcn_exp2f(-2.302208198f * x * (1.0f + 0.044715f * x * x))); }
__device__ __forceinline__ unsigned idw(const v4u& a, const v4u& b, int g) { const unsigned w = g < 8 ? a[(g & 7) >> 1] : b[(g & 7) >> 1]; return (g & 1) ? (w >> 16) : (w & 0xffffu); }
__device__ __forceinline__ unsigned q4(float a, float b, float c, float d, float inv, int bias) {
    const int qa = (int)rintf(a * inv) + bias, qb = (int)rintf(b * inv) + bias, qc = (int)rintf(c * inv) + bias, qd = (int)rintf(d * inv) + bias;
    return (unsigned)(qa & 0xff) | ((unsigned)(qb & 0xff) << 8) | ((unsigned)(qc & 0xff) << 16) | ((unsigned)(qd & 0xff) << 24);
}
__device__ __forceinline__ void qrow_load(f32x4 (&v)[8], const float* src, size_t e, int lane) {
#pragma unroll
    for (int j = 0; j < 8; ++j) v[j] = __builtin_nontemporal_load((const GAS f32x4*)(src + e * D + j * 256 + lane * 4));
}
__device__ __forceinline__ void qrow_finish(f32x4 (&v)[8], const float* gcol, unsigned char* dst, float* scale_out, size_t e, int lane) {
    float am = 0.f;
#pragma unroll
    for (int j = 0; j < 8; ++j) {
        if (gcol) { const f32x4 g = *(const GAS f32x4*)(gcol + j * 256 + lane * 4); v[j] = v[j] * g; }
        am = fmaxf(am, fmaxf(fmaxf(fabsf(v[j].x), fabsf(v[j].y)), fmaxf(fabsf(v[j].z), fabsf(v[j].w))));
    }
    am = max64(am);
    const float inv = am > 0.f ? 127.0f / am : 0.f;
#pragma unroll
    for (int j = 0; j < 8; ++j)
        *(GAS unsigned*)(dst + ((size_t)(2 * j + (lane >> 5)) * 16384 + e) * 128 + (lane & 31) * 4) = q4(v[j].x, v[j].y, v[j].z, v[j].w, inv, 0);
    if (lane == 0) scale_out[e] = am * (1.0f / 127.0f);
}
__device__ __forceinline__ void qx_load(v4u (&x)[4], const bf16* H1B, size_t tok, int lane) {
#pragma unroll
    for (int j = 0; j < 4; ++j) x[j] = *(const GAS v4u*)(H1B + tok * D + j * 512 + lane * 8);
}
__device__ __forceinline__ void qx_finish(const v4u (&x)[4], unsigned char* X8, float* SX, size_t tok, int lane) {
#pragma unroll
    for (int j = 0; j < 4; ++j) {
        float f[8]; float am = 0.f;
#pragma unroll
        for (int k = 0; k < 4; ++k) { f[2 * k] = blo(x[j][k]); f[2 * k + 1] = bhi(x[j][k]); am = fmaxf(am, fmaxf(fabsf(f[2 * k]), fabsf(f[2 * k + 1]))); }
        am = max16(am);
        const float inv = am > 0.f ? 127.0f / am : 0.f;
        typedef unsigned u32x2v __attribute__((ext_vector_type(2)));
        u32x2v o; o.x = q4(f[0], f[1], f[2], f[3], inv, 0); o.y = q4(f[4], f[5], f[6], f[7], inv, 0);
        *(GAS u32x2v*)(X8 + tok * D + j * 512 + lane * 8) = o;
        if ((lane & 15) == 0) SX[tok * 16 + 4 * j + (lane >> 4)] = am * (1.0f / 127.0f);
    }
}

typedef int i32x16 __attribute__((ext_vector_type(16)));
typedef float f32x16v __attribute__((ext_vector_type(16)));
__device__ __forceinline__ int seli(int m, int a, int b) { return (a & m) | (b & ~m); }
__device__ __forceinline__ float self(int m, float a, float b) { return __builtin_bit_cast(float, seli(m, __builtin_bit_cast(int, a), __builtin_bit_cast(int, b))); }
__device__ __forceinline__ void usweep(const unsigned char* X8, const float* SX, const unsigned char* U8, const unsigned short* IDS, bf16* PART, int slot, int rank, int nrank, int wave, int lane) {
    const int ps = lane >> 3, ch = lane & 7;
    const int first = rank * 8 + wave, stride = nrank * 8;
    const int n = first < MREAL ? (MREAL - first + stride - 1) / stride : 0, NQ = 2 * n;
    if (NQ == 0) return;
    const int m4 = -((lane >> 2) & 1), m2 = -((lane >> 1) & 1), m1 = -(lane & 1);
#define U_LOAD(q_, I0, I1, XV, SX_, T_, SG_) do { const int qq_ = (q_) < NQ ? (q_) : NQ - 1; const int rd_ = qq_ >= n ? 1 : 0; T_ = first + (qq_ - rd_ * n) * stride; SG_ = rd_ * 8 + slot; \
        I0 = *(const GAS v4u*)(IDS + (size_t)T_ * 128 + ps * 16); I1 = *(const GAS v4u*)(IDS + (size_t)T_ * 128 + ps * 16 + 8); \
        XV = *(const GAS v4u*)(X8 + (size_t)T_ * D + SG_ * 128 + ch * 16); SX_ = SX[(size_t)T_ * 16 + SG_]; } while (0)
#define U_ISSUE(BUF, I0, I1, SG_) do { const unsigned char* tab_ = U8 + (size_t)(SG_) * 16384 * 128 + ch * 16; \
        _Pragma("unroll") for (int g = 0; g < 16; ++g) BUF[g] = *(const GAS v4u*)(tab_ + (size_t)idw(I0, I1, g) * 128); } while (0)
#define U_FINISH(BUF, XV, SX_, T_, SG_) do { i32x16 d; \
        _Pragma("unroll") for (int g = 0; g < 16; ++g) { int a_ = __builtin_amdgcn_sdot4((int)BUF[g][0], (int)XV[0], 0, false); a_ = __builtin_amdgcn_sdot4((int)BUF[g][1], (int)XV[1], a_, false); \
            a_ = __builtin_amdgcn_sdot4((int)BUF[g][2], (int)XV[2], a_, false); a_ = __builtin_amdgcn_sdot4((int)BUF[g][3], (int)XV[3], a_, false); d[g] = a_; } \
        int r8[8], r4[4], r2[2]; \
        _Pragma("unroll") for (int k = 0; k < 8; ++k) r8[k] = seli(m4, d[8 + k], d[k]) + dpp_hm(seli(m4, d[k], d[8 + k])); \
        _Pragma("unroll") for (int k = 0; k < 4; ++k) r4[k] = seli(m2, r8[4 + k], r8[k]) + dpp_x2(seli(m2, r8[k], r8[4 + k])); \
        _Pragma("unroll") for (int k = 0; k < 2; ++k) r2[k] = seli(m1, r4[2 + k], r4[k]) + dpp_x1(seli(m1, r4[k], r4[2 + k])); \
        *(GAS unsigned*)(PART + ((size_t)(SG_) * MREAL + T_) * 128 + ps * 16 + 2 * ch) = pk2((float)r2[0] * SX_, (float)r2[1] * SX_); } while (0)
    v4u bufA[16], bufB[16];
    v4u a0, a1, ax, b0, b1, bx, c0, c1, cx; float as, bs, cs; int at, bt, ct, ag, bg, cg;
    U_LOAD(0, a0, a1, ax, as, at, ag); U_LOAD(1, b0, b1, bx, bs, bt, bg);
    U_ISSUE(bufA, a0, a1, ag);
    for (int q = 0; q < NQ; q += 2) {
        U_ISSUE(bufB, b0, b1, bg);
        U_LOAD(q + 2, c0, c1, cx, cs, ct, cg);
        U_FINISH(bufA, ax, as, at, ag);
        U_ISSUE(bufA, c0, c1, cg);
        U_LOAD(q + 3, a0, a1, ax, as, at, ag);
        U_FINISH(bufB, bx, bs, bt, bg);
        { const v4u t0 = a0, t1 = a1, tx = ax; const float ts = as; const int tt = at, tg = ag;
          a0 = c0; a1 = c1; ax = cx; as = cs; at = ct; ag = cg; b0 = t0; b1 = t1; bx = tx; bs = ts; bt = tt; bg = tg; }
    }
#undef U_LOAD
#undef U_ISSUE
#undef U_FINISH
}
__device__ __forceinline__ void wreduce(const bf16* PART, const float* GW, const float* RSTD2, const unsigned short* IDS, const float* SCU, const float* SCV, unsigned char* W8, float* WS8, size_t gt, size_t NT) {
    for (size_t i8 = gt; i8 < (size_t)MREAL * 128 / 8; i8 += NT) {
        float s[8];
#pragma unroll
        for (int k = 0; k < 8; ++k) s[k] = 0.f;
#pragma unroll 8
        for (int sg = 0; sg < 16; ++sg) {
            const v4u p = *(const GAS v4u*)(PART + (size_t)sg * MREAL * 128 + i8 * 8);
#pragma unroll
            for (int k = 0; k < 4; ++k) { s[2 * k] += blo(p[k]); s[2 * k + 1] += bhi(p[k]); }
        }
        const float rs = RSTD2[i8 >> 4];
        const v4u idv = *(const GAS v4u*)(IDS + i8 * 8);
        const f32x4 g0 = *(const GAS f32x4*)(GW + i8 * 8), g1 = *(const GAS f32x4*)(GW + i8 * 8 + 4);
        float w[8]; float am = 0.f;
#pragma unroll
        for (int k = 0; k < 8; ++k) {
            const unsigned e = (k & 1) ? (idv[k >> 1] >> 16) : (idv[k >> 1] & 0xffffu);
            const float g = k < 4 ? g0[k & 3] : g1[k & 3];
            w[k] = g * gelu_fast(rs * SCU[e] * s[k]) * SCV[e]; am = fmaxf(am, fabsf(w[k]));
        }
        am = max16(am);
        const float inv = am > 0.f ? 127.0f / am : 0.f;
        typedef unsigned u32x2v __attribute__((ext_vector_type(2)));
        u32x2v o; o.x = q4(w[0], w[1], w[2], w[3], inv, 0); o.y = q4(w[4], w[5], w[6], w[7], inv, 0);
        *(GAS u32x2v*)(W8 + i8 * 8) = o;
        if ((i8 & 15) == 0) WS8[i8 >> 4] = am * (1.0f / 127.0f);
    }
}
__device__ __forceinline__ void vsweep(const bf16* H1B, const unsigned char* V8, const unsigned short* IDS, const unsigned char* W8, const float* WS8, bf16* Z, float* SSF, int slot, int rank, int nrank, int wave, int lane) {
    const int ps = lane >> 3, ch = lane & 7;
    const int first = rank * 8 + wave, stride = nrank * 8;
    const int n = first < MREAL ? (MREAL - first + stride - 1) / stride : 0, NQ = 2 * n;
    if (NQ == 0) return;
    const int m8 = -((lane >> 3) & 1);
#define V_LOAD(q_, I0, I1, T_, SG_) do { const int qq_ = (q_) < NQ ? (q_) : NQ - 1; const int rd_ = qq_ >= n ? 1 : 0; T_ = first + (qq_ - rd_ * n) * stride; SG_ = rd_ * 8 + slot; \
        I0 = *(const GAS v4u*)(IDS + (size_t)T_ * 128 + ps * 16); I1 = *(const GAS v4u*)(IDS + (size_t)T_ * 128 + ps * 16 + 8); } while (0)
#define V_ISSUE(BUF, WQ, WSC, I0, I1, T_, SG_) do { const unsigned char* tab_ = V8 + (size_t)(SG_) * 16384 * 128 + ch * 16; \
        _Pragma("unroll") for (int g = 0; g < 16; ++g) BUF[g] = *(const GAS v4u*)(tab_ + (size_t)idw(I0, I1, g) * 128); \
        WQ = *(const GAS v4u*)(W8 + (size_t)T_ * 128 + ps * 16); WSC = WS8[T_]; } while (0)
#define V_FINISH(BUF, WQ, WSC, T_, SG_) do { i32x16 acc = {0, 0, 0, 0, 0, 0, 0, 0, 0, 0, 0, 0, 0, 0, 0, 0}; \
        const unsigned hx_ = *(const GAS unsigned*)(H1B + (size_t)T_ * D + (SG_) * 128 + ch * 16 + 2 * ps); \
        _Pragma("unroll") for (int j = 0; j < 4; ++j) { const int wq_ = (int)WQ[j]; \
            _Pragma("unroll") for (int k = 0; k < 4; ++k) { \
                const unsigned d0_ = BUF[4 * j][k], d1_ = BUF[4 * j + 1][k], d2_ = BUF[4 * j + 2][k], d3_ = BUF[4 * j + 3][k]; \
                const unsigned p0_ = __builtin_amdgcn_perm(d1_, d0_, 0x05010400u), p1_ = __builtin_amdgcn_perm(d1_, d0_, 0x07030602u); \
                const unsigned q0_ = __builtin_amdgcn_perm(d3_, d2_, 0x05010400u), q1_ = __builtin_amdgcn_perm(d3_, d2_, 0x07030602u); \
                acc[4 * k + 0] = __builtin_amdgcn_sdot4((int)__builtin_amdgcn_perm(q0_, p0_, 0x05040100u), wq_, acc[4 * k + 0], false); \
                acc[4 * k + 1] = __builtin_amdgcn_sdot4((int)__builtin_amdgcn_perm(q0_, p0_, 0x07060302u), wq_, acc[4 * k + 1], false); \
                acc[4 * k + 2] = __builtin_amdgcn_sdot4((int)__builtin_amdgcn_perm(q1_, p1_, 0x05040100u), wq_, acc[4 * k + 2], false); \
                acc[4 * k + 3] = __builtin_amdgcn_sdot4((int)__builtin_amdgcn_perm(q1_, p1_, 0x07060302u), wq_, acc[4 * k + 3], false); } } \
        int r8[8], r4[4], r2[2]; \
        _Pragma("unroll") for (int k = 0; k < 8; ++k) { const auto rr_ = __builtin_amdgcn_permlane32_swap((unsigned)acc[k], (unsigned)acc[8 + k], false, false); r8[k] = (int)rr_[0] + (int)rr_[1]; } \
        _Pragma("unroll") for (int k = 0; k < 4; ++k) { const auto rr_ = __builtin_amdgcn_permlane16_swap((unsigned)r8[k], (unsigned)r8[4 + k], false, false); r4[k] = (int)rr_[0] + (int)rr_[1]; } \
        _Pragma("unroll") for (int k = 0; k < 2; ++k) r2[k] = seli(m8, r4[2 + k], r4[k]) + dpp_r8(seli(m8, r4[k], r4[2 + k])); \
        const float z0_ = (float)r2[0] * WSC + blo(hx_), z1_ = (float)r2[1] * WSC + bhi(hx_); \
        *(GAS unsigned*)(Z + (size_t)T_ * D + (SG_) * 128 + ch * 16 + 2 * ps) = pk2(z0_, z1_); \
        const float ss_ = sum64(z0_ * z0_ + z1_ * z1_); \
        if (lane == 0) SSF[(size_t)T_ * 16 + (SG_)] = ss_; } while (0)
    v4u bufA[16], bufB[16]; v4u wA, wB; float sA, sB;
    v4u a0, a1, b0, b1, c0, c1; int at, bt, ct, ag, bg, cg;
    V_LOAD(0, a0, a1, at, ag); V_LOAD(1, b0, b1, bt, bg);
    V_ISSUE(bufA, wA, sA, a0, a1, at, ag);
    for (int q = 0; q < NQ; q += 2) {
        V_ISSUE(bufB, wB, sB, b0, b1, bt, bg);
        V_LOAD(q + 2, c0, c1, ct, cg);
        V_FINISH(bufA, wA, sA, at, ag);
        V_ISSUE(bufA, wA, sA, c0, c1, ct, cg);
        V_LOAD(q + 3, a0, a1, at, ag);
        V_FINISH(bufB, wB, sB, bt, bg);
        { const v4u t0 = a0, t1 = a1; const int tt = at, tg = ag; a0 = c0; a1 = c1; at = ct; ag = cg; b0 = t0; b1 = t1; bt = tt; bg = tg; }
    }
#undef V_LOAD
#undef V_ISSUE
#undef V_FINISH
}
__device__ __forceinline__ void final_row(const bf16* Z, const float* SSF, const float* fg, float* out, size_t tok, int lane) {
    v4u z[4];
#pragma unroll
    for (int j = 0; j < 4; ++j) z[j] = *(const GAS v4u*)(Z + tok * D + j * 512 + lane * 8);
    float ss = 0.f;
#pragma unroll
    for (int k = 0; k < 4; ++k) { const f32x4 v = *(const GAS f32x4*)(SSF + tok * 16 + 4 * k); ss += (v.x + v.y) + (v.z + v.w); }
    const float rf = 1.0f / sqrtf(ss * (1.0f / D) + EPS);
#pragma unroll
    for (int j = 0; j < 4; ++j) {
        const f32x4 ga = *(const GAS f32x4*)(fg + j * 512 + lane * 8), gb = *(const GAS f32x4*)(fg + j * 512 + lane * 8 + 4);
        *(GAS f32x4*)(out + tok * D + j * 512 + lane * 8) = (f32x4){blo(z[j][0]) * rf * ga.x, bhi(z[j][0]) * rf * ga.y, blo(z[j][1]) * rf * ga.z, bhi(z[j][1]) * rf * ga.w};
        *(GAS f32x4*)(out + tok * D + j * 512 + lane * 8 + 4) = (f32x4){blo(z[j][2]) * rf * gb.x, bhi(z[j][2]) * rf * gb.y, blo(z[j][3]) * rf * gb.z, bhi(z[j][3]) * rf * gb.w};
    }
}
}

struct Frame {
    LAS unsigned char* lds;
    volatile LAS unsigned* MISC;
    gu32* ctl;
    int tid, lane, wave, vcu, G;
};
__device__ __forceinline__ float wave_sum(float v) { return sum64(v); }
__device__ __forceinline__ void p0_transpose_item(const float* W, int K, int N, bf16* WT, const float* g0, const float* g1, int ksplit, LAS float* scr, int item, int lane) {
    const int nblk = N / 32, kb = item / nblk, nb = item % nblk, k0 = 64 * kb, n0 = 32 * nb;
#pragma unroll 16
    for (int i = 0; i < 32; ++i) { const int kk = 2 * i + (lane >> 5); const int kg = k0 + kk; const float gv = kg < ksplit ? g0[kg] : g1[kg - ksplit];
        scr[kk * 33 + (lane & 31)] = W[(size_t)kg * N + n0 + (lane & 31)] * gv; }
    LDS_WAIT(); asm volatile("" ::: "memory");
    const int c = lane & 7;
#pragma unroll
    for (int j = 0; j < 4; ++j) { const int n = (lane >> 3) + 8 * j; const LAS float* s = scr + (8 * c) * 33 + n;
        v4u o; o.x = pk2(s[0 * 33], s[1 * 33]); o.y = pk2(s[2 * 33], s[3 * 33]); o.z = pk2(s[4 * 33], s[5 * 33]); o.w = pk2(s[6 * 33], s[7 * 33]);
        *(GAS v4u*)(WT + (size_t)(n0 + n) * K + k0 + 8 * c) = o; }
    LDS_WAIT(); asm volatile("" ::: "memory");
}
__device__ __forceinline__ void p0_row_load(f32x4 (&v)[8], const float* xrow, int lane) {
    const GAS f32x4* xr = (const GAS f32x4*)xrow + lane;
#pragma unroll
    for (int j = 0; j < 8; ++j) v[j] = __builtin_nontemporal_load(xr + 64 * j);
}
__device__ __forceinline__ void p0_row_finish(const f32x4 (&v)[8], bf16* orow, float* rstd_out, int lane) {
    float s = 0.f;
#pragma unroll
    for (int j = 0; j < 8; ++j) s += (v[j].x * v[j].x + v[j].y * v[j].y) + (v[j].z * v[j].z + v[j].w * v[j].w);
    s = wave_sum(s);
    GAS unsigned long long* o8 = (GAS unsigned long long*)orow + lane;
#pragma unroll
    for (int j = 0; j < 8; ++j) o8[64 * j] = (unsigned long long)pk2(v[j].x, v[j].y) | ((unsigned long long)pk2(v[j].z, v[j].w) << 32);
    if (lane == 0) *rstd_out = 1.0f / sqrtf(s * (1.0f / D) + EPS);
}
__device__ __forceinline__ void p0_cvt8(const float* src, bf16* dst, const float* gcol, size_t idx8) {
    const f32x4 a = *(const GAS f32x4*)(src + idx8 * 8), b = *(const GAS f32x4*)(src + idx8 * 8 + 4);
    f32x4 ga = {1.f, 1.f, 1.f, 1.f}, gb = {1.f, 1.f, 1.f, 1.f};
    if (gcol) { const int c = (int)((idx8 * 8) & (D - 1)); ga = *(const GAS f32x4*)(gcol + c); gb = *(const GAS f32x4*)(gcol + c + 4); }
    v4u o; o.x = pk2(a.x * ga.x, a.y * ga.y); o.y = pk2(a.z * ga.z, a.w * ga.w); o.z = pk2(b.x * gb.x, b.y * gb.y); o.w = pk2(b.z * gb.z, b.w * gb.w);
    *(GAS v4u*)(dst + idx8 * 8) = o;
}

struct Args { const float* in[22]; float* out; unsigned char* ws; int ph_lo, ph_hi, rep_mask, pad; };

__global__ void __launch_bounds__(NWAVES * 64, 2) fwd(Args args) {
    extern __shared__ __attribute__((aligned(16))) unsigned char lds[];
    Frame F;
    F.lds = (LAS unsigned char*)lds;
    F.MISC = (volatile LAS unsigned*)(F.lds + MISC_OFF);
    F.tid = threadIdx.x; F.lane = F.tid & 63; F.wave = __builtin_amdgcn_readfirstlane(F.tid >> 6);
    F.G = gridDim.x; { const int bx = blockIdx.x; F.vcu = (F.G % 8 == 0) ? (bx % 8) * (F.G / 8) + bx / 8 : bx; }
    unsigned char* ws = args.ws;
    F.ctl = (gu32*)(ws + WS_CTL);
    for (int u = F.tid; u < (LDS_BYTES - LDSCTL_OFF) / 4; u += NWAVES * 64) ((LAS unsigned*)(F.lds + LDSCTL_OFF))[u] = 0u;
    __syncthreads();
    XcdBarrier bar = xcd_barrier_post((unsigned*)(F.ctl + CW_BAR), F.MISC + 8);
    const int lo = args.ph_lo, hi = args.ph_hi;
#define IN(k) (lo <= (k) && (k) < hi)
#define BOTH(k) (IN(k) && IN((k) + 1))
#ifndef PROBE_PH
#define PROBE_PH (-1)
#endif
#define REP(k) for (int rep_ = 0; rep_ < ((k) == PROBE_PH ? 2 : 1); ++rep_)

    const float* x = args.in[0]; const float* meta = args.in[1]; const float* norm_mix_g = args.in[2]; const float* w_in = args.in[3]; const float* b_in = args.in[4];
    const float* gn_attn_g = args.in[13]; const float* gn_lru_g = args.in[14]; const float* w_out = args.in[15]; const float* norm_ffn_g = args.in[16];
    const float* peer_wq = args.in[17]; const float* sub_keys = args.in[18]; const float* peer_u = args.in[19]; const float* peer_v = args.in[20];
    bf16* W1T = (bf16*)(ws + WS_W1T); bf16* W2T = (bf16*)(ws + WS_W2T); bf16* W3T = (bf16*)(ws + WS_W3T); bf16* SKB = (bf16*)(ws + WS_SKB);
    float* RSTD1 = (float*)(ws + WS_RSTD1);
    unsigned char* U8 = ws + WS_U8; unsigned char* V8 = ws + WS_V8; unsigned char* X8 = ws + WS_X8; float* SX = (float*)(ws + WS_SX); float* SCU = (float*)(ws + WS_SCU); float* SCV = (float*)(ws + WS_SCV);
    bf16* A1 = (bf16*)(ws + WS_A1);
    bf16* QB = (bf16*)(ws + WS_Q); bf16* KVB = (bf16*)(ws + WS_KV); bf16* XBB = (bf16*)(ws + WS_XB); bf16* GTB = (bf16*)(ws + WS_GT);

    if (IN(0)) { REP(0) {
        LAS float* scr = (LAS float*)(F.lds + RING_OFF + F.wave * 16384);
        const int gw = F.vcu * NWAVES + F.wave, NGW = F.G * NWAVES;
        constexpr int I_1 = (D / 64) * (IND / 32), I_2 = (D / 64) * (D / 32), I_3 = I_2;
        for (int it = gw; it < I_1 + I_2 + I_3; it += NGW) {
            int r = it;
            if (r < I_1) { p0_transpose_item(w_in, D, IND, W1T, norm_mix_g, norm_mix_g, D, scr, r, F.lane); continue; } r -= I_1;
            if (r < I_2) { p0_transpose_item(w_out, D, D, W2T, gn_attn_g, gn_lru_g, 1024, scr, r, F.lane); continue; } r -= I_2;
            p0_transpose_item(peer_wq, D, D, W3T, norm_ffn_g, norm_ffn_g, D, scr, r, F.lane);
        }
        {
            f32x4 cur[8], nxt[8];
            if (gw < MREAL + NMETA) p0_row_load(cur, gw < MREAL ? x + (size_t)gw * D : meta + (size_t)(gw - MREAL) * D, F.lane);
            for (int m = gw; m < MREAL + NMETA; m += NGW) {
                const int mn = m + NGW;
                if (mn < MREAL + NMETA) p0_row_load(nxt, mn < MREAL ? x + (size_t)mn * D : meta + (size_t)(mn - MREAL) * D, F.lane);
                p0_row_finish(cur, A1 + (size_t)m * D, RSTD1 + m, F.lane);
#pragma unroll
                for (int j = 0; j < 8; ++j) cur[j] = nxt[j];
            }
        }
        {
            const size_t gt = (size_t)gw * 64 + F.lane, NT = (size_t)NGW * 64;
            for (size_t i = gt; i < (size_t)(8 * 2 * 128 * 128) / 8; i += NT) p0_cvt8(sub_keys, SKB, nullptr, i);
            {
                f32x4 cur[8], nxt[8];
                constexpr int QV0 = 6144;
                if (QV0 + gw < 16384) p6::qrow_load(cur, peer_v, (size_t)(QV0 + gw), F.lane);
                for (int rj = QV0 + gw; rj < 16384; rj += NGW) {
                    const int rn = rj + NGW;
                    if (rn < 16384) p6::qrow_load(nxt, peer_v, (size_t)rn, F.lane);
                    p6::qrow_finish(cur, nullptr, V8, SCV, (size_t)rj, F.lane);
#pragma unroll
                    for (int j = 0; j < 8; ++j) cur[j] = nxt[j];
                }
            }
        } }
        if (BOTH(0)) xcd_barrier(bar);
    }
    if (IN(1)) {
        pg8::Gemm g{A1, W1T, MPAD, IND, D};
        pg8::Order1 S{F.G, (int)blockIdx.x};
        pg8::Epi1 E{QB, KVB, XBB, GTB, RSTD1, b_in};
        REP(1) pg8::gemm_phase<pg8::Epi1, pg8::Order1, true, true>(F.lds + RING_OFF, g, S, E);
        {
            volatile LAS int* qb = (volatile LAS int*)(F.lds + LDSCTL_OFF + 512);
            for (;;) {
                __syncthreads();
                if (F.tid == 0) qb[0] = (int)__hip_atomic_fetch_add((unsigned*)(F.ctl + CW_QROW), 32u, __ATOMIC_RELAXED, __HIP_MEMORY_SCOPE_AGENT);
                __syncthreads();
                const int base = qb[0];
                if (base >= 16384 + 6144) break;
                f32x4 r0[8], r1[8], r2[8], r3[8];
                const bool isu = base < 16384;
                const float* src = isu ? peer_u : peer_v; const float* gc = isu ? norm_ffn_g : nullptr; unsigned char* dst = isu ? U8 : V8; float* sc = isu ? SCU : SCV;
                const size_t e0 = (size_t)(isu ? base : base - 16384) + F.wave * 4;
                p6::qrow_load(r0, src, e0, F.lane); p6::qrow_load(r1, src, e0 + 1, F.lane); p6::qrow_load(r2, src, e0 + 2, F.lane); p6::qrow_load(r3, src, e0 + 3, F.lane);
                p6::qrow_finish(r0, gc, dst, sc, e0, F.lane); p6::qrow_finish(r1, gc, dst, sc, e0 + 1, F.lane);
                p6::qrow_finish(r2, gc, dst, sc, e0 + 2, F.lane); p6::qrow_finish(r3, gc, dst, sc, e0 + 3, F.lane);
            }
        }
        if (BOTH(1)) xcd_barrier(bar);
    }
    if (IN(2)) {
        bf16* MIX = (bf16*)(ws + WS_A1); float* SSA = (float*)(ws + WS_SSA); float* SSL = (float*)(ws + WS_SSL);
        const p2::LruP LP{args.in[6], args.in[7], args.in[8], args.in[9], args.in[10], args.in[11], args.in[12]};
        {
        REP(20) for (int u = (int)blockIdx.x; u < 256; u += F.G) p2::lru_unit(F.lds + RING_OFF, F.lds + LDSCTL_OFF + 5120, u >> 5, (u >> 1) & 15, u & 1, XBB, GTB, LP, MIX, SSL, F.tid);
        REP(21) for (int a = (int)blockIdx.x; a < 256; a += F.G) p2::attn_unit(F.lds + RING_OFF, a >> 5, (a >> 1) & 15, a & 1, QB, KVB, args.in[5], MIX, SSA, F.tid);
        }
        if (BOTH(2)) xcd_barrier(bar);
    }
    if (IN(3)) {
        bf16* MIX = (bf16*)(ws + WS_A1); const float* SSA = (const float*)(ws + WS_SSA); const float* SSL = (const float*)(ws + WS_SSL);
        bf16* H1B = (bf16*)(ws + WS_H1); float* SS2 = (float*)(ws + WS_SS2);
        pg8::Order2 S{F.G, (int)blockIdx.x};
        LAS float* tbl = (LAS float*)(F.lds + LDSCTL_OFF + 1024);
        pg8::Unit u0{0, 0};
        for (int i = 0; i < 2; ++i) {
            pg8::Unit u; if (!S.next(i, u)) break; if (i == 0) u0 = u;
            if (F.tid < 256) {
                const size_t row = (size_t)u.pm * 256 + F.tid; float sa = 0.f, sl = 0.f;
#pragma unroll
                for (int k = 0; k < 4; ++k) { const f32x4 v = *(const GAS f32x4*)(SSA + row * 16 + 4 * k); sa += (v.x + v.y) + (v.z + v.w); }
#pragma unroll
                for (int k = 0; k < 8; ++k) { const f32x4 v = *(const GAS f32x4*)(SSL + row * 32 + 4 * k); sl += (v.x + v.y) + (v.z + v.w); }
                const float ra = 1.0f / sqrtf(sa * (1.0f / 1024) + EPS), rl = 1.0f / sqrtf(sl * (1.0f / 1024) + EPS);
                tbl[(i * 256 + F.tid) * 2] = ra / rl; tbl[(i * 256 + F.tid) * 2 + 1] = rl;
            }
        }
        __syncthreads();
        pg8::Gemm g{MIX, W2T, MREAL, D, D};
        pg8::Epi2 E{H1B, x, SS2, (const LAS float*)tbl, u0.pm};
        REP(3) pg8::gemm_phase<pg8::Epi2, pg8::Order2, true, true>(F.lds + RING_OFF, g, S, E);
        if (BOTH(3)) xcd_barrier(bar);
    }
    if (IN(4)) {
        bf16* H1B = (bf16*)(ws + WS_H1); bf16* QPB = (bf16*)(ws + WS_A1);
        pg8::Order2 S{F.G, (int)blockIdx.x};
        {
            const float* SS2 = (const float*)(ws + WS_SS2); float* RSTD2 = (float*)(ws + WS_RSTD2);
            pg8::Unit u; if (S.next(0, u) && F.tid < 256) {
                const size_t row = (size_t)u.pm * 256 + F.tid; float ssq = 0.f;
#pragma unroll
                for (int k = 0; k < 8; ++k) { const f32x4 v = *(const GAS f32x4*)(SS2 + row * 32 + 4 * k); ssq += (v.x + v.y) + (v.z + v.w); }
                RSTD2[row] = 1.0f / sqrtf(ssq * (1.0f / D) + EPS);
            }
        }
        pg8::Gemm g{H1B, W3T, MREAL, D, D};
        pg8::Epi3 E{QPB};
        REP(4) pg8::gemm_phase<pg8::Epi3, pg8::Order2, true, true>(F.lds + RING_OFF, g, S, E);
        if (BOTH(4)) xcd_barrier(bar);
    }
    if (IN(5)) {
        const bf16* QPB = (const bf16*)(ws + WS_A1);
        unsigned short* IDS = (unsigned short*)(ws + WS_IDS); float* GW = (float*)(ws + WS_GW); float* RSTD2 = (float*)(ws + WS_RSTD2);
        const bf16* H1B = (const bf16*)(ws + WS_H1);
        REP(5) for (int u = (int)blockIdx.x; u < 512; u += F.G) {
            v4u xq[4][4]; const size_t tb = (size_t)(u >> 3) * 256 + F.wave * 32 + (u & 7);
#pragma unroll
            for (int k = 0; k < 4; ++k) p6::qx_load(xq[k], H1B, tb + 8 * k, F.lane);
            p5::retr_unit(F.lds + RING_OFF, u & 7, u >> 3, QPB, SKB, IDS, GW, RSTD2, F.tid);
#pragma unroll
            for (int k = 0; k < 4; ++k) p6::qx_finish(xq[k], X8, SX, tb + 8 * k, F.lane);
        }
        if (BOTH(5)) xcd_barrier(bar);
    }
    {
        const bf16* H1B = (const bf16*)(ws + WS_H1); const unsigned short* IDS = (const unsigned short*)(ws + WS_IDS); const float* GW = (const float*)(ws + WS_GW);
        const float* RSTD2 = (const float*)(ws + WS_RSTD2); bf16* PART = (bf16*)(ws + WS_PART); unsigned char* W8 = ws + WS_W; float* WS8 = (float*)(ws + WS_WSUM); bf16* ZB = (bf16*)(ws + WS_Z); float* SSF = (float*)(ws + WS_SSL);
        const int slot = (int)blockIdx.x & 7, rank = (int)blockIdx.x >> 3, nrank = (F.G - slot + 7) >> 3;
        const int gw = F.vcu * NWAVES + F.wave, NGW = F.G * NWAVES;
        if (IN(6)) { REP(6) p6::usweep(X8, SX, U8, IDS, PART, slot, rank, nrank, F.wave, F.lane); if (BOTH(6)) xcd_barrier(bar); }
        if (IN(7)) { REP(7) p6::wreduce(PART, GW, RSTD2, IDS, SCU, SCV, W8, WS8, (size_t)gw * 64 + F.lane, (size_t)NGW * 64); if (BOTH(7)) xcd_barrier(bar); }
        if (IN(8)) { REP(8) p6::vsweep(H1B, V8, IDS, W8, WS8, ZB, SSF, slot, rank, nrank, F.wave, F.lane); if (BOTH(8)) xcd_barrier(bar); }
        if (PROBE_PH == 30) { for (int k = 0; k < 16; ++k) xcd_barrier(bar); }
        if (IN(9)) { REP(9) for (int t = gw; t < MREAL; t += NGW) p6::final_row(ZB, SSF, args.in[21], args.out, (size_t)t, F.lane); }
    }
#undef IN
#undef BOTH
}

extern "C" void kernel_launch(void* const* d_in, const int* in_sizes, int n_in, void* d_out, int out_size, void* d_ws, size_t ws_size, hipStream_t stream) {
    static int grid = 0;
    if (grid == 0) {
        int dev = 0, cus = 0;
        if (hipGetDevice(&dev) != hipSuccess || hipDeviceGetAttribute(&cus, hipDeviceAttributeMultiprocessorCount, dev) != hipSuccess) { fprintf(stderr, "kernel_launch: device query failed\n"); grid = -1; return; }
        if (hipFuncSetAttribute((const void*)fwd, hipFuncAttributeMaxDynamicSharedMemorySize, LDS_BYTES) != hipSuccess) { fprintf(stderr, "kernel_launch: hipFuncSetAttribute failed\n"); grid = -1; return; }
        int per_cu = 0;
        if (hipOccupancyMaxActiveBlocksPerMultiprocessor(&per_cu, (const void*)fwd, NWAVES * 64, LDS_BYTES) != hipSuccess || per_cu < 1) fprintf(stderr, "kernel_launch: occupancy query says %d\n", per_cu);
        (void)hipGetLastError();
        grid = cus;
        if (cus != 256) { fprintf(stderr, "kernel_launch: built for a 256-CU device (tile-to-workgroup maps of the GEMM phases), found %d CUs; nothing launched\n", cus); grid = -1; return; }
        if (ws_size < WS_END) { fprintf(stderr, "kernel_launch: ws too small %zu\n", ws_size); grid = -1; return; }
    }
    if (grid < 0) return;
    (void)hipMemsetAsync((char*)d_ws + WS_CTL, 0, CTL_ZERO_BYTES, stream);
    Args a{};
    for (int i = 0; i < 22; ++i) a.in[i] = (const float*)d_in[i];
    a.out = (float*)d_out; a.ws = (unsigned char*)d_ws; a.ph_lo = 0; a.ph_hi = 10;
    hipLaunchKernelGGL(fwd, dim3(grid), dim3(NWAVES * 64), LDS_BYTES, stream, a);
}
```

```cpp
#include <hip/hip_runtime.h>
#include <cstdio>
#include <cstdint>
#include <math.h>

#define D 2048
#define NB 8
#define SEQ 2048
#define NMETA 16
#define TT (SEQ + NMETA)
#define MR (NB * TT)
#define MREAL (NB * SEQ)
#define MPAD (MREAL + 256)
#define QD 1024
#define KVD 128
#define LW 1024
#define IND 3328
#define EPS 1e-6f
#define QSCALE (0.125f * 1.4426950408889634f)
#define GAS __attribute__((address_space(1)))
#define LAS __attribute__((address_space(3)))

#define DPP_I(x, ctrl) __builtin_amdgcn_update_dpp(0, (x), (ctrl), 0xf, 0xf, true)
__device__ __forceinline__ int dpp_x1(int x) { return DPP_I(x, 0xB1); }
__device__ __forceinline__ int dpp_x2(int x) { return DPP_I(x, 0x4E); }
__device__ __forceinline__ int dpp_hm(int x) { return DPP_I(x, 0x141); }
__device__ __forceinline__ int dpp_rm(int x) { return DPP_I(x, 0x140); }
__device__ __forceinline__ int dpp_r8(int x) { return DPP_I(x, 0x128); }
__device__ __forceinline__ float fdpp_x1(float x) { return __builtin_bit_cast(float, dpp_x1(__builtin_bit_cast(int, x))); }
__device__ __forceinline__ float fdpp_x2(float x) { return __builtin_bit_cast(float, dpp_x2(__builtin_bit_cast(int, x))); }
__device__ __forceinline__ float fdpp_hm(float x) { return __builtin_bit_cast(float, dpp_hm(__builtin_bit_cast(int, x))); }
__device__ __forceinline__ float fdpp_rm(float x) { return __builtin_bit_cast(float, dpp_rm(__builtin_bit_cast(int, x))); }
__device__ __forceinline__ float max16(float v) { v = fmaxf(v, fdpp_x1(v)); v = fmaxf(v, fdpp_x2(v)); v = fmaxf(v, fdpp_hm(v)); return fmaxf(v, fdpp_rm(v)); }
__device__ __forceinline__ float sum64(float v) {
    v += fdpp_x1(v); v += fdpp_x2(v); v += fdpp_hm(v); v += fdpp_rm(v);
    return (__builtin_bit_cast(float, __builtin_amdgcn_readlane(__builtin_bit_cast(int, v), 0)) + __builtin_bit_cast(float, __builtin_amdgcn_readlane(__builtin_bit_cast(int, v), 16)))
         + (__builtin_bit_cast(float, __builtin_amdgcn_readlane(__builtin_bit_cast(int, v), 32)) + __builtin_bit_cast(float, __builtin_amdgcn_readlane(__builtin_bit_cast(int, v), 48)));
}
__device__ __forceinline__ float max64(float v) {
    v = max16(v);
    return fmaxf(fmaxf(__builtin_bit_cast(float, __builtin_amdgcn_readlane(__builtin_bit_cast(int, v), 0)), __builtin_bit_cast(float, __builtin_amdgcn_readlane(__builtin_bit_cast(int, v), 16))),
                 fmaxf(__builtin_bit_cast(float, __builtin_amdgcn_readlane(__builtin_bit_cast(int, v), 32)), __builtin_bit_cast(float, __builtin_amdgcn_readlane(__builtin_bit_cast(int, v), 48))));
}
__device__ __forceinline__ float sum8(float v) { v += fdpp_x1(v); v += fdpp_x2(v); return v + fdpp_hm(v); }
__device__ __forceinline__ float sum4(float v) { v += fdpp_x1(v); return v + fdpp_x2(v); }
__device__ __forceinline__ float sum_x32(float v) { return v + __shfl_xor(v, 32); }
__device__ __forceinline__ float max_x32(float v) { return fmaxf(v, __shfl_xor(v, 32)); }
__device__ __forceinline__ float sum_x16(float v) { return v + __shfl_xor(v, 16); }
namespace pg8 {
#define PG8_LAS __attribute__((address_space(3)))
typedef unsigned short bf16_t;
typedef short bf16x8 __attribute__((ext_vector_type(8)));
typedef float f32x4 __attribute__((ext_vector_type(4)));
typedef unsigned u32x4 __attribute__((ext_vector_type(4)));
constexpr int BM = 256, BK = 64, HALF = 128, HTB = HALF * BK * 2  , STAGE_BYTES = 8 * HTB, NXCD = 8, WGM = 8;

__host__ __device__ __forceinline__ int lds_byte(int r, int c) { const int st = (r >> 4) * 2 + (c >> 5), rr = r & 15, cc = c & 31, ob = rr * 64 + cc * 2; return st * 1024 + (ob ^ (((ob >> 9) & 1) << 5)); }
__host__ __device__ __forceinline__ void stage_rc(int b, int& R, int& C) { const int st = b / 1024, sb = b % 1024, swz = sb ^ (((sb >> 9) & 1) << 5); R = (st >> 1) * 16 + swz / 64; C = (st & 1) * 32 + (swz % 64) / 2; }
__host__ __device__ __forceinline__ int perm32(int rho) { const int n = rho >> 4, i = rho & 15; return 8 * (i >> 2) + 4 * n + (i & 3); }

struct Unit { int pm, pn; };
struct Gemm { const bf16_t* A; const bf16_t* Bt; int M, N, K; };

struct StaticOrder {
    int nM, nN, nwg, G, c;
    __host__ __device__ void init(int M, int N, int G_, int c_) { nM = M / BM; nN = N / BM; nwg = nM * nN; G = G_; c = c_; }
    __host__ __device__ bool next(int i, Unit& u) const {
        const long L = (long)i * G + c; if (L >= nwg) return false;
        int wgid = (int)L; { const int q = nwg / NXCD, r = nwg % NXCD, xcd = wgid % NXCD, off = wgid / NXCD; wgid = (xcd < r ? xcd * (q + 1) : r * (q + 1) + (xcd - r) * q) + off; }
        const int nig = WGM * nN, gid = wgid / nig, fm = gid * WGM, gsz = (nM - fm) < WGM ? (nM - fm) : WGM;
        u.pm = fm + ((wgid % nig) % gsz); u.pn = (wgid % nig) / gsz; return true;
    }
    __device__ __forceinline__ void a_ready(const Unit&) const {}
    __device__ __forceinline__ void done(const Unit&) const {}
};

__device__ __forceinline__ unsigned cvt_pk_bf16(float lo, float hi) { unsigned r; asm volatile("v_cvt_pk_bf16_f32 %0, %1, %2" : "=v"(r) : "v"(lo), "v"(hi)); return r; }
typedef unsigned u32x2 __attribute__((ext_vector_type(2)));
struct Order1 {
    int G, c;
    __device__ __forceinline__ bool next(int i, Unit& u) const {
        const int L = i * G + c; if (L >= 837) return false;
        if (L >= 832) { u.pm = 64; u.pn = 4 + (L - 832); return true; }
        const int nwg = 832, nN = 13;
        int wgid = L; { const int q = nwg / NXCD, xcd = wgid % NXCD, off = wgid / NXCD; wgid = xcd * q + off; }
        const int nig = WGM * nN, gid = wgid / nig, fm = gid * WGM;
        u.pm = fm + ((wgid % nig) % WGM); u.pn = (wgid % nig) / WGM; return true;
    }
    __device__ __forceinline__ void a_ready(const Unit&) const {}
    __device__ __forceinline__ void done(const Unit&) const {}
};
struct Order2 {
    int G, c;
    __device__ __forceinline__ bool next(int i, Unit& u) const {
        const int L = i * G + c; if (L >= 512) return false;
        const int nwg = 512, nN = 8;
        int wgid = L; { const int q = nwg / NXCD, xcd = wgid % NXCD, off = wgid / NXCD; wgid = xcd * q + off; }
        const int nig = WGM * nN, gid = wgid / nig, fm = gid * WGM;
        u.pm = fm + ((wgid % nig) % WGM); u.pn = (wgid % nig) / WGM; return true;
    }
    __device__ __forceinline__ void a_ready(const Unit&) const {}
    __device__ __forceinline__ void done(const Unit&) const {}
};

struct Epi1 {
    static constexpr bool PERM = true, AFTER_DRAIN = false, MIDK = false;
    bf16_t *Q, *KV, *XB, *GT; const float* rstd; const float* bias;
    __device__ __forceinline__ void midk(f32x4 (&acc)[2][2][4][2], const Unit& u, int wr, int wc, int fr, int fq) const {}
    __device__ __forceinline__ void operator()(const f32x4 (&acc)[2][2][4][2], const Unit& u, int wr, int wc, int fr, int fq) const {
        const int row0 = u.pm * BM + wr * 64 + fr;
        bf16_t* base; int ldc, colb; float sc = 1.f;
        if (u.pn < 4) { base = Q; ldc = 1024; colb = u.pn * BM; sc = QSCALE; }
        else if (u.pn == 4) { base = KV; ldc = 256; colb = 0; }
        else if (u.pn < 9) { base = XB; ldc = 1024; colb = (u.pn - 5) * BM; }
        else { base = GT; ldc = 1024; colb = (u.pn - 9) * BM; }
        const int col0 = colb + wc * 32 + 8 * fq, bcol0 = u.pn * BM + wc * 32 + 8 * fq;
        f32x4 bv[2][2];
#pragma unroll
        for (int bj = 0; bj < 2; ++bj)
#pragma unroll
            for (int n = 0; n < 2; ++n) bv[bj][n] = *(const f32x4*)(bias + bcol0 + bj * HALF + 4 * n);
#pragma unroll
        for (int ai = 0; ai < 2; ++ai)
#pragma unroll
            for (int m = 0; m < 4; ++m) {
                const int row = row0 + ai * HALF + m * 16; const float rs = rstd[row];
                bf16_t* rowp = base + (size_t)row * ldc + col0;
#pragma unroll
                for (int bj = 0; bj < 2; ++bj) {
                    f32x4 v0 = (acc[ai][bj][m][0] * rs + bv[bj][0]) * sc, v1 = (acc[ai][bj][m][1] * rs + bv[bj][1]) * sc;
                    u32x4 w; w.x = cvt_pk_bf16(v0[0], v0[1]); w.y = cvt_pk_bf16(v0[2], v0[3]); w.z = cvt_pk_bf16(v1[0], v1[1]); w.w = cvt_pk_bf16(v1[2], v1[3]);
                    *(u32x4*)(rowp + bj * HALF) = w; } }
    }
};
struct Epi2 {
    static constexpr bool PERM = true, AFTER_DRAIN = false, MIDK = true;
    bf16_t* H1; const float* x; float* SS2; const LAS float* tbl; int pm0;
    __device__ __forceinline__ void midk(f32x4 (&acc)[2][2][4][2], const Unit& u, int wr, int wc, int fr, int fq) const {
        const LAS float* t = tbl + (u.pm == pm0 ? 0 : 512);
#pragma unroll
        for (int ai = 0; ai < 2; ++ai)
#pragma unroll
            for (int m = 0; m < 4; ++m) { const float ra = t[(ai * HALF + wr * 64 + m * 16 + fr) * 2];
#pragma unroll
                for (int bj = 0; bj < 2; ++bj)
#pragma unroll
                    for (int n = 0; n < 2; ++n) acc[ai][bj][m][n] = acc[ai][bj][m][n] * ra; }
    }
    __device__ __forceinline__ void operator()(const f32x4 (&acc)[2][2][4][2], const Unit& u, int wr, int wc, int fr, int fq) const {
        const LAS float* t = tbl + (u.pm == pm0 ? 0 : 512);
        const int col0 = u.pn * BM + wc * 32 + 8 * fq;
#pragma unroll
        for (int ai = 0; ai < 2; ++ai)
#pragma unroll
            for (int m = 0; m < 4; ++m) {
                const int rl = ai * HALF + wr * 64 + m * 16 + fr; const size_t row = (size_t)u.pm * BM + rl; const float rs = t[rl * 2 + 1];
                float ss = 0.f;
#pragma unroll
                for (int bj = 0; bj < 2; ++bj) {
                    const f32x4 x0 = *(const f32x4*)(x + row * 2048 + col0 + bj * HALF), x1 = *(const f32x4*)(x + row * 2048 + col0 + bj * HALF + 4);
                    const f32x4 v0 = acc[ai][bj][m][0] * rs + x0, v1 = acc[ai][bj][m][1] * rs + x1;
                    ss += (v0[0] * v0[0] + v0[1] * v0[1]) + (v0[2] * v0[2] + v0[3] * v0[3]) + (v1[0] * v1[0] + v1[1] * v1[1]) + (v1[2] * v1[2] + v1[3] * v1[3]);
                    u32x4 w; w.x = cvt_pk_bf16(v0[0], v0[1]); w.y = cvt_pk_bf16(v0[2], v0[3]); w.z = cvt_pk_bf16(v1[0], v1[1]); w.w = cvt_pk_bf16(v1[2], v1[3]);
                    *(u32x4*)(H1 + row * 2048 + col0 + bj * HALF) = w; }
                ss = sum_x32(sum_x16(ss));
                if (fq == 0) SS2[row * 32 + u.pn * 4 + wc] = ss;
            }
    }
};
struct Epi3 {
    static constexpr bool PERM = true, AFTER_DRAIN = false, MIDK = false;
    bf16_t* O;
    __device__ __forceinline__ void midk(f32x4 (&acc)[2][2][4][2], const Unit& u, int wr, int wc, int fr, int fq) const {}
    __device__ __forceinline__ void operator()(const f32x4 (&acc)[2][2][4][2], const Unit& u, int wr, int wc, int fr, int fq) const {
        const int col0 = u.pn * BM + wc * 32 + 8 * fq;
#pragma unroll
        for (int ai = 0; ai < 2; ++ai)
#pragma unroll
            for (int m = 0; m < 4; ++m) { const size_t row = (size_t)u.pm * BM + ai * HALF + wr * 64 + m * 16 + fr;
#pragma unroll
                for (int bj = 0; bj < 2; ++bj) { const f32x4 v0 = acc[ai][bj][m][0], v1 = acc[ai][bj][m][1];
                    u32x4 w; w.x = cvt_pk_bf16(v0[0], v0[1]); w.y = cvt_pk_bf16(v0[2], v0[3]); w.z = cvt_pk_bf16(v1[0], v1[1]); w.w = cvt_pk_bf16(v1[2], v1[3]);
                    *(u32x4*)(O + row * 2048 + col0 + bj * HALF) = w; } }
    }
};
template <class Epi, class Sched, bool ALIGN_EPI = false, bool SP2 = false>
__device__ __forceinline__ void gemm_phase(PG8_LAS unsigned char* lds, const Gemm g, const Sched& S, const Epi& E) {
    const int tid = threadIdx.x, wid = __builtin_amdgcn_readfirstlane(tid >> 6), lane = tid & 63, wr = wid >> 2, wc = wid & 3, fr = lane & 15, fq = lane >> 4;
    const int K = g.K, nt = K / BK;
    unsigned voffA[2], voffB[2];
#pragma unroll
    for (int i = 0; i < 2; ++i) { int R, C; stage_rc(tid * 16 + i * 8192, R, C); const int Rb = Epi::PERM ? ((R & ~31) + perm32(R & 31)) : R;
        voffA[i] = (unsigned)(R * K + C) * 2u; voffB[i] = (unsigned)(Rb * K + C) * 2u; }
    const size_t kstep = (size_t)(BK * 2);
    const size_t hstep = (size_t)HALF * K * 2;
    const size_t tstep = 2 * hstep;
    const unsigned ldsw = (unsigned)wid * 1024u;
    const int aoff = lds_byte(wr * 64 + fr, fq * 8), boff = lds_byte(wc * 32 + fr, fq * 8);
#define PG8_SA(b, h) (((b) * 2 + (h)) * HTB)
#define PG8_SB(b, h) ((4 + (b) * 2 + (h)) * HTB)
#define PG8_STAGE(bufoff, gbase, voff) do { _Pragma("unroll") for (int _i = 0; _i < 2; ++_i) \
        __builtin_amdgcn_global_load_lds((const unsigned*)((const char*)(gbase) + (voff)[_i]), (PG8_LAS unsigned*)(lds + (bufoff) + ldsw + _i * 8192), 16, 0, 0); } while (0)
#define PG8_LDA(dst, b, h) do { _Pragma("unroll") for (int m = 0; m < 4; ++m) _Pragma("unroll") for (int k = 0; k < 2; ++k) dst[m][k] = *(const PG8_LAS bf16x8*)(lds + PG8_SA(b, h) + aoff + m * 2048 + k * 1024); } while (0)
#define PG8_LDB(dst, b, h) do { _Pragma("unroll") for (int n = 0; n < 2; ++n) _Pragma("unroll") for (int k = 0; k < 2; ++k) dst[n][k] = *(const PG8_LAS bf16x8*)(lds + PG8_SB(b, h) + boff + n * 2048 + k * 1024); } while (0)
#define PG8_MMA(ai, bj, At, Bt) do { __builtin_amdgcn_s_setprio(1); _Pragma("unroll") for (int m = 0; m < 4; ++m) _Pragma("unroll") for (int n = 0; n < 2; ++n) _Pragma("unroll") for (int k = 0; k < 2; ++k) \
        acc[ai][bj][m][n] = __builtin_amdgcn_mfma_f32_16x16x32_bf16(Bt[n][k], At[m][k], acc[ai][bj][m][n], 0, 0, 0); __builtin_amdgcn_s_setprio(0); } while (0)
#define PG8_WAIT_V(n) asm volatile("s_waitcnt vmcnt(" #n ")" ::: "memory")
#define PG8_WAIT_L(n) asm volatile("s_waitcnt lgkmcnt(" #n ")" ::: "memory")
#define PG8_BAR __builtin_amdgcn_s_barrier()
#define PG8_SCHED __builtin_amdgcn_sched_barrier(0)
    Unit cur, nxt; int ui = 0;
    if (!S.next(0, cur)) return;
    f32x4 acc[2][2][4][2];
#pragma unroll
    for (int a = 0; a < 2; ++a)
#pragma unroll
        for (int b = 0; b < 2; ++b)
#pragma unroll
            for (int m = 0; m < 4; ++m)
#pragma unroll
                for (int n = 0; n < 2; ++n) acc[a][b][m][n] = (f32x4){0.f, 0.f, 0.f, 0.f};
    bf16x8 At[4][2], B0[2][2], B1[2][2];
    const char* cA = (const char*)g.A + (size_t)cur.pm * tstep; const char* cB = (const char*)g.Bt + (size_t)cur.pn * tstep;
    S.a_ready(cur);
    if constexpr (SP2) {
        PG8_STAGE(PG8_SB(0, 0), cB, voffB); PG8_STAGE(PG8_SB(0, 1), cB + hstep, voffB); PG8_STAGE(PG8_SA(0, 0), cA, voffA); PG8_STAGE(PG8_SA(0, 1), cA + hstep, voffA);
        if (wr == 1) PG8_BAR;
        PG8_WAIT_V(2); PG8_BAR;
        PG8_STAGE(PG8_SB(1, 0), cB + kstep, voffB); PG8_STAGE(PG8_SA(1, 0), cA + kstep, voffA); PG8_STAGE(PG8_SB(1, 1), cB + hstep + kstep, voffB);
        PG8_WAIT_V(6); PG8_BAR;
    } else {
        PG8_STAGE(PG8_SB(0, 0), cB, voffB); PG8_STAGE(PG8_SA(0, 0), cA, voffA); PG8_STAGE(PG8_SB(0, 1), cB + hstep, voffB); PG8_STAGE(PG8_SA(0, 1), cA + hstep, voffA);
        if (wr == 1) PG8_BAR;
        PG8_WAIT_V(4); PG8_BAR;
        PG8_STAGE(PG8_SB(1, 0), cB + kstep, voffB); PG8_STAGE(PG8_SA(1, 0), cA + kstep, voffA); PG8_STAGE(PG8_SB(1, 1), cB + hstep + kstep, voffB);
        PG8_WAIT_V(6); PG8_BAR;
    }
    for (;;) {
        const bool has_next = S.next(ui + 1, nxt);
        const char* nA = has_next ? (const char*)g.A + (size_t)nxt.pm * tstep : cA; const char* nB = has_next ? (const char*)g.Bt + (size_t)nxt.pn * tstep : cB;
        for (int t = 0; t < nt; t += 2) {
            if constexpr (Epi::MIDK) { if (t == nt / 2) E.midk(acc, cur, wr, wc, fr, fq); }
            const bool last = (t == nt - 2);
            const char* a1 = cA + (size_t)(t + 1) * kstep;
            const char* a2 = last ? nA : cA + (size_t)(t + 2) * kstep; const char* b2 = last ? nB : cB + (size_t)(t + 2) * kstep;
            const char* a3 = a2 + kstep; const char* b3 = b2 + kstep;
            if (last && has_next) S.a_ready(nxt);
            if constexpr (SP2) {
            PG8_LDB(B0, 0, 0); PG8_LDB(B1, 0, 1); PG8_SCHED; PG8_LDA(At, 0, 0); PG8_STAGE(PG8_SA(1, 1), a1 + hstep, voffA);
            PG8_WAIT_V(8); PG8_WAIT_L(0); PG8_BAR; PG8_MMA(0, 0, At, B0); PG8_MMA(0, 1, At, B1); PG8_BAR; PG8_SCHED;
            PG8_LDA(At, 0, 1); PG8_STAGE(PG8_SB(0, 0), b2, voffB); PG8_STAGE(PG8_SB(0, 1), b2 + hstep, voffB); PG8_STAGE(PG8_SA(0, 0), a2, voffA);
            PG8_WAIT_V(8); PG8_WAIT_L(0); PG8_BAR; PG8_MMA(1, 0, At, B0); PG8_MMA(1, 1, At, B1); PG8_BAR; PG8_SCHED;
            PG8_LDB(B0, 1, 0); PG8_LDB(B1, 1, 1); PG8_SCHED; PG8_LDA(At, 1, 0); PG8_STAGE(PG8_SA(0, 1), a2 + hstep, voffA);
            PG8_WAIT_V(8); PG8_WAIT_L(0); PG8_BAR; PG8_MMA(0, 0, At, B0); PG8_MMA(0, 1, At, B1); PG8_BAR; PG8_SCHED;
            PG8_LDA(At, 1, 1); PG8_STAGE(PG8_SB(1, 0), b3, voffB); PG8_STAGE(PG8_SB(1, 1), b3 + hstep, voffB); PG8_STAGE(PG8_SA(1, 0), a3, voffA);
            PG8_WAIT_V(8); PG8_WAIT_L(0); PG8_BAR; PG8_MMA(1, 0, At, B0); PG8_MMA(1, 1, At, B1); PG8_BAR; PG8_SCHED;
            } else {
            PG8_LDB(B0, 0, 0); PG8_SCHED; PG8_LDA(At, 0, 0); PG8_STAGE(PG8_SA(1, 1), a1 + hstep, voffA);
            PG8_WAIT_L(8); PG8_BAR; PG8_WAIT_L(0); PG8_MMA(0, 0, At, B0); PG8_BAR; PG8_SCHED;
            PG8_LDB(B1, 0, 1); PG8_STAGE(PG8_SB(0, 0), b2, voffB);
            PG8_BAR; PG8_WAIT_L(0); PG8_MMA(0, 1, At, B1); PG8_BAR;
            PG8_LDA(At, 0, 1); PG8_STAGE(PG8_SA(0, 0), a2, voffA);
            PG8_BAR; PG8_WAIT_L(0); PG8_MMA(1, 0, At, B0); PG8_BAR; PG8_SCHED;
            PG8_STAGE(PG8_SB(0, 1), b2 + hstep, voffB);
            PG8_WAIT_V(6); PG8_BAR; PG8_MMA(1, 1, At, B1); PG8_BAR;
            PG8_LDB(B0, 1, 0); PG8_SCHED; PG8_LDA(At, 1, 0); PG8_STAGE(PG8_SA(0, 1), a2 + hstep, voffA);
            PG8_WAIT_L(8); PG8_BAR; PG8_WAIT_L(0); PG8_MMA(0, 0, At, B0); PG8_BAR; PG8_SCHED;
            PG8_LDB(B1, 1, 1); PG8_STAGE(PG8_SB(1, 0), b3, voffB);
            PG8_BAR; PG8_WAIT_L(0); PG8_MMA(0, 1, At, B1); PG8_BAR;
            PG8_LDA(At, 1, 1); PG8_STAGE(PG8_SA(1, 0), a3, voffA);
            PG8_BAR; PG8_WAIT_L(0); PG8_MMA(1, 0, At, B0); PG8_BAR; PG8_SCHED;
            PG8_STAGE(PG8_SB(1, 1), b3 + hstep, voffB);
            PG8_WAIT_V(6); PG8_BAR; PG8_MMA(1, 1, At, B1); PG8_BAR;
            }
        }
        if constexpr (ALIGN_EPI) { if (wr == 0) PG8_BAR; }
        if constexpr (!Epi::AFTER_DRAIN) { E(acc, cur, wr, wc, fr, fq); S.done(cur); }
        if (!has_next) break;
#pragma unroll
        for (int a = 0; a < 2; ++a)
#pragma unroll
            for (int b = 0; b < 2; ++b)
#pragma unroll
                for (int m = 0; m < 4; ++m)
#pragma unroll
                    for (int n = 0; n < 2; ++n) acc[a][b][m][n] = (f32x4){0.f, 0.f, 0.f, 0.f};
        cur = nxt; cA = nA; cB = nB; ++ui;
        if constexpr (ALIGN_EPI) { if (wr == 1) PG8_BAR; }
    }
    PG8_WAIT_V(0);
    if constexpr (!ALIGN_EPI) { if (wr == 0) PG8_BAR; }
    PG8_BAR;
    if constexpr (Epi::AFTER_DRAIN) { E.fused(acc, cur, wr, wc, fr, fq, lds, wid, lane); S.done(cur); }
#undef PG8_SA
#undef PG8_SB
#undef PG8_STAGE
#undef PG8_LDA
#undef PG8_LDB
#undef PG8_MMA
#undef PG8_WAIT_V
#undef PG8_WAIT_L
#undef PG8_BAR
#undef PG8_SCHED
}
}
#define XB_TMO      128
#define XB_XCNT(j)  (256  + 64 * (j))
#define XB_XSUB(j)  (1280 + 64 * (j))
#define XB_XGEN(j)  (2304 + 64 * (j))
#define XB_TOP      3328
#define XB_TOPGEN   3392
#define XCD_BAR_WORDS 3456
#define XB_SPIN_CAP (1u << 18)

__device__ __forceinline__ unsigned xb_ld(unsigned* p)              { return __hip_atomic_load(p, __ATOMIC_RELAXED, __HIP_MEMORY_SCOPE_AGENT); }
__device__ __forceinline__ unsigned xb_add(unsigned* p, unsigned v) { return __hip_atomic_fetch_add(p, v, __ATOMIC_RELAXED, __HIP_MEMORY_SCOPE_AGENT); }
__device__ __forceinline__ unsigned xb_xcc_id() { return (unsigned)__builtin_amdgcn_s_getreg((3 << 11) | 20) & 0xFu; }
#define XB_SPIN(cond, bar) do { unsigned _sp = 0; while (cond) { __builtin_amdgcn_s_sleep(1); \
    if ((++_sp & 255u) == 0u) { if (xb_ld(&(bar)[XB_TMO])) break; if (_sp > XB_SPIN_CAP) { atomicAdd(&(bar)[XB_TMO], 1u); break; } } } } while (0)

struct XcdBarrier {
    unsigned* bar; unsigned x;
    volatile LAS unsigned* st;
};

__device__ __forceinline__ XcdBarrier xcd_barrier_post(unsigned* bar, volatile LAS unsigned* st) {
    XcdBarrier b; b.bar = bar; b.x = xb_xcc_id(); b.st = st;
    if (threadIdx.x == 0) (void)xb_add(&bar[XB_XCNT(b.x)], 1u);
    return b;
}
__device__ __forceinline__ void xcd_barrier_complete(unsigned* bar, unsigned x, unsigned& nloc, unsigned& nx) {
    const unsigned G = gridDim.x * gridDim.y * gridDim.z;
    unsigned sum, cnt, mine, sp = 0u;
    for (;;) {
        sum = 0u; cnt = 0u; mine = 0u;
#pragma unroll
        for (unsigned j = 0; j < 16; ++j) { const unsigned c = xb_ld(&bar[XB_XCNT(j)]); sum += c; cnt += (c > 0u) ? 1u : 0u; mine = (j == x) ? c : mine; }
        if (sum == G) break;
        __builtin_amdgcn_s_sleep(1);
        if ((++sp & 255u) == 0u) { if (xb_ld(&bar[XB_TMO])) break; if (sp > XB_SPIN_CAP) { atomicAdd(&bar[XB_TMO], 1u); break; } }
    }
    nloc = mine > 0u ? mine : 1u; nx = cnt > 0u ? cnt : 1u;
}

__device__ __forceinline__ void xcd_barrier(const XcdBarrier& b) {
    asm volatile("s_waitcnt vmcnt(0)" ::: "memory");
    __syncthreads();
    if (threadIdx.x == 0) {
        unsigned* bar = b.bar;
        __builtin_amdgcn_s_waitcnt(0);
        unsigned nloc = b.st[0], nx = b.st[1];
        if (nloc == 0u) { xcd_barrier_complete(bar, b.x, nloc, nx); b.st[0] = nloc; b.st[1] = nx; }
        const unsigned old = xb_add(&bar[XB_XSUB(b.x)], 1u);
        const unsigned gen = old / nloc;
        if (old + 1u == (gen + 1u) * nloc) {
            __builtin_amdgcn_fence(__ATOMIC_RELEASE, "agent");
            asm volatile("s_waitcnt vmcnt(0)" ::: "memory");
            const unsigned og = xb_add(&bar[XB_TOP], 1u);
            const unsigned tg = og / nx;
            if (og + 1u == (tg + 1u) * nx) xb_add(&bar[XB_TOPGEN], 1u);
            else XB_SPIN(xb_ld(&bar[XB_TOPGEN]) == tg, bar);
            __builtin_amdgcn_fence(__ATOMIC_ACQUIRE, "agent");
            xb_add(&bar[XB_XGEN(b.x)], 1u);
            asm volatile("s_waitcnt vmcnt(0)" ::: "memory");
        } else {
            XB_SPIN(xb_ld(&bar[XB_XGEN(b.x)]) == gen, bar);
            __builtin_amdgcn_fence(__ATOMIC_ACQUIRE, "agent");
            asm volatile("s_waitcnt vmcnt(0)" ::: "memory");
        }
    }
    __syncthreads();
}

constexpr int NWAVES = 8;
constexpr size_t MiB = 1u << 20;
constexpr size_t WS_CTL = 0, CTL_ZERO_BYTES = 1 * MiB;
constexpr size_t WS_W1T = 2 * MiB;
constexpr size_t WS_W2T = 16 * MiB;
constexpr size_t WS_W3T = 24 * MiB;
constexpr size_t WS_SKB = 32 * MiB;
constexpr size_t WS_RSTD1 = 33 * MiB;
constexpr size_t WS_SSA = 34 * MiB;
constexpr size_t WS_SSL = 35 * MiB;
constexpr size_t WS_SS2 = 37 * MiB;
constexpr size_t WS_RSTD2 = 39 * MiB;
constexpr size_t WS_IDS = 40 * MiB;
constexpr size_t WS_GW = 48 * MiB;
constexpr size_t WS_U8 = 64 * MiB;
constexpr size_t WS_V8 = 96 * MiB;
constexpr size_t WS_X8 = 128 * MiB;
constexpr size_t WS_SX = 160 * MiB;
constexpr size_t WS_SCU = 162 * MiB;
constexpr size_t WS_SCV = 163 * MiB;
constexpr size_t WS_WSUM = 164 * MiB;
constexpr size_t WS_A1 = 192 * MiB;
constexpr size_t WS_Q = 258 * MiB;
constexpr size_t WS_KV = 290 * MiB;
constexpr size_t WS_XB = 299 * MiB;
constexpr size_t WS_GT = 332 * MiB;
constexpr size_t WS_H1 = 364 * MiB;
constexpr size_t WS_PART = 192 * MiB;
constexpr size_t WS_W = 56 * MiB;
constexpr size_t WS_Z = 428 * MiB;
constexpr size_t WS_END = 492 * MiB;
constexpr int CW_QROW = 2048;
constexpr int CW_BAR = 4096;

constexpr int RING_OFF = 0, RING_BYTES = 131072;
constexpr int LDSCTL_OFF = RING_BYTES, MISC_OFF = LDSCTL_OFF + 320;
constexpr int LDS_BYTES = 147456;

typedef unsigned short bf16;
typedef unsigned v4u __attribute__((ext_vector_type(4)));
typedef float f32x4 __attribute__((ext_vector_type(4)));
typedef short bf16x8 __attribute__((ext_vector_type(8)));
typedef GAS unsigned gu32;
#define RLX_AGENT __ATOMIC_RELAXED, __HIP_MEMORY_SCOPE_AGENT
#define LDS_WAIT() asm volatile("s_waitcnt lgkmcnt(0)" ::: "memory")
#define VM_WAIT() asm volatile("s_waitcnt vmcnt(0)" ::: "memory")
__device__ __forceinline__ unsigned f2bf(float f) { unsigned u = __builtin_bit_cast(unsigned, f); return (u + 0x7fffu + ((u >> 16) & 1u)) >> 16; }
__device__ __forceinline__ unsigned pk2(float lo, float hi) { return f2bf(lo) | (f2bf(hi) << 16); }
__device__ __forceinline__ float bf2f(unsigned short b) { return __builtin_bit_cast(float, (unsigned)b << 16); }


namespace p2 {
typedef float f32x16 __attribute__((ext_vector_type(16)));
typedef unsigned u32x2 __attribute__((ext_vector_type(2)));
constexpr float LOG2E = 1.4426950408889634f;
constexpr float NEGBIG = -1e30f;
__device__ __forceinline__ int crow(int r, int hi) { return (r & 3) + 8 * (r >> 2) + 4 * hi; }
__device__ __forceinline__ unsigned cvtpk(float lo, float hi) { unsigned r; asm volatile("v_cvt_pk_bf16_f32 %0, %1, %2" : "=v"(r) : "v"(lo), "v"(hi)); return r; }
__device__ __forceinline__ float ex2(float x) { return __builtin_amdgcn_exp2f(x); }
__device__ __forceinline__ float rcp(float x) { return __builtin_amdgcn_rcpf(x); }
__device__ __forceinline__ float gelu_fast(float x) { return x * rcp(1.0f + ex2(-2.302208198f * x * (1.0f + 0.044715f * x * x))); }

constexpr int A_KS = 0, A_KSP = 144, A_VT = 288 * 144, A_VTP = 584, A_ST = A_VT + 64 * 584, A_END = A_ST + 8 * 4096;
__device__ __forceinline__ void attn_unit(LAS unsigned char* lds, int b, int qblk, int kvh, const bf16* QB, const bf16* KVB, const float* sinks, bf16* MIX, float* SSA, int tid) {
    const int lane = tid & 63, wave = __builtin_amdgcn_readfirstlane(tid >> 6), r = lane & 31, hi = lane >> 5;
    const int q0 = qblk * 128, hq = kvh * 8 + wave;
    for (int it = 0; it < 5; ++it) {
        const int cid = it * 512 + tid;
        if (cid < 288 * 8) {
            const int key = cid >> 3, ch = cid & 7;
            bool valid; size_t row = 0;
            if (key < 256) { const int pos = q0 - 128 + key; valid = pos >= 0; row = (size_t)b * SEQ + pos; }
            else if (key < 272) { valid = true; row = (size_t)MREAL + (key - 256); }
            else valid = false;
            v4u kv = {0u, 0u, 0u, 0u}, vv = {0u, 0u, 0u, 0u};
            if (valid) { kv = *(const GAS v4u*)(KVB + row * 256 + kvh * 64 + ch * 8); vv = *(const GAS v4u*)(KVB + row * 256 + 128 + kvh * 64 + ch * 8); }
            *(LAS v4u*)(lds + A_KS + key * A_KSP + ch * 16) = kv;
            LAS unsigned short* vt = (LAS unsigned short*)(lds + A_VT);
#pragma unroll
            for (int j = 0; j < 8; ++j) { const unsigned wv = vv[j >> 1]; vt[(ch * 8 + j) * (A_VTP / 2) + key] = (unsigned short)((j & 1) ? (wv >> 16) : (wv & 0xffffu)); }
        }
    }
    __syncthreads();
    const float sink2 = sinks[hq] * LOG2E;
    for (int qg = 0; qg < 4; ++qg) {
        const size_t mrow = (size_t)b * SEQ + q0 + 32 * qg + r;
        bf16x8 qf[4];
#pragma unroll
        for (int ks = 0; ks < 4; ++ks) qf[ks] = *(const GAS bf16x8*)(QB + mrow * 1024 + hq * 64 + ks * 16 + hi * 8);
        f32x16 s[6];
#pragma unroll
        for (int t = 0; t < 6; ++t) {
            const int kbase = t < 5 ? 32 * (qg + t) : 256;
            f32x16 acc = {0.f, 0.f, 0.f, 0.f, 0.f, 0.f, 0.f, 0.f, 0.f, 0.f, 0.f, 0.f, 0.f, 0.f, 0.f, 0.f};
#pragma unroll
            for (int ks = 0; ks < 4; ++ks) {
                const bf16x8 kf = *(const LAS bf16x8*)(lds + A_KS + (kbase + r) * A_KSP + ks * 32 + hi * 16);
                acc = __builtin_amdgcn_mfma_f32_32x32x16_bf16(kf, qf[ks], acc, 0, 0, 0);
            }
            s[t] = acc;
        }
        const bool blk0 = (qblk == 0);
#pragma unroll
        for (int reg = 0; reg < 16; ++reg) {
            const int j = crow(reg, hi);
            s[0][reg] = (j > r) ? s[0][reg] : NEGBIG;
            s[4][reg] = (j <= r) ? s[4][reg] : NEGBIG;
            s[5][reg] = (j < 16) ? s[5][reg] : NEGBIG;
        }
#pragma unroll
        for (int t = 0; t < 4; ++t) if (blk0 && (qg + t < 4)) {
#pragma unroll
            for (int reg = 0; reg < 16; ++reg) s[t][reg] = NEGBIG;
        }
        float m = sink2;
#pragma unroll
        for (int t = 0; t < 6; ++t)
#pragma unroll
            for (int reg = 0; reg < 16; ++reg) m = fmaxf(m, s[t][reg]);
        m = max_x32(m);
        float l = 0.f;
#pragma unroll
        for (int t = 0; t < 6; ++t)
#pragma unroll
            for (int reg = 0; reg < 16; ++reg) { const float p = ex2(s[t][reg] - m); s[t][reg] = p; l += p; }
        l = sum_x32(l);
        l += ex2(sink2 - m);
        const float linv = 1.0f / l;
        f32x16 o0 = {0.f, 0.f, 0.f, 0.f, 0.f, 0.f, 0.f, 0.f, 0.f, 0.f, 0.f, 0.f, 0.f, 0.f, 0.f, 0.f}, o1 = o0;
#pragma unroll
        for (int t = 0; t < 6; ++t) {
            const int kbase = t < 5 ? 32 * (qg + t) : 256;
#pragma unroll
            for (int ss = 0; ss < 2; ++ss) {
                v4u pw; pw.x = cvtpk(s[t][8 * ss + 0], s[t][8 * ss + 1]); pw.y = cvtpk(s[t][8 * ss + 2], s[t][8 * ss + 3]);
                pw.z = cvtpk(s[t][8 * ss + 4], s[t][8 * ss + 5]); pw.w = cvtpk(s[t][8 * ss + 6], s[t][8 * ss + 7]);
                const bf16x8 pa = __builtin_bit_cast(bf16x8, pw);
                const int ko = (kbase + 16 * ss + 4 * hi) * 2;
                {   const u32x2 lo = *(const LAS u32x2*)(lds + A_VT + r * A_VTP + ko), h2 = *(const LAS u32x2*)(lds + A_VT + r * A_VTP + ko + 16);
                    v4u vw; vw.x = lo.x; vw.y = lo.y; vw.z = h2.x; vw.w = h2.y;
                    o0 = __builtin_amdgcn_mfma_f32_32x32x16_bf16(pa, __builtin_bit_cast(bf16x8, vw), o0, 0, 0, 0); }
                {   const u32x2 lo = *(const LAS u32x2*)(lds + A_VT + (32 + r) * A_VTP + ko), h2 = *(const LAS u32x2*)(lds + A_VT + (32 + r) * A_VTP + ko + 16);
                    v4u vw; vw.x = lo.x; vw.y = lo.y; vw.z = h2.x; vw.w = h2.y;
                    o1 = __builtin_amdgcn_mfma_f32_32x32x16_bf16(pa, __builtin_bit_cast(bf16x8, vw), o1, 0, 0, 0); }
            }
        }
        LAS unsigned short* stg = (LAS unsigned short*)(lds + A_ST + wave * 4096);
#pragma unroll
        for (int reg = 0; reg < 16; ++reg) {
            const int qr = crow(reg, hi); const float li = __shfl(linv, qr);
            stg[qr * 64 + r] = (unsigned short)f2bf(o0[reg] * li);
            stg[qr * 64 + 32 + r] = (unsigned short)f2bf(o1[reg] * li);
        }
        asm volatile("s_waitcnt lgkmcnt(0)" ::: "memory");
#pragma unroll
        for (int i = 0; i < 4; ++i) {
            const int row = i * 8 + (lane >> 3), ch = lane & 7;
            const v4u v = *(const LAS v4u*)(stg + row * 64 + ch * 8);
            float ss = 0.f;
#pragma unroll
            for (int k = 0; k < 4; ++k) { const float a = __builtin_bit_cast(float, v[k] << 16), c = __builtin_bit_cast(float, v[k] & 0xffff0000u); ss += a * a + c * c; }
            ss = sum8(ss);
            const size_t orow = (size_t)b * SEQ + q0 + 32 * qg + row;
            *(GAS v4u*)(MIX + orow * D + hq * 64 + ch * 8) = v;
            if (ch == 0) SSA[orow * 16 + hq] = ss;
        }
        asm volatile("s_waitcnt lgkmcnt(0)" ::: "memory");
    }
    __syncthreads();
}

constexpr int LW_XS = 0, LW_GS = 4608, LW_XC = LW_GS + 2048, LW_XCF = LW_XC + 4608, LW_BYTES = LW_XCF + 4096 + 128;
constexpr int L_CT = 8 * LW_BYTES, L_END = L_CT + 2 * 2048;
static_assert(L_END <= 131072, "lru lds");
struct LruP { const float *conv_w, *conv_b, *w_r, *b_r, *w_i, *b_i, *lam; };
__device__ __forceinline__ void lru_unit(LAS unsigned char* lds, LAS unsigned char* ldsw  , int b, int nb, int cg, const bf16* XBB, const bf16* GTB, const LruP P, bf16* MIX, float* SSL, int tid) {
    const int lane = tid & 63, wave = __builtin_amdgcn_readfirstlane(tid >> 6), r = lane & 31, hi = lane >> 5;
    LAS unsigned char* lw = lds + wave * LW_BYTES;
    {
        LAS unsigned short* wt = (LAS unsigned short*)ldsw;
#pragma unroll
        for (int i = 0; i < 4; ++i) {
            const int e = tid + 512 * i, c = e >> 5, dl = e & 31;
            const size_t gi = (size_t)(nb * 64 + c) * 64 + 32 * cg + dl;
            wt[dl * 72 + c] = (unsigned short)f2bf(P.w_r[gi]);
            wt[32 * 72 + dl * 72 + c] = (unsigned short)f2bf(P.w_i[gi]);
        }
    }
    const int cc = lane, chc = nb * 64 + cc;
    const float cw0 = P.conv_w[0 * LW + chc], cw1 = P.conv_w[1 * LW + chc], cw2 = P.conv_w[2 * LW + chc], cw3 = P.conv_w[3 * LW + chc], cbv = P.conv_b[chc];
    const int chd = nb * 64 + 32 * cg + r;
    const float br = P.b_r[chd], bi = P.b_i[chd];
    const float ls8 = -8.0f * log1pf(expf(-P.lam[chd])) * LOG2E;
    float state = 0.f;
    v4u px[5], pg[2];
#define LRU_PREFETCH(tl) do { \
        _Pragma("unroll") for (int it = 0; it < 5; ++it) { const int cid = it * 64 + lane; px[it] = (v4u){0u, 0u, 0u, 0u}; \
            if (cid < 35 * 8) { const int j = cid >> 3, ch = cid & 7, t = 32 * wave + j - 3; bool valid; size_t row = 0; \
                if ((tl) == 0) { valid = (t >= 0 && t < NMETA); row = (size_t)MREAL + t; } \
                else if ((tl) == 1 && t < 0) { valid = true; row = (size_t)MREAL + NMETA + t; } \
                else { valid = true; row = (size_t)b * SEQ + 256 * ((tl) - 1) + t; } \
                if (valid) px[it] = *(const GAS v4u*)(XBB + row * 1024 + nb * 64 + ch * 8); } } \
        if ((tl) > 0) { _Pragma("unroll") for (int it = 0; it < 2; ++it) { const int cid = it * 64 + lane, t = 32 * wave + (cid >> 2), ch = cid & 3; \
            pg[it] = *(const GAS v4u*)(GTB + ((size_t)b * SEQ + 256 * ((tl) - 1) + t) * 1024 + nb * 64 + 32 * cg + ch * 8); } } } while (0)
    LRU_PREFETCH(0);
    __syncthreads();
    for (int tile = 0; tile < 9; ++tile) {
#pragma unroll
        for (int it = 0; it < 5; ++it) { const int cid = it * 64 + lane; if (cid < 35 * 8) *(LAS v4u*)(lw + LW_XS + (cid >> 3) * 128 + (cid & 7) * 16) = px[it]; }
        if (tile > 0) {
#pragma unroll
            for (int it = 0; it < 2; ++it) { const int cid = it * 64 + lane; *(LAS v4u*)(lw + LW_GS + (cid >> 2) * 64 + (cid & 3) * 16) = pg[it]; }
        }
        asm volatile("s_waitcnt lgkmcnt(0)" ::: "memory");
        if (tile + 1 < 9) LRU_PREFETCH(tile + 1);
        {
            const LAS unsigned short* xs = (const LAS unsigned short*)(lw + LW_XS);
            LAS unsigned short* xc = (LAS unsigned short*)(lw + LW_XC);
            LAS float* xcf = (LAS float*)(lw + LW_XCF);
            const bool own = (cc >> 5) == cg; const int xoff = own ? (cc & 31) : 32 * 32 + (cc & 31);
            float x0 = bf2f(xs[0 * 64 + cc]), x1 = bf2f(xs[1 * 64 + cc]), x2 = bf2f(xs[2 * 64 + cc]);
#pragma unroll 8
            for (int k = 0; k < 32; ++k) {
                const float x3 = bf2f(xs[(k + 3) * 64 + cc]);
                const float v = cbv + cw0 * x0 + cw1 * x1 + cw2 * x2 + cw3 * x3;
                xc[k * 72 + cc] = (unsigned short)cvtpk(v, v);
                xcf[(own ? k * 32 : 0) + xoff] = v;
                x0 = x1; x1 = x2; x2 = x3;
            }
        }
        asm volatile("s_waitcnt lgkmcnt(0)" ::: "memory");
        f32x16 aR = {0.f, 0.f, 0.f, 0.f, 0.f, 0.f, 0.f, 0.f, 0.f, 0.f, 0.f, 0.f, 0.f, 0.f, 0.f, 0.f}, aI = aR;
#pragma unroll
        for (int ks = 0; ks < 4; ++ks) {
            const bf16x8 xa = *(const LAS bf16x8*)(lw + LW_XC + r * 144 + ks * 32 + hi * 16);
            const bf16x8 wr_ = *(const LAS bf16x8*)(ldsw + r * 144 + ks * 32 + hi * 16);
            const bf16x8 wi_ = *(const LAS bf16x8*)(ldsw + 32 * 144 + r * 144 + ks * 32 + hi * 16);
            aR = __builtin_amdgcn_mfma_f32_32x32x16_bf16(xa, wr_, aR, 0, 0, 0);
            aI = __builtin_amdgcn_mfma_f32_32x32x16_bf16(xa, wi_, aI, 0, 0, 0);
        }
        float Av[16], Bv[16];
        {
            const LAS float* xcf = (const LAS float*)(lw + LW_XCF);
#pragma unroll
            for (int reg = 0; reg < 16; ++reg) {
                const int tl = crow(reg, hi), t = 32 * wave + tl;
                const bool valid = (tile > 0) || (t < NMETA);
                const float rg = rcp(1.0f + ex2(-(aR[reg] + br) * LOG2E));
                const float ig = rcp(1.0f + ex2(-(aI[reg] + bi) * LOG2E));
                const float a = ex2(rg * ls8);
                const float mult = __builtin_amdgcn_sqrtf(fmaxf(1.0f - a * a, 0.f));
                const float bx = mult * ig * xcf[tl * 32 + r];
                Av[reg] = valid ? a : 1.0f; Bv[reg] = valid ? bx : 0.0f;
            }
        }
#pragma unroll
        for (int g = 0; g < 4; ++g) {
#pragma unroll
            for (int k = 1; k < 4; ++k) { Bv[4 * g + k] = Av[4 * g + k] * Bv[4 * g + k - 1] + Bv[4 * g + k]; Av[4 * g + k] = Av[4 * g + k] * Av[4 * g + k - 1]; }
        }
        float myCz[4], myCp[4], PW, HW;
        {
            float cz = 0.f, cp = 1.f;
#pragma unroll
            for (int g = 0; g < 4; ++g) {
                const float mP = Av[4 * g + 3], mH = Bv[4 * g + 3];
                const float oP = __shfl_xor(mP, 32), oH = __shfl_xor(mH, 32);
                const float eP = hi ? oP : mP, eH = hi ? oH : mH, dP = hi ? mP : oP, dH = hi ? mH : oH;
                const float cz0 = cz, cp0 = cp;
                cz = eP * cz + eH; cp = cp * eP;
                myCz[g] = hi ? cz : cz0; myCp[g] = hi ? cp : cp0;
                cz = dP * cz + dH; cp = cp * dP;
            }
            PW = cp; HW = cz;
        }
        LAS float* ct = (LAS float*)(lds + L_CT + (tile & 1) * 2048);
        if (hi == 0) { ct[(wave * 32 + r) * 2] = PW; ct[(wave * 32 + r) * 2 + 1] = HW; }
        __syncthreads();
        float cin = 0.f;
        {
            float c = state;
#pragma unroll
            for (int w2 = 0; w2 < 8; ++w2) { if (w2 == wave) cin = c; c = ct[(w2 * 32 + r) * 2] * c + ct[(w2 * 32 + r) * 2 + 1]; }
            state = c;
        }
        if (tile > 0) {
            const LAS unsigned short* gs = (const LAS unsigned short*)(lw + LW_GS);
            LAS unsigned short* os = (LAS unsigned short*)(lw + LW_XS);
#pragma unroll
            for (int reg = 0; reg < 16; ++reg) {
                const int g = reg >> 2, tl = crow(reg, hi);
                const float h = Bv[reg] + Av[reg] * (myCz[g] + myCp[g] * cin);
                const float gt = bf2f(gs[tl * 32 + r]);
                { const float ov = gelu_fast(gt) * h; os[tl * 32 + r] = (unsigned short)cvtpk(ov, ov); }
            }
            asm volatile("s_waitcnt lgkmcnt(0)" ::: "memory");
#pragma unroll
            for (int it = 0; it < 2; ++it) {
                const int cid = it * 64 + lane, tl = cid >> 2, ch = cid & 3;
                const v4u v = *(const LAS v4u*)(lw + LW_XS + tl * 64 + ch * 16);
                float ss = 0.f;
#pragma unroll
                for (int k = 0; k < 4; ++k) { const float a = __builtin_bit_cast(float, v[k] << 16), c = __builtin_bit_cast(float, v[k] & 0xffff0000u); ss += a * a + c * c; }
                ss = sum4(ss);
                const size_t row = (size_t)b * SEQ + 256 * (tile - 1) + 32 * wave + tl;
                *(GAS v4u*)(MIX + row * D + 1024 + nb * 64 + 32 * cg + ch * 8) = v;
                if (ch == 0) SSL[row * 32 + nb * 2 + cg] = ss;
            }
            asm volatile("s_waitcnt lgkmcnt(0)" ::: "memory");
        }
    }
#undef LRU_PREFETCH
    __syncthreads();
}
}

namespace p5 {
typedef float f32x16 __attribute__((ext_vector_type(16)));
constexpr int KP = 272;
constexpr int R_KEYS = 0, R_IDX = 256 * KP, R_END = R_IDX + 8 * 1024;
__device__ __forceinline__ int crow(int r, int hi) { return (r & 3) + 8 * (r >> 2) + 4 * hi; }
__device__ __forceinline__ float fkey(float s, int mask, int payload) { return __builtin_bit_cast(float, (__builtin_bit_cast(int, s) & mask) | payload); }
__device__ __forceinline__ int fbits(float f) { return __builtin_bit_cast(int, f); }
__device__ __forceinline__ float fval(float f, int mask) { return __builtin_bit_cast(float, __builtin_bit_cast(int, f) & mask); }
__device__ __forceinline__ void ins16(float (&L)[16], float v) {
#pragma unroll
    for (int k = 15; k >= 1; --k) L[k] = __builtin_amdgcn_fmed3f(L[k - 1], L[k], v);
    L[0] = fmaxf(L[0], v);
}
__device__ __forceinline__ void half_top16(const LAS unsigned char* keys, const bf16x8 (&qf)[8], int r, int hi, float (&T)[16]) {
    float L[16];
#pragma unroll
    for (int k = 0; k < 16; ++k) L[k] = -INFINITY;
    const int h4 = 4 * hi;
#pragma unroll
    for (int kt = 0; kt < 4; ++kt) {
        f32x16 acc = {0.f, 0.f, 0.f, 0.f, 0.f, 0.f, 0.f, 0.f, 0.f, 0.f, 0.f, 0.f, 0.f, 0.f, 0.f, 0.f};
#pragma unroll
        for (int ks = 0; ks < 8; ++ks) {
            const bf16x8 kf = *(const LAS bf16x8*)(keys + (kt * 32 + r) * KP + ks * 32 + hi * 16);
            acc = __builtin_amdgcn_mfma_f32_32x32x16_bf16(kf, qf[ks], acc, 0, 0, 0);
        }
#pragma unroll
        for (int reg = 0; reg < 16; ++reg) {
            const int C = 127 - 32 * kt - (reg & 3) - 8 * (reg >> 2);
            ins16(L, fkey(acc[reg], (int)0xffffff80, C - h4));
        }
    }
    float M[16];
#pragma unroll
    for (int i = 0; i < 16; ++i) M[i] = fmaxf(L[i], __shfl_xor(L[15 - i], 32));
#define P5_STAGE(st) _Pragma("unroll") for (int i = 0; i < 16; ++i) if ((i & (st)) == 0) { const float a = fmaxf(M[i], M[i + (st)]), b = fminf(M[i], M[i + (st)]); M[i] = a; M[i + (st)] = b; }
    P5_STAGE(8) P5_STAGE(4) P5_STAGE(2) P5_STAGE(1)
#undef P5_STAGE
#pragma unroll
    for (int i = 0; i < 16; ++i) T[i] = M[i];
}

__device__ __forceinline__ void retr_unit(LAS unsigned char* lds, int h, int tg, const bf16* QPB, const bf16* SKB, unsigned short* IDS, float* GW, const float* RSTD2, int tid) {
    const int lane = tid & 63, wave = __builtin_amdgcn_readfirstlane(tid >> 6), r = lane & 31, hi = lane >> 5;
#pragma unroll
    for (int it = 0; it < 8; ++it) {
        const int cid = it * 512 + tid, row = cid >> 4, ch = cid & 15;
        *(LAS v4u*)(lds + R_KEYS + row * KP + ch * 16) = *(const GAS v4u*)(SKB + ((size_t)h * 256 + row) * 128 + ch * 8);
    }
    const size_t tok = (size_t)tg * 256 + wave * 32 + r;
    bf16x8 qa[8], qb[8];
#pragma unroll
    for (int ks = 0; ks < 8; ++ks) { qa[ks] = *(const GAS bf16x8*)(QPB + tok * D + h * 256 + ks * 16 + hi * 8); qb[ks] = *(const GAS bf16x8*)(QPB + tok * D + h * 256 + 128 + ks * 16 + hi * 8); }
    const float rs = RSTD2[tok];
    __syncthreads();
    float TA[16], TB[16];
    half_top16(lds + R_KEYS, qa, r, hi, TA);
    half_top16(lds + R_KEYS + 128 * KP, qb, r, hi, TB);
    LAS unsigned char* sc = lds + R_IDX + wave * 1024 + r * 32;
    const int hm = -hi;
    {
        v4u w;
#pragma unroll
        for (int q = 0; q < 4; ++q) { unsigned x = 0;
#pragma unroll
            for (int k = 0; k < 4; ++k) { const int t = (fbits(TB[4 * q + k]) & hm) | (fbits(TA[4 * q + k]) & ~hm); x |= (unsigned)(127 - (t & 0x7f)) << (8 * k); }
            w[q] = x; }
        *(LAS v4u*)(sc + hi * 16) = w;
    }
    float sA[16], sB[16];
#pragma unroll
    for (int i = 0; i < 16; ++i) { sA[i] = fval(TA[i], (int)0xffffff80); sB[i] = fval(TB[i], (int)0xffffff80); }
    float L[16];
#pragma unroll
    for (int k = 0; k < 16; ++k) L[k] = -INFINITY;
#pragma unroll
    for (int i = 0; i < 16; ++i)
#pragma unroll
        for (int j = 0; j < 16; ++j) if ((i + 1) * (j + 1) <= 16) {
            ins16(L, fkey(sA[i] + sB[j], (int)0xffffff00, 255 - (i * 16 + j)));
        }
    const float v0 = fval(L[0], (int)0xffffff00);
    asm volatile("s_waitcnt lgkmcnt(0)" ::: "memory");
    int ex[8]; float ew[8]; float esum = 0.f;
#pragma unroll
    for (int k = 0; k < 8; ++k) {
        const int t = (fbits(L[8 + k]) & hm) | (fbits(L[k]) & ~hm);
        const int c = 255 - (t & 0xff);
        const int ia = sc[c >> 4], ib = sc[16 + (c & 15)];
        ex[k] = ia * 128 + ib;
        const float e = __builtin_amdgcn_exp2f((__builtin_bit_cast(float, t & (int)0xffffff00) - v0) * rs * 1.4426950408889634f);
        ew[k] = e; esum += e;
    }
    esum = sum_x32(esum);
    const float inv = 1.0f / esum;
    unsigned short* ip = IDS + tok * 128 + h * 16 + hi * 8; float* gp = GW + tok * 128 + h * 16 + hi * 8;
    *(GAS v4u*)(ip) = (v4u){(unsigned)ex[0] | ((unsigned)ex[1] << 16), (unsigned)ex[2] | ((unsigned)ex[3] << 16), (unsigned)ex[4] | ((unsigned)ex[5] << 16), (unsigned)ex[6] | ((unsigned)ex[7] << 16)};
    *(GAS f32x4*)(gp) = (f32x4){ew[0] * inv, ew[1] * inv, ew[2] * inv, ew[3] * inv};
    *(GAS f32x4*)(gp + 4) = (f32x4){ew[4] * inv, ew[5] * inv, ew[6] * inv, ew[7] * inv};
    __syncthreads();
}
}

namespace p6 {
__device__ __forceinline__ float blo(unsigned w) { return __builtin_bit_cast(float, w << 16); }
__device__ __forceinline__ float bhi(unsigned w) { return __builtin_bit_cast(float, w & 0xffff0000u); }
__device__ __forceinline__ float gelu_fast(float x) { return x * __builtin_amdgcn_rcpf(1.0f + __builtin_amdgcn_exp2f(-2.302208198f * x * (1.0f + 0.044715f * x * x))); }
__device__ __forceinline__ unsigned idw(const v4u& a, const v4u& b, int g) { const unsigned w = g < 8 ? a[(g & 7) >> 1] : b[(g & 7) >> 1]; return (g & 1) ? (w >> 16) : (w & 0xffffu); }
__device__ __forceinline__ unsigned q4(float a, float b, float c, float d, float inv, int bias) {
    const int qa = (int)rintf(a * inv) + bias, qb = (int)rintf(b * inv) + bias, qc = (int)rintf(c * inv) + bias, qd = (int)rintf(d * inv) + bias;
    return (unsigned)(qa & 0xff) | ((unsigned)(qb & 0xff) << 8) | ((unsigned)(qc & 0xff) << 16) | ((unsigned)(qd & 0xff) << 24);
}
__device__ __forceinline__ void qrow_load(f32x4 (&v)[8], const float* src, size_t e, int lane) {
#pragma unroll
    for (int j = 0; j < 8; ++j) v[j] = __builtin_nontemporal_load((const GAS f32x4*)(src + e * D + j * 256 + lane * 4));
}
__device__ __forceinline__ void qrow_finish(f32x4 (&v)[8], const float* gcol, unsigned char* dst, float* scale_out, size_t e, int lane) {
    float am = 0.f;
#pragma unroll
    for (int j = 0; j < 8; ++j) {
        if (gcol) { const f32x4 g = *(const GAS f32x4*)(gcol + j * 256 + lane * 4); v[j] = v[j] * g; }
        am = fmaxf(am, fmaxf(fmaxf(fabsf(v[j].x), fabsf(v[j].y)), fmaxf(fabsf(v[j].z), fabsf(v[j].w))));
    }
    am = max64(am);
    const float inv = am > 0.f ? 127.0f / am : 0.f;
#pragma unroll
    for (int j = 0; j < 8; ++j)
        *(GAS unsigned*)(dst + ((size_t)(2 * j + (lane >> 5)) * 16384 + e) * 128 + (lane & 31) * 4) = q4(v[j].x, v[j].y, v[j].z, v[j].w, inv, 0);
    if (lane == 0) scale_out[e] = am * (1.0f / 127.0f);
}
__device__ __forceinline__ void qx_load(v4u (&x)[4], const bf16* H1B, size_t tok, int lane) {
#pragma unroll
    for (int j = 0; j < 4; ++j) x[j] = *(const GAS v4u*)(H1B + tok * D + j * 512 + lane * 8);
}
__device__ __forceinline__ void qx_finish(const v4u (&x)[4], unsigned char* X8, float* SX, size_t tok, int lane) {
#pragma unroll
    for (int j = 0; j < 4; ++j) {
        float f[8]; float am = 0.f;
#pragma unroll
        for (int k = 0; k < 4; ++k) { f[2 * k] = blo(x[j][k]); f[2 * k + 1] = bhi(x[j][k]); am = fmaxf(am, fmaxf(fabsf(f[2 * k]), fabsf(f[2 * k + 1]))); }
        am = max16(am);
        const float inv = am > 0.f ? 127.0f / am : 0.f;
        typedef unsigned u32x2v __attribute__((ext_vector_type(2)));
        u32x2v o; o.x = q4(f[0], f[1], f[2], f[3], inv, 0); o.y = q4(f[4], f[5], f[6], f[7], inv, 0);
        *(GAS u32x2v*)(X8 + tok * D + j * 512 + lane * 8) = o;
        if ((lane & 15) == 0) SX[tok * 16 + 4 * j + (lane >> 4)] = am * (1.0f / 127.0f);
    }
}

typedef int i32x16 __attribute__((ext_vector_type(16)));
typedef float f32x16v __attribute__((ext_vector_type(16)));
__device__ __forceinline__ int seli(int m, int a, int b) { return (a & m) | (b & ~m); }
__device__ __forceinline__ float self(int m, float a, float b) { return __builtin_bit_cast(float, seli(m, __builtin_bit_cast(int, a), __builtin_bit_cast(int, b))); }
__device__ __forceinline__ void usweep(const unsigned char* X8, const float* SX, const unsigned char* U8, const unsigned short* IDS, bf16* PART, LAS unsigned char* lds, int slot, int rank, int nrank, int wave, int lane) {
    const int ps = lane >> 3, ch = lane & 7;
    const int first = rank * 8 + wave, stride = nrank * 8;
    const int n = first < MREAL ? (MREAL - first + stride - 1) / stride : 0, NQ = 2 * n;
    if (NQ == 0) return;
    const int m4 = -((lane >> 2) & 1), m2 = -((lane >> 1) & 1), m1 = -(lane & 1);
    LAS unsigned char* sl = lds + wave * 1024;
#define U_LOAD(q_, RI, RX, SX_, T_, SG_) do { const int qq_ = (q_) < NQ ? (q_) : NQ - 1; const int rd_ = qq_ >= n ? 1 : 0; T_ = first + (qq_ - rd_ * n) * stride; SG_ = rd_ * 8 + slot; \
        RI = *(const GAS unsigned*)(IDS + (size_t)T_ * 128 + lane * 2); RX = *(const GAS unsigned*)(X8 + (size_t)T_ * D + SG_ * 128 + (lane & 31) * 4); SX_ = SX[(size_t)T_ * 16 + SG_]; } while (0)
#define U_EXPAND(SLOT, RI, RX, I0, I1, XV) do { LAS unsigned char* s_ = sl + (SLOT) * 512; \
        *(LAS unsigned*)(s_ + lane * 4) = RI; if (lane < 32) *(LAS unsigned*)(s_ + 256 + lane * 4) = RX; \
        asm volatile("s_waitcnt lgkmcnt(0)" ::: "memory"); \
        I0 = *(const LAS v4u*)(s_ + ps * 32); I1 = *(const LAS v4u*)(s_ + ps * 32 + 16); XV = *(const LAS v4u*)(s_ + 256 + ch * 16); } while (0)
#define U_ISSUE(BUF, I0, I1, SG_) do { const unsigned char* tab_ = U8 + (size_t)(SG_) * 16384 * 128 + ch * 16; \
        _Pragma("unroll") for (int g = 0; g < 16; ++g) BUF[g] = *(const GAS v4u*)(tab_ + (size_t)idw(I0, I1, g) * 128); } while (0)
#define U_FINISH(BUF, XV, SX_, T_, SG_) do { i32x16 d; \
        _Pragma("unroll") for (int g = 0; g < 16; ++g) { int a_ = __builtin_amdgcn_sdot4((int)BUF[g][0], (int)XV[0], 0, false); a_ = __builtin_amdgcn_sdot4((int)BUF[g][1], (int)XV[1], a_, false); \
            a_ = __builtin_amdgcn_sdot4((int)BUF[g][2], (int)XV[2], a_, false); a_ = __builtin_amdgcn_sdot4((int)BUF[g][3], (int)XV[3], a_, false); d[g] = a_; } \
        int r8[8], r4[4], r2[2]; \
        _Pragma("unroll") for (int k = 0; k < 8; ++k) r8[k] = seli(m4, d[8 + k], d[k]) + dpp_hm(seli(m4, d[k], d[8 + k])); \
        _Pragma("unroll") for (int k = 0; k < 4; ++k) r4[k] = seli(m2, r8[4 + k], r8[k]) + dpp_x2(seli(m2, r8[k], r8[4 + k])); \
        _Pragma("unroll") for (int k = 0; k < 2; ++k) r2[k] = seli(m1, r4[2 + k], r4[k]) + dpp_x1(seli(m1, r4[k], r4[2 + k])); \
        *(GAS unsigned*)(PART + ((size_t)(SG_) * MREAL + T_) * 128 + ps * 16 + 2 * ch) = pk2((float)r2[0] * SX_, (float)r2[1] * SX_); } while (0)
    v4u bufA[16], bufB[16];
    v4u a0, a1, ax, b0, b1, bx; unsigned ri, rx; float as, bs, cs; int at, bt, ct, ag, bg, cg;
    U_LOAD(0, ri, rx, as, at, ag); U_EXPAND(0, ri, rx, a0, a1, ax);
    U_LOAD(1, ri, rx, bs, bt, bg); U_EXPAND(1, ri, rx, b0, b1, bx);
    U_ISSUE(bufA, a0, a1, ag);
    for (int q = 0; q < NQ; q += 2) {
        U_ISSUE(bufB, b0, b1, bg);
        U_LOAD(q + 2, ri, rx, cs, ct, cg);
        U_FINISH(bufA, ax, as, at, ag);
        U_EXPAND(0, ri, rx, a0, a1, ax); as = cs; at = ct; ag = cg;
        U_ISSUE(bufA, a0, a1, ag);
        U_LOAD(q + 3, ri, rx, cs, ct, cg);
        U_FINISH(bufB, bx, bs, bt, bg);
        U_EXPAND(1, ri, rx, b0, b1, bx); bs = cs; bt = ct; bg = cg;
    }
#undef U_LOAD
#undef U_EXPAND
#undef U_ISSUE
#undef U_FINISH
}
__device__ __forceinline__ void wreduce(const bf16* PART, const float* GW, const float* RSTD2, const unsigned short* IDS, const float* SCU, const float* SCV, unsigned char* W8, float* WS8, size_t gt, size_t NT) {
    for (size_t i8 = gt; i8 < (size_t)MREAL * 128 / 8; i8 += NT) {
        float s[8];
#pragma unroll
        for (int k = 0; k < 8; ++k) s[k] = 0.f;
#pragma unroll 8
        for (int sg = 0; sg < 16; ++sg) {
            const v4u p = *(const GAS v4u*)(PART + (size_t)sg * MREAL * 128 + i8 * 8);
#pragma unroll
            for (int k = 0; k < 4; ++k) { s[2 * k] += blo(p[k]); s[2 * k + 1] += bhi(p[k]); }
        }
        const float rs = RSTD2[i8 >> 4];
        const v4u idv = *(const GAS v4u*)(IDS + i8 * 8);
        const f32x4 g0 = *(const GAS f32x4*)(GW + i8 * 8), g1 = *(const GAS f32x4*)(GW + i8 * 8 + 4);
        float w[8]; float am = 0.f;
#pragma unroll
        for (int k = 0; k < 8; ++k) {
            const unsigned e = (k & 1) ? (idv[k >> 1] >> 16) : (idv[k >> 1] & 0xffffu);
            const float g = k < 4 ? g0[k & 3] : g1[k & 3];
            w[k] = g * gelu_fast(rs * SCU[e] * s[k]) * SCV[e]; am = fmaxf(am, fabsf(w[k]));
        }
        am = max16(am);
        const float inv = am > 0.f ? 127.0f / am : 0.f;
        typedef unsigned u32x2v __attribute__((ext_vector_type(2)));
        u32x2v o; o.x = q4(w[0], w[1], w[2], w[3], inv, 0); o.y = q4(w[4], w[5], w[6], w[7], inv, 0);
        *(GAS u32x2v*)(W8 + i8 * 8) = o;
        if ((i8 & 15) == 0) WS8[i8 >> 4] = am * (1.0f / 127.0f);
    }
}
__device__ __forceinline__ void vsweep(const bf16* H1B, const unsigned char* V8, const unsigned short* IDS, const unsigned char* W8, const float* WS8, bf16* Z, float* SSF, LAS unsigned char* lds, int slot, int rank, int nrank, int wave, int lane) {
    const int ps = lane >> 3, ch = lane & 7;
    const int first = rank * 8 + wave, stride = nrank * 8;
    const int n = first < MREAL ? (MREAL - first + stride - 1) / stride : 0, NQ = 2 * n;
    if (NQ == 0) return;
    const int m8 = -((lane >> 3) & 1);
    LAS unsigned char* sl = lds + wave * 1024;
#define V_LOAD(q_, RI, RW, WSC, HX, T_, SG_) do { const int qq_ = (q_) < NQ ? (q_) : NQ - 1; const int rd_ = qq_ >= n ? 1 : 0; T_ = first + (qq_ - rd_ * n) * stride; SG_ = rd_ * 8 + slot; \
        RI = *(const GAS unsigned*)(IDS + (size_t)T_ * 128 + lane * 2); RW = *(const GAS unsigned*)(W8 + (size_t)T_ * 128 + (lane & 31) * 4); WSC = WS8[T_]; \
        HX = *(const GAS unsigned*)(H1B + (size_t)T_ * D + SG_ * 128 + ch * 16 + 2 * ps); } while (0)
#define V_EXPAND(SLOT, RI, RW, I0, I1, WQ) do { LAS unsigned char* s_ = sl + (SLOT) * 512; \
        *(LAS unsigned*)(s_ + lane * 4) = RI; if (lane < 32) *(LAS unsigned*)(s_ + 256 + lane * 4) = RW; \
        asm volatile("s_waitcnt lgkmcnt(0)" ::: "memory"); \
        I0 = *(const LAS v4u*)(s_ + ps * 32); I1 = *(const LAS v4u*)(s_ + ps * 32 + 16); WQ = *(const LAS v4u*)(s_ + 256 + ps * 16); } while (0)
#define V_ISSUE(BUF, I0, I1, SG_) do { const unsigned char* tab_ = V8 + (size_t)(SG_) * 16384 * 128 + ch * 16; \
        _Pragma("unroll") for (int g = 0; g < 16; ++g) BUF[g] = *(const GAS v4u*)(tab_ + (size_t)idw(I0, I1, g) * 128); } while (0)
#define V_FINISH(BUF, WQ, WSC, HX, T_, SG_) do { i32x16 acc = {0, 0, 0, 0, 0, 0, 0, 0, 0, 0, 0, 0, 0, 0, 0, 0}; const unsigned hx_ = HX; \
        _Pragma("unroll") for (int j = 0; j < 4; ++j) { const int wq_ = (int)WQ[j]; \
            _Pragma("unroll") for (int k = 0; k < 4; ++k) { \
                const unsigned d0_ = BUF[4 * j][k], d1_ = BUF[4 * j + 1][k], d2_ = BUF[4 * j + 2][k], d3_ = BUF[4 * j + 3][k]; \
                const unsigned p0_ = __builtin_amdgcn_perm(d1_, d0_, 0x05010400u), p1_ = __builtin_amdgcn_perm(d1_, d0_, 0x07030602u); \
                const unsigned q0_ = __builtin_amdgcn_perm(d3_, d2_, 0x05010400u), q1_ = __builtin_amdgcn_perm(d3_, d2_, 0x07030602u); \
                acc[4 * k + 0] = __builtin_amdgcn_sdot4((int)__builtin_amdgcn_perm(q0_, p0_, 0x05040100u), wq_, acc[4 * k + 0], false); \
                acc[4 * k + 1] = __builtin_amdgcn_sdot4((int)__builtin_amdgcn_perm(q0_, p0_, 0x07060302u), wq_, acc[4 * k + 1], false); \
                acc[4 * k + 2] = __builtin_amdgcn_sdot4((int)__builtin_amdgcn_perm(q1_, p1_, 0x05040100u), wq_, acc[4 * k + 2], false); \
                acc[4 * k + 3] = __builtin_amdgcn_sdot4((int)__builtin_amdgcn_perm(q1_, p1_, 0x07060302u), wq_, acc[4 * k + 3], false); } } \
        int r8[8], r4[4], r2[2]; \
        _Pragma("unroll") for (int k = 0; k < 8; ++k) { const auto rr_ = __builtin_amdgcn_permlane32_swap((unsigned)acc[k], (unsigned)acc[8 + k], false, false); r8[k] = (int)rr_[0] + (int)rr_[1]; } \
        _Pragma("unroll") for (int k = 0; k < 4; ++k) { const auto rr_ = __builtin_amdgcn_permlane16_swap((unsigned)r8[k], (unsigned)r8[4 + k], false, false); r4[k] = (int)rr_[0] + (int)rr_[1]; } \
        _Pragma("unroll") for (int k = 0; k < 2; ++k) r2[k] = seli(m8, r4[2 + k], r4[k]) + dpp_r8(seli(m8, r4[k], r4[2 + k])); \
        const float z0_ = (float)r2[0] * WSC + blo(hx_), z1_ = (float)r2[1] * WSC + bhi(hx_); \
        *(GAS unsigned*)(Z + (size_t)T_ * D + (SG_) * 128 + ch * 16 + 2 * ps) = pk2(z0_, z1_); \
        const float ss_ = sum64(z0_ * z0_ + z1_ * z1_); \
        if (lane == 0) SSF[(size_t)T_ * 16 + (SG_)] = ss_; } while (0)
    v4u bufA[16], bufB[16];
    v4u a0, a1, aw, b0, b1, bw; unsigned ri, rw, ah, bh, chx; float as, bs, cs; int at, bt, ct, ag, bg, cg;
    V_LOAD(0, ri, rw, as, ah, at, ag); V_EXPAND(0, ri, rw, a0, a1, aw);
    V_LOAD(1, ri, rw, bs, bh, bt, bg); V_EXPAND(1, ri, rw, b0, b1, bw);
    V_ISSUE(bufA, a0, a1, ag);
    for (int q = 0; q < NQ; q += 2) {
        V_ISSUE(bufB, b0, b1, bg);
        V_LOAD(q + 2, ri, rw, cs, chx, ct, cg);
        V_FINISH(bufA, aw, as, ah, at, ag);
        V_EXPAND(0, ri, rw, a0, a1, aw); as = cs; ah = chx; at = ct; ag = cg;
        V_ISSUE(bufA, a0, a1, ag);
        V_LOAD(q + 3, ri, rw, cs, chx, ct, cg);
        V_FINISH(bufB, bw, bs, bh, bt, bg);
        V_EXPAND(1, ri, rw, b0, b1, bw); bs = cs; bh = chx; bt = ct; bg = cg;
    }
#undef V_LOAD
#undef V_EXPAND
#undef V_ISSUE
#undef V_FINISH
}
__device__ __forceinline__ void final_row(const bf16* Z, const float* SSF, const float* fg, float* out, size_t tok, int lane) {
    v4u z[4];
#pragma unroll
    for (int j = 0; j < 4; ++j) z[j] = *(const GAS v4u*)(Z + tok * D + j * 512 + lane * 8);
    float ss = 0.f;
#pragma unroll
    for (int k = 0; k < 4; ++k) { const f32x4 v = *(const GAS f32x4*)(SSF + tok * 16 + 4 * k); ss += (v.x + v.y) + (v.z + v.w); }
    const float rf = 1.0f / sqrtf(ss * (1.0f / D) + EPS);
#pragma unroll
    for (int j = 0; j < 4; ++j) {
        const f32x4 ga = *(const GAS f32x4*)(fg + j * 512 + lane * 8), gb = *(const GAS f32x4*)(fg + j * 512 + lane * 8 + 4);
        *(GAS f32x4*)(out + tok * D + j * 512 + lane * 8) = (f32x4){blo(z[j][0]) * rf * ga.x, bhi(z[j][0]) * rf * ga.y, blo(z[j][1]) * rf * ga.z, bhi(z[j][1]) * rf * ga.w};
        *(GAS f32x4*)(out + tok * D + j * 512 + lane * 8 + 4) = (f32x4){blo(z[j][2]) * rf * gb.x, bhi(z[j][2]) * rf * gb.y, blo(z[j][3]) * rf * gb.z, bhi(z[j][3]) * rf * gb.w};
    }
}
}

struct Frame {
    LAS unsigned char* lds;
    volatile LAS unsigned* MISC;
    gu32* ctl;
    int tid, lane, wave, vcu, G;
};
__device__ __forceinline__ float wave_sum(float v) { return sum64(v); }
__device__ __forceinline__ void p0_transpose_item(const float* W, int K, int N, bf16* WT, const float* g0, const float* g1, int ksplit, LAS float* scr, int item, int lane) {
    const int nblk = N / 32, kb = item / nblk, nb = item % nblk, k0 = 64 * kb, n0 = 32 * nb;
#pragma unroll 16
    for (int i = 0; i < 32; ++i) { const int kk = 2 * i + (lane >> 5); const int kg = k0 + kk; const float gv = kg < ksplit ? g0[kg] : g1[kg - ksplit];
        scr[kk * 33 + (lane & 31)] = W[(size_t)kg * N + n0 + (lane & 31)] * gv; }
    LDS_WAIT(); asm volatile("" ::: "memory");
    const int c = lane & 7;
#pragma unroll
    for (int j = 0; j < 4; ++j) { const int n = (lane >> 3) + 8 * j; const LAS float* s = scr + (8 * c) * 33 + n;
        v4u o; o.x = pk2(s[0 * 33], s[1 * 33]); o.y = pk2(s[2 * 33], s[3 * 33]); o.z = pk2(s[4 * 33], s[5 * 33]); o.w = pk2(s[6 * 33], s[7 * 33]);
        *(GAS v4u*)(WT + (size_t)(n0 + n) * K + k0 + 8 * c) = o; }
    LDS_WAIT(); asm volatile("" ::: "memory");
}
__device__ __forceinline__ void p0_row_load(f32x4 (&v)[8], const float* xrow, int lane) {
    const GAS f32x4* xr = (const GAS f32x4*)xrow + lane;
#pragma unroll
    for (int j = 0; j < 8; ++j) v[j] = __builtin_nontemporal_load(xr + 64 * j);
}
__device__ __forceinline__ void p0_row_finish(const f32x4 (&v)[8], bf16* orow, float* rstd_out, int lane) {
    float s = 0.f;
#pragma unroll
    for (int j = 0; j < 8; ++j) s += (v[j].x * v[j].x + v[j].y * v[j].y) + (v[j].z * v[j].z + v[j].w * v[j].w);
    s = wave_sum(s);
    GAS unsigned long long* o8 = (GAS unsigned long long*)orow + lane;
#pragma unroll
    for (int j = 0; j < 8; ++j) o8[64 * j] = (unsigned long long)pk2(v[j].x, v[j].y) | ((unsigned long long)pk2(v[j].z, v[j].w) << 32);
    if (lane == 0) *rstd_out = 1.0f / sqrtf(s * (1.0f / D) + EPS);
}
__device__ __forceinline__ void p0_cvt8(const float* src, bf16* dst, const float* gcol, size_t idx8) {
    const f32x4 a = *(const GAS f32x4*)(src + idx8 * 8), b = *(const GAS f32x4*)(src + idx8 * 8 + 4);
    f32x4 ga = {1.f, 1.f, 1.f, 1.f}, gb = {1.f, 1.f, 1.f, 1.f};
    if (gcol) { const int c = (int)((idx8 * 8) & (D - 1)); ga = *(const GAS f32x4*)(gcol + c); gb = *(const GAS f32x4*)(gcol + c + 4); }
    v4u o; o.x = pk2(a.x * ga.x, a.y * ga.y); o.y = pk2(a.z * ga.z, a.w * ga.w); o.z = pk2(b.x * gb.x, b.y * gb.y); o.w = pk2(b.z * gb.z, b.w * gb.w);
    *(GAS v4u*)(dst + idx8 * 8) = o;
}

struct Args { const float* in[22]; float* out; unsigned char* ws; int ph_lo, ph_hi, rep_mask, pad; };

__global__ void __launch_bounds__(NWAVES * 64, 2) fwd(Args args) {
    extern __shared__ __attribute__((aligned(16))) unsigned char lds[];
    Frame F;
    F.lds = (LAS unsigned char*)lds;
    F.MISC = (volatile LAS unsigned*)(F.lds + MISC_OFF);
    F.tid = threadIdx.x; F.lane = F.tid & 63; F.wave = __builtin_amdgcn_readfirstlane(F.tid >> 6);
    F.G = gridDim.x; { const int bx = blockIdx.x; F.vcu = (F.G % 8 == 0) ? (bx % 8) * (F.G / 8) + bx / 8 : bx; }
    unsigned char* ws = args.ws;
    F.ctl = (gu32*)(ws + WS_CTL);
    for (int u = F.tid; u < (LDS_BYTES - LDSCTL_OFF) / 4; u += NWAVES * 64) ((LAS unsigned*)(F.lds + LDSCTL_OFF))[u] = 0u;
    __syncthreads();
    XcdBarrier bar = xcd_barrier_post((unsigned*)(F.ctl + CW_BAR), F.MISC + 8);
    const int lo = args.ph_lo, hi = args.ph_hi;
#define IN(k) (lo <= (k) && (k) < hi)
#define BOTH(k) (IN(k) && IN((k) + 1))
#ifndef PROBE_PH
#define PROBE_PH (-1)
#endif
#define REP(k) for (int rep_ = 0; rep_ < ((k) == PROBE_PH ? 2 : 1); ++rep_)

    const float* x = args.in[0]; const float* meta = args.in[1]; const float* norm_mix_g = args.in[2]; const float* w_in = args.in[3]; const float* b_in = args.in[4];
    const float* gn_attn_g = args.in[13]; const float* gn_lru_g = args.in[14]; const float* w_out = args.in[15]; const float* norm_ffn_g = args.in[16];
    const float* peer_wq = args.in[17]; const float* sub_keys = args.in[18]; const float* peer_u = args.in[19]; const float* peer_v = args.in[20];
    bf16* W1T = (bf16*)(ws + WS_W1T); bf16* W2T = (bf16*)(ws + WS_W2T); bf16* W3T = (bf16*)(ws + WS_W3T); bf16* SKB = (bf16*)(ws + WS_SKB);
    float* RSTD1 = (float*)(ws + WS_RSTD1);
    unsigned char* U8 = ws + WS_U8; unsigned char* V8 = ws + WS_V8; unsigned char* X8 = ws + WS_X8; float* SX = (float*)(ws + WS_SX); float* SCU = (float*)(ws + WS_SCU); float* SCV = (float*)(ws + WS_SCV);
    bf16* A1 = (bf16*)(ws + WS_A1);
    bf16* QB = (bf16*)(ws + WS_Q); bf16* KVB = (bf16*)(ws + WS_KV); bf16* XBB = (bf16*)(ws + WS_XB); bf16* GTB = (bf16*)(ws + WS_GT);

    if (IN(0)) { REP(0) {
        LAS float* scr = (LAS float*)(F.lds + RING_OFF + F.wave * 16384);
        const int gw = F.vcu * NWAVES + F.wave, NGW = F.G * NWAVES;
        constexpr int I_1 = (D / 64) * (IND / 32), I_2 = (D / 64) * (D / 32), I_3 = I_2;
        for (int it = gw; it < I_1 + I_2 + I_3; it += NGW) {
            int r = it;
            if (r < I_1) { p0_transpose_item(w_in, D, IND, W1T, norm_mix_g, norm_mix_g, D, scr, r, F.lane); continue; } r -= I_1;
            if (r < I_2) { p0_transpose_item(w_out, D, D, W2T, gn_attn_g, gn_lru_g, 1024, scr, r, F.lane); continue; } r -= I_2;
            p0_transpose_item(peer_wq, D, D, W3T, norm_ffn_g, norm_ffn_g, D, scr, r, F.lane);
        }
        {
            f32x4 cur[8], nxt[8];
            if (gw < MREAL + NMETA) p0_row_load(cur, gw < MREAL ? x + (size_t)gw * D : meta + (size_t)(gw - MREAL) * D, F.lane);
            for (int m = gw; m < MREAL + NMETA; m += NGW) {
                const int mn = m + NGW;
                if (mn < MREAL + NMETA) p0_row_load(nxt, mn < MREAL ? x + (size_t)mn * D : meta + (size_t)(mn - MREAL) * D, F.lane);
                p0_row_finish(cur, A1 + (size_t)m * D, RSTD1 + m, F.lane);
#pragma unroll
                for (int j = 0; j < 8; ++j) cur[j] = nxt[j];
            }
        }
        {
            const size_t gt = (size_t)gw * 64 + F.lane, NT = (size_t)NGW * 64;
            for (size_t i = gt; i < (size_t)(8 * 2 * 128 * 128) / 8; i += NT) p0_cvt8(sub_keys, SKB, nullptr, i);
            {
                f32x4 cur[8], nxt[8];
                constexpr int QV0 = 6144;
                if (QV0 + gw < 16384) p6::qrow_load(cur, peer_v, (size_t)(QV0 + gw), F.lane);
                for (int rj = QV0 + gw; rj < 16384; rj += NGW) {
                    const int rn = rj + NGW;
                    if (rn < 16384) p6::qrow_load(nxt, peer_v, (size_t)rn, F.lane);
                    p6::qrow_finish(cur, nullptr, V8, SCV, (size_t)rj, F.lane);
#pragma unroll
                    for (int j = 0; j < 8; ++j) cur[j] = nxt[j];
                }
            }
        } }
        if (BOTH(0)) xcd_barrier(bar);
    }
    if (IN(1)) {
        pg8::Gemm g{A1, W1T, MPAD, IND, D};
        pg8::Order1 S{F.G, (int)blockIdx.x};
        pg8::Epi1 E{QB, KVB, XBB, GTB, RSTD1, b_in};
        REP(1) pg8::gemm_phase<pg8::Epi1, pg8::Order1, true, true>(F.lds + RING_OFF, g, S, E);
        {
            volatile LAS int* qb = (volatile LAS int*)(F.lds + LDSCTL_OFF + 512);
            for (;;) {
                __syncthreads();
                if (F.tid == 0) qb[0] = (int)__hip_atomic_fetch_add((unsigned*)(F.ctl + CW_QROW), 32u, __ATOMIC_RELAXED, __HIP_MEMORY_SCOPE_AGENT);
                __syncthreads();
                const int base = qb[0];
                if (base >= 16384 + 6144) break;
                f32x4 r0[8], r1[8], r2[8], r3[8];
                const bool isu = base < 16384;
                const float* src = isu ? peer_u : peer_v; const float* gc = isu ? norm_ffn_g : nullptr; unsigned char* dst = isu ? U8 : V8; float* sc = isu ? SCU : SCV;
                const size_t e0 = (size_t)(isu ? base : base - 16384) + F.wave * 4;
                p6::qrow_load(r0, src, e0, F.lane); p6::qrow_load(r1, src, e0 + 1, F.lane); p6::qrow_load(r2, src, e0 + 2, F.lane); p6::qrow_load(r3, src, e0 + 3, F.lane);
                p6::qrow_finish(r0, gc, dst, sc, e0, F.lane); p6::qrow_finish(r1, gc, dst, sc, e0 + 1, F.lane);
                p6::qrow_finish(r2, gc, dst, sc, e0 + 2, F.lane); p6::qrow_finish(r3, gc, dst, sc, e0 + 3, F.lane);
            }
        }
        if (BOTH(1)) xcd_barrier(bar);
    }
    if (IN(2)) {
        bf16* MIX = (bf16*)(ws + WS_A1); float* SSA = (float*)(ws + WS_SSA); float* SSL = (float*)(ws + WS_SSL);
        const p2::LruP LP{args.in[6], args.in[7], args.in[8], args.in[9], args.in[10], args.in[11], args.in[12]};
        {
        REP(20) for (int u = (int)blockIdx.x; u < 256; u += F.G) p2::lru_unit(F.lds + RING_OFF, F.lds + LDSCTL_OFF + 5120, u >> 5, (u >> 1) & 15, u & 1, XBB, GTB, LP, MIX, SSL, F.tid);
        REP(21) for (int a = (int)blockIdx.x; a < 256; a += F.G) p2::attn_unit(F.lds + RING_OFF, a >> 5, (a >> 1) & 15, a & 1, QB, KVB, args.in[5], MIX, SSA, F.tid);
        }
        if (BOTH(2)) xcd_barrier(bar);
    }
    if (IN(3)) {
        bf16* MIX = (bf16*)(ws + WS_A1); const float* SSA = (const float*)(ws + WS_SSA); const float* SSL = (const float*)(ws + WS_SSL);
        bf16* H1B = (bf16*)(ws + WS_H1); float* SS2 = (float*)(ws + WS_SS2);
        pg8::Order2 S{F.G, (int)blockIdx.x};
        LAS float* tbl = (LAS float*)(F.lds + LDSCTL_OFF + 1024);
        pg8::Unit u0{0, 0};
        for (int i = 0; i < 2; ++i) {
            pg8::Unit u; if (!S.next(i, u)) break; if (i == 0) u0 = u;
            if (F.tid < 256) {
                const size_t row = (size_t)u.pm * 256 + F.tid; float sa = 0.f, sl = 0.f;
#pragma unroll
                for (int k = 0; k < 4; ++k) { const f32x4 v = *(const GAS f32x4*)(SSA + row * 16 + 4 * k); sa += (v.x + v.y) + (v.z + v.w); }
#pragma unroll
                for (int k = 0; k < 8; ++k) { const f32x4 v = *(const GAS f32x4*)(SSL + row * 32 + 4 * k); sl += (v.x + v.y) + (v.z + v.w); }
                const float ra = 1.0f / sqrtf(sa * (1.0f / 1024) + EPS), rl = 1.0f / sqrtf(sl * (1.0f / 1024) + EPS);
                tbl[(i * 256 + F.tid) * 2] = ra / rl; tbl[(i * 256 + F.tid) * 2 + 1] = rl;
            }
        }
        __syncthreads();
        pg8::Gemm g{MIX, W2T, MREAL, D, D};
        pg8::Epi2 E{H1B, x, SS2, (const LAS float*)tbl, u0.pm};
        REP(3) pg8::gemm_phase<pg8::Epi2, pg8::Order2, true, true>(F.lds + RING_OFF, g, S, E);
        if (BOTH(3)) xcd_barrier(bar);
    }
    if (IN(4)) {
        bf16* H1B = (bf16*)(ws + WS_H1); bf16* QPB = (bf16*)(ws + WS_A1);
        pg8::Order2 S{F.G, (int)blockIdx.x};
        {
            const float* SS2 = (const float*)(ws + WS_SS2); float* RSTD2 = (float*)(ws + WS_RSTD2);
            pg8::Unit u; if (S.next(0, u) && F.tid < 256) {
                const size_t row = (size_t)u.pm * 256 + F.tid; float ssq = 0.f;
#pragma unroll
                for (int k = 0; k < 8; ++k) { const f32x4 v = *(const GAS f32x4*)(SS2 + row * 32 + 4 * k); ssq += (v.x + v.y) + (v.z + v.w); }
                RSTD2[row] = 1.0f / sqrtf(ssq * (1.0f / D) + EPS);
            }
        }
        pg8::Gemm g{H1B, W3T, MREAL, D, D};
        pg8::Epi3 E{QPB};
        REP(4) pg8::gemm_phase<pg8::Epi3, pg8::Order2, true, true>(F.lds + RING_OFF, g, S, E);
        if (BOTH(4)) xcd_barrier(bar);
    }
    if (IN(5)) {
        const bf16* QPB = (const bf16*)(ws + WS_A1);
        unsigned short* IDS = (unsigned short*)(ws + WS_IDS); float* GW = (float*)(ws + WS_GW); float* RSTD2 = (float*)(ws + WS_RSTD2);
        const bf16* H1B = (const bf16*)(ws + WS_H1);
        REP(5) for (int u = (int)blockIdx.x; u < 512; u += F.G) {
            v4u xq[4][4]; const size_t tb = (size_t)(u >> 3) * 256 + F.wave * 32 + (u & 7);
#pragma unroll
            for (int k = 0; k < 4; ++k) p6::qx_load(xq[k], H1B, tb + 8 * k, F.lane);
            p5::retr_unit(F.lds + RING_OFF, u & 7, u >> 3, QPB, SKB, IDS, GW, RSTD2, F.tid);
#pragma unroll
            for (int k = 0; k < 4; ++k) p6::qx_finish(xq[k], X8, SX, tb + 8 * k, F.lane);
        }
        if (BOTH(5)) xcd_barrier(bar);
    }
    {
        const bf16* H1B = (const bf16*)(ws + WS_H1); const unsigned short* IDS = (const unsigned short*)(ws + WS_IDS); const float* GW = (const float*)(ws + WS_GW);
        const float* RSTD2 = (const float*)(ws + WS_RSTD2); bf16* PART = (bf16*)(ws + WS_PART); unsigned char* W8 = ws + WS_W; float* WS8 = (float*)(ws + WS_WSUM); bf16* ZB = (bf16*)(ws + WS_Z); float* SSF = (float*)(ws + WS_SSL);
        const int slot = (int)blockIdx.x & 7, rank = (int)blockIdx.x >> 3, nrank = (F.G - slot + 7) >> 3;
        const int gw = F.vcu * NWAVES + F.wave, NGW = F.G * NWAVES;
        if (IN(6)) { REP(6) p6::usweep(X8, SX, U8, IDS, PART, F.lds + RING_OFF, slot, rank, nrank, F.wave, F.lane); if (BOTH(6)) xcd_barrier(bar); }
        if (IN(7)) { REP(7) p6::wreduce(PART, GW, RSTD2, IDS, SCU, SCV, W8, WS8, (size_t)gw * 64 + F.lane, (size_t)NGW * 64); if (BOTH(7)) xcd_barrier(bar); }
        if (IN(8)) { REP(8) p6::vsweep(H1B, V8, IDS, W8, WS8, ZB, SSF, F.lds + RING_OFF, slot, rank, nrank, F.wave, F.lane); if (BOTH(8)) xcd_barrier(bar); }
        if (PROBE_PH == 30) { for (int k = 0; k < 16; ++k) xcd_barrier(bar); }
        if (IN(9)) { REP(9) for (int t = gw; t < MREAL; t += NGW) p6::final_row(ZB, SSF, args.in[21], args.out, (size_t)t, F.lane); }
    }
#undef IN
#undef BOTH
}

extern "C" void kernel_launch(void* const* d_in, const int* in_sizes, int n_in, void* d_out, int out_size, void* d_ws, size_t ws_size, hipStream_t stream) {
    static int grid = 0;
    if (grid == 0) {
        int dev = 0, cus = 0;
        if (hipGetDevice(&dev) != hipSuccess || hipDeviceGetAttribute(&cus, hipDeviceAttributeMultiprocessorCount, dev) != hipSuccess) { fprintf(stderr, "kernel_launch: device query failed\n"); grid = -1; return; }
        if (hipFuncSetAttribute((const void*)fwd, hipFuncAttributeMaxDynamicSharedMemorySize, LDS_BYTES) != hipSuccess) { fprintf(stderr, "kernel_launch: hipFuncSetAttribute failed\n"); grid = -1; return; }
        int per_cu = 0;
        if (hipOccupancyMaxActiveBlocksPerMultiprocessor(&per_cu, (const void*)fwd, NWAVES * 64, LDS_BYTES) != hipSuccess || per_cu < 1) fprintf(stderr, "kernel_launch: occupancy query says %d\n", per_cu);
        (void)hipGetLastError();
        grid = cus;
        if (cus != 256) { fprintf(stderr, "kernel_launch: built for a 256-CU device (tile-to-workgroup maps of the GEMM phases), found %d CUs; nothing launched\n", cus); grid = -1; return; }
        if (ws_size < WS_END) { fprintf(stderr, "kernel_launch: ws too small %zu\n", ws_size); grid = -1; return; }
    }
    if (grid < 0) return;
    (void)hipMemsetAsync((char*)d_ws + WS_CTL, 0, CTL_ZERO_BYTES, stream);
    Args a{};
    for (int i = 0; i < 22; ++i) a.in[i] = (const float*)d_in[i];
    a.out = (float*)d_out; a.ws = (unsigned char*)d_ws; a.ph_lo = 0; a.ph_hi = 10;
    hipLaunchKernelGGL(fwd, dim3(grid), dim3(NWAVES * 64), LDS_BYTES, stream, a);
}
```

```cpp
#include <hip/hip_runtime.h>
#include <cstdio>
#include <cstdint>
#include <math.h>

#define D 2048
#define NB 8
#define SEQ 2048
#define NMETA 16
#define TT (SEQ + NMETA)
#define MR (NB * TT)
#define MREAL (NB * SEQ)
#define MPAD (MREAL + 256)
#define QD 1024
#define KVD 128
#define LW 1024
#define IND 3328
#define EPS 1e-6f
#define QSCALE (0.125f * 1.4426950408889634f)
#define GAS __attribute__((address_space(1)))
#define LAS __attribute__((address_space(3)))

#define DPP_I(x, ctrl) __builtin_amdgcn_update_dpp(0, (x), (ctrl), 0xf, 0xf, true)
__device__ __forceinline__ int dpp_x1(int x) { return DPP_I(x, 0xB1); }
__device__ __forceinline__ int dpp_x2(int x) { return DPP_I(x, 0x4E); }
__device__ __forceinline__ int dpp_hm(int x) { return DPP_I(x, 0x141); }
__device__ __forceinline__ int dpp_rm(int x) { return DPP_I(x, 0x140); }
__device__ __forceinline__ int dpp_r8(int x) { return DPP_I(x, 0x128); }
__device__ __forceinline__ float fdpp_x1(float x) { return __builtin_bit_cast(float, dpp_x1(__builtin_bit_cast(int, x))); }
__device__ __forceinline__ float fdpp_x2(float x) { return __builtin_bit_cast(float, dpp_x2(__builtin_bit_cast(int, x))); }
__device__ __forceinline__ float fdpp_hm(float x) { return __builtin_bit_cast(float, dpp_hm(__builtin_bit_cast(int, x))); }
__device__ __forceinline__ float fdpp_rm(float x) { return __builtin_bit_cast(float, dpp_rm(__builtin_bit_cast(int, x))); }
__device__ __forceinline__ float max16(float v) { v = fmaxf(v, fdpp_x1(v)); v = fmaxf(v, fdpp_x2(v)); v = fmaxf(v, fdpp_hm(v)); return fmaxf(v, fdpp_rm(v)); }
__device__ __forceinline__ float sum64(float v) {
    v += fdpp_x1(v); v += fdpp_x2(v); v += fdpp_hm(v); v += fdpp_rm(v);
    return (__builtin_bit_cast(float, __builtin_amdgcn_readlane(__builtin_bit_cast(int, v), 0)) + __builtin_bit_cast(float, __builtin_amdgcn_readlane(__builtin_bit_cast(int, v), 16)))
         + (__builtin_bit_cast(float, __builtin_amdgcn_readlane(__builtin_bit_cast(int, v), 32)) + __builtin_bit_cast(float, __builtin_amdgcn_readlane(__builtin_bit_cast(int, v), 48)));
}
__device__ __forceinline__ float max64(float v) {
    v = max16(v);
    return fmaxf(fmaxf(__builtin_bit_cast(float, __builtin_amdgcn_readlane(__builtin_bit_cast(int, v), 0)), __builtin_bit_cast(float, __builtin_amdgcn_readlane(__builtin_bit_cast(int, v), 16))),
                 fmaxf(__builtin_bit_cast(float, __builtin_amdgcn_readlane(__builtin_bit_cast(int, v), 32)), __builtin_bit_cast(float, __builtin_amdgcn_readlane(__builtin_bit_cast(int, v), 48))));
}
__device__ __forceinline__ float sum8(float v) { v += fdpp_x1(v); v += fdpp_x2(v); return v + fdpp_hm(v); }
__device__ __forceinline__ float sum4(float v) { v += fdpp_x1(v); return v + fdpp_x2(v); }
__device__ __forceinline__ float sum_x32(float v) { return v + __shfl_xor(v, 32); }
__device__ __forceinline__ float max_x32(float v) { return fmaxf(v, __shfl_xor(v, 32)); }
__device__ __forceinline__ float sum_x16(float v) { return v + __shfl_xor(v, 16); }
namespace pg8 {
#define PG8_LAS __attribute__((address_space(3)))
typedef unsigned short bf16_t;
typedef short bf16x8 __attribute__((ext_vector_type(8)));
typedef float f32x4 __attribute__((ext_vector_type(4)));
typedef unsigned u32x4 __attribute__((ext_vector_type(4)));
constexpr int BM = 256, BK = 64, HALF = 128, HTB = HALF * BK * 2  , STAGE_BYTES = 8 * HTB, NXCD = 8, WGM = 8;

__host__ __device__ __forceinline__ int lds_byte(int r, int c) { const int st = (r >> 4) * 2 + (c >> 5), rr = r & 15, cc = c & 31, ob = rr * 64 + cc * 2; return st * 1024 + (ob ^ (((ob >> 9) & 1) << 5)); }
__host__ __device__ __forceinline__ void stage_rc(int b, int& R, int& C) { const int st = b / 1024, sb = b % 1024, swz = sb ^ (((sb >> 9) & 1) << 5); R = (st >> 1) * 16 + swz / 64; C = (st & 1) * 32 + (swz % 64) / 2; }
__host__ __device__ __forceinline__ int perm32(int rho) { const int n = rho >> 4, i = rho & 15; return 8 * (i >> 2) + 4 * n + (i & 3); }

struct Unit { int pm, pn; };
struct Gemm { const bf16_t* A; const bf16_t* Bt; int M, N, K; };

struct StaticOrder {
    int nM, nN, nwg, G, c;
    __host__ __device__ void init(int M, int N, int G_, int c_) { nM = M / BM; nN = N / BM; nwg = nM * nN; G = G_; c = c_; }
    __host__ __device__ bool next(int i, Unit& u) const {
        const long L = (long)i * G + c; if (L >= nwg) return false;
        int wgid = (int)L; { const int q = nwg / NXCD, r = nwg % NXCD, xcd = wgid % NXCD, off = wgid / NXCD; wgid = (xcd < r ? xcd * (q + 1) : r * (q + 1) + (xcd - r) * q) + off; }
        const int nig = WGM * nN, gid = wgid / nig, fm = gid * WGM, gsz = (nM - fm) < WGM ? (nM - fm) : WGM;
        u.pm = fm + ((wgid % nig) % gsz); u.pn = (wgid % nig) / gsz; return true;
    }
    __device__ __forceinline__ void a_ready(const Unit&) const {}
    __device__ __forceinline__ void done(const Unit&) const {}
};

__device__ __forceinline__ unsigned cvt_pk_bf16(float lo, float hi) { unsigned r; asm volatile("v_cvt_pk_bf16_f32 %0, %1, %2" : "=v"(r) : "v"(lo), "v"(hi)); return r; }
typedef unsigned u32x2 __attribute__((ext_vector_type(2)));
struct Order1 {
    int G, c;
    __device__ __forceinline__ bool next(int i, Unit& u) const {
        const int L = i * G + c; if (L >= 837) return false;
        if (L >= 832) { u.pm = 64; u.pn = 4 + (L - 832); return true; }
        const int nwg = 832, nN = 13;
        int wgid = L; { const int q = nwg / NXCD, xcd = wgid % NXCD, off = wgid / NXCD; wgid = xcd * q + off; }
        const int nig = WGM * nN, gid = wgid / nig, fm = gid * WGM;
        u.pm = fm + ((wgid % nig) % WGM); u.pn = (wgid % nig) / WGM; return true;
    }
    __device__ __forceinline__ void a_ready(const Unit&) const {}
    __device__ __forceinline__ void done(const Unit&) const {}
};
struct Order2 {
    int G, c;
    __device__ __forceinline__ bool next(int i, Unit& u) const {
        const int L = i * G + c; if (L >= 512) return false;
        const int nwg = 512, nN = 8;
        int wgid = L; { const int q = nwg / NXCD, xcd = wgid % NXCD, off = wgid / NXCD; wgid = xcd * q + off; }
        const int nig = WGM * nN, gid = wgid / nig, fm = gid * WGM;
        u.pm = fm + ((wgid % nig) % WGM); u.pn = (wgid % nig) / WGM; return true;
    }
    __device__ __forceinline__ void a_ready(const Unit&) const {}
    __device__ __forceinline__ void done(const Unit&) const {}
};

struct Epi1 {
    static constexpr bool PERM = true, AFTER_DRAIN = false, MIDK = false;
    bf16_t *Q, *KV, *XB, *GT; const float* rstd; const float* bias;
    __device__ __forceinline__ void midk(f32x4 (&acc)[2][2][4][2], const Unit& u, int wr, int wc, int fr, int fq) const {}
    __device__ __forceinline__ void operator()(const f32x4 (&acc)[2][2][4][2], const Unit& u, int wr, int wc, int fr, int fq) const {
        const int row0 = u.pm * BM + wr * 64 + fr;
        bf16_t* base; int ldc, colb; float sc = 1.f;
        if (u.pn < 4) { base = Q; ldc = 1024; colb = u.pn * BM; sc = QSCALE; }
        else if (u.pn == 4) { base = KV; ldc = 256; colb = 0; }
        else if (u.pn < 9) { base = XB; ldc = 1024; colb = (u.pn - 5) * BM; }
        else { base = GT; ldc = 1024; colb = (u.pn - 9) * BM; }
        const int col0 = colb + wc * 32 + 8 * fq, bcol0 = u.pn * BM + wc * 32 + 8 * fq;
        f32x4 bv[2][2];
#pragma unroll
        for (int bj = 0; bj < 2; ++bj)
#pragma unroll
            for (int n = 0; n < 2; ++n) bv[bj][n] = *(const f32x4*)(bias + bcol0 + bj * HALF + 4 * n);
#pragma unroll
        for (int ai = 0; ai < 2; ++ai)
#pragma unroll
            for (int m = 0; m < 4; ++m) {
                const int row = row0 + ai * HALF + m * 16; const float rs = rstd[row];
                bf16_t* rowp = base + (size_t)row * ldc + col0;
#pragma unroll
                for (int bj = 0; bj < 2; ++bj) {
                    f32x4 v0 = (acc[ai][bj][m][0] * rs + bv[bj][0]) * sc, v1 = (acc[ai][bj][m][1] * rs + bv[bj][1]) * sc;
                    u32x4 w; w.x = cvt_pk_bf16(v0[0], v0[1]); w.y = cvt_pk_bf16(v0[2], v0[3]); w.z = cvt_pk_bf16(v1[0], v1[1]); w.w = cvt_pk_bf16(v1[2], v1[3]);
                    *(u32x4*)(rowp + bj * HALF) = w; } }
    }
};
struct Epi2 {
    static constexpr bool PERM = true, AFTER_DRAIN = false, MIDK = true;
    bf16_t* H1; const float* x; float* SS2; const LAS float* tbl; int pm0;
    __device__ __forceinline__ void midk(f32x4 (&acc)[2][2][4][2], const Unit& u, int wr, int wc, int fr, int fq) const {
        const LAS float* t = tbl + (u.pm == pm0 ? 0 : 512);
#pragma unroll
        for (int ai = 0; ai < 2; ++ai)
#pragma unroll
            for (int m = 0; m < 4; ++m) { const float ra = t[(ai * HALF + wr * 64 + m * 16 + fr) * 2];
#pragma unroll
                for (int bj = 0; bj < 2; ++bj)
#pragma unroll
                    for (int n = 0; n < 2; ++n) acc[ai][bj][m][n] = acc[ai][bj][m][n] * ra; }
    }
    __device__ __forceinline__ void operator()(const f32x4 (&acc)[2][2][4][2], const Unit& u, int wr, int wc, int fr, int fq) const {
        const LAS float* t = tbl + (u.pm == pm0 ? 0 : 512);
        const int col0 = u.pn * BM + wc * 32 + 8 * fq;
#pragma unroll
        for (int ai = 0; ai < 2; ++ai)
#pragma unroll
            for (int m = 0; m < 4; ++m) {
                const int rl = ai * HALF + wr * 64 + m * 16 + fr; const size_t row = (size_t)u.pm * BM + rl; const float rs = t[rl * 2 + 1];
                float ss = 0.f;
#pragma unroll
                for (int bj = 0; bj < 2; ++bj) {
                    const f32x4 x0 = *(const f32x4*)(x + row * 2048 + col0 + bj * HALF), x1 = *(const f32x4*)(x + row * 2048 + col0 + bj * HALF + 4);
                    const f32x4 v0 = acc[ai][bj][m][0] * rs + x0, v1 = acc[ai][bj][m][1] * rs + x1;
                    ss += (v0[0] * v0[0] + v0[1] * v0[1]) + (v0[2] * v0[2] + v0[3] * v0[3]) + (v1[0] * v1[0] + v1[1] * v1[1]) + (v1[2] * v1[2] + v1[3] * v1[3]);
                    u32x4 w; w.x = cvt_pk_bf16(v0[0], v0[1]); w.y = cvt_pk_bf16(v0[2], v0[3]); w.z = cvt_pk_bf16(v1[0], v1[1]); w.w = cvt_pk_bf16(v1[2], v1[3]);
                    *(u32x4*)(H1 + row * 2048 + col0 + bj * HALF) = w; }
                ss = sum_x32(sum_x16(ss));
                if (fq == 0) SS2[row * 32 + u.pn * 4 + wc] = ss;
            }
    }
};
struct Epi3 {
    static constexpr bool PERM = true, AFTER_DRAIN = false, MIDK = false;
    bf16_t* O;
    __device__ __forceinline__ void midk(f32x4 (&acc)[2][2][4][2], const Unit& u, int wr, int wc, int fr, int fq) const {}
    __device__ __forceinline__ void operator()(const f32x4 (&acc)[2][2][4][2], const Unit& u, int wr, int wc, int fr, int fq) const {
        const int col0 = u.pn * BM + wc * 32 + 8 * fq;
#pragma unroll
        for (int ai = 0; ai < 2; ++ai)
#pragma unroll
            for (int m = 0; m < 4; ++m) { const size_t row = (size_t)u.pm * BM + ai * HALF + wr * 64 + m * 16 + fr;
#pragma unroll
                for (int bj = 0; bj < 2; ++bj) { const f32x4 v0 = acc[ai][bj][m][0], v1 = acc[ai][bj][m][1];
                    u32x4 w; w.x = cvt_pk_bf16(v0[0], v0[1]); w.y = cvt_pk_bf16(v0[2], v0[3]); w.z = cvt_pk_bf16(v1[0], v1[1]); w.w = cvt_pk_bf16(v1[2], v1[3]);
                    *(u32x4*)(O + row * 2048 + col0 + bj * HALF) = w; } }
    }
};
template <class Epi, class Sched, bool ALIGN_EPI = false, bool SP2 = false>
__device__ __forceinline__ void gemm_phase(PG8_LAS unsigned char* lds, const Gemm g, const Sched& S, const Epi& E) {
    const int tid = threadIdx.x, wid = __builtin_amdgcn_readfirstlane(tid >> 6), lane = tid & 63, wr = wid >> 2, wc = wid & 3, fr = lane & 15, fq = lane >> 4;
    const int K = g.K, nt = K / BK;
    unsigned voffA[2], voffB[2];
#pragma unroll
    for (int i = 0; i < 2; ++i) { int R, C; stage_rc(tid * 16 + i * 8192, R, C); const int Rb = Epi::PERM ? ((R & ~31) + perm32(R & 31)) : R;
        voffA[i] = (unsigned)(R * K + C) * 2u; voffB[i] = (unsigned)(Rb * K + C) * 2u; }
    const size_t kstep = (size_t)(BK * 2);
    const size_t hstep = (size_t)HALF * K * 2;
    const size_t tstep = 2 * hstep;
    const unsigned ldsw = (unsigned)wid * 1024u;
    const int aoff = lds_byte(wr * 64 + fr, fq * 8), boff = lds_byte(wc * 32 + fr, fq * 8);
#define PG8_SA(b, h) (((b) * 2 + (h)) * HTB)
#define PG8_SB(b, h) ((4 + (b) * 2 + (h)) * HTB)
#define PG8_STAGE(bufoff, gbase, voff) do { _Pragma("unroll") for (int _i = 0; _i < 2; ++_i) \
        __builtin_amdgcn_global_load_lds((const unsigned*)((const char*)(gbase) + (voff)[_i]), (PG8_LAS unsigned*)(lds + (bufoff) + ldsw + _i * 8192), 16, 0, 0); } while (0)
#define PG8_LDA(dst, b, h) do { _Pragma("unroll") for (int m = 0; m < 4; ++m) _Pragma("unroll") for (int k = 0; k < 2; ++k) dst[m][k] = *(const PG8_LAS bf16x8*)(lds + PG8_SA(b, h) + aoff + m * 2048 + k * 1024); } while (0)
#define PG8_LDB(dst, b, h) do { _Pragma("unroll") for (int n = 0; n < 2; ++n) _Pragma("unroll") for (int k = 0; k < 2; ++k) dst[n][k] = *(const PG8_LAS bf16x8*)(lds + PG8_SB(b, h) + boff + n * 2048 + k * 1024); } while (0)
#define PG8_MMA(ai, bj, At, Bt) do { __builtin_amdgcn_s_setprio(1); _Pragma("unroll") for (int m = 0; m < 4; ++m) _Pragma("unroll") for (int n = 0; n < 2; ++n) _Pragma("unroll") for (int k = 0; k < 2; ++k) \
        acc[ai][bj][m][n] = __builtin_amdgcn_mfma_f32_16x16x32_bf16(Bt[n][k], At[m][k], acc[ai][bj][m][n], 0, 0, 0); __builtin_amdgcn_s_setprio(0); } while (0)
#define PG8_WAIT_V(n) asm volatile("s_waitcnt vmcnt(" #n ")" ::: "memory")
#define PG8_WAIT_L(n) asm volatile("s_waitcnt lgkmcnt(" #n ")" ::: "memory")
#define PG8_BAR __builtin_amdgcn_s_barrier()
#define PG8_SCHED __builtin_amdgcn_sched_barrier(0)
    Unit cur, nxt; int ui = 0;
    if (!S.next(0, cur)) return;
    f32x4 acc[2][2][4][2];
#pragma unroll
    for (int a = 0; a < 2; ++a)
#pragma unroll
        for (int b = 0; b < 2; ++b)
#pragma unroll
            for (int m = 0; m < 4; ++m)
#pragma unroll
                for (int n = 0; n < 2; ++n) acc[a][b][m][n] = (f32x4){0.f, 0.f, 0.f, 0.f};
    bf16x8 At[4][2], B0[2][2], B1[2][2];
    const char* cA = (const char*)g.A + (size_t)cur.pm * tstep; const char* cB = (const char*)g.Bt + (size_t)cur.pn * tstep;
    S.a_ready(cur);
    if constexpr (SP2) {
        PG8_STAGE(PG8_SB(0, 0), cB, voffB); PG8_STAGE(PG8_SB(0, 1), cB + hstep, voffB); PG8_STAGE(PG8_SA(0, 0), cA, voffA); PG8_STAGE(PG8_SA(0, 1), cA + hstep, voffA);
        if (wr == 1) PG8_BAR;
        PG8_WAIT_V(2); PG8_BAR;
        PG8_STAGE(PG8_SB(1, 0), cB + kstep, voffB); PG8_STAGE(PG8_SA(1, 0), cA + kstep, voffA); PG8_STAGE(PG8_SB(1, 1), cB + hstep + kstep, voffB);
        PG8_WAIT_V(6); PG8_BAR;
    } else {
        PG8_STAGE(PG8_SB(0, 0), cB, voffB); PG8_STAGE(PG8_SA(0, 0), cA, voffA); PG8_STAGE(PG8_SB(0, 1), cB + hstep, voffB); PG8_STAGE(PG8_SA(0, 1), cA + hstep, voffA);
        if (wr == 1) PG8_BAR;
        PG8_WAIT_V(4); PG8_BAR;
        PG8_STAGE(PG8_SB(1, 0), cB + kstep, voffB); PG8_STAGE(PG8_SA(1, 0), cA + kstep, voffA); PG8_STAGE(PG8_SB(1, 1), cB + hstep + kstep, voffB);
        PG8_WAIT_V(6); PG8_BAR;
    }
    for (;;) {
        const bool has_next = S.next(ui + 1, nxt);
        const char* nA = has_next ? (const char*)g.A + (size_t)nxt.pm * tstep : cA; const char* nB = has_next ? (const char*)g.Bt + (size_t)nxt.pn * tstep : cB;
        for (int t = 0; t < nt; t += 2) {
            if constexpr (Epi::MIDK) { if (t == nt / 2) E.midk(acc, cur, wr, wc, fr, fq); }
            const bool last = (t == nt - 2);
            const char* a1 = cA + (size_t)(t + 1) * kstep;
            const char* a2 = last ? nA : cA + (size_t)(t + 2) * kstep; const char* b2 = last ? nB : cB + (size_t)(t + 2) * kstep;
            const char* a3 = a2 + kstep; const char* b3 = b2 + kstep;
            if (last && has_next) S.a_ready(nxt);
            if constexpr (SP2) {
            PG8_LDB(B0, 0, 0); PG8_LDB(B1, 0, 1); PG8_SCHED; PG8_LDA(At, 0, 0); PG8_STAGE(PG8_SA(1, 1), a1 + hstep, voffA);
            PG8_WAIT_V(8); PG8_WAIT_L(0); PG8_BAR; PG8_MMA(0, 0, At, B0); PG8_MMA(0, 1, At, B1); PG8_BAR; PG8_SCHED;
            PG8_LDA(At, 0, 1); PG8_STAGE(PG8_SB(0, 0), b2, voffB); PG8_STAGE(PG8_SB(0, 1), b2 + hstep, voffB); PG8_STAGE(PG8_SA(0, 0), a2, voffA);
            PG8_WAIT_V(8); PG8_WAIT_L(0); PG8_BAR; PG8_MMA(1, 0, At, B0); PG8_MMA(1, 1, At, B1); PG8_BAR; PG8_SCHED;
            PG8_LDB(B0, 1, 0); PG8_LDB(B1, 1, 1); PG8_SCHED; PG8_LDA(At, 1, 0); PG8_STAGE(PG8_SA(0, 1), a2 + hstep, voffA);
            PG8_WAIT_V(8); PG8_WAIT_L(0); PG8_BAR; PG8_MMA(0, 0, At, B0); PG8_MMA(0, 1, At, B1); PG8_BAR; PG8_SCHED;
            PG8_LDA(At, 1, 1); PG8_STAGE(PG8_SB(1, 0), b3, voffB); PG8_STAGE(PG8_SB(1, 1), b3 + hstep, voffB); PG8_STAGE(PG8_SA(1, 0), a3, voffA);
            PG8_WAIT_V(8); PG8_WAIT_L(0); PG8_BAR; PG8_MMA(1, 0, At, B0); PG8_MMA(1, 1, At, B1); PG8_BAR; PG8_SCHED;
            } else {
            PG8_LDB(B0, 0, 0); PG8_SCHED; PG8_LDA(At, 0, 0); PG8_STAGE(PG8_SA(1, 1), a1 + hstep, voffA);
            PG8_WAIT_L(8); PG8_BAR; PG8_WAIT_L(0); PG8_MMA(0, 0, At, B0); PG8_BAR; PG8_SCHED;
            PG8_LDB(B1, 0, 1); PG8_STAGE(PG8_SB(0, 0), b2, voffB);
            PG8_BAR; PG8_WAIT_L(0); PG8_MMA(0, 1, At, B1); PG8_BAR;
            PG8_LDA(At, 0, 1); PG8_STAGE(PG8_SA(0, 0), a2, voffA);
            PG8_BAR; PG8_WAIT_L(0); PG8_MMA(1, 0, At, B0); PG8_BAR; PG8_SCHED;
            PG8_STAGE(PG8_SB(0, 1), b2 + hstep, voffB);
            PG8_WAIT_V(6); PG8_BAR; PG8_MMA(1, 1, At, B1); PG8_BAR;
            PG8_LDB(B0, 1, 0); PG8_SCHED; PG8_LDA(At, 1, 0); PG8_STAGE(PG8_SA(0, 1), a2 + hstep, voffA);
            PG8_WAIT_L(8); PG8_BAR; PG8_WAIT_L(0); PG8_MMA(0, 0, At, B0); PG8_BAR; PG8_SCHED;
            PG8_LDB(B1, 1, 1); PG8_STAGE(PG8_SB(1, 0), b3, voffB);
            PG8_BAR; PG8_WAIT_L(0); PG8_MMA(0, 1, At, B1); PG8_BAR;
            PG8_LDA(At, 1, 1); PG8_STAGE(PG8_SA(1, 0), a3, voffA);
            PG8_BAR; PG8_WAIT_L(0); PG8_MMA(1, 0, At, B0); PG8_BAR; PG8_SCHED;
            PG8_STAGE(PG8_SB(1, 1), b3 + hstep, voffB);
            PG8_WAIT_V(6); PG8_BAR; PG8_MMA(1, 1, At, B1); PG8_BAR;
            }
        }
        if constexpr (ALIGN_EPI) { if (wr == 0) PG8_BAR; }
        if constexpr (!Epi::AFTER_DRAIN) { E(acc, cur, wr, wc, fr, fq); S.done(cur); }
        if (!has_next) break;
#pragma unroll
        for (int a = 0; a < 2; ++a)
#pragma unroll
            for (int b = 0; b < 2; ++b)
#pragma unroll
                for (int m = 0; m < 4; ++m)
#pragma unroll
                    for (int n = 0; n < 2; ++n) acc[a][b][m][n] = (f32x4){0.f, 0.f, 0.f, 0.f};
        cur = nxt; cA = nA; cB = nB; ++ui;
        if constexpr (ALIGN_EPI) { if (wr == 1) PG8_BAR; }
    }
    PG8_WAIT_V(0);
    if constexpr (!ALIGN_EPI) { if (wr == 0) PG8_BAR; }
    PG8_BAR;
    if constexpr (Epi::AFTER_DRAIN) { E.fused(acc, cur, wr, wc, fr, fq, lds, wid, lane); S.done(cur); }
#undef PG8_SA
#undef PG8_SB
#undef PG8_STAGE
#undef PG8_LDA
#undef PG8_LDB
#undef PG8_MMA
#undef PG8_WAIT_V
#undef PG8_WAIT_L
#undef PG8_BAR
#undef PG8_SCHED
}
}
#define XB_TMO      128
#define XB_XCNT(j)  (256  + 64 * (j))
#define XB_XSUB(j)  (1280 + 64 * (j))
#define XB_XGEN(j)  (2304 + 64 * (j))
#define XB_TOP      3328
#define XB_TOPGEN   3392
#define XCD_BAR_WORDS 3456
#define XB_SPIN_CAP (1u << 18)

__device__ __forceinline__ unsigned xb_ld(unsigned* p)              { return __hip_atomic_load(p, __ATOMIC_RELAXED, __HIP_MEMORY_SCOPE_AGENT); }
__device__ __forceinline__ unsigned xb_add(unsigned* p, unsigned v) { return __hip_atomic_fetch_add(p, v, __ATOMIC_RELAXED, __HIP_MEMORY_SCOPE_AGENT); }
__device__ __forceinline__ unsigned xb_xcc_id() { return (unsigned)__builtin_amdgcn_s_getreg((3 << 11) | 20) & 0xFu; }
#define XB_SPIN(cond, bar) do { unsigned _sp = 0; while (cond) { __builtin_amdgcn_s_sleep(1); \
    if ((++_sp & 255u) == 0u) { if (xb_ld(&(bar)[XB_TMO])) break; if (_sp > XB_SPIN_CAP) { atomicAdd(&(bar)[XB_TMO], 1u); break; } } } } while (0)

struct XcdBarrier {
    unsigned* bar; unsigned x;
    volatile LAS unsigned* st;
};

__device__ __forceinline__ XcdBarrier xcd_barrier_post(unsigned* bar, volatile LAS unsigned* st) {
    XcdBarrier b; b.bar = bar; b.x = xb_xcc_id(); b.st = st;
    if (threadIdx.x == 0) (void)xb_add(&bar[XB_XCNT(b.x)], 1u);
    return b;
}
__device__ __forceinline__ void xcd_barrier_complete(unsigned* bar, unsigned x, unsigned& nloc, unsigned& nx) {
    const unsigned G = gridDim.x * gridDim.y * gridDim.z;
    unsigned sum, cnt, mine, sp = 0u;
    for (;;) {
        sum = 0u; cnt = 0u; mine = 0u;
#pragma unroll
        for (unsigned j = 0; j < 16; ++j) { const unsigned c = xb_ld(&bar[XB_XCNT(j)]); sum += c; cnt += (c > 0u) ? 1u : 0u; mine = (j == x) ? c : mine; }
        if (sum == G) break;
        __builtin_amdgcn_s_sleep(1);
        if ((++sp & 255u) == 0u) { if (xb_ld(&bar[XB_TMO])) break; if (sp > XB_SPIN_CAP) { atomicAdd(&bar[XB_TMO], 1u); break; } }
    }
    nloc = mine > 0u ? mine : 1u; nx = cnt > 0u ? cnt : 1u;
}

__device__ __forceinline__ void xcd_barrier(const XcdBarrier& b) {
    asm volatile("s_waitcnt vmcnt(0)" ::: "memory");
    __syncthreads();
    if (threadIdx.x == 0) {
        unsigned* bar = b.bar;
        __builtin_amdgcn_s_waitcnt(0);
        unsigned nloc = b.st[0], nx = b.st[1];
        if (nloc == 0u) { xcd_barrier_complete(bar, b.x, nloc, nx); b.st[0] = nloc; b.st[1] = nx; }
        const unsigned old = xb_add(&bar[XB_XSUB(b.x)], 1u);
        const unsigned gen = old / nloc;
        if (old + 1u == (gen + 1u) * nloc) {
            __builtin_amdgcn_fence(__ATOMIC_RELEASE, "agent");
            asm volatile("s_waitcnt vmcnt(0)" ::: "memory");
            const unsigned og = xb_add(&bar[XB_TOP], 1u);
            const unsigned tg = og / nx;
            if (og + 1u == (tg + 1u) * nx) xb_add(&bar[XB_TOPGEN], 1u);
            else XB_SPIN(xb_ld(&bar[XB_TOPGEN]) == tg, bar);
            __builtin_amdgcn_fence(__ATOMIC_ACQUIRE, "agent");
            xb_add(&bar[XB_XGEN(b.x)], 1u);
            asm volatile("s_waitcnt vmcnt(0)" ::: "memory");
        } else {
            XB_SPIN(xb_ld(&bar[XB_XGEN(b.x)]) == gen, bar);
            __builtin_amdgcn_fence(__ATOMIC_ACQUIRE, "agent");
            asm volatile("s_waitcnt vmcnt(0)" ::: "memory");
        }
    }
    __syncthreads();
}

constexpr int NWAVES = 8;
constexpr size_t MiB = 1u << 20;
constexpr size_t WS_CTL = 0, CTL_ZERO_BYTES = 1 * MiB;
constexpr size_t WS_W1T = 2 * MiB;
constexpr size_t WS_W2T = 16 * MiB;
constexpr size_t WS_W3T = 24 * MiB;
constexpr size_t WS_SKB = 32 * MiB;
constexpr size_t WS_RSTD1 = 33 * MiB;
constexpr size_t WS_SSA = 34 * MiB;
constexpr size_t WS_SSL = 35 * MiB;
constexpr size_t WS_SS2 = 37 * MiB;
constexpr size_t WS_RSTD2 = 39 * MiB;
constexpr size_t WS_IDS = 40 * MiB;
constexpr size_t WS_GW = 48 * MiB;
constexpr size_t WS_U8 = 64 * MiB;
constexpr size_t WS_V8 = 96 * MiB;
constexpr size_t WS_X8 = 128 * MiB;
constexpr size_t WS_SX = 160 * MiB;
constexpr size_t WS_SCU = 162 * MiB;
constexpr size_t WS_SCV = 163 * MiB;
constexpr size_t WS_WSUM = 164 * MiB;
constexpr size_t WS_A1 = 192 * MiB;
constexpr size_t WS_Q = 258 * MiB;
constexpr size_t WS_KV = 290 * MiB;
constexpr size_t WS_XB = 299 * MiB;
constexpr size_t WS_GT = 332 * MiB;
constexpr size_t WS_H1 = 364 * MiB;
constexpr size_t WS_PART = 192 * MiB;
constexpr size_t WS_W = 56 * MiB;
constexpr size_t WS_Z = 428 * MiB;
constexpr size_t WS_END = 492 * MiB;
constexpr int CW_QROW = 2048;
constexpr int CW_BAR = 4096;

constexpr int RING_OFF = 0, RING_BYTES = 131072;
constexpr int LDSCTL_OFF = RING_BYTES, MISC_OFF = LDSCTL_OFF + 320;
constexpr int LDS_BYTES = 147456;

typedef unsigned short bf16;
typedef unsigned v4u __attribute__((ext_vector_type(4)));
typedef float f32x4 __attribute__((ext_vector_type(4)));
typedef short bf16x8 __attribute__((ext_vector_type(8)));
typedef GAS unsigned gu32;
#define RLX_AGENT __ATOMIC_RELAXED, __HIP_MEMORY_SCOPE_AGENT
#define LDS_WAIT() asm volatile("s_waitcnt lgkmcnt(0)" ::: "memory")
#define VM_WAIT() asm volatile("s_waitcnt vmcnt(0)" ::: "memory")
__device__ __forceinline__ unsigned f2bf(float f) { unsigned u = __builtin_bit_cast(unsigned, f); return (u + 0x7fffu + ((u >> 16) & 1u)) >> 16; }
__device__ __forceinline__ unsigned pk2(float lo, float hi) { return f2bf(lo) | (f2bf(hi) << 16); }
__device__ __forceinline__ float bf2f(unsigned short b) { return __builtin_bit_cast(float, (unsigned)b << 16); }


namespace p2 {
typedef float f32x16 __attribute__((ext_vector_type(16)));
typedef unsigned u32x2 __attribute__((ext_vector_type(2)));
constexpr float LOG2E = 1.4426950408889634f;
constexpr float NEGBIG = -1e30f;
__device__ __forceinline__ int crow(int r, int hi) { return (r & 3) + 8 * (r >> 2) + 4 * hi; }
__device__ __forceinline__ unsigned cvtpk(float lo, float hi) { unsigned r; asm volatile("v_cvt_pk_bf16_f32 %0, %1, %2" : "=v"(r) : "v"(lo), "v"(hi)); return r; }
__device__ __forceinline__ float ex2(float x) { return __builtin_amdgcn_exp2f(x); }
__device__ __forceinline__ float rcp(float x) { return __builtin_amdgcn_rcpf(x); }
__device__ __forceinline__ float gelu_fast(float x) { return x * rcp(1.0f + ex2(x * (-2.302208198f - 0.102943240f * (x * x)))); }

constexpr int A_KS = 0, A_KSP = 144, A_VT = 288 * 144, A_VTP = 584, A_ST = A_VT + 64 * 584, A_END = A_ST + 8 * 4096;
__device__ __forceinline__ void attn_unit(LAS unsigned char* lds, int b, int qblk, int kvh, const bf16* QB, const bf16* KVB, const float* sinks, bf16* MIX, float* SSA, int tid) {
    const int lane = tid & 63, wave = __builtin_amdgcn_readfirstlane(tid >> 6), r = lane & 31, hi = lane >> 5;
    const int q0 = qblk * 128, hq = kvh * 8 + wave;
    for (int it = 0; it < 5; ++it) {
        const int cid = it * 512 + tid;
        if (cid < 288 * 8) {
            const int key = cid >> 3, ch = cid & 7;
            bool valid; size_t row = 0;
            if (key < 256) { const int pos = q0 - 128 + key; valid = pos >= 0; row = (size_t)b * SEQ + pos; }
            else if (key < 272) { valid = true; row = (size_t)MREAL + (key - 256); }
            else valid = false;
            v4u kv = {0u, 0u, 0u, 0u}, vv = {0u, 0u, 0u, 0u};
            if (valid) { kv = *(const GAS v4u*)(KVB + row * 256 + kvh * 64 + ch * 8); vv = *(const GAS v4u*)(KVB + row * 256 + 128 + kvh * 64 + ch * 8); }
            *(LAS v4u*)(lds + A_KS + key * A_KSP + ch * 16) = kv;
            LAS unsigned short* vt = (LAS unsigned short*)(lds + A_VT);
#pragma unroll
            for (int j = 0; j < 8; ++j) { const unsigned wv = vv[j >> 1]; vt[(ch * 8 + j) * (A_VTP / 2) + key] = (unsigned short)((j & 1) ? (wv >> 16) : (wv & 0xffffu)); }
        }
    }
    __syncthreads();
    const float sink2 = sinks[hq] * LOG2E;
    for (int qg = 0; qg < 4; ++qg) {
        const size_t mrow = (size_t)b * SEQ + q0 + 32 * qg + r;
        bf16x8 qf[4];
#pragma unroll
        for (int ks = 0; ks < 4; ++ks) qf[ks] = *(const GAS bf16x8*)(QB + mrow * 1024 + hq * 64 + ks * 16 + hi * 8);
        f32x16 s[6];
#pragma unroll
        for (int t = 0; t < 6; ++t) {
            const int kbase = t < 5 ? 32 * (qg + t) : 256;
            f32x16 acc = {0.f, 0.f, 0.f, 0.f, 0.f, 0.f, 0.f, 0.f, 0.f, 0.f, 0.f, 0.f, 0.f, 0.f, 0.f, 0.f};
#pragma unroll
            for (int ks = 0; ks < 4; ++ks) {
                const bf16x8 kf = *(const LAS bf16x8*)(lds + A_KS + (kbase + r) * A_KSP + ks * 32 + hi * 16);
                acc = __builtin_amdgcn_mfma_f32_32x32x16_bf16(kf, qf[ks], acc, 0, 0, 0);
            }
            s[t] = acc;
        }
        const bool blk0 = (qblk == 0);
#pragma unroll
        for (int reg = 0; reg < 16; ++reg) {
            const int j = crow(reg, hi);
            s[0][reg] = (j > r) ? s[0][reg] : NEGBIG;
            s[4][reg] = (j <= r) ? s[4][reg] : NEGBIG;
            s[5][reg] = (j < 16) ? s[5][reg] : NEGBIG;
        }
#pragma unroll
        for (int t = 0; t < 4; ++t) if (blk0 && (qg + t < 4)) {
#pragma unroll
            for (int reg = 0; reg < 16; ++reg) s[t][reg] = NEGBIG;
        }
        float m = sink2;
#pragma unroll
        for (int t = 0; t < 6; ++t)
#pragma unroll
            for (int reg = 0; reg < 16; ++reg) m = fmaxf(m, s[t][reg]);
        m = max_x32(m);
        float l = 0.f;
#pragma unroll
        for (int t = 0; t < 6; ++t)
#pragma unroll
            for (int reg = 0; reg < 16; ++reg) { const float p = ex2(s[t][reg] - m); s[t][reg] = p; l += p; }
        l = sum_x32(l);
        l += ex2(sink2 - m);
        const float linv = 1.0f / l;
        f32x16 o0 = {0.f, 0.f, 0.f, 0.f, 0.f, 0.f, 0.f, 0.f, 0.f, 0.f, 0.f, 0.f, 0.f, 0.f, 0.f, 0.f}, o1 = o0;
#pragma unroll
        for (int t = 0; t < 6; ++t) {
            const int kbase = t < 5 ? 32 * (qg + t) : 256;
#pragma unroll
            for (int ss = 0; ss < 2; ++ss) {
                v4u pw; pw.x = cvtpk(s[t][8 * ss + 0], s[t][8 * ss + 1]); pw.y = cvtpk(s[t][8 * ss + 2], s[t][8 * ss + 3]);
                pw.z = cvtpk(s[t][8 * ss + 4], s[t][8 * ss + 5]); pw.w = cvtpk(s[t][8 * ss + 6], s[t][8 * ss + 7]);
                const bf16x8 pa = __builtin_bit_cast(bf16x8, pw);
                const int ko = (kbase + 16 * ss + 4 * hi) * 2;
                {   const u32x2 lo = *(const LAS u32x2*)(lds + A_VT + r * A_VTP + ko), h2 = *(const LAS u32x2*)(lds + A_VT + r * A_VTP + ko + 16);
                    v4u vw; vw.x = lo.x; vw.y = lo.y; vw.z = h2.x; vw.w = h2.y;
                    o0 = __builtin_amdgcn_mfma_f32_32x32x16_bf16(pa, __builtin_bit_cast(bf16x8, vw), o0, 0, 0, 0); }
                {   const u32x2 lo = *(const LAS u32x2*)(lds + A_VT + (32 + r) * A_VTP + ko), h2 = *(const LAS u32x2*)(lds + A_VT + (32 + r) * A_VTP + ko + 16);
                    v4u vw; vw.x = lo.x; vw.y = lo.y; vw.z = h2.x; vw.w = h2.y;
                    o1 = __builtin_amdgcn_mfma_f32_32x32x16_bf16(pa, __builtin_bit_cast(bf16x8, vw), o1, 0, 0, 0); }
            }
        }
        LAS unsigned short* stg = (LAS unsigned short*)(lds + A_ST + wave * 4096);
#pragma unroll
        for (int reg = 0; reg < 16; ++reg) {
            const int qr = crow(reg, hi); const float li = __shfl(linv, qr);
            stg[qr * 64 + r] = (unsigned short)f2bf(o0[reg] * li);
            stg[qr * 64 + 32 + r] = (unsigned short)f2bf(o1[reg] * li);
        }
        asm volatile("s_waitcnt lgkmcnt(0)" ::: "memory");
#pragma unroll
        for (int i = 0; i < 4; ++i) {
            const int row = i * 8 + (lane >> 3), ch = lane & 7;
            const v4u v = *(const LAS v4u*)(stg + row * 64 + ch * 8);
            float ss = 0.f;
#pragma unroll
            for (int k = 0; k < 4; ++k) { const float a = __builtin_bit_cast(float, v[k] << 16), c = __builtin_bit_cast(float, v[k] & 0xffff0000u); ss += a * a + c * c; }
            ss = sum8(ss);
            const size_t orow = (size_t)b * SEQ + q0 + 32 * qg + row;
            *(GAS v4u*)(MIX + orow * D + hq * 64 + ch * 8) = v;
            if (ch == 0) SSA[orow * 16 + hq] = ss;
        }
        asm volatile("s_waitcnt lgkmcnt(0)" ::: "memory");
    }
    __syncthreads();
}

constexpr int LW_XS = 0, LW_GS = 4608, LW_XC = LW_GS + 2048, LW_XCF = LW_XC + 4608, LW_BYTES = LW_XCF + 4096 + 128;
constexpr int L_CT = 8 * LW_BYTES, L_END = L_CT + 2 * 2048;
static_assert(L_END <= 131072, "lru lds");
struct LruP { const float *conv_w, *conv_b, *w_r, *b_r, *w_i, *b_i, *lam; };
__device__ __forceinline__ void lru_unit(LAS unsigned char* lds, LAS unsigned char* ldsw  , int b, int nb, int cg, const bf16* XBB, const bf16* GTB, const LruP P, bf16* MIX, float* SSL, int tid) {
    const int lane = tid & 63, wave = __builtin_amdgcn_readfirstlane(tid >> 6), r = lane & 31, hi = lane >> 5;
    LAS unsigned char* lw = lds + wave * LW_BYTES;
    {
        LAS unsigned short* wt = (LAS unsigned short*)ldsw;
#pragma unroll
        for (int i = 0; i < 4; ++i) {
            const int e = tid + 512 * i, c = e >> 5, dl = e & 31;
            const size_t gi = (size_t)(nb * 64 + c) * 64 + 32 * cg + dl;
            wt[dl * 72 + c] = (unsigned short)f2bf(-LOG2E * P.w_r[gi]);
            wt[32 * 72 + dl * 72 + c] = (unsigned short)f2bf(-LOG2E * P.w_i[gi]);
        }
    }
    const int cc = lane, chc = nb * 64 + cc;
    const float cw0 = P.conv_w[0 * LW + chc], cw1 = P.conv_w[1 * LW + chc], cw2 = P.conv_w[2 * LW + chc], cw3 = P.conv_w[3 * LW + chc], cbv = P.conv_b[chc];
    const int chd = nb * 64 + 32 * cg + r;
    const float br = -LOG2E * P.b_r[chd], bi = -LOG2E * P.b_i[chd];
    const float ls8 = -8.0f * log1pf(expf(-P.lam[chd])) * LOG2E;
    float state = 0.f;
    v4u px[5], pg[2];
#define LRU_PREFETCH(tl) do { \
        _Pragma("unroll") for (int it = 0; it < 5; ++it) { const int cid = it * 64 + lane; px[it] = (v4u){0u, 0u, 0u, 0u}; \
            if (cid < 35 * 8) { const int j = cid >> 3, ch = cid & 7, t = 32 * wave + j - 3; bool valid; size_t row = 0; \
                if ((tl) == 0) { valid = (t >= 0 && t < NMETA); row = (size_t)MREAL + t; } \
                else if ((tl) == 1 && t < 0) { valid = true; row = (size_t)MREAL + NMETA + t; } \
                else { valid = true; row = (size_t)b * SEQ + 256 * ((tl) - 1) + t; } \
                if (valid) px[it] = *(const GAS v4u*)(XBB + row * 1024 + nb * 64 + ch * 8); } } \
        if ((tl) > 0) { _Pragma("unroll") for (int it = 0; it < 2; ++it) { const int cid = it * 64 + lane, t = 32 * wave + (cid >> 2), ch = cid & 3; \
            pg[it] = *(const GAS v4u*)(GTB + ((size_t)b * SEQ + 256 * ((tl) - 1) + t) * 1024 + nb * 64 + 32 * cg + ch * 8); } } } while (0)
    LRU_PREFETCH(0);
    __syncthreads();
    for (int tile = 0; tile < 9; ++tile) {
#pragma unroll
        for (int it = 0; it < 5; ++it) { const int cid = it * 64 + lane; if (cid < 35 * 8) *(LAS v4u*)(lw + LW_XS + (cid >> 3) * 128 + (cid & 7) * 16) = px[it]; }
        if (tile > 0) {
#pragma unroll
            for (int it = 0; it < 2; ++it) { const int cid = it * 64 + lane; *(LAS v4u*)(lw + LW_GS + (cid >> 2) * 64 + (cid & 3) * 16) = pg[it]; }
        }
        asm volatile("s_waitcnt lgkmcnt(0)" ::: "memory");
        if (tile + 1 < 9) LRU_PREFETCH(tile + 1);
        {
            const LAS unsigned short* xs = (const LAS unsigned short*)(lw + LW_XS);
            LAS unsigned short* xc = (LAS unsigned short*)(lw + LW_XC);
            LAS float* xcf = (LAS float*)(lw + LW_XCF);
            const bool own = (cc >> 5) == cg; const int xoff = own ? (cc & 31) : 32 * 32 + (cc & 31);
            float x0 = bf2f(xs[0 * 64 + cc]), x1 = bf2f(xs[1 * 64 + cc]), x2 = bf2f(xs[2 * 64 + cc]);
#pragma unroll 8
            for (int k = 0; k < 32; ++k) {
                const float x3 = bf2f(xs[(k + 3) * 64 + cc]);
                const float v = cbv + cw0 * x0 + cw1 * x1 + cw2 * x2 + cw3 * x3;
                xc[k * 72 + cc] = (unsigned short)cvtpk(v, v);
                xcf[(own ? k * 32 : 0) + xoff] = v;
                x0 = x1; x1 = x2; x2 = x3;
            }
        }
        asm volatile("s_waitcnt lgkmcnt(0)" ::: "memory");
        f32x16 aR = {br, br, br, br, br, br, br, br, br, br, br, br, br, br, br, br}, aI = {bi, bi, bi, bi, bi, bi, bi, bi, bi, bi, bi, bi, bi, bi, bi, bi};
#pragma unroll
        for (int ks = 0; ks < 4; ++ks) {
            const bf16x8 xa = *(const LAS bf16x8*)(lw + LW_XC + r * 144 + ks * 32 + hi * 16);
            const bf16x8 wr_ = *(const LAS bf16x8*)(ldsw + r * 144 + ks * 32 + hi * 16);
            const bf16x8 wi_ = *(const LAS bf16x8*)(ldsw + 32 * 144 + r * 144 + ks * 32 + hi * 16);
            aR = __builtin_amdgcn_mfma_f32_32x32x16_bf16(xa, wr_, aR, 0, 0, 0);
            aI = __builtin_amdgcn_mfma_f32_32x32x16_bf16(xa, wi_, aI, 0, 0, 0);
        }
        float Av[16], Bv[16];
        {
            const LAS float* xcf = (const LAS float*)(lw + LW_XCF);
#pragma unroll
            for (int reg = 0; reg < 16; ++reg) {
                const int tl = crow(reg, hi), t = 32 * wave + tl;
                const bool valid = (tile > 0) || (t < NMETA);
                const float rg = rcp(1.0f + ex2(aR[reg]));
                const float ig = rcp(1.0f + ex2(aI[reg]));
                const float a = ex2(rg * ls8);
                const float mult = __builtin_amdgcn_sqrtf(fmaxf(1.0f - a * a, 0.f));
                const float bx = mult * ig * xcf[tl * 32 + r];
                Av[reg] = valid ? a : 1.0f; Bv[reg] = valid ? bx : 0.0f;
            }
        }
#pragma unroll
        for (int g = 0; g < 4; ++g) {
#pragma unroll
            for (int k = 1; k < 4; ++k) { Bv[4 * g + k] = Av[4 * g + k] * Bv[4 * g + k - 1] + Bv[4 * g + k]; Av[4 * g + k] = Av[4 * g + k] * Av[4 * g + k - 1]; }
        }
        float myCz[4], myCp[4], PW, HW;
        {
            float cz = 0.f, cp = 1.f;
#pragma unroll
            for (int g = 0; g < 4; ++g) {
                const float mP = Av[4 * g + 3], mH = Bv[4 * g + 3];
                const float oP = __shfl_xor(mP, 32), oH = __shfl_xor(mH, 32);
                const float eP = hi ? oP : mP, eH = hi ? oH : mH, dP = hi ? mP : oP, dH = hi ? mH : oH;
                const float cz0 = cz, cp0 = cp;
                cz = eP * cz + eH; cp = cp * eP;
                myCz[g] = hi ? cz : cz0; myCp[g] = hi ? cp : cp0;
                cz = dP * cz + dH; cp = cp * dP;
            }
            PW = cp; HW = cz;
        }
        LAS float* ct = (LAS float*)(lds + L_CT + (tile & 1) * 2048);
        if (hi == 0) { ct[(wave * 32 + r) * 2] = PW; ct[(wave * 32 + r) * 2 + 1] = HW; }
        __syncthreads();
        float cin = 0.f;
        {
            float c = state;
#pragma unroll
            for (int w2 = 0; w2 < 8; ++w2) { if (w2 == wave) cin = c; c = ct[(w2 * 32 + r) * 2] * c + ct[(w2 * 32 + r) * 2 + 1]; }
            state = c;
        }
        if (tile > 0) {
            const LAS unsigned short* gs = (const LAS unsigned short*)(lw + LW_GS);
            LAS unsigned short* os = (LAS unsigned short*)(lw + LW_XS);
#pragma unroll
            for (int reg = 0; reg < 16; ++reg) {
                const int g = reg >> 2, tl = crow(reg, hi);
                const float h = Bv[reg] + Av[reg] * (myCz[g] + myCp[g] * cin);
                const float gt = bf2f(gs[tl * 32 + r]);
                { const float ov = gelu_fast(gt) * h; os[tl * 32 + r] = (unsigned short)cvtpk(ov, ov); }
            }
            asm volatile("s_waitcnt lgkmcnt(0)" ::: "memory");
#pragma unroll
            for (int it = 0; it < 2; ++it) {
                const int cid = it * 64 + lane, tl = cid >> 2, ch = cid & 3;
                const v4u v = *(const LAS v4u*)(lw + LW_XS + tl * 64 + ch * 16);
                float ss = 0.f;
#pragma unroll
                for (int k = 0; k < 4; ++k) { const float a = __builtin_bit_cast(float, v[k] << 16), c = __builtin_bit_cast(float, v[k] & 0xffff0000u); ss += a * a + c * c; }
                ss = sum4(ss);
                const size_t row = (size_t)b * SEQ + 256 * (tile - 1) + 32 * wave + tl;
                *(GAS v4u*)(MIX + row * D + 1024 + nb * 64 + 32 * cg + ch * 8) = v;
                if (ch == 0) SSL[row * 32 + nb * 2 + cg] = ss;
            }
            asm volatile("s_waitcnt lgkmcnt(0)" ::: "memory");
        }
    }
#undef LRU_PREFETCH
    __syncthreads();
}
}

namespace p5 {
typedef float f32x16 __attribute__((ext_vector_type(16)));
constexpr int KP = 272;
constexpr int R_KEYS = 0, R_IDX = 256 * KP, R_END = R_IDX + 8 * 1024;
__device__ __forceinline__ int crow(int r, int hi) { return (r & 3) + 8 * (r >> 2) + 4 * hi; }
__device__ __forceinline__ float fkey(float s, int mask, int payload) { return __builtin_bit_cast(float, (__builtin_bit_cast(int, s) & mask) | payload); }
__device__ __forceinline__ int fbits(float f) { return __builtin_bit_cast(int, f); }
__device__ __forceinline__ float fval(float f, int mask) { return __builtin_bit_cast(float, __builtin_bit_cast(int, f) & mask); }
__device__ __forceinline__ void ins16(float (&L)[16], float v) {
#pragma unroll
    for (int k = 15; k >= 1; --k) L[k] = __builtin_amdgcn_fmed3f(L[k - 1], L[k], v);
    L[0] = fmaxf(L[0], v);
}
__device__ __forceinline__ void half_top16(const LAS unsigned char* keys, const bf16x8 (&qf)[8], int r, int hi, float (&T)[16]) {
    float L[16];
#pragma unroll
    for (int k = 0; k < 16; ++k) L[k] = -INFINITY;
    const int h4 = 4 * hi;
#pragma unroll
    for (int kt = 0; kt < 4; ++kt) {
        f32x16 acc = {0.f, 0.f, 0.f, 0.f, 0.f, 0.f, 0.f, 0.f, 0.f, 0.f, 0.f, 0.f, 0.f, 0.f, 0.f, 0.f};
#pragma unroll
        for (int ks = 0; ks < 8; ++ks) {
            const bf16x8 kf = *(const LAS bf16x8*)(keys + (kt * 32 + r) * KP + ks * 32 + hi * 16);
            acc = __builtin_amdgcn_mfma_f32_32x32x16_bf16(kf, qf[ks], acc, 0, 0, 0);
        }
#pragma unroll
        for (int reg = 0; reg < 16; ++reg) {
            const int C = 127 - 32 * kt - (reg & 3) - 8 * (reg >> 2);
            ins16(L, fkey(acc[reg], (int)0xffffff80, C - h4));
        }
    }
    float M[16];
#pragma unroll
    for (int i = 0; i < 16; ++i) M[i] = fmaxf(L[i], __shfl_xor(L[15 - i], 32));
#define P5_STAGE(st) _Pragma("unroll") for (int i = 0; i < 16; ++i) if ((i & (st)) == 0) { const float a = fmaxf(M[i], M[i + (st)]), b = fminf(M[i], M[i + (st)]); M[i] = a; M[i + (st)] = b; }
    P5_STAGE(8) P5_STAGE(4) P5_STAGE(2) P5_STAGE(1)
#undef P5_STAGE
#pragma unroll
    for (int i = 0; i < 16; ++i) T[i] = M[i];
}

__device__ __forceinline__ void retr_unit(LAS unsigned char* lds, int h, int tg, const bf16* QPB, const bf16* SKB, unsigned short* IDS, float* GW, const float* RSTD2, int tid) {
    const int lane = tid & 63, wave = __builtin_amdgcn_readfirstlane(tid >> 6), r = lane & 31, hi = lane >> 5;
#pragma unroll
    for (int it = 0; it < 8; ++it) {
        const int cid = it * 512 + tid, row = cid >> 4, ch = cid & 15;
        *(LAS v4u*)(lds + R_KEYS + row * KP + ch * 16) = *(const GAS v4u*)(SKB + ((size_t)h * 256 + row) * 128 + ch * 8);
    }
    const size_t tok = (size_t)tg * 256 + wave * 32 + r;
    bf16x8 qa[8], qb[8];
#pragma unroll
    for (int ks = 0; ks < 8; ++ks) { qa[ks] = *(const GAS bf16x8*)(QPB + tok * D + h * 256 + ks * 16 + hi * 8); qb[ks] = *(const GAS bf16x8*)(QPB + tok * D + h * 256 + 128 + ks * 16 + hi * 8); }
    const float rs = RSTD2[tok];
    __syncthreads();
    float TA[16], TB[16];
    half_top16(lds + R_KEYS, qa, r, hi, TA);
    half_top16(lds + R_KEYS + 128 * KP, qb, r, hi, TB);
    LAS unsigned char* sc = lds + R_IDX + wave * 1024 + r * 32;
    const int hm = -hi;
    {
        v4u w;
#pragma unroll
        for (int q = 0; q < 4; ++q) { unsigned x = 0;
#pragma unroll
            for (int k = 0; k < 4; ++k) { const int t = (fbits(TB[4 * q + k]) & hm) | (fbits(TA[4 * q + k]) & ~hm); x |= (unsigned)(127 - (t & 0x7f)) << (8 * k); }
            w[q] = x; }
        *(LAS v4u*)(sc + hi * 16) = w;
    }
    float sA[16], sB[16];
#pragma unroll
    for (int i = 0; i < 16; ++i) { sA[i] = fval(TA[i], (int)0xffffff80); sB[i] = fval(TB[i], (int)0xffffff80); }
    float L[16];
#pragma unroll
    for (int k = 0; k < 16; ++k) L[k] = -INFINITY;
#pragma unroll
    for (int i = 0; i < 16; ++i)
#pragma unroll
        for (int j = 0; j < 16; ++j) if ((i + 1) * (j + 1) <= 16) {
            ins16(L, fkey(sA[i] + sB[j], (int)0xffffff00, 255 - (i * 16 + j)));
        }
    const float v0 = fval(L[0], (int)0xffffff00);
    asm volatile("s_waitcnt lgkmcnt(0)" ::: "memory");
    int ex[8]; float ew[8]; float esum = 0.f;
#pragma unroll
    for (int k = 0; k < 8; ++k) {
        const int t = (fbits(L[8 + k]) & hm) | (fbits(L[k]) & ~hm);
        const int c = 255 - (t & 0xff);
        const int ia = sc[c >> 4], ib = sc[16 + (c & 15)];
        ex[k] = ia * 128 + ib;
        const float e = __builtin_amdgcn_exp2f((__builtin_bit_cast(float, t & (int)0xffffff00) - v0) * rs * 1.4426950408889634f);
        ew[k] = e; esum += e;
    }
    esum = sum_x32(esum);
    const float inv = 1.0f / esum;
    unsigned short* ip = IDS + tok * 128 + h * 16 + hi * 8; float* gp = GW + tok * 128 + h * 16 + hi * 8;
    *(GAS v4u*)(ip) = (v4u){(unsigned)ex[0] | ((unsigned)ex[1] << 16), (unsigned)ex[2] | ((unsigned)ex[3] << 16), (unsigned)ex[4] | ((unsigned)ex[5] << 16), (unsigned)ex[6] | ((unsigned)ex[7] << 16)};
    *(GAS f32x4*)(gp) = (f32x4){ew[0] * inv, ew[1] * inv, ew[2] * inv, ew[3] * inv};
    *(GAS f32x4*)(gp + 4) = (f32x4){ew[4] * inv, ew[5] * inv, ew[6] * inv, ew[7] * inv};
    __syncthreads();
}
}

namespace p6 {
__device__ __forceinline__ float blo(unsigned w) { return __builtin_bit_cast(float, w << 16); }
__device__ __forceinline__ float bhi(unsigned w) { return __builtin_bit_cast(float, w & 0xffff0000u); }
__device__ __forceinline__ float gelu_fast(float x) { return x * __builtin_amdgcn_rcpf(1.0f + __builtin_amdgcn_exp2f(-2.302208198f * x * (1.0f + 0.044715f * x * x))); }
__device__ __forceinline__ unsigned idw(const v4u& a, const v4u& b, int g) { const unsigned w = g < 8 ? a[(g & 7) >> 1] : b[(g & 7) >> 1]; return (g & 1) ? (w >> 16) : (w & 0xffffu); }
__device__ __forceinline__ unsigned q4(float a, float b, float c, float d, float inv, int bias) {
    const int qa = (int)rintf(a * inv) + bias, qb = (int)rintf(b * inv) + bias, qc = (int)rintf(c * inv) + bias, qd = (int)rintf(d * inv) + bias;
    return (unsigned)(qa & 0xff) | ((unsigned)(qb & 0xff) << 8) | ((unsigned)(qc & 0xff) << 16) | ((unsigned)(qd & 0xff) << 24);
}
__device__ __forceinline__ void qrow_load(f32x4 (&v)[8], const float* src, size_t e, int lane) {
#pragma unroll
    for (int j = 0; j < 8; ++j) v[j] = __builtin_nontemporal_load((const GAS f32x4*)(src + e * D + j * 256 + lane * 4));
}
__device__ __forceinline__ void qrow_finish(f32x4 (&v)[8], const float* gcol, unsigned char* dst, float* scale_out, size_t e, int lane) {
    float am = 0.f;
#pragma unroll
    for (int j = 0; j < 8; ++j) {
        if (gcol) { const f32x4 g = *(const GAS f32x4*)(gcol + j * 256 + lane * 4); v[j] = v[j] * g; }
        am = fmaxf(am, fmaxf(fmaxf(fabsf(v[j].x), fabsf(v[j].y)), fmaxf(fabsf(v[j].z), fabsf(v[j].w))));
    }
    am = max64(am);
    const float inv = am > 0.f ? 127.0f / am : 0.f;
#pragma unroll
    for (int j = 0; j < 8; ++j)
        *(GAS unsigned*)(dst + ((size_t)(2 * j + (lane >> 5)) * 16384 + e) * 128 + (lane & 31) * 4) = q4(v[j].x, v[j].y, v[j].z, v[j].w, inv, 0);
    if (lane == 0) scale_out[e] = am * (1.0f / 127.0f);
}
__device__ __forceinline__ void qx_load(v4u (&x)[4], const bf16* H1B, size_t tok, int lane) {
#pragma unroll
    for (int j = 0; j < 4; ++j) x[j] = *(const GAS v4u*)(H1B + tok * D + j * 512 + lane * 8);
}
__device__ __forceinline__ void qx_finish(const v4u (&x)[4], unsigned char* X8, float* SX, size_t tok, int lane) {
#pragma unroll
    for (int j = 0; j < 4; ++j) {
        float f[8]; float am = 0.f;
#pragma unroll
        for (int k = 0; k < 4; ++k) { f[2 * k] = blo(x[j][k]); f[2 * k + 1] = bhi(x[j][k]); am = fmaxf(am, fmaxf(fabsf(f[2 * k]), fabsf(f[2 * k + 1]))); }
        am = max16(am);
        const float inv = am > 0.f ? 127.0f / am : 0.f;
        typedef unsigned u32x2v __attribute__((ext_vector_type(2)));
        u32x2v o; o.x = q4(f[0], f[1], f[2], f[3], inv, 0); o.y = q4(f[4], f[5], f[6], f[7], inv, 0);
        *(GAS u32x2v*)(X8 + tok * D + j * 512 + lane * 8) = o;
        if ((lane & 15) == 0) SX[tok * 16 + 4 * j + (lane >> 4)] = am * (1.0f / 127.0f);
    }
}

typedef int i32x16 __attribute__((ext_vector_type(16)));
typedef float f32x16v __attribute__((ext_vector_type(16)));
__device__ __forceinline__ int seli(int m, int a, int b) { return (a & m) | (b & ~m); }
__device__ __forceinline__ float self(int m, float a, float b) { return __builtin_bit_cast(float, seli(m, __builtin_bit_cast(int, a), __builtin_bit_cast(int, b))); }
__device__ __forceinline__ void usweep(const unsigned char* X8, const float* SX, const unsigned char* U8, const unsigned short* IDS, bf16* PART, LAS unsigned char* lds, int slot, int rank, int nrank, int wave, int lane) {
    const int ps = lane >> 3, ch = lane & 7;
    const int first = rank * 8 + wave, stride = nrank * 8;
    const int n = first < MREAL ? (MREAL - first + stride - 1) / stride : 0, NQ = 2 * n;
    if (NQ == 0) return;
    const int m4 = -((lane >> 2) & 1), m2 = -((lane >> 1) & 1), m1 = -(lane & 1);
    LAS unsigned char* sl = lds + wave * 1024;
#define U_LOAD(q_, RI, RX, SX_, T_, SG_) do { const int qq_ = (q_) < NQ ? (q_) : NQ - 1; const int rd_ = qq_ >= n ? 1 : 0; T_ = first + (qq_ - rd_ * n) * stride; SG_ = rd_ * 8 + slot; \
        RI = *(const GAS unsigned*)(IDS + (size_t)T_ * 128 + lane * 2); RX = *(const GAS unsigned*)(X8 + (size_t)T_ * D + SG_ * 128 + (lane & 31) * 4); SX_ = SX[(size_t)T_ * 16 + SG_]; } while (0)
#define U_EXPAND(SLOT, RI, RX, I0, I1, XV) do { LAS unsigned char* s_ = sl + (SLOT) * 512; \
        *(LAS unsigned*)(s_ + lane * 4) = RI; if (lane < 32) *(LAS unsigned*)(s_ + 256 + lane * 4) = RX; \
        asm volatile("s_waitcnt lgkmcnt(0)" ::: "memory"); \
        I0 = *(const LAS v4u*)(s_ + ps * 32); I1 = *(const LAS v4u*)(s_ + ps * 32 + 16); XV = *(const LAS v4u*)(s_ + 256 + ch * 16); } while (0)
#define U_ISSUE(BUF, I0, I1, SG_) do { const unsigned char* tab_ = U8 + (size_t)(SG_) * 16384 * 128 + ch * 16; \
        _Pragma("unroll") for (int g = 0; g < 16; ++g) BUF[g] = *(const GAS v4u*)(tab_ + (size_t)idw(I0, I1, g) * 128); } while (0)
#define U_FINISH(BUF, XV, SX_, T_, SG_) do { i32x16 d; \
        _Pragma("unroll") for (int g = 0; g < 16; ++g) { int a_ = __builtin_amdgcn_sdot4((int)BUF[g][0], (int)XV[0], 0, false); a_ = __builtin_amdgcn_sdot4((int)BUF[g][1], (int)XV[1], a_, false); \
            a_ = __builtin_amdgcn_sdot4((int)BUF[g][2], (int)XV[2], a_, false); a_ = __builtin_amdgcn_sdot4((int)BUF[g][3], (int)XV[3], a_, false); d[g] = a_; } \
        int r8[8], r4[4], r2[2]; \
        _Pragma("unroll") for (int k = 0; k < 8; ++k) r8[k] = seli(m4, d[8 + k], d[k]) + dpp_hm(seli(m4, d[k], d[8 + k])); \
        _Pragma("unroll") for (int k = 0; k < 4; ++k) r4[k] = seli(m2, r8[4 + k], r8[k]) + dpp_x2(seli(m2, r8[k], r8[4 + k])); \
        _Pragma("unroll") for (int k = 0; k < 2; ++k) r2[k] = seli(m1, r4[2 + k], r4[k]) + dpp_x1(seli(m1, r4[k], r4[2 + k])); \
        *(GAS unsigned*)(PART + ((size_t)(SG_) * MREAL + T_) * 128 + ps * 16 + 2 * ch) = pk2((float)r2[0] * SX_, (float)r2[1] * SX_); } while (0)
    v4u bufA[16], bufB[16];
    v4u a0, a1, ax, b0, b1, bx; unsigned ri, rx; float as, bs, cs; int at, bt, ct, ag, bg, cg;
    U_LOAD(0, ri, rx, as, at, ag); U_EXPAND(0, ri, rx, a0, a1, ax);
    U_LOAD(1, ri, rx, bs, bt, bg); U_EXPAND(1, ri, rx, b0, b1, bx);
    U_ISSUE(bufA, a0, a1, ag);
    for (int q = 0; q < NQ; q += 2) {
        U_ISSUE(bufB, b0, b1, bg);
        U_LOAD(q + 2, ri, rx, cs, ct, cg);
        U_FINISH(bufA, ax, as, at, ag);
        U_EXPAND(0, ri, rx, a0, a1, ax); as = cs; at = ct; ag = cg;
        U_ISSUE(bufA, a0, a1, ag);
        U_LOAD(q + 3, ri, rx, cs, ct, cg);
        U_FINISH(bufB, bx, bs, bt, bg);
        U_EXPAND(1, ri, rx, b0, b1, bx); bs = cs; bt = ct; bg = cg;
    }
#undef U_LOAD
#undef U_EXPAND
#undef U_ISSUE
#undef U_FINISH
}
__device__ __forceinline__ void wreduce(const bf16* PART, const float* GW, const float* RSTD2, const unsigned short* IDS, const float* SCU, const float* SCV, unsigned char* W8, float* WS8, size_t gt, size_t NT) {
    for (size_t i8 = gt; i8 < (size_t)MREAL * 128 / 8; i8 += NT) {
        float s[8];
#pragma unroll
        for (int k = 0; k < 8; ++k) s[k] = 0.f;
#pragma unroll 8
        for (int sg = 0; sg < 16; ++sg) {
            const v4u p = *(const GAS v4u*)(PART + (size_t)sg * MREAL * 128 + i8 * 8);
#pragma unroll
            for (int k = 0; k < 4; ++k) { s[2 * k] += blo(p[k]); s[2 * k + 1] += bhi(p[k]); }
        }
        const float rs = RSTD2[i8 >> 4];
        const v4u idv = *(const GAS v4u*)(IDS + i8 * 8);
        const f32x4 g0 = *(const GAS f32x4*)(GW + i8 * 8), g1 = *(const GAS f32x4*)(GW + i8 * 8 + 4);
        float w[8]; float am = 0.f;
#pragma unroll
        for (int k = 0; k < 8; ++k) {
            const unsigned e = (k & 1) ? (idv[k >> 1] >> 16) : (idv[k >> 1] & 0xffffu);
            const float g = k < 4 ? g0[k & 3] : g1[k & 3];
            w[k] = g * gelu_fast(rs * SCU[e] * s[k]) * SCV[e]; am = fmaxf(am, fabsf(w[k]));
        }
        am = max16(am);
        const float inv = am > 0.f ? 127.0f / am : 0.f;
        typedef unsigned u32x2v __attribute__((ext_vector_type(2)));
        u32x2v o; o.x = q4(w[0], w[1], w[2], w[3], inv, 0); o.y = q4(w[4], w[5], w[6], w[7], inv, 0);
        *(GAS u32x2v*)(W8 + i8 * 8) = o;
        if ((i8 & 15) == 0) WS8[i8 >> 4] = am * (1.0f / 127.0f);
    }
}
__device__ __forceinline__ void vsweep(const bf16* H1B, const unsigned char* V8, const unsigned short* IDS, const unsigned char* W8, const float* WS8, bf16* Z, float* SSF, LAS unsigned char* lds, int slot, int rank, int nrank, int wave, int lane) {
    const int ps = lane >> 3, ch = lane & 7;
    const int first = rank * 8 + wave, stride = nrank * 8;
    const int n = first < MREAL ? (MREAL - first + stride - 1) / stride : 0, NQ = 2 * n;
    if (NQ == 0) return;
    const int m8 = -((lane >> 3) & 1);
    LAS unsigned char* sl = lds + wave * 1024;
#define V_LOAD(q_, RI, RW, WSC, HX, T_, SG_) do { const int qq_ = (q_) < NQ ? (q_) : NQ - 1; const int rd_ = qq_ >= n ? 1 : 0; T_ = first + (qq_ - rd_ * n) * stride; SG_ = rd_ * 8 + slot; \
        RI = *(const GAS unsigned*)(IDS + (size_t)T_ * 128 + lane * 2); RW = *(const GAS unsigned*)(W8 + (size_t)T_ * 128 + (lane & 31) * 4); WSC = WS8[T_]; \
        HX = *(const GAS unsigned*)(H1B + (size_t)T_ * D + SG_ * 128 + ch * 16 + 2 * ps); } while (0)
#define V_EXPAND(SLOT, RI, RW, I0, I1, WQ) do { LAS unsigned char* s_ = sl + (SLOT) * 512; \
        *(LAS unsigned*)(s_ + lane * 4) = RI; if (lane < 32) *(LAS unsigned*)(s_ + 256 + lane * 4) = RW; \
        asm volatile("s_waitcnt lgkmcnt(0)" ::: "memory"); \
        I0 = *(const LAS v4u*)(s_ + ps * 32); I1 = *(const LAS v4u*)(s_ + ps * 32 + 16); WQ = *(const LAS v4u*)(s_ + 256 + ps * 16); } while (0)
#define V_ISSUE(BUF, I0, I1, SG_) do { const unsigned char* tab_ = V8 + (size_t)(SG_) * 16384 * 128 + ch * 16; \
        _Pragma("unroll") for (int g = 0; g < 16; ++g) BUF[g] = *(const GAS v4u*)(tab_ + (size_t)idw(I0, I1, g) * 128); } while (0)
#define V_FINISH(BUF, WQ, WSC, HX, T_, SG_) do { i32x16 acc = {0, 0, 0, 0, 0, 0, 0, 0, 0, 0, 0, 0, 0, 0, 0, 0}; const unsigned hx_ = HX; \
        _Pragma("unroll") for (int j = 0; j < 4; ++j) { const int wq_ = (int)WQ[j]; \
            _Pragma("unroll") for (int k = 0; k < 4; ++k) { \
                const unsigned d0_ = BUF[4 * j][k], d1_ = BUF[4 * j + 1][k], d2_ = BUF[4 * j + 2][k], d3_ = BUF[4 * j + 3][k]; \
                const unsigned p0_ = __builtin_amdgcn_perm(d1_, d0_, 0x05010400u), p1_ = __builtin_amdgcn_perm(d1_, d0_, 0x07030602u); \
                const unsigned q0_ = __builtin_amdgcn_perm(d3_, d2_, 0x05010400u), q1_ = __builtin_amdgcn_perm(d3_, d2_, 0x07030602u); \
                acc[4 * k + 0] = __builtin_amdgcn_sdot4((int)__builtin_amdgcn_perm(q0_, p0_, 0x05040100u), wq_, acc[4 * k + 0], false); \
                acc[4 * k + 1] = __builtin_amdgcn_sdot4((int)__builtin_amdgcn_perm(q0_, p0_, 0x07060302u), wq_, acc[4 * k + 1], false); \
                acc[4 * k + 2] = __builtin_amdgcn_sdot4((int)__builtin_amdgcn_perm(q1_, p1_, 0x05040100u), wq_, acc[4 * k + 2], false); \
                acc[4 * k + 3] = __builtin_amdgcn_sdot4((int)__builtin_amdgcn_perm(q1_, p1_, 0x07060302u), wq_, acc[4 * k + 3], false); } } \
        int r8[8], r4[4], r2[2]; \
        _Pragma("unroll") for (int k = 0; k < 8; ++k) { const auto rr_ = __builtin_amdgcn_permlane32_swap((unsigned)acc[k], (unsigned)acc[8 + k], false, false); r8[k] = (int)rr_[0] + (int)rr_[1]; } \
        _Pragma("unroll") for (int k = 0; k < 4; ++k) { const auto rr_ = __builtin_amdgcn_permlane16_swap((unsigned)r8[k], (unsigned)r8[4 + k], false, false); r4[k] = (int)rr_[0] + (int)rr_[1]; } \
        _Pragma("unroll") for (int k = 0; k < 2; ++k) r2[k] = seli(m8, r4[2 + k], r4[k]) + dpp_r8(seli(m8, r4[k], r4[2 + k])); \
        const float z0_ = (float)r2[0] * WSC + blo(hx_), z1_ = (float)r2[1] * WSC + bhi(hx_); \
        *(GAS unsigned*)(Z + (size_t)T_ * D + (SG_) * 128 + ch * 16 + 2 * ps) = pk2(z0_, z1_); \
        const float ss_ = sum64(z0_ * z0_ + z1_ * z1_); \
        if (lane == 0) SSF[(size_t)T_ * 16 + (SG_)] = ss_; } while (0)
    v4u bufA[16], bufB[16];
    v4u a0, a1, aw, b0, b1, bw; unsigned ri, rw, ah, bh, chx; float as, bs, cs; int at, bt, ct, ag, bg, cg;
    V_LOAD(0, ri, rw, as, ah, at, ag); V_EXPAND(0, ri, rw, a0, a1, aw);
    V_LOAD(1, ri, rw, bs, bh, bt, bg); V_EXPAND(1, ri, rw, b0, b1, bw);
    V_ISSUE(bufA, a0, a1, ag);
    for (int q = 0; q < NQ; q += 2) {
        V_ISSUE(bufB, b0, b1, bg);
        V_LOAD(q + 2, ri, rw, cs, chx, ct, cg);
        V_FINISH(bufA, aw, as, ah, at, ag);
        V_EXPAND(0, ri, rw, a0, a1, aw); as = cs; ah = chx; at = ct; ag = cg;
        V_ISSUE(bufA, a0, a1, ag);
        V_LOAD(q + 3, ri, rw, cs, chx, ct, cg);
        V_FINISH(bufB, bw, bs, bh, bt, bg);
        V_EXPAND(1, ri, rw, b0, b1, bw); bs = cs; bh = chx; bt = ct; bg = cg;
    }
#undef V_LOAD
#undef V_EXPAND
#undef V_ISSUE
#undef V_FINISH
}
__device__ __forceinline__ void final_row(const bf16* Z, const float* SSF, const float* fg, float* out, size_t tok, int lane) {
    v4u z[4];
#pragma unroll
    for (int j = 0; j < 4; ++j) z[j] = *(const GAS v4u*)(Z + tok * D + j * 512 + lane * 8);
    float ss = 0.f;
#pragma unroll
    for (int k = 0; k < 4; ++k) { const f32x4 v = *(const GAS f32x4*)(SSF + tok * 16 + 4 * k); ss += (v.x + v.y) + (v.z + v.w); }
    const float rf = 1.0f / sqrtf(ss * (1.0f / D) + EPS);
#pragma unroll
    for (int j = 0; j < 4; ++j) {
        const f32x4 ga = *(const GAS f32x4*)(fg + j * 512 + lane * 8), gb = *(const GAS f32x4*)(fg + j * 512 + lane * 8 + 4);
        *(GAS f32x4*)(out + tok * D + j * 512 + lane * 8) = (f32x4){blo(z[j][0]) * rf * ga.x, bhi(z[j][0]) * rf * ga.y, blo(z[j][1]) * rf * ga.z, bhi(z[j][1]) * rf * ga.w};
        *(GAS f32x4*)(out + tok * D + j * 512 + lane * 8 + 4) = (f32x4){blo(z[j][2]) * rf * gb.x, bhi(z[j][2]) * rf * gb.y, blo(z[j][3]) * rf * gb.z, bhi(z[j][3]) * rf * gb.w};
    }
}
}

struct Frame {
    LAS unsigned char* lds;
    volatile LAS unsigned* MISC;
    gu32* ctl;
    int tid, lane, wave, vcu, G;
};
__device__ __forceinline__ float wave_sum(float v) { return sum64(v); }
__device__ __forceinline__ void p0_transpose_item(const float* W, int K, int N, bf16* WT, const float* g0, const float* g1, int ksplit, LAS float* scr, int item, int lane) {
    const int nblk = N / 32, kb = item / nblk, nb = item % nblk, k0 = 64 * kb, n0 = 32 * nb;
#pragma unroll 16
    for (int i = 0; i < 32; ++i) { const int kk = 2 * i + (lane >> 5); const int kg = k0 + kk; const float gv = kg < ksplit ? g0[kg] : g1[kg - ksplit];
        scr[kk * 33 + (lane & 31)] = W[(size_t)kg * N + n0 + (lane & 31)] * gv; }
    LDS_WAIT(); asm volatile("" ::: "memory");
    const int c = lane & 7;
#pragma unroll
    for (int j = 0; j < 4; ++j) { const int n = (lane >> 3) + 8 * j; const LAS float* s = scr + (8 * c) * 33 + n;
        v4u o; o.x = pk2(s[0 * 33], s[1 * 33]); o.y = pk2(s[2 * 33], s[3 * 33]); o.z = pk2(s[4 * 33], s[5 * 33]); o.w = pk2(s[6 * 33], s[7 * 33]);
        *(GAS v4u*)(WT + (size_t)(n0 + n) * K + k0 + 8 * c) = o; }
    LDS_WAIT(); asm volatile("" ::: "memory");
}
__device__ __forceinline__ void p0_row_load(f32x4 (&v)[8], const float* xrow, int lane) {
    const GAS f32x4* xr = (const GAS f32x4*)xrow + lane;
#pragma unroll
    for (int j = 0; j < 8; ++j) v[j] = __builtin_nontemporal_load(xr + 64 * j);
}
__device__ __forceinline__ void p0_row_finish(const f32x4 (&v)[8], bf16* orow, float* rstd_out, int lane) {
    float s = 0.f;
#pragma unroll
    for (int j = 0; j < 8; ++j) s += (v[j].x * v[j].x + v[j].y * v[j].y) + (v[j].z * v[j].z + v[j].w * v[j].w);
    s = wave_sum(s);
    GAS unsigned long long* o8 = (GAS unsigned long long*)orow + lane;
#pragma unroll
    for (int j = 0; j < 8; ++j) o8[64 * j] = (unsigned long long)pk2(v[j].x, v[j].y) | ((unsigned long long)pk2(v[j].z, v[j].w) << 32);
    if (lane == 0) *rstd_out = 1.0f / sqrtf(s * (1.0f / D) + EPS);
}
__device__ __forceinline__ void p0_cvt8(const float* src, bf16* dst, const float* gcol, size_t idx8) {
    const f32x4 a = *(const GAS f32x4*)(src + idx8 * 8), b = *(const GAS f32x4*)(src + idx8 * 8 + 4);
    f32x4 ga = {1.f, 1.f, 1.f, 1.f}, gb = {1.f, 1.f, 1.f, 1.f};
    if (gcol) { const int c = (int)((idx8 * 8) & (D - 1)); ga = *(const GAS f32x4*)(gcol + c); gb = *(const GAS f32x4*)(gcol + c + 4); }
    v4u o; o.x = pk2(a.x * ga.x, a.y * ga.y); o.y = pk2(a.z * ga.z, a.w * ga.w); o.z = pk2(b.x * gb.x, b.y * gb.y); o.w = pk2(b.z * gb.z, b.w * gb.w);
    *(GAS v4u*)(dst + idx8 * 8) = o;
}

struct Args { const float* in[22]; float* out; unsigned char* ws; int ph_lo, ph_hi, rep_mask, pad; };

__global__ void __launch_bounds__(NWAVES * 64, 2) fwd(Args args) {
    extern __shared__ __attribute__((aligned(16))) unsigned char lds[];
    Frame F;
    F.lds = (LAS unsigned char*)lds;
    F.MISC = (volatile LAS unsigned*)(F.lds + MISC_OFF);
    F.tid = threadIdx.x; F.lane = F.tid & 63; F.wave = __builtin_amdgcn_readfirstlane(F.tid >> 6);
    F.G = gridDim.x; { const int bx = blockIdx.x; F.vcu = (F.G % 8 == 0) ? (bx % 8) * (F.G / 8) + bx / 8 : bx; }
    unsigned char* ws = args.ws;
    F.ctl = (gu32*)(ws + WS_CTL);
    for (int u = F.tid; u < (LDS_BYTES - LDSCTL_OFF) / 4; u += NWAVES * 64) ((LAS unsigned*)(F.lds + LDSCTL_OFF))[u] = 0u;
    __syncthreads();
    XcdBarrier bar = xcd_barrier_post((unsigned*)(F.ctl + CW_BAR), F.MISC + 8);
    const int lo = args.ph_lo, hi = args.ph_hi;
#define IN(k) (lo <= (k) && (k) < hi)
#define BOTH(k) (IN(k) && IN((k) + 1))
#ifndef PROBE_PH
#define PROBE_PH (-1)
#endif
#define REP(k) for (int rep_ = 0; rep_ < ((k) == PROBE_PH ? 2 : 1); ++rep_)

    const float* x = args.in[0]; const float* meta = args.in[1]; const float* norm_mix_g = args.in[2]; const float* w_in = args.in[3]; const float* b_in = args.in[4];
    const float* gn_attn_g = args.in[13]; const float* gn_lru_g = args.in[14]; const float* w_out = args.in[15]; const float* norm_ffn_g = args.in[16];
    const float* peer_wq = args.in[17]; const float* sub_keys = args.in[18]; const float* peer_u = args.in[19]; const float* peer_v = args.in[20];
    bf16* W1T = (bf16*)(ws + WS_W1T); bf16* W2T = (bf16*)(ws + WS_W2T); bf16* W3T = (bf16*)(ws + WS_W3T); bf16* SKB = (bf16*)(ws + WS_SKB);
    float* RSTD1 = (float*)(ws + WS_RSTD1);
    unsigned char* U8 = ws + WS_U8; unsigned char* V8 = ws + WS_V8; unsigned char* X8 = ws + WS_X8; float* SX = (float*)(ws + WS_SX); float* SCU = (float*)(ws + WS_SCU); float* SCV = (float*)(ws + WS_SCV);
    bf16* A1 = (bf16*)(ws + WS_A1);
    bf16* QB = (bf16*)(ws + WS_Q); bf16* KVB = (bf16*)(ws + WS_KV); bf16* XBB = (bf16*)(ws + WS_XB); bf16* GTB = (bf16*)(ws + WS_GT);

    if (IN(0)) { REP(0) {
        LAS float* scr = (LAS float*)(F.lds + RING_OFF + F.wave * 16384);
        const int gw = F.vcu * NWAVES + F.wave, NGW = F.G * NWAVES;
        constexpr int I_1 = (D / 64) * (IND / 32), I_2 = (D / 64) * (D / 32), I_3 = I_2;
        for (int it = gw; it < I_1 + I_2 + I_3; it += NGW) {
            int r = it;
            if (r < I_1) { p0_transpose_item(w_in, D, IND, W1T, norm_mix_g, norm_mix_g, D, scr, r, F.lane); continue; } r -= I_1;
            if (r < I_2) { p0_transpose_item(w_out, D, D, W2T, gn_attn_g, gn_lru_g, 1024, scr, r, F.lane); continue; } r -= I_2;
            p0_transpose_item(peer_wq, D, D, W3T, norm_ffn_g, norm_ffn_g, D, scr, r, F.lane);
        }
        {
            f32x4 cur[8], nxt[8];
            if (gw < MREAL + NMETA) p0_row_load(cur, gw < MREAL ? x + (size_t)gw * D : meta + (size_t)(gw - MREAL) * D, F.lane);
            for (int m = gw; m < MREAL + NMETA; m += NGW) {
                const int mn = m + NGW;
                if (mn < MREAL + NMETA) p0_row_load(nxt, mn < MREAL ? x + (size_t)mn * D : meta + (size_t)(mn - MREAL) * D, F.lane);
                p0_row_finish(cur, A1 + (size_t)m * D, RSTD1 + m, F.lane);
#pragma unroll
                for (int j = 0; j < 8; ++j) cur[j] = nxt[j];
            }
        }
        {
            const size_t gt = (size_t)gw * 64 + F.lane, NT = (size_t)NGW * 64;
            for (size_t i = gt; i < (size_t)(8 * 2 * 128 * 128) / 8; i += NT) p0_cvt8(sub_keys, SKB, nullptr, i);
            {
                f32x4 cur[8], nxt[8];
                constexpr int QV0 = 6144;
                if (QV0 + gw < 16384) p6::qrow_load(cur, peer_v, (size_t)(QV0 + gw), F.lane);
                for (int rj = QV0 + gw; rj < 16384; rj += NGW) {
                    const int rn = rj + NGW;
                    if (rn < 16384) p6::qrow_load(nxt, peer_v, (size_t)rn, F.lane);
                    p6::qrow_finish(cur, nullptr, V8, SCV, (size_t)rj, F.lane);
#pragma unroll
                    for (int j = 0; j < 8; ++j) cur[j] = nxt[j];
                }
            }
        } }
        if (BOTH(0)) xcd_barrier(bar);
    }
    if (IN(1)) {
        pg8::Gemm g{A1, W1T, MPAD, IND, D};
        pg8::Order1 S{F.G, (int)blockIdx.x};
        pg8::Epi1 E{QB, KVB, XBB, GTB, RSTD1, b_in};
        REP(1) pg8::gemm_phase<pg8::Epi1, pg8::Order1, true, true>(F.lds + RING_OFF, g, S, E);
        {
            volatile LAS int* qb = (volatile LAS int*)(F.lds + LDSCTL_OFF + 512);
            for (;;) {
                __syncthreads();
                if (F.tid == 0) qb[0] = (int)__hip_atomic_fetch_add((unsigned*)(F.ctl + CW_QROW), 32u, __ATOMIC_RELAXED, __HIP_MEMORY_SCOPE_AGENT);
                __syncthreads();
                const int base = qb[0];
                if (base >= 16384 + 6144) break;
                f32x4 r0[8], r1[8], r2[8], r3[8];
                const bool isu = base < 16384;
                const float* src = isu ? peer_u : peer_v; const float* gc = isu ? norm_ffn_g : nullptr; unsigned char* dst = isu ? U8 : V8; float* sc = isu ? SCU : SCV;
                const size_t e0 = (size_t)(isu ? base : base - 16384) + F.wave * 4;
                p6::qrow_load(r0, src, e0, F.lane); p6::qrow_load(r1, src, e0 + 1, F.lane); p6::qrow_load(r2, src, e0 + 2, F.lane); p6::qrow_load(r3, src, e0 + 3, F.lane);
                p6::qrow_finish(r0, gc, dst, sc, e0, F.lane); p6::qrow_finish(r1, gc, dst, sc, e0 + 1, F.lane);
                p6::qrow_finish(r2, gc, dst, sc, e0 + 2, F.lane); p6::qrow_finish(r3, gc, dst, sc, e0 + 3, F.lane);
            }
        }
        if (BOTH(1)) xcd_barrier(bar);
    }
    if (IN(2)) {
        bf16* MIX = (bf16*)(ws + WS_A1); float* SSA = (float*)(ws + WS_SSA); float* SSL = (float*)(ws + WS_SSL);
        const p2::LruP LP{args.in[6], args.in[7], args.in[8], args.in[9], args.in[10], args.in[11], args.in[12]};
        {
        REP(20) for (int u = (int)blockIdx.x; u < 256; u += F.G) p2::lru_unit(F.lds + RING_OFF, F.lds + LDSCTL_OFF + 5120, u >> 5, (u >> 1) & 15, u & 1, XBB, GTB, LP, MIX, SSL, F.tid);
        REP(21) for (int a = (int)blockIdx.x; a < 256; a += F.G) p2::attn_unit(F.lds + RING_OFF, a >> 5, (a >> 1) & 15, a & 1, QB, KVB, args.in[5], MIX, SSA, F.tid);
        }
        if (BOTH(2)) xcd_barrier(bar);
    }
    if (IN(3)) {
        bf16* MIX = (bf16*)(ws + WS_A1); const float* SSA = (const float*)(ws + WS_SSA); const float* SSL = (const float*)(ws + WS_SSL);
        bf16* H1B = (bf16*)(ws + WS_H1); float* SS2 = (float*)(ws + WS_SS2);
        pg8::Order2 S{F.G, (int)blockIdx.x};
        LAS float* tbl = (LAS float*)(F.lds + LDSCTL_OFF + 1024);
        pg8::Unit u0{0, 0};
        for (int i = 0; i < 2; ++i) {
            pg8::Unit u; if (!S.next(i, u)) break; if (i == 0) u0 = u;
            if (F.tid < 256) {
                const size_t row = (size_t)u.pm * 256 + F.tid; float sa = 0.f, sl = 0.f;
#pragma unroll
                for (int k = 0; k < 4; ++k) { const f32x4 v = *(const GAS f32x4*)(SSA + row * 16 + 4 * k); sa += (v.x + v.y) + (v.z + v.w); }
#pragma unroll
                for (int k = 0; k < 8; ++k) { const f32x4 v = *(const GAS f32x4*)(SSL + row * 32 + 4 * k); sl += (v.x + v.y) + (v.z + v.w); }
                const float ra = 1.0f / sqrtf(sa * (1.0f / 1024) + EPS), rl = 1.0f / sqrtf(sl * (1.0f / 1024) + EPS);
                tbl[(i * 256 + F.tid) * 2] = ra / rl; tbl[(i * 256 + F.tid) * 2 + 1] = rl;
            }
        }
        __syncthreads();
        pg8::Gemm g{MIX, W2T, MREAL, D, D};
        pg8::Epi2 E{H1B, x, SS2, (const LAS float*)tbl, u0.pm};
        REP(3) pg8::gemm_phase<pg8::Epi2, pg8::Order2, true, true>(F.lds + RING_OFF, g, S, E);
        if (BOTH(3)) xcd_barrier(bar);
    }
    if (IN(4)) {
        bf16* H1B = (bf16*)(ws + WS_H1); bf16* QPB = (bf16*)(ws + WS_A1);
        pg8::Order2 S{F.G, (int)blockIdx.x};
        {
            const float* SS2 = (const float*)(ws + WS_SS2); float* RSTD2 = (float*)(ws + WS_RSTD2);
            pg8::Unit u; if (S.next(0, u) && F.tid < 256) {
                const size_t row = (size_t)u.pm * 256 + F.tid; float ssq = 0.f;
#pragma unroll
                for (int k = 0; k < 8; ++k) { const f32x4 v = *(const GAS f32x4*)(SS2 + row * 32 + 4 * k); ssq += (v.x + v.y) + (v.z + v.w); }
                RSTD2[row] = 1.0f / sqrtf(ssq * (1.0f / D) + EPS);
            }
        }
        pg8::Gemm g{H1B, W3T, MREAL, D, D};
        pg8::Epi3 E{QPB};
        REP(4) pg8::gemm_phase<pg8::Epi3, pg8::Order2, true, true>(F.lds + RING_OFF, g, S, E);
        if (BOTH(4)) xcd_barrier(bar);
    }
    if (IN(5)) {
        const bf16* QPB = (const bf16*)(ws + WS_A1);
        unsigned short* IDS = (unsigned short*)(ws + WS_IDS); float* GW = (float*)(ws + WS_GW); float* RSTD2 = (float*)(ws + WS_RSTD2);
        const bf16* H1B = (const bf16*)(ws + WS_H1);
        REP(5) for (int u = (int)blockIdx.x; u < 512; u += F.G) {
            v4u xq[4][4]; const size_t tb = (size_t)(u >> 3) * 256 + F.wave * 32 + (u & 7);
#pragma unroll
            for (int k = 0; k < 4; ++k) p6::qx_load(xq[k], H1B, tb + 8 * k, F.lane);
            p5::retr_unit(F.lds + RING_OFF, u & 7, u >> 3, QPB, SKB, IDS, GW, RSTD2, F.tid);
#pragma unroll
            for (int k = 0; k < 4; ++k) p6::qx_finish(xq[k], X8, SX, tb + 8 * k, F.lane);
        }
        if (BOTH(5)) xcd_barrier(bar);
    }
    {
        const bf16* H1B = (const bf16*)(ws + WS_H1); const unsigned short* IDS = (const unsigned short*)(ws + WS_IDS); const float* GW = (const float*)(ws + WS_GW);
        const float* RSTD2 = (const float*)(ws + WS_RSTD2); bf16* PART = (bf16*)(ws + WS_PART); unsigned char* W8 = ws + WS_W; float* WS8 = (float*)(ws + WS_WSUM); bf16* ZB = (bf16*)(ws + WS_Z); float* SSF = (float*)(ws + WS_SSL);
        const int slot = (int)blockIdx.x & 7, rank = (int)blockIdx.x >> 3, nrank = (F.G - slot + 7) >> 3;
        const int gw = F.vcu * NWAVES + F.wave, NGW = F.G * NWAVES;
        if (IN(6)) { REP(6) p6::usweep(X8, SX, U8, IDS, PART, F.lds + RING_OFF, slot, rank, nrank, F.wave, F.lane); if (BOTH(6)) xcd_barrier(bar); }
        if (IN(7)) { REP(7) p6::wreduce(PART, GW, RSTD2, IDS, SCU, SCV, W8, WS8, (size_t)gw * 64 + F.lane, (size_t)NGW * 64); if (BOTH(7)) xcd_barrier(bar); }
        if (IN(8)) { REP(8) p6::vsweep(H1B, V8, IDS, W8, WS8, ZB, SSF, F.lds + RING_OFF, slot, rank, nrank, F.wave, F.lane); if (BOTH(8)) xcd_barrier(bar); }
        if (PROBE_PH == 30) { for (int k = 0; k < 16; ++k) xcd_barrier(bar); }
        if (IN(9)) { REP(9) for (int t = gw; t < MREAL; t += NGW) p6::final_row(ZB, SSF, args.in[21], args.out, (size_t)t, F.lane); }
    }
#undef IN
#undef BOTH
}

extern "C" void kernel_launch(void* const* d_in, const int* in_sizes, int n_in, void* d_out, int out_size, void* d_ws, size_t ws_size, hipStream_t stream) {
    static int grid = 0;
    if (grid == 0) {
        int dev = 0, cus = 0;
        if (hipGetDevice(&dev) != hipSuccess || hipDeviceGetAttribute(&cus, hipDeviceAttributeMultiprocessorCount, dev) != hipSuccess) { fprintf(stderr, "kernel_launch: device query failed\n"); grid = -1; return; }
        if (hipFuncSetAttribute((const void*)fwd, hipFuncAttributeMaxDynamicSharedMemorySize, LDS_BYTES) != hipSuccess) { fprintf(stderr, "kernel_launch: hipFuncSetAttribute failed\n"); grid = -1; return; }
        int per_cu = 0;
        if (hipOccupancyMaxActiveBlocksPerMultiprocessor(&per_cu, (const void*)fwd, NWAVES * 64, LDS_BYTES) != hipSuccess || per_cu < 1) fprintf(stderr, "kernel_launch: occupancy query says %d\n", per_cu);
        (void)hipGetLastError();
        grid = cus;
        if (cus != 256) { fprintf(stderr, "kernel_launch: built for a 256-CU device (tile-to-workgroup maps of the GEMM phases), found %d CUs; nothing launched\n", cus); grid = -1; return; }
        if (ws_size < WS_END) { fprintf(stderr, "kernel_launch: ws too small %zu\n", ws_size); grid = -1; return; }
    }
    if (grid < 0) return;
    (void)hipMemsetAsync((char*)d_ws + WS_CTL, 0, CTL_ZERO_BYTES, stream);
    Args a{};
    for (int i = 0; i < 22; ++i) a.in[i] = (const float*)d_in[i];
    a.out = (float*)d_out; a.ws = (unsigned char*)d_ws; a.ph_lo = 0; a.ph_hi = 10;
    hipLaunchKernelGGL(fwd, dim3(grid), dim3(NWAVES * 64), LDS_BYTES, stream, a);
}
```

```cpp
#include <hip/hip_runtime.h>
#include <cstdio>
#include <cstdint>
#include <math.h>

#define D 2048
#define NB 8
#define SEQ 2048
#define NMETA 16
#define TT (SEQ + NMETA)
#define MR (NB * TT)
#define MREAL (NB * SEQ)
#define MPAD (MREAL + 256)
#define QD 1024
#define KVD 128
#define LW 1024
#define IND 3328
#define EPS 1e-6f
#define QSCALE (0.125f * 1.4426950408889634f)
#define GAS __attribute__((address_space(1)))
#define LAS __attribute__((address_space(3)))

#define DPP_I(x, ctrl) __builtin_amdgcn_update_dpp(0, (x), (ctrl), 0xf, 0xf, true)
__device__ __forceinline__ int dpp_x1(int x) { return DPP_I(x, 0xB1); }
__device__ __forceinline__ int dpp_x2(int x) { return DPP_I(x, 0x4E); }
__device__ __forceinline__ int dpp_hm(int x) { return DPP_I(x, 0x141); }
__device__ __forceinline__ int dpp_rm(int x) { return DPP_I(x, 0x140); }
__device__ __forceinline__ int dpp_r8(int x) { return DPP_I(x, 0x128); }
__device__ __forceinline__ float fdpp_x1(float x) { return __builtin_bit_cast(float, dpp_x1(__builtin_bit_cast(int, x))); }
__device__ __forceinline__ float fdpp_x2(float x) { return __builtin_bit_cast(float, dpp_x2(__builtin_bit_cast(int, x))); }
__device__ __forceinline__ float fdpp_hm(float x) { return __builtin_bit_cast(float, dpp_hm(__builtin_bit_cast(int, x))); }
__device__ __forceinline__ float fdpp_rm(float x) { return __builtin_bit_cast(float, dpp_rm(__builtin_bit_cast(int, x))); }
__device__ __forceinline__ float max16(float v) { v = fmaxf(v, fdpp_x1(v)); v = fmaxf(v, fdpp_x2(v)); v = fmaxf(v, fdpp_hm(v)); return fmaxf(v, fdpp_rm(v)); }
__device__ __forceinline__ float sum64(float v) {
    v += fdpp_x1(v); v += fdpp_x2(v); v += fdpp_hm(v); v += fdpp_rm(v);
    return (__builtin_bit_cast(float, __builtin_amdgcn_readlane(__builtin_bit_cast(int, v), 0)) + __builtin_bit_cast(float, __builtin_amdgcn_readlane(__builtin_bit_cast(int, v), 16)))
         + (__builtin_bit_cast(float, __builtin_amdgcn_readlane(__builtin_bit_cast(int, v), 32)) + __builtin_bit_cast(float, __builtin_amdgcn_readlane(__builtin_bit_cast(int, v), 48)));
}
__device__ __forceinline__ float max64(float v) {
    v = max16(v);
    return fmaxf(fmaxf(__builtin_bit_cast(float, __builtin_amdgcn_readlane(__builtin_bit_cast(int, v), 0)), __builtin_bit_cast(float, __builtin_amdgcn_readlane(__builtin_bit_cast(int, v), 16))),
                 fmaxf(__builtin_bit_cast(float, __builtin_amdgcn_readlane(__builtin_bit_cast(int, v), 32)), __builtin_bit_cast(float, __builtin_amdgcn_readlane(__builtin_bit_cast(int, v), 48))));
}
__device__ __forceinline__ float sum8(float v) { v += fdpp_x1(v); v += fdpp_x2(v); return v + fdpp_hm(v); }
__device__ __forceinline__ float sum4(float v) { v += fdpp_x1(v); return v + fdpp_x2(v); }
__device__ __forceinline__ float sum_x32(float v) { return v + __shfl_xor(v, 32); }
__device__ __forceinline__ float max_x32(float v) { return fmaxf(v, __shfl_xor(v, 32)); }
__device__ __forceinline__ float sum_x16(float v) { return v + __shfl_xor(v, 16); }
namespace pg8 {
#define PG8_LAS __attribute__((address_space(3)))
typedef unsigned short bf16_t;
typedef short bf16x8 __attribute__((ext_vector_type(8)));
typedef float f32x4 __attribute__((ext_vector_type(4)));
typedef unsigned u32x4 __attribute__((ext_vector_type(4)));
constexpr int BM = 256, BK = 64, HALF = 128, HTB = HALF * BK * 2  , STAGE_BYTES = 8 * HTB, NXCD = 8, WGM = 8;

__host__ __device__ __forceinline__ int lds_byte(int r, int c) { const int st = (r >> 4) * 2 + (c >> 5), rr = r & 15, cc = c & 31, ob = rr * 64 + cc * 2; return st * 1024 + (ob ^ (((ob >> 9) & 1) << 5)); }
__host__ __device__ __forceinline__ void stage_rc(int b, int& R, int& C) { const int st = b / 1024, sb = b % 1024, swz = sb ^ (((sb >> 9) & 1) << 5); R = (st >> 1) * 16 + swz / 64; C = (st & 1) * 32 + (swz % 64) / 2; }
__host__ __device__ __forceinline__ int perm32(int rho) { const int n = rho >> 4, i = rho & 15; return 8 * (i >> 2) + 4 * n + (i & 3); }

struct Unit { int pm, pn; };
struct Gemm { const bf16_t* A; const bf16_t* Bt; int M, N, K; };

struct StaticOrder {
    int nM, nN, nwg, G, c;
    __host__ __device__ void init(int M, int N, int G_, int c_) { nM = M / BM; nN = N / BM; nwg = nM * nN; G = G_; c = c_; }
    __host__ __device__ bool next(int i, Unit& u) const {
        const long L = (long)i * G + c; if (L >= nwg) return false;
        int wgid = (int)L; { const int q = nwg / NXCD, r = nwg % NXCD, xcd = wgid % NXCD, off = wgid / NXCD; wgid = (xcd < r ? xcd * (q + 1) : r * (q + 1) + (xcd - r) * q) + off; }
        const int nig = WGM * nN, gid = wgid / nig, fm = gid * WGM, gsz = (nM - fm) < WGM ? (nM - fm) : WGM;
        u.pm = fm + ((wgid % nig) % gsz); u.pn = (wgid % nig) / gsz; return true;
    }
    __device__ __forceinline__ void a_ready(const Unit&) const {}
    __device__ __forceinline__ void done(const Unit&) const {}
};

__device__ __forceinline__ unsigned cvt_pk_bf16(float lo, float hi) { unsigned r; asm volatile("v_cvt_pk_bf16_f32 %0, %1, %2" : "=v"(r) : "v"(lo), "v"(hi)); return r; }
typedef unsigned u32x2 __attribute__((ext_vector_type(2)));
struct Order1 {
    int G, c;
    __device__ __forceinline__ bool next(int i, Unit& u) const {
        const int L = i * G + c; if (L >= 837) return false;
        if (L >= 832) { u.pm = 64; u.pn = 4 + (L - 832); return true; }
        const int nwg = 832, nN = 13;
        int wgid = L; { const int q = nwg / NXCD, xcd = wgid % NXCD, off = wgid / NXCD; wgid = xcd * q + off; }
        const int nig = WGM * nN, gid = wgid / nig, fm = gid * WGM;
        u.pm = fm + ((wgid % nig) % WGM); u.pn = (wgid % nig) / WGM; return true;
    }
    __device__ __forceinline__ void a_ready(const Unit&) const {}
    __device__ __forceinline__ void done(const Unit&) const {}
};
struct Order2 {
    int G, c;
    __device__ __forceinline__ bool next(int i, Unit& u) const {
        const int L = i * G + c; if (L >= 512) return false;
        const int nwg = 512, nN = 8;
        int wgid = L; { const int q = nwg / NXCD, xcd = wgid % NXCD, off = wgid / NXCD; wgid = xcd * q + off; }
        const int nig = WGM * nN, gid = wgid / nig, fm = gid * WGM;
        u.pm = fm + ((wgid % nig) % WGM); u.pn = (wgid % nig) / WGM; return true;
    }
    __device__ __forceinline__ void a_ready(const Unit&) const {}
    __device__ __forceinline__ void done(const Unit&) const {}
};

struct Epi1 {
    static constexpr bool PERM = true, AFTER_DRAIN = false, MIDK = false;
    bf16_t *Q, *KV, *XB, *GT; const float* rstd; const float* bias;
    __device__ __forceinline__ void midk(f32x4 (&acc)[2][2][4][2], const Unit& u, int wr, int wc, int fr, int fq) const {}
    __device__ __forceinline__ void operator()(const f32x4 (&acc)[2][2][4][2], const Unit& u, int wr, int wc, int fr, int fq) const {
        const int row0 = u.pm * BM + wr * 64 + fr;
        bf16_t* base; int ldc, colb; float sc = 1.f;
        if (u.pn < 4) { base = Q; ldc = 1024; colb = u.pn * BM; sc = QSCALE; }
        else if (u.pn == 4) { base = KV; ldc = 256; colb = 0; }
        else if (u.pn < 9) { base = XB; ldc = 1024; colb = (u.pn - 5) * BM; }
        else { base = GT; ldc = 1024; colb = (u.pn - 9) * BM; }
        const int col0 = colb + wc * 32 + 8 * fq, bcol0 = u.pn * BM + wc * 32 + 8 * fq;
        f32x4 bv[2][2];
#pragma unroll
        for (int bj = 0; bj < 2; ++bj)
#pragma unroll
            for (int n = 0; n < 2; ++n) bv[bj][n] = *(const f32x4*)(bias + bcol0 + bj * HALF + 4 * n);
#pragma unroll
        for (int ai = 0; ai < 2; ++ai)
#pragma unroll
            for (int m = 0; m < 4; ++m) {
                const int row = row0 + ai * HALF + m * 16; const float rs = rstd[row];
                bf16_t* rowp = base + (size_t)row * ldc + col0;
#pragma unroll
                for (int bj = 0; bj < 2; ++bj) {
                    f32x4 v0 = (acc[ai][bj][m][0] * rs + bv[bj][0]) * sc, v1 = (acc[ai][bj][m][1] * rs + bv[bj][1]) * sc;
                    u32x4 w; w.x = cvt_pk_bf16(v0[0], v0[1]); w.y = cvt_pk_bf16(v0[2], v0[3]); w.z = cvt_pk_bf16(v1[0], v1[1]); w.w = cvt_pk_bf16(v1[2], v1[3]);
                    *(u32x4*)(rowp + bj * HALF) = w; } }
    }
};
struct Epi2 {
    static constexpr bool PERM = true, AFTER_DRAIN = false, MIDK = true;
    bf16_t* H1; const float* x; float* SS2; const LAS float* tbl; int pm0;
    __device__ __forceinline__ void midk(f32x4 (&acc)[2][2][4][2], const Unit& u, int wr, int wc, int fr, int fq) const {
        const LAS float* t = tbl + (u.pm == pm0 ? 0 : 512);
#pragma unroll
        for (int ai = 0; ai < 2; ++ai)
#pragma unroll
            for (int m = 0; m < 4; ++m) { const float ra = t[(ai * HALF + wr * 64 + m * 16 + fr) * 2];
#pragma unroll
                for (int bj = 0; bj < 2; ++bj)
#pragma unroll
                    for (int n = 0; n < 2; ++n) acc[ai][bj][m][n] = acc[ai][bj][m][n] * ra; }
    }
    __device__ __forceinline__ void operator()(const f32x4 (&acc)[2][2][4][2], const Unit& u, int wr, int wc, int fr, int fq) const {
        const LAS float* t = tbl + (u.pm == pm0 ? 0 : 512);
        const int col0 = u.pn * BM + wc * 32 + 8 * fq;
#pragma unroll
        for (int ai = 0; ai < 2; ++ai)
#pragma unroll
            for (int m = 0; m < 4; ++m) {
                const int rl = ai * HALF + wr * 64 + m * 16 + fr; const size_t row = (size_t)u.pm * BM + rl; const float rs = t[rl * 2 + 1];
                float ss = 0.f;
#pragma unroll
                for (int bj = 0; bj < 2; ++bj) {
                    const f32x4 x0 = *(const f32x4*)(x + row * 2048 + col0 + bj * HALF), x1 = *(const f32x4*)(x + row * 2048 + col0 + bj * HALF + 4);
                    const f32x4 v0 = acc[ai][bj][m][0] * rs + x0, v1 = acc[ai][bj][m][1] * rs + x1;
                    ss += (v0[0] * v0[0] + v0[1] * v0[1]) + (v0[2] * v0[2] + v0[3] * v0[3]) + (v1[0] * v1[0] + v1[1] * v1[1]) + (v1[2] * v1[2] + v1[3] * v1[3]);
                    u32x4 w; w.x = cvt_pk_bf16(v0[0], v0[1]); w.y = cvt_pk_bf16(v0[2], v0[3]); w.z = cvt_pk_bf16(v1[0], v1[1]); w.w = cvt_pk_bf16(v1[2], v1[3]);
                    *(u32x4*)(H1 + row * 2048 + col0 + bj * HALF) = w; }
                ss = sum_x32(sum_x16(ss));
                if (fq == 0) SS2[row * 32 + u.pn * 4 + wc] = ss;
            }
    }
};
struct Epi3 {
    static constexpr bool PERM = true, AFTER_DRAIN = false, MIDK = false;
    bf16_t* O;
    __device__ __forceinline__ void midk(f32x4 (&acc)[2][2][4][2], const Unit& u, int wr, int wc, int fr, int fq) const {}
    __device__ __forceinline__ void operator()(const f32x4 (&acc)[2][2][4][2], const Unit& u, int wr, int wc, int fr, int fq) const {
        const int col0 = u.pn * BM + wc * 32 + 8 * fq;
#pragma unroll
        for (int ai = 0; ai < 2; ++ai)
#pragma unroll
            for (int m = 0; m < 4; ++m) { const size_t row = (size_t)u.pm * BM + ai * HALF + wr * 64 + m * 16 + fr;
#pragma unroll
                for (int bj = 0; bj < 2; ++bj) { const f32x4 v0 = acc[ai][bj][m][0], v1 = acc[ai][bj][m][1];
                    u32x4 w; w.x = cvt_pk_bf16(v0[0], v0[1]); w.y = cvt_pk_bf16(v0[2], v0[3]); w.z = cvt_pk_bf16(v1[0], v1[1]); w.w = cvt_pk_bf16(v1[2], v1[3]);
                    *(u32x4*)(O + row * 2048 + col0 + bj * HALF) = w; } }
    }
};
template <class Epi, class Sched, bool ALIGN_EPI = false, bool SP2 = false>
__device__ __forceinline__ void gemm_phase(PG8_LAS unsigned char* lds, const Gemm g, const Sched& S, const Epi& E) {
    const int tid = threadIdx.x, wid = __builtin_amdgcn_readfirstlane(tid >> 6), lane = tid & 63, wr = wid >> 2, wc = wid & 3, fr = lane & 15, fq = lane >> 4;
    const int K = g.K, nt = K / BK;
    unsigned voffA[2], voffB[2];
#pragma unroll
    for (int i = 0; i < 2; ++i) { int R, C; stage_rc(tid * 16 + i * 8192, R, C); const int Rb = Epi::PERM ? ((R & ~31) + perm32(R & 31)) : R;
        voffA[i] = (unsigned)(R * K + C) * 2u; voffB[i] = (unsigned)(Rb * K + C) * 2u; }
    const size_t kstep = (size_t)(BK * 2);
    const size_t hstep = (size_t)HALF * K * 2;
    const size_t tstep = 2 * hstep;
    const unsigned ldsw = (unsigned)wid * 1024u;
    const int aoff = lds_byte(wr * 64 + fr, fq * 8), boff = lds_byte(wc * 32 + fr, fq * 8);
#define PG8_SA(b, h) (((b) * 2 + (h)) * HTB)
#define PG8_SB(b, h) ((4 + (b) * 2 + (h)) * HTB)
#define PG8_STAGE(bufoff, gbase, voff) do { _Pragma("unroll") for (int _i = 0; _i < 2; ++_i) \
        __builtin_amdgcn_global_load_lds((const unsigned*)((const char*)(gbase) + (voff)[_i]), (PG8_LAS unsigned*)(lds + (bufoff) + ldsw + _i * 8192), 16, 0, 0); } while (0)
#define PG8_LDA(dst, b, h) do { _Pragma("unroll") for (int m = 0; m < 4; ++m) _Pragma("unroll") for (int k = 0; k < 2; ++k) dst[m][k] = *(const PG8_LAS bf16x8*)(lds + PG8_SA(b, h) + aoff + m * 2048 + k * 1024); } while (0)
#define PG8_LDB(dst, b, h) do { _Pragma("unroll") for (int n = 0; n < 2; ++n) _Pragma("unroll") for (int k = 0; k < 2; ++k) dst[n][k] = *(const PG8_LAS bf16x8*)(lds + PG8_SB(b, h) + boff + n * 2048 + k * 1024); } while (0)
#define PG8_MMA(ai, bj, At, Bt) do { __builtin_amdgcn_s_setprio(1); _Pragma("unroll") for (int m = 0; m < 4; ++m) _Pragma("unroll") for (int n = 0; n < 2; ++n) _Pragma("unroll") for (int k = 0; k < 2; ++k) \
        acc[ai][bj][m][n] = __builtin_amdgcn_mfma_f32_16x16x32_bf16(Bt[n][k], At[m][k], acc[ai][bj][m][n], 0, 0, 0); __builtin_amdgcn_s_setprio(0); } while (0)
#define PG8_WAIT_V(n) asm volatile("s_waitcnt vmcnt(" #n ")" ::: "memory")
#define PG8_WAIT_L(n) asm volatile("s_waitcnt lgkmcnt(" #n ")" ::: "memory")
#define PG8_BAR __builtin_amdgcn_s_barrier()
#define PG8_SCHED __builtin_amdgcn_sched_barrier(0)
    Unit cur, nxt; int ui = 0;
    if (!S.next(0, cur)) return;
    f32x4 acc[2][2][4][2];
#pragma unroll
    for (int a = 0; a < 2; ++a)
#pragma unroll
        for (int b = 0; b < 2; ++b)
#pragma unroll
            for (int m = 0; m < 4; ++m)
#pragma unroll
                for (int n = 0; n < 2; ++n) acc[a][b][m][n] = (f32x4){0.f, 0.f, 0.f, 0.f};
    bf16x8 At[4][2], B0[2][2], B1[2][2];
    const char* cA = (const char*)g.A + (size_t)cur.pm * tstep; const char* cB = (const char*)g.Bt + (size_t)cur.pn * tstep;
    S.a_ready(cur);
    if constexpr (SP2) {
        PG8_STAGE(PG8_SB(0, 0), cB, voffB); PG8_STAGE(PG8_SB(0, 1), cB + hstep, voffB); PG8_STAGE(PG8_SA(0, 0), cA, voffA); PG8_STAGE(PG8_SA(0, 1), cA + hstep, voffA);
        if (wr == 1) PG8_BAR;
        PG8_WAIT_V(2); PG8_BAR;
        PG8_STAGE(PG8_SB(1, 0), cB + kstep, voffB); PG8_STAGE(PG8_SA(1, 0), cA + kstep, voffA); PG8_STAGE(PG8_SB(1, 1), cB + hstep + kstep, voffB);
        PG8_WAIT_V(6); PG8_BAR;
    } else {
        PG8_STAGE(PG8_SB(0, 0), cB, voffB); PG8_STAGE(PG8_SA(0, 0), cA, voffA); PG8_STAGE(PG8_SB(0, 1), cB + hstep, voffB); PG8_STAGE(PG8_SA(0, 1), cA + hstep, voffA);
        if (wr == 1) PG8_BAR;
        PG8_WAIT_V(4); PG8_BAR;
        PG8_STAGE(PG8_SB(1, 0), cB + kstep, voffB); PG8_STAGE(PG8_SA(1, 0), cA + kstep, voffA); PG8_STAGE(PG8_SB(1, 1), cB + hstep + kstep, voffB);
        PG8_WAIT_V(6); PG8_BAR;
    }
    for (;;) {
        const bool has_next = S.next(ui + 1, nxt);
        const char* nA = has_next ? (const char*)g.A + (size_t)nxt.pm * tstep : cA; const char* nB = has_next ? (const char*)g.Bt + (size_t)nxt.pn * tstep : cB;
        for (int t = 0; t < nt; t += 2) {
            if constexpr (Epi::MIDK) { if (t == nt / 2) E.midk(acc, cur, wr, wc, fr, fq); }
            const bool last = (t == nt - 2);
            const char* a1 = cA + (size_t)(t + 1) * kstep;
            const char* a2 = last ? nA : cA + (size_t)(t + 2) * kstep; const char* b2 = last ? nB : cB + (size_t)(t + 2) * kstep;
            const char* a3 = a2 + kstep; const char* b3 = b2 + kstep;
            if (last && has_next) S.a_ready(nxt);
            if constexpr (SP2) {
            PG8_LDB(B0, 0, 0); PG8_LDB(B1, 0, 1); PG8_SCHED; PG8_LDA(At, 0, 0); PG8_STAGE(PG8_SA(1, 1), a1 + hstep, voffA);
            PG8_WAIT_V(8); PG8_WAIT_L(0); PG8_BAR; PG8_MMA(0, 0, At, B0); PG8_MMA(0, 1, At, B1); PG8_BAR; PG8_SCHED;
            PG8_LDA(At, 0, 1); PG8_STAGE(PG8_SB(0, 0), b2, voffB); PG8_STAGE(PG8_SB(0, 1), b2 + hstep, voffB); PG8_STAGE(PG8_SA(0, 0), a2, voffA);
            PG8_WAIT_V(8); PG8_WAIT_L(0); PG8_BAR; PG8_MMA(1, 0, At, B0); PG8_MMA(1, 1, At, B1); PG8_BAR; PG8_SCHED;
            PG8_LDB(B0, 1, 0); PG8_LDB(B1, 1, 1); PG8_SCHED; PG8_LDA(At, 1, 0); PG8_STAGE(PG8_SA(0, 1), a2 + hstep, voffA);
            PG8_WAIT_V(8); PG8_WAIT_L(0); PG8_BAR; PG8_MMA(0, 0, At, B0); PG8_MMA(0, 1, At, B1); PG8_BAR; PG8_SCHED;
            PG8_LDA(At, 1, 1); PG8_STAGE(PG8_SB(1, 0), b3, voffB); PG8_STAGE(PG8_SB(1, 1), b3 + hstep, voffB); PG8_STAGE(PG8_SA(1, 0), a3, voffA);
            PG8_WAIT_V(8); PG8_WAIT_L(0); PG8_BAR; PG8_MMA(1, 0, At, B0); PG8_MMA(1, 1, At, B1); PG8_BAR; PG8_SCHED;
            } else {
            PG8_LDB(B0, 0, 0); PG8_SCHED; PG8_LDA(At, 0, 0); PG8_STAGE(PG8_SA(1, 1), a1 + hstep, voffA);
            PG8_WAIT_L(8); PG8_BAR; PG8_WAIT_L(0); PG8_MMA(0, 0, At, B0); PG8_BAR; PG8_SCHED;
            PG8_LDB(B1, 0, 1); PG8_STAGE(PG8_SB(0, 0), b2, voffB);
            PG8_BAR; PG8_WAIT_L(0); PG8_MMA(0, 1, At, B1); PG8_BAR;
            PG8_LDA(At, 0, 1); PG8_STAGE(PG8_SA(0, 0), a2, voffA);
            PG8_BAR; PG8_WAIT_L(0); PG8_MMA(1, 0, At, B0); PG8_BAR; PG8_SCHED;
            PG8_STAGE(PG8_SB(0, 1), b2 + hstep, voffB);
            PG8_WAIT_V(6); PG8_BAR; PG8_MMA(1, 1, At, B1); PG8_BAR;
            PG8_LDB(B0, 1, 0); PG8_SCHED; PG8_LDA(At, 1, 0); PG8_STAGE(PG8_SA(0, 1), a2 + hstep, voffA);
            PG8_WAIT_L(8); PG8_BAR; PG8_WAIT_L(0); PG8_MMA(0, 0, At, B0); PG8_BAR; PG8_SCHED;
            PG8_LDB(B1, 1, 1); PG8_STAGE(PG8_SB(1, 0), b3, voffB);
            PG8_BAR; PG8_WAIT_L(0); PG8_MMA(0, 1, At, B1); PG8_BAR;
            PG8_LDA(At, 1, 1); PG8_STAGE(PG8_SA(1, 0), a3, voffA);
            PG8_BAR; PG8_WAIT_L(0); PG8_MMA(1, 0, At, B0); PG8_BAR; PG8_SCHED;
            PG8_STAGE(PG8_SB(1, 1), b3 + hstep, voffB);
            PG8_WAIT_V(6); PG8_BAR; PG8_MMA(1, 1, At, B1); PG8_BAR;
            }
        }
        if constexpr (ALIGN_EPI) { if (wr == 0) PG8_BAR; }
        if constexpr (!Epi::AFTER_DRAIN) { E(acc, cur, wr, wc, fr, fq); S.done(cur); }
        if (!has_next) break;
#pragma unroll
        for (int a = 0; a < 2; ++a)
#pragma unroll
            for (int b = 0; b < 2; ++b)
#pragma unroll
                for (int m = 0; m < 4; ++m)
#pragma unroll
                    for (int n = 0; n < 2; ++n) acc[a][b][m][n] = (f32x4){0.f, 0.f, 0.f, 0.f};
        cur = nxt; cA = nA; cB = nB; ++ui;
        if constexpr (ALIGN_EPI) { if (wr == 1) PG8_BAR; }
    }
    PG8_WAIT_V(0);
    if constexpr (!ALIGN_EPI) { if (wr == 0) PG8_BAR; }
    PG8_BAR;
    if constexpr (Epi::AFTER_DRAIN) { E.fused(acc, cur, wr, wc, fr, fq, lds, wid, lane); S.done(cur); }
#undef PG8_SA
#undef PG8_SB
#undef PG8_STAGE
#undef PG8_LDA
#undef PG8_LDB
#undef PG8_MMA
#undef PG8_WAIT_V
#undef PG8_WAIT_L
#undef PG8_BAR
#undef PG8_SCHED
}
}
#define XB_TMO      128
#define XB_XCNT(j)  (256  + 64 * (j))
#define XB_XSUB(j)  (1280 + 64 * (j))
#define XB_XGEN(j)  (2304 + 64 * (j))
#define XB_TOP      3328
#define XB_TOPGEN   3392
#define XCD_BAR_WORDS 3456
#define XB_SPIN_CAP (1u << 18)

__device__ __forceinline__ unsigned xb_ld(unsigned* p)              { return __hip_atomic_load(p, __ATOMIC_RELAXED, __HIP_MEMORY_SCOPE_AGENT); }
__device__ __forceinline__ unsigned xb_add(unsigned* p, unsigned v) { return __hip_atomic_fetch_add(p, v, __ATOMIC_RELAXED, __HIP_MEMORY_SCOPE_AGENT); }
__device__ __forceinline__ unsigned xb_xcc_id() { return (unsigned)__builtin_amdgcn_s_getreg((3 << 11) | 20) & 0xFu; }
#define XB_SPIN(cond, bar) do { unsigned _sp = 0; while (cond) { __builtin_amdgcn_s_sleep(1); \
    if ((++_sp & 255u) == 0u) { if (xb_ld(&(bar)[XB_TMO])) break; if (_sp > XB_SPIN_CAP) { atomicAdd(&(bar)[XB_TMO], 1u); break; } } } } while (0)

struct XcdBarrier {
    unsigned* bar; unsigned x;
    volatile LAS unsigned* st;
};

__device__ __forceinline__ XcdBarrier xcd_barrier_post(unsigned* bar, volatile LAS unsigned* st) {
    XcdBarrier b; b.bar = bar; b.x = xb_xcc_id(); b.st = st;
    if (threadIdx.x == 0) (void)xb_add(&bar[XB_XCNT(b.x)], 1u);
    return b;
}
__device__ __forceinline__ void xcd_barrier_complete(unsigned* bar, unsigned x, unsigned& nloc, unsigned& nx) {
    const unsigned G = gridDim.x * gridDim.y * gridDim.z;
    unsigned sum, cnt, mine, sp = 0u;
    for (;;) {
        sum = 0u; cnt = 0u; mine = 0u;
#pragma unroll
        for (unsigned j = 0; j < 16; ++j) { const unsigned c = xb_ld(&bar[XB_XCNT(j)]); sum += c; cnt += (c > 0u) ? 1u : 0u; mine = (j == x) ? c : mine; }
        if (sum == G) break;
        __builtin_amdgcn_s_sleep(1);
        if ((++sp & 255u) == 0u) { if (xb_ld(&bar[XB_TMO])) break; if (sp > XB_SPIN_CAP) { atomicAdd(&bar[XB_TMO], 1u); break; } }
    }
    nloc = mine > 0u ? mine : 1u; nx = cnt > 0u ? cnt : 1u;
}

__device__ __forceinline__ void xcd_barrier(const XcdBarrier& b) {
    asm volatile("s_waitcnt vmcnt(0)" ::: "memory");
    __syncthreads();
    if (threadIdx.x == 0) {
        unsigned* bar = b.bar;
        __builtin_amdgcn_s_waitcnt(0);
        unsigned nloc = b.st[0], nx = b.st[1];
        if (nloc == 0u) { xcd_barrier_complete(bar, b.x, nloc, nx); b.st[0] = nloc; b.st[1] = nx; }
        const unsigned old = xb_add(&bar[XB_XSUB(b.x)], 1u);
        const unsigned gen = old / nloc;
        if (old + 1u == (gen + 1u) * nloc) {
            __builtin_amdgcn_fence(__ATOMIC_RELEASE, "agent");
            asm volatile("s_waitcnt vmcnt(0)" ::: "memory");
            const unsigned og = xb_add(&bar[XB_TOP], 1u);
            const unsigned tg = og / nx;
            if (og + 1u == (tg + 1u) * nx) xb_add(&bar[XB_TOPGEN], 1u);
            else XB_SPIN(xb_ld(&bar[XB_TOPGEN]) == tg, bar);
            __builtin_amdgcn_fence(__ATOMIC_ACQUIRE, "agent");
            xb_add(&bar[XB_XGEN(b.x)], 1u);
            asm volatile("s_waitcnt vmcnt(0)" ::: "memory");
        } else {
            XB_SPIN(xb_ld(&bar[XB_XGEN(b.x)]) == gen, bar);
            __builtin_amdgcn_fence(__ATOMIC_ACQUIRE, "agent");
            asm volatile("s_waitcnt vmcnt(0)" ::: "memory");
        }
    }
    __syncthreads();
}

constexpr int NWAVES = 8;
constexpr size_t MiB = 1u << 20;
constexpr size_t WS_CTL = 0, CTL_ZERO_BYTES = 1 * MiB;
constexpr size_t WS_W1T = 2 * MiB;
constexpr size_t WS_W2T = 16 * MiB;
constexpr size_t WS_W3T = 24 * MiB;
constexpr size_t WS_SKB = 32 * MiB;
constexpr size_t WS_RSTD1 = 33 * MiB;
constexpr size_t WS_SSA = 34 * MiB;
constexpr size_t WS_SSL = 35 * MiB;
constexpr size_t WS_SS2 = 37 * MiB;
constexpr size_t WS_RSTD2 = 39 * MiB;
constexpr size_t WS_IDS = 40 * MiB;
constexpr size_t WS_GW = 48 * MiB;
constexpr size_t WS_U8 = 64 * MiB;
constexpr size_t WS_V8 = 96 * MiB;
constexpr size_t WS_X8 = 128 * MiB;
constexpr size_t WS_SX = 160 * MiB;
constexpr size_t WS_SCU = 162 * MiB;
constexpr size_t WS_SCV = 163 * MiB;
constexpr size_t WS_WSUM = 164 * MiB;
constexpr size_t WS_A1 = 192 * MiB;
constexpr size_t WS_Q = 258 * MiB;
constexpr size_t WS_KV = 290 * MiB;
constexpr size_t WS_XB = 299 * MiB;
constexpr size_t WS_GT = 332 * MiB;
constexpr size_t WS_H1 = 364 * MiB;
constexpr size_t WS_PART = 192 * MiB;
constexpr size_t WS_W = 56 * MiB;
constexpr size_t WS_Z = 428 * MiB;
constexpr size_t WS_END = 492 * MiB;
constexpr int CW_QROW = 2048;
constexpr int CW_BAR = 4096;

constexpr int RING_OFF = 0, RING_BYTES = 131072;
constexpr int LDSCTL_OFF = RING_BYTES, MISC_OFF = LDSCTL_OFF + 320;
constexpr int LDS_BYTES = 147456;

typedef unsigned short bf16;
typedef unsigned v4u __attribute__((ext_vector_type(4)));
typedef float f32x4 __attribute__((ext_vector_type(4)));
typedef short bf16x8 __attribute__((ext_vector_type(8)));
typedef GAS unsigned gu32;
#define RLX_AGENT __ATOMIC_RELAXED, __HIP_MEMORY_SCOPE_AGENT
#define LDS_WAIT() asm volatile("s_waitcnt lgkmcnt(0)" ::: "memory")
#define VM_WAIT() asm volatile("s_waitcnt vmcnt(0)" ::: "memory")
__device__ __forceinline__ unsigned f2bf(float f) { unsigned u = __builtin_bit_cast(unsigned, f); return (u + 0x7fffu + ((u >> 16) & 1u)) >> 16; }
__device__ __forceinline__ unsigned pk2(float lo, float hi) { return f2bf(lo) | (f2bf(hi) << 16); }
__device__ __forceinline__ float bf2f(unsigned short b) { return __builtin_bit_cast(float, (unsigned)b << 16); }


namespace p2 {
typedef float f32x16 __attribute__((ext_vector_type(16)));
typedef unsigned u32x2 __attribute__((ext_vector_type(2)));
constexpr float LOG2E = 1.4426950408889634f;
constexpr float NEGBIG = -1e30f;
__device__ __forceinline__ int crow(int r, int hi) { return (r & 3) + 8 * (r >> 2) + 4 * hi; }
__device__ __forceinline__ unsigned cvtpk(float lo, float hi) { unsigned r; asm volatile("v_cvt_pk_bf16_f32 %0, %1, %2" : "=v"(r) : "v"(lo), "v"(hi)); return r; }
__device__ __forceinline__ float ex2(float x) { return __builtin_amdgcn_exp2f(x); }
__device__ __forceinline__ float rcp(float x) { return __builtin_amdgcn_rcpf(x); }
__device__ __forceinline__ float gelu_fast(float x) { return x * rcp(1.0f + ex2(x * (-2.302208198f - 0.102943240f * (x * x)))); }

constexpr int A_KS = 0, A_KSP = 144, A_VT = 288 * 144, A_VTP = 584, A_ST = A_VT + 64 * 584, A_END = A_ST + 8 * 4096;
__device__ __forceinline__ void attn_unit(LAS unsigned char* lds, int b, int qblk, int kvh, const bf16* QB, const bf16* KVB, const float* sinks, bf16* MIX, float* SSA, int tid) {
    const int lane = tid & 63, wave = __builtin_amdgcn_readfirstlane(tid >> 6), r = lane & 31, hi = lane >> 5;
    const int q0 = qblk * 128, hq = kvh * 8 + wave;
    for (int it = 0; it < 5; ++it) {
        const int cid = it * 512 + tid;
        if (cid < 288 * 8) {
            const int key = cid >> 3, ch = cid & 7;
            bool valid; size_t row = 0;
            if (key < 256) { const int pos = q0 - 128 + key; valid = pos >= 0; row = (size_t)b * SEQ + pos; }
            else if (key < 272) { valid = true; row = (size_t)MREAL + (key - 256); }
            else valid = false;
            v4u kv = {0u, 0u, 0u, 0u}, vv = {0u, 0u, 0u, 0u};
            if (valid) { kv = *(const GAS v4u*)(KVB + row * 256 + kvh * 64 + ch * 8); vv = *(const GAS v4u*)(KVB + row * 256 + 128 + kvh * 64 + ch * 8); }
            *(LAS v4u*)(lds + A_KS + key * A_KSP + ch * 16) = kv;
            LAS unsigned short* vt = (LAS unsigned short*)(lds + A_VT);
#pragma unroll
            for (int j = 0; j < 8; ++j) { const unsigned wv = vv[j >> 1]; vt[(ch * 8 + j) * (A_VTP / 2) + key] = (unsigned short)((j & 1) ? (wv >> 16) : (wv & 0xffffu)); }
        }
    }
    __syncthreads();
    const float sink2 = sinks[hq] * LOG2E;
    bf16x8 qf[4];
#pragma unroll
    for (int ks = 0; ks < 4; ++ks) qf[ks] = *(const GAS bf16x8*)(QB + ((size_t)b * SEQ + q0 + r) * 1024 + hq * 64 + ks * 16 + hi * 8);
    for (int qg = 0; qg < 4; ++qg) {
        f32x16 s[6];
#pragma unroll
        for (int t = 0; t < 6; ++t) {
            const int kbase = t < 5 ? 32 * (qg + t) : 256;
            f32x16 acc = {0.f, 0.f, 0.f, 0.f, 0.f, 0.f, 0.f, 0.f, 0.f, 0.f, 0.f, 0.f, 0.f, 0.f, 0.f, 0.f};
#pragma unroll
            for (int ks = 0; ks < 4; ++ks) {
                const bf16x8 kf = *(const LAS bf16x8*)(lds + A_KS + (kbase + r) * A_KSP + ks * 32 + hi * 16);
                acc = __builtin_amdgcn_mfma_f32_32x32x16_bf16(kf, qf[ks], acc, 0, 0, 0);
            }
            s[t] = acc;
        }
        if (qg + 1 < 4) {
#pragma unroll
            for (int ks = 0; ks < 4; ++ks) qf[ks] = *(const GAS bf16x8*)(QB + ((size_t)b * SEQ + q0 + 32 * (qg + 1) + r) * 1024 + hq * 64 + ks * 16 + hi * 8);
        }
        const bool blk0 = (qblk == 0);
#pragma unroll
        for (int reg = 0; reg < 16; ++reg) {
            const int j = crow(reg, hi);
            s[0][reg] = (j > r) ? s[0][reg] : NEGBIG;
            s[4][reg] = (j <= r) ? s[4][reg] : NEGBIG;
            s[5][reg] = (j < 16) ? s[5][reg] : NEGBIG;
        }
#pragma unroll
        for (int t = 0; t < 4; ++t) if (blk0 && (qg + t < 4)) {
#pragma unroll
            for (int reg = 0; reg < 16; ++reg) s[t][reg] = NEGBIG;
        }
        float m = sink2;
#pragma unroll
        for (int t = 0; t < 6; ++t)
#pragma unroll
            for (int reg = 0; reg < 16; ++reg) m = fmaxf(m, s[t][reg]);
        m = max_x32(m);
        float l = 0.f;
#pragma unroll
        for (int t = 0; t < 6; ++t)
#pragma unroll
            for (int reg = 0; reg < 16; ++reg) { const float p = ex2(s[t][reg] - m); s[t][reg] = p; l += p; }
        l = sum_x32(l);
        l += ex2(sink2 - m);
        const float linv = 1.0f / l;
        f32x16 o0 = {0.f, 0.f, 0.f, 0.f, 0.f, 0.f, 0.f, 0.f, 0.f, 0.f, 0.f, 0.f, 0.f, 0.f, 0.f, 0.f}, o1 = o0;
#pragma unroll
        for (int t = 0; t < 6; ++t) {
            const int kbase = t < 5 ? 32 * (qg + t) : 256;
#pragma unroll
            for (int ss = 0; ss < 2; ++ss) {
                v4u pw; pw.x = cvtpk(s[t][8 * ss + 0], s[t][8 * ss + 1]); pw.y = cvtpk(s[t][8 * ss + 2], s[t][8 * ss + 3]);
                pw.z = cvtpk(s[t][8 * ss + 4], s[t][8 * ss + 5]); pw.w = cvtpk(s[t][8 * ss + 6], s[t][8 * ss + 7]);
                const bf16x8 pa = __builtin_bit_cast(bf16x8, pw);
                const int ko = (kbase + 16 * ss + 4 * hi) * 2;
                {   const u32x2 lo = *(const LAS u32x2*)(lds + A_VT + r * A_VTP + ko), h2 = *(const LAS u32x2*)(lds + A_VT + r * A_VTP + ko + 16);
                    v4u vw; vw.x = lo.x; vw.y = lo.y; vw.z = h2.x; vw.w = h2.y;
                    o0 = __builtin_amdgcn_mfma_f32_32x32x16_bf16(pa, __builtin_bit_cast(bf16x8, vw), o0, 0, 0, 0); }
                {   const u32x2 lo = *(const LAS u32x2*)(lds + A_VT + (32 + r) * A_VTP + ko), h2 = *(const LAS u32x2*)(lds + A_VT + (32 + r) * A_VTP + ko + 16);
                    v4u vw; vw.x = lo.x; vw.y = lo.y; vw.z = h2.x; vw.w = h2.y;
                    o1 = __builtin_amdgcn_mfma_f32_32x32x16_bf16(pa, __builtin_bit_cast(bf16x8, vw), o1, 0, 0, 0); }
            }
        }
        LAS unsigned short* stg = (LAS unsigned short*)(lds + A_ST + wave * 4096);
#pragma unroll
        for (int reg = 0; reg < 16; ++reg) {
            const int qr = crow(reg, hi); const float li = __shfl(linv, qr);
            stg[qr * 64 + r] = (unsigned short)f2bf(o0[reg] * li);
            stg[qr * 64 + 32 + r] = (unsigned short)f2bf(o1[reg] * li);
        }
        asm volatile("s_waitcnt lgkmcnt(0)" ::: "memory");
#pragma unroll
        for (int i = 0; i < 4; ++i) {
            const int row = i * 8 + (lane >> 3), ch = lane & 7;
            const v4u v = *(const LAS v4u*)(stg + row * 64 + ch * 8);
            float ss = 0.f;
#pragma unroll
            for (int k = 0; k < 4; ++k) { const float a = __builtin_bit_cast(float, v[k] << 16), c = __builtin_bit_cast(float, v[k] & 0xffff0000u); ss += a * a + c * c; }
            ss = sum8(ss);
            const size_t orow = (size_t)b * SEQ + q0 + 32 * qg + row;
            *(GAS v4u*)(MIX + orow * D + hq * 64 + ch * 8) = v;
            if (ch == 0) SSA[orow * 16 + hq] = ss;
        }
        asm volatile("s_waitcnt lgkmcnt(0)" ::: "memory");
    }
    __syncthreads();
}

constexpr int LW_XS = 0, LW_GS = 4608, LW_XC = LW_GS + 2048, LW_XCF = LW_XC + 4608, LW_BYTES = LW_XCF + 4096 + 128;
constexpr int L_CT = 8 * LW_BYTES, L_END = L_CT + 2 * 2048;
static_assert(L_END <= 131072, "lru lds");
struct LruP { const float *conv_w, *conv_b, *w_r, *b_r, *w_i, *b_i, *lam; };
__device__ __forceinline__ void lru_unit(LAS unsigned char* lds, LAS unsigned char* ldsw  , int b, int nb, int cg, const bf16* XBB, const bf16* GTB, const LruP P, bf16* MIX, float* SSL, int tid) {
    const int lane = tid & 63, wave = __builtin_amdgcn_readfirstlane(tid >> 6), r = lane & 31, hi = lane >> 5;
    LAS unsigned char* lw = lds + wave * LW_BYTES;
    {
        LAS unsigned short* wt = (LAS unsigned short*)ldsw;
#pragma unroll
        for (int i = 0; i < 4; ++i) {
            const int e = tid + 512 * i, c = e >> 5, dl = e & 31;
            const size_t gi = (size_t)(nb * 64 + c) * 64 + 32 * cg + dl;
            wt[dl * 72 + c] = (unsigned short)f2bf(-LOG2E * P.w_r[gi]);
            wt[32 * 72 + dl * 72 + c] = (unsigned short)f2bf(-LOG2E * P.w_i[gi]);
        }
    }
    const int cc = lane, chc = nb * 64 + cc;
    const float cw0 = P.conv_w[0 * LW + chc], cw1 = P.conv_w[1 * LW + chc], cw2 = P.conv_w[2 * LW + chc], cw3 = P.conv_w[3 * LW + chc], cbv = P.conv_b[chc];
    const int chd = nb * 64 + 32 * cg + r;
    const float br = -LOG2E * P.b_r[chd], bi = -LOG2E * P.b_i[chd];
    const float ls8 = -8.0f * log1pf(expf(-P.lam[chd])) * LOG2E;
    float state = 0.f;
    v4u px[5], pg[2];
#define LRU_PREFETCH(tl) do { \
        _Pragma("unroll") for (int it = 0; it < 5; ++it) { const int cid = it * 64 + lane; px[it] = (v4u){0u, 0u, 0u, 0u}; \
            if (cid < 35 * 8) { const int j = cid >> 3, ch = cid & 7, t = 32 * wave + j - 3; bool valid; size_t row = 0; \
                if ((tl) == 0) { valid = (t >= 0 && t < NMETA); row = (size_t)MREAL + t; } \
                else if ((tl) == 1 && t < 0) { valid = true; row = (size_t)MREAL + NMETA + t; } \
                else { valid = true; row = (size_t)b * SEQ + 256 * ((tl) - 1) + t; } \
                if (valid) px[it] = *(const GAS v4u*)(XBB + row * 1024 + nb * 64 + ch * 8); } } \
        if ((tl) > 0) { _Pragma("unroll") for (int it = 0; it < 2; ++it) { const int cid = it * 64 + lane, t = 32 * wave + (cid >> 2), ch = cid & 3; \
            pg[it] = *(const GAS v4u*)(GTB + ((size_t)b * SEQ + 256 * ((tl) - 1) + t) * 1024 + nb * 64 + 32 * cg + ch * 8); } } } while (0)
    LRU_PREFETCH(0);
    __syncthreads();
    for (int tile = 0; tile < 9; ++tile) {
#pragma unroll
        for (int it = 0; it < 5; ++it) { const int cid = it * 64 + lane; if (cid < 35 * 8) *(LAS v4u*)(lw + LW_XS + (cid >> 3) * 128 + (cid & 7) * 16) = px[it]; }
        if (tile > 0) {
#pragma unroll
            for (int it = 0; it < 2; ++it) { const int cid = it * 64 + lane; *(LAS v4u*)(lw + LW_GS + (cid >> 2) * 64 + (cid & 3) * 16) = pg[it]; }
        }
        asm volatile("s_waitcnt lgkmcnt(0)" ::: "memory");
        if (tile + 1 < 9) LRU_PREFETCH(tile + 1);
        {
            const LAS unsigned short* xs = (const LAS unsigned short*)(lw + LW_XS);
            LAS unsigned short* xc = (LAS unsigned short*)(lw + LW_XC);
            LAS float* xcf = (LAS float*)(lw + LW_XCF);
            const bool own = (cc >> 5) == cg; const int xoff = own ? (cc & 31) : 32 * 32 + (cc & 31);
            float x0 = bf2f(xs[0 * 64 + cc]), x1 = bf2f(xs[1 * 64 + cc]), x2 = bf2f(xs[2 * 64 + cc]);
#pragma unroll 8
            for (int k = 0; k < 32; ++k) {
                const float x3 = bf2f(xs[(k + 3) * 64 + cc]);
                const float v = cbv + cw0 * x0 + cw1 * x1 + cw2 * x2 + cw3 * x3;
                xc[k * 72 + cc] = (unsigned short)cvtpk(v, v);
                xcf[(own ? k * 32 : 0) + xoff] = v;
                x0 = x1; x1 = x2; x2 = x3;
            }
        }
        asm volatile("s_waitcnt lgkmcnt(0)" ::: "memory");
        f32x16 aR = {br, br, br, br, br, br, br, br, br, br, br, br, br, br, br, br}, aI = {bi, bi, bi, bi, bi, bi, bi, bi, bi, bi, bi, bi, bi, bi, bi, bi};
#pragma unroll
        for (int ks = 0; ks < 4; ++ks) {
            const bf16x8 xa = *(const LAS bf16x8*)(lw + LW_XC + r * 144 + ks * 32 + hi * 16);
            const bf16x8 wr_ = *(const LAS bf16x8*)(ldsw + r * 144 + ks * 32 + hi * 16);
            const bf16x8 wi_ = *(const LAS bf16x8*)(ldsw + 32 * 144 + r * 144 + ks * 32 + hi * 16);
            aR = __builtin_amdgcn_mfma_f32_32x32x16_bf16(xa, wr_, aR, 0, 0, 0);
            aI = __builtin_amdgcn_mfma_f32_32x32x16_bf16(xa, wi_, aI, 0, 0, 0);
        }
        float Av[16], Bv[16];
        {
            const LAS float* xcf = (const LAS float*)(lw + LW_XCF);
#pragma unroll
            for (int reg = 0; reg < 16; ++reg) {
                const int tl = crow(reg, hi), t = 32 * wave + tl;
                const bool valid = (tile > 0) || (t < NMETA);
                const float rg = rcp(1.0f + ex2(aR[reg]));
                const float ig = rcp(1.0f + ex2(aI[reg]));
                const float a = ex2(rg * ls8);
                const float mult = __builtin_amdgcn_sqrtf(fmaxf(1.0f - a * a, 0.f));
                const float bx = mult * ig * xcf[tl * 32 + r];
                Av[reg] = valid ? a : 1.0f; Bv[reg] = valid ? bx : 0.0f;
            }
        }
#pragma unroll
        for (int g = 0; g < 4; ++g) {
#pragma unroll
            for (int k = 1; k < 4; ++k) { Bv[4 * g + k] = Av[4 * g + k] * Bv[4 * g + k - 1] + Bv[4 * g + k]; Av[4 * g + k] = Av[4 * g + k] * Av[4 * g + k - 1]; }
        }
        float myCz[4], myCp[4], PW, HW;
        {
            float cz = 0.f, cp = 1.f;
#pragma unroll
            for (int g = 0; g < 4; ++g) {
                const float mP = Av[4 * g + 3], mH = Bv[4 * g + 3];
                const float oP = __shfl_xor(mP, 32), oH = __shfl_xor(mH, 32);
                const float eP = hi ? oP : mP, eH = hi ? oH : mH, dP = hi ? mP : oP, dH = hi ? mH : oH;
                const float cz0 = cz, cp0 = cp;
                cz = eP * cz + eH; cp = cp * eP;
                myCz[g] = hi ? cz : cz0; myCp[g] = hi ? cp : cp0;
                cz = dP * cz + dH; cp = cp * dP;
            }
            PW = cp; HW = cz;
        }
        LAS float* ct = (LAS float*)(lds + L_CT + (tile & 1) * 2048);
        if (hi == 0) { ct[(wave * 32 + r) * 2] = PW; ct[(wave * 32 + r) * 2 + 1] = HW; }
        __syncthreads();
        float cin = 0.f;
        {
            float c = state;
#pragma unroll
            for (int w2 = 0; w2 < 8; ++w2) { if (w2 == wave) cin = c; c = ct[(w2 * 32 + r) * 2] * c + ct[(w2 * 32 + r) * 2 + 1]; }
            state = c;
        }
        if (tile > 0) {
            const LAS unsigned short* gs = (const LAS unsigned short*)(lw + LW_GS);
            LAS unsigned short* os = (LAS unsigned short*)(lw + LW_XS);
#pragma unroll
            for (int reg = 0; reg < 16; ++reg) {
                const int g = reg >> 2, tl = crow(reg, hi);
                const float h = Bv[reg] + Av[reg] * (myCz[g] + myCp[g] * cin);
                const float gt = bf2f(gs[tl * 32 + r]);
                { const float ov = gelu_fast(gt) * h; os[tl * 32 + r] = (unsigned short)cvtpk(ov, ov); }
            }
            asm volatile("s_waitcnt lgkmcnt(0)" ::: "memory");
#pragma unroll
            for (int it = 0; it < 2; ++it) {
                const int cid = it * 64 + lane, tl = cid >> 2, ch = cid & 3;
                const v4u v = *(const LAS v4u*)(lw + LW_XS + tl * 64 + ch * 16);
                float ss = 0.f;
#pragma unroll
                for (int k = 0; k < 4; ++k) { const float a = __builtin_bit_cast(float, v[k] << 16), c = __builtin_bit_cast(float, v[k] & 0xffff0000u); ss += a * a + c * c; }
                ss = sum4(ss);
                const size_t row = (size_t)b * SEQ + 256 * (tile - 1) + 32 * wave + tl;
                *(GAS v4u*)(MIX + row * D + 1024 + nb * 64 + 32 * cg + ch * 8) = v;
                if (ch == 0) SSL[row * 32 + nb * 2 + cg] = ss;
            }
            asm volatile("s_waitcnt lgkmcnt(0)" ::: "memory");
        }
    }
#undef LRU_PREFETCH
    __syncthreads();
}
}

namespace p5 {
typedef float f32x16 __attribute__((ext_vector_type(16)));
constexpr int KP = 272;
constexpr int R_KEYS = 0, R_IDX = 256 * KP, R_END = R_IDX + 8 * 1024;
__device__ __forceinline__ int crow(int r, int hi) { return (r & 3) + 8 * (r >> 2) + 4 * hi; }
__device__ __forceinline__ float fkey(float s, int mask, int payload) { return __builtin_bit_cast(float, (__builtin_bit_cast(int, s) & mask) | payload); }
__device__ __forceinline__ int fbits(float f) { return __builtin_bit_cast(int, f); }
__device__ __forceinline__ float fval(float f, int mask) { return __builtin_bit_cast(float, __builtin_bit_cast(int, f) & mask); }
__device__ __forceinline__ void ins16(float (&L)[16], float v) {
#pragma unroll
    for (int k = 15; k >= 1; --k) L[k] = __builtin_amdgcn_fmed3f(L[k - 1], L[k], v);
    L[0] = fmaxf(L[0], v);
}
__device__ __forceinline__ void half_top16(const LAS unsigned char* keys, const bf16x8 (&qf)[8], int r, int hi, float (&T)[16]) {
    float L[16];
#pragma unroll
    for (int k = 0; k < 16; ++k) L[k] = -INFINITY;
    const int h4 = 4 * hi;
#pragma unroll
    for (int kt = 0; kt < 4; ++kt) {
        f32x16 acc = {0.f, 0.f, 0.f, 0.f, 0.f, 0.f, 0.f, 0.f, 0.f, 0.f, 0.f, 0.f, 0.f, 0.f, 0.f, 0.f};
#pragma unroll
        for (int ks = 0; ks < 8; ++ks) {
            const bf16x8 kf = *(const LAS bf16x8*)(keys + (kt * 32 + r) * KP + ks * 32 + hi * 16);
            acc = __builtin_amdgcn_mfma_f32_32x32x16_bf16(kf, qf[ks], acc, 0, 0, 0);
        }
#pragma unroll
        for (int reg = 0; reg < 16; ++reg) {
            const int C = 127 - 32 * kt - (reg & 3) - 8 * (reg >> 2);
            ins16(L, fkey(acc[reg], (int)0xffffff80, C - h4));
        }
    }
    float M[16];
#pragma unroll
    for (int i = 0; i < 16; ++i) M[i] = fmaxf(L[i], __shfl_xor(L[15 - i], 32));
#define P5_STAGE(st) _Pragma("unroll") for (int i = 0; i < 16; ++i) if ((i & (st)) == 0) { const float a = fmaxf(M[i], M[i + (st)]), b = fminf(M[i], M[i + (st)]); M[i] = a; M[i + (st)] = b; }
    P5_STAGE(8) P5_STAGE(4) P5_STAGE(2) P5_STAGE(1)
#undef P5_STAGE
#pragma unroll
    for (int i = 0; i < 16; ++i) T[i] = M[i];
}

__device__ __forceinline__ void retr_unit(LAS unsigned char* lds, int h, int tg, const bf16* QPB, const bf16* SKB, unsigned short* IDS, float* GW, const float* RSTD2, int tid) {
    const int lane = tid & 63, wave = __builtin_amdgcn_readfirstlane(tid >> 6), r = lane & 31, hi = lane >> 5;
#pragma unroll
    for (int it = 0; it < 8; ++it) {
        const int cid = it * 512 + tid, row = cid >> 4, ch = cid & 15;
        *(LAS v4u*)(lds + R_KEYS + row * KP + ch * 16) = *(const GAS v4u*)(SKB + ((size_t)h * 256 + row) * 128 + ch * 8);
    }
    const size_t tok = (size_t)tg * 256 + wave * 32 + r;
    bf16x8 qa[8], qb[8];
#pragma unroll
    for (int ks = 0; ks < 8; ++ks) { qa[ks] = *(const GAS bf16x8*)(QPB + tok * D + h * 256 + ks * 16 + hi * 8); qb[ks] = *(const GAS bf16x8*)(QPB + tok * D + h * 256 + 128 + ks * 16 + hi * 8); }
    const float rs = RSTD2[tok];
    __syncthreads();
    float TA[16], TB[16];
    half_top16(lds + R_KEYS, qa, r, hi, TA);
    half_top16(lds + R_KEYS + 128 * KP, qb, r, hi, TB);
    LAS unsigned char* sc = lds + R_IDX + wave * 1024 + r * 32;
    const int hm = -hi;
    {
        v4u w;
#pragma unroll
        for (int q = 0; q < 4; ++q) { unsigned x = 0;
#pragma unroll
            for (int k = 0; k < 4; ++k) { const int t = (fbits(TB[4 * q + k]) & hm) | (fbits(TA[4 * q + k]) & ~hm); x |= (unsigned)(127 - (t & 0x7f)) << (8 * k); }
            w[q] = x; }
        *(LAS v4u*)(sc + hi * 16) = w;
    }
    float sA[16], sB[16];
#pragma unroll
    for (int i = 0; i < 16; ++i) { sA[i] = fval(TA[i], (int)0xffffff80); sB[i] = fval(TB[i], (int)0xffffff80); }
    float L[16];
#pragma unroll
    for (int k = 0; k < 16; ++k) L[k] = -INFINITY;
#pragma unroll
    for (int i = 0; i < 16; ++i)
#pragma unroll
        for (int j = 0; j < 16; ++j) if ((i + 1) * (j + 1) <= 16) {
            ins16(L, fkey(sA[i] + sB[j], (int)0xffffff00, 255 - (i * 16 + j)));
        }
    const float v0 = fval(L[0], (int)0xffffff00);
    asm volatile("s_waitcnt lgkmcnt(0)" ::: "memory");
    int ex[8]; float ew[8]; float esum = 0.f;
#pragma unroll
    for (int k = 0; k < 8; ++k) {
        const int t = (fbits(L[8 + k]) & hm) | (fbits(L[k]) & ~hm);
        const int c = 255 - (t & 0xff);
        const int ia = sc[c >> 4], ib = sc[16 + (c & 15)];
        ex[k] = ia * 128 + ib;
        const float e = __builtin_amdgcn_exp2f((__builtin_bit_cast(float, t & (int)0xffffff00) - v0) * rs * 1.4426950408889634f);
        ew[k] = e; esum += e;
    }
    esum = sum_x32(esum);
    const float inv = 1.0f / esum;
    unsigned short* ip = IDS + tok * 128 + h * 16 + hi * 8; float* gp = GW + tok * 128 + h * 16 + hi * 8;
    *(GAS v4u*)(ip) = (v4u){(unsigned)ex[0] | ((unsigned)ex[1] << 16), (unsigned)ex[2] | ((unsigned)ex[3] << 16), (unsigned)ex[4] | ((unsigned)ex[5] << 16), (unsigned)ex[6] | ((unsigned)ex[7] << 16)};
    *(GAS f32x4*)(gp) = (f32x4){ew[0] * inv, ew[1] * inv, ew[2] * inv, ew[3] * inv};
    *(GAS f32x4*)(gp + 4) = (f32x4){ew[4] * inv, ew[5] * inv, ew[6] * inv, ew[7] * inv};
    __syncthreads();
}
}

namespace p6 {
__device__ __forceinline__ float blo(unsigned w) { return __builtin_bit_cast(float, w << 16); }
__device__ __forceinline__ float bhi(unsigned w) { return __builtin_bit_cast(float, w & 0xffff0000u); }
__device__ __forceinline__ float gelu_fast(float x) { return x * __builtin_amdgcn_rcpf(1.0f + __builtin_amdgcn_exp2f(-2.302208198f * x * (1.0f + 0.044715f * x * x))); }
__device__ __forceinline__ unsigned idw(const v4u& a, const v4u& b, int g) { const unsigned w = g < 8 ? a[(g & 7) >> 1] : b[(g & 7) >> 1]; return (g & 1) ? (w >> 16) : (w & 0xffffu); }
__device__ __forceinline__ unsigned q4(float a, float b, float c, float d, float inv, int bias) {
    const int qa = (int)rintf(a * inv) + bias, qb = (int)rintf(b * inv) + bias, qc = (int)rintf(c * inv) + bias, qd = (int)rintf(d * inv) + bias;
    return (unsigned)(qa & 0xff) | ((unsigned)(qb & 0xff) << 8) | ((unsigned)(qc & 0xff) << 16) | ((unsigned)(qd & 0xff) << 24);
}
__device__ __forceinline__ void qrow_load(f32x4 (&v)[8], const float* src, size_t e, int lane) {
#pragma unroll
    for (int j = 0; j < 8; ++j) v[j] = __builtin_nontemporal_load((const GAS f32x4*)(src + e * D + j * 256 + lane * 4));
}
__device__ __forceinline__ void qrow_finish(f32x4 (&v)[8], const float* gcol, unsigned char* dst, float* scale_out, size_t e, int lane) {
    float am = 0.f;
#pragma unroll
    for (int j = 0; j < 8; ++j) {
        if (gcol) { const f32x4 g = *(const GAS f32x4*)(gcol + j * 256 + lane * 4); v[j] = v[j] * g; }
        am = fmaxf(am, fmaxf(fmaxf(fabsf(v[j].x), fabsf(v[j].y)), fmaxf(fabsf(v[j].z), fabsf(v[j].w))));
    }
    am = max64(am);
    const float inv = am > 0.f ? 127.0f / am : 0.f;
#pragma unroll
    for (int j = 0; j < 8; ++j)
        *(GAS unsigned*)(dst + ((size_t)(2 * j + (lane >> 5)) * 16384 + e) * 128 + (lane & 31) * 4) = q4(v[j].x, v[j].y, v[j].z, v[j].w, inv, 0);
    if (lane == 0) scale_out[e] = am * (1.0f / 127.0f);
}
__device__ __forceinline__ void qx_load(v4u (&x)[4], const bf16* H1B, size_t tok, int lane) {
#pragma unroll
    for (int j = 0; j < 4; ++j) x[j] = *(const GAS v4u*)(H1B + tok * D + j * 512 + lane * 8);
}
__device__ __forceinline__ void qx_finish(const v4u (&x)[4], unsigned char* X8, float* SX, size_t tok, int lane) {
#pragma unroll
    for (int j = 0; j < 4; ++j) {
        float f[8]; float am = 0.f;
#pragma unroll
        for (int k = 0; k < 4; ++k) { f[2 * k] = blo(x[j][k]); f[2 * k + 1] = bhi(x[j][k]); am = fmaxf(am, fmaxf(fabsf(f[2 * k]), fabsf(f[2 * k + 1]))); }
        am = max16(am);
        const float inv = am > 0.f ? 127.0f / am : 0.f;
        typedef unsigned u32x2v __attribute__((ext_vector_type(2)));
        u32x2v o; o.x = q4(f[0], f[1], f[2], f[3], inv, 0); o.y = q4(f[4], f[5], f[6], f[7], inv, 0);
        *(GAS u32x2v*)(X8 + tok * D + j * 512 + lane * 8) = o;
        if ((lane & 15) == 0) SX[tok * 16 + 4 * j + (lane >> 4)] = am * (1.0f / 127.0f);
    }
}

typedef int i32x16 __attribute__((ext_vector_type(16)));
typedef float f32x16v __attribute__((ext_vector_type(16)));
__device__ __forceinline__ int seli(int m, int a, int b) { return (a & m) | (b & ~m); }
__device__ __forceinline__ float self(int m, float a, float b) { return __builtin_bit_cast(float, seli(m, __builtin_bit_cast(int, a), __builtin_bit_cast(int, b))); }
__device__ __forceinline__ void usweep(const unsigned char* X8, const float* SX, const unsigned char* U8, const unsigned short* IDS, bf16* PART, LAS unsigned char* lds, int slot, int rank, int nrank, int wave, int lane) {
    const int ps = lane >> 3, ch = lane & 7;
    const int first = rank * 8 + wave, stride = nrank * 8;
    const int n = first < MREAL ? (MREAL - first + stride - 1) / stride : 0, NQ = 2 * n;
    if (NQ == 0) return;
    const int m4 = -((lane >> 2) & 1), m2 = -((lane >> 1) & 1), m1 = -(lane & 1);
    LAS unsigned char* sl = lds + wave * 1024;
#define U_LOAD(q_, RI, RX, SX_, T_, SG_) do { const int qq_ = (q_) < NQ ? (q_) : NQ - 1; const int rd_ = qq_ >= n ? 1 : 0; T_ = first + (qq_ - rd_ * n) * stride; SG_ = rd_ * 8 + slot; \
        RI = *(const GAS unsigned*)(IDS + (size_t)T_ * 128 + lane * 2); RX = *(const GAS unsigned*)(X8 + (size_t)T_ * D + SG_ * 128 + (lane & 31) * 4); SX_ = SX[(size_t)T_ * 16 + SG_]; } while (0)
#define U_EXPAND(SLOT, RI, RX, I0, I1, XV) do { LAS unsigned char* s_ = sl + (SLOT) * 512; \
        *(LAS unsigned*)(s_ + lane * 4) = RI; if (lane < 32) *(LAS unsigned*)(s_ + 256 + lane * 4) = RX; \
        asm volatile("s_waitcnt lgkmcnt(0)" ::: "memory"); \
        I0 = *(const LAS v4u*)(s_ + ps * 32); I1 = *(const LAS v4u*)(s_ + ps * 32 + 16); XV = *(const LAS v4u*)(s_ + 256 + ch * 16); } while (0)
#define U_ISSUE(BUF, I0, I1, SG_) do { const unsigned char* tab_ = U8 + (size_t)(SG_) * 16384 * 128 + ch * 16; \
        _Pragma("unroll") for (int g = 0; g < 16; ++g) BUF[g] = *(const GAS v4u*)(tab_ + (size_t)idw(I0, I1, g) * 128); } while (0)
#define U_FINISH(BUF, XV, SX_, T_, SG_) do { i32x16 d; \
        _Pragma("unroll") for (int g = 0; g < 16; ++g) { int a_ = __builtin_amdgcn_sdot4((int)BUF[g][0], (int)XV[0], 0, false); a_ = __builtin_amdgcn_sdot4((int)BUF[g][1], (int)XV[1], a_, false); \
            a_ = __builtin_amdgcn_sdot4((int)BUF[g][2], (int)XV[2], a_, false); a_ = __builtin_amdgcn_sdot4((int)BUF[g][3], (int)XV[3], a_, false); d[g] = a_; } \
        int r8[8], r4[4], r2[2]; \
        _Pragma("unroll") for (int k = 0; k < 8; ++k) r8[k] = seli(m4, d[8 + k], d[k]) + dpp_hm(seli(m4, d[k], d[8 + k])); \
        _Pragma("unroll") for (int k = 0; k < 4; ++k) r4[k] = seli(m2, r8[4 + k], r8[k]) + dpp_x2(seli(m2, r8[k], r8[4 + k])); \
        _Pragma("unroll") for (int k = 0; k < 2; ++k) r2[k] = seli(m1, r4[2 + k], r4[k]) + dpp_x1(seli(m1, r4[k], r4[2 + k])); \
        *(GAS unsigned*)(PART + ((size_t)(SG_) * MREAL + T_) * 128 + ps * 16 + 2 * ch) = pk2((float)r2[0] * SX_, (float)r2[1] * SX_); } while (0)
    v4u bufA[16], bufB[16];
    v4u a0, a1, ax, b0, b1, bx; unsigned ri, rx; float as, bs, cs; int at, bt, ct, ag, bg, cg;
    U_LOAD(0, ri, rx, as, at, ag); U_EXPAND(0, ri, rx, a0, a1, ax);
    U_LOAD(1, ri, rx, bs, bt, bg); U_EXPAND(1, ri, rx, b0, b1, bx);
    U_ISSUE(bufA, a0, a1, ag);
    for (int q = 0; q < NQ; q += 2) {
        U_ISSUE(bufB, b0, b1, bg);
        U_LOAD(q + 2, ri, rx, cs, ct, cg);
        U_FINISH(bufA, ax, as, at, ag);
        U_EXPAND(0, ri, rx, a0, a1, ax); as = cs; at = ct; ag = cg;
        U_ISSUE(bufA, a0, a1, ag);
        U_LOAD(q + 3, ri, rx, cs, ct, cg);
        U_FINISH(bufB, bx, bs, bt, bg);
        U_EXPAND(1, ri, rx, b0, b1, bx); bs = cs; bt = ct; bg = cg;
    }
#undef U_LOAD
#undef U_EXPAND
#undef U_ISSUE
#undef U_FINISH
}
__device__ __forceinline__ void wreduce(const bf16* PART, const float* GW, const float* RSTD2, const unsigned short* IDS, const float* SCU, const float* SCV, unsigned char* W8, float* WS8, size_t gt, size_t NT) {
    for (size_t i8 = gt; i8 < (size_t)MREAL * 128 / 8; i8 += NT) {
        float s[8];
#pragma unroll
        for (int k = 0; k < 8; ++k) s[k] = 0.f;
#pragma unroll 8
        for (int sg = 0; sg < 16; ++sg) {
            const v4u p = *(const GAS v4u*)(PART + (size_t)sg * MREAL * 128 + i8 * 8);
#pragma unroll
            for (int k = 0; k < 4; ++k) { s[2 * k] += blo(p[k]); s[2 * k + 1] += bhi(p[k]); }
        }
        const float rs = RSTD2[i8 >> 4];
        const v4u idv = *(const GAS v4u*)(IDS + i8 * 8);
        const f32x4 g0 = *(const GAS f32x4*)(GW + i8 * 8), g1 = *(const GAS f32x4*)(GW + i8 * 8 + 4);
        float w[8]; float am = 0.f;
#pragma unroll
        for (int k = 0; k < 8; ++k) {
            const unsigned e = (k & 1) ? (idv[k >> 1] >> 16) : (idv[k >> 1] & 0xffffu);
            const float g = k < 4 ? g0[k & 3] : g1[k & 3];
            w[k] = g * gelu_fast(rs * SCU[e] * s[k]) * SCV[e]; am = fmaxf(am, fabsf(w[k]));
        }
        am = max16(am);
        const float inv = am > 0.f ? 127.0f / am : 0.f;
        typedef unsigned u32x2v __attribute__((ext_vector_type(2)));
        u32x2v o; o.x = q4(w[0], w[1], w[2], w[3], inv, 0); o.y = q4(w[4], w[5], w[6], w[7], inv, 0);
        *(GAS u32x2v*)(W8 + i8 * 8) = o;
        if ((i8 & 15) == 0) WS8[i8 >> 4] = am * (1.0f / 127.0f);
    }
}
__device__ __forceinline__ void vsweep(const bf16* H1B, const unsigned char* V8, const unsigned short* IDS, const unsigned char* W8, const float* WS8, bf16* Z, float* SSF, LAS unsigned char* lds, int slot, int rank, int nrank, int wave, int lane) {
    const int ps = lane >> 3, ch = lane & 7;
    const int first = rank * 8 + wave, stride = nrank * 8;
    const int n = first < MREAL ? (MREAL - first + stride - 1) / stride : 0, NQ = 2 * n;
    if (NQ == 0) return;
    const int m8 = -((lane >> 3) & 1);
    LAS unsigned char* sl = lds + wave * 1024;
#define V_LOAD(q_, RI, RW, WSC, HX, T_, SG_) do { const int qq_ = (q_) < NQ ? (q_) : NQ - 1; const int rd_ = qq_ >= n ? 1 : 0; T_ = first + (qq_ - rd_ * n) * stride; SG_ = rd_ * 8 + slot; \
        RI = *(const GAS unsigned*)(IDS + (size_t)T_ * 128 + lane * 2); RW = *(const GAS unsigned*)(W8 + (size_t)T_ * 128 + (lane & 31) * 4); WSC = WS8[T_]; \
        HX = *(const GAS unsigned*)(H1B + (size_t)T_ * D + SG_ * 128 + ch * 16 + 2 * ps); } while (0)
#define V_EXPAND(SLOT, RI, RW, I0, I1, WQ) do { LAS unsigned char* s_ = sl + (SLOT) * 512; \
        *(LAS unsigned*)(s_ + lane * 4) = RI; if (lane < 32) *(LAS unsigned*)(s_ + 256 + lane * 4) = RW; \
        asm volatile("s_waitcnt lgkmcnt(0)" ::: "memory"); \
        I0 = *(const LAS v4u*)(s_ + ps * 32); I1 = *(const LAS v4u*)(s_ + ps * 32 + 16); WQ = *(const LAS v4u*)(s_ + 256 + ps * 16); } while (0)
#define V_ISSUE(BUF, I0, I1, SG_) do { const unsigned char* tab_ = V8 + (size_t)(SG_) * 16384 * 128 + ch * 16; \
        _Pragma("unroll") for (int g = 0; g < 16; ++g) BUF[g] = *(const GAS v4u*)(tab_ + (size_t)idw(I0, I1, g) * 128); } while (0)
#define V_FINISH(BUF, WQ, WSC, HX, T_, SG_) do { i32x16 acc = {0, 0, 0, 0, 0, 0, 0, 0, 0, 0, 0, 0, 0, 0, 0, 0}; const unsigned hx_ = HX; \
        _Pragma("unroll") for (int j = 0; j < 4; ++j) { const int wq_ = (int)WQ[j]; \
            _Pragma("unroll") for (int k = 0; k < 4; ++k) { \
                const unsigned d0_ = BUF[4 * j][k], d1_ = BUF[4 * j + 1][k], d2_ = BUF[4 * j + 2][k], d3_ = BUF[4 * j + 3][k]; \
                const unsigned p0_ = __builtin_amdgcn_perm(d1_, d0_, 0x05010400u), p1_ = __builtin_amdgcn_perm(d1_, d0_, 0x07030602u); \
                const unsigned q0_ = __builtin_amdgcn_perm(d3_, d2_, 0x05010400u), q1_ = __builtin_amdgcn_perm(d3_, d2_, 0x07030602u); \
                acc[4 * k + 0] = __builtin_amdgcn_sdot4((int)__builtin_amdgcn_perm(q0_, p0_, 0x05040100u), wq_, acc[4 * k + 0], false); \
                acc[4 * k + 1] = __builtin_amdgcn_sdot4((int)__builtin_amdgcn_perm(q0_, p0_, 0x07060302u), wq_, acc[4 * k + 1], false); \
                acc[4 * k + 2] = __builtin_amdgcn_sdot4((int)__builtin_amdgcn_perm(q1_, p1_, 0x05040100u), wq_, acc[4 * k + 2], false); \
                acc[4 * k + 3] = __builtin_amdgcn_sdot4((int)__builtin_amdgcn_perm(q1_, p1_, 0x07060302u), wq_, acc[4 * k + 3], false); } } \
        int r8[8], r4[4], r2[2]; \
        _Pragma("unroll") for (int k = 0; k < 8; ++k) { const auto rr_ = __builtin_amdgcn_permlane32_swap((unsigned)acc[k], (unsigned)acc[8 + k], false, false); r8[k] = (int)rr_[0] + (int)rr_[1]; } \
        _Pragma("unroll") for (int k = 0; k < 4; ++k) { const auto rr_ = __builtin_amdgcn_permlane16_swap((unsigned)r8[k], (unsigned)r8[4 + k], false, false); r4[k] = (int)rr_[0] + (int)rr_[1]; } \
        _Pragma("unroll") for (int k = 0; k < 2; ++k) r2[k] = seli(m8, r4[2 + k], r4[k]) + dpp_r8(seli(m8, r4[k], r4[2 + k])); \
        const float z0_ = (float)r2[0] * WSC + blo(hx_), z1_ = (float)r2[1] * WSC + bhi(hx_); \
        *(GAS unsigned*)(Z + (size_t)T_ * D + (SG_) * 128 + ch * 16 + 2 * ps) = pk2(z0_, z1_); \
        const float ss_ = sum64(z0_ * z0_ + z1_ * z1_); \
        if (lane == 0) SSF[(size_t)T_ * 16 + (SG_)] = ss_; } while (0)
    v4u bufA[16], bufB[16];
    v4u a0, a1, aw, b0, b1, bw; unsigned ri, rw, ah, bh, chx; float as, bs, cs; int at, bt, ct, ag, bg, cg;
    V_LOAD(0, ri, rw, as, ah, at, ag); V_EXPAND(0, ri, rw, a0, a1, aw);
    V_LOAD(1, ri, rw, bs, bh, bt, bg); V_EXPAND(1, ri, rw, b0, b1, bw);
    V_ISSUE(bufA, a0, a1, ag);
    for (int q = 0; q < NQ; q += 2) {
        V_ISSUE(bufB, b0, b1, bg);
        V_LOAD(q + 2, ri, rw, cs, chx, ct, cg);
        V_FINISH(bufA, aw, as, ah, at, ag);
        V_EXPAND(0, ri, rw, a0, a1, aw); as = cs; ah = chx; at = ct; ag = cg;
        V_ISSUE(bufA, a0, a1, ag);
        V_LOAD(q + 3, ri, rw, cs, chx, ct, cg);
        V_FINISH(bufB, bw, bs, bh, bt, bg);
        V_EXPAND(1, ri, rw, b0, b1, bw); bs = cs; bh = chx; bt = ct; bg = cg;
    }
#undef V_LOAD
#undef V_EXPAND
#undef V_ISSUE
#undef V_FINISH
}
__device__ __forceinline__ void final_row(const bf16* Z, const float* SSF, const float* fg, float* out, size_t tok, int lane) {
    v4u z[4];
#pragma unroll
    for (int j = 0; j < 4; ++j) z[j] = *(const GAS v4u*)(Z + tok * D + j * 512 + lane * 8);
    float ss = 0.f;
#pragma unroll
    for (int k = 0; k < 4; ++k) { const f32x4 v = *(const GAS f32x4*)(SSF + tok * 16 + 4 * k); ss += (v.x + v.y) + (v.z + v.w); }
    const float rf = 1.0f / sqrtf(ss * (1.0f / D) + EPS);
#pragma unroll
    for (int j = 0; j < 4; ++j) {
        const f32x4 ga = *(const GAS f32x4*)(fg + j * 512 + lane * 8), gb = *(const GAS f32x4*)(fg + j * 512 + lane * 8 + 4);
        *(GAS f32x4*)(out + tok * D + j * 512 + lane * 8) = (f32x4){blo(z[j][0]) * rf * ga.x, bhi(z[j][0]) * rf * ga.y, blo(z[j][1]) * rf * ga.z, bhi(z[j][1]) * rf * ga.w};
        *(GAS f32x4*)(out + tok * D + j * 512 + lane * 8 + 4) = (f32x4){blo(z[j][2]) * rf * gb.x, bhi(z[j][2]) * rf * gb.y, blo(z[j][3]) * rf * gb.z, bhi(z[j][3]) * rf * gb.w};
    }
}
}

struct Frame {
    LAS unsigned char* lds;
    volatile LAS unsigned* MISC;
    gu32* ctl;
    int tid, lane, wave, vcu, G;
};
__device__ __forceinline__ float wave_sum(float v) { return sum64(v); }
__device__ __forceinline__ void p0_transpose_item(const float* W, int K, int N, bf16* WT, const float* g0, const float* g1, int ksplit, LAS float* scr, int item, int lane) {
    const int nblk = N / 32, kb = item / nblk, nb = item % nblk, k0 = 64 * kb, n0 = 32 * nb;
#pragma unroll 16
    for (int i = 0; i < 32; ++i) { const int kk = 2 * i + (lane >> 5); const int kg = k0 + kk; const float gv = kg < ksplit ? g0[kg] : g1[kg - ksplit];
        scr[kk * 33 + (lane & 31)] = W[(size_t)kg * N + n0 + (lane & 31)] * gv; }
    LDS_WAIT(); asm volatile("" ::: "memory");
    const int c = lane & 7;
#pragma unroll
    for (int j = 0; j < 4; ++j) { const int n = (lane >> 3) + 8 * j; const LAS float* s = scr + (8 * c) * 33 + n;
        v4u o; o.x = pk2(s[0 * 33], s[1 * 33]); o.y = pk2(s[2 * 33], s[3 * 33]); o.z = pk2(s[4 * 33], s[5 * 33]); o.w = pk2(s[6 * 33], s[7 * 33]);
        *(GAS v4u*)(WT + (size_t)(n0 + n) * K + k0 + 8 * c) = o; }
    LDS_WAIT(); asm volatile("" ::: "memory");
}
__device__ __forceinline__ void p0_row_load(f32x4 (&v)[8], const float* xrow, int lane) {
    const GAS f32x4* xr = (const GAS f32x4*)xrow + lane;
#pragma unroll
    for (int j = 0; j < 8; ++j) v[j] = __builtin_nontemporal_load(xr + 64 * j);
}
__device__ __forceinline__ void p0_row_finish(const f32x4 (&v)[8], bf16* orow, float* rstd_out, int lane) {
    float s = 0.f;
#pragma unroll
    for (int j = 0; j < 8; ++j) s += (v[j].x * v[j].x + v[j].y * v[j].y) + (v[j].z * v[j].z + v[j].w * v[j].w);
    s = wave_sum(s);
    GAS unsigned long long* o8 = (GAS unsigned long long*)orow + lane;
#pragma unroll
    for (int j = 0; j < 8; ++j) o8[64 * j] = (unsigned long long)pk2(v[j].x, v[j].y) | ((unsigned long long)pk2(v[j].z, v[j].w) << 32);
    if (lane == 0) *rstd_out = 1.0f / sqrtf(s * (1.0f / D) + EPS);
}
__device__ __forceinline__ void p0_cvt8(const float* src, bf16* dst, const float* gcol, size_t idx8) {
    const f32x4 a = *(const GAS f32x4*)(src + idx8 * 8), b = *(const GAS f32x4*)(src + idx8 * 8 + 4);
    f32x4 ga = {1.f, 1.f, 1.f, 1.f}, gb = {1.f, 1.f, 1.f, 1.f};
    if (gcol) { const int c = (int)((idx8 * 8) & (D - 1)); ga = *(const GAS f32x4*)(gcol + c); gb = *(const GAS f32x4*)(gcol + c + 4); }
    v4u o; o.x = pk2(a.x * ga.x, a.y * ga.y); o.y = pk2(a.z * ga.z, a.w * ga.w); o.z = pk2(b.x * gb.x, b.y * gb.y); o.w = pk2(b.z * gb.z, b.w * gb.w);
    *(GAS v4u*)(dst + idx8 * 8) = o;
}

struct Args { const float* in[22]; float* out; unsigned char* ws; int ph_lo, ph_hi, rep_mask, pad; };

__global__ void __launch_bounds__(NWAVES * 64, 2) fwd(Args args) {
    extern __shared__ __attribute__((aligned(16))) unsigned char lds[];
    Frame F;
    F.lds = (LAS unsigned char*)lds;
    F.MISC = (volatile LAS unsigned*)(F.lds + MISC_OFF);
    F.tid = threadIdx.x; F.lane = F.tid & 63; F.wave = __builtin_amdgcn_readfirstlane(F.tid >> 6);
    F.G = gridDim.x; { const int bx = blockIdx.x; F.vcu = (F.G % 8 == 0) ? (bx % 8) * (F.G / 8) + bx / 8 : bx; }
    unsigned char* ws = args.ws;
    F.ctl = (gu32*)(ws + WS_CTL);
    for (int u = F.tid; u < (LDS_BYTES - LDSCTL_OFF) / 4; u += NWAVES * 64) ((LAS unsigned*)(F.lds + LDSCTL_OFF))[u] = 0u;
    __syncthreads();
    XcdBarrier bar = xcd_barrier_post((unsigned*)(F.ctl + CW_BAR), F.MISC + 8);
    const int lo = args.ph_lo, hi = args.ph_hi;
#define IN(k) (lo <= (k) && (k) < hi)
#define BOTH(k) (IN(k) && IN((k) + 1))
#ifndef PROBE_PH
#define PROBE_PH (-1)
#endif
#define REP(k) for (int rep_ = 0; rep_ < ((k) == PROBE_PH ? 2 : 1); ++rep_)

    const float* x = args.in[0]; const float* meta = args.in[1]; const float* norm_mix_g = args.in[2]; const float* w_in = args.in[3]; const float* b_in = args.in[4];
    const float* gn_attn_g = args.in[13]; const float* gn_lru_g = args.in[14]; const float* w_out = args.in[15]; const float* norm_ffn_g = args.in[16];
    const float* peer_wq = args.in[17]; const float* sub_keys = args.in[18]; const float* peer_u = args.in[19]; const float* peer_v = args.in[20];
    bf16* W1T = (bf16*)(ws + WS_W1T); bf16* W2T = (bf16*)(ws + WS_W2T); bf16* W3T = (bf16*)(ws + WS_W3T); bf16* SKB = (bf16*)(ws + WS_SKB);
    float* RSTD1 = (float*)(ws + WS_RSTD1);
    unsigned char* U8 = ws + WS_U8; unsigned char* V8 = ws + WS_V8; unsigned char* X8 = ws + WS_X8; float* SX = (float*)(ws + WS_SX); float* SCU = (float*)(ws + WS_SCU); float* SCV = (float*)(ws + WS_SCV);
    bf16* A1 = (bf16*)(ws + WS_A1);
    bf16* QB = (bf16*)(ws + WS_Q); bf16* KVB = (bf16*)(ws + WS_KV); bf16* XBB = (bf16*)(ws + WS_XB); bf16* GTB = (bf16*)(ws + WS_GT);

    if (IN(0)) { REP(0) {
        LAS float* scr = (LAS float*)(F.lds + RING_OFF + F.wave * 16384);
        const int gw = F.vcu * NWAVES + F.wave, NGW = F.G * NWAVES;
        constexpr int I_1 = (D / 64) * (IND / 32), I_2 = (D / 64) * (D / 32), I_3 = I_2;
        for (int it = gw; it < I_1 + I_2 + I_3; it += NGW) {
            int r = it;
            if (r < I_1) { p0_transpose_item(w_in, D, IND, W1T, norm_mix_g, norm_mix_g, D, scr, r, F.lane); continue; } r -= I_1;
            if (r < I_2) { p0_transpose_item(w_out, D, D, W2T, gn_attn_g, gn_lru_g, 1024, scr, r, F.lane); continue; } r -= I_2;
            p0_transpose_item(peer_wq, D, D, W3T, norm_ffn_g, norm_ffn_g, D, scr, r, F.lane);
        }
        {
            f32x4 cur[8], nxt[8];
            if (gw < MREAL + NMETA) p0_row_load(cur, gw < MREAL ? x + (size_t)gw * D : meta + (size_t)(gw - MREAL) * D, F.lane);
            for (int m = gw; m < MREAL + NMETA; m += NGW) {
                const int mn = m + NGW;
                if (mn < MREAL + NMETA) p0_row_load(nxt, mn < MREAL ? x + (size_t)mn * D : meta + (size_t)(mn - MREAL) * D, F.lane);
                p0_row_finish(cur, A1 + (size_t)m * D, RSTD1 + m, F.lane);
#pragma unroll
                for (int j = 0; j < 8; ++j) cur[j] = nxt[j];
            }
        }
        {
            const size_t gt = (size_t)gw * 64 + F.lane, NT = (size_t)NGW * 64;
            for (size_t i = gt; i < (size_t)(8 * 2 * 128 * 128) / 8; i += NT) p0_cvt8(sub_keys, SKB, nullptr, i);
            {
                f32x4 cur[8], nxt[8];
                constexpr int QV0 = 6144;
                if (QV0 + gw < 16384) p6::qrow_load(cur, peer_v, (size_t)(QV0 + gw), F.lane);
                for (int rj = QV0 + gw; rj < 16384; rj += NGW) {
                    const int rn = rj + NGW;
                    if (rn < 16384) p6::qrow_load(nxt, peer_v, (size_t)rn, F.lane);
                    p6::qrow_finish(cur, nullptr, V8, SCV, (size_t)rj, F.lane);
#pragma unroll
                    for (int j = 0; j < 8; ++j) cur[j] = nxt[j];
                }
            }
        } }
        if (BOTH(0)) xcd_barrier(bar);
    }
    if (IN(1)) {
        pg8::Gemm g{A1, W1T, MPAD, IND, D};
        pg8::Order1 S{F.G, (int)blockIdx.x};
        pg8::Epi1 E{QB, KVB, XBB, GTB, RSTD1, b_in};
        REP(1) pg8::gemm_phase<pg8::Epi1, pg8::Order1, true, true>(F.lds + RING_OFF, g, S, E);
        {
            volatile LAS int* qb = (volatile LAS int*)(F.lds + LDSCTL_OFF + 512);
            for (;;) {
                __syncthreads();
                if (F.tid == 0) qb[0] = (int)__hip_atomic_fetch_add((unsigned*)(F.ctl + CW_QROW), 32u, __ATOMIC_RELAXED, __HIP_MEMORY_SCOPE_AGENT);
                __syncthreads();
                const int base = qb[0];
                if (base >= 16384 + 6144) break;
                f32x4 r0[8], r1[8], r2[8], r3[8];
                const bool isu = base < 16384;
                const float* src = isu ? peer_u : peer_v; const float* gc = isu ? norm_ffn_g : nullptr; unsigned char* dst = isu ? U8 : V8; float* sc = isu ? SCU : SCV;
                const size_t e0 = (size_t)(isu ? base : base - 16384) + F.wave * 4;
                p6::qrow_load(r0, src, e0, F.lane); p6::qrow_load(r1, src, e0 + 1, F.lane); p6::qrow_load(r2, src, e0 + 2, F.lane); p6::qrow_load(r3, src, e0 + 3, F.lane);
                p6::qrow_finish(r0, gc, dst, sc, e0, F.lane); p6::qrow_finish(r1, gc, dst, sc, e0 + 1, F.lane);
                p6::qrow_finish(r2, gc, dst, sc, e0 + 2, F.lane); p6::qrow_finish(r3, gc, dst, sc, e0 + 3, F.lane);
            }
        }
        if (BOTH(1)) xcd_barrier(bar);
    }
    if (IN(2)) {
        bf16* MIX = (bf16*)(ws + WS_A1); float* SSA = (float*)(ws + WS_SSA); float* SSL = (float*)(ws + WS_SSL);
        const p2::LruP LP{args.in[6], args.in[7], args.in[8], args.in[9], args.in[10], args.in[11], args.in[12]};
        {
        REP(20) for (int u = (int)blockIdx.x; u < 256; u += F.G) p2::lru_unit(F.lds + RING_OFF, F.lds + LDSCTL_OFF + 5120, u >> 5, (u >> 1) & 15, u & 1, XBB, GTB, LP, MIX, SSL, F.tid);
        REP(21) for (int a = (int)blockIdx.x; a < 256; a += F.G) p2::attn_unit(F.lds + RING_OFF, a >> 5, (a >> 1) & 15, a & 1, QB, KVB, args.in[5], MIX, SSA, F.tid);
        }
        if (BOTH(2)) xcd_barrier(bar);
    }
    if (IN(3)) {
        bf16* MIX = (bf16*)(ws + WS_A1); const float* SSA = (const float*)(ws + WS_SSA); const float* SSL = (const float*)(ws + WS_SSL);
        bf16* H1B = (bf16*)(ws + WS_H1); float* SS2 = (float*)(ws + WS_SS2);
        pg8::Order2 S{F.G, (int)blockIdx.x};
        LAS float* tbl = (LAS float*)(F.lds + LDSCTL_OFF + 1024);
        pg8::Unit u0{0, 0};
        for (int i = 0; i < 2; ++i) {
            pg8::Unit u; if (!S.next(i, u)) break; if (i == 0) u0 = u;
            if (F.tid < 256) {
                const size_t row = (size_t)u.pm * 256 + F.tid; float sa = 0.f, sl = 0.f;
#pragma unroll
                for (int k = 0; k < 4; ++k) { const f32x4 v = *(const GAS f32x4*)(SSA + row * 16 + 4 * k); sa += (v.x + v.y) + (v.z + v.w); }
#pragma unroll
                for (int k = 0; k < 8; ++k) { const f32x4 v = *(const GAS f32x4*)(SSL + row * 32 + 4 * k); sl += (v.x + v.y) + (v.z + v.w); }
                const float ra = 1.0f / sqrtf(sa * (1.0f / 1024) + EPS), rl = 1.0f / sqrtf(sl * (1.0f / 1024) + EPS);
                tbl[(i * 256 + F.tid) * 2] = ra / rl; tbl[(i * 256 + F.tid) * 2 + 1] = rl;
            }
        }
        __syncthreads();
        pg8::Gemm g{MIX, W2T, MREAL, D, D};
        pg8::Epi2 E{H1B, x, SS2, (const LAS float*)tbl, u0.pm};
        REP(3) pg8::gemm_phase<pg8::Epi2, pg8::Order2, true, true>(F.lds + RING_OFF, g, S, E);
        if (BOTH(3)) xcd_barrier(bar);
    }
    if (IN(4)) {
        bf16* H1B = (bf16*)(ws + WS_H1); bf16* QPB = (bf16*)(ws + WS_A1);
        pg8::Order2 S{F.G, (int)blockIdx.x};
        {
            const float* SS2 = (const float*)(ws + WS_SS2); float* RSTD2 = (float*)(ws + WS_RSTD2);
            pg8::Unit u; if (S.next(0, u) && F.tid < 256) {
                const size_t row = (size_t)u.pm * 256 + F.tid; float ssq = 0.f;
#pragma unroll
                for (int k = 0; k < 8; ++k) { const f32x4 v = *(const GAS f32x4*)(SS2 + row * 32 + 4 * k); ssq += (v.x + v.y) + (v.z + v.w); }
                RSTD2[row] = 1.0f / sqrtf(ssq * (1.0f / D) + EPS);
            }
        }
        pg8::Gemm g{H1B, W3T, MREAL, D, D};
        pg8::Epi3 E{QPB};
        REP(4) pg8::gemm_phase<pg8::Epi3, pg8::Order2, true, true>(F.lds + RING_OFF, g, S, E);
        if (BOTH(4)) xcd_barrier(bar);
    }
    if (IN(5)) {
        const bf16* QPB = (const bf16*)(ws + WS_A1);
        unsigned short* IDS = (unsigned short*)(ws + WS_IDS); float* GW = (float*)(ws + WS_GW); float* RSTD2 = (float*)(ws + WS_RSTD2);
        const bf16* H1B = (const bf16*)(ws + WS_H1);
        REP(5) for (int u = (int)blockIdx.x; u < 512; u += F.G) {
            v4u xq[4][4]; const size_t tb = (size_t)(u >> 3) * 256 + F.wave * 32 + (u & 7);
#pragma unroll
            for (int k = 0; k < 4; ++k) p6::qx_load(xq[k], H1B, tb + 8 * k, F.lane);
            p5::retr_unit(F.lds + RING_OFF, u & 7, u >> 3, QPB, SKB, IDS, GW, RSTD2, F.tid);
#pragma unroll
            for (int k = 0; k < 4; ++k) p6::qx_finish(xq[k], X8, SX, tb + 8 * k, F.lane);
        }
        if (BOTH(5)) xcd_barrier(bar);
    }
    {
        const bf16* H1B = (const bf16*)(ws + WS_H1); const unsigned short* IDS = (const unsigned short*)(ws + WS_IDS); const float* GW = (const float*)(ws + WS_GW);
        const float* RSTD2 = (const float*)(ws + WS_RSTD2); bf16* PART = (bf16*)(ws + WS_PART); unsigned char* W8 = ws + WS_W; float* WS8 = (float*)(ws + WS_WSUM); bf16* ZB = (bf16*)(ws + WS_Z); float* SSF = (float*)(ws + WS_SSL);
        const int slot = (int)blockIdx.x & 7, rank = (int)blockIdx.x >> 3, nrank = (F.G - slot + 7) >> 3;
        const int gw = F.vcu * NWAVES + F.wave, NGW = F.G * NWAVES;
        if (IN(6)) { REP(6) p6::usweep(X8, SX, U8, IDS, PART, F.lds + RING_OFF, slot, rank, nrank, F.wave, F.lane); if (BOTH(6)) xcd_barrier(bar); }
        if (IN(7)) { REP(7) p6::wreduce(PART, GW, RSTD2, IDS, SCU, SCV, W8, WS8, (size_t)gw * 64 + F.lane, (size_t)NGW * 64); if (BOTH(7)) xcd_barrier(bar); }
        if (IN(8)) { REP(8) p6::vsweep(H1B, V8, IDS, W8, WS8, ZB, SSF, F.lds + RING_OFF, slot, rank, nrank, F.wave, F.lane); if (BOTH(8)) xcd_barrier(bar); }
        if (PROBE_PH == 30) { for (int k = 0; k < 16; ++k) xcd_barrier(bar); }
        if (IN(9)) { REP(9) for (int t = gw; t < MREAL; t += NGW) p6::final_row(ZB, SSF, args.in[21], args.out, (size_t)t, F.lane); }
    }
#undef IN
#undef BOTH
}

extern "C" void kernel_launch(void* const* d_in, const int* in_sizes, int n_in, void* d_out, int out_size, void* d_ws, size_t ws_size, hipStream_t stream) {
    static int grid = 0;
    if (grid == 0) {
        int dev = 0, cus = 0;
        if (hipGetDevice(&dev) != hipSuccess || hipDeviceGetAttribute(&cus, hipDeviceAttributeMultiprocessorCount, dev) != hipSuccess) { fprintf(stderr, "kernel_launch: device query failed\n"); grid = -1; return; }
        if (hipFuncSetAttribute((const void*)fwd, hipFuncAttributeMaxDynamicSharedMemorySize, LDS_BYTES) != hipSuccess) { fprintf(stderr, "kernel_launch: hipFuncSetAttribute failed\n"); grid = -1; return; }
        int per_cu = 0;
        if (hipOccupancyMaxActiveBlocksPerMultiprocessor(&per_cu, (const void*)fwd, NWAVES * 64, LDS_BYTES) != hipSuccess || per_cu < 1) fprintf(stderr, "kernel_launch: occupancy query says %d\n", per_cu);
        (void)hipGetLastError();
        grid = cus;
        if (cus != 256) { fprintf(stderr, "kernel_launch: built for a 256-CU device (tile-to-workgroup maps of the GEMM phases), found %d CUs; nothing launched\n", cus); grid = -1; return; }
        if (ws_size < WS_END) { fprintf(stderr, "kernel_launch: ws too small %zu\n", ws_size); grid = -1; return; }
    }
    if (grid < 0) return;
    (void)hipMemsetAsync((char*)d_ws + WS_CTL, 0, CTL_ZERO_BYTES, stream);
    Args a{};
    for (int i = 0; i < 22; ++i) a.in[i] = (const float*)d_in[i];
    a.out = (float*)d_out; a.ws = (unsigned char*)d_ws; a.ph_lo = 0; a.ph_hi = 10;
    hipLaunchKernelGGL(fwd, dim3(grid), dim3(NWAVES * 64), LDS_BYTES, stream, a);
}
```

```cpp
#include <hip/hip_runtime.h>
#include <cstdio>
#include <cstdint>
#include <math.h>

#define D 2048
#define NB 8
#define SEQ 2048
#define NMETA 16
#define TT (SEQ + NMETA)
#define MR (NB * TT)
#define MREAL (NB * SEQ)
#define MPAD (MREAL + 256)
#define QD 1024
#define KVD 128
#define LW 1024
#define IND 3328
#define EPS 1e-6f
#define QSCALE (0.125f * 1.4426950408889634f)
#define GAS __attribute__((address_space(1)))
#define LAS __attribute__((address_space(3)))

#define DPP_I(x, ctrl) __builtin_amdgcn_update_dpp(0, (x), (ctrl), 0xf, 0xf, true)
__device__ __forceinline__ int dpp_x1(int x) { return DPP_I(x, 0xB1); }
__device__ __forceinline__ int dpp_x2(int x) { return DPP_I(x, 0x4E); }
__device__ __forceinline__ int dpp_hm(int x) { return DPP_I(x, 0x141); }
__device__ __forceinline__ int dpp_rm(int x) { return DPP_I(x, 0x140); }
__device__ __forceinline__ int dpp_r8(int x) { return DPP_I(x, 0x128); }
__device__ __forceinline__ float fdpp_x1(float x) { return __builtin_bit_cast(float, dpp_x1(__builtin_bit_cast(int, x))); }
__device__ __forceinline__ float fdpp_x2(float x) { return __builtin_bit_cast(float, dpp_x2(__builtin_bit_cast(int, x))); }
__device__ __forceinline__ float fdpp_hm(float x) { return __builtin_bit_cast(float, dpp_hm(__builtin_bit_cast(int, x))); }
__device__ __forceinline__ float fdpp_rm(float x) { return __builtin_bit_cast(float, dpp_rm(__builtin_bit_cast(int, x))); }
__device__ __forceinline__ float max16(float v) { v = fmaxf(v, fdpp_x1(v)); v = fmaxf(v, fdpp_x2(v)); v = fmaxf(v, fdpp_hm(v)); return fmaxf(v, fdpp_rm(v)); }
__device__ __forceinline__ float sum64(float v) {
    v += fdpp_x1(v); v += fdpp_x2(v); v += fdpp_hm(v); v += fdpp_rm(v);
    return (__builtin_bit_cast(float, __builtin_amdgcn_readlane(__builtin_bit_cast(int, v), 0)) + __builtin_bit_cast(float, __builtin_amdgcn_readlane(__builtin_bit_cast(int, v), 16)))
         + (__builtin_bit_cast(float, __builtin_amdgcn_readlane(__builtin_bit_cast(int, v), 32)) + __builtin_bit_cast(float, __builtin_amdgcn_readlane(__builtin_bit_cast(int, v), 48)));
}
__device__ __forceinline__ float max64(float v) {
    v = max16(v);
    return fmaxf(fmaxf(__builtin_bit_cast(float, __builtin_amdgcn_readlane(__builtin_bit_cast(int, v), 0)), __builtin_bit_cast(float, __builtin_amdgcn_readlane(__builtin_bit_cast(int, v), 16))),
                 fmaxf(__builtin_bit_cast(float, __builtin_amdgcn_readlane(__builtin_bit_cast(int, v), 32)), __builtin_bit_cast(float, __builtin_amdgcn_readlane(__builtin_bit_cast(int, v), 48))));
}
__device__ __forceinline__ float sum8(float v) { v += fdpp_x1(v); v += fdpp_x2(v); return v + fdpp_hm(v); }
__device__ __forceinline__ float sum4(float v) { v += fdpp_x1(v); return v + fdpp_x2(v); }
__device__ __forceinline__ float sum_x32(float v) { return v + __shfl_xor(v, 32); }
__device__ __forceinline__ float max_x32(float v) { return fmaxf(v, __shfl_xor(v, 32)); }
__device__ __forceinline__ float sum_x16(float v) { return v + __shfl_xor(v, 16); }
namespace pg8 {
#define PG8_LAS __attribute__((address_space(3)))
typedef unsigned short bf16_t;
typedef short bf16x8 __attribute__((ext_vector_type(8)));
typedef float f32x4 __attribute__((ext_vector_type(4)));
typedef unsigned u32x4 __attribute__((ext_vector_type(4)));
constexpr int BM = 256, BK = 64, HALF = 128, HTB = HALF * BK * 2  , STAGE_BYTES = 8 * HTB, NXCD = 8, WGM = 8;

__host__ __device__ __forceinline__ int lds_byte(int r, int c) { const int st = (r >> 4) * 2 + (c >> 5), rr = r & 15, cc = c & 31, ob = rr * 64 + cc * 2; return st * 1024 + (ob ^ (((ob >> 9) & 1) << 5)); }
__host__ __device__ __forceinline__ void stage_rc(int b, int& R, int& C) { const int st = b / 1024, sb = b % 1024, swz = sb ^ (((sb >> 9) & 1) << 5); R = (st >> 1) * 16 + swz / 64; C = (st & 1) * 32 + (swz % 64) / 2; }
__host__ __device__ __forceinline__ int perm32(int rho) { const int n = rho >> 4, i = rho & 15; return 8 * (i >> 2) + 4 * n + (i & 3); }

struct Unit { int pm, pn; };
struct Gemm { const bf16_t* A; const bf16_t* Bt; int M, N, K; };

struct StaticOrder {
    int nM, nN, nwg, G, c;
    __host__ __device__ void init(int M, int N, int G_, int c_) { nM = M / BM; nN = N / BM; nwg = nM * nN; G = G_; c = c_; }
    __host__ __device__ bool next(int i, Unit& u) const {
        const long L = (long)i * G + c; if (L >= nwg) return false;
        int wgid = (int)L; { const int q = nwg / NXCD, r = nwg % NXCD, xcd = wgid % NXCD, off = wgid / NXCD; wgid = (xcd < r ? xcd * (q + 1) : r * (q + 1) + (xcd - r) * q) + off; }
        const int nig = WGM * nN, gid = wgid / nig, fm = gid * WGM, gsz = (nM - fm) < WGM ? (nM - fm) : WGM;
        u.pm = fm + ((wgid % nig) % gsz); u.pn = (wgid % nig) / gsz; return true;
    }
    __device__ __forceinline__ void a_ready(const Unit&) const {}
    __device__ __forceinline__ void done(const Unit&) const {}
};

__device__ __forceinline__ unsigned cvt_pk_bf16(float lo, float hi) { unsigned r; asm volatile("v_cvt_pk_bf16_f32 %0, %1, %2" : "=v"(r) : "v"(lo), "v"(hi)); return r; }
typedef unsigned u32x2 __attribute__((ext_vector_type(2)));
struct Order1 {
    int G, c;
    __device__ __forceinline__ bool next(int i, Unit& u) const {
        const int L = i * G + c; if (L >= 837) return false;
        if (L >= 832) { u.pm = 64; u.pn = 4 + (L - 832); return true; }
        const int nwg = 832, nN = 13;
        int wgid = L; { const int q = nwg / NXCD, xcd = wgid % NXCD, off = wgid / NXCD; wgid = xcd * q + off; }
        const int nig = WGM * nN, gid = wgid / nig, fm = gid * WGM;
        u.pm = fm + ((wgid % nig) % WGM); u.pn = (wgid % nig) / WGM; return true;
    }
    __device__ __forceinline__ void a_ready(const Unit&) const {}
    __device__ __forceinline__ void done(const Unit&) const {}
};
struct Order2 {
    int G, c;
    __device__ __forceinline__ bool next(int i, Unit& u) const {
        const int L = i * G + c; if (L >= 512) return false;
        const int nwg = 512, nN = 8;
        int wgid = L; { const int q = nwg / NXCD, xcd = wgid % NXCD, off = wgid / NXCD; wgid = xcd * q + off; }
        const int nig = WGM * nN, gid = wgid / nig, fm = gid * WGM;
        u.pm = fm + ((wgid % nig) % WGM); u.pn = (wgid % nig) / WGM; return true;
    }
    __device__ __forceinline__ void a_ready(const Unit&) const {}
    __device__ __forceinline__ void done(const Unit&) const {}
};

struct Epi1 {
    static constexpr bool PERM = true, AFTER_DRAIN = false, MIDK = false, INIT = false;
    bf16_t *Q, *KV, *XB, *GT; const float* rstd; const float* bias;
    __device__ __forceinline__ void midk(f32x4 (&acc)[2][2][4][2], const Unit& u, int wr, int wc, int fr, int fq) const {}
    __device__ __forceinline__ void operator()(const f32x4 (&acc)[2][2][4][2], const Unit& u, int wr, int wc, int fr, int fq) const {
        const int row0 = u.pm * BM + wr * 64 + fr;
        bf16_t* base; int ldc, colb; float sc = 1.f;
        if (u.pn < 4) { base = Q; ldc = 1024; colb = u.pn * BM; sc = QSCALE; }
        else if (u.pn == 4) { base = KV; ldc = 256; colb = 0; }
        else if (u.pn < 9) { base = XB; ldc = 1024; colb = (u.pn - 5) * BM; }
        else { base = GT; ldc = 1024; colb = (u.pn - 9) * BM; }
        const int col0 = colb + wc * 32 + 8 * fq, bcol0 = u.pn * BM + wc * 32 + 8 * fq;
        f32x4 bv[2][2];
#pragma unroll
        for (int bj = 0; bj < 2; ++bj)
#pragma unroll
            for (int n = 0; n < 2; ++n) bv[bj][n] = *(const f32x4*)(bias + bcol0 + bj * HALF + 4 * n);
#pragma unroll
        for (int ai = 0; ai < 2; ++ai)
#pragma unroll
            for (int m = 0; m < 4; ++m) {
                const int row = row0 + ai * HALF + m * 16; const float rs = rstd[row];
                bf16_t* rowp = base + (size_t)row * ldc + col0;
#pragma unroll
                for (int bj = 0; bj < 2; ++bj) {
                    f32x4 v0 = (acc[ai][bj][m][0] * rs + bv[bj][0]) * sc, v1 = (acc[ai][bj][m][1] * rs + bv[bj][1]) * sc;
                    u32x4 w; w.x = cvt_pk_bf16(v0[0], v0[1]); w.y = cvt_pk_bf16(v0[2], v0[3]); w.z = cvt_pk_bf16(v1[0], v1[1]); w.w = cvt_pk_bf16(v1[2], v1[3]);
                    *(u32x4*)(rowp + bj * HALF) = w; } }
    }
};
struct Epi2 {
    static constexpr bool PERM = true, AFTER_DRAIN = false, MIDK = true, INIT = true;
    bf16_t* H1; const bf16_t* xb; float* SS2; const LAS float* tbl; int pm0;
    __device__ __forceinline__ void init(f32x4 (&acc)[2][2][4][2], const Unit& u, int wr, int wc, int fr, int fq) const {
        const LAS float* t = tbl + (u.pm == pm0 ? 0 : 1024);
        const int col0 = u.pn * BM + wc * 32 + 8 * fq;
#pragma unroll
        for (int ai = 0; ai < 2; ++ai)
#pragma unroll
            for (int m = 0; m < 4; ++m) {
                const int rl = ai * HALF + wr * 64 + m * 16 + fr; const size_t row = (size_t)u.pm * BM + rl; const float ia = t[rl * 4 + 2];
#pragma unroll
                for (int bj = 0; bj < 2; ++bj) {
                    const u32x4 xw = *(const u32x4*)(xb + row * 2048 + col0 + bj * HALF);
                    acc[ai][bj][m][0] = (f32x4){__builtin_bit_cast(float, xw.x << 16), __builtin_bit_cast(float, xw.x & 0xffff0000u), __builtin_bit_cast(float, xw.y << 16), __builtin_bit_cast(float, xw.y & 0xffff0000u)} * ia;
                    acc[ai][bj][m][1] = (f32x4){__builtin_bit_cast(float, xw.z << 16), __builtin_bit_cast(float, xw.z & 0xffff0000u), __builtin_bit_cast(float, xw.w << 16), __builtin_bit_cast(float, xw.w & 0xffff0000u)} * ia; }
            }
    }
    __device__ __forceinline__ void midk(f32x4 (&acc)[2][2][4][2], const Unit& u, int wr, int wc, int fr, int fq) const {
        const LAS float* t = tbl + (u.pm == pm0 ? 0 : 1024);
#pragma unroll
        for (int ai = 0; ai < 2; ++ai)
#pragma unroll
            for (int m = 0; m < 4; ++m) { const float ra = t[(ai * HALF + wr * 64 + m * 16 + fr) * 4];
#pragma unroll
                for (int bj = 0; bj < 2; ++bj)
#pragma unroll
                    for (int n = 0; n < 2; ++n) acc[ai][bj][m][n] = acc[ai][bj][m][n] * ra; }
    }
    __device__ __forceinline__ void operator()(const f32x4 (&acc)[2][2][4][2], const Unit& u, int wr, int wc, int fr, int fq) const {
        const LAS float* t = tbl + (u.pm == pm0 ? 0 : 1024);
        const int col0 = u.pn * BM + wc * 32 + 8 * fq;
#pragma unroll
        for (int ai = 0; ai < 2; ++ai)
#pragma unroll
            for (int m = 0; m < 4; ++m) {
                const int rl = ai * HALF + wr * 64 + m * 16 + fr; const size_t row = (size_t)u.pm * BM + rl; const float rs = t[rl * 4 + 1];
                float ss = 0.f;
#pragma unroll
                for (int bj = 0; bj < 2; ++bj) {
                    const f32x4 v0 = acc[ai][bj][m][0] * rs, v1 = acc[ai][bj][m][1] * rs;
                    ss += (v0[0] * v0[0] + v0[1] * v0[1]) + (v0[2] * v0[2] + v0[3] * v0[3]) + (v1[0] * v1[0] + v1[1] * v1[1]) + (v1[2] * v1[2] + v1[3] * v1[3]);
                    u32x4 w; w.x = cvt_pk_bf16(v0[0], v0[1]); w.y = cvt_pk_bf16(v0[2], v0[3]); w.z = cvt_pk_bf16(v1[0], v1[1]); w.w = cvt_pk_bf16(v1[2], v1[3]);
                    *(u32x4*)(H1 + row * 2048 + col0 + bj * HALF) = w; }
                ss = sum_x32(sum_x16(ss));
                if (fq == 0) SS2[row * 32 + u.pn * 4 + wc] = ss;
            }
    }
};
struct Epi3 {
    static constexpr bool PERM = true, AFTER_DRAIN = false, MIDK = false, INIT = false;
    bf16_t* O;
    __device__ __forceinline__ void midk(f32x4 (&acc)[2][2][4][2], const Unit& u, int wr, int wc, int fr, int fq) const {}
    __device__ __forceinline__ void operator()(const f32x4 (&acc)[2][2][4][2], const Unit& u, int wr, int wc, int fr, int fq) const {
        const int col0 = u.pn * BM + wc * 32 + 8 * fq;
#pragma unroll
        for (int ai = 0; ai < 2; ++ai)
#pragma unroll
            for (int m = 0; m < 4; ++m) { const size_t row = (size_t)u.pm * BM + ai * HALF + wr * 64 + m * 16 + fr;
#pragma unroll
                for (int bj = 0; bj < 2; ++bj) { const f32x4 v0 = acc[ai][bj][m][0], v1 = acc[ai][bj][m][1];
                    u32x4 w; w.x = cvt_pk_bf16(v0[0], v0[1]); w.y = cvt_pk_bf16(v0[2], v0[3]); w.z = cvt_pk_bf16(v1[0], v1[1]); w.w = cvt_pk_bf16(v1[2], v1[3]);
                    *(u32x4*)(O + row * 2048 + col0 + bj * HALF) = w; } }
    }
};
template <class Epi, class Sched, bool ALIGN_EPI = false, bool SP2 = false>
__device__ __forceinline__ void gemm_phase(PG8_LAS unsigned char* lds, const Gemm g, const Sched& S, const Epi& E) {
    const int tid = threadIdx.x, wid = __builtin_amdgcn_readfirstlane(tid >> 6), lane = tid & 63, wr = wid >> 2, wc = wid & 3, fr = lane & 15, fq = lane >> 4;
    const int K = g.K, nt = K / BK;
    unsigned voffA[2], voffB[2];
#pragma unroll
    for (int i = 0; i < 2; ++i) { int R, C; stage_rc(tid * 16 + i * 8192, R, C); const int Rb = Epi::PERM ? ((R & ~31) + perm32(R & 31)) : R;
        voffA[i] = (unsigned)(R * K + C) * 2u; voffB[i] = (unsigned)(Rb * K + C) * 2u; }
    const size_t kstep = (size_t)(BK * 2);
    const size_t hstep = (size_t)HALF * K * 2;
    const size_t tstep = 2 * hstep;
    const unsigned ldsw = (unsigned)wid * 1024u;
    const int aoff = lds_byte(wr * 64 + fr, fq * 8), boff = lds_byte(wc * 32 + fr, fq * 8);
#define PG8_SA(b, h) (((b) * 2 + (h)) * HTB)
#define PG8_SB(b, h) ((4 + (b) * 2 + (h)) * HTB)
#define PG8_STAGE(bufoff, gbase, voff) do { _Pragma("unroll") for (int _i = 0; _i < 2; ++_i) \
        __builtin_amdgcn_global_load_lds((const unsigned*)((const char*)(gbase) + (voff)[_i]), (PG8_LAS unsigned*)(lds + (bufoff) + ldsw + _i * 8192), 16, 0, 0); } while (0)
#define PG8_LDA(dst, b, h) do { _Pragma("unroll") for (int m = 0; m < 4; ++m) _Pragma("unroll") for (int k = 0; k < 2; ++k) dst[m][k] = *(const PG8_LAS bf16x8*)(lds + PG8_SA(b, h) + aoff + m * 2048 + k * 1024); } while (0)
#define PG8_LDB(dst, b, h) do { _Pragma("unroll") for (int n = 0; n < 2; ++n) _Pragma("unroll") for (int k = 0; k < 2; ++k) dst[n][k] = *(const PG8_LAS bf16x8*)(lds + PG8_SB(b, h) + boff + n * 2048 + k * 1024); } while (0)
#define PG8_MMA(ai, bj, At, Bt) do { __builtin_amdgcn_s_setprio(1); _Pragma("unroll") for (int m = 0; m < 4; ++m) _Pragma("unroll") for (int n = 0; n < 2; ++n) _Pragma("unroll") for (int k = 0; k < 2; ++k) \
        acc[ai][bj][m][n] = __builtin_amdgcn_mfma_f32_16x16x32_bf16(Bt[n][k], At[m][k], acc[ai][bj][m][n], 0, 0, 0); __builtin_amdgcn_s_setprio(0); } while (0)
#define PG8_WAIT_V(n) asm volatile("s_waitcnt vmcnt(" #n ")" ::: "memory")
#define PG8_WAIT_L(n) asm volatile("s_waitcnt lgkmcnt(" #n ")" ::: "memory")
#define PG8_BAR __builtin_amdgcn_s_barrier()
#define PG8_SCHED __builtin_amdgcn_sched_barrier(0)
    Unit cur, nxt; int ui = 0;
    if (!S.next(0, cur)) return;
    f32x4 acc[2][2][4][2];
    if constexpr (Epi::INIT) E.init(acc, cur, wr, wc, fr, fq);
    else {
#pragma unroll
    for (int a = 0; a < 2; ++a)
#pragma unroll
        for (int b = 0; b < 2; ++b)
#pragma unroll
            for (int m = 0; m < 4; ++m)
#pragma unroll
                for (int n = 0; n < 2; ++n) acc[a][b][m][n] = (f32x4){0.f, 0.f, 0.f, 0.f};
    }
    bf16x8 At[4][2], B0[2][2], B1[2][2];
    const char* cA = (const char*)g.A + (size_t)cur.pm * tstep; const char* cB = (const char*)g.Bt + (size_t)cur.pn * tstep;
    S.a_ready(cur);
    if constexpr (SP2) {
        PG8_STAGE(PG8_SB(0, 0), cB, voffB); PG8_STAGE(PG8_SB(0, 1), cB + hstep, voffB); PG8_STAGE(PG8_SA(0, 0), cA, voffA); PG8_STAGE(PG8_SA(0, 1), cA + hstep, voffA);
        if (wr == 1) PG8_BAR;
        PG8_WAIT_V(2); PG8_BAR;
        PG8_STAGE(PG8_SB(1, 0), cB + kstep, voffB); PG8_STAGE(PG8_SA(1, 0), cA + kstep, voffA); PG8_STAGE(PG8_SB(1, 1), cB + hstep + kstep, voffB);
        PG8_WAIT_V(6); PG8_BAR;
    } else {
        PG8_STAGE(PG8_SB(0, 0), cB, voffB); PG8_STAGE(PG8_SA(0, 0), cA, voffA); PG8_STAGE(PG8_SB(0, 1), cB + hstep, voffB); PG8_STAGE(PG8_SA(0, 1), cA + hstep, voffA);
        if (wr == 1) PG8_BAR;
        PG8_WAIT_V(4); PG8_BAR;
        PG8_STAGE(PG8_SB(1, 0), cB + kstep, voffB); PG8_STAGE(PG8_SA(1, 0), cA + kstep, voffA); PG8_STAGE(PG8_SB(1, 1), cB + hstep + kstep, voffB);
        PG8_WAIT_V(6); PG8_BAR;
    }
    for (;;) {
        const bool has_next = S.next(ui + 1, nxt);
        const char* nA = has_next ? (const char*)g.A + (size_t)nxt.pm * tstep : cA; const char* nB = has_next ? (const char*)g.Bt + (size_t)nxt.pn * tstep : cB;
        for (int t = 0; t < nt; t += 2) {
            if constexpr (Epi::MIDK) { if (t == nt / 2) E.midk(acc, cur, wr, wc, fr, fq); }
            const bool last = (t == nt - 2);
            const char* a1 = cA + (size_t)(t + 1) * kstep;
            const char* a2 = last ? nA : cA + (size_t)(t + 2) * kstep; const char* b2 = last ? nB : cB + (size_t)(t + 2) * kstep;
            const char* a3 = a2 + kstep; const char* b3 = b2 + kstep;
            if (last && has_next) S.a_ready(nxt);
            if constexpr (SP2) {
            PG8_LDB(B0, 0, 0); PG8_LDB(B1, 0, 1); PG8_SCHED; PG8_LDA(At, 0, 0); PG8_STAGE(PG8_SA(1, 1), a1 + hstep, voffA);
            PG8_WAIT_V(8); PG8_WAIT_L(0); PG8_BAR; PG8_MMA(0, 0, At, B0); PG8_MMA(0, 1, At, B1); PG8_BAR; PG8_SCHED;
            PG8_LDA(At, 0, 1); PG8_STAGE(PG8_SB(0, 0), b2, voffB); PG8_STAGE(PG8_SB(0, 1), b2 + hstep, voffB); PG8_STAGE(PG8_SA(0, 0), a2, voffA);
            PG8_WAIT_V(8); PG8_WAIT_L(0); PG8_BAR; PG8_MMA(1, 0, At, B0); PG8_MMA(1, 1, At, B1); PG8_BAR; PG8_SCHED;
            PG8_LDB(B0, 1, 0); PG8_LDB(B1, 1, 1); PG8_SCHED; PG8_LDA(At, 1, 0); PG8_STAGE(PG8_SA(0, 1), a2 + hstep, voffA);
            PG8_WAIT_V(8); PG8_WAIT_L(0); PG8_BAR; PG8_MMA(0, 0, At, B0); PG8_MMA(0, 1, At, B1); PG8_BAR; PG8_SCHED;
            PG8_LDA(At, 1, 1); PG8_STAGE(PG8_SB(1, 0), b3, voffB); PG8_STAGE(PG8_SB(1, 1), b3 + hstep, voffB); PG8_STAGE(PG8_SA(1, 0), a3, voffA);
            PG8_WAIT_V(8); PG8_WAIT_L(0); PG8_BAR; PG8_MMA(1, 0, At, B0); PG8_MMA(1, 1, At, B1); PG8_BAR; PG8_SCHED;
            } else {
            PG8_LDB(B0, 0, 0); PG8_SCHED; PG8_LDA(At, 0, 0); PG8_STAGE(PG8_SA(1, 1), a1 + hstep, voffA);
            PG8_WAIT_L(8); PG8_BAR; PG8_WAIT_L(0); PG8_MMA(0, 0, At, B0); PG8_BAR; PG8_SCHED;
            PG8_LDB(B1, 0, 1); PG8_STAGE(PG8_SB(0, 0), b2, voffB);
            PG8_BAR; PG8_WAIT_L(0); PG8_MMA(0, 1, At, B1); PG8_BAR;
            PG8_LDA(At, 0, 1); PG8_STAGE(PG8_SA(0, 0), a2, voffA);
            PG8_BAR; PG8_WAIT_L(0); PG8_MMA(1, 0, At, B0); PG8_BAR; PG8_SCHED;
            PG8_STAGE(PG8_SB(0, 1), b2 + hstep, voffB);
            PG8_WAIT_V(6); PG8_BAR; PG8_MMA(1, 1, At, B1); PG8_BAR;
            PG8_LDB(B0, 1, 0); PG8_SCHED; PG8_LDA(At, 1, 0); PG8_STAGE(PG8_SA(0, 1), a2 + hstep, voffA);
            PG8_WAIT_L(8); PG8_BAR; PG8_WAIT_L(0); PG8_MMA(0, 0, At, B0); PG8_BAR; PG8_SCHED;
            PG8_LDB(B1, 1, 1); PG8_STAGE(PG8_SB(1, 0), b3, voffB);
            PG8_BAR; PG8_WAIT_L(0); PG8_MMA(0, 1, At, B1); PG8_BAR;
            PG8_LDA(At, 1, 1); PG8_STAGE(PG8_SA(1, 0), a3, voffA);
            PG8_BAR; PG8_WAIT_L(0); PG8_MMA(1, 0, At, B0); PG8_BAR; PG8_SCHED;
            PG8_STAGE(PG8_SB(1, 1), b3 + hstep, voffB);
            PG8_WAIT_V(6); PG8_BAR; PG8_MMA(1, 1, At, B1); PG8_BAR;
            }
        }
        if constexpr (ALIGN_EPI) { if (wr == 0) PG8_BAR; }
        if constexpr (!Epi::AFTER_DRAIN) { E(acc, cur, wr, wc, fr, fq); S.done(cur); }
        if (!has_next) break;
        if constexpr (Epi::INIT) E.init(acc, nxt, wr, wc, fr, fq);
        else {
#pragma unroll
        for (int a = 0; a < 2; ++a)
#pragma unroll
            for (int b = 0; b < 2; ++b)
#pragma unroll
                for (int m = 0; m < 4; ++m)
#pragma unroll
                    for (int n = 0; n < 2; ++n) acc[a][b][m][n] = (f32x4){0.f, 0.f, 0.f, 0.f};
        }
        cur = nxt; cA = nA; cB = nB; ++ui;
        if constexpr (ALIGN_EPI) { if (wr == 1) PG8_BAR; }
    }
    PG8_WAIT_V(0);
    if constexpr (!ALIGN_EPI) { if (wr == 0) PG8_BAR; }
    PG8_BAR;
    if constexpr (Epi::AFTER_DRAIN) { E.fused(acc, cur, wr, wc, fr, fq, lds, wid, lane); S.done(cur); }
#undef PG8_SA
#undef PG8_SB
#undef PG8_STAGE
#undef PG8_LDA
#undef PG8_LDB
#undef PG8_MMA
#undef PG8_WAIT_V
#undef PG8_WAIT_L
#undef PG8_BAR
#undef PG8_SCHED
}
}
#define XB_TMO      128
#define XB_XCNT(j)  (256  + 64 * (j))
#define XB_XSUB(j)  (1280 + 64 * (j))
#define XB_XGEN(j)  (2304 + 64 * (j))
#define XB_TOP      3328
#define XB_TOPGEN   3392
#define XCD_BAR_WORDS 3456
#define XB_SPIN_CAP (1u << 18)

__device__ __forceinline__ unsigned xb_ld(unsigned* p)              { return __hip_atomic_load(p, __ATOMIC_RELAXED, __HIP_MEMORY_SCOPE_AGENT); }
__device__ __forceinline__ unsigned xb_add(unsigned* p, unsigned v) { return __hip_atomic_fetch_add(p, v, __ATOMIC_RELAXED, __HIP_MEMORY_SCOPE_AGENT); }
__device__ __forceinline__ unsigned xb_xcc_id() { return (unsigned)__builtin_amdgcn_s_getreg((3 << 11) | 20) & 0xFu; }
#define XB_SPIN(cond, bar) do { unsigned _sp = 0; while (cond) { __builtin_amdgcn_s_sleep(1); \
    if ((++_sp & 255u) == 0u) { if (xb_ld(&(bar)[XB_TMO])) break; if (_sp > XB_SPIN_CAP) { atomicAdd(&(bar)[XB_TMO], 1u); break; } } } } while (0)

struct XcdBarrier {
    unsigned* bar; unsigned x;
    volatile LAS unsigned* st;
};

__device__ __forceinline__ XcdBarrier xcd_barrier_post(unsigned* bar, volatile LAS unsigned* st) {
    XcdBarrier b; b.bar = bar; b.x = xb_xcc_id(); b.st = st;
    if (threadIdx.x == 0) (void)xb_add(&bar[XB_XCNT(b.x)], 1u);
    return b;
}
__device__ __forceinline__ void xcd_barrier_complete(unsigned* bar, unsigned x, unsigned& nloc, unsigned& nx) {
    const unsigned G = gridDim.x * gridDim.y * gridDim.z;
    unsigned sum, cnt, mine, sp = 0u;
    for (;;) {
        sum = 0u; cnt = 0u; mine = 0u;
#pragma unroll
        for (unsigned j = 0; j < 16; ++j) { const unsigned c = xb_ld(&bar[XB_XCNT(j)]); sum += c; cnt += (c > 0u) ? 1u : 0u; mine = (j == x) ? c : mine; }
        if (sum == G) break;
        __builtin_amdgcn_s_sleep(1);
        if ((++sp & 255u) == 0u) { if (xb_ld(&bar[XB_TMO])) break; if (sp > XB_SPIN_CAP) { atomicAdd(&bar[XB_TMO], 1u); break; } }
    }
    nloc = mine > 0u ? mine : 1u; nx = cnt > 0u ? cnt : 1u;
}

__device__ __forceinline__ void xcd_barrier(const XcdBarrier& b) {
    asm volatile("s_waitcnt vmcnt(0)" ::: "memory");
    __syncthreads();
    if (threadIdx.x == 0) {
        unsigned* bar = b.bar;
        __builtin_amdgcn_s_waitcnt(0);
        unsigned nloc = b.st[0], nx = b.st[1];
        if (nloc == 0u) { xcd_barrier_complete(bar, b.x, nloc, nx); b.st[0] = nloc; b.st[1] = nx; }
        const unsigned old = xb_add(&bar[XB_XSUB(b.x)], 1u);
        const unsigned gen = old / nloc;
        if (old + 1u == (gen + 1u) * nloc) {
            __builtin_amdgcn_fence(__ATOMIC_RELEASE, "agent");
            asm volatile("s_waitcnt vmcnt(0)" ::: "memory");
            const unsigned og = xb_add(&bar[XB_TOP], 1u);
            const unsigned tg = og / nx;
            if (og + 1u == (tg + 1u) * nx) xb_add(&bar[XB_TOPGEN], 1u);
            else XB_SPIN(xb_ld(&bar[XB_TOPGEN]) == tg, bar);
            __builtin_amdgcn_fence(__ATOMIC_ACQUIRE, "agent");
            xb_add(&bar[XB_XGEN(b.x)], 1u);
            asm volatile("s_waitcnt vmcnt(0)" ::: "memory");
        } else {
            XB_SPIN(xb_ld(&bar[XB_XGEN(b.x)]) == gen, bar);
            __builtin_amdgcn_fence(__ATOMIC_ACQUIRE, "agent");
            asm volatile("s_waitcnt vmcnt(0)" ::: "memory");
        }
    }
    __syncthreads();
}

constexpr int NWAVES = 8;
constexpr size_t MiB = 1u << 20;
constexpr size_t WS_CTL = 0, CTL_ZERO_BYTES = 1 * MiB;
constexpr size_t WS_W1T = 2 * MiB;
constexpr size_t WS_W2T = 16 * MiB;
constexpr size_t WS_W3T = 24 * MiB;
constexpr size_t WS_SKB = 32 * MiB;
constexpr size_t WS_RSTD1 = 33 * MiB;
constexpr size_t WS_SSA = 34 * MiB;
constexpr size_t WS_SSL = 35 * MiB;
constexpr size_t WS_SS2 = 37 * MiB;
constexpr size_t WS_RSTD2 = 39 * MiB;
constexpr size_t WS_IDS = 40 * MiB;
constexpr size_t WS_GW = 48 * MiB;
constexpr size_t WS_U8 = 64 * MiB;
constexpr size_t WS_V8 = 96 * MiB;
constexpr size_t WS_X8 = 128 * MiB;
constexpr size_t WS_SX = 160 * MiB;
constexpr size_t WS_SCU = 162 * MiB;
constexpr size_t WS_SCV = 163 * MiB;
constexpr size_t WS_WSUM = 164 * MiB;
constexpr size_t WS_A1 = 192 * MiB;
constexpr size_t WS_Q = 258 * MiB;
constexpr size_t WS_KV = 290 * MiB;
constexpr size_t WS_XB = 299 * MiB;
constexpr size_t WS_GT = 332 * MiB;
constexpr size_t WS_H1 = 364 * MiB;
constexpr size_t WS_PART = 192 * MiB;
constexpr size_t WS_W = 56 * MiB;
constexpr size_t WS_Z = 428 * MiB;
constexpr size_t WS_END = 492 * MiB;
constexpr int CW_QROW = 2048;
constexpr int CW_BAR = 4096;

constexpr int RING_OFF = 0, RING_BYTES = 131072;
constexpr int LDSCTL_OFF = RING_BYTES, MISC_OFF = LDSCTL_OFF + 320;
constexpr int LDS_BYTES = 147456;

typedef unsigned short bf16;
typedef unsigned v4u __attribute__((ext_vector_type(4)));
typedef float f32x4 __attribute__((ext_vector_type(4)));
typedef short bf16x8 __attribute__((ext_vector_type(8)));
typedef GAS unsigned gu32;
#define RLX_AGENT __ATOMIC_RELAXED, __HIP_MEMORY_SCOPE_AGENT
#define LDS_WAIT() asm volatile("s_waitcnt lgkmcnt(0)" ::: "memory")
#define VM_WAIT() asm volatile("s_waitcnt vmcnt(0)" ::: "memory")
__device__ __forceinline__ unsigned f2bf(float f) { unsigned u = __builtin_bit_cast(unsigned, f); return (u + 0x7fffu + ((u >> 16) & 1u)) >> 16; }
__device__ __forceinline__ unsigned pk2(float lo, float hi) { return f2bf(lo) | (f2bf(hi) << 16); }
__device__ __forceinline__ float bf2f(unsigned short b) { return __builtin_bit_cast(float, (unsigned)b << 16); }


namespace p2 {
typedef float f32x16 __attribute__((ext_vector_type(16)));
typedef unsigned u32x2 __attribute__((ext_vector_type(2)));
constexpr float LOG2E = 1.4426950408889634f;
constexpr float NEGBIG = -1e30f;
__device__ __forceinline__ int crow(int r, int hi) { return (r & 3) + 8 * (r >> 2) + 4 * hi; }
__device__ __forceinline__ unsigned cvtpk(float lo, float hi) { unsigned r; asm volatile("v_cvt_pk_bf16_f32 %0, %1, %2" : "=v"(r) : "v"(lo), "v"(hi)); return r; }
__device__ __forceinline__ float ex2(float x) { return __builtin_amdgcn_exp2f(x); }
__device__ __forceinline__ float rcp(float x) { return __builtin_amdgcn_rcpf(x); }
__device__ __forceinline__ float gelu_fast(float x) { return x * rcp(1.0f + ex2(x * (-2.302208198f - 0.102943240f * (x * x)))); }

constexpr int A_KS = 0, A_KSP = 144, A_VT = 288 * 144, A_VTP = 584, A_ST = A_VT + 64 * 584, A_END = A_ST + 8 * 4096;
__device__ __forceinline__ void attn_unit(LAS unsigned char* lds, int b, int qblk, int kvh, const bf16* QB, const bf16* KVB, const float* sinks, bf16* MIX, float* SSA, int tid) {
    const int lane = tid & 63, wave = __builtin_amdgcn_readfirstlane(tid >> 6), r = lane & 31, hi = lane >> 5;
    const int q0 = qblk * 128, hq = kvh * 8 + wave;
    for (int it = 0; it < 5; ++it) {
        const int cid = it * 512 + tid;
        if (cid < 288 * 8) {
            const int key = cid >> 3, ch = cid & 7;
            bool valid; size_t row = 0;
            if (key < 256) { const int pos = q0 - 128 + key; valid = pos >= 0; row = (size_t)b * SEQ + pos; }
            else if (key < 272) { valid = true; row = (size_t)MREAL + (key - 256); }
            else valid = false;
            v4u kv = {0u, 0u, 0u, 0u}, vv = {0u, 0u, 0u, 0u};
            if (valid) { kv = *(const GAS v4u*)(KVB + row * 256 + kvh * 64 + ch * 8); vv = *(const GAS v4u*)(KVB + row * 256 + 128 + kvh * 64 + ch * 8); }
            *(LAS v4u*)(lds + A_KS + key * A_KSP + ch * 16) = kv;
            LAS unsigned short* vt = (LAS unsigned short*)(lds + A_VT);
#pragma unroll
            for (int j = 0; j < 8; ++j) { const unsigned wv = vv[j >> 1]; vt[(ch * 8 + j) * (A_VTP / 2) + key] = (unsigned short)((j & 1) ? (wv >> 16) : (wv & 0xffffu)); }
        }
    }
    __syncthreads();
    const float sink2 = sinks[hq] * LOG2E;
    bf16x8 qf[4];
#pragma unroll
    for (int ks = 0; ks < 4; ++ks) qf[ks] = *(const GAS bf16x8*)(QB + ((size_t)b * SEQ + q0 + r) * 1024 + hq * 64 + ks * 16 + hi * 8);
    for (int qg = 0; qg < 4; ++qg) {
        f32x16 s[6];
#pragma unroll
        for (int t = 0; t < 6; ++t) {
            const int kbase = t < 5 ? 32 * (qg + t) : 256;
            f32x16 acc = {0.f, 0.f, 0.f, 0.f, 0.f, 0.f, 0.f, 0.f, 0.f, 0.f, 0.f, 0.f, 0.f, 0.f, 0.f, 0.f};
#pragma unroll
            for (int ks = 0; ks < 4; ++ks) {
                const bf16x8 kf = *(const LAS bf16x8*)(lds + A_KS + (kbase + r) * A_KSP + ks * 32 + hi * 16);
                acc = __builtin_amdgcn_mfma_f32_32x32x16_bf16(kf, qf[ks], acc, 0, 0, 0);
            }
            s[t] = acc;
        }
        if (qg + 1 < 4) {
#pragma unroll
            for (int ks = 0; ks < 4; ++ks) qf[ks] = *(const GAS bf16x8*)(QB + ((size_t)b * SEQ + q0 + 32 * (qg + 1) + r) * 1024 + hq * 64 + ks * 16 + hi * 8);
        }
        const bool blk0 = (qblk == 0);
#pragma unroll
        for (int reg = 0; reg < 16; ++reg) {
            const int j = crow(reg, hi);
            s[0][reg] = (j > r) ? s[0][reg] : NEGBIG;
            s[4][reg] = (j <= r) ? s[4][reg] : NEGBIG;
            s[5][reg] = (j < 16) ? s[5][reg] : NEGBIG;
        }
#pragma unroll
        for (int t = 0; t < 4; ++t) if (blk0 && (qg + t < 4)) {
#pragma unroll
            for (int reg = 0; reg < 16; ++reg) s[t][reg] = NEGBIG;
        }
        float m = sink2;
#pragma unroll
        for (int t = 0; t < 6; ++t)
#pragma unroll
            for (int reg = 0; reg < 16; ++reg) m = fmaxf(m, s[t][reg]);
        m = max_x32(m);
        float l = 0.f;
#pragma unroll
        for (int t = 0; t < 6; ++t)
#pragma unroll
            for (int reg = 0; reg < 16; ++reg) { const float p = ex2(s[t][reg] - m); s[t][reg] = p; l += p; }
        l = sum_x32(l);
        l += ex2(sink2 - m);
        const float linv = 1.0f / l;
        f32x16 o0 = {0.f, 0.f, 0.f, 0.f, 0.f, 0.f, 0.f, 0.f, 0.f, 0.f, 0.f, 0.f, 0.f, 0.f, 0.f, 0.f}, o1 = o0;
#pragma unroll
        for (int t = 0; t < 6; ++t) {
            const int kbase = t < 5 ? 32 * (qg + t) : 256;
#pragma unroll
            for (int ss = 0; ss < 2; ++ss) {
                v4u pw; pw.x = cvtpk(s[t][8 * ss + 0], s[t][8 * ss + 1]); pw.y = cvtpk(s[t][8 * ss + 2], s[t][8 * ss + 3]);
                pw.z = cvtpk(s[t][8 * ss + 4], s[t][8 * ss + 5]); pw.w = cvtpk(s[t][8 * ss + 6], s[t][8 * ss + 7]);
                const bf16x8 pa = __builtin_bit_cast(bf16x8, pw);
                const int ko = (kbase + 16 * ss + 4 * hi) * 2;
                {   const u32x2 lo = *(const LAS u32x2*)(lds + A_VT + r * A_VTP + ko), h2 = *(const LAS u32x2*)(lds + A_VT + r * A_VTP + ko + 16);
                    v4u vw; vw.x = lo.x; vw.y = lo.y; vw.z = h2.x; vw.w = h2.y;
                    o0 = __builtin_amdgcn_mfma_f32_32x32x16_bf16(pa, __builtin_bit_cast(bf16x8, vw), o0, 0, 0, 0); }
                {   const u32x2 lo = *(const LAS u32x2*)(lds + A_VT + (32 + r) * A_VTP + ko), h2 = *(const LAS u32x2*)(lds + A_VT + (32 + r) * A_VTP + ko + 16);
                    v4u vw; vw.x = lo.x; vw.y = lo.y; vw.z = h2.x; vw.w = h2.y;
                    o1 = __builtin_amdgcn_mfma_f32_32x32x16_bf16(pa, __builtin_bit_cast(bf16x8, vw), o1, 0, 0, 0); }
            }
        }
        LAS unsigned short* stg = (LAS unsigned short*)(lds + A_ST + wave * 4096);
#pragma unroll
        for (int reg = 0; reg < 16; ++reg) {
            const int qr = crow(reg, hi); const float li = __shfl(linv, qr);
            stg[qr * 64 + r] = (unsigned short)f2bf(o0[reg] * li);
            stg[qr * 64 + 32 + r] = (unsigned short)f2bf(o1[reg] * li);
        }
        asm volatile("s_waitcnt lgkmcnt(0)" ::: "memory");
#pragma unroll
        for (int i = 0; i < 4; ++i) {
            const int row = i * 8 + (lane >> 3), ch = lane & 7;
            const v4u v = *(const LAS v4u*)(stg + row * 64 + ch * 8);
            float ss = 0.f;
#pragma unroll
            for (int k = 0; k < 4; ++k) { const float a = __builtin_bit_cast(float, v[k] << 16), c = __builtin_bit_cast(float, v[k] & 0xffff0000u); ss += a * a + c * c; }
            ss = sum8(ss);
            const size_t orow = (size_t)b * SEQ + q0 + 32 * qg + row;
            *(GAS v4u*)(MIX + orow * D + hq * 64 + ch * 8) = v;
            if (ch == 0) SSA[orow * 16 + hq] = ss;
        }
        asm volatile("s_waitcnt lgkmcnt(0)" ::: "memory");
    }
    __syncthreads();
}

constexpr int LW_XS = 0, LW_GS = 4608, LW_XC = LW_GS + 2048, LW_XCF = LW_XC + 4608, LW_BYTES = LW_XCF + 4096 + 128;
constexpr int L_CT = 8 * LW_BYTES, L_END = L_CT + 2 * 2048;
static_assert(L_END <= 131072, "lru lds");
struct LruP { const float *conv_w, *conv_b, *w_r, *b_r, *w_i, *b_i, *lam; };
__device__ __forceinline__ void lru_unit(LAS unsigned char* lds, LAS unsigned char* ldsw  , int b, int nb, int cg, const bf16* XBB, const bf16* GTB, const LruP P, bf16* MIX, float* SSL, int tid) {
    const int lane = tid & 63, wave = __builtin_amdgcn_readfirstlane(tid >> 6), r = lane & 31, hi = lane >> 5;
    LAS unsigned char* lw = lds + wave * LW_BYTES;
    {
        LAS unsigned short* wt = (LAS unsigned short*)ldsw;
#pragma unroll
        for (int i = 0; i < 4; ++i) {
            const int e = tid + 512 * i, c = e >> 5, dl = e & 31;
            const size_t gi = (size_t)(nb * 64 + c) * 64 + 32 * cg + dl;
            wt[dl * 72 + c] = (unsigned short)f2bf(-LOG2E * P.w_r[gi]);
            wt[32 * 72 + dl * 72 + c] = (unsigned short)f2bf(-LOG2E * P.w_i[gi]);
        }
    }
    const int cc = lane, chc = nb * 64 + cc;
    const float cw0 = P.conv_w[0 * LW + chc], cw1 = P.conv_w[1 * LW + chc], cw2 = P.conv_w[2 * LW + chc], cw3 = P.conv_w[3 * LW + chc], cbv = P.conv_b[chc];
    const int chd = nb * 64 + 32 * cg + r;
    const float br = -LOG2E * P.b_r[chd], bi = -LOG2E * P.b_i[chd];
    const float ls8 = -8.0f * log1pf(expf(-P.lam[chd])) * LOG2E;
    float state = 0.f;
    v4u px[5], pg[2];
#define LRU_PREFETCH(tl) do { \
        _Pragma("unroll") for (int it = 0; it < 5; ++it) { const int cid = it * 64 + lane; px[it] = (v4u){0u, 0u, 0u, 0u}; \
            if (cid < 35 * 8) { const int j = cid >> 3, ch = cid & 7, t = 32 * wave + j - 3; bool valid; size_t row = 0; \
                if ((tl) == 0) { valid = (t >= 0 && t < NMETA); row = (size_t)MREAL + t; } \
                else if ((tl) == 1 && t < 0) { valid = true; row = (size_t)MREAL + NMETA + t; } \
                else { valid = true; row = (size_t)b * SEQ + 256 * ((tl) - 1) + t; } \
                if (valid) px[it] = *(const GAS v4u*)(XBB + row * 1024 + nb * 64 + ch * 8); } } \
        if ((tl) > 0) { _Pragma("unroll") for (int it = 0; it < 2; ++it) { const int cid = it * 64 + lane, t = 32 * wave + (cid >> 2), ch = cid & 3; \
            pg[it] = *(const GAS v4u*)(GTB + ((size_t)b * SEQ + 256 * ((tl) - 1) + t) * 1024 + nb * 64 + 32 * cg + ch * 8); } } } while (0)
    LRU_PREFETCH(0);
    __syncthreads();
    for (int tile = 0; tile < 9; ++tile) {
#pragma unroll
        for (int it = 0; it < 5; ++it) { const int cid = it * 64 + lane; if (cid < 35 * 8) *(LAS v4u*)(lw + LW_XS + (cid >> 3) * 128 + (cid & 7) * 16) = px[it]; }
        if (tile > 0) {
#pragma unroll
            for (int it = 0; it < 2; ++it) { const int cid = it * 64 + lane; *(LAS v4u*)(lw + LW_GS + (cid >> 2) * 64 + (cid & 3) * 16) = pg[it]; }
        }
        asm volatile("s_waitcnt lgkmcnt(0)" ::: "memory");
        if (tile + 1 < 9) LRU_PREFETCH(tile + 1);
        {
            const LAS unsigned short* xs = (const LAS unsigned short*)(lw + LW_XS);
            LAS unsigned short* xc = (LAS unsigned short*)(lw + LW_XC);
            LAS float* xcf = (LAS float*)(lw + LW_XCF);
            const bool own = (cc >> 5) == cg; const int xoff = own ? (cc & 31) : 32 * 32 + (cc & 31);
            float x0 = bf2f(xs[0 * 64 + cc]), x1 = bf2f(xs[1 * 64 + cc]), x2 = bf2f(xs[2 * 64 + cc]);
#pragma unroll 8
            for (int k = 0; k < 32; ++k) {
                const float x3 = bf2f(xs[(k + 3) * 64 + cc]);
                const float v = cbv + cw0 * x0 + cw1 * x1 + cw2 * x2 + cw3 * x3;
                xc[k * 72 + cc] = (unsigned short)cvtpk(v, v);
                xcf[(own ? k * 32 : 0) + xoff] = v;
                x0 = x1; x1 = x2; x2 = x3;
            }
        }
        asm volatile("s_waitcnt lgkmcnt(0)" ::: "memory");
        f32x16 aR = {br, br, br, br, br, br, br, br, br, br, br, br, br, br, br, br}, aI = {bi, bi, bi, bi, bi, bi, bi, bi, bi, bi, bi, bi, bi, bi, bi, bi};
#pragma unroll
        for (int ks = 0; ks < 4; ++ks) {
            const bf16x8 xa = *(const LAS bf16x8*)(lw + LW_XC + r * 144 + ks * 32 + hi * 16);
            const bf16x8 wr_ = *(const LAS bf16x8*)(ldsw + r * 144 + ks * 32 + hi * 16);
            const bf16x8 wi_ = *(const LAS bf16x8*)(ldsw + 32 * 144 + r * 144 + ks * 32 + hi * 16);
            aR = __builtin_amdgcn_mfma_f32_32x32x16_bf16(xa, wr_, aR, 0, 0, 0);
            aI = __builtin_amdgcn_mfma_f32_32x32x16_bf16(xa, wi_, aI, 0, 0, 0);
        }
        float Av[16], Bv[16];
        {
            const LAS float* xcf = (const LAS float*)(lw + LW_XCF);
#pragma unroll
            for (int reg = 0; reg < 16; ++reg) {
                const int tl = crow(reg, hi), t = 32 * wave + tl;
                const bool valid = (tile > 0) || (t < NMETA);
                const float rg = rcp(1.0f + ex2(aR[reg]));
                const float ig = rcp(1.0f + ex2(aI[reg]));
                const float a = ex2(rg * ls8);
                const float mult = __builtin_amdgcn_sqrtf(fmaxf(1.0f - a * a, 0.f));
                const float bx = mult * ig * xcf[tl * 32 + r];
                Av[reg] = valid ? a : 1.0f; Bv[reg] = valid ? bx : 0.0f;
            }
        }
#pragma unroll
        for (int g = 0; g < 4; ++g) {
#pragma unroll
            for (int k = 1; k < 4; ++k) { Bv[4 * g + k] = Av[4 * g + k] * Bv[4 * g + k - 1] + Bv[4 * g + k]; Av[4 * g + k] = Av[4 * g + k] * Av[4 * g + k - 1]; }
        }
        float myCz[4], myCp[4], PW, HW;
        {
            float cz = 0.f, cp = 1.f;
#pragma unroll
            for (int g = 0; g < 4; ++g) {
                const float mP = Av[4 * g + 3], mH = Bv[4 * g + 3];
                const float oP = __shfl_xor(mP, 32), oH = __shfl_xor(mH, 32);
                const float eP = hi ? oP : mP, eH = hi ? oH : mH, dP = hi ? mP : oP, dH = hi ? mH : oH;
                const float cz0 = cz, cp0 = cp;
                cz = eP * cz + eH; cp = cp * eP;
                myCz[g] = hi ? cz : cz0; myCp[g] = hi ? cp : cp0;
                cz = dP * cz + dH; cp = cp * dP;
            }
            PW = cp; HW = cz;
        }
        LAS float* ct = (LAS float*)(lds + L_CT + (tile & 1) * 2048);
        if (hi == 0) { ct[(wave * 32 + r) * 2] = PW; ct[(wave * 32 + r) * 2 + 1] = HW; }
        __syncthreads();
        float cin = 0.f;
        {
            float c = state;
#pragma unroll
            for (int w2 = 0; w2 < 8; ++w2) { if (w2 == wave) cin = c; c = ct[(w2 * 32 + r) * 2] * c + ct[(w2 * 32 + r) * 2 + 1]; }
            state = c;
        }
        if (tile > 0) {
            const LAS unsigned short* gs = (const LAS unsigned short*)(lw + LW_GS);
            LAS unsigned short* os = (LAS unsigned short*)(lw + LW_XS);
#pragma unroll
            for (int reg = 0; reg < 16; ++reg) {
                const int g = reg >> 2, tl = crow(reg, hi);
                const float h = Bv[reg] + Av[reg] * (myCz[g] + myCp[g] * cin);
                const float gt = bf2f(gs[tl * 32 + r]);
                { const float ov = gelu_fast(gt) * h; os[tl * 32 + r] = (unsigned short)cvtpk(ov, ov); }
            }
            asm volatile("s_waitcnt lgkmcnt(0)" ::: "memory");
#pragma unroll
            for (int it = 0; it < 2; ++it) {
                const int cid = it * 64 + lane, tl = cid >> 2, ch = cid & 3;
                const v4u v = *(const LAS v4u*)(lw + LW_XS + tl * 64 + ch * 16);
                float ss = 0.f;
#pragma unroll
                for (int k = 0; k < 4; ++k) { const float a = __builtin_bit_cast(float, v[k] << 16), c = __builtin_bit_cast(float, v[k] & 0xffff0000u); ss += a * a + c * c; }
                ss = sum4(ss);
                const size_t row = (size_t)b * SEQ + 256 * (tile - 1) + 32 * wave + tl;
                *(GAS v4u*)(MIX + row * D + 1024 + nb * 64 + 32 * cg + ch * 8) = v;
                if (ch == 0) SSL[row * 32 + nb * 2 + cg] = ss;
            }
            asm volatile("s_waitcnt lgkmcnt(0)" ::: "memory");
        }
    }
#undef LRU_PREFETCH
    __syncthreads();
}
}

namespace p5 {
typedef float f32x16 __attribute__((ext_vector_type(16)));
constexpr int KP = 272;
constexpr int R_KEYS = 0, R_IDX = 256 * KP, R_END = R_IDX + 8 * 1024;
__device__ __forceinline__ int crow(int r, int hi) { return (r & 3) + 8 * (r >> 2) + 4 * hi; }
__device__ __forceinline__ float fkey(float s, int mask, int payload) { return __builtin_bit_cast(float, (__builtin_bit_cast(int, s) & mask) | payload); }
__device__ __forceinline__ int fbits(float f) { return __builtin_bit_cast(int, f); }
__device__ __forceinline__ float fval(float f, int mask) { return __builtin_bit_cast(float, __builtin_bit_cast(int, f) & mask); }
__device__ __forceinline__ void ins16(float (&L)[16], float v) {
#pragma unroll
    for (int k = 15; k >= 1; --k) L[k] = __builtin_amdgcn_fmed3f(L[k - 1], L[k], v);
    L[0] = fmaxf(L[0], v);
}
__device__ __forceinline__ void half_top16(const LAS unsigned char* keys, const bf16x8 (&qf)[8], int r, int hi, float (&T)[16]) {
    float L[16];
#pragma unroll
    for (int k = 0; k < 16; ++k) L[k] = -INFINITY;
    const int h4 = 4 * hi;
#pragma unroll
    for (int kt = 0; kt < 4; ++kt) {
        f32x16 acc = {0.f, 0.f, 0.f, 0.f, 0.f, 0.f, 0.f, 0.f, 0.f, 0.f, 0.f, 0.f, 0.f, 0.f, 0.f, 0.f};
#pragma unroll
        for (int ks = 0; ks < 8; ++ks) {
            const bf16x8 kf = *(const LAS bf16x8*)(keys + (kt * 32 + r) * KP + ks * 32 + hi * 16);
            acc = __builtin_amdgcn_mfma_f32_32x32x16_bf16(kf, qf[ks], acc, 0, 0, 0);
        }
#pragma unroll
        for (int reg = 0; reg < 16; ++reg) {
            const int C = 127 - 32 * kt - (reg & 3) - 8 * (reg >> 2);
            ins16(L, fkey(acc[reg], (int)0xffffff80, C - h4));
        }
    }
    float M[16];
#pragma unroll
    for (int i = 0; i < 16; ++i) M[i] = fmaxf(L[i], __shfl_xor(L[15 - i], 32));
#define P5_STAGE(st) _Pragma("unroll") for (int i = 0; i < 16; ++i) if ((i & (st)) == 0) { const float a = fmaxf(M[i], M[i + (st)]), b = fminf(M[i], M[i + (st)]); M[i] = a; M[i + (st)] = b; }
    P5_STAGE(8) P5_STAGE(4) P5_STAGE(2) P5_STAGE(1)
#undef P5_STAGE
#pragma unroll
    for (int i = 0; i < 16; ++i) T[i] = M[i];
}

__device__ __forceinline__ void retr_unit(LAS unsigned char* lds, int h, int tg, const bf16* QPB, const bf16* SKB, unsigned short* IDS, float* GW, const float* RSTD2, int tid) {
    const int lane = tid & 63, wave = __builtin_amdgcn_readfirstlane(tid >> 6), r = lane & 31, hi = lane >> 5;
#pragma unroll
    for (int it = 0; it < 8; ++it) {
        const int cid = it * 512 + tid, row = cid >> 4, ch = cid & 15;
        *(LAS v4u*)(lds + R_KEYS + row * KP + ch * 16) = *(const GAS v4u*)(SKB + ((size_t)h * 256 + row) * 128 + ch * 8);
    }
    const size_t tok = (size_t)tg * 256 + wave * 32 + r;
    bf16x8 qa[8], qb[8];
#pragma unroll
    for (int ks = 0; ks < 8; ++ks) { qa[ks] = *(const GAS bf16x8*)(QPB + tok * D + h * 256 + ks * 16 + hi * 8); qb[ks] = *(const GAS bf16x8*)(QPB + tok * D + h * 256 + 128 + ks * 16 + hi * 8); }
    const float rs = RSTD2[tok];
    __syncthreads();
    float TA[16], TB[16];
    half_top16(lds + R_KEYS, qa, r, hi, TA);
    half_top16(lds + R_KEYS + 128 * KP, qb, r, hi, TB);
    LAS unsigned char* sc = lds + R_IDX + wave * 1024 + r * 32;
    const int hm = -hi;
    {
        v4u w;
#pragma unroll
        for (int q = 0; q < 4; ++q) { unsigned x = 0;
#pragma unroll
            for (int k = 0; k < 4; ++k) { const int t = (fbits(TB[4 * q + k]) & hm) | (fbits(TA[4 * q + k]) & ~hm); x |= (unsigned)(127 - (t & 0x7f)) << (8 * k); }
            w[q] = x; }
        *(LAS v4u*)(sc + hi * 16) = w;
    }
    float sA[16], sB[16];
#pragma unroll
    for (int i = 0; i < 16; ++i) { sA[i] = fval(TA[i], (int)0xffffff80); sB[i] = fval(TB[i], (int)0xffffff80); }
    float L[16];
#pragma unroll
    for (int k = 0; k < 16; ++k) L[k] = -INFINITY;
#pragma unroll
    for (int i = 0; i < 16; ++i)
#pragma unroll
        for (int j = 0; j < 16; ++j) if ((i + 1) * (j + 1) <= 16) {
            ins16(L, fkey(sA[i] + sB[j], (int)0xffffff00, 255 - (i * 16 + j)));
        }
    const float v0 = fval(L[0], (int)0xffffff00);
    asm volatile("s_waitcnt lgkmcnt(0)" ::: "memory");
    int ex[8]; float ew[8]; float esum = 0.f;
#pragma unroll
    for (int k = 0; k < 8; ++k) {
        const int t = (fbits(L[8 + k]) & hm) | (fbits(L[k]) & ~hm);
        const int c = 255 - (t & 0xff);
        const int ia = sc[c >> 4], ib = sc[16 + (c & 15)];
        ex[k] = ia * 128 + ib;
        const float e = __builtin_amdgcn_exp2f((__builtin_bit_cast(float, t & (int)0xffffff00) - v0) * rs * 1.4426950408889634f);
        ew[k] = e; esum += e;
    }
    esum = sum_x32(esum);
    const float inv = 1.0f / esum;
    unsigned short* ip = IDS + tok * 128 + h * 16 + hi * 8; float* gp = GW + tok * 128 + h * 16 + hi * 8;
    *(GAS v4u*)(ip) = (v4u){(unsigned)ex[0] | ((unsigned)ex[1] << 16), (unsigned)ex[2] | ((unsigned)ex[3] << 16), (unsigned)ex[4] | ((unsigned)ex[5] << 16), (unsigned)ex[6] | ((unsigned)ex[7] << 16)};
    *(GAS f32x4*)(gp) = (f32x4){ew[0] * inv, ew[1] * inv, ew[2] * inv, ew[3] * inv};
    *(GAS f32x4*)(gp + 4) = (f32x4){ew[4] * inv, ew[5] * inv, ew[6] * inv, ew[7] * inv};
    __syncthreads();
}
}

namespace p6 {
__device__ __forceinline__ float blo(unsigned w) { return __builtin_bit_cast(float, w << 16); }
__device__ __forceinline__ float bhi(unsigned w) { return __builtin_bit_cast(float, w & 0xffff0000u); }
__device__ __forceinline__ float gelu_fast(float x) { return x * __builtin_amdgcn_rcpf(1.0f + __builtin_amdgcn_exp2f(-2.302208198f * x * (1.0f + 0.044715f * x * x))); }
__device__ __forceinline__ unsigned idw(const v4u& a, const v4u& b, int g) { const unsigned w = g < 8 ? a[(g & 7) >> 1] : b[(g & 7) >> 1]; return (g & 1) ? (w >> 16) : (w & 0xffffu); }
__device__ __forceinline__ unsigned q4(float a, float b, float c, float d, float inv, int bias) {
    const int qa = (int)rintf(a * inv) + bias, qb = (int)rintf(b * inv) + bias, qc = (int)rintf(c * inv) + bias, qd = (int)rintf(d * inv) + bias;
    return (unsigned)(qa & 0xff) | ((unsigned)(qb & 0xff) << 8) | ((unsigned)(qc & 0xff) << 16) | ((unsigned)(qd & 0xff) << 24);
}
__device__ __forceinline__ void qrow_load(f32x4 (&v)[8], const float* src, size_t e, int lane) {
#pragma unroll
    for (int j = 0; j < 8; ++j) v[j] = __builtin_nontemporal_load((const GAS f32x4*)(src + e * D + j * 256 + lane * 4));
}
__device__ __forceinline__ void qrow_finish(f32x4 (&v)[8], const float* gcol, unsigned char* dst, float* scale_out, size_t e, int lane) {
    float am = 0.f;
#pragma unroll
    for (int j = 0; j < 8; ++j) {
        if (gcol) { const f32x4 g = *(const GAS f32x4*)(gcol + j * 256 + lane * 4); v[j] = v[j] * g; }
        am = fmaxf(am, fmaxf(fmaxf(fabsf(v[j].x), fabsf(v[j].y)), fmaxf(fabsf(v[j].z), fabsf(v[j].w))));
    }
    am = max64(am);
    const float inv = am > 0.f ? 127.0f / am : 0.f;
#pragma unroll
    for (int j = 0; j < 8; ++j)
        *(GAS unsigned*)(dst + ((size_t)(2 * j + (lane >> 5)) * 16384 + e) * 128 + (lane & 31) * 4) = q4(v[j].x, v[j].y, v[j].z, v[j].w, inv, 0);
    if (lane == 0) scale_out[e] = am * (1.0f / 127.0f);
}
__device__ __forceinline__ void qx_load(v4u (&x)[4], const bf16* H1B, size_t tok, int lane) {
#pragma unroll
    for (int j = 0; j < 4; ++j) x[j] = *(const GAS v4u*)(H1B + tok * D + j * 512 + lane * 8);
}
__device__ __forceinline__ void qx_finish(const v4u (&x)[4], unsigned char* X8, float* SX, size_t tok, int lane) {
#pragma unroll
    for (int j = 0; j < 4; ++j) {
        float f[8]; float am = 0.f;
#pragma unroll
        for (int k = 0; k < 4; ++k) { f[2 * k] = blo(x[j][k]); f[2 * k + 1] = bhi(x[j][k]); am = fmaxf(am, fmaxf(fabsf(f[2 * k]), fabsf(f[2 * k + 1]))); }
        am = max16(am);
        const float inv = am > 0.f ? 127.0f / am : 0.f;
        typedef unsigned u32x2v __attribute__((ext_vector_type(2)));
        u32x2v o; o.x = q4(f[0], f[1], f[2], f[3], inv, 0); o.y = q4(f[4], f[5], f[6], f[7], inv, 0);
        *(GAS u32x2v*)(X8 + tok * D + j * 512 + lane * 8) = o;
        if ((lane & 15) == 0) SX[tok * 16 + 4 * j + (lane >> 4)] = am * (1.0f / 127.0f);
    }
}

typedef int i32x16 __attribute__((ext_vector_type(16)));
typedef float f32x16v __attribute__((ext_vector_type(16)));
__device__ __forceinline__ int seli(int m, int a, int b) { return (a & m) | (b & ~m); }
__device__ __forceinline__ float self(int m, float a, float b) { return __builtin_bit_cast(float, seli(m, __builtin_bit_cast(int, a), __builtin_bit_cast(int, b))); }
__device__ __forceinline__ void usweep(const unsigned char* X8, const float* SX, const unsigned char* U8, const unsigned short* IDS, bf16* PART, LAS unsigned char* lds, int slot, int rank, int nrank, int wave, int lane) {
    const int ps = lane >> 3, ch = lane & 7;
    const int first = rank * 8 + wave, stride = nrank * 8;
    const int n = first < MREAL ? (MREAL - first + stride - 1) / stride : 0, NQ = 2 * n;
    if (NQ == 0) return;
    const int m4 = -((lane >> 2) & 1), m2 = -((lane >> 1) & 1), m1 = -(lane & 1);
    LAS unsigned char* sl = lds + wave * 1024;
#define U_LOAD(q_, RI, RX, SX_, T_, SG_) do { const int qq_ = (q_) < NQ ? (q_) : NQ - 1; const int rd_ = qq_ >= n ? 1 : 0; T_ = first + (qq_ - rd_ * n) * stride; SG_ = rd_ * 8 + slot; \
        RI = *(const GAS unsigned*)(IDS + (size_t)T_ * 128 + lane * 2); RX = *(const GAS unsigned*)(X8 + (size_t)T_ * D + SG_ * 128 + (lane & 31) * 4); SX_ = SX[(size_t)T_ * 16 + SG_]; } while (0)
#define U_EXPAND(SLOT, RI, RX, I0, I1, XV) do { LAS unsigned char* s_ = sl + (SLOT) * 512; \
        *(LAS unsigned*)(s_ + lane * 4) = RI; if (lane < 32) *(LAS unsigned*)(s_ + 256 + lane * 4) = RX; \
        asm volatile("s_waitcnt lgkmcnt(0)" ::: "memory"); \
        I0 = *(const LAS v4u*)(s_ + ps * 32); I1 = *(const LAS v4u*)(s_ + ps * 32 + 16); XV = *(const LAS v4u*)(s_ + 256 + ch * 16); } while (0)
#define U_ISSUE(BUF, I0, I1, SG_) do { const unsigned char* tab_ = U8 + (size_t)(SG_) * 16384 * 128 + ch * 16; \
        _Pragma("unroll") for (int g = 0; g < 16; ++g) BUF[g] = *(const GAS v4u*)(tab_ + (size_t)idw(I0, I1, g) * 128); } while (0)
#define U_FINISH(BUF, XV, SX_, T_, SG_) do { i32x16 d; \
        _Pragma("unroll") for (int g = 0; g < 16; ++g) { int a_ = __builtin_amdgcn_sdot4((int)BUF[g][0], (int)XV[0], 0, false); a_ = __builtin_amdgcn_sdot4((int)BUF[g][1], (int)XV[1], a_, false); \
            a_ = __builtin_amdgcn_sdot4((int)BUF[g][2], (int)XV[2], a_, false); a_ = __builtin_amdgcn_sdot4((int)BUF[g][3], (int)XV[3], a_, false); d[g] = a_; } \
        int r8[8], r4[4], r2[2]; \
        _Pragma("unroll") for (int k = 0; k < 8; ++k) r8[k] = seli(m4, d[8 + k], d[k]) + dpp_hm(seli(m4, d[k], d[8 + k])); \
        _Pragma("unroll") for (int k = 0; k < 4; ++k) r4[k] = seli(m2, r8[4 + k], r8[k]) + dpp_x2(seli(m2, r8[k], r8[4 + k])); \
        _Pragma("unroll") for (int k = 0; k < 2; ++k) r2[k] = seli(m1, r4[2 + k], r4[k]) + dpp_x1(seli(m1, r4[k], r4[2 + k])); \
        *(GAS unsigned*)(PART + ((size_t)(SG_) * MREAL + T_) * 128 + ps * 16 + 2 * ch) = pk2((float)r2[0] * SX_, (float)r2[1] * SX_); } while (0)
    v4u bufA[16], bufB[16];
    v4u a0, a1, ax, b0, b1, bx; unsigned ri, rx; float as, bs, cs; int at, bt, ct, ag, bg, cg;
    U_LOAD(0, ri, rx, as, at, ag); U_EXPAND(0, ri, rx, a0, a1, ax);
    U_LOAD(1, ri, rx, bs, bt, bg); U_EXPAND(1, ri, rx, b0, b1, bx);
    U_ISSUE(bufA, a0, a1, ag);
    for (int q = 0; q < NQ; q += 2) {
        U_ISSUE(bufB, b0, b1, bg);
        U_LOAD(q + 2, ri, rx, cs, ct, cg);
        U_FINISH(bufA, ax, as, at, ag);
        U_EXPAND(0, ri, rx, a0, a1, ax); as = cs; at = ct; ag = cg;
        U_ISSUE(bufA, a0, a1, ag);
        U_LOAD(q + 3, ri, rx, cs, ct, cg);
        U_FINISH(bufB, bx, bs, bt, bg);
        U_EXPAND(1, ri, rx, b0, b1, bx); bs = cs; bt = ct; bg = cg;
    }
#undef U_LOAD
#undef U_EXPAND
#undef U_ISSUE
#undef U_FINISH
}
__device__ __forceinline__ void wreduce(const bf16* PART, const float* GW, const float* RSTD2, const unsigned short* IDS, const float* SCU, const float* SCV, unsigned char* W8, float* WS8, size_t gt, size_t NT) {
    for (size_t i8 = gt; i8 < (size_t)MREAL * 128 / 8; i8 += NT) {
        float s[8];
#pragma unroll
        for (int k = 0; k < 8; ++k) s[k] = 0.f;
#pragma unroll 8
        for (int sg = 0; sg < 16; ++sg) {
            const v4u p = *(const GAS v4u*)(PART + (size_t)sg * MREAL * 128 + i8 * 8);
#pragma unroll
            for (int k = 0; k < 4; ++k) { s[2 * k] += blo(p[k]); s[2 * k + 1] += bhi(p[k]); }
        }
        const float rs = RSTD2[i8 >> 4];
        const v4u idv = *(const GAS v4u*)(IDS + i8 * 8);
        const f32x4 g0 = *(const GAS f32x4*)(GW + i8 * 8), g1 = *(const GAS f32x4*)(GW + i8 * 8 + 4);
        float w[8]; float am = 0.f;
#pragma unroll
        for (int k = 0; k < 8; ++k) {
            const unsigned e = (k & 1) ? (idv[k >> 1] >> 16) : (idv[k >> 1] & 0xffffu);
            const float g = k < 4 ? g0[k & 3] : g1[k & 3];
            w[k] = g * gelu_fast(rs * SCU[e] * s[k]) * SCV[e]; am = fmaxf(am, fabsf(w[k]));
        }
        am = max16(am);
        const float inv = am > 0.f ? 127.0f / am : 0.f;
        typedef unsigned u32x2v __attribute__((ext_vector_type(2)));
        u32x2v o; o.x = q4(w[0], w[1], w[2], w[3], inv, 0); o.y = q4(w[4], w[5], w[6], w[7], inv, 0);
        *(GAS u32x2v*)(W8 + i8 * 8) = o;
        if ((i8 & 15) == 0) WS8[i8 >> 4] = am * (1.0f / 127.0f);
    }
}
__device__ __forceinline__ void vsweep(const bf16* H1B, const unsigned char* V8, const unsigned short* IDS, const unsigned char* W8, const float* WS8, bf16* Z, LAS unsigned char* lds, int slot, int rank, int nrank, int wave, int lane) {
    const int ps = lane >> 3, ch = lane & 7;
    const int first = rank * 8 + wave, stride = nrank * 8;
    const int n = first < MREAL ? (MREAL - first + stride - 1) / stride : 0, NQ = 2 * n;
    if (NQ == 0) return;
    const int m8 = -((lane >> 3) & 1);
    LAS unsigned char* sl = lds + wave * 1024;
#define V_LOAD(q_, RI, RW, WSC, HX, T_, SG_) do { const int qq_ = (q_) < NQ ? (q_) : NQ - 1; const int rd_ = qq_ >= n ? 1 : 0; T_ = first + (qq_ - rd_ * n) * stride; SG_ = rd_ * 8 + slot; \
        RI = *(const GAS unsigned*)(IDS + (size_t)T_ * 128 + lane * 2); RW = *(const GAS unsigned*)(W8 + (size_t)T_ * 128 + (lane & 31) * 4); WSC = WS8[T_]; \
        HX = *(const GAS unsigned*)(H1B + (size_t)T_ * D + SG_ * 128 + ch * 16 + 2 * ps); } while (0)
#define V_EXPAND(SLOT, RI, RW, I0, I1, WQ) do { LAS unsigned char* s_ = sl + (SLOT) * 512; \
        *(LAS unsigned*)(s_ + lane * 4) = RI; if (lane < 32) *(LAS unsigned*)(s_ + 256 + lane * 4) = RW; \
        asm volatile("s_waitcnt lgkmcnt(0)" ::: "memory"); \
        I0 = *(const LAS v4u*)(s_ + ps * 32); I1 = *(const LAS v4u*)(s_ + ps * 32 + 16); WQ = *(const LAS v4u*)(s_ + 256 + ps * 16); } while (0)
#define V_ISSUE(BUF, I0, I1, SG_) do { const unsigned char* tab_ = V8 + (size_t)(SG_) * 16384 * 128 + ch * 16; \
        _Pragma("unroll") for (int g = 0; g < 16; ++g) BUF[g] = *(const GAS v4u*)(tab_ + (size_t)idw(I0, I1, g) * 128); } while (0)
#define V_FINISH(BUF, WQ, WSC, HX, T_, SG_) do { i32x16 acc = {0, 0, 0, 0, 0, 0, 0, 0, 0, 0, 0, 0, 0, 0, 0, 0}; const unsigned hx_ = HX; \
        _Pragma("unroll") for (int j = 0; j < 4; ++j) { const int wq_ = (int)WQ[j]; \
            _Pragma("unroll") for (int k = 0; k < 4; ++k) { \
                const unsigned d0_ = BUF[4 * j][k], d1_ = BUF[4 * j + 1][k], d2_ = BUF[4 * j + 2][k], d3_ = BUF[4 * j + 3][k]; \
                const unsigned p0_ = __builtin_amdgcn_perm(d1_, d0_, 0x05010400u), p1_ = __builtin_amdgcn_perm(d1_, d0_, 0x07030602u); \
                const unsigned q0_ = __builtin_amdgcn_perm(d3_, d2_, 0x05010400u), q1_ = __builtin_amdgcn_perm(d3_, d2_, 0x07030602u); \
                acc[4 * k + 0] = __builtin_amdgcn_sdot4((int)__builtin_amdgcn_perm(q0_, p0_, 0x05040100u), wq_, acc[4 * k + 0], false); \
                acc[4 * k + 1] = __builtin_amdgcn_sdot4((int)__builtin_amdgcn_perm(q0_, p0_, 0x07060302u), wq_, acc[4 * k + 1], false); \
                acc[4 * k + 2] = __builtin_amdgcn_sdot4((int)__builtin_amdgcn_perm(q1_, p1_, 0x05040100u), wq_, acc[4 * k + 2], false); \
                acc[4 * k + 3] = __builtin_amdgcn_sdot4((int)__builtin_amdgcn_perm(q1_, p1_, 0x07060302u), wq_, acc[4 * k + 3], false); } } \
        int r8[8], r4[4], r2[2]; \
        _Pragma("unroll") for (int k = 0; k < 8; ++k) { const auto rr_ = __builtin_amdgcn_permlane32_swap((unsigned)acc[k], (unsigned)acc[8 + k], false, false); r8[k] = (int)rr_[0] + (int)rr_[1]; } \
        _Pragma("unroll") for (int k = 0; k < 4; ++k) { const auto rr_ = __builtin_amdgcn_permlane16_swap((unsigned)r8[k], (unsigned)r8[4 + k], false, false); r4[k] = (int)rr_[0] + (int)rr_[1]; } \
        _Pragma("unroll") for (int k = 0; k < 2; ++k) r2[k] = seli(m8, r4[2 + k], r4[k]) + dpp_r8(seli(m8, r4[k], r4[2 + k])); \
        const float z0_ = (float)r2[0] * WSC + blo(hx_), z1_ = (float)r2[1] * WSC + bhi(hx_); \
        *(GAS unsigned*)(Z + (size_t)T_ * D + (SG_) * 128 + ch * 16 + 2 * ps) = pk2(z0_, z1_); } while (0)
    v4u bufA[16], bufB[16];
    v4u a0, a1, aw, b0, b1, bw; unsigned ri, rw, ah, bh, chx; float as, bs, cs; int at, bt, ct, ag, bg, cg;
    V_LOAD(0, ri, rw, as, ah, at, ag); V_EXPAND(0, ri, rw, a0, a1, aw);
    V_LOAD(1, ri, rw, bs, bh, bt, bg); V_EXPAND(1, ri, rw, b0, b1, bw);
    V_ISSUE(bufA, a0, a1, ag);
    for (int q = 0; q < NQ; q += 2) {
        V_ISSUE(bufB, b0, b1, bg);
        V_LOAD(q + 2, ri, rw, cs, chx, ct, cg);
        V_FINISH(bufA, aw, as, ah, at, ag);
        V_EXPAND(0, ri, rw, a0, a1, aw); as = cs; ah = chx; at = ct; ag = cg;
        V_ISSUE(bufA, a0, a1, ag);
        V_LOAD(q + 3, ri, rw, cs, chx, ct, cg);
        V_FINISH(bufB, bw, bs, bh, bt, bg);
        V_EXPAND(1, ri, rw, b0, b1, bw); bs = cs; bh = chx; bt = ct; bg = cg;
    }
#undef V_LOAD
#undef V_EXPAND
#undef V_ISSUE
#undef V_FINISH
}
__device__ __forceinline__ void final_load(v4u (&z)[4], const bf16* Z, size_t tok, int lane) {
#pragma unroll
    for (int j = 0; j < 4; ++j) z[j] = __builtin_nontemporal_load((const GAS v4u*)(Z + tok * D + j * 512 + lane * 8));
}
__device__ __forceinline__ void final_finish(const v4u (&z)[4], const float* fg, float* out, size_t tok, int lane) {
    float ss = 0.f;
#pragma unroll
    for (int j = 0; j < 4; ++j)
#pragma unroll
        for (int k = 0; k < 4; ++k) { const float a = blo(z[j][k]), b = bhi(z[j][k]); ss += a * a + b * b; }
    ss = sum64(ss);
    const float rf = 1.0f / sqrtf(ss * (1.0f / D) + EPS);
#pragma unroll
    for (int j = 0; j < 4; ++j) {
        const f32x4 ga = *(const GAS f32x4*)(fg + j * 512 + lane * 8), gb = *(const GAS f32x4*)(fg + j * 512 + lane * 8 + 4);
        __builtin_nontemporal_store((f32x4){blo(z[j][0]) * rf * ga.x, bhi(z[j][0]) * rf * ga.y, blo(z[j][1]) * rf * ga.z, bhi(z[j][1]) * rf * ga.w}, (GAS f32x4*)(out + tok * D + j * 512 + lane * 8));
        __builtin_nontemporal_store((f32x4){blo(z[j][2]) * rf * gb.x, bhi(z[j][2]) * rf * gb.y, blo(z[j][3]) * rf * gb.z, bhi(z[j][3]) * rf * gb.w}, (GAS f32x4*)(out + tok * D + j * 512 + lane * 8 + 4));
    }
}
}

struct Frame {
    LAS unsigned char* lds;
    volatile LAS unsigned* MISC;
    gu32* ctl;
    int tid, lane, wave, vcu, G;
};
__device__ __forceinline__ float wave_sum(float v) { return sum64(v); }
__device__ __forceinline__ void p0_transpose_item(const float* W, int K, int N, bf16* WT, const float* g0, const float* g1, int ksplit, LAS float* scr, int item, int lane) {
    const int nblk = N / 32, kb = item / nblk, nb = item % nblk, k0 = 64 * kb, n0 = 32 * nb;
    f32x4 v[8];
#pragma unroll
    for (int i = 0; i < 8; ++i) v[i] = __builtin_nontemporal_load((const GAS f32x4*)(W + (size_t)(k0 + 8 * i + (lane >> 3)) * N + n0 + (lane & 7) * 4));
#pragma unroll
    for (int i = 0; i < 8; ++i) { const int kk = 8 * i + (lane >> 3), kg = k0 + kk; const float gv = kg < ksplit ? g0[kg] : g1[kg - ksplit];
        LAS float* d = scr + kk * 33 + (lane & 7) * 4; d[0] = v[i].x * gv; d[1] = v[i].y * gv; d[2] = v[i].z * gv; d[3] = v[i].w * gv; }
    LDS_WAIT(); asm volatile("" ::: "memory");
    const int c = lane & 7;
#pragma unroll
    for (int j = 0; j < 4; ++j) { const int n = (lane >> 3) + 8 * j; const LAS float* s = scr + (8 * c) * 33 + n;
        v4u o; o.x = pk2(s[0 * 33], s[1 * 33]); o.y = pk2(s[2 * 33], s[3 * 33]); o.z = pk2(s[4 * 33], s[5 * 33]); o.w = pk2(s[6 * 33], s[7 * 33]);
        *(GAS v4u*)(WT + (size_t)(n0 + n) * K + k0 + 8 * c) = o; }
    LDS_WAIT(); asm volatile("" ::: "memory");
}
__device__ __forceinline__ void p0_row_load(f32x4 (&v)[8], const float* xrow, int lane) {
    const GAS f32x4* xr = (const GAS f32x4*)xrow + lane;
#pragma unroll
    for (int j = 0; j < 8; ++j) v[j] = __builtin_nontemporal_load(xr + 64 * j);
}
__device__ __forceinline__ void p0_row_finish(const f32x4 (&v)[8], bf16* orow, float* rstd_out, int lane) {
    float s = 0.f;
#pragma unroll
    for (int j = 0; j < 8; ++j) s += (v[j].x * v[j].x + v[j].y * v[j].y) + (v[j].z * v[j].z + v[j].w * v[j].w);
    s = wave_sum(s);
    GAS unsigned long long* o8 = (GAS unsigned long long*)orow + lane;
#pragma unroll
    for (int j = 0; j < 8; ++j) o8[64 * j] = (unsigned long long)pk2(v[j].x, v[j].y) | ((unsigned long long)pk2(v[j].z, v[j].w) << 32);
    if (lane == 0) *rstd_out = 1.0f / sqrtf(s * (1.0f / D) + EPS);
}
__device__ __forceinline__ void p0_cvt8(const float* src, bf16* dst, const float* gcol, size_t idx8) {
    const f32x4 a = *(const GAS f32x4*)(src + idx8 * 8), b = *(const GAS f32x4*)(src + idx8 * 8 + 4);
    f32x4 ga = {1.f, 1.f, 1.f, 1.f}, gb = {1.f, 1.f, 1.f, 1.f};
    if (gcol) { const int c = (int)((idx8 * 8) & (D - 1)); ga = *(const GAS f32x4*)(gcol + c); gb = *(const GAS f32x4*)(gcol + c + 4); }
    v4u o; o.x = pk2(a.x * ga.x, a.y * ga.y); o.y = pk2(a.z * ga.z, a.w * ga.w); o.z = pk2(b.x * gb.x, b.y * gb.y); o.w = pk2(b.z * gb.z, b.w * gb.w);
    *(GAS v4u*)(dst + idx8 * 8) = o;
}

struct Args { const float* in[22]; float* out; unsigned char* ws; int ph_lo, ph_hi, rep_mask, pad; };

__global__ void __launch_bounds__(NWAVES * 64, 2) fwd(Args args) {
    extern __shared__ __attribute__((aligned(16))) unsigned char lds[];
    Frame F;
    F.lds = (LAS unsigned char*)lds;
    F.MISC = (volatile LAS unsigned*)(F.lds + MISC_OFF);
    F.tid = threadIdx.x; F.lane = F.tid & 63; F.wave = __builtin_amdgcn_readfirstlane(F.tid >> 6);
    F.G = gridDim.x; { const int bx = blockIdx.x; F.vcu = (F.G % 8 == 0) ? (bx % 8) * (F.G / 8) + bx / 8 : bx; }
    unsigned char* ws = args.ws;
    F.ctl = (gu32*)(ws + WS_CTL);
    for (int u = F.tid; u < (LDS_BYTES - LDSCTL_OFF) / 4; u += NWAVES * 64) ((LAS unsigned*)(F.lds + LDSCTL_OFF))[u] = 0u;
    __syncthreads();
    XcdBarrier bar = xcd_barrier_post((unsigned*)(F.ctl + CW_BAR), F.MISC + 8);
    const int lo = args.ph_lo, hi = args.ph_hi;
#define IN(k) (lo <= (k) && (k) < hi)
#define BOTH(k) (IN(k) && IN((k) + 1))
#ifndef PROBE_PH
#define PROBE_PH (-1)
#endif
#define REP(k) for (int rep_ = 0; rep_ < ((k) == PROBE_PH ? 2 : 1); ++rep_)
#define STAMP(i) do { if (PROBE_PH >= 100 && blockIdx.x == 0 && F.tid == 0) ((volatile LAS unsigned long long*)(F.lds + LDSCTL_OFF + 640))[i] = __builtin_amdgcn_s_memrealtime(); } while (0)

    const float* x = args.in[0]; const float* meta = args.in[1]; const float* norm_mix_g = args.in[2]; const float* w_in = args.in[3]; const float* b_in = args.in[4];
    const float* gn_attn_g = args.in[13]; const float* gn_lru_g = args.in[14]; const float* w_out = args.in[15]; const float* norm_ffn_g = args.in[16];
    const float* peer_wq = args.in[17]; const float* sub_keys = args.in[18]; const float* peer_u = args.in[19]; const float* peer_v = args.in[20];
    bf16* W1T = (bf16*)(ws + WS_W1T); bf16* W2T = (bf16*)(ws + WS_W2T); bf16* W3T = (bf16*)(ws + WS_W3T); bf16* SKB = (bf16*)(ws + WS_SKB);
    float* RSTD1 = (float*)(ws + WS_RSTD1);
    unsigned char* U8 = ws + WS_U8; unsigned char* V8 = ws + WS_V8; unsigned char* X8 = ws + WS_X8; float* SX = (float*)(ws + WS_SX); float* SCU = (float*)(ws + WS_SCU); float* SCV = (float*)(ws + WS_SCV);
    bf16* A1 = (bf16*)(ws + WS_A1);
    bf16* QB = (bf16*)(ws + WS_Q); bf16* KVB = (bf16*)(ws + WS_KV); bf16* XBB = (bf16*)(ws + WS_XB); bf16* GTB = (bf16*)(ws + WS_GT);

    STAMP(0);
    if (IN(0)) { REP(0) {
        LAS float* scr = (LAS float*)(F.lds + RING_OFF + F.wave * 16384);
        const int gw = F.vcu * NWAVES + F.wave, NGW = F.G * NWAVES;
        constexpr int I_1 = (D / 64) * (IND / 32), I_2 = (D / 64) * (D / 32), I_3 = I_2;
        for (int it = gw; it < I_1 + I_2 + I_3; it += NGW) {
            int r = it;
            if (r < I_1) { p0_transpose_item(w_in, D, IND, W1T, norm_mix_g, norm_mix_g, D, scr, r, F.lane); continue; } r -= I_1;
            if (r < I_2) { p0_transpose_item(w_out, D, D, W2T, gn_attn_g, gn_lru_g, 1024, scr, r, F.lane); continue; } r -= I_2;
            p0_transpose_item(peer_wq, D, D, W3T, norm_ffn_g, norm_ffn_g, D, scr, r, F.lane);
        }
        {
            f32x4 r0[8], r1[8], r2[8];
            const int NR = MREAL + NMETA;
#define P0_XSRC(m_) ((m_) < MREAL ? x + (size_t)(m_) * D : meta + (size_t)((m_) - MREAL) * D)
            if (gw < NR) p0_row_load(r0, P0_XSRC(gw), F.lane);
            if (gw + NGW < NR) p0_row_load(r1, P0_XSRC(gw + NGW), F.lane);
            for (int m = gw; m < NR; m += 3 * NGW) {
                if (m + 2 * NGW < NR) p0_row_load(r2, P0_XSRC(m + 2 * NGW), F.lane);
                p0_row_finish(r0, A1 + (size_t)m * D, RSTD1 + m, F.lane);
                if (m + NGW < NR) {
                    if (m + 3 * NGW < NR) p0_row_load(r0, P0_XSRC(m + 3 * NGW), F.lane);
                    p0_row_finish(r1, A1 + (size_t)(m + NGW) * D, RSTD1 + m + NGW, F.lane);
                }
                if (m + 2 * NGW < NR) {
                    if (m + 4 * NGW < NR) p0_row_load(r1, P0_XSRC(m + 4 * NGW), F.lane);
                    p0_row_finish(r2, A1 + (size_t)(m + 2 * NGW) * D, RSTD1 + m + 2 * NGW, F.lane);
                }
            }
#undef P0_XSRC
        }
        {
            const size_t gt = (size_t)gw * 64 + F.lane, NT = (size_t)NGW * 64;
            for (size_t i = gt; i < (size_t)(8 * 2 * 128 * 128) / 8; i += NT) p0_cvt8(sub_keys, SKB, nullptr, i);
            {
                f32x4 r0[8], r1[8], r2[8];
                constexpr int QV0 = 6144, NR = 16384;
                const int b0 = QV0 + gw;
                if (b0 < NR) p6::qrow_load(r0, peer_v, (size_t)b0, F.lane);
                if (b0 + NGW < NR) p6::qrow_load(r1, peer_v, (size_t)(b0 + NGW), F.lane);
                for (int rj = b0; rj < NR; rj += 3 * NGW) {
                    if (rj + 2 * NGW < NR) p6::qrow_load(r2, peer_v, (size_t)(rj + 2 * NGW), F.lane);
                    p6::qrow_finish(r0, nullptr, V8, SCV, (size_t)rj, F.lane);
                    if (rj + NGW < NR) {
                        if (rj + 3 * NGW < NR) p6::qrow_load(r0, peer_v, (size_t)(rj + 3 * NGW), F.lane);
                        p6::qrow_finish(r1, nullptr, V8, SCV, (size_t)(rj + NGW), F.lane);
                    }
                    if (rj + 2 * NGW < NR) {
                        if (rj + 4 * NGW < NR) p6::qrow_load(r1, peer_v, (size_t)(rj + 4 * NGW), F.lane);
                        p6::qrow_finish(r2, nullptr, V8, SCV, (size_t)(rj + 2 * NGW), F.lane);
                    }
                }
            }
        } }
        if (BOTH(0)) xcd_barrier(bar);
        STAMP(1);
    }
    if (IN(1)) {
        pg8::Gemm g{A1, W1T, MPAD, IND, D};
        pg8::Order1 S{F.G, (int)blockIdx.x};
        pg8::Epi1 E{QB, KVB, XBB, GTB, RSTD1, b_in};
        REP(1) pg8::gemm_phase<pg8::Epi1, pg8::Order1, true, true>(F.lds + RING_OFF, g, S, E);
        {
            volatile LAS int* qb = (volatile LAS int*)(F.lds + LDSCTL_OFF + 512);
            for (;;) {
                __syncthreads();
                if (F.tid == 0) qb[0] = (int)__hip_atomic_fetch_add((unsigned*)(F.ctl + CW_QROW), 32u, __ATOMIC_RELAXED, __HIP_MEMORY_SCOPE_AGENT);
                __syncthreads();
                const int base = qb[0];
                if (base >= 16384 + 6144) break;
                f32x4 r0[8], r1[8], r2[8], r3[8];
                const bool isu = base < 16384;
                const float* src = isu ? peer_u : peer_v; const float* gc = isu ? norm_ffn_g : nullptr; unsigned char* dst = isu ? U8 : V8; float* sc = isu ? SCU : SCV;
                const size_t e0 = (size_t)(isu ? base : base - 16384) + F.wave * 4;
                p6::qrow_load(r0, src, e0, F.lane); p6::qrow_load(r1, src, e0 + 1, F.lane); p6::qrow_load(r2, src, e0 + 2, F.lane); p6::qrow_load(r3, src, e0 + 3, F.lane);
                p6::qrow_finish(r0, gc, dst, sc, e0, F.lane); p6::qrow_finish(r1, gc, dst, sc, e0 + 1, F.lane);
                p6::qrow_finish(r2, gc, dst, sc, e0 + 2, F.lane); p6::qrow_finish(r3, gc, dst, sc, e0 + 3, F.lane);
            }
        }
        if (BOTH(1)) xcd_barrier(bar);
        STAMP(2);
    }
    if (IN(2)) {
        bf16* MIX = (bf16*)(ws + WS_Z); float* SSA = (float*)(ws + WS_SSA); float* SSL = (float*)(ws + WS_SSL);
        const p2::LruP LP{args.in[6], args.in[7], args.in[8], args.in[9], args.in[10], args.in[11], args.in[12]};
        {
        REP(20) for (int u = (int)blockIdx.x; u < 256; u += F.G) p2::lru_unit(F.lds + RING_OFF, F.lds + LDSCTL_OFF + 5120, u >> 5, (u >> 1) & 15, u & 1, XBB, GTB, LP, MIX, SSL, F.tid);
        REP(21) for (int a = (int)blockIdx.x; a < 256; a += F.G) p2::attn_unit(F.lds + RING_OFF, a >> 5, (a >> 1) & 15, a & 1, QB, KVB, args.in[5], MIX, SSA, F.tid);
        }
        if (BOTH(2)) xcd_barrier(bar);
        STAMP(3);
    }
    if (IN(3)) {
        bf16* MIX = (bf16*)(ws + WS_Z); const float* SSA = (const float*)(ws + WS_SSA); const float* SSL = (const float*)(ws + WS_SSL);
        bf16* H1B = (bf16*)(ws + WS_H1); float* SS2 = (float*)(ws + WS_SS2);
        pg8::Order2 S{F.G, (int)blockIdx.x};
        LAS float* tbl = (LAS float*)(F.lds + LDSCTL_OFF + 1024);
        pg8::Unit u0{0, 0};
        for (int i = 0; i < 2; ++i) {
            pg8::Unit u; if (!S.next(i, u)) break; if (i == 0) u0 = u;
            if (F.tid < 256) {
                const size_t row = (size_t)u.pm * 256 + F.tid; float sa = 0.f, sl = 0.f;
#pragma unroll
                for (int k = 0; k < 4; ++k) { const f32x4 v = *(const GAS f32x4*)(SSA + row * 16 + 4 * k); sa += (v.x + v.y) + (v.z + v.w); }
#pragma unroll
                for (int k = 0; k < 8; ++k) { const f32x4 v = *(const GAS f32x4*)(SSL + row * 32 + 4 * k); sl += (v.x + v.y) + (v.z + v.w); }
                const float ra = 1.0f / sqrtf(sa * (1.0f / 1024) + EPS), rl = 1.0f / sqrtf(sl * (1.0f / 1024) + EPS);
                tbl[(i * 256 + F.tid) * 4] = ra / rl; tbl[(i * 256 + F.tid) * 4 + 1] = rl; tbl[(i * 256 + F.tid) * 4 + 2] = 1.0f / ra;
            }
        }
        __syncthreads();
        pg8::Gemm g{MIX, W2T, MREAL, D, D};
        pg8::Epi2 E{H1B, A1, SS2, (const LAS float*)tbl, u0.pm};
        REP(3) pg8::gemm_phase<pg8::Epi2, pg8::Order2, true, true>(F.lds + RING_OFF, g, S, E);
        if (BOTH(3)) xcd_barrier(bar);
        STAMP(4);
    }
    if (IN(4)) {
        bf16* H1B = (bf16*)(ws + WS_H1); bf16* QPB = (bf16*)(ws + WS_A1);
        pg8::Order2 S{F.G, (int)blockIdx.x};
        {
            const float* SS2 = (const float*)(ws + WS_SS2); float* RSTD2 = (float*)(ws + WS_RSTD2);
            pg8::Unit u; if (S.next(0, u) && F.tid < 256) {
                const size_t row = (size_t)u.pm * 256 + F.tid; float ssq = 0.f;
#pragma unroll
                for (int k = 0; k < 8; ++k) { const f32x4 v = *(const GAS f32x4*)(SS2 + row * 32 + 4 * k); ssq += (v.x + v.y) + (v.z + v.w); }
                RSTD2[row] = 1.0f / sqrtf(ssq * (1.0f / D) + EPS);
            }
        }
        pg8::Gemm g{H1B, W3T, MREAL, D, D};
        pg8::Epi3 E{QPB};
        REP(4) pg8::gemm_phase<pg8::Epi3, pg8::Order2, true, true>(F.lds + RING_OFF, g, S, E);
        if (BOTH(4)) { asm volatile("s_waitcnt vmcnt(0)" ::: "memory"); __syncthreads();
            if (F.tid == 0) { __builtin_amdgcn_fence(__ATOMIC_ACQUIRE, "agent"); asm volatile("s_waitcnt vmcnt(0)" ::: "memory"); }
            __syncthreads(); }
        STAMP(5);
    }
    if (IN(5)) {
        const bf16* QPB = (const bf16*)(ws + WS_A1);
        unsigned short* IDS = (unsigned short*)(ws + WS_IDS); float* GW = (float*)(ws + WS_GW); float* RSTD2 = (float*)(ws + WS_RSTD2);
        const bf16* H1B = (const bf16*)(ws + WS_H1);
        const pg8::Order2 S5{F.G, (int)blockIdx.x};
        REP(5) for (int ui = 0; ; ++ui) {
            pg8::Unit un; if (!S5.next(ui, un)) break;
            const int uh = un.pn, utg = un.pm;
            v4u xq[4][4]; const size_t tb = (size_t)utg * 256 + F.wave * 32 + uh;
#pragma unroll
            for (int k = 0; k < 4; ++k) p6::qx_load(xq[k], H1B, tb + 8 * k, F.lane);
            p5::retr_unit(F.lds + RING_OFF, uh, utg, QPB, SKB, IDS, GW, RSTD2, F.tid);
#pragma unroll
            for (int k = 0; k < 4; ++k) p6::qx_finish(xq[k], X8, SX, tb + 8 * k, F.lane);
        }
        if (BOTH(5)) xcd_barrier(bar);
        STAMP(6);
    }
    {
        const bf16* H1B = (const bf16*)(ws + WS_H1); const unsigned short* IDS = (const unsigned short*)(ws + WS_IDS); const float* GW = (const float*)(ws + WS_GW);
        const float* RSTD2 = (const float*)(ws + WS_RSTD2); bf16* PART = (bf16*)(ws + WS_PART); unsigned char* W8 = ws + WS_W; float* WS8 = (float*)(ws + WS_WSUM); bf16* ZB = (bf16*)(ws + WS_Z);
        const int slot = (int)blockIdx.x & 7, rank = (int)blockIdx.x >> 3, nrank = (F.G - slot + 7) >> 3;
        const int gw = F.vcu * NWAVES + F.wave, NGW = F.G * NWAVES;
        if (IN(6)) { REP(6) p6::usweep(X8, SX, U8, IDS, PART, F.lds + RING_OFF, slot, rank, nrank, F.wave, F.lane); if (BOTH(6)) xcd_barrier(bar); STAMP(7); }
        if (IN(7)) { REP(7) p6::wreduce(PART, GW, RSTD2, IDS, SCU, SCV, W8, WS8, (size_t)gw * 64 + F.lane, (size_t)NGW * 64); if (BOTH(7)) xcd_barrier(bar); STAMP(8); }
        if (IN(8)) { REP(8) p6::vsweep(H1B, V8, IDS, W8, WS8, ZB, F.lds + RING_OFF, slot, rank, nrank, F.wave, F.lane); if (BOTH(8)) xcd_barrier(bar); STAMP(9); }
        if (PROBE_PH == 30) { for (int k = 0; k < 16; ++k) xcd_barrier(bar); }
        if (IN(9)) { REP(9) {
            v4u zc[4], zn[4];
            if (gw < MREAL) p6::final_load(zc, ZB, (size_t)gw, F.lane);
            for (int t = gw; t < MREAL; t += NGW) {
                if (t + NGW < MREAL) p6::final_load(zn, ZB, (size_t)(t + NGW), F.lane);
                p6::final_finish(zc, args.in[21], args.out, (size_t)t, F.lane);
#pragma unroll
                for (int j = 0; j < 4; ++j) zc[j] = zn[j];
            } } }
        if (PROBE_PH >= 100) {
            asm volatile("s_waitcnt vmcnt(0)" ::: "memory"); __syncthreads(); STAMP(10);
            if (blockIdx.x == 0 && F.tid == 0) {
                volatile LAS unsigned long long* ts = (volatile LAS unsigned long long*)(F.lds + LDSCTL_OFF + 640);
                const unsigned long long span = ts[PROBE_PH - 100 + 1] - ts[PROBE_PH - 100], t0 = __builtin_amdgcn_s_memrealtime();
                while (__builtin_amdgcn_s_memrealtime() - t0 < span) __builtin_amdgcn_s_sleep(8);
            }
        }
    }
#undef IN
#undef BOTH
}

extern "C" void kernel_launch(void* const* d_in, const int* in_sizes, int n_in, void* d_out, int out_size, void* d_ws, size_t ws_size, hipStream_t stream) {
    static int grid = 0;
    if (grid == 0) {
        int dev = 0, cus = 0;
        if (hipGetDevice(&dev) != hipSuccess || hipDeviceGetAttribute(&cus, hipDeviceAttributeMultiprocessorCount, dev) != hipSuccess) { fprintf(stderr, "kernel_launch: device query failed\n"); grid = -1; return; }
        if (hipFuncSetAttribute((const void*)fwd, hipFuncAttributeMaxDynamicSharedMemorySize, LDS_BYTES) != hipSuccess) { fprintf(stderr, "kernel_launch: hipFuncSetAttribute failed\n"); grid = -1; return; }
        int per_cu = 0;
        if (hipOccupancyMaxActiveBlocksPerMultiprocessor(&per_cu, (const void*)fwd, NWAVES * 64, LDS_BYTES) != hipSuccess || per_cu < 1) fprintf(stderr, "kernel_launch: occupancy query says %d\n", per_cu);
        (void)hipGetLastError();
        grid = cus;
        if (cus != 256) { fprintf(stderr, "kernel_launch: built for a 256-CU device (tile-to-workgroup maps of the GEMM phases), found %d CUs; nothing launched\n", cus); grid = -1; return; }
        if (ws_size < WS_END) { fprintf(stderr, "kernel_launch: ws too small %zu\n", ws_size); grid = -1; return; }
    }
    if (grid < 0) return;
    (void)hipMemsetAsync((char*)d_ws + WS_CTL, 0, CTL_ZERO_BYTES, stream);
    Args a{};
    for (int i = 0; i < 22; ++i) a.in[i] = (const float*)d_in[i];
    a.out = (float*)d_out; a.ws = (unsigned char*)d_ws; a.ph_lo = 0; a.ph_hi = 10;
    hipLaunchKernelGGL(fwd, dim3(grid), dim3(NWAVES * 64), LDS_BYTES, stream, a);
}
```

```cpp
#include <hip/hip_runtime.h>
#include <cstdio>
#include <cstdint>
#include <math.h>

#define D 2048
#define NB 8
#define SEQ 2048
#define NMETA 16
#define TT (SEQ + NMETA)
#define MR (NB * TT)
#define MREAL (NB * SEQ)
#define MPAD (MREAL + 256)
#define QD 1024
#define KVD 128
#define LW 1024
#define IND 3328
#define EPS 1e-6f
#define QSCALE (0.125f * 1.4426950408889634f)
#define GAS __attribute__((address_space(1)))
#define LAS __attribute__((address_space(3)))

#define DPP_I(x, ctrl) __builtin_amdgcn_update_dpp(0, (x), (ctrl), 0xf, 0xf, true)
__device__ __forceinline__ int dpp_x1(int x) { return DPP_I(x, 0xB1); }
__device__ __forceinline__ int dpp_x2(int x) { return DPP_I(x, 0x4E); }
__device__ __forceinline__ int dpp_hm(int x) { return DPP_I(x, 0x141); }
__device__ __forceinline__ int dpp_rm(int x) { return DPP_I(x, 0x140); }
__device__ __forceinline__ int dpp_r8(int x) { return DPP_I(x, 0x128); }
__device__ __forceinline__ float fdpp_x1(float x) { return __builtin_bit_cast(float, dpp_x1(__builtin_bit_cast(int, x))); }
__device__ __forceinline__ float fdpp_x2(float x) { return __builtin_bit_cast(float, dpp_x2(__builtin_bit_cast(int, x))); }
__device__ __forceinline__ float fdpp_hm(float x) { return __builtin_bit_cast(float, dpp_hm(__builtin_bit_cast(int, x))); }
__device__ __forceinline__ float fdpp_rm(float x) { return __builtin_bit_cast(float, dpp_rm(__builtin_bit_cast(int, x))); }
__device__ __forceinline__ float max16(float v) { v = fmaxf(v, fdpp_x1(v)); v = fmaxf(v, fdpp_x2(v)); v = fmaxf(v, fdpp_hm(v)); return fmaxf(v, fdpp_rm(v)); }
__device__ __forceinline__ float sum64(float v) {
    v += fdpp_x1(v); v += fdpp_x2(v); v += fdpp_hm(v); v += fdpp_rm(v);
    return (__builtin_bit_cast(float, __builtin_amdgcn_readlane(__builtin_bit_cast(int, v), 0)) + __builtin_bit_cast(float, __builtin_amdgcn_readlane(__builtin_bit_cast(int, v), 16)))
         + (__builtin_bit_cast(float, __builtin_amdgcn_readlane(__builtin_bit_cast(int, v), 32)) + __builtin_bit_cast(float, __builtin_amdgcn_readlane(__builtin_bit_cast(int, v), 48)));
}
__device__ __forceinline__ float max64(float v) {
    v = max16(v);
    return fmaxf(fmaxf(__builtin_bit_cast(float, __builtin_amdgcn_readlane(__builtin_bit_cast(int, v), 0)), __builtin_bit_cast(float, __builtin_amdgcn_readlane(__builtin_bit_cast(int, v), 16))),
                 fmaxf(__builtin_bit_cast(float, __builtin_amdgcn_readlane(__builtin_bit_cast(int, v), 32)), __builtin_bit_cast(float, __builtin_amdgcn_readlane(__builtin_bit_cast(int, v), 48))));
}
__device__ __forceinline__ float sum8(float v) { v += fdpp_x1(v); v += fdpp_x2(v); return v + fdpp_hm(v); }
__device__ __forceinline__ float sum4(float v) { v += fdpp_x1(v); return v + fdpp_x2(v); }
__device__ __forceinline__ float sum_x32(float v) { return v + __shfl_xor(v, 32); }
__device__ __forceinline__ float max_x32(float v) { return fmaxf(v, __shfl_xor(v, 32)); }
__device__ __forceinline__ float sum_x16(float v) { return v + __shfl_xor(v, 16); }
namespace pg8 {
#define PG8_LAS __attribute__((address_space(3)))
typedef unsigned short bf16_t;
typedef short bf16x8 __attribute__((ext_vector_type(8)));
typedef float f32x4 __attribute__((ext_vector_type(4)));
typedef unsigned u32x4 __attribute__((ext_vector_type(4)));
constexpr int BM = 256, BK = 64, HALF = 128, HTB = HALF * BK * 2  , STAGE_BYTES = 8 * HTB, NXCD = 8, WGM = 8;

__host__ __device__ __forceinline__ int lds_byte(int r, int c) { const int st = (r >> 4) * 2 + (c >> 5), rr = r & 15, cc = c & 31, ob = rr * 64 + cc * 2; return st * 1024 + (ob ^ (((ob >> 9) & 1) << 5)); }
__host__ __device__ __forceinline__ void stage_rc(int b, int& R, int& C) { const int st = b / 1024, sb = b % 1024, swz = sb ^ (((sb >> 9) & 1) << 5); R = (st >> 1) * 16 + swz / 64; C = (st & 1) * 32 + (swz % 64) / 2; }
__host__ __device__ __forceinline__ int perm32(int rho) { const int n = rho >> 4, i = rho & 15; return 8 * (i >> 2) + 4 * n + (i & 3); }

struct Unit { int pm, pn; };
struct Gemm { const bf16_t* A; const bf16_t* Bt; int M, N, K; };

struct StaticOrder {
    int nM, nN, nwg, G, c;
    __host__ __device__ void init(int M, int N, int G_, int c_) { nM = M / BM; nN = N / BM; nwg = nM * nN; G = G_; c = c_; }
    __host__ __device__ bool next(int i, Unit& u) const {
        const long L = (long)i * G + c; if (L >= nwg) return false;
        int wgid = (int)L; { const int q = nwg / NXCD, r = nwg % NXCD, xcd = wgid % NXCD, off = wgid / NXCD; wgid = (xcd < r ? xcd * (q + 1) : r * (q + 1) + (xcd - r) * q) + off; }
        const int nig = WGM * nN, gid = wgid / nig, fm = gid * WGM, gsz = (nM - fm) < WGM ? (nM - fm) : WGM;
        u.pm = fm + ((wgid % nig) % gsz); u.pn = (wgid % nig) / gsz; return true;
    }
    __device__ __forceinline__ void a_ready(const Unit&) const {}
    __device__ __forceinline__ void done(const Unit&) const {}
};

__device__ __forceinline__ unsigned cvt_pk_bf16(float lo, float hi) { unsigned r; asm volatile("v_cvt_pk_bf16_f32 %0, %1, %2" : "=v"(r) : "v"(lo), "v"(hi)); return r; }
typedef unsigned u32x2 __attribute__((ext_vector_type(2)));
struct Order1 {
    int G, c;
    __device__ __forceinline__ bool next(int i, Unit& u) const {
        const int L = i * G + c; if (L >= 837) return false;
        if (L >= 832) { u.pm = 64; u.pn = 4 + (L - 832); return true; }
        const int nwg = 832, nN = 13;
        int wgid = L; { const int q = nwg / NXCD, xcd = wgid % NXCD, off = wgid / NXCD; wgid = xcd * q + off; }
        const int nig = WGM * nN, gid = wgid / nig, fm = gid * WGM;
        u.pm = fm + ((wgid % nig) % WGM); u.pn = (wgid % nig) / WGM; return true;
    }
    __device__ __forceinline__ void a_ready(const Unit&) const {}
    __device__ __forceinline__ void done(const Unit&) const {}
};
struct Order2 {
    int G, c;
    __device__ __forceinline__ bool next(int i, Unit& u) const {
        const int L = i * G + c; if (L >= 512) return false;
        const int nwg = 512, nN = 8;
        int wgid = L; { const int q = nwg / NXCD, xcd = wgid % NXCD, off = wgid / NXCD; wgid = xcd * q + off; }
        const int nig = WGM * nN, gid = wgid / nig, fm = gid * WGM;
        u.pm = fm + ((wgid % nig) % WGM); u.pn = (wgid % nig) / WGM; return true;
    }
    __device__ __forceinline__ void a_ready(const Unit&) const {}
    __device__ __forceinline__ void done(const Unit&) const {}
};

struct Epi1 {
    static constexpr bool PERM = true, AFTER_DRAIN = false, MIDK = false, INIT = false;
    bf16_t *Q, *KV, *XB, *GT; const float* rstd; const float* bias;
    __device__ __forceinline__ void midk(f32x4 (&acc)[2][2][4][2], const Unit& u, int wr, int wc, int fr, int fq) const {}
    __device__ __forceinline__ void operator()(const f32x4 (&acc)[2][2][4][2], const Unit& u, int wr, int wc, int fr, int fq) const {
        const int row0 = u.pm * BM + wr * 64 + fr;
        bf16_t* base; int ldc, colb; float sc = 1.f;
        if (u.pn < 4) { base = Q; ldc = 1024; colb = u.pn * BM; sc = QSCALE; }
        else if (u.pn == 4) { base = KV; ldc = 256; colb = 0; }
        else if (u.pn < 9) { base = XB; ldc = 1024; colb = (u.pn - 5) * BM; }
        else { base = GT; ldc = 1024; colb = (u.pn - 9) * BM; }
        const int col0 = colb + wc * 32 + 8 * fq, bcol0 = u.pn * BM + wc * 32 + 8 * fq;
        f32x4 bv[2][2];
#pragma unroll
        for (int bj = 0; bj < 2; ++bj)
#pragma unroll
            for (int n = 0; n < 2; ++n) bv[bj][n] = *(const f32x4*)(bias + bcol0 + bj * HALF + 4 * n);
#pragma unroll
        for (int ai = 0; ai < 2; ++ai)
#pragma unroll
            for (int m = 0; m < 4; ++m) {
                const int row = row0 + ai * HALF + m * 16; const float rs = rstd[row];
                bf16_t* rowp = base + (size_t)row * ldc + col0;
#pragma unroll
                for (int bj = 0; bj < 2; ++bj) {
                    f32x4 v0 = (acc[ai][bj][m][0] * rs + bv[bj][0]) * sc, v1 = (acc[ai][bj][m][1] * rs + bv[bj][1]) * sc;
                    u32x4 w; w.x = cvt_pk_bf16(v0[0], v0[1]); w.y = cvt_pk_bf16(v0[2], v0[3]); w.z = cvt_pk_bf16(v1[0], v1[1]); w.w = cvt_pk_bf16(v1[2], v1[3]);
                    *(u32x4*)(rowp + bj * HALF) = w; } }
    }
};
struct Epi2 {
    static constexpr bool PERM = true, AFTER_DRAIN = false, MIDK = true, INIT = true;
    bf16_t* H1; const bf16_t* xb; float* SS2; const LAS float* tbl; int pm0;
    __device__ __forceinline__ void init(f32x4 (&acc)[2][2][4][2], const Unit& u, int wr, int wc, int fr, int fq) const {
        const LAS float* t = tbl + (u.pm == pm0 ? 0 : 1024);
        const int col0 = u.pn * BM + wc * 32 + 8 * fq;
#pragma unroll
        for (int ai = 0; ai < 2; ++ai)
#pragma unroll
            for (int m = 0; m < 4; ++m) {
                const int rl = ai * HALF + wr * 64 + m * 16 + fr; const size_t row = (size_t)u.pm * BM + rl; const float ia = t[rl * 4 + 2];
#pragma unroll
                for (int bj = 0; bj < 2; ++bj) {
                    const u32x4 xw = *(const u32x4*)(xb + row * 2048 + col0 + bj * HALF);
                    acc[ai][bj][m][0] = (f32x4){__builtin_bit_cast(float, xw.x << 16), __builtin_bit_cast(float, xw.x & 0xffff0000u), __builtin_bit_cast(float, xw.y << 16), __builtin_bit_cast(float, xw.y & 0xffff0000u)} * ia;
                    acc[ai][bj][m][1] = (f32x4){__builtin_bit_cast(float, xw.z << 16), __builtin_bit_cast(float, xw.z & 0xffff0000u), __builtin_bit_cast(float, xw.w << 16), __builtin_bit_cast(float, xw.w & 0xffff0000u)} * ia; }
            }
    }
    __device__ __forceinline__ void midk(f32x4 (&acc)[2][2][4][2], const Unit& u, int wr, int wc, int fr, int fq) const {
        const LAS float* t = tbl + (u.pm == pm0 ? 0 : 1024);
#pragma unroll
        for (int ai = 0; ai < 2; ++ai)
#pragma unroll
            for (int m = 0; m < 4; ++m) { const float ra = t[(ai * HALF + wr * 64 + m * 16 + fr) * 4];
#pragma unroll
                for (int bj = 0; bj < 2; ++bj)
#pragma unroll
                    for (int n = 0; n < 2; ++n) acc[ai][bj][m][n] = acc[ai][bj][m][n] * ra; }
    }
    __device__ __forceinline__ void operator()(const f32x4 (&acc)[2][2][4][2], const Unit& u, int wr, int wc, int fr, int fq) const {
        const LAS float* t = tbl + (u.pm == pm0 ? 0 : 1024);
        const int col0 = u.pn * BM + wc * 32 + 8 * fq;
#pragma unroll
        for (int ai = 0; ai < 2; ++ai)
#pragma unroll
            for (int m = 0; m < 4; ++m) {
                const int rl = ai * HALF + wr * 64 + m * 16 + fr; const size_t row = (size_t)u.pm * BM + rl; const float rs = t[rl * 4 + 1];
                float ss = 0.f;
#pragma unroll
                for (int bj = 0; bj < 2; ++bj) {
                    const f32x4 v0 = acc[ai][bj][m][0] * rs, v1 = acc[ai][bj][m][1] * rs;
                    ss += (v0[0] * v0[0] + v0[1] * v0[1]) + (v0[2] * v0[2] + v0[3] * v0[3]) + (v1[0] * v1[0] + v1[1] * v1[1]) + (v1[2] * v1[2] + v1[3] * v1[3]);
                    u32x4 w; w.x = cvt_pk_bf16(v0[0], v0[1]); w.y = cvt_pk_bf16(v0[2], v0[3]); w.z = cvt_pk_bf16(v1[0], v1[1]); w.w = cvt_pk_bf16(v1[2], v1[3]);
                    *(u32x4*)(H1 + row * 2048 + col0 + bj * HALF) = w; }
                ss = sum_x32(sum_x16(ss));
                if (fq == 0) SS2[row * 32 + u.pn * 4 + wc] = ss;
            }
    }
};
struct Epi3 {
    static constexpr bool PERM = true, AFTER_DRAIN = false, MIDK = false, INIT = false;
    bf16_t* O;
    __device__ __forceinline__ void midk(f32x4 (&acc)[2][2][4][2], const Unit& u, int wr, int wc, int fr, int fq) const {}
    __device__ __forceinline__ void operator()(const f32x4 (&acc)[2][2][4][2], const Unit& u, int wr, int wc, int fr, int fq) const {
        const int col0 = u.pn * BM + wc * 32 + 8 * fq;
#pragma unroll
        for (int ai = 0; ai < 2; ++ai)
#pragma unroll
            for (int m = 0; m < 4; ++m) { const size_t row = (size_t)u.pm * BM + ai * HALF + wr * 64 + m * 16 + fr;
#pragma unroll
                for (int bj = 0; bj < 2; ++bj) { const f32x4 v0 = acc[ai][bj][m][0], v1 = acc[ai][bj][m][1];
                    u32x4 w; w.x = cvt_pk_bf16(v0[0], v0[1]); w.y = cvt_pk_bf16(v0[2], v0[3]); w.z = cvt_pk_bf16(v1[0], v1[1]); w.w = cvt_pk_bf16(v1[2], v1[3]);
                    *(u32x4*)(O + row * 2048 + col0 + bj * HALF) = w; } }
    }
};
template <class Epi, class Sched, bool ALIGN_EPI = false, bool SP2 = false>
__device__ __forceinline__ void gemm_phase(PG8_LAS unsigned char* lds, const Gemm g, const Sched& S, const Epi& E) {
    const int tid = threadIdx.x, wid = __builtin_amdgcn_readfirstlane(tid >> 6), lane = tid & 63, wr = wid >> 2, wc = wid & 3, fr = lane & 15, fq = lane >> 4;
    const int K = g.K, nt = K / BK;
    unsigned voffA[2], voffB[2];
#pragma unroll
    for (int i = 0; i < 2; ++i) { int R, C; stage_rc(tid * 16 + i * 8192, R, C); const int Rb = Epi::PERM ? ((R & ~31) + perm32(R & 31)) : R;
        voffA[i] = (unsigned)(R * K + C) * 2u; voffB[i] = (unsigned)(Rb * K + C) * 2u; }
    const size_t kstep = (size_t)(BK * 2);
    const size_t hstep = (size_t)HALF * K * 2;
    const size_t tstep = 2 * hstep;
    const unsigned ldsw = (unsigned)wid * 1024u;
    const int aoff = lds_byte(wr * 64 + fr, fq * 8), boff = lds_byte(wc * 32 + fr, fq * 8);
#define PG8_SA(b, h) (((b) * 2 + (h)) * HTB)
#define PG8_SB(b, h) ((4 + (b) * 2 + (h)) * HTB)
#define PG8_STAGE(bufoff, gbase, voff) do { _Pragma("unroll") for (int _i = 0; _i < 2; ++_i) \
        __builtin_amdgcn_global_load_lds((const unsigned*)((const char*)(gbase) + (voff)[_i]), (PG8_LAS unsigned*)(lds + (bufoff) + ldsw + _i * 8192), 16, 0, 0); } while (0)
#define PG8_LDA(dst, b, h) do { _Pragma("unroll") for (int m = 0; m < 4; ++m) _Pragma("unroll") for (int k = 0; k < 2; ++k) dst[m][k] = *(const PG8_LAS bf16x8*)(lds + PG8_SA(b, h) + aoff + m * 2048 + k * 1024); } while (0)
#define PG8_LDB(dst, b, h) do { _Pragma("unroll") for (int n = 0; n < 2; ++n) _Pragma("unroll") for (int k = 0; k < 2; ++k) dst[n][k] = *(const PG8_LAS bf16x8*)(lds + PG8_SB(b, h) + boff + n * 2048 + k * 1024); } while (0)
#define PG8_MMA(ai, bj, At, Bt) do { __builtin_amdgcn_s_setprio(1); _Pragma("unroll") for (int m = 0; m < 4; ++m) _Pragma("unroll") for (int n = 0; n < 2; ++n) _Pragma("unroll") for (int k = 0; k < 2; ++k) \
        acc[ai][bj][m][n] = __builtin_amdgcn_mfma_f32_16x16x32_bf16(Bt[n][k], At[m][k], acc[ai][bj][m][n], 0, 0, 0); __builtin_amdgcn_s_setprio(0); } while (0)
#define PG8_WAIT_V(n) asm volatile("s_waitcnt vmcnt(" #n ")" ::: "memory")
#define PG8_WAIT_L(n) asm volatile("s_waitcnt lgkmcnt(" #n ")" ::: "memory")
#define PG8_BAR __builtin_amdgcn_s_barrier()
#define PG8_SCHED __builtin_amdgcn_sched_barrier(0)
    Unit cur, nxt; int ui = 0;
    if (!S.next(0, cur)) return;
    f32x4 acc[2][2][4][2];
    if constexpr (Epi::INIT) E.init(acc, cur, wr, wc, fr, fq);
    else {
#pragma unroll
    for (int a = 0; a < 2; ++a)
#pragma unroll
        for (int b = 0; b < 2; ++b)
#pragma unroll
            for (int m = 0; m < 4; ++m)
#pragma unroll
                for (int n = 0; n < 2; ++n) acc[a][b][m][n] = (f32x4){0.f, 0.f, 0.f, 0.f};
    }
    bf16x8 At[4][2], B0[2][2], B1[2][2];
    const char* cA = (const char*)g.A + (size_t)cur.pm * tstep; const char* cB = (const char*)g.Bt + (size_t)cur.pn * tstep;
    S.a_ready(cur);
    if constexpr (SP2) {
        PG8_STAGE(PG8_SB(0, 0), cB, voffB); PG8_STAGE(PG8_SB(0, 1), cB + hstep, voffB); PG8_STAGE(PG8_SA(0, 0), cA, voffA); PG8_STAGE(PG8_SA(0, 1), cA + hstep, voffA);
        if (wr == 1) PG8_BAR;
        PG8_WAIT_V(2); PG8_BAR;
        PG8_STAGE(PG8_SB(1, 0), cB + kstep, voffB); PG8_STAGE(PG8_SA(1, 0), cA + kstep, voffA); PG8_STAGE(PG8_SB(1, 1), cB + hstep + kstep, voffB);
        PG8_WAIT_V(6); PG8_BAR;
    } else {
        PG8_STAGE(PG8_SB(0, 0), cB, voffB); PG8_STAGE(PG8_SA(0, 0), cA, voffA); PG8_STAGE(PG8_SB(0, 1), cB + hstep, voffB); PG8_STAGE(PG8_SA(0, 1), cA + hstep, voffA);
        if (wr == 1) PG8_BAR;
        PG8_WAIT_V(4); PG8_BAR;
        PG8_STAGE(PG8_SB(1, 0), cB + kstep, voffB); PG8_STAGE(PG8_SA(1, 0), cA + kstep, voffA); PG8_STAGE(PG8_SB(1, 1), cB + hstep + kstep, voffB);
        PG8_WAIT_V(6); PG8_BAR;
    }
    for (;;) {
        const bool has_next = S.next(ui + 1, nxt);
        const char* nA = has_next ? (const char*)g.A + (size_t)nxt.pm * tstep : cA; const char* nB = has_next ? (const char*)g.Bt + (size_t)nxt.pn * tstep : cB;
        for (int t = 0; t < nt; t += 2) {
            if constexpr (Epi::MIDK) { if (t == nt / 2) E.midk(acc, cur, wr, wc, fr, fq); }
            const bool last = (t == nt - 2);
            const char* a1 = cA + (size_t)(t + 1) * kstep;
            const char* a2 = last ? nA : cA + (size_t)(t + 2) * kstep; const char* b2 = last ? nB : cB + (size_t)(t + 2) * kstep;
            const char* a3 = a2 + kstep; const char* b3 = b2 + kstep;
            if (last && has_next) S.a_ready(nxt);
            if constexpr (SP2) {
            PG8_LDB(B0, 0, 0); PG8_LDB(B1, 0, 1); PG8_SCHED; PG8_LDA(At, 0, 0); PG8_STAGE(PG8_SA(1, 1), a1 + hstep, voffA);
            PG8_WAIT_V(8); PG8_WAIT_L(0); PG8_BAR; PG8_MMA(0, 0, At, B0); PG8_MMA(0, 1, At, B1); PG8_BAR; PG8_SCHED;
            PG8_LDA(At, 0, 1); PG8_STAGE(PG8_SB(0, 0), b2, voffB); PG8_STAGE(PG8_SB(0, 1), b2 + hstep, voffB); PG8_STAGE(PG8_SA(0, 0), a2, voffA);
            PG8_WAIT_V(8); PG8_WAIT_L(0); PG8_BAR; PG8_MMA(1, 0, At, B0); PG8_MMA(1, 1, At, B1); PG8_BAR; PG8_SCHED;
            PG8_LDB(B0, 1, 0); PG8_LDB(B1, 1, 1); PG8_SCHED; PG8_LDA(At, 1, 0); PG8_STAGE(PG8_SA(0, 1), a2 + hstep, voffA);
            PG8_WAIT_V(8); PG8_WAIT_L(0); PG8_BAR; PG8_MMA(0, 0, At, B0); PG8_MMA(0, 1, At, B1); PG8_BAR; PG8_SCHED;
            PG8_LDA(At, 1, 1); PG8_STAGE(PG8_SB(1, 0), b3, voffB); PG8_STAGE(PG8_SB(1, 1), b3 + hstep, voffB); PG8_STAGE(PG8_SA(1, 0), a3, voffA);
            PG8_WAIT_V(8); PG8_WAIT_L(0); PG8_BAR; PG8_MMA(1, 0, At, B0); PG8_MMA(1, 1, At, B1); PG8_BAR; PG8_SCHED;
            } else {
            PG8_LDB(B0, 0, 0); PG8_SCHED; PG8_LDA(At, 0, 0); PG8_STAGE(PG8_SA(1, 1), a1 + hstep, voffA);
            PG8_WAIT_L(8); PG8_BAR; PG8_WAIT_L(0); PG8_MMA(0, 0, At, B0); PG8_BAR; PG8_SCHED;
            PG8_LDB(B1, 0, 1); PG8_STAGE(PG8_SB(0, 0), b2, voffB);
            PG8_BAR; PG8_WAIT_L(0); PG8_MMA(0, 1, At, B1); PG8_BAR;
            PG8_LDA(At, 0, 1); PG8_STAGE(PG8_SA(0, 0), a2, voffA);
            PG8_BAR; PG8_WAIT_L(0); PG8_MMA(1, 0, At, B0); PG8_BAR; PG8_SCHED;
            PG8_STAGE(PG8_SB(0, 1), b2 + hstep, voffB);
            PG8_WAIT_V(6); PG8_BAR; PG8_MMA(1, 1, At, B1); PG8_BAR;
            PG8_LDB(B0, 1, 0); PG8_SCHED; PG8_LDA(At, 1, 0); PG8_STAGE(PG8_SA(0, 1), a2 + hstep, voffA);
            PG8_WAIT_L(8); PG8_BAR; PG8_WAIT_L(0); PG8_MMA(0, 0, At, B0); PG8_BAR; PG8_SCHED;
            PG8_LDB(B1, 1, 1); PG8_STAGE(PG8_SB(1, 0), b3, voffB);
            PG8_BAR; PG8_WAIT_L(0); PG8_MMA(0, 1, At, B1); PG8_BAR;
            PG8_LDA(At, 1, 1); PG8_STAGE(PG8_SA(1, 0), a3, voffA);
            PG8_BAR; PG8_WAIT_L(0); PG8_MMA(1, 0, At, B0); PG8_BAR; PG8_SCHED;
            PG8_STAGE(PG8_SB(1, 1), b3 + hstep, voffB);
            PG8_WAIT_V(6); PG8_BAR; PG8_MMA(1, 1, At, B1); PG8_BAR;
            }
        }
        if constexpr (ALIGN_EPI) { if (wr == 0) PG8_BAR; }
        if constexpr (!Epi::AFTER_DRAIN) { E(acc, cur, wr, wc, fr, fq); S.done(cur); }
        if (!has_next) break;
        if constexpr (Epi::INIT) E.init(acc, nxt, wr, wc, fr, fq);
        else {
#pragma unroll
        for (int a = 0; a < 2; ++a)
#pragma unroll
            for (int b = 0; b < 2; ++b)
#pragma unroll
                for (int m = 0; m < 4; ++m)
#pragma unroll
                    for (int n = 0; n < 2; ++n) acc[a][b][m][n] = (f32x4){0.f, 0.f, 0.f, 0.f};
        }
        cur = nxt; cA = nA; cB = nB; ++ui;
        if constexpr (ALIGN_EPI) { if (wr == 1) PG8_BAR; }
    }
    PG8_WAIT_V(0);
    if constexpr (!ALIGN_EPI) { if (wr == 0) PG8_BAR; }
    PG8_BAR;
    if constexpr (Epi::AFTER_DRAIN) { E.fused(acc, cur, wr, wc, fr, fq, lds, wid, lane); S.done(cur); }
#undef PG8_SA
#undef PG8_SB
#undef PG8_STAGE
#undef PG8_LDA
#undef PG8_LDB
#undef PG8_MMA
#undef PG8_WAIT_V
#undef PG8_WAIT_L
#undef PG8_BAR
#undef PG8_SCHED
}
}
#define XB_TMO      128
#define XB_XCNT(j)  (256  + 64 * (j))
#define XB_XSUB(j)  (1280 + 64 * (j))
#define XB_XGEN(j)  (2304 + 64 * (j))
#define XB_TOP      3328
#define XB_TOPGEN   3392
#define XCD_BAR_WORDS 3456
#define XB_SPIN_CAP (1u << 18)

__device__ __forceinline__ unsigned xb_ld(unsigned* p)              { return __hip_atomic_load(p, __ATOMIC_RELAXED, __HIP_MEMORY_SCOPE_AGENT); }
__device__ __forceinline__ unsigned xb_add(unsigned* p, unsigned v) { return __hip_atomic_fetch_add(p, v, __ATOMIC_RELAXED, __HIP_MEMORY_SCOPE_AGENT); }
__device__ __forceinline__ unsigned xb_xcc_id() { return (unsigned)__builtin_amdgcn_s_getreg((3 << 11) | 20) & 0xFu; }
#define XB_SPIN(cond, bar) do { unsigned _sp = 0; while (cond) { __builtin_amdgcn_s_sleep(1); \
    if ((++_sp & 255u) == 0u) { if (xb_ld(&(bar)[XB_TMO])) break; if (_sp > XB_SPIN_CAP) { atomicAdd(&(bar)[XB_TMO], 1u); break; } } } } while (0)

struct XcdBarrier {
    unsigned* bar; unsigned x;
    volatile LAS unsigned* st;
};

__device__ __forceinline__ XcdBarrier xcd_barrier_post(unsigned* bar, volatile LAS unsigned* st) {
    XcdBarrier b; b.bar = bar; b.x = xb_xcc_id(); b.st = st;
    if (threadIdx.x == 0) (void)xb_add(&bar[XB_XCNT(b.x)], 1u);
    return b;
}
__device__ __forceinline__ void xcd_barrier_complete(unsigned* bar, unsigned x, unsigned& nloc, unsigned& nx) {
    const unsigned G = gridDim.x * gridDim.y * gridDim.z;
    unsigned sum, cnt, mine, sp = 0u;
    for (;;) {
        sum = 0u; cnt = 0u; mine = 0u;
#pragma unroll
        for (unsigned j = 0; j < 16; ++j) { const unsigned c = xb_ld(&bar[XB_XCNT(j)]); sum += c; cnt += (c > 0u) ? 1u : 0u; mine = (j == x) ? c : mine; }
        if (sum == G) break;
        __builtin_amdgcn_s_sleep(1);
        if ((++sp & 255u) == 0u) { if (xb_ld(&bar[XB_TMO])) break; if (sp > XB_SPIN_CAP) { atomicAdd(&bar[XB_TMO], 1u); break; } }
    }
    nloc = mine > 0u ? mine : 1u; nx = cnt > 0u ? cnt : 1u;
}

__device__ __forceinline__ void xcd_barrier(const XcdBarrier& b) {
    asm volatile("s_waitcnt vmcnt(0)" ::: "memory");
    __syncthreads();
    if (threadIdx.x == 0) {
        unsigned* bar = b.bar;
        __builtin_amdgcn_s_waitcnt(0);
        unsigned nloc = b.st[0], nx = b.st[1];
        if (nloc == 0u) { xcd_barrier_complete(bar, b.x, nloc, nx); b.st[0] = nloc; b.st[1] = nx; }
        const unsigned old = xb_add(&bar[XB_XSUB(b.x)], 1u);
        const unsigned gen = old / nloc;
        if (old + 1u == (gen + 1u) * nloc) {
            __builtin_amdgcn_fence(__ATOMIC_RELEASE, "agent");
            asm volatile("s_waitcnt vmcnt(0)" ::: "memory");
            const unsigned og = xb_add(&bar[XB_TOP], 1u);
            const unsigned tg = og / nx;
            if (og + 1u == (tg + 1u) * nx) xb_add(&bar[XB_TOPGEN], 1u);
            else XB_SPIN(xb_ld(&bar[XB_TOPGEN]) == tg, bar);
            __builtin_amdgcn_fence(__ATOMIC_ACQUIRE, "agent");
            xb_add(&bar[XB_XGEN(b.x)], 1u);
            asm volatile("s_waitcnt vmcnt(0)" ::: "memory");
        } else {
            XB_SPIN(xb_ld(&bar[XB_XGEN(b.x)]) == gen, bar);
            __builtin_amdgcn_fence(__ATOMIC_ACQUIRE, "agent");
            asm volatile("s_waitcnt vmcnt(0)" ::: "memory");
        }
    }
    __syncthreads();
}

constexpr int NWAVES = 8;
constexpr size_t MiB = 1u << 20;
constexpr size_t WS_CTL = 0, CTL_ZERO_BYTES = 1 * MiB;
constexpr size_t WS_W1T = 2 * MiB;
constexpr size_t WS_W2T = 16 * MiB;
constexpr size_t WS_W3T = 24 * MiB;
constexpr size_t WS_SKB = 32 * MiB;
constexpr size_t WS_RSTD1 = 33 * MiB;
constexpr size_t WS_SSA = 34 * MiB;
constexpr size_t WS_SSL = 35 * MiB;
constexpr size_t WS_SS2 = 37 * MiB;
constexpr size_t WS_RSTD2 = 39 * MiB;
constexpr size_t WS_IDS = 40 * MiB;
constexpr size_t WS_GW = 48 * MiB;
constexpr size_t WS_U8 = 64 * MiB;
constexpr size_t WS_V8 = 96 * MiB;
constexpr size_t WS_X8 = 128 * MiB;
constexpr size_t WS_SX = 160 * MiB;
constexpr size_t WS_SCU = 162 * MiB;
constexpr size_t WS_SCV = 163 * MiB;
constexpr size_t WS_WSUM = 164 * MiB;
constexpr size_t WS_A1 = 192 * MiB;
constexpr size_t WS_Q = 258 * MiB;
constexpr size_t WS_KV = 290 * MiB;
constexpr size_t WS_XB = 299 * MiB;
constexpr size_t WS_GT = 332 * MiB;
constexpr size_t WS_H1 = 364 * MiB;
constexpr size_t WS_PART = 192 * MiB;
constexpr size_t WS_W = 56 * MiB;
constexpr size_t WS_Z = 428 * MiB;
constexpr size_t WS_END = 492 * MiB;
constexpr int CW_QROW = 2048;
constexpr int CW_BAR = 4096;

constexpr int RING_OFF = 0, RING_BYTES = 131072;
constexpr int LDSCTL_OFF = RING_BYTES, MISC_OFF = LDSCTL_OFF + 320;
constexpr int LDS_BYTES = 147456;

typedef unsigned short bf16;
typedef unsigned v4u __attribute__((ext_vector_type(4)));
typedef float f32x4 __attribute__((ext_vector_type(4)));
typedef short bf16x8 __attribute__((ext_vector_type(8)));
typedef GAS unsigned gu32;
#define RLX_AGENT __ATOMIC_RELAXED, __HIP_MEMORY_SCOPE_AGENT
#define LDS_WAIT() asm volatile("s_waitcnt lgkmcnt(0)" ::: "memory")
#define VM_WAIT() asm volatile("s_waitcnt vmcnt(0)" ::: "memory")
__device__ __forceinline__ unsigned f2bf(float f) { unsigned u = __builtin_bit_cast(unsigned, f); return (u + 0x7fffu + ((u >> 16) & 1u)) >> 16; }
__device__ __forceinline__ unsigned pk2(float lo, float hi) { return f2bf(lo) | (f2bf(hi) << 16); }
__device__ __forceinline__ float bf2f(unsigned short b) { return __builtin_bit_cast(float, (unsigned)b << 16); }


namespace p2 {
typedef float f32x16 __attribute__((ext_vector_type(16)));
typedef unsigned u32x2 __attribute__((ext_vector_type(2)));
constexpr float LOG2E = 1.4426950408889634f;
constexpr float NEGBIG = -1e30f;
__device__ __forceinline__ int crow(int r, int hi) { return (r & 3) + 8 * (r >> 2) + 4 * hi; }
__device__ __forceinline__ unsigned cvtpk(float lo, float hi) { unsigned r; asm volatile("v_cvt_pk_bf16_f32 %0, %1, %2" : "=v"(r) : "v"(lo), "v"(hi)); return r; }
__device__ __forceinline__ float ex2(float x) { return __builtin_amdgcn_exp2f(x); }
__device__ __forceinline__ float rcp(float x) { return __builtin_amdgcn_rcpf(x); }
__device__ __forceinline__ float gelu_fast(float x) { return x * rcp(1.0f + ex2(x * (-2.302208198f - 0.102943240f * (x * x)))); }

constexpr int A_KS = 0, A_KSP = 144, A_VT = 288 * 144, A_VTP = 584, A_ST = A_VT + 64 * 584, A_END = A_ST + 8 * 4096;
__device__ __forceinline__ void attn_unit(LAS unsigned char* lds, int b, int qblk, int kvh, const bf16* QB, const bf16* KVB, const float* sinks, bf16* MIX, float* SSA, int tid) {
    const int lane = tid & 63, wave = __builtin_amdgcn_readfirstlane(tid >> 6), r = lane & 31, hi = lane >> 5;
    const int q0 = qblk * 128, hq = kvh * 8 + wave;
    for (int it = 0; it < 5; ++it) {
        const int cid = it * 512 + tid;
        if (cid < 288 * 8) {
            const int key = cid >> 3, ch = cid & 7;
            bool valid; size_t row = 0;
            if (key < 256) { const int pos = q0 - 128 + key; valid = pos >= 0; row = (size_t)b * SEQ + pos; }
            else if (key < 272) { valid = true; row = (size_t)MREAL + (key - 256); }
            else valid = false;
            v4u kv = {0u, 0u, 0u, 0u}, vv = {0u, 0u, 0u, 0u};
            if (valid) { kv = *(const GAS v4u*)(KVB + row * 256 + kvh * 64 + ch * 8); vv = *(const GAS v4u*)(KVB + row * 256 + 128 + kvh * 64 + ch * 8); }
            *(LAS v4u*)(lds + A_KS + key * A_KSP + ch * 16) = kv;
            LAS unsigned short* vt = (LAS unsigned short*)(lds + A_VT);
#pragma unroll
            for (int j = 0; j < 8; ++j) { const unsigned wv = vv[j >> 1]; vt[(ch * 8 + j) * (A_VTP / 2) + key] = (unsigned short)((j & 1) ? (wv >> 16) : (wv & 0xffffu)); }
        }
    }
    __syncthreads();
    const float sink2 = sinks[hq] * LOG2E;
    bf16x8 qf[4];
#pragma unroll
    for (int ks = 0; ks < 4; ++ks) qf[ks] = *(const GAS bf16x8*)(QB + ((size_t)b * SEQ + q0 + r) * 1024 + hq * 64 + ks * 16 + hi * 8);
    for (int qg = 0; qg < 4; ++qg) {
        f32x16 s[6];
#pragma unroll
        for (int t = 0; t < 6; ++t) {
            const int kbase = t < 5 ? 32 * (qg + t) : 256;
            f32x16 acc = {0.f, 0.f, 0.f, 0.f, 0.f, 0.f, 0.f, 0.f, 0.f, 0.f, 0.f, 0.f, 0.f, 0.f, 0.f, 0.f};
#pragma unroll
            for (int ks = 0; ks < 4; ++ks) {
                const bf16x8 kf = *(const LAS bf16x8*)(lds + A_KS + (kbase + r) * A_KSP + ks * 32 + hi * 16);
                acc = __builtin_amdgcn_mfma_f32_32x32x16_bf16(kf, qf[ks], acc, 0, 0, 0);
            }
            s[t] = acc;
        }
        if (qg + 1 < 4) {
#pragma unroll
            for (int ks = 0; ks < 4; ++ks) qf[ks] = *(const GAS bf16x8*)(QB + ((size_t)b * SEQ + q0 + 32 * (qg + 1) + r) * 1024 + hq * 64 + ks * 16 + hi * 8);
        }
        const bool blk0 = (qblk == 0);
#pragma unroll
        for (int reg = 0; reg < 16; ++reg) {
            const int j = crow(reg, hi);
            s[0][reg] = (j > r) ? s[0][reg] : NEGBIG;
            s[4][reg] = (j <= r) ? s[4][reg] : NEGBIG;
            s[5][reg] = (j < 16) ? s[5][reg] : NEGBIG;
        }
#pragma unroll
        for (int t = 0; t < 4; ++t) if (blk0 && (qg + t < 4)) {
#pragma unroll
            for (int reg = 0; reg < 16; ++reg) s[t][reg] = NEGBIG;
        }
        float m = sink2;
#pragma unroll
        for (int t = 0; t < 6; ++t)
#pragma unroll
            for (int reg = 0; reg < 16; ++reg) m = fmaxf(m, s[t][reg]);
        m = max_x32(m);
        float l = 0.f;
#pragma unroll
        for (int t = 0; t < 6; ++t)
#pragma unroll
            for (int reg = 0; reg < 16; ++reg) { const float p = ex2(s[t][reg] - m); s[t][reg] = p; l += p; }
        l = sum_x32(l);
        l += ex2(sink2 - m);
        const float linv = 1.0f / l;
        f32x16 o0 = {0.f, 0.f, 0.f, 0.f, 0.f, 0.f, 0.f, 0.f, 0.f, 0.f, 0.f, 0.f, 0.f, 0.f, 0.f, 0.f}, o1 = o0;
#pragma unroll
        for (int t = 0; t < 6; ++t) {
            const int kbase = t < 5 ? 32 * (qg + t) : 256;
#pragma unroll
            for (int ss = 0; ss < 2; ++ss) {
                v4u pw; pw.x = cvtpk(s[t][8 * ss + 0], s[t][8 * ss + 1]); pw.y = cvtpk(s[t][8 * ss + 2], s[t][8 * ss + 3]);
                pw.z = cvtpk(s[t][8 * ss + 4], s[t][8 * ss + 5]); pw.w = cvtpk(s[t][8 * ss + 6], s[t][8 * ss + 7]);
                const bf16x8 pa = __builtin_bit_cast(bf16x8, pw);
                const int ko = (kbase + 16 * ss + 4 * hi) * 2;
                {   const u32x2 lo = *(const LAS u32x2*)(lds + A_VT + r * A_VTP + ko), h2 = *(const LAS u32x2*)(lds + A_VT + r * A_VTP + ko + 16);
                    v4u vw; vw.x = lo.x; vw.y = lo.y; vw.z = h2.x; vw.w = h2.y;
                    o0 = __builtin_amdgcn_mfma_f32_32x32x16_bf16(pa, __builtin_bit_cast(bf16x8, vw), o0, 0, 0, 0); }
                {   const u32x2 lo = *(const LAS u32x2*)(lds + A_VT + (32 + r) * A_VTP + ko), h2 = *(const LAS u32x2*)(lds + A_VT + (32 + r) * A_VTP + ko + 16);
                    v4u vw; vw.x = lo.x; vw.y = lo.y; vw.z = h2.x; vw.w = h2.y;
                    o1 = __builtin_amdgcn_mfma_f32_32x32x16_bf16(pa, __builtin_bit_cast(bf16x8, vw), o1, 0, 0, 0); }
            }
        }
        LAS unsigned short* stg = (LAS unsigned short*)(lds + A_ST + wave * 4096);
#pragma unroll
        for (int reg = 0; reg < 16; ++reg) {
            const int qr = crow(reg, hi); const float li = __shfl(linv, qr);
            stg[qr * 64 + r] = (unsigned short)f2bf(o0[reg] * li);
            stg[qr * 64 + 32 + r] = (unsigned short)f2bf(o1[reg] * li);
        }
        asm volatile("s_waitcnt lgkmcnt(0)" ::: "memory");
#pragma unroll
        for (int i = 0; i < 4; ++i) {
            const int row = i * 8 + (lane >> 3), ch = lane & 7;
            const v4u v = *(const LAS v4u*)(stg + row * 64 + ch * 8);
            float ss = 0.f;
#pragma unroll
            for (int k = 0; k < 4; ++k) { const float a = __builtin_bit_cast(float, v[k] << 16), c = __builtin_bit_cast(float, v[k] & 0xffff0000u); ss += a * a + c * c; }
            ss = sum8(ss);
            const size_t orow = (size_t)b * SEQ + q0 + 32 * qg + row;
            *(GAS v4u*)(MIX + orow * D + hq * 64 + ch * 8) = v;
            if (ch == 0) SSA[orow * 16 + hq] = ss;
        }
        asm volatile("s_waitcnt lgkmcnt(0)" ::: "memory");
    }
    __syncthreads();
}

constexpr int LW_XS = 0, LW_GS = 4608, LW_XC = LW_GS + 2048, LW_XCF = LW_XC + 4608, LW_BYTES = LW_XCF + 4096 + 128;
constexpr int L_CT = 8 * LW_BYTES, L_END = L_CT + 2 * 2048;
static_assert(L_END <= 131072, "lru lds");
struct LruP { const float *conv_w, *conv_b, *w_r, *b_r, *w_i, *b_i, *lam; };
__device__ __forceinline__ void lru_unit(LAS unsigned char* lds, LAS unsigned char* ldsw  , int b, int nb, int cg, const bf16* XBB, const bf16* GTB, const LruP P, bf16* MIX, float* SSL, int tid) {
    const int lane = tid & 63, wave = __builtin_amdgcn_readfirstlane(tid >> 6), r = lane & 31, hi = lane >> 5;
    LAS unsigned char* lw = lds + wave * LW_BYTES;
    {
        LAS unsigned short* wt = (LAS unsigned short*)ldsw;
#pragma unroll
        for (int i = 0; i < 4; ++i) {
            const int e = tid + 512 * i, c = e >> 5, dl = e & 31;
            const size_t gi = (size_t)(nb * 64 + c) * 64 + 32 * cg + dl;
            wt[dl * 72 + c] = (unsigned short)f2bf(-LOG2E * P.w_r[gi]);
            wt[32 * 72 + dl * 72 + c] = (unsigned short)f2bf(-LOG2E * P.w_i[gi]);
        }
    }
    const int cc = lane, chc = nb * 64 + cc;
    const float cw0 = P.conv_w[0 * LW + chc], cw1 = P.conv_w[1 * LW + chc], cw2 = P.conv_w[2 * LW + chc], cw3 = P.conv_w[3 * LW + chc], cbv = P.conv_b[chc];
    const int chd = nb * 64 + 32 * cg + r;
    const float br = -LOG2E * P.b_r[chd], bi = -LOG2E * P.b_i[chd];
    const float ls8 = -8.0f * log1pf(expf(-P.lam[chd])) * LOG2E;
    float state = 0.f;
    v4u px[5], pg[2];
#define LRU_PREFETCH(tl) do { \
        _Pragma("unroll") for (int it = 0; it < 5; ++it) { const int cid = it * 64 + lane; px[it] = (v4u){0u, 0u, 0u, 0u}; \
            if (cid < 35 * 8) { const int j = cid >> 3, ch = cid & 7, t = 32 * wave + j - 3; bool valid; size_t row = 0; \
                if ((tl) == 0) { valid = (t >= 0 && t < NMETA); row = (size_t)MREAL + t; } \
                else if ((tl) == 1 && t < 0) { valid = true; row = (size_t)MREAL + NMETA + t; } \
                else { valid = true; row = (size_t)b * SEQ + 256 * ((tl) - 1) + t; } \
                if (valid) px[it] = *(const GAS v4u*)(XBB + row * 1024 + nb * 64 + ch * 8); } } \
        if ((tl) > 0) { _Pragma("unroll") for (int it = 0; it < 2; ++it) { const int cid = it * 64 + lane, t = 32 * wave + (cid >> 2), ch = cid & 3; \
            pg[it] = *(const GAS v4u*)(GTB + ((size_t)b * SEQ + 256 * ((tl) - 1) + t) * 1024 + nb * 64 + 32 * cg + ch * 8); } } } while (0)
    LRU_PREFETCH(0);
    __syncthreads();
    for (int tile = 0; tile < 9; ++tile) {
#pragma unroll
        for (int it = 0; it < 5; ++it) { const int cid = it * 64 + lane; if (cid < 35 * 8) *(LAS v4u*)(lw + LW_XS + (cid >> 3) * 128 + (cid & 7) * 16) = px[it]; }
        if (tile > 0) {
#pragma unroll
            for (int it = 0; it < 2; ++it) { const int cid = it * 64 + lane; *(LAS v4u*)(lw + LW_GS + (cid >> 2) * 64 + (cid & 3) * 16) = pg[it]; }
        }
        asm volatile("s_waitcnt lgkmcnt(0)" ::: "memory");
        if (tile + 1 < 9) LRU_PREFETCH(tile + 1);
        {
            const LAS unsigned short* xs = (const LAS unsigned short*)(lw + LW_XS);
            LAS unsigned short* xc = (LAS unsigned short*)(lw + LW_XC);
            LAS float* xcf = (LAS float*)(lw + LW_XCF);
            const bool own = (cc >> 5) == cg; const int xoff = own ? (cc & 31) : 32 * 32 + (cc & 31);
            float x0 = bf2f(xs[0 * 64 + cc]), x1 = bf2f(xs[1 * 64 + cc]), x2 = bf2f(xs[2 * 64 + cc]);
#pragma unroll 8
            for (int k = 0; k < 32; ++k) {
                const float x3 = bf2f(xs[(k + 3) * 64 + cc]);
                const float v = cbv + cw0 * x0 + cw1 * x1 + cw2 * x2 + cw3 * x3;
                xc[k * 72 + cc] = (unsigned short)cvtpk(v, v);
                xcf[(own ? k * 32 : 0) + xoff] = v;
                x0 = x1; x1 = x2; x2 = x3;
            }
        }
        asm volatile("s_waitcnt lgkmcnt(0)" ::: "memory");
        f32x16 aR = {br, br, br, br, br, br, br, br, br, br, br, br, br, br, br, br}, aI = {bi, bi, bi, bi, bi, bi, bi, bi, bi, bi, bi, bi, bi, bi, bi, bi};
#pragma unroll
        for (int ks = 0; ks < 4; ++ks) {
            const bf16x8 xa = *(const LAS bf16x8*)(lw + LW_XC + r * 144 + ks * 32 + hi * 16);
            const bf16x8 wr_ = *(const LAS bf16x8*)(ldsw + r * 144 + ks * 32 + hi * 16);
            const bf16x8 wi_ = *(const LAS bf16x8*)(ldsw + 32 * 144 + r * 144 + ks * 32 + hi * 16);
            aR = __builtin_amdgcn_mfma_f32_32x32x16_bf16(xa, wr_, aR, 0, 0, 0);
            aI = __builtin_amdgcn_mfma_f32_32x32x16_bf16(xa, wi_, aI, 0, 0, 0);
        }
        float Av[16], Bv[16];
        {
            const LAS float* xcf = (const LAS float*)(lw + LW_XCF);
#pragma unroll
            for (int reg = 0; reg < 16; ++reg) {
                const int tl = crow(reg, hi), t = 32 * wave + tl;
                const bool valid = (tile > 0) || (t < NMETA);
                const float rg = rcp(1.0f + ex2(aR[reg]));
                const float ig = rcp(1.0f + ex2(aI[reg]));
                const float a = ex2(rg * ls8);
                const float mult = __builtin_amdgcn_sqrtf(fmaxf(1.0f - a * a, 0.f));
                const float bx = mult * ig * xcf[tl * 32 + r];
                Av[reg] = valid ? a : 1.0f; Bv[reg] = valid ? bx : 0.0f;
            }
        }
#pragma unroll
        for (int g = 0; g < 4; ++g) {
#pragma unroll
            for (int k = 1; k < 4; ++k) { Bv[4 * g + k] = Av[4 * g + k] * Bv[4 * g + k - 1] + Bv[4 * g + k]; Av[4 * g + k] = Av[4 * g + k] * Av[4 * g + k - 1]; }
        }
        float myCz[4], myCp[4], PW, HW;
        {
            float cz = 0.f, cp = 1.f;
#pragma unroll
            for (int g = 0; g < 4; ++g) {
                const float mP = Av[4 * g + 3], mH = Bv[4 * g + 3];
                const float oP = __shfl_xor(mP, 32), oH = __shfl_xor(mH, 32);
                const float eP = hi ? oP : mP, eH = hi ? oH : mH, dP = hi ? mP : oP, dH = hi ? mH : oH;
                const float cz0 = cz, cp0 = cp;
                cz = eP * cz + eH; cp = cp * eP;
                myCz[g] = hi ? cz : cz0; myCp[g] = hi ? cp : cp0;
                cz = dP * cz + dH; cp = cp * dP;
            }
            PW = cp; HW = cz;
        }
        LAS float* ct = (LAS float*)(lds + L_CT + (tile & 1) * 2048);
        if (hi == 0) { ct[(wave * 32 + r) * 2] = PW; ct[(wave * 32 + r) * 2 + 1] = HW; }
        __syncthreads();
        float cin = 0.f;
        {
            float c = state;
#pragma unroll
            for (int w2 = 0; w2 < 8; ++w2) { if (w2 == wave) cin = c; c = ct[(w2 * 32 + r) * 2] * c + ct[(w2 * 32 + r) * 2 + 1]; }
            state = c;
        }
        if (tile > 0) {
            const LAS unsigned short* gs = (const LAS unsigned short*)(lw + LW_GS);
            LAS unsigned short* os = (LAS unsigned short*)(lw + LW_XS);
#pragma unroll
            for (int reg = 0; reg < 16; ++reg) {
                const int g = reg >> 2, tl = crow(reg, hi);
                const float h = Bv[reg] + Av[reg] * (myCz[g] + myCp[g] * cin);
                const float gt = bf2f(gs[tl * 32 + r]);
                { const float ov = gelu_fast(gt) * h; os[tl * 32 + r] = (unsigned short)cvtpk(ov, ov); }
            }
            asm volatile("s_waitcnt lgkmcnt(0)" ::: "memory");
#pragma unroll
            for (int it = 0; it < 2; ++it) {
                const int cid = it * 64 + lane, tl = cid >> 2, ch = cid & 3;
                const v4u v = *(const LAS v4u*)(lw + LW_XS + tl * 64 + ch * 16);
                float ss = 0.f;
#pragma unroll
                for (int k = 0; k < 4; ++k) { const float a = __builtin_bit_cast(float, v[k] << 16), c = __builtin_bit_cast(float, v[k] & 0xffff0000u); ss += a * a + c * c; }
                ss = sum4(ss);
                const size_t row = (size_t)b * SEQ + 256 * (tile - 1) + 32 * wave + tl;
                *(GAS v4u*)(MIX + row * D + 1024 + nb * 64 + 32 * cg + ch * 8) = v;
                if (ch == 0) SSL[row * 32 + nb * 2 + cg] = ss;
            }
            asm volatile("s_waitcnt lgkmcnt(0)" ::: "memory");
        }
    }
#undef LRU_PREFETCH
    __syncthreads();
}
}

namespace p5 {
typedef float f32x16 __attribute__((ext_vector_type(16)));
constexpr int KP = 272;
constexpr int R_KEYS = 0, R_IDX = 256 * KP, R_END = R_IDX + 8 * 1024;
__device__ __forceinline__ int crow(int r, int hi) { return (r & 3) + 8 * (r >> 2) + 4 * hi; }
__device__ __forceinline__ float fkey(float s, int mask, int payload) { return __builtin_bit_cast(float, (__builtin_bit_cast(int, s) & mask) | payload); }
__device__ __forceinline__ int fbits(float f) { return __builtin_bit_cast(int, f); }
__device__ __forceinline__ float fval(float f, int mask) { return __builtin_bit_cast(float, __builtin_bit_cast(int, f) & mask); }
__device__ __forceinline__ void ins16(float (&L)[16], float v) {
#pragma unroll
    for (int k = 15; k >= 1; --k) L[k] = __builtin_amdgcn_fmed3f(L[k - 1], L[k], v);
    L[0] = fmaxf(L[0], v);
}
#define P5_CE(a, b) do { const float hi_ = fmaxf(a, b), lo_ = fminf(a, b); a = hi_; b = lo_; } while (0)
#define P5_SORT16(X) do { P5_CE(X[0], X[1]); P5_CE(X[2], X[3]); P5_CE(X[0], X[2]); P5_CE(X[1], X[3]); P5_CE(X[1], X[2]); P5_CE(X[4], X[5]); P5_CE(X[6], X[7]); P5_CE(X[4], X[6]); P5_CE(X[5], X[7]); P5_CE(X[5], X[6]); P5_CE(X[0], X[4]); P5_CE(X[2], X[6]); P5_CE(X[2], X[4]); P5_CE(X[1], X[5]); P5_CE(X[3], X[7]); P5_CE(X[3], X[5]); P5_CE(X[1], X[2]); P5_CE(X[3], X[4]); P5_CE(X[5], X[6]); P5_CE(X[8], X[9]); P5_CE(X[10], X[11]); P5_CE(X[8], X[10]); P5_CE(X[9], X[11]); P5_CE(X[9], X[10]); P5_CE(X[12], X[13]); P5_CE(X[14], X[15]); P5_CE(X[12], X[14]); P5_CE(X[13], X[15]); P5_CE(X[13], X[14]); P5_CE(X[8], X[12]); P5_CE(X[10], X[14]); P5_CE(X[10], X[12]); P5_CE(X[9], X[13]); P5_CE(X[11], X[15]); P5_CE(X[11], X[13]); P5_CE(X[9], X[10]); P5_CE(X[11], X[12]); P5_CE(X[13], X[14]); P5_CE(X[0], X[8]); P5_CE(X[4], X[12]); P5_CE(X[4], X[8]); P5_CE(X[2], X[10]); P5_CE(X[6], X[14]); P5_CE(X[6], X[10]); P5_CE(X[2], X[4]); P5_CE(X[6], X[8]); P5_CE(X[10], X[12]); P5_CE(X[1], X[9]); P5_CE(X[5], X[13]); P5_CE(X[5], X[9]); P5_CE(X[3], X[11]); P5_CE(X[7], X[15]); P5_CE(X[7], X[11]); P5_CE(X[3], X[5]); P5_CE(X[7], X[9]); P5_CE(X[11], X[13]); P5_CE(X[1], X[2]); P5_CE(X[3], X[4]); P5_CE(X[5], X[6]); P5_CE(X[7], X[8]); P5_CE(X[9], X[10]); P5_CE(X[11], X[12]); P5_CE(X[13], X[14]); } while (0)
#define P5_BMERGE16(X) do { P5_CE(X[0], X[8]); P5_CE(X[1], X[9]); P5_CE(X[2], X[10]); P5_CE(X[3], X[11]); P5_CE(X[4], X[12]); P5_CE(X[5], X[13]); P5_CE(X[6], X[14]); P5_CE(X[7], X[15]); P5_CE(X[0], X[4]); P5_CE(X[1], X[5]); P5_CE(X[2], X[6]); P5_CE(X[3], X[7]); P5_CE(X[8], X[12]); P5_CE(X[9], X[13]); P5_CE(X[10], X[14]); P5_CE(X[11], X[15]); P5_CE(X[0], X[2]); P5_CE(X[1], X[3]); P5_CE(X[4], X[6]); P5_CE(X[5], X[7]); P5_CE(X[8], X[10]); P5_CE(X[9], X[11]); P5_CE(X[12], X[14]); P5_CE(X[13], X[15]); P5_CE(X[0], X[1]); P5_CE(X[2], X[3]); P5_CE(X[4], X[5]); P5_CE(X[6], X[7]); P5_CE(X[8], X[9]); P5_CE(X[10], X[11]); P5_CE(X[12], X[13]); P5_CE(X[14], X[15]); } while (0)
#define P5_TOP16(A, B) do { _Pragma("unroll") for (int i_ = 0; i_ < 16; ++i_) A[i_] = fmaxf(A[i_], B[15 - i_]); P5_BMERGE16(A); } while (0)
#define P5_KEYS(G, ACC, KT) do { _Pragma("unroll") for (int reg = 0; reg < 16; ++reg) G[reg] = fkey(ACC[reg], (int)0xffffff80, (127 - 32 * (KT) - (reg & 3) - 8 * (reg >> 2)) - h4); } while (0)
__device__ __forceinline__ void score_tile(f32x16& acc, const LAS unsigned char* keys, const bf16x8 (&qf)[8], int kt, int r, int hi) {
    acc = (f32x16){0.f, 0.f, 0.f, 0.f, 0.f, 0.f, 0.f, 0.f, 0.f, 0.f, 0.f, 0.f, 0.f, 0.f, 0.f, 0.f};
#pragma unroll
    for (int ks = 0; ks < 8; ++ks) {
        const bf16x8 kf = *(const LAS bf16x8*)(keys + (kt * 32 + r) * KP + ks * 32 + hi * 16);
        acc = __builtin_amdgcn_mfma_f32_32x32x16_bf16(kf, qf[ks], acc, 0, 0, 0);
    }
}
__device__ __forceinline__ void half_top16(const LAS unsigned char* keys, const bf16x8 (&qf)[8], int r, int hi, float (&T)[16]) {
    const int h4 = 4 * hi;
    f32x16 acc;
    float A[16], B[16];
    score_tile(acc, keys, qf, 0, r, hi); P5_KEYS(A, acc, 0); P5_SORT16(A);
    score_tile(acc, keys, qf, 1, r, hi); P5_KEYS(B, acc, 1); P5_SORT16(B);
    P5_TOP16(A, B);
    float C[16];
    score_tile(acc, keys, qf, 2, r, hi); P5_KEYS(C, acc, 2); P5_SORT16(C);
    score_tile(acc, keys, qf, 3, r, hi); P5_KEYS(B, acc, 3); P5_SORT16(B);
    P5_TOP16(C, B);
    P5_TOP16(A, C);
#pragma unroll
    for (int i = 0; i < 16; ++i) B[i] = __shfl_xor(A[15 - i], 32);
#pragma unroll
    for (int i = 0; i < 16; ++i) A[i] = fmaxf(A[i], B[i]);
    P5_BMERGE16(A);
#pragma unroll
    for (int i = 0; i < 16; ++i) T[i] = A[i];
}

__device__ __forceinline__ void retr_unit(LAS unsigned char* lds, int h, int tg, const bf16* QPB, const bf16* SKB, unsigned short* IDS, float* GW, const float* RSTD2, int tid) {
    const int lane = tid & 63, wave = __builtin_amdgcn_readfirstlane(tid >> 6), r = lane & 31, hi = lane >> 5;
#pragma unroll
    for (int it = 0; it < 8; ++it) {
        const int cid = it * 512 + tid, row = cid >> 4, ch = cid & 15;
        *(LAS v4u*)(lds + R_KEYS + row * KP + ch * 16) = *(const GAS v4u*)(SKB + ((size_t)h * 256 + row) * 128 + ch * 8);
    }
    const size_t tok = (size_t)tg * 256 + wave * 32 + r;
    bf16x8 qa[8], qb[8];
#pragma unroll
    for (int ks = 0; ks < 8; ++ks) { qa[ks] = *(const GAS bf16x8*)(QPB + tok * D + h * 256 + ks * 16 + hi * 8); qb[ks] = *(const GAS bf16x8*)(QPB + tok * D + h * 256 + 128 + ks * 16 + hi * 8); }
    const float rs = RSTD2[tok];
    __syncthreads();
    float TA[16], TB[16];
    half_top16(lds + R_KEYS, qa, r, hi, TA);
    half_top16(lds + R_KEYS + 128 * KP, qb, r, hi, TB);
    LAS unsigned char* sc = lds + R_IDX + wave * 1024 + r * 32;
    const int hm = -hi;
    {
        v4u w;
#pragma unroll
        for (int q = 0; q < 4; ++q) { unsigned x = 0;
#pragma unroll
            for (int k = 0; k < 4; ++k) { const int t = (fbits(TB[4 * q + k]) & hm) | (fbits(TA[4 * q + k]) & ~hm); x |= (unsigned)(127 - (t & 0x7f)) << (8 * k); }
            w[q] = x; }
        *(LAS v4u*)(sc + hi * 16) = w;
    }
    float sA[16], sB[16];
#pragma unroll
    for (int i = 0; i < 16; ++i) { sA[i] = fval(TA[i], (int)0xffffff80); sB[i] = fval(TB[i], (int)0xffffff80); }
#define P5_K(i, j) fkey(sA[i] + sB[j], (int)0xffffff00, 255 - ((i) * 16 + (j)))
    float L[16], X[16];
#pragma unroll
    for (int j = 0; j < 16; ++j) L[j] = P5_K(0, j);
#pragma unroll
    for (int j = 0; j < 8; ++j) { X[j] = P5_K(1, j); X[8 + j] = P5_K(15 - j, 0); }
    P5_BMERGE16(X);
    P5_TOP16(L, X);
    X[0] = P5_K(2, 0); X[1] = P5_K(2, 1); X[2] = P5_K(2, 2); X[3] = P5_K(2, 3); X[4] = P5_K(2, 4);
    X[5] = P5_K(3, 0); X[6] = P5_K(3, 1); X[7] = P5_K(3, 2); X[8] = P5_K(3, 3);
    X[9] = P5_K(4, 0); X[10] = P5_K(4, 1); X[11] = P5_K(4, 2);
    X[12] = P5_K(5, 0); X[13] = P5_K(5, 1); X[14] = P5_K(6, 0); X[15] = P5_K(6, 1);
    P5_SORT16(X);
    P5_TOP16(L, X);
    ins16(L, P5_K(7, 0)); ins16(L, P5_K(7, 1));
#undef P5_K
    const float v0 = fval(L[0], (int)0xffffff00);
    asm volatile("s_waitcnt lgkmcnt(0)" ::: "memory");
    int ex[8]; float ew[8]; float esum = 0.f;
#pragma unroll
    for (int k = 0; k < 8; ++k) {
        const int t = (fbits(L[8 + k]) & hm) | (fbits(L[k]) & ~hm);
        const int c = 255 - (t & 0xff);
        const int ia = sc[c >> 4], ib = sc[16 + (c & 15)];
        ex[k] = ia * 128 + ib;
        const float e = __builtin_amdgcn_exp2f((__builtin_bit_cast(float, t & (int)0xffffff00) - v0) * rs * 1.4426950408889634f);
        ew[k] = e; esum += e;
    }
    esum = sum_x32(esum);
    const float inv = 1.0f / esum;
    unsigned short* ip = IDS + tok * 128 + h * 16 + hi * 8; float* gp = GW + tok * 128 + h * 16 + hi * 8;
    *(GAS v4u*)(ip) = (v4u){(unsigned)ex[0] | ((unsigned)ex[1] << 16), (unsigned)ex[2] | ((unsigned)ex[3] << 16), (unsigned)ex[4] | ((unsigned)ex[5] << 16), (unsigned)ex[6] | ((unsigned)ex[7] << 16)};
    *(GAS f32x4*)(gp) = (f32x4){ew[0] * inv, ew[1] * inv, ew[2] * inv, ew[3] * inv};
    *(GAS f32x4*)(gp + 4) = (f32x4){ew[4] * inv, ew[5] * inv, ew[6] * inv, ew[7] * inv};
    __syncthreads();
}
}

namespace p6 {
__device__ __forceinline__ float blo(unsigned w) { return __builtin_bit_cast(float, w << 16); }
__device__ __forceinline__ float bhi(unsigned w) { return __builtin_bit_cast(float, w & 0xffff0000u); }
__device__ __forceinline__ float gelu_fast(float x) { return x * __builtin_amdgcn_rcpf(1.0f + __builtin_amdgcn_exp2f(-2.302208198f * x * (1.0f + 0.044715f * x * x))); }
__device__ __forceinline__ unsigned idw(const v4u& a, const v4u& b, int g) { const unsigned w = g < 8 ? a[(g & 7) >> 1] : b[(g & 7) >> 1]; return (g & 1) ? (w >> 16) : (w & 0xffffu); }
__device__ __forceinline__ unsigned q4(float a, float b, float c, float d, float inv, int bias) {
    const int qa = (int)rintf(a * inv) + bias, qb = (int)rintf(b * inv) + bias, qc = (int)rintf(c * inv) + bias, qd = (int)rintf(d * inv) + bias;
    return (unsigned)(qa & 0xff) | ((unsigned)(qb & 0xff) << 8) | ((unsigned)(qc & 0xff) << 16) | ((unsigned)(qd & 0xff) << 24);
}
__device__ __forceinline__ void qrow_load(f32x4 (&v)[8], const float* src, size_t e, int lane) {
#pragma unroll
    for (int j = 0; j < 8; ++j) v[j] = __builtin_nontemporal_load((const GAS f32x4*)(src + e * D + j * 256 + lane * 4));
}
__device__ __forceinline__ void qrow_finish(f32x4 (&v)[8], const float* gcol, unsigned char* dst, float* scale_out, size_t e, int lane) {
    float am = 0.f;
#pragma unroll
    for (int j = 0; j < 8; ++j) {
        if (gcol) { const f32x4 g = *(const GAS f32x4*)(gcol + j * 256 + lane * 4); v[j] = v[j] * g; }
        am = fmaxf(am, fmaxf(fmaxf(fabsf(v[j].x), fabsf(v[j].y)), fmaxf(fabsf(v[j].z), fabsf(v[j].w))));
    }
    am = max64(am);
    const float inv = am > 0.f ? 127.0f / am : 0.f;
#pragma unroll
    for (int j = 0; j < 8; ++j)
        *(GAS unsigned*)(dst + ((size_t)(2 * j + (lane >> 5)) * 16384 + e) * 128 + (lane & 31) * 4) = q4(v[j].x, v[j].y, v[j].z, v[j].w, inv, 0);
    if (lane == 0) scale_out[e] = am * (1.0f / 127.0f);
}
__device__ __forceinline__ void qx_load(v4u (&x)[4], const bf16* H1B, size_t tok, int lane) {
#pragma unroll
    for (int j = 0; j < 4; ++j) x[j] = *(const GAS v4u*)(H1B + tok * D + j * 512 + lane * 8);
}
__device__ __forceinline__ void qx_finish(const v4u (&x)[4], unsigned char* X8, float* SX, size_t tok, int lane) {
#pragma unroll
    for (int j = 0; j < 4; ++j) {
        float f[8]; float am = 0.f;
#pragma unroll
        for (int k = 0; k < 4; ++k) { f[2 * k] = blo(x[j][k]); f[2 * k + 1] = bhi(x[j][k]); am = fmaxf(am, fmaxf(fabsf(f[2 * k]), fabsf(f[2 * k + 1]))); }
        am = max16(am);
        const float inv = am > 0.f ? 127.0f / am : 0.f;
        typedef unsigned u32x2v __attribute__((ext_vector_type(2)));
        u32x2v o; o.x = q4(f[0], f[1], f[2], f[3], inv, 0); o.y = q4(f[4], f[5], f[6], f[7], inv, 0);
        *(GAS u32x2v*)(X8 + tok * D + j * 512 + lane * 8) = o;
        if ((lane & 15) == 0) SX[tok * 16 + 4 * j + (lane >> 4)] = am * (1.0f / 127.0f);
    }
}

typedef int i32x16 __attribute__((ext_vector_type(16)));
typedef float f32x16v __attribute__((ext_vector_type(16)));
__device__ __forceinline__ int seli(int m, int a, int b) { return (a & m) | (b & ~m); }
__device__ __forceinline__ float self(int m, float a, float b) { return __builtin_bit_cast(float, seli(m, __builtin_bit_cast(int, a), __builtin_bit_cast(int, b))); }
__device__ __forceinline__ void usweep(const unsigned char* X8, const float* SX, const unsigned char* U8, const unsigned short* IDS, bf16* PART, LAS unsigned char* lds, int slot, int rank, int nrank, int wave, int lane) {
    const int ps = lane >> 3, ch = lane & 7;
    const int first = rank * 8 + wave, stride = nrank * 8;
    const int n = first < MREAL ? (MREAL - first + stride - 1) / stride : 0, NQ = 2 * n;
    if (NQ == 0) return;
    const int m4 = -((lane >> 2) & 1), m2 = -((lane >> 1) & 1), m1 = -(lane & 1);
    LAS unsigned char* sl = lds + wave * 1024;
#define U_LOAD(q_, RI, RX, SX_, T_, SG_) do { const int qq_ = (q_) < NQ ? (q_) : NQ - 1; const int rd_ = qq_ >= n ? 1 : 0; T_ = first + (qq_ - rd_ * n) * stride; SG_ = rd_ * 8 + slot; \
        RI = *(const GAS unsigned*)(IDS + (size_t)T_ * 128 + lane * 2); RX = *(const GAS unsigned*)(X8 + (size_t)T_ * D + SG_ * 128 + (lane & 31) * 4); SX_ = SX[(size_t)T_ * 16 + SG_]; } while (0)
#define U_EXPAND(SLOT, RI, RX, I0, I1, XV) do { LAS unsigned char* s_ = sl + (SLOT) * 512; \
        *(LAS unsigned*)(s_ + lane * 4) = RI; if (lane < 32) *(LAS unsigned*)(s_ + 256 + lane * 4) = RX; \
        asm volatile("s_waitcnt lgkmcnt(0)" ::: "memory"); \
        I0 = *(const LAS v4u*)(s_ + ps * 32); I1 = *(const LAS v4u*)(s_ + ps * 32 + 16); XV = *(const LAS v4u*)(s_ + 256 + ch * 16); } while (0)
#define U_ISSUE(BUF, I0, I1, SG_) do { const unsigned char* tab_ = U8 + (size_t)(SG_) * 16384 * 128 + ch * 16; \
        _Pragma("unroll") for (int g = 0; g < 16; ++g) BUF[g] = *(const GAS v4u*)(tab_ + (size_t)idw(I0, I1, g) * 128); } while (0)
#define U_FINISH(BUF, XV, SX_, T_, SG_) do { i32x16 d; \
        _Pragma("unroll") for (int g = 0; g < 16; ++g) { int a_ = __builtin_amdgcn_sdot4((int)BUF[g][0], (int)XV[0], 0, false); a_ = __builtin_amdgcn_sdot4((int)BUF[g][1], (int)XV[1], a_, false); \
            a_ = __builtin_amdgcn_sdot4((int)BUF[g][2], (int)XV[2], a_, false); a_ = __builtin_amdgcn_sdot4((int)BUF[g][3], (int)XV[3], a_, false); d[g] = a_; } \
        int r8[8], r4[4], r2[2]; \
        _Pragma("unroll") for (int k = 0; k < 8; ++k) r8[k] = seli(m4, d[8 + k], d[k]) + dpp_hm(seli(m4, d[k], d[8 + k])); \
        _Pragma("unroll") for (int k = 0; k < 4; ++k) r4[k] = seli(m2, r8[4 + k], r8[k]) + dpp_x2(seli(m2, r8[k], r8[4 + k])); \
        _Pragma("unroll") for (int k = 0; k < 2; ++k) r2[k] = seli(m1, r4[2 + k], r4[k]) + dpp_x1(seli(m1, r4[k], r4[2 + k])); \
        *(GAS unsigned*)(PART + ((size_t)(SG_) * MREAL + T_) * 128 + ps * 16 + 2 * ch) = pk2((float)r2[0] * SX_, (float)r2[1] * SX_); } while (0)
    v4u bufA[16], bufB[16];
    v4u a0, a1, ax, b0, b1, bx; unsigned ri, rx; float as, bs, cs; int at, bt, ct, ag, bg, cg;
    U_LOAD(0, ri, rx, as, at, ag); U_EXPAND(0, ri, rx, a0, a1, ax);
    U_LOAD(1, ri, rx, bs, bt, bg); U_EXPAND(1, ri, rx, b0, b1, bx);
    U_ISSUE(bufA, a0, a1, ag);
    for (int q = 0; q < NQ; q += 2) {
        U_ISSUE(bufB, b0, b1, bg);
        U_LOAD(q + 2, ri, rx, cs, ct, cg);
        U_FINISH(bufA, ax, as, at, ag);
        U_EXPAND(0, ri, rx, a0, a1, ax); as = cs; at = ct; ag = cg;
        U_ISSUE(bufA, a0, a1, ag);
        U_LOAD(q + 3, ri, rx, cs, ct, cg);
        U_FINISH(bufB, bx, bs, bt, bg);
        U_EXPAND(1, ri, rx, b0, b1, bx); bs = cs; bt = ct; bg = cg;
    }
#undef U_LOAD
#undef U_EXPAND
#undef U_ISSUE
#undef U_FINISH
}
__device__ __forceinline__ void wreduce(const bf16* PART, const float* GW, const float* RSTD2, const unsigned short* IDS, const float* SCU, const float* SCV, unsigned char* W8, float* WS8, size_t gt, size_t NT) {
    for (size_t i8 = gt; i8 < (size_t)MREAL * 128 / 8; i8 += NT) {
        float s[8];
#pragma unroll
        for (int k = 0; k < 8; ++k) s[k] = 0.f;
#pragma unroll 8
        for (int sg = 0; sg < 16; ++sg) {
            const v4u p = *(const GAS v4u*)(PART + (size_t)sg * MREAL * 128 + i8 * 8);
#pragma unroll
            for (int k = 0; k < 4; ++k) { s[2 * k] += blo(p[k]); s[2 * k + 1] += bhi(p[k]); }
        }
        const float rs = RSTD2[i8 >> 4];
        const v4u idv = *(const GAS v4u*)(IDS + i8 * 8);
        const f32x4 g0 = *(const GAS f32x4*)(GW + i8 * 8), g1 = *(const GAS f32x4*)(GW + i8 * 8 + 4);
        float w[8]; float am = 0.f;
#pragma unroll
        for (int k = 0; k < 8; ++k) {
            const unsigned e = (k & 1) ? (idv[k >> 1] >> 16) : (idv[k >> 1] & 0xffffu);
            const float g = k < 4 ? g0[k & 3] : g1[k & 3];
            w[k] = g * gelu_fast(rs * SCU[e] * s[k]) * SCV[e]; am = fmaxf(am, fabsf(w[k]));
        }
        am = max16(am);
        const float inv = am > 0.f ? 127.0f / am : 0.f;
        typedef unsigned u32x2v __attribute__((ext_vector_type(2)));
        u32x2v o; o.x = q4(w[0], w[1], w[2], w[3], inv, 0); o.y = q4(w[4], w[5], w[6], w[7], inv, 0);
        *(GAS u32x2v*)(W8 + i8 * 8) = o;
        if ((i8 & 15) == 0) WS8[i8 >> 4] = am * (1.0f / 127.0f);
    }
}
__device__ __forceinline__ void vsweep(const bf16* H1B, const unsigned char* V8, const unsigned short* IDS, const unsigned char* W8, const float* WS8, bf16* Z, LAS unsigned char* lds, int slot, int rank, int nrank, int wave, int lane) {
    const int ps = lane >> 3, ch = lane & 7;
    const int first = rank * 8 + wave, stride = nrank * 8;
    const int n = first < MREAL ? (MREAL - first + stride - 1) / stride : 0, NQ = 2 * n;
    if (NQ == 0) return;
    const int m8 = -((lane >> 3) & 1);
    LAS unsigned char* sl = lds + wave * 1024;
#define V_LOAD(q_, RI, RW, WSC, HX, T_, SG_) do { const int qq_ = (q_) < NQ ? (q_) : NQ - 1; const int rd_ = qq_ >= n ? 1 : 0; T_ = first + (qq_ - rd_ * n) * stride; SG_ = rd_ * 8 + slot; \
        RI = *(const GAS unsigned*)(IDS + (size_t)T_ * 128 + lane * 2); RW = *(const GAS unsigned*)(W8 + (size_t)T_ * 128 + (lane & 31) * 4); WSC = WS8[T_]; \
        HX = 0u; } while (0)
#define V_EXPAND(SLOT, RI, RW, I0, I1, WQ) do { LAS unsigned char* s_ = sl + (SLOT) * 512; \
        *(LAS unsigned*)(s_ + lane * 4) = RI; if (lane < 32) *(LAS unsigned*)(s_ + 256 + lane * 4) = RW; \
        asm volatile("s_waitcnt lgkmcnt(0)" ::: "memory"); \
        I0 = *(const LAS v4u*)(s_ + ps * 32); I1 = *(const LAS v4u*)(s_ + ps * 32 + 16); WQ = *(const LAS v4u*)(s_ + 256 + ps * 16); } while (0)
#define V_ISSUE(BUF, I0, I1, SG_) do { const unsigned char* tab_ = V8 + (size_t)(SG_) * 16384 * 128 + ch * 16; \
        _Pragma("unroll") for (int g = 0; g < 16; ++g) BUF[g] = *(const GAS v4u*)(tab_ + (size_t)idw(I0, I1, g) * 128); } while (0)
#define V_FINISH(BUF, WQ, WSC, HX, T_, SG_) do { i32x16 acc = {0, 0, 0, 0, 0, 0, 0, 0, 0, 0, 0, 0, 0, 0, 0, 0}; const unsigned hx_ = HX; \
        _Pragma("unroll") for (int j = 0; j < 4; ++j) { const int wq_ = (int)WQ[j]; \
            _Pragma("unroll") for (int k = 0; k < 4; ++k) { \
                const unsigned d0_ = BUF[4 * j][k], d1_ = BUF[4 * j + 1][k], d2_ = BUF[4 * j + 2][k], d3_ = BUF[4 * j + 3][k]; \
                const unsigned p0_ = __builtin_amdgcn_perm(d1_, d0_, 0x05010400u), p1_ = __builtin_amdgcn_perm(d1_, d0_, 0x07030602u); \
                const unsigned q0_ = __builtin_amdgcn_perm(d3_, d2_, 0x05010400u), q1_ = __builtin_amdgcn_perm(d3_, d2_, 0x07030602u); \
                acc[4 * k + 0] = __builtin_amdgcn_sdot4((int)__builtin_amdgcn_perm(q0_, p0_, 0x05040100u), wq_, acc[4 * k + 0], false); \
                acc[4 * k + 1] = __builtin_amdgcn_sdot4((int)__builtin_amdgcn_perm(q0_, p0_, 0x07060302u), wq_, acc[4 * k + 1], false); \
                acc[4 * k + 2] = __builtin_amdgcn_sdot4((int)__builtin_amdgcn_perm(q1_, p1_, 0x05040100u), wq_, acc[4 * k + 2], false); \
                acc[4 * k + 3] = __builtin_amdgcn_sdot4((int)__builtin_amdgcn_perm(q1_, p1_, 0x07060302u), wq_, acc[4 * k + 3], false); } } \
        int r8[8], r4[4], r2[2]; \
        _Pragma("unroll") for (int k = 0; k < 8; ++k) { const auto rr_ = __builtin_amdgcn_permlane32_swap((unsigned)acc[k], (unsigned)acc[8 + k], false, false); r8[k] = (int)rr_[0] + (int)rr_[1]; } \
        _Pragma("unroll") for (int k = 0; k < 4; ++k) { const auto rr_ = __builtin_amdgcn_permlane16_swap((unsigned)r8[k], (unsigned)r8[4 + k], false, false); r4[k] = (int)rr_[0] + (int)rr_[1]; } \
        _Pragma("unroll") for (int k = 0; k < 2; ++k) r2[k] = seli(m8, r4[2 + k], r4[k]) + dpp_r8(seli(m8, r4[k], r4[2 + k])); \
        const float z0_ = (float)r2[0] * WSC + blo(hx_), z1_ = (float)r2[1] * WSC + bhi(hx_); \
        *(GAS unsigned*)(Z + (size_t)T_ * D + (SG_) * 128 + ch * 16 + 2 * ps) = pk2(z0_, z1_); } while (0)
    v4u bufA[16], bufB[16];
    v4u a0, a1, aw, b0, b1, bw; unsigned ri, rw, ah, bh, chx; float as, bs, cs; int at, bt, ct, ag, bg, cg;
    V_LOAD(0, ri, rw, as, ah, at, ag); V_EXPAND(0, ri, rw, a0, a1, aw);
    V_LOAD(1, ri, rw, bs, bh, bt, bg); V_EXPAND(1, ri, rw, b0, b1, bw);
    V_ISSUE(bufA, a0, a1, ag);
    for (int q = 0; q < NQ; q += 2) {
        V_ISSUE(bufB, b0, b1, bg);
        V_LOAD(q + 2, ri, rw, cs, chx, ct, cg);
        V_FINISH(bufA, aw, as, ah, at, ag);
        V_EXPAND(0, ri, rw, a0, a1, aw); as = cs; ah = chx; at = ct; ag = cg;
        V_ISSUE(bufA, a0, a1, ag);
        V_LOAD(q + 3, ri, rw, cs, chx, ct, cg);
        V_FINISH(bufB, bw, bs, bh, bt, bg);
        V_EXPAND(1, ri, rw, b0, b1, bw); bs = cs; bh = chx; bt = ct; bg = cg;
    }
#undef V_LOAD
#undef V_EXPAND
#undef V_ISSUE
#undef V_FINISH
}
__device__ __forceinline__ void final_load(v4u (&z)[4], v4u (&h)[4], const bf16* Z, const bf16* H1B, size_t tok, int lane) {
#pragma unroll
    for (int j = 0; j < 4; ++j) { z[j] = __builtin_nontemporal_load((const GAS v4u*)(Z + tok * D + j * 512 + lane * 8)); h[j] = __builtin_nontemporal_load((const GAS v4u*)(H1B + tok * D + j * 512 + lane * 8)); }
}
__device__ __forceinline__ void final_finish(const v4u (&z)[4], const v4u (&h)[4], const float* fg, float* out, size_t tok, int lane) {
    float v[4][8]; float ss = 0.f;
#pragma unroll
    for (int j = 0; j < 4; ++j)
#pragma unroll
        for (int k = 0; k < 4; ++k) { v[j][2 * k] = blo(z[j][k]) + blo(h[j][k]); v[j][2 * k + 1] = bhi(z[j][k]) + bhi(h[j][k]); ss += v[j][2 * k] * v[j][2 * k] + v[j][2 * k + 1] * v[j][2 * k + 1]; }
    ss = sum64(ss);
    const float rf = 1.0f / sqrtf(ss * (1.0f / D) + EPS);
#pragma unroll
    for (int j = 0; j < 4; ++j) {
        const f32x4 ga = *(const GAS f32x4*)(fg + j * 512 + lane * 8), gb = *(const GAS f32x4*)(fg + j * 512 + lane * 8 + 4);
        __builtin_nontemporal_store((f32x4){v[j][0] * rf * ga.x, v[j][1] * rf * ga.y, v[j][2] * rf * ga.z, v[j][3] * rf * ga.w}, (GAS f32x4*)(out + tok * D + j * 512 + lane * 8));
        __builtin_nontemporal_store((f32x4){v[j][4] * rf * gb.x, v[j][5] * rf * gb.y, v[j][6] * rf * gb.z, v[j][7] * rf * gb.w}, (GAS f32x4*)(out + tok * D + j * 512 + lane * 8 + 4));
    }
}
}

struct Frame {
    LAS unsigned char* lds;
    volatile LAS unsigned* MISC;
    gu32* ctl;
    int tid, lane, wave, vcu, G;
};
__device__ __forceinline__ float wave_sum(float v) { return sum64(v); }
__device__ __forceinline__ void p0_transpose_item(const float* W, int K, int N, bf16* WT, const float* g0, const float* g1, int ksplit, LAS float* scr, int item, int lane) {
    const int nblk = N / 32, kb = item / nblk, nb = item % nblk, k0 = 64 * kb, n0 = 32 * nb;
    f32x4 v[8];
#pragma unroll
    for (int i = 0; i < 8; ++i) v[i] = __builtin_nontemporal_load((const GAS f32x4*)(W + (size_t)(k0 + 8 * i + (lane >> 3)) * N + n0 + (lane & 7) * 4));
#pragma unroll
    for (int i = 0; i < 8; ++i) { const int kk = 8 * i + (lane >> 3), kg = k0 + kk; const float gv = kg < ksplit ? g0[kg] : g1[kg - ksplit];
        LAS float* d = scr + kk * 33 + (lane & 7) * 4; d[0] = v[i].x * gv; d[1] = v[i].y * gv; d[2] = v[i].z * gv; d[3] = v[i].w * gv; }
    LDS_WAIT(); asm volatile("" ::: "memory");
    const int c = lane & 7;
#pragma unroll
    for (int j = 0; j < 4; ++j) { const int n = (lane >> 3) + 8 * j; const LAS float* s = scr + (8 * c) * 33 + n;
        v4u o; o.x = pk2(s[0 * 33], s[1 * 33]); o.y = pk2(s[2 * 33], s[3 * 33]); o.z = pk2(s[4 * 33], s[5 * 33]); o.w = pk2(s[6 * 33], s[7 * 33]);
        *(GAS v4u*)(WT + (size_t)(n0 + n) * K + k0 + 8 * c) = o; }
    LDS_WAIT(); asm volatile("" ::: "memory");
}
__device__ __forceinline__ void p0_row_load(f32x4 (&v)[8], const float* xrow, int lane) {
    const GAS f32x4* xr = (const GAS f32x4*)xrow + lane;
#pragma unroll
    for (int j = 0; j < 8; ++j) v[j] = __builtin_nontemporal_load(xr + 64 * j);
}
__device__ __forceinline__ void p0_row_finish(const f32x4 (&v)[8], bf16* orow, float* rstd_out, int lane) {
    float s = 0.f;
#pragma unroll
    for (int j = 0; j < 8; ++j) s += (v[j].x * v[j].x + v[j].y * v[j].y) + (v[j].z * v[j].z + v[j].w * v[j].w);
    s = wave_sum(s);
    GAS unsigned long long* o8 = (GAS unsigned long long*)orow + lane;
#pragma unroll
    for (int j = 0; j < 8; ++j) o8[64 * j] = (unsigned long long)pk2(v[j].x, v[j].y) | ((unsigned long long)pk2(v[j].z, v[j].w) << 32);
    if (lane == 0) *rstd_out = 1.0f / sqrtf(s * (1.0f / D) + EPS);
}
__device__ __forceinline__ void p0_cvt8(const float* src, bf16* dst, const float* gcol, size_t idx8) {
    const f32x4 a = *(const GAS f32x4*)(src + idx8 * 8), b = *(const GAS f32x4*)(src + idx8 * 8 + 4);
    f32x4 ga = {1.f, 1.f, 1.f, 1.f}, gb = {1.f, 1.f, 1.f, 1.f};
    if (gcol) { const int c = (int)((idx8 * 8) & (D - 1)); ga = *(const GAS f32x4*)(gcol + c); gb = *(const GAS f32x4*)(gcol + c + 4); }
    v4u o; o.x = pk2(a.x * ga.x, a.y * ga.y); o.y = pk2(a.z * ga.z, a.w * ga.w); o.z = pk2(b.x * gb.x, b.y * gb.y); o.w = pk2(b.z * gb.z, b.w * gb.w);
    *(GAS v4u*)(dst + idx8 * 8) = o;
}

struct Args { const float* in[22]; float* out; unsigned char* ws; int ph_lo, ph_hi, rep_mask, pad; };

__global__ void __launch_bounds__(NWAVES * 64, 2) fwd(Args args) {
    extern __shared__ __attribute__((aligned(16))) unsigned char lds[];
    Frame F;
    F.lds = (LAS unsigned char*)lds;
    F.MISC = (volatile LAS unsigned*)(F.lds + MISC_OFF);
    F.tid = threadIdx.x; F.lane = F.tid & 63; F.wave = __builtin_amdgcn_readfirstlane(F.tid >> 6);
    F.G = gridDim.x; { const int bx = blockIdx.x; F.vcu = (F.G % 8 == 0) ? (bx % 8) * (F.G / 8) + bx / 8 : bx; }
    unsigned char* ws = args.ws;
    F.ctl = (gu32*)(ws + WS_CTL);
    for (int u = F.tid; u < (LDS_BYTES - LDSCTL_OFF) / 4; u += NWAVES * 64) ((LAS unsigned*)(F.lds + LDSCTL_OFF))[u] = 0u;
    __syncthreads();
    XcdBarrier bar = xcd_barrier_post((unsigned*)(F.ctl + CW_BAR), F.MISC + 8);
    const int lo = args.ph_lo, hi = args.ph_hi;
#define IN(k) (lo <= (k) && (k) < hi)
#define BOTH(k) (IN(k) && IN((k) + 1))
#ifndef PROBE_PH
#define PROBE_PH (-1)
#endif
#define REP(k) for (int rep_ = 0; rep_ < ((k) == PROBE_PH ? 2 : 1); ++rep_)
#define STAMP(i) do { if (PROBE_PH >= 100 && blockIdx.x == 0 && F.tid == 0) ((volatile LAS unsigned long long*)(F.lds + LDSCTL_OFF + 640))[i] = __builtin_amdgcn_s_memrealtime(); } while (0)

    const float* x = args.in[0]; const float* meta = args.in[1]; const float* norm_mix_g = args.in[2]; const float* w_in = args.in[3]; const float* b_in = args.in[4];
    const float* gn_attn_g = args.in[13]; const float* gn_lru_g = args.in[14]; const float* w_out = args.in[15]; const float* norm_ffn_g = args.in[16];
    const float* peer_wq = args.in[17]; const float* sub_keys = args.in[18]; const float* peer_u = args.in[19]; const float* peer_v = args.in[20];
    bf16* W1T = (bf16*)(ws + WS_W1T); bf16* W2T = (bf16*)(ws + WS_W2T); bf16* W3T = (bf16*)(ws + WS_W3T); bf16* SKB = (bf16*)(ws + WS_SKB);
    float* RSTD1 = (float*)(ws + WS_RSTD1);
    unsigned char* U8 = ws + WS_U8; unsigned char* V8 = ws + WS_V8; unsigned char* X8 = ws + WS_X8; float* SX = (float*)(ws + WS_SX); float* SCU = (float*)(ws + WS_SCU); float* SCV = (float*)(ws + WS_SCV);
    bf16* A1 = (bf16*)(ws + WS_A1);
    bf16* QB = (bf16*)(ws + WS_Q); bf16* KVB = (bf16*)(ws + WS_KV); bf16* XBB = (bf16*)(ws + WS_XB); bf16* GTB = (bf16*)(ws + WS_GT);

    STAMP(0);
    if (IN(0)) { REP(0) {
        LAS float* scr = (LAS float*)(F.lds + RING_OFF + F.wave * 16384);
        const int gw = F.vcu * NWAVES + F.wave, NGW = F.G * NWAVES;
        constexpr int I_1 = (D / 64) * (IND / 32), I_2 = (D / 64) * (D / 32), I_3 = I_2;
        for (int it = gw; it < I_1 + I_2 + I_3; it += NGW) {
            int r = it;
            if (r < I_1) { p0_transpose_item(w_in, D, IND, W1T, norm_mix_g, norm_mix_g, D, scr, r, F.lane); continue; } r -= I_1;
            if (r < I_2) { p0_transpose_item(w_out, D, D, W2T, gn_attn_g, gn_lru_g, 1024, scr, r, F.lane); continue; } r -= I_2;
            p0_transpose_item(peer_wq, D, D, W3T, norm_ffn_g, norm_ffn_g, D, scr, r, F.lane);
        }
        {
            f32x4 r0[8], r1[8], r2[8];
            const int NR = MREAL + NMETA;
#define P0_XSRC(m_) ((m_) < MREAL ? x + (size_t)(m_) * D : meta + (size_t)((m_) - MREAL) * D)
            if (gw < NR) p0_row_load(r0, P0_XSRC(gw), F.lane);
            if (gw + NGW < NR) p0_row_load(r1, P0_XSRC(gw + NGW), F.lane);
            for (int m = gw; m < NR; m += 3 * NGW) {
                if (m + 2 * NGW < NR) p0_row_load(r2, P0_XSRC(m + 2 * NGW), F.lane);
                p0_row_finish(r0, A1 + (size_t)m * D, RSTD1 + m, F.lane);
                if (m + NGW < NR) {
                    if (m + 3 * NGW < NR) p0_row_load(r0, P0_XSRC(m + 3 * NGW), F.lane);
                    p0_row_finish(r1, A1 + (size_t)(m + NGW) * D, RSTD1 + m + NGW, F.lane);
                }
                if (m + 2 * NGW < NR) {
                    if (m + 4 * NGW < NR) p0_row_load(r1, P0_XSRC(m + 4 * NGW), F.lane);
                    p0_row_finish(r2, A1 + (size_t)(m + 2 * NGW) * D, RSTD1 + m + 2 * NGW, F.lane);
                }
            }
#undef P0_XSRC
        }
        {
            const size_t gt = (size_t)gw * 64 + F.lane, NT = (size_t)NGW * 64;
            for (size_t i = gt; i < (size_t)(8 * 2 * 128 * 128) / 8; i += NT) p0_cvt8(sub_keys, SKB, nullptr, i);
            {
                f32x4 r0[8], r1[8], r2[8];
                constexpr int QV0 = 6144, NR = 16384;
                const int b0 = QV0 + gw;
                if (b0 < NR) p6::qrow_load(r0, peer_v, (size_t)b0, F.lane);
                if (b0 + NGW < NR) p6::qrow_load(r1, peer_v, (size_t)(b0 + NGW), F.lane);
                for (int rj = b0; rj < NR; rj += 3 * NGW) {
                    if (rj + 2 * NGW < NR) p6::qrow_load(r2, peer_v, (size_t)(rj + 2 * NGW), F.lane);
                    p6::qrow_finish(r0, nullptr, V8, SCV, (size_t)rj, F.lane);
                    if (rj + NGW < NR) {
                        if (rj + 3 * NGW < NR) p6::qrow_load(r0, peer_v, (size_t)(rj + 3 * NGW), F.lane);
                        p6::qrow_finish(r1, nullptr, V8, SCV, (size_t)(rj + NGW), F.lane);
                    }
                    if (rj + 2 * NGW < NR) {
                        if (rj + 4 * NGW < NR) p6::qrow_load(r1, peer_v, (size_t)(rj + 4 * NGW), F.lane);
                        p6::qrow_finish(r2, nullptr, V8, SCV, (size_t)(rj + 2 * NGW), F.lane);
                    }
                }
            }
        } }
        if (BOTH(0)) xcd_barrier(bar);
        STAMP(1);
    }
    if (IN(1)) {
        pg8::Gemm g{A1, W1T, MPAD, IND, D};
        pg8::Order1 S{F.G, (int)blockIdx.x};
        pg8::Epi1 E{QB, KVB, XBB, GTB, RSTD1, b_in};
        REP(1) pg8::gemm_phase<pg8::Epi1, pg8::Order1, true, true>(F.lds + RING_OFF, g, S, E);
        {
            volatile LAS int* qb = (volatile LAS int*)(F.lds + LDSCTL_OFF + 512);
            for (;;) {
                __syncthreads();
                if (F.tid == 0) qb[0] = (int)__hip_atomic_fetch_add((unsigned*)(F.ctl + CW_QROW), 32u, __ATOMIC_RELAXED, __HIP_MEMORY_SCOPE_AGENT);
                __syncthreads();
                const int base = qb[0];
                if (base >= 16384 + 6144) break;
                f32x4 r0[8], r1[8], r2[8], r3[8];
                const bool isu = base < 16384;
                const float* src = isu ? peer_u : peer_v; const float* gc = isu ? norm_ffn_g : nullptr; unsigned char* dst = isu ? U8 : V8; float* sc = isu ? SCU : SCV;
                const size_t e0 = (size_t)(isu ? base : base - 16384) + F.wave * 4;
                p6::qrow_load(r0, src, e0, F.lane); p6::qrow_load(r1, src, e0 + 1, F.lane); p6::qrow_load(r2, src, e0 + 2, F.lane); p6::qrow_load(r3, src, e0 + 3, F.lane);
                p6::qrow_finish(r0, gc, dst, sc, e0, F.lane); p6::qrow_finish(r1, gc, dst, sc, e0 + 1, F.lane);
                p6::qrow_finish(r2, gc, dst, sc, e0 + 2, F.lane); p6::qrow_finish(r3, gc, dst, sc, e0 + 3, F.lane);
            }
        }
        if (BOTH(1)) xcd_barrier(bar);
        STAMP(2);
    }
    if (IN(2)) {
        bf16* MIX = (bf16*)(ws + WS_Z); float* SSA = (float*)(ws + WS_SSA); float* SSL = (float*)(ws + WS_SSL);
        const p2::LruP LP{args.in[6], args.in[7], args.in[8], args.in[9], args.in[10], args.in[11], args.in[12]};
        {
        REP(20) for (int u = (int)blockIdx.x; u < 256; u += F.G) p2::lru_unit(F.lds + RING_OFF, F.lds + LDSCTL_OFF + 5120, u >> 5, (u >> 1) & 15, u & 1, XBB, GTB, LP, MIX, SSL, F.tid);
        REP(21) for (int a = (int)blockIdx.x; a < 256; a += F.G) p2::attn_unit(F.lds + RING_OFF, a >> 5, (a >> 1) & 15, a & 1, QB, KVB, args.in[5], MIX, SSA, F.tid);
        }
        if (BOTH(2)) xcd_barrier(bar);
        STAMP(3);
    }
    if (IN(3)) {
        bf16* MIX = (bf16*)(ws + WS_Z); const float* SSA = (const float*)(ws + WS_SSA); const float* SSL = (const float*)(ws + WS_SSL);
        bf16* H1B = (bf16*)(ws + WS_H1); float* SS2 = (float*)(ws + WS_SS2);
        pg8::Order2 S{F.G, (int)blockIdx.x};
        LAS float* tbl = (LAS float*)(F.lds + LDSCTL_OFF + 1024);
        pg8::Unit u0{0, 0};
        for (int i = 0; i < 2; ++i) {
            pg8::Unit u; if (!S.next(i, u)) break; if (i == 0) u0 = u;
            if (F.tid < 256) {
                const size_t row = (size_t)u.pm * 256 + F.tid; float sa = 0.f, sl = 0.f;
#pragma unroll
                for (int k = 0; k < 4; ++k) { const f32x4 v = *(const GAS f32x4*)(SSA + row * 16 + 4 * k); sa += (v.x + v.y) + (v.z + v.w); }
#pragma unroll
                for (int k = 0; k < 8; ++k) { const f32x4 v = *(const GAS f32x4*)(SSL + row * 32 + 4 * k); sl += (v.x + v.y) + (v.z + v.w); }
                const float ra = 1.0f / sqrtf(sa * (1.0f / 1024) + EPS), rl = 1.0f / sqrtf(sl * (1.0f / 1024) + EPS);
                tbl[(i * 256 + F.tid) * 4] = ra / rl; tbl[(i * 256 + F.tid) * 4 + 1] = rl; tbl[(i * 256 + F.tid) * 4 + 2] = 1.0f / ra;
            }
        }
        __syncthreads();
        pg8::Gemm g{MIX, W2T, MREAL, D, D};
        pg8::Epi2 E{H1B, A1, SS2, (const LAS float*)tbl, u0.pm};
        REP(3) pg8::gemm_phase<pg8::Epi2, pg8::Order2, true, true>(F.lds + RING_OFF, g, S, E);
        if (BOTH(3)) xcd_barrier(bar);
        STAMP(4);
    }
    if (IN(4)) {
        bf16* H1B = (bf16*)(ws + WS_H1); bf16* QPB = (bf16*)(ws + WS_A1);
        pg8::Order2 S{F.G, (int)blockIdx.x};
        {
            const float* SS2 = (const float*)(ws + WS_SS2); float* RSTD2 = (float*)(ws + WS_RSTD2);
            pg8::Unit u; if (S.next(0, u) && F.tid < 256) {
                const size_t row = (size_t)u.pm * 256 + F.tid; float ssq = 0.f;
#pragma unroll
                for (int k = 0; k < 8; ++k) { const f32x4 v = *(const GAS f32x4*)(SS2 + row * 32 + 4 * k); ssq += (v.x + v.y) + (v.z + v.w); }
                RSTD2[row] = 1.0f / sqrtf(ssq * (1.0f / D) + EPS);
            }
        }
        pg8::Gemm g{H1B, W3T, MREAL, D, D};
        pg8::Epi3 E{QPB};
        REP(4) pg8::gemm_phase<pg8::Epi3, pg8::Order2, true, true>(F.lds + RING_OFF, g, S, E);
        if (BOTH(4)) { asm volatile("s_waitcnt vmcnt(0)" ::: "memory"); __syncthreads();
            if (F.tid == 0) { __builtin_amdgcn_fence(__ATOMIC_ACQUIRE, "agent"); asm volatile("s_waitcnt vmcnt(0)" ::: "memory"); }
            __syncthreads(); }
        STAMP(5);
    }
    if (IN(5)) {
        const bf16* QPB = (const bf16*)(ws + WS_A1);
        unsigned short* IDS = (unsigned short*)(ws + WS_IDS); float* GW = (float*)(ws + WS_GW); float* RSTD2 = (float*)(ws + WS_RSTD2);
        const bf16* H1B = (const bf16*)(ws + WS_H1);
        const pg8::Order2 S5{F.G, (int)blockIdx.x};
        REP(5) for (int ui = 0; ; ++ui) {
            pg8::Unit un; if (!S5.next(ui, un)) break;
            const int uh = un.pn, utg = un.pm;
            v4u xq[4][4]; const size_t tb = (size_t)utg * 256 + F.wave * 32 + uh;
            p5::retr_unit(F.lds + RING_OFF, uh, utg, QPB, SKB, IDS, GW, RSTD2, F.tid);
#pragma unroll
            for (int k = 0; k < 4; ++k) p6::qx_load(xq[k], H1B, tb + 8 * k, F.lane);
#pragma unroll
            for (int k = 0; k < 4; ++k) p6::qx_finish(xq[k], X8, SX, tb + 8 * k, F.lane);
        }
        if (BOTH(5)) xcd_barrier(bar);
        STAMP(6);
    }
    {
        const bf16* H1B = (const bf16*)(ws + WS_H1); const unsigned short* IDS = (const unsigned short*)(ws + WS_IDS); const float* GW = (const float*)(ws + WS_GW);
        const float* RSTD2 = (const float*)(ws + WS_RSTD2); bf16* PART = (bf16*)(ws + WS_PART); unsigned char* W8 = ws + WS_W; float* WS8 = (float*)(ws + WS_WSUM); bf16* ZB = (bf16*)(ws + WS_Z);
        const int slot = (int)blockIdx.x & 7, rank = (int)blockIdx.x >> 3, nrank = (F.G - slot + 7) >> 3;
        const int gw = F.vcu * NWAVES + F.wave, NGW = F.G * NWAVES;
        if (IN(6)) { REP(6) p6::usweep(X8, SX, U8, IDS, PART, F.lds + RING_OFF, slot, rank, nrank, F.wave, F.lane); if (BOTH(6)) xcd_barrier(bar); STAMP(7); }
        if (IN(7)) { REP(7) p6::wreduce(PART, GW, RSTD2, IDS, SCU, SCV, W8, WS8, (size_t)gw * 64 + F.lane, (size_t)NGW * 64); if (BOTH(7)) xcd_barrier(bar); STAMP(8); }
        if (IN(8)) { REP(8) p6::vsweep(H1B, V8, IDS, W8, WS8, ZB, F.lds + RING_OFF, slot, rank, nrank, F.wave, F.lane); if (BOTH(8)) xcd_barrier(bar); STAMP(9); }
        if (PROBE_PH == 30) { for (int k = 0; k < 16; ++k) xcd_barrier(bar); }
        if (IN(9)) { REP(9) {
            v4u zc[4], zn[4], hc[4], hn[4];
            if (gw < MREAL) p6::final_load(zc, hc, ZB, H1B, (size_t)gw, F.lane);
            for (int t = gw; t < MREAL; t += NGW) {
                if (t + NGW < MREAL) p6::final_load(zn, hn, ZB, H1B, (size_t)(t + NGW), F.lane);
                p6::final_finish(zc, hc, args.in[21], args.out, (size_t)t, F.lane);
#pragma unroll
                for (int j = 0; j < 4; ++j) { zc[j] = zn[j]; hc[j] = hn[j]; }
            } } }
        if (PROBE_PH >= 100) {
            asm volatile("s_waitcnt vmcnt(0)" ::: "memory"); __syncthreads(); STAMP(10);
            if (blockIdx.x == 0 && F.tid == 0) {
                volatile LAS unsigned long long* ts = (volatile LAS unsigned long long*)(F.lds + LDSCTL_OFF + 640);
                const unsigned long long span = ts[PROBE_PH - 100 + 1] - ts[PROBE_PH - 100], t0 = __builtin_amdgcn_s_memrealtime();
                while (__builtin_amdgcn_s_memrealtime() - t0 < span) __builtin_amdgcn_s_sleep(8);
            }
        }
    }
#undef IN
#undef BOTH
}

extern "C" void kernel_launch(void* const* d_in, const int* in_sizes, int n_in, void* d_out, int out_size, void* d_ws, size_t ws_size, hipStream_t stream) {
    static int grid = 0;
    if (grid == 0) {
        int dev = 0, cus = 0;
        if (hipGetDevice(&dev) != hipSuccess || hipDeviceGetAttribute(&cus, hipDeviceAttributeMultiprocessorCount, dev) != hipSuccess) { fprintf(stderr, "kernel_launch: device query failed\n"); grid = -1; return; }
        if (hipFuncSetAttribute((const void*)fwd, hipFuncAttributeMaxDynamicSharedMemorySize, LDS_BYTES) != hipSuccess) { fprintf(stderr, "kernel_launch: hipFuncSetAttribute failed\n"); grid = -1; return; }
        int per_cu = 0;
        if (hipOccupancyMaxActiveBlocksPerMultiprocessor(&per_cu, (const void*)fwd, NWAVES * 64, LDS_BYTES) != hipSuccess || per_cu < 1) fprintf(stderr, "kernel_launch: occupancy query says %d\n", per_cu);
        (void)hipGetLastError();
        grid = cus;
        if (cus != 256) { fprintf(stderr, "kernel_launch: built for a 256-CU device (tile-to-workgroup maps of the GEMM phases), found %d CUs; nothing launched\n", cus); grid = -1; return; }
        if (ws_size < WS_END) { fprintf(stderr, "kernel_launch: ws too small %zu\n", ws_size); grid = -1; return; }
    }
    if (grid < 0) return;
    (void)hipMemsetAsync((char*)d_ws + WS_CTL, 0, CTL_ZERO_BYTES, stream);
    Args a{};
    for (int i = 0; i < 22; ++i) a.in[i] = (const float*)d_in[i];
    a.out = (float*)d_out; a.ws = (unsigned char*)d_ws; a.ph_lo = 0; a.ph_hi = 10;
    hipLaunchKernelGGL(fwd, dim3(grid), dim3(NWAVES * 64), LDS_BYTES, stream, a);
}
```

```cpp
#include <hip/hip_runtime.h>
#include <cstdio>
#include <cstdint>
#include <math.h>

#define D 2048
#define NB 8
#define SEQ 2048
#define NMETA 16
#define TT (SEQ + NMETA)
#define MR (NB * TT)
#define MREAL (NB * SEQ)
#define MPAD (MREAL + 256)
#define QD 1024
#define KVD 128
#define LW 1024
#define IND 3328
#define EPS 1e-6f
#define QSCALE (0.125f * 1.4426950408889634f)
#define GAS __attribute__((address_space(1)))
#define LAS __attribute__((address_space(3)))

#define DPP_I(x, ctrl) __builtin_amdgcn_update_dpp(0, (x), (ctrl), 0xf, 0xf, true)
__device__ __forceinline__ int dpp_x1(int x) { return DPP_I(x, 0xB1); }
__device__ __forceinline__ int dpp_x2(int x) { return DPP_I(x, 0x4E); }
__device__ __forceinline__ int dpp_hm(int x) { return DPP_I(x, 0x141); }
__device__ __forceinline__ int dpp_rm(int x) { return DPP_I(x, 0x140); }
__device__ __forceinline__ int dpp_r8(int x) { return DPP_I(x, 0x128); }
__device__ __forceinline__ float fdpp_x1(float x) { return __builtin_bit_cast(float, dpp_x1(__builtin_bit_cast(int, x))); }
__device__ __forceinline__ float fdpp_x2(float x) { return __builtin_bit_cast(float, dpp_x2(__builtin_bit_cast(int, x))); }
__device__ __forceinline__ float fdpp_hm(float x) { return __builtin_bit_cast(float, dpp_hm(__builtin_bit_cast(int, x))); }
__device__ __forceinline__ float fdpp_rm(float x) { return __builtin_bit_cast(float, dpp_rm(__builtin_bit_cast(int, x))); }
__device__ __forceinline__ float max16(float v) { v = fmaxf(v, fdpp_x1(v)); v = fmaxf(v, fdpp_x2(v)); v = fmaxf(v, fdpp_hm(v)); return fmaxf(v, fdpp_rm(v)); }
__device__ __forceinline__ float sum64(float v) {
    v += fdpp_x1(v); v += fdpp_x2(v); v += fdpp_hm(v); v += fdpp_rm(v);
    return (__builtin_bit_cast(float, __builtin_amdgcn_readlane(__builtin_bit_cast(int, v), 0)) + __builtin_bit_cast(float, __builtin_amdgcn_readlane(__builtin_bit_cast(int, v), 16)))
         + (__builtin_bit_cast(float, __builtin_amdgcn_readlane(__builtin_bit_cast(int, v), 32)) + __builtin_bit_cast(float, __builtin_amdgcn_readlane(__builtin_bit_cast(int, v), 48)));
}
__device__ __forceinline__ float max64(float v) {
    v = max16(v);
    return fmaxf(fmaxf(__builtin_bit_cast(float, __builtin_amdgcn_readlane(__builtin_bit_cast(int, v), 0)), __builtin_bit_cast(float, __builtin_amdgcn_readlane(__builtin_bit_cast(int, v), 16))),
                 fmaxf(__builtin_bit_cast(float, __builtin_amdgcn_readlane(__builtin_bit_cast(int, v), 32)), __builtin_bit_cast(float, __builtin_amdgcn_readlane(__builtin_bit_cast(int, v), 48))));
}
__device__ __forceinline__ float sum8(float v) { v += fdpp_x1(v); v += fdpp_x2(v); return v + fdpp_hm(v); }
__device__ __forceinline__ float sum4(float v) { v += fdpp_x1(v); return v + fdpp_x2(v); }
__device__ __forceinline__ float sum_x32(float v) { return v + __shfl_xor(v, 32); }
__device__ __forceinline__ float max_x32(float v) { return fmaxf(v, __shfl_xor(v, 32)); }
__device__ __forceinline__ float sum_x16(float v) { return v + __shfl_xor(v, 16); }
namespace pg8 {
#define PG8_LAS __attribute__((address_space(3)))
typedef unsigned short bf16_t;
typedef short bf16x8 __attribute__((ext_vector_type(8)));
typedef float f32x4 __attribute__((ext_vector_type(4)));
typedef unsigned u32x4 __attribute__((ext_vector_type(4)));
constexpr int BM = 256, BK = 64, HALF = 128, HTB = HALF * BK * 2  , STAGE_BYTES = 8 * HTB, NXCD = 8, WGM = 8;

__host__ __device__ __forceinline__ int lds_byte(int r, int c) { const int st = (r >> 4) * 2 + (c >> 5), rr = r & 15, cc = c & 31, ob = rr * 64 + cc * 2; return st * 1024 + (ob ^ (((ob >> 9) & 1) << 5)); }
__host__ __device__ __forceinline__ void stage_rc(int b, int& R, int& C) { const int st = b / 1024, sb = b % 1024, swz = sb ^ (((sb >> 9) & 1) << 5); R = (st >> 1) * 16 + swz / 64; C = (st & 1) * 32 + (swz % 64) / 2; }
__host__ __device__ __forceinline__ int perm32(int rho) { const int n = rho >> 4, i = rho & 15; return 8 * (i >> 2) + 4 * n + (i & 3); }

struct Unit { int pm, pn; };
struct Gemm { const bf16_t* A; const bf16_t* Bt; int M, N, K; };

struct StaticOrder {
    int nM, nN, nwg, G, c;
    __host__ __device__ void init(int M, int N, int G_, int c_) { nM = M / BM; nN = N / BM; nwg = nM * nN; G = G_; c = c_; }
    __host__ __device__ bool next(int i, Unit& u) const {
        const long L = (long)i * G + c; if (L >= nwg) return false;
        int wgid = (int)L; { const int q = nwg / NXCD, r = nwg % NXCD, xcd = wgid % NXCD, off = wgid / NXCD; wgid = (xcd < r ? xcd * (q + 1) : r * (q + 1) + (xcd - r) * q) + off; }
        const int nig = WGM * nN, gid = wgid / nig, fm = gid * WGM, gsz = (nM - fm) < WGM ? (nM - fm) : WGM;
        u.pm = fm + ((wgid % nig) % gsz); u.pn = (wgid % nig) / gsz; return true;
    }
    __device__ __forceinline__ void a_ready(const Unit&) const {}
    __device__ __forceinline__ void done(const Unit&) const {}
};

__device__ __forceinline__ unsigned cvt_pk_bf16(float lo, float hi) { unsigned r; asm volatile("v_cvt_pk_bf16_f32 %0, %1, %2" : "=v"(r) : "v"(lo), "v"(hi)); return r; }
typedef unsigned u32x2 __attribute__((ext_vector_type(2)));
struct Order1 {
    int G, c;
    __device__ __forceinline__ bool next(int i, Unit& u) const {
        const int L = i * G + c; if (L >= 837) return false;
        if (L >= 832) { u.pm = 64; u.pn = 4 + (L - 832); return true; }
        const int nwg = 832, nN = 13;
        int wgid = L; { const int q = nwg / NXCD, xcd = wgid % NXCD, off = wgid / NXCD; wgid = xcd * q + off; }
        const int nig = WGM * nN, gid = wgid / nig, fm = gid * WGM;
        u.pm = fm + ((wgid % nig) % WGM); u.pn = (wgid % nig) / WGM; return true;
    }
    __device__ __forceinline__ void a_ready(const Unit&) const {}
    __device__ __forceinline__ void done(const Unit&) const {}
};
struct Order2 {
    int G, c;
    __device__ __forceinline__ bool next(int i, Unit& u) const {
        const int L = i * G + c; if (L >= 512) return false;
        const int nwg = 512, nN = 8;
        int wgid = L; { const int q = nwg / NXCD, xcd = wgid % NXCD, off = wgid / NXCD; wgid = xcd * q + off; }
        const int nig = WGM * nN, gid = wgid / nig, fm = gid * WGM;
        u.pm = fm + ((wgid % nig) % WGM); u.pn = (wgid % nig) / WGM; return true;
    }
    __device__ __forceinline__ void a_ready(const Unit&) const {}
    __device__ __forceinline__ void done(const Unit&) const {}
};

struct Epi1 {
    static constexpr bool PERM = true, AFTER_DRAIN = false, MIDK = false, INIT = false;
    bf16_t *Q, *KV, *XB, *GT; const float* rstd; const float* bias;
    __device__ __forceinline__ void midk(f32x4 (&acc)[2][2][4][2], const Unit& u, int wr, int wc, int fr, int fq) const {}
    __device__ __forceinline__ void operator()(const f32x4 (&acc)[2][2][4][2], const Unit& u, int wr, int wc, int fr, int fq) const {
        const int row0 = u.pm * BM + wr * 64 + fr;
        bf16_t* base; int ldc, colb; float sc = 1.f;
        if (u.pn < 4) { base = Q; ldc = 1024; colb = u.pn * BM; sc = QSCALE; }
        else if (u.pn == 4) { base = KV; ldc = 256; colb = 0; }
        else if (u.pn < 9) { base = XB; ldc = 1024; colb = (u.pn - 5) * BM; }
        else { base = GT; ldc = 1024; colb = (u.pn - 9) * BM; }
        const int col0 = colb + wc * 32 + 8 * fq, bcol0 = u.pn * BM + wc * 32 + 8 * fq;
        f32x4 bv[2][2];
#pragma unroll
        for (int bj = 0; bj < 2; ++bj)
#pragma unroll
            for (int n = 0; n < 2; ++n) bv[bj][n] = *(const f32x4*)(bias + bcol0 + bj * HALF + 4 * n);
#pragma unroll
        for (int ai = 0; ai < 2; ++ai)
#pragma unroll
            for (int m = 0; m < 4; ++m) {
                const int row = row0 + ai * HALF + m * 16; const float rs = rstd[row];
                bf16_t* rowp = base + (size_t)row * ldc + col0;
#pragma unroll
                for (int bj = 0; bj < 2; ++bj) {
                    f32x4 v0 = (acc[ai][bj][m][0] * rs + bv[bj][0]) * sc, v1 = (acc[ai][bj][m][1] * rs + bv[bj][1]) * sc;
                    u32x4 w; w.x = cvt_pk_bf16(v0[0], v0[1]); w.y = cvt_pk_bf16(v0[2], v0[3]); w.z = cvt_pk_bf16(v1[0], v1[1]); w.w = cvt_pk_bf16(v1[2], v1[3]);
                    *(u32x4*)(rowp + bj * HALF) = w; } }
    }
};
struct Epi2 {
    static constexpr bool PERM = true, AFTER_DRAIN = false, MIDK = true, INIT = true;
    bf16_t* H1; const bf16_t* xb; float* SS2; const LAS float* tbl; int pm0;
    __device__ __forceinline__ void init(f32x4 (&acc)[2][2][4][2], const Unit& u, int wr, int wc, int fr, int fq) const {
        const LAS float* t = tbl + (u.pm == pm0 ? 0 : 1024);
        const int col0 = u.pn * BM + wc * 32 + 8 * fq;
#pragma unroll
        for (int ai = 0; ai < 2; ++ai)
#pragma unroll
            for (int m = 0; m < 4; ++m) {
                const int rl = ai * HALF + wr * 64 + m * 16 + fr; const size_t row = (size_t)u.pm * BM + rl; const float ia = t[rl * 4 + 2];
#pragma unroll
                for (int bj = 0; bj < 2; ++bj) {
                    const u32x4 xw = *(const u32x4*)(xb + row * 2048 + col0 + bj * HALF);
                    acc[ai][bj][m][0] = (f32x4){__builtin_bit_cast(float, xw.x << 16), __builtin_bit_cast(float, xw.x & 0xffff0000u), __builtin_bit_cast(float, xw.y << 16), __builtin_bit_cast(float, xw.y & 0xffff0000u)} * ia;
                    acc[ai][bj][m][1] = (f32x4){__builtin_bit_cast(float, xw.z << 16), __builtin_bit_cast(float, xw.z & 0xffff0000u), __builtin_bit_cast(float, xw.w << 16), __builtin_bit_cast(float, xw.w & 0xffff0000u)} * ia; }
            }
    }
    __device__ __forceinline__ void midk(f32x4 (&acc)[2][2][4][2], const Unit& u, int wr, int wc, int fr, int fq) const {
        const LAS float* t = tbl + (u.pm == pm0 ? 0 : 1024);
#pragma unroll
        for (int ai = 0; ai < 2; ++ai)
#pragma unroll
            for (int m = 0; m < 4; ++m) { const float ra = t[(ai * HALF + wr * 64 + m * 16 + fr) * 4];
#pragma unroll
                for (int bj = 0; bj < 2; ++bj)
#pragma unroll
                    for (int n = 0; n < 2; ++n) acc[ai][bj][m][n] = acc[ai][bj][m][n] * ra; }
    }
    __device__ __forceinline__ void operator()(const f32x4 (&acc)[2][2][4][2], const Unit& u, int wr, int wc, int fr, int fq) const {
        const LAS float* t = tbl + (u.pm == pm0 ? 0 : 1024);
        const int col0 = u.pn * BM + wc * 32 + 8 * fq;
#pragma unroll
        for (int ai = 0; ai < 2; ++ai)
#pragma unroll
            for (int m = 0; m < 4; ++m) {
                const int rl = ai * HALF + wr * 64 + m * 16 + fr; const size_t row = (size_t)u.pm * BM + rl; const float rs = t[rl * 4 + 1];
                float ss = 0.f;
#pragma unroll
                for (int bj = 0; bj < 2; ++bj) {
                    const f32x4 v0 = acc[ai][bj][m][0] * rs, v1 = acc[ai][bj][m][1] * rs;
                    ss += (v0[0] * v0[0] + v0[1] * v0[1]) + (v0[2] * v0[2] + v0[3] * v0[3]) + (v1[0] * v1[0] + v1[1] * v1[1]) + (v1[2] * v1[2] + v1[3] * v1[3]);
                    u32x4 w; w.x = cvt_pk_bf16(v0[0], v0[1]); w.y = cvt_pk_bf16(v0[2], v0[3]); w.z = cvt_pk_bf16(v1[0], v1[1]); w.w = cvt_pk_bf16(v1[2], v1[3]);
                    *(u32x4*)(H1 + row * 2048 + col0 + bj * HALF) = w; }
                ss = sum_x32(sum_x16(ss));
                if (fq == 0) SS2[row * 32 + u.pn * 4 + wc] = ss;
            }
    }
};
struct Epi3 {
    static constexpr bool PERM = true, AFTER_DRAIN = false, MIDK = false, INIT = false;
    bf16_t* O;
    __device__ __forceinline__ void midk(f32x4 (&acc)[2][2][4][2], const Unit& u, int wr, int wc, int fr, int fq) const {}
    __device__ __forceinline__ void operator()(const f32x4 (&acc)[2][2][4][2], const Unit& u, int wr, int wc, int fr, int fq) const {
        const int col0 = u.pn * BM + wc * 32 + 8 * fq;
#pragma unroll
        for (int ai = 0; ai < 2; ++ai)
#pragma unroll
            for (int m = 0; m < 4; ++m) { const size_t row = (size_t)u.pm * BM + ai * HALF + wr * 64 + m * 16 + fr;
#pragma unroll
                for (int bj = 0; bj < 2; ++bj) { const f32x4 v0 = acc[ai][bj][m][0], v1 = acc[ai][bj][m][1];
                    u32x4 w; w.x = cvt_pk_bf16(v0[0], v0[1]); w.y = cvt_pk_bf16(v0[2], v0[3]); w.z = cvt_pk_bf16(v1[0], v1[1]); w.w = cvt_pk_bf16(v1[2], v1[3]);
                    *(u32x4*)(O + row * 2048 + col0 + bj * HALF) = w; } }
    }
};
template <class Epi, class Sched, bool ALIGN_EPI = false, bool SP2 = false>
__device__ __forceinline__ void gemm_phase(PG8_LAS unsigned char* lds, const Gemm g, const Sched& S, const Epi& E) {
    const int tid = threadIdx.x, wid = __builtin_amdgcn_readfirstlane(tid >> 6), lane = tid & 63, wr = wid >> 2, wc = wid & 3, fr = lane & 15, fq = lane >> 4;
    const int K = g.K, nt = K / BK;
    unsigned voffA[2], voffB[2];
#pragma unroll
    for (int i = 0; i < 2; ++i) { int R, C; stage_rc(tid * 16 + i * 8192, R, C); const int Rb = Epi::PERM ? ((R & ~31) + perm32(R & 31)) : R;
        voffA[i] = (unsigned)(R * K + C) * 2u; voffB[i] = (unsigned)(Rb * K + C) * 2u; }
    const size_t kstep = (size_t)(BK * 2);
    const size_t hstep = (size_t)HALF * K * 2;
    const size_t tstep = 2 * hstep;
    const unsigned ldsw = (unsigned)wid * 1024u;
    const int aoff = lds_byte(wr * 64 + fr, fq * 8), boff = lds_byte(wc * 32 + fr, fq * 8);
#define PG8_SA(b, h) (((b) * 2 + (h)) * HTB)
#define PG8_SB(b, h) ((4 + (b) * 2 + (h)) * HTB)
#define PG8_STAGE(bufoff, gbase, voff) do { _Pragma("unroll") for (int _i = 0; _i < 2; ++_i) \
        __builtin_amdgcn_global_load_lds((const unsigned*)((const char*)(gbase) + (voff)[_i]), (PG8_LAS unsigned*)(lds + (bufoff) + ldsw + _i * 8192), 16, 0, 0); } while (0)
#define PG8_LDA(dst, b, h) do { _Pragma("unroll") for (int m = 0; m < 4; ++m) _Pragma("unroll") for (int k = 0; k < 2; ++k) dst[m][k] = *(const PG8_LAS bf16x8*)(lds + PG8_SA(b, h) + aoff + m * 2048 + k * 1024); } while (0)
#define PG8_LDB(dst, b, h) do { _Pragma("unroll") for (int n = 0; n < 2; ++n) _Pragma("unroll") for (int k = 0; k < 2; ++k) dst[n][k] = *(const PG8_LAS bf16x8*)(lds + PG8_SB(b, h) + boff + n * 2048 + k * 1024); } while (0)
#define PG8_MMA(ai, bj, At, Bt) do { __builtin_amdgcn_s_setprio(1); _Pragma("unroll") for (int m = 0; m < 4; ++m) _Pragma("unroll") for (int n = 0; n < 2; ++n) _Pragma("unroll") for (int k = 0; k < 2; ++k) \
        acc[ai][bj][m][n] = __builtin_amdgcn_mfma_f32_16x16x32_bf16(Bt[n][k], At[m][k], acc[ai][bj][m][n], 0, 0, 0); __builtin_amdgcn_s_setprio(0); } while (0)
#define PG8_WAIT_V(n) asm volatile("s_waitcnt vmcnt(" #n ")" ::: "memory")
#define PG8_WAIT_L(n) asm volatile("s_waitcnt lgkmcnt(" #n ")" ::: "memory")
#define PG8_BAR __builtin_amdgcn_s_barrier()
#define PG8_SCHED __builtin_amdgcn_sched_barrier(0)
    Unit cur, nxt; int ui = 0;
    if (!S.next(0, cur)) return;
    f32x4 acc[2][2][4][2];
    if constexpr (Epi::INIT) E.init(acc, cur, wr, wc, fr, fq);
    else {
#pragma unroll
    for (int a = 0; a < 2; ++a)
#pragma unroll
        for (int b = 0; b < 2; ++b)
#pragma unroll
            for (int m = 0; m < 4; ++m)
#pragma unroll
                for (int n = 0; n < 2; ++n) acc[a][b][m][n] = (f32x4){0.f, 0.f, 0.f, 0.f};
    }
    bf16x8 At[4][2], B0[2][2], B1[2][2];
    const char* cA = (const char*)g.A + (size_t)cur.pm * tstep; const char* cB = (const char*)g.Bt + (size_t)cur.pn * tstep;
    S.a_ready(cur);
    if constexpr (SP2) {
        PG8_STAGE(PG8_SB(0, 0), cB, voffB); PG8_STAGE(PG8_SB(0, 1), cB + hstep, voffB); PG8_STAGE(PG8_SA(0, 0), cA, voffA); PG8_STAGE(PG8_SA(0, 1), cA + hstep, voffA);
        if (wr == 1) PG8_BAR;
        PG8_WAIT_V(2); PG8_BAR;
        PG8_STAGE(PG8_SB(1, 0), cB + kstep, voffB); PG8_STAGE(PG8_SA(1, 0), cA + kstep, voffA); PG8_STAGE(PG8_SB(1, 1), cB + hstep + kstep, voffB);
        PG8_WAIT_V(6); PG8_BAR;
    } else {
        PG8_STAGE(PG8_SB(0, 0), cB, voffB); PG8_STAGE(PG8_SA(0, 0), cA, voffA); PG8_STAGE(PG8_SB(0, 1), cB + hstep, voffB); PG8_STAGE(PG8_SA(0, 1), cA + hstep, voffA);
        if (wr == 1) PG8_BAR;
        PG8_WAIT_V(4); PG8_BAR;
        PG8_STAGE(PG8_SB(1, 0), cB + kstep, voffB); PG8_STAGE(PG8_SA(1, 0), cA + kstep, voffA); PG8_STAGE(PG8_SB(1, 1), cB + hstep + kstep, voffB);
        PG8_WAIT_V(6); PG8_BAR;
    }
    for (;;) {
        const bool has_next = S.next(ui + 1, nxt);
        const char* nA = has_next ? (const char*)g.A + (size_t)nxt.pm * tstep : cA; const char* nB = has_next ? (const char*)g.Bt + (size_t)nxt.pn * tstep : cB;
        for (int t = 0; t < nt; t += 2) {
            if constexpr (Epi::MIDK) { if (t == nt / 2) E.midk(acc, cur, wr, wc, fr, fq); }
            const bool last = (t == nt - 2);
            const char* a1 = cA + (size_t)(t + 1) * kstep;
            const char* a2 = last ? nA : cA + (size_t)(t + 2) * kstep; const char* b2 = last ? nB : cB + (size_t)(t + 2) * kstep;
            const char* a3 = a2 + kstep; const char* b3 = b2 + kstep;
            if (last && has_next) S.a_ready(nxt);
            if constexpr (SP2) {
            PG8_LDB(B0, 0, 0); PG8_LDB(B1, 0, 1); PG8_SCHED; PG8_LDA(At, 0, 0); PG8_STAGE(PG8_SA(1, 1), a1 + hstep, voffA);
            PG8_WAIT_V(8); PG8_WAIT_L(0); PG8_BAR; PG8_MMA(0, 0, At, B0); PG8_MMA(0, 1, At, B1); PG8_BAR; PG8_SCHED;
            PG8_LDA(At, 0, 1); PG8_STAGE(PG8_SB(0, 0), b2, voffB); PG8_STAGE(PG8_SB(0, 1), b2 + hstep, voffB); PG8_STAGE(PG8_SA(0, 0), a2, voffA);
            PG8_WAIT_V(8); PG8_WAIT_L(0); PG8_BAR; PG8_MMA(1, 0, At, B0); PG8_MMA(1, 1, At, B1); PG8_BAR; PG8_SCHED;
            PG8_LDB(B0, 1, 0); PG8_LDB(B1, 1, 1); PG8_SCHED; PG8_LDA(At, 1, 0); PG8_STAGE(PG8_SA(0, 1), a2 + hstep, voffA);
            PG8_WAIT_V(8); PG8_WAIT_L(0); PG8_BAR; PG8_MMA(0, 0, At, B0); PG8_MMA(0, 1, At, B1); PG8_BAR; PG8_SCHED;
            PG8_LDA(At, 1, 1); PG8_STAGE(PG8_SB(1, 0), b3, voffB); PG8_STAGE(PG8_SB(1, 1), b3 + hstep, voffB); PG8_STAGE(PG8_SA(1, 0), a3, voffA);
            PG8_WAIT_V(8); PG8_WAIT_L(0); PG8_BAR; PG8_MMA(1, 0, At, B0); PG8_MMA(1, 1, At, B1); PG8_BAR; PG8_SCHED;
            } else {
            PG8_LDB(B0, 0, 0); PG8_SCHED; PG8_LDA(At, 0, 0); PG8_STAGE(PG8_SA(1, 1), a1 + hstep, voffA);
            PG8_WAIT_L(8); PG8_BAR; PG8_WAIT_L(0); PG8_MMA(0, 0, At, B0); PG8_BAR; PG8_SCHED;
            PG8_LDB(B1, 0, 1); PG8_STAGE(PG8_SB(0, 0), b2, voffB);
            PG8_BAR; PG8_WAIT_L(0); PG8_MMA(0, 1, At, B1); PG8_BAR;
            PG8_LDA(At, 0, 1); PG8_STAGE(PG8_SA(0, 0), a2, voffA);
            PG8_BAR; PG8_WAIT_L(0); PG8_MMA(1, 0, At, B0); PG8_BAR; PG8_SCHED;
            PG8_STAGE(PG8_SB(0, 1), b2 + hstep, voffB);
            PG8_WAIT_V(6); PG8_BAR; PG8_MMA(1, 1, At, B1); PG8_BAR;
            PG8_LDB(B0, 1, 0); PG8_SCHED; PG8_LDA(At, 1, 0); PG8_STAGE(PG8_SA(0, 1), a2 + hstep, voffA);
            PG8_WAIT_L(8); PG8_BAR; PG8_WAIT_L(0); PG8_MMA(0, 0, At, B0); PG8_BAR; PG8_SCHED;
            PG8_LDB(B1, 1, 1); PG8_STAGE(PG8_SB(1, 0), b3, voffB);
            PG8_BAR; PG8_WAIT_L(0); PG8_MMA(0, 1, At, B1); PG8_BAR;
            PG8_LDA(At, 1, 1); PG8_STAGE(PG8_SA(1, 0), a3, voffA);
            PG8_BAR; PG8_WAIT_L(0); PG8_MMA(1, 0, At, B0); PG8_BAR; PG8_SCHED;
            PG8_STAGE(PG8_SB(1, 1), b3 + hstep, voffB);
            PG8_WAIT_V(6); PG8_BAR; PG8_MMA(1, 1, At, B1); PG8_BAR;
            }
        }
        if constexpr (ALIGN_EPI) { if (wr == 0) PG8_BAR; }
        if constexpr (!Epi::AFTER_DRAIN) { E(acc, cur, wr, wc, fr, fq); S.done(cur); }
        if (!has_next) break;
        if constexpr (Epi::INIT) E.init(acc, nxt, wr, wc, fr, fq);
        else {
#pragma unroll
        for (int a = 0; a < 2; ++a)
#pragma unroll
            for (int b = 0; b < 2; ++b)
#pragma unroll
                for (int m = 0; m < 4; ++m)
#pragma unroll
                    for (int n = 0; n < 2; ++n) acc[a][b][m][n] = (f32x4){0.f, 0.f, 0.f, 0.f};
        }
        cur = nxt; cA = nA; cB = nB; ++ui;
        if constexpr (ALIGN_EPI) { if (wr == 1) PG8_BAR; }
    }
    PG8_WAIT_V(0);
    if constexpr (!ALIGN_EPI) { if (wr == 0) PG8_BAR; }
    PG8_BAR;
    if constexpr (Epi::AFTER_DRAIN) { E.fused(acc, cur, wr, wc, fr, fq, lds, wid, lane); S.done(cur); }
#undef PG8_SA
#undef PG8_SB
#undef PG8_STAGE
#undef PG8_LDA
#undef PG8_LDB
#undef PG8_MMA
#undef PG8_WAIT_V
#undef PG8_WAIT_L
#undef PG8_BAR
#undef PG8_SCHED
}
}
#define XB_TMO      128
#define XB_XCNT(j)  (256  + 64 * (j))
#define XB_XSUB(j)  (1280 + 64 * (j))
#define XB_XGEN(j)  (2304 + 64 * (j))
#define XB_TOP      3328
#define XB_TOPGEN   3392
#define XCD_BAR_WORDS 3456
#define XB_SPIN_CAP (1u << 18)

__device__ __forceinline__ unsigned xb_ld(unsigned* p)              { return __hip_atomic_load(p, __ATOMIC_RELAXED, __HIP_MEMORY_SCOPE_AGENT); }
__device__ __forceinline__ unsigned xb_add(unsigned* p, unsigned v) { return __hip_atomic_fetch_add(p, v, __ATOMIC_RELAXED, __HIP_MEMORY_SCOPE_AGENT); }
__device__ __forceinline__ unsigned xb_xcc_id() { return (unsigned)__builtin_amdgcn_s_getreg((3 << 11) | 20) & 0xFu; }
#define XB_SPIN(cond, bar) do { unsigned _sp = 0; while (cond) { __builtin_amdgcn_s_sleep(1); \
    if ((++_sp & 255u) == 0u) { if (xb_ld(&(bar)[XB_TMO])) break; if (_sp > XB_SPIN_CAP) { atomicAdd(&(bar)[XB_TMO], 1u); break; } } } } while (0)

struct XcdBarrier {
    unsigned* bar; unsigned x;
    volatile LAS unsigned* st;
};

__device__ __forceinline__ XcdBarrier xcd_barrier_post(unsigned* bar, volatile LAS unsigned* st) {
    XcdBarrier b; b.bar = bar; b.x = xb_xcc_id(); b.st = st;
    if (threadIdx.x == 0) (void)xb_add(&bar[XB_XCNT(b.x)], 1u);
    return b;
}
__device__ __forceinline__ void xcd_barrier_complete(unsigned* bar, unsigned x, unsigned& nloc, unsigned& nx) {
    const unsigned G = gridDim.x * gridDim.y * gridDim.z;
    unsigned sum, cnt, mine, sp = 0u;
    for (;;) {
        sum = 0u; cnt = 0u; mine = 0u;
#pragma unroll
        for (unsigned j = 0; j < 16; ++j) { const unsigned c = xb_ld(&bar[XB_XCNT(j)]); sum += c; cnt += (c > 0u) ? 1u : 0u; mine = (j == x) ? c : mine; }
        if (sum == G) break;
        __builtin_amdgcn_s_sleep(1);
        if ((++sp & 255u) == 0u) { if (xb_ld(&bar[XB_TMO])) break; if (sp > XB_SPIN_CAP) { atomicAdd(&bar[XB_TMO], 1u); break; } }
    }
    nloc = mine > 0u ? mine : 1u; nx = cnt > 0u ? cnt : 1u;
}

__device__ __forceinline__ void xcd_barrier(const XcdBarrier& b) {
    asm volatile("s_waitcnt vmcnt(0)" ::: "memory");
    __syncthreads();
    if (threadIdx.x == 0) {
        unsigned* bar = b.bar;
        __builtin_amdgcn_s_waitcnt(0);
        unsigned nloc = b.st[0], nx = b.st[1];
        if (nloc == 0u) { xcd_barrier_complete(bar, b.x, nloc, nx); b.st[0] = nloc; b.st[1] = nx; }
        const unsigned old = xb_add(&bar[XB_XSUB(b.x)], 1u);
        const unsigned gen = old / nloc;
        if (old + 1u == (gen + 1u) * nloc) {
            __builtin_amdgcn_fence(__ATOMIC_RELEASE, "agent");
            asm volatile("s_waitcnt vmcnt(0)" ::: "memory");
            const unsigned og = xb_add(&bar[XB_TOP], 1u);
            const unsigned tg = og / nx;
            if (og + 1u == (tg + 1u) * nx) xb_add(&bar[XB_TOPGEN], 1u);
            else XB_SPIN(xb_ld(&bar[XB_TOPGEN]) == tg, bar);
            __builtin_amdgcn_fence(__ATOMIC_ACQUIRE, "agent");
            xb_add(&bar[XB_XGEN(b.x)], 1u);
            asm volatile("s_waitcnt vmcnt(0)" ::: "memory");
        } else {
            XB_SPIN(xb_ld(&bar[XB_XGEN(b.x)]) == gen, bar);
            __builtin_amdgcn_fence(__ATOMIC_ACQUIRE, "agent");
            asm volatile("s_waitcnt vmcnt(0)" ::: "memory");
        }
    }
    __syncthreads();
}

constexpr int NWAVES = 8;
constexpr size_t MiB = 1u << 20;
constexpr size_t WS_CTL = 0, CTL_ZERO_BYTES = 1 * MiB;
constexpr size_t WS_W1T = 2 * MiB;
constexpr size_t WS_W2T = 16 * MiB;
constexpr size_t WS_W3T = 24 * MiB;
constexpr size_t WS_SKB = 32 * MiB;
constexpr size_t WS_RSTD1 = 33 * MiB;
constexpr size_t WS_SSA = 34 * MiB;
constexpr size_t WS_SSL = 35 * MiB;
constexpr size_t WS_SS2 = 37 * MiB;
constexpr size_t WS_RSTD2 = 39 * MiB;
constexpr size_t WS_IDS = 40 * MiB;
constexpr size_t WS_GW = 48 * MiB;
constexpr size_t WS_U8 = 64 * MiB;
constexpr size_t WS_V8 = 96 * MiB;
constexpr size_t WS_X8 = 128 * MiB;
constexpr size_t WS_SX = 160 * MiB;
constexpr size_t WS_SCU = 162 * MiB;
constexpr size_t WS_SCV = 163 * MiB;
constexpr size_t WS_WSUM = 164 * MiB;
constexpr size_t WS_A1 = 192 * MiB;
constexpr size_t WS_Q = 258 * MiB;
constexpr size_t WS_KV = 290 * MiB;
constexpr size_t WS_XB = 299 * MiB;
constexpr size_t WS_GT = 332 * MiB;
constexpr size_t WS_H1 = 364 * MiB;
constexpr size_t WS_PART = 192 * MiB;
constexpr size_t WS_W = 56 * MiB;
constexpr size_t WS_Z = 428 * MiB;
constexpr size_t WS_END = 492 * MiB;
constexpr int CW_QROW = 2048;
constexpr int CW_BAR = 4096;

constexpr int RING_OFF = 0, RING_BYTES = 131072;
constexpr int LDSCTL_OFF = RING_BYTES, MISC_OFF = LDSCTL_OFF + 320;
constexpr int LDS_BYTES = 147456;

typedef unsigned short bf16;
typedef unsigned v4u __attribute__((ext_vector_type(4)));
typedef float f32x4 __attribute__((ext_vector_type(4)));
typedef short bf16x8 __attribute__((ext_vector_type(8)));
typedef GAS unsigned gu32;
#define RLX_AGENT __ATOMIC_RELAXED, __HIP_MEMORY_SCOPE_AGENT
#define LDS_WAIT() asm volatile("s_waitcnt lgkmcnt(0)" ::: "memory")
#define VM_WAIT() asm volatile("s_waitcnt vmcnt(0)" ::: "memory")
__device__ __forceinline__ unsigned f2bf(float f) { unsigned u = __builtin_bit_cast(unsigned, f); return (u + 0x7fffu + ((u >> 16) & 1u)) >> 16; }
__device__ __forceinline__ unsigned pk2(float lo, float hi) { return f2bf(lo) | (f2bf(hi) << 16); }
__device__ __forceinline__ float bf2f(unsigned short b) { return __builtin_bit_cast(float, (unsigned)b << 16); }


namespace p2 {
typedef float f32x16 __attribute__((ext_vector_type(16)));
typedef unsigned u32x2 __attribute__((ext_vector_type(2)));
constexpr float LOG2E = 1.4426950408889634f;
constexpr float NEGBIG = -1e30f;
__device__ __forceinline__ int crow(int r, int hi) { return (r & 3) + 8 * (r >> 2) + 4 * hi; }
__device__ __forceinline__ unsigned cvtpk(float lo, float hi) { unsigned r; asm volatile("v_cvt_pk_bf16_f32 %0, %1, %2" : "=v"(r) : "v"(lo), "v"(hi)); return r; }
__device__ __forceinline__ float ex2(float x) { return __builtin_amdgcn_exp2f(x); }
__device__ __forceinline__ float rcp(float x) { return __builtin_amdgcn_rcpf(x); }
__device__ __forceinline__ float gelu_fast(float x) { return x * rcp(1.0f + ex2(x * (-2.302208198f - 0.102943240f * (x * x)))); }

constexpr int A_KS = 0, A_KSP = 144, A_VT = 288 * 144, A_VTP = 584, A_ST = A_VT + 64 * 584, A_END = A_ST + 8 * 4096;
__device__ __forceinline__ void attn_unit(LAS unsigned char* lds, int b, int qblk, int kvh, const bf16* QB, const bf16* KVB, const float* sinks, bf16* MIX, float* SSA, int tid) {
    const int lane = tid & 63, wave = __builtin_amdgcn_readfirstlane(tid >> 6), r = lane & 31, hi = lane >> 5;
    const int q0 = qblk * 128, hq = kvh * 8 + wave;
    for (int it = 0; it < 5; ++it) {
        const int cid = it * 512 + tid;
        if (cid < 288 * 8) {
            const int key = cid >> 3, ch = cid & 7;
            bool valid; size_t row = 0;
            if (key < 256) { const int pos = q0 - 128 + key; valid = pos >= 0; row = (size_t)b * SEQ + pos; }
            else if (key < 272) { valid = true; row = (size_t)MREAL + (key - 256); }
            else valid = false;
            v4u kv = {0u, 0u, 0u, 0u}, vv = {0u, 0u, 0u, 0u};
            if (valid) { kv = *(const GAS v4u*)(KVB + row * 256 + kvh * 64 + ch * 8); vv = *(const GAS v4u*)(KVB + row * 256 + 128 + kvh * 64 + ch * 8); }
            *(LAS v4u*)(lds + A_KS + key * A_KSP + ch * 16) = kv;
            LAS unsigned short* vt = (LAS unsigned short*)(lds + A_VT);
#pragma unroll
            for (int j = 0; j < 8; ++j) { const unsigned wv = vv[j >> 1]; vt[(ch * 8 + j) * (A_VTP / 2) + key] = (unsigned short)((j & 1) ? (wv >> 16) : (wv & 0xffffu)); }
        }
    }
    __syncthreads();
    const float sink2 = sinks[hq] * LOG2E;
    bf16x8 qf[4];
#pragma unroll
    for (int ks = 0; ks < 4; ++ks) qf[ks] = *(const GAS bf16x8*)(QB + ((size_t)b * SEQ + q0 + r) * 1024 + hq * 64 + ks * 16 + hi * 8);
    for (int qg = 0; qg < 4; ++qg) {
        f32x16 s[6];
#pragma unroll
        for (int t = 0; t < 6; ++t) {
            const int kbase = t < 5 ? 32 * (qg + t) : 256;
            f32x16 acc = {0.f, 0.f, 0.f, 0.f, 0.f, 0.f, 0.f, 0.f, 0.f, 0.f, 0.f, 0.f, 0.f, 0.f, 0.f, 0.f};
#pragma unroll
            for (int ks = 0; ks < 4; ++ks) {
                const bf16x8 kf = *(const LAS bf16x8*)(lds + A_KS + (kbase + r) * A_KSP + ks * 32 + hi * 16);
                acc = __builtin_amdgcn_mfma_f32_32x32x16_bf16(kf, qf[ks], acc, 0, 0, 0);
            }
            s[t] = acc;
        }
        if (qg + 1 < 4) {
#pragma unroll
            for (int ks = 0; ks < 4; ++ks) qf[ks] = *(const GAS bf16x8*)(QB + ((size_t)b * SEQ + q0 + 32 * (qg + 1) + r) * 1024 + hq * 64 + ks * 16 + hi * 8);
        }
        const bool blk0 = (qblk == 0);
#pragma unroll
        for (int reg = 0; reg < 16; ++reg) {
            const int j = crow(reg, hi);
            s[0][reg] = (j > r) ? s[0][reg] : NEGBIG;
            s[4][reg] = (j <= r) ? s[4][reg] : NEGBIG;
            if (reg >= 8) s[5][reg] = NEGBIG;
        }
#pragma unroll
        for (int t = 0; t < 4; ++t) if (blk0 && (qg + t < 4)) {
#pragma unroll
            for (int reg = 0; reg < 16; ++reg) s[t][reg] = NEGBIG;
        }
        float m = sink2;
#pragma unroll
        for (int t = 0; t < 6; ++t)
#pragma unroll
            for (int reg = 0; reg < (t == 5 ? 8 : 16); ++reg) m = fmaxf(m, s[t][reg]);
        m = max_x32(m);
        float l = 0.f;
#pragma unroll
        for (int t = 0; t < 6; ++t)
#pragma unroll
            for (int reg = 0; reg < (t == 5 ? 8 : 16); ++reg) { const float p = ex2(s[t][reg] - m); s[t][reg] = p; l += p; }
        l = sum_x32(l);
        l += ex2(sink2 - m);
        const float linv = 1.0f / l;
        f32x16 o0 = {0.f, 0.f, 0.f, 0.f, 0.f, 0.f, 0.f, 0.f, 0.f, 0.f, 0.f, 0.f, 0.f, 0.f, 0.f, 0.f}, o1 = o0;
#pragma unroll
        for (int t = 0; t < 6; ++t) {
            const int kbase = t < 5 ? 32 * (qg + t) : 256;
#pragma unroll
            for (int ss = 0; ss < (t == 5 ? 1 : 2); ++ss) {
                v4u pw; pw.x = cvtpk(s[t][8 * ss + 0], s[t][8 * ss + 1]); pw.y = cvtpk(s[t][8 * ss + 2], s[t][8 * ss + 3]);
                pw.z = cvtpk(s[t][8 * ss + 4], s[t][8 * ss + 5]); pw.w = cvtpk(s[t][8 * ss + 6], s[t][8 * ss + 7]);
                const bf16x8 pa = __builtin_bit_cast(bf16x8, pw);
                const int ko = (kbase + 16 * ss + 4 * hi) * 2;
                {   const u32x2 lo = *(const LAS u32x2*)(lds + A_VT + r * A_VTP + ko), h2 = *(const LAS u32x2*)(lds + A_VT + r * A_VTP + ko + 16);
                    v4u vw; vw.x = lo.x; vw.y = lo.y; vw.z = h2.x; vw.w = h2.y;
                    o0 = __builtin_amdgcn_mfma_f32_32x32x16_bf16(pa, __builtin_bit_cast(bf16x8, vw), o0, 0, 0, 0); }
                {   const u32x2 lo = *(const LAS u32x2*)(lds + A_VT + (32 + r) * A_VTP + ko), h2 = *(const LAS u32x2*)(lds + A_VT + (32 + r) * A_VTP + ko + 16);
                    v4u vw; vw.x = lo.x; vw.y = lo.y; vw.z = h2.x; vw.w = h2.y;
                    o1 = __builtin_amdgcn_mfma_f32_32x32x16_bf16(pa, __builtin_bit_cast(bf16x8, vw), o1, 0, 0, 0); }
            }
        }
        LAS unsigned short* stg = (LAS unsigned short*)(lds + A_ST + wave * 4096);
#pragma unroll
        for (int reg = 0; reg < 16; ++reg) {
            const int qr = crow(reg, hi); const float li = __shfl(linv, qr);
            stg[qr * 64 + r] = (unsigned short)f2bf(o0[reg] * li);
            stg[qr * 64 + 32 + r] = (unsigned short)f2bf(o1[reg] * li);
        }
        asm volatile("s_waitcnt lgkmcnt(0)" ::: "memory");
#pragma unroll
        for (int i = 0; i < 4; ++i) {
            const int row = i * 8 + (lane >> 3), ch = lane & 7;
            const v4u v = *(const LAS v4u*)(stg + row * 64 + ch * 8);
            float ss = 0.f;
#pragma unroll
            for (int k = 0; k < 4; ++k) { const float a = __builtin_bit_cast(float, v[k] << 16), c = __builtin_bit_cast(float, v[k] & 0xffff0000u); ss += a * a + c * c; }
            ss = sum8(ss);
            const size_t orow = (size_t)b * SEQ + q0 + 32 * qg + row;
            *(GAS v4u*)(MIX + orow * D + hq * 64 + ch * 8) = v;
            if (ch == 0) SSA[orow * 16 + hq] = ss;
        }
        asm volatile("s_waitcnt lgkmcnt(0)" ::: "memory");
    }
    __syncthreads();
}

constexpr int LW_XS = 0, LW_GS = 4608, LW_XC = LW_GS + 2048, LW_XCF = LW_XC + 4608, LW_BYTES = LW_XCF + 4096 + 128;
constexpr int L_CT = 8 * LW_BYTES, L_END = L_CT + 2 * 2048;
static_assert(L_END <= 131072, "lru lds");
struct LruP { const float *conv_w, *conv_b, *w_r, *b_r, *w_i, *b_i, *lam; };
__device__ __forceinline__ void lru_unit(LAS unsigned char* lds, LAS unsigned char* ldsw  , int b, int nb, int cg, const bf16* XBB, const bf16* GTB, const LruP P, bf16* MIX, float* SSL, int tid) {
    const int lane = tid & 63, wave = __builtin_amdgcn_readfirstlane(tid >> 6), r = lane & 31, hi = lane >> 5;
    LAS unsigned char* lw = lds + wave * LW_BYTES;
    {
        LAS unsigned short* wt = (LAS unsigned short*)ldsw;
#pragma unroll
        for (int i = 0; i < 4; ++i) {
            const int e = tid + 512 * i, c = e >> 5, dl = e & 31;
            const size_t gi = (size_t)(nb * 64 + c) * 64 + 32 * cg + dl;
            wt[dl * 72 + c] = (unsigned short)f2bf(-LOG2E * P.w_r[gi]);
            wt[32 * 72 + dl * 72 + c] = (unsigned short)f2bf(-LOG2E * P.w_i[gi]);
        }
    }
    const int cc = lane, chc = nb * 64 + cc;
    const float cw0 = P.conv_w[0 * LW + chc], cw1 = P.conv_w[1 * LW + chc], cw2 = P.conv_w[2 * LW + chc], cw3 = P.conv_w[3 * LW + chc], cbv = P.conv_b[chc];
    const int chd = nb * 64 + 32 * cg + r;
    const float br = -LOG2E * P.b_r[chd], bi = -LOG2E * P.b_i[chd];
    const float ls8 = -8.0f * log1pf(expf(-P.lam[chd])) * LOG2E;
    float state = 0.f;
    v4u px[5], pg[2];
#define LRU_PREFETCH(tl) do { \
        _Pragma("unroll") for (int it = 0; it < 5; ++it) { const int cid = it * 64 + lane; px[it] = (v4u){0u, 0u, 0u, 0u}; \
            if (cid < 35 * 8) { const int j = cid >> 3, ch = cid & 7, t = 32 * wave + j - 3; bool valid; size_t row = 0; \
                if ((tl) == 0) { valid = (t >= 0 && t < NMETA); row = (size_t)MREAL + t; } \
                else if ((tl) == 1 && t < 0) { valid = true; row = (size_t)MREAL + NMETA + t; } \
                else { valid = true; row = (size_t)b * SEQ + 256 * ((tl) - 1) + t; } \
                if (valid) px[it] = *(const GAS v4u*)(XBB + row * 1024 + nb * 64 + ch * 8); } } \
        if ((tl) > 0) { _Pragma("unroll") for (int it = 0; it < 2; ++it) { const int cid = it * 64 + lane, t = 32 * wave + (cid >> 2), ch = cid & 3; \
            pg[it] = *(const GAS v4u*)(GTB + ((size_t)b * SEQ + 256 * ((tl) - 1) + t) * 1024 + nb * 64 + 32 * cg + ch * 8); } } } while (0)
    LRU_PREFETCH(0);
    __syncthreads();
    for (int tile = 0; tile < 9; ++tile) {
#pragma unroll
        for (int it = 0; it < 5; ++it) { const int cid = it * 64 + lane; if (cid < 35 * 8) *(LAS v4u*)(lw + LW_XS + (cid >> 3) * 128 + (cid & 7) * 16) = px[it]; }
        if (tile > 0) {
#pragma unroll
            for (int it = 0; it < 2; ++it) { const int cid = it * 64 + lane; *(LAS v4u*)(lw + LW_GS + (cid >> 2) * 64 + (cid & 3) * 16) = pg[it]; }
        }
        asm volatile("s_waitcnt lgkmcnt(0)" ::: "memory");
        if (tile + 1 < 9) LRU_PREFETCH(tile + 1);
        {
            const LAS unsigned short* xs = (const LAS unsigned short*)(lw + LW_XS);
            LAS unsigned short* xc = (LAS unsigned short*)(lw + LW_XC);
            LAS float* xcf = (LAS float*)(lw + LW_XCF);
            const bool own = (cc >> 5) == cg; const int xoff = own ? (cc & 31) : 32 * 32 + (cc & 31);
            float x0 = bf2f(xs[0 * 64 + cc]), x1 = bf2f(xs[1 * 64 + cc]), x2 = bf2f(xs[2 * 64 + cc]);
#pragma unroll 8
            for (int k = 0; k < 32; ++k) {
                const float x3 = bf2f(xs[(k + 3) * 64 + cc]);
                const float v = cbv + cw0 * x0 + cw1 * x1 + cw2 * x2 + cw3 * x3;
                xc[k * 72 + cc] = (unsigned short)cvtpk(v, v);
                xcf[(own ? k * 32 : 0) + xoff] = v;
                x0 = x1; x1 = x2; x2 = x3;
            }
        }
        asm volatile("s_waitcnt lgkmcnt(0)" ::: "memory");
        f32x16 aR = {br, br, br, br, br, br, br, br, br, br, br, br, br, br, br, br}, aI = {bi, bi, bi, bi, bi, bi, bi, bi, bi, bi, bi, bi, bi, bi, bi, bi};
#pragma unroll
        for (int ks = 0; ks < 4; ++ks) {
            const bf16x8 xa = *(const LAS bf16x8*)(lw + LW_XC + r * 144 + ks * 32 + hi * 16);
            const bf16x8 wr_ = *(const LAS bf16x8*)(ldsw + r * 144 + ks * 32 + hi * 16);
            const bf16x8 wi_ = *(const LAS bf16x8*)(ldsw + 32 * 144 + r * 144 + ks * 32 + hi * 16);
            aR = __builtin_amdgcn_mfma_f32_32x32x16_bf16(xa, wr_, aR, 0, 0, 0);
            aI = __builtin_amdgcn_mfma_f32_32x32x16_bf16(xa, wi_, aI, 0, 0, 0);
        }
        float Av[16], Bv[16];
        {
            const LAS float* xcf = (const LAS float*)(lw + LW_XCF);
#pragma unroll
            for (int reg = 0; reg < 16; ++reg) {
                const int tl = crow(reg, hi), t = 32 * wave + tl;
                const bool valid = (tile > 0) || (t < NMETA);
                const float rg = rcp(1.0f + ex2(aR[reg]));
                const float ig = rcp(1.0f + ex2(aI[reg]));
                const float a = ex2(rg * ls8);
                const float mult = __builtin_amdgcn_sqrtf(fmaxf(1.0f - a * a, 0.f));
                const float bx = mult * ig * xcf[tl * 32 + r];
                Av[reg] = valid ? a : 1.0f; Bv[reg] = valid ? bx : 0.0f;
            }
        }
#pragma unroll
        for (int g = 0; g < 4; ++g) {
#pragma unroll
            for (int k = 1; k < 4; ++k) { Bv[4 * g + k] = Av[4 * g + k] * Bv[4 * g + k - 1] + Bv[4 * g + k]; Av[4 * g + k] = Av[4 * g + k] * Av[4 * g + k - 1]; }
        }
        float myCz[4], myCp[4], PW, HW;
        {
            float cz = 0.f, cp = 1.f;
#pragma unroll
            for (int g = 0; g < 4; ++g) {
                const float mP = Av[4 * g + 3], mH = Bv[4 * g + 3];
                const float oP = __shfl_xor(mP, 32), oH = __shfl_xor(mH, 32);
                const float eP = hi ? oP : mP, eH = hi ? oH : mH, dP = hi ? mP : oP, dH = hi ? mH : oH;
                const float cz0 = cz, cp0 = cp;
                cz = eP * cz + eH; cp = cp * eP;
                myCz[g] = hi ? cz : cz0; myCp[g] = hi ? cp : cp0;
                cz = dP * cz + dH; cp = cp * dP;
            }
            PW = cp; HW = cz;
        }
        LAS float* ct = (LAS float*)(lds + L_CT + (tile & 1) * 2048);
        if (hi == 0) { ct[(wave * 32 + r) * 2] = PW; ct[(wave * 32 + r) * 2 + 1] = HW; }
        __syncthreads();
        float cin = 0.f;
        {
            float c = state;
#pragma unroll
            for (int w2 = 0; w2 < 8; ++w2) { if (w2 == wave) cin = c; c = ct[(w2 * 32 + r) * 2] * c + ct[(w2 * 32 + r) * 2 + 1]; }
            state = c;
        }
        if (tile > 0) {
            const LAS unsigned short* gs = (const LAS unsigned short*)(lw + LW_GS);
            LAS unsigned short* os = (LAS unsigned short*)(lw + LW_XS);
#pragma unroll
            for (int reg = 0; reg < 16; ++reg) {
                const int g = reg >> 2, tl = crow(reg, hi);
                const float h = Bv[reg] + Av[reg] * (myCz[g] + myCp[g] * cin);
                const float gt = bf2f(gs[tl * 32 + r]);
                { const float ov = gelu_fast(gt) * h; os[tl * 32 + r] = (unsigned short)cvtpk(ov, ov); }
            }
            asm volatile("s_waitcnt lgkmcnt(0)" ::: "memory");
#pragma unroll
            for (int it = 0; it < 2; ++it) {
                const int cid = it * 64 + lane, tl = cid >> 2, ch = cid & 3;
                const v4u v = *(const LAS v4u*)(lw + LW_XS + tl * 64 + ch * 16);
                float ss = 0.f;
#pragma unroll
                for (int k = 0; k < 4; ++k) { const float a = __builtin_bit_cast(float, v[k] << 16), c = __builtin_bit_cast(float, v[k] & 0xffff0000u); ss += a * a + c * c; }
                ss = sum4(ss);
                const size_t row = (size_t)b * SEQ + 256 * (tile - 1) + 32 * wave + tl;
                *(GAS v4u*)(MIX + row * D + 1024 + nb * 64 + 32 * cg + ch * 8) = v;
                if (ch == 0) SSL[row * 32 + nb * 2 + cg] = ss;
            }
            asm volatile("s_waitcnt lgkmcnt(0)" ::: "memory");
        }
    }
#undef LRU_PREFETCH
    __syncthreads();
}
}

namespace p5 {
typedef float f32x16 __attribute__((ext_vector_type(16)));
constexpr int KP = 272;
constexpr int R_KEYS = 0, R_IDX = 256 * KP, R_END = R_IDX + 8 * 1024;
__device__ __forceinline__ int crow(int r, int hi) { return (r & 3) + 8 * (r >> 2) + 4 * hi; }
__device__ __forceinline__ float fkey(float s, int mask, int payload) { return __builtin_bit_cast(float, (__builtin_bit_cast(int, s) & mask) | payload); }
__device__ __forceinline__ int fbits(float f) { return __builtin_bit_cast(int, f); }
__device__ __forceinline__ float fval(float f, int mask) { return __builtin_bit_cast(float, __builtin_bit_cast(int, f) & mask); }
__device__ __forceinline__ void ins16(float (&L)[16], float v) {
#pragma unroll
    for (int k = 15; k >= 1; --k) L[k] = __builtin_amdgcn_fmed3f(L[k - 1], L[k], v);
    L[0] = fmaxf(L[0], v);
}
#define P5_CE(a, b) do { const float hi_ = fmaxf(a, b), lo_ = fminf(a, b); a = hi_; b = lo_; } while (0)
#define P5_SORT16(X) do { P5_CE(X[0], X[1]); P5_CE(X[2], X[3]); P5_CE(X[0], X[2]); P5_CE(X[1], X[3]); P5_CE(X[1], X[2]); P5_CE(X[4], X[5]); P5_CE(X[6], X[7]); P5_CE(X[4], X[6]); P5_CE(X[5], X[7]); P5_CE(X[5], X[6]); P5_CE(X[0], X[4]); P5_CE(X[2], X[6]); P5_CE(X[2], X[4]); P5_CE(X[1], X[5]); P5_CE(X[3], X[7]); P5_CE(X[3], X[5]); P5_CE(X[1], X[2]); P5_CE(X[3], X[4]); P5_CE(X[5], X[6]); P5_CE(X[8], X[9]); P5_CE(X[10], X[11]); P5_CE(X[8], X[10]); P5_CE(X[9], X[11]); P5_CE(X[9], X[10]); P5_CE(X[12], X[13]); P5_CE(X[14], X[15]); P5_CE(X[12], X[14]); P5_CE(X[13], X[15]); P5_CE(X[13], X[14]); P5_CE(X[8], X[12]); P5_CE(X[10], X[14]); P5_CE(X[10], X[12]); P5_CE(X[9], X[13]); P5_CE(X[11], X[15]); P5_CE(X[11], X[13]); P5_CE(X[9], X[10]); P5_CE(X[11], X[12]); P5_CE(X[13], X[14]); P5_CE(X[0], X[8]); P5_CE(X[4], X[12]); P5_CE(X[4], X[8]); P5_CE(X[2], X[10]); P5_CE(X[6], X[14]); P5_CE(X[6], X[10]); P5_CE(X[2], X[4]); P5_CE(X[6], X[8]); P5_CE(X[10], X[12]); P5_CE(X[1], X[9]); P5_CE(X[5], X[13]); P5_CE(X[5], X[9]); P5_CE(X[3], X[11]); P5_CE(X[7], X[15]); P5_CE(X[7], X[11]); P5_CE(X[3], X[5]); P5_CE(X[7], X[9]); P5_CE(X[11], X[13]); P5_CE(X[1], X[2]); P5_CE(X[3], X[4]); P5_CE(X[5], X[6]); P5_CE(X[7], X[8]); P5_CE(X[9], X[10]); P5_CE(X[11], X[12]); P5_CE(X[13], X[14]); } while (0)
#define P5_BMERGE16(X) do { P5_CE(X[0], X[8]); P5_CE(X[1], X[9]); P5_CE(X[2], X[10]); P5_CE(X[3], X[11]); P5_CE(X[4], X[12]); P5_CE(X[5], X[13]); P5_CE(X[6], X[14]); P5_CE(X[7], X[15]); P5_CE(X[0], X[4]); P5_CE(X[1], X[5]); P5_CE(X[2], X[6]); P5_CE(X[3], X[7]); P5_CE(X[8], X[12]); P5_CE(X[9], X[13]); P5_CE(X[10], X[14]); P5_CE(X[11], X[15]); P5_CE(X[0], X[2]); P5_CE(X[1], X[3]); P5_CE(X[4], X[6]); P5_CE(X[5], X[7]); P5_CE(X[8], X[10]); P5_CE(X[9], X[11]); P5_CE(X[12], X[14]); P5_CE(X[13], X[15]); P5_CE(X[0], X[1]); P5_CE(X[2], X[3]); P5_CE(X[4], X[5]); P5_CE(X[6], X[7]); P5_CE(X[8], X[9]); P5_CE(X[10], X[11]); P5_CE(X[12], X[13]); P5_CE(X[14], X[15]); } while (0)
#define P5_TOP16(A, B) do { _Pragma("unroll") for (int i_ = 0; i_ < 16; ++i_) A[i_] = fmaxf(A[i_], B[15 - i_]); P5_BMERGE16(A); } while (0)
#define P5_KEYS(G, ACC, KT) do { _Pragma("unroll") for (int reg = 0; reg < 16; ++reg) G[reg] = fkey(ACC[reg], (int)0xffffff80, (127 - 32 * (KT) - (reg & 3) - 8 * (reg >> 2)) - h4); } while (0)
__device__ __forceinline__ void score_tile(f32x16& acc, const LAS unsigned char* keys, const bf16x8 (&qf)[8], int kt, int r, int hi) {
    acc = (f32x16){0.f, 0.f, 0.f, 0.f, 0.f, 0.f, 0.f, 0.f, 0.f, 0.f, 0.f, 0.f, 0.f, 0.f, 0.f, 0.f};
#pragma unroll
    for (int ks = 0; ks < 8; ++ks) {
        const bf16x8 kf = *(const LAS bf16x8*)(keys + (kt * 32 + r) * KP + ks * 32 + hi * 16);
        acc = __builtin_amdgcn_mfma_f32_32x32x16_bf16(kf, qf[ks], acc, 0, 0, 0);
    }
}
__device__ __forceinline__ void half_top16(const LAS unsigned char* keys, const bf16x8 (&qf)[8], int r, int hi, float (&T)[16]) {
    const int h4 = 4 * hi;
    f32x16 acc;
    float A[16], B[16];
    score_tile(acc, keys, qf, 0, r, hi); P5_KEYS(A, acc, 0); P5_SORT16(A);
    score_tile(acc, keys, qf, 1, r, hi); P5_KEYS(B, acc, 1); P5_SORT16(B);
    P5_TOP16(A, B);
    float C[16];
    score_tile(acc, keys, qf, 2, r, hi); P5_KEYS(C, acc, 2); P5_SORT16(C);
    score_tile(acc, keys, qf, 3, r, hi); P5_KEYS(B, acc, 3); P5_SORT16(B);
    P5_TOP16(C, B);
    P5_TOP16(A, C);
#pragma unroll
    for (int i = 0; i < 16; ++i) B[i] = __shfl_xor(A[15 - i], 32);
#pragma unroll
    for (int i = 0; i < 16; ++i) A[i] = fmaxf(A[i], B[i]);
    P5_BMERGE16(A);
#pragma unroll
    for (int i = 0; i < 16; ++i) T[i] = A[i];
}

__device__ __forceinline__ void retr_unit(LAS unsigned char* lds, int h, int tg, const bf16* QPB, const bf16* SKB, unsigned short* IDS, float* GW, const float* RSTD2, int tid) {
    const int lane = tid & 63, wave = __builtin_amdgcn_readfirstlane(tid >> 6), r = lane & 31, hi = lane >> 5;
#pragma unroll
    for (int it = 0; it < 8; ++it) {
        const int cid = it * 512 + tid, row = cid >> 4, ch = cid & 15;
        *(LAS v4u*)(lds + R_KEYS + row * KP + ch * 16) = *(const GAS v4u*)(SKB + ((size_t)h * 256 + row) * 128 + ch * 8);
    }
    const size_t tok = (size_t)tg * 256 + wave * 32 + r;
    bf16x8 qa[8], qb[8];
#pragma unroll
    for (int ks = 0; ks < 8; ++ks) { qa[ks] = *(const GAS bf16x8*)(QPB + tok * D + h * 256 + ks * 16 + hi * 8); qb[ks] = *(const GAS bf16x8*)(QPB + tok * D + h * 256 + 128 + ks * 16 + hi * 8); }
    const float rs = RSTD2[tok];
    __syncthreads();
    float TA[16], TB[16];
    half_top16(lds + R_KEYS, qa, r, hi, TA);
    half_top16(lds + R_KEYS + 128 * KP, qb, r, hi, TB);
    LAS unsigned char* sc = lds + R_IDX + wave * 1024 + r * 32;
    const int hm = -hi;
    {
        v4u w;
#pragma unroll
        for (int q = 0; q < 4; ++q) { unsigned x = 0;
#pragma unroll
            for (int k = 0; k < 4; ++k) { const int t = (fbits(TB[4 * q + k]) & hm) | (fbits(TA[4 * q + k]) & ~hm); x |= (unsigned)(127 - (t & 0x7f)) << (8 * k); }
            w[q] = x; }
        *(LAS v4u*)(sc + hi * 16) = w;
    }
    float sA[16], sB[16];
#pragma unroll
    for (int i = 0; i < 16; ++i) { sA[i] = fval(TA[i], (int)0xffffff80); sB[i] = fval(TB[i], (int)0xffffff80); }
#define P5_K(i, j) fkey(sA[i] + sB[j], (int)0xffffff00, 255 - ((i) * 16 + (j)))
    float L[16], X[16];
#pragma unroll
    for (int j = 0; j < 16; ++j) L[j] = P5_K(0, j);
#pragma unroll
    for (int j = 0; j < 8; ++j) { X[j] = P5_K(1, j); X[8 + j] = P5_K(15 - j, 0); }
    P5_BMERGE16(X);
    P5_TOP16(L, X);
    X[0] = P5_K(2, 0); X[1] = P5_K(2, 1); X[2] = P5_K(2, 2); X[3] = P5_K(2, 3); X[4] = P5_K(2, 4);
    X[5] = P5_K(3, 0); X[6] = P5_K(3, 1); X[7] = P5_K(3, 2); X[8] = P5_K(3, 3);
    X[9] = P5_K(4, 0); X[10] = P5_K(4, 1); X[11] = P5_K(4, 2);
    X[12] = P5_K(5, 0); X[13] = P5_K(5, 1); X[14] = P5_K(6, 0); X[15] = P5_K(6, 1);
    P5_SORT16(X);
    P5_TOP16(L, X);
    ins16(L, P5_K(7, 0)); ins16(L, P5_K(7, 1));
#undef P5_K
    const float v0 = fval(L[0], (int)0xffffff00);
    asm volatile("s_waitcnt lgkmcnt(0)" ::: "memory");
    int ex[8]; float ew[8]; float esum = 0.f;
#pragma unroll
    for (int k = 0; k < 8; ++k) {
        const int t = (fbits(L[8 + k]) & hm) | (fbits(L[k]) & ~hm);
        const int c = 255 - (t & 0xff);
        const int ia = sc[c >> 4], ib = sc[16 + (c & 15)];
        ex[k] = ia * 128 + ib;
        const float e = __builtin_amdgcn_exp2f((__builtin_bit_cast(float, t & (int)0xffffff00) - v0) * rs * 1.4426950408889634f);
        ew[k] = e; esum += e;
    }
    esum = sum_x32(esum);
    const float inv = 1.0f / esum;
    unsigned short* ip = IDS + tok * 128 + h * 16 + hi * 8; float* gp = GW + tok * 128 + h * 16 + hi * 8;
    *(GAS v4u*)(ip) = (v4u){(unsigned)ex[0] | ((unsigned)ex[1] << 16), (unsigned)ex[2] | ((unsigned)ex[3] << 16), (unsigned)ex[4] | ((unsigned)ex[5] << 16), (unsigned)ex[6] | ((unsigned)ex[7] << 16)};
    *(GAS f32x4*)(gp) = (f32x4){ew[0] * inv, ew[1] * inv, ew[2] * inv, ew[3] * inv};
    *(GAS f32x4*)(gp + 4) = (f32x4){ew[4] * inv, ew[5] * inv, ew[6] * inv, ew[7] * inv};
    __syncthreads();
}
}

namespace p6 {
__device__ __forceinline__ float blo(unsigned w) { return __builtin_bit_cast(float, w << 16); }
__device__ __forceinline__ float bhi(unsigned w) { return __builtin_bit_cast(float, w & 0xffff0000u); }
__device__ __forceinline__ float gelu_fast(float x) { return x * __builtin_amdgcn_rcpf(1.0f + __builtin_amdgcn_exp2f(-2.302208198f * x * (1.0f + 0.044715f * x * x))); }
__device__ __forceinline__ unsigned idw(const v4u& a, const v4u& b, int g) { const unsigned w = g < 8 ? a[(g & 7) >> 1] : b[(g & 7) >> 1]; return (g & 1) ? (w >> 16) : (w & 0xffffu); }
__device__ __forceinline__ unsigned q4(float a, float b, float c, float d, float inv, int bias) {
    const int qa = (int)rintf(a * inv) + bias, qb = (int)rintf(b * inv) + bias, qc = (int)rintf(c * inv) + bias, qd = (int)rintf(d * inv) + bias;
    return (unsigned)(qa & 0xff) | ((unsigned)(qb & 0xff) << 8) | ((unsigned)(qc & 0xff) << 16) | ((unsigned)(qd & 0xff) << 24);
}
__device__ __forceinline__ void qrow_load(f32x4 (&v)[8], const float* src, size_t e, int lane) {
#pragma unroll
    for (int j = 0; j < 8; ++j) v[j] = __builtin_nontemporal_load((const GAS f32x4*)(src + e * D + j * 256 + lane * 4));
}
__device__ __forceinline__ void qrow_finish(f32x4 (&v)[8], const float* gcol, unsigned char* dst, float* scale_out, size_t e, int lane) {
    float am = 0.f;
#pragma unroll
    for (int j = 0; j < 8; ++j) {
        if (gcol) { const f32x4 g = *(const GAS f32x4*)(gcol + j * 256 + lane * 4); v[j] = v[j] * g; }
        am = fmaxf(am, fmaxf(fmaxf(fabsf(v[j].x), fabsf(v[j].y)), fmaxf(fabsf(v[j].z), fabsf(v[j].w))));
    }
    am = max64(am);
    const float inv = am > 0.f ? 127.0f / am : 0.f;
#pragma unroll
    for (int j = 0; j < 8; ++j)
        *(GAS unsigned*)(dst + ((size_t)(2 * j + (lane >> 5)) * 16384 + e) * 128 + (lane & 31) * 4) = q4(v[j].x, v[j].y, v[j].z, v[j].w, inv, 0);
    if (lane == 0) scale_out[e] = am * (1.0f / 127.0f);
}
__device__ __forceinline__ void qx_load(v4u (&x)[4], const bf16* H1B, size_t tok, int lane) {
#pragma unroll
    for (int j = 0; j < 4; ++j) x[j] = *(const GAS v4u*)(H1B + tok * D + j * 512 + lane * 8);
}
__device__ __forceinline__ void qx_finish(const v4u (&x)[4], unsigned char* X8, float* SX, size_t tok, int lane) {
#pragma unroll
    for (int j = 0; j < 4; ++j) {
        float f[8]; float am = 0.f;
#pragma unroll
        for (int k = 0; k < 4; ++k) { f[2 * k] = blo(x[j][k]); f[2 * k + 1] = bhi(x[j][k]); am = fmaxf(am, fmaxf(fabsf(f[2 * k]), fabsf(f[2 * k + 1]))); }
        am = max16(am);
        const float inv = am > 0.f ? 127.0f / am : 0.f;
        typedef unsigned u32x2v __attribute__((ext_vector_type(2)));
        u32x2v o; o.x = q4(f[0], f[1], f[2], f[3], inv, 0); o.y = q4(f[4], f[5], f[6], f[7], inv, 0);
        *(GAS u32x2v*)(X8 + tok * D + j * 512 + lane * 8) = o;
        if ((lane & 15) == 0) SX[tok * 16 + 4 * j + (lane >> 4)] = am * (1.0f / 127.0f);
    }
}

typedef int i32x16 __attribute__((ext_vector_type(16)));
typedef float f32x16v __attribute__((ext_vector_type(16)));
__device__ __forceinline__ int seli(int m, int a, int b) { return (a & m) | (b & ~m); }
__device__ __forceinline__ float self(int m, float a, float b) { return __builtin_bit_cast(float, seli(m, __builtin_bit_cast(int, a), __builtin_bit_cast(int, b))); }
__device__ __forceinline__ void usweep(const unsigned char* X8, const float* SX, const unsigned char* U8, const unsigned short* IDS, bf16* PART, LAS unsigned char* lds, int slot, int rank, int nrank, int wave, int lane) {
    const int ps = lane >> 3, ch = lane & 7;
    const int first = rank * 8 + wave, stride = nrank * 8;
    const int n = first < MREAL ? (MREAL - first + stride - 1) / stride : 0, NQ = 2 * n;
    if (NQ == 0) return;
    const int m4 = -((lane >> 2) & 1), m2 = -((lane >> 1) & 1), m1 = -(lane & 1);
    LAS unsigned char* sl = lds + wave * 1024;
#define U_LOAD(q_, RI, RX, SX_, T_, SG_) do { const int qq_ = (q_) < NQ ? (q_) : NQ - 1; const int rd_ = qq_ >= n ? 1 : 0; T_ = first + (qq_ - rd_ * n) * stride; SG_ = rd_ * 8 + slot; \
        RI = *(const GAS unsigned*)(IDS + (size_t)T_ * 128 + lane * 2); RX = *(const GAS unsigned*)(X8 + (size_t)T_ * D + SG_ * 128 + (lane & 31) * 4); SX_ = SX[(size_t)T_ * 16 + SG_]; } while (0)
#define U_EXPAND(SLOT, RI, RX, I0, I1, XV) do { LAS unsigned char* s_ = sl + (SLOT) * 512; \
        *(LAS unsigned*)(s_ + lane * 4) = RI; if (lane < 32) *(LAS unsigned*)(s_ + 256 + lane * 4) = RX; \
        asm volatile("s_waitcnt lgkmcnt(0)" ::: "memory"); \
        I0 = *(const LAS v4u*)(s_ + ps * 32); I1 = *(const LAS v4u*)(s_ + ps * 32 + 16); XV = *(const LAS v4u*)(s_ + 256 + ch * 16); } while (0)
#define U_ISSUE(BUF, I0, I1, SG_) do { const unsigned char* tab_ = U8 + (size_t)(SG_) * 16384 * 128 + ch * 16; \
        _Pragma("unroll") for (int g = 0; g < 16; ++g) BUF[g] = *(const GAS v4u*)(tab_ + (size_t)idw(I0, I1, g) * 128); } while (0)
#define U_FINISH(BUF, XV, SX_, T_, SG_) do { i32x16 d; \
        _Pragma("unroll") for (int g = 0; g < 16; ++g) { int a_ = __builtin_amdgcn_sdot4((int)BUF[g][0], (int)XV[0], 0, false); a_ = __builtin_amdgcn_sdot4((int)BUF[g][1], (int)XV[1], a_, false); \
            a_ = __builtin_amdgcn_sdot4((int)BUF[g][2], (int)XV[2], a_, false); a_ = __builtin_amdgcn_sdot4((int)BUF[g][3], (int)XV[3], a_, false); d[g] = a_; } \
        int r8[8], r4[4], r2[2]; \
        _Pragma("unroll") for (int k = 0; k < 8; ++k) r8[k] = seli(m4, d[8 + k], d[k]) + dpp_hm(seli(m4, d[k], d[8 + k])); \
        _Pragma("unroll") for (int k = 0; k < 4; ++k) r4[k] = seli(m2, r8[4 + k], r8[k]) + dpp_x2(seli(m2, r8[k], r8[4 + k])); \
        _Pragma("unroll") for (int k = 0; k < 2; ++k) r2[k] = seli(m1, r4[2 + k], r4[k]) + dpp_x1(seli(m1, r4[k], r4[2 + k])); \
        *(GAS unsigned*)(PART + ((size_t)(SG_) * MREAL + T_) * 128 + ps * 16 + 2 * ch) = pk2((float)r2[0] * SX_, (float)r2[1] * SX_); } while (0)
    v4u bufA[16], bufB[16];
    v4u a0, a1, ax, b0, b1, bx; unsigned ri, rx; float as, bs, cs; int at, bt, ct, ag, bg, cg;
    U_LOAD(0, ri, rx, as, at, ag); U_EXPAND(0, ri, rx, a0, a1, ax);
    U_LOAD(1, ri, rx, bs, bt, bg); U_EXPAND(1, ri, rx, b0, b1, bx);
    U_ISSUE(bufA, a0, a1, ag);
    for (int q = 0; q < NQ; q += 2) {
        U_ISSUE(bufB, b0, b1, bg);
        U_LOAD(q + 2, ri, rx, cs, ct, cg);
        U_FINISH(bufA, ax, as, at, ag);
        U_EXPAND(0, ri, rx, a0, a1, ax); as = cs; at = ct; ag = cg;
        U_ISSUE(bufA, a0, a1, ag);
        U_LOAD(q + 3, ri, rx, cs, ct, cg);
        U_FINISH(bufB, bx, bs, bt, bg);
        U_EXPAND(1, ri, rx, b0, b1, bx); bs = cs; bt = ct; bg = cg;
    }
#undef U_LOAD
#undef U_EXPAND
#undef U_ISSUE
#undef U_FINISH
}
__device__ __forceinline__ void wreduce(const bf16* PART, const float* GW, const float* RSTD2, const unsigned short* IDS, const float* SCU, const float* SCV, unsigned char* W8, float* WS8, size_t gt, size_t NT) {
    for (size_t i8 = gt; i8 < (size_t)MREAL * 128 / 8; i8 += NT) {
        float s[8];
#pragma unroll
        for (int k = 0; k < 8; ++k) s[k] = 0.f;
#pragma unroll 8
        for (int sg = 0; sg < 16; ++sg) {
            const v4u p = *(const GAS v4u*)(PART + (size_t)sg * MREAL * 128 + i8 * 8);
#pragma unroll
            for (int k = 0; k < 4; ++k) { s[2 * k] += blo(p[k]); s[2 * k + 1] += bhi(p[k]); }
        }
        const float rs = RSTD2[i8 >> 4];
        const v4u idv = *(const GAS v4u*)(IDS + i8 * 8);
        const f32x4 g0 = *(const GAS f32x4*)(GW + i8 * 8), g1 = *(const GAS f32x4*)(GW + i8 * 8 + 4);
        float w[8]; float am = 0.f;
#pragma unroll
        for (int k = 0; k < 8; ++k) {
            const unsigned e = (k & 1) ? (idv[k >> 1] >> 16) : (idv[k >> 1] & 0xffffu);
            const float g = k < 4 ? g0[k & 3] : g1[k & 3];
            w[k] = g * gelu_fast(rs * SCU[e] * s[k]) * SCV[e]; am = fmaxf(am, fabsf(w[k]));
        }
        am = max16(am);
        const float inv = am > 0.f ? 127.0f / am : 0.f;
        typedef unsigned u32x2v __attribute__((ext_vector_type(2)));
        u32x2v o; o.x = q4(w[0], w[1], w[2], w[3], inv, 0); o.y = q4(w[4], w[5], w[6], w[7], inv, 0);
        *(GAS u32x2v*)(W8 + i8 * 8) = o;
        if ((i8 & 15) == 0) WS8[i8 >> 4] = am * (1.0f / 127.0f);
    }
}
__device__ __forceinline__ void vsweep(const bf16* H1B, const unsigned char* V8, const unsigned short* IDS, const unsigned char* W8, const float* WS8, bf16* Z, LAS unsigned char* lds, int slot, int rank, int nrank, int wave, int lane) {
    const int ps = lane >> 3, ch = lane & 7;
    const int first = rank * 8 + wave, stride = nrank * 8;
    const int n = first < MREAL ? (MREAL - first + stride - 1) / stride : 0, NQ = 2 * n;
    if (NQ == 0) return;
    const int m8 = -((lane >> 3) & 1);
    LAS unsigned char* sl = lds + wave * 1024;
#define V_LOAD(q_, RI, RW, WSC, HX, T_, SG_) do { const int qq_ = (q_) < NQ ? (q_) : NQ - 1; const int rd_ = qq_ >= n ? 1 : 0; T_ = first + (qq_ - rd_ * n) * stride; SG_ = rd_ * 8 + slot; \
        RI = *(const GAS unsigned*)(IDS + (size_t)T_ * 128 + lane * 2); RW = *(const GAS unsigned*)(W8 + (size_t)T_ * 128 + (lane & 31) * 4); WSC = WS8[T_]; \
        HX = 0u; } while (0)
#define V_EXPAND(SLOT, RI, RW, I0, I1, WQ) do { LAS unsigned char* s_ = sl + (SLOT) * 512; \
        *(LAS unsigned*)(s_ + lane * 4) = RI; if (lane < 32) *(LAS unsigned*)(s_ + 256 + lane * 4) = RW; \
        asm volatile("s_waitcnt lgkmcnt(0)" ::: "memory"); \
        I0 = *(const LAS v4u*)(s_ + ps * 32); I1 = *(const LAS v4u*)(s_ + ps * 32 + 16); WQ = *(const LAS v4u*)(s_ + 256 + ps * 16); } while (0)
#define V_ISSUE(BUF, I0, I1, SG_) do { const unsigned char* tab_ = V8 + (size_t)(SG_) * 16384 * 128 + ch * 16; \
        _Pragma("unroll") for (int g = 0; g < 16; ++g) BUF[g] = *(const GAS v4u*)(tab_ + (size_t)idw(I0, I1, g) * 128); } while (0)
#define V_FINISH(BUF, WQ, WSC, HX, T_, SG_) do { i32x16 acc = {0, 0, 0, 0, 0, 0, 0, 0, 0, 0, 0, 0, 0, 0, 0, 0}; const unsigned hx_ = HX; \
        _Pragma("unroll") for (int j = 0; j < 4; ++j) { const int wq_ = (int)WQ[j]; \
            _Pragma("unroll") for (int k = 0; k < 4; ++k) { \
                const unsigned d0_ = BUF[4 * j][k], d1_ = BUF[4 * j + 1][k], d2_ = BUF[4 * j + 2][k], d3_ = BUF[4 * j + 3][k]; \
                const unsigned p0_ = __builtin_amdgcn_perm(d1_, d0_, 0x05010400u), p1_ = __builtin_amdgcn_perm(d1_, d0_, 0x07030602u); \
                const unsigned q0_ = __builtin_amdgcn_perm(d3_, d2_, 0x05010400u), q1_ = __builtin_amdgcn_perm(d3_, d2_, 0x07030602u); \
                acc[4 * k + 0] = __builtin_amdgcn_sdot4((int)__builtin_amdgcn_perm(q0_, p0_, 0x05040100u), wq_, acc[4 * k + 0], false); \
                acc[4 * k + 1] = __builtin_amdgcn_sdot4((int)__builtin_amdgcn_perm(q0_, p0_, 0x07060302u), wq_, acc[4 * k + 1], false); \
                acc[4 * k + 2] = __builtin_amdgcn_sdot4((int)__builtin_amdgcn_perm(q1_, p1_, 0x05040100u), wq_, acc[4 * k + 2], false); \
                acc[4 * k + 3] = __builtin_amdgcn_sdot4((int)__builtin_amdgcn_perm(q1_, p1_, 0x07060302u), wq_, acc[4 * k + 3], false); } } \
        int r8[8], r4[4], r2[2]; \
        _Pragma("unroll") for (int k = 0; k < 8; ++k) { const auto rr_ = __builtin_amdgcn_permlane32_swap((unsigned)acc[k], (unsigned)acc[8 + k], false, false); r8[k] = (int)rr_[0] + (int)rr_[1]; } \
        _Pragma("unroll") for (int k = 0; k < 4; ++k) { const auto rr_ = __builtin_amdgcn_permlane16_swap((unsigned)r8[k], (unsigned)r8[4 + k], false, false); r4[k] = (int)rr_[0] + (int)rr_[1]; } \
        _Pragma("unroll") for (int k = 0; k < 2; ++k) r2[k] = seli(m8, r4[2 + k], r4[k]) + dpp_r8(seli(m8, r4[k], r4[2 + k])); \
        const float z0_ = (float)r2[0] * WSC + blo(hx_), z1_ = (float)r2[1] * WSC + bhi(hx_); \
        *(GAS unsigned*)(Z + (size_t)T_ * D + (SG_) * 128 + ch * 16 + 2 * ps) = pk2(z0_, z1_); } while (0)
    v4u bufA[16], bufB[16];
    v4u a0, a1, aw, b0, b1, bw; unsigned ri, rw, ah, bh, chx; float as, bs, cs; int at, bt, ct, ag, bg, cg;
    V_LOAD(0, ri, rw, as, ah, at, ag); V_EXPAND(0, ri, rw, a0, a1, aw);
    V_LOAD(1, ri, rw, bs, bh, bt, bg); V_EXPAND(1, ri, rw, b0, b1, bw);
    V_ISSUE(bufA, a0, a1, ag);
    for (int q = 0; q < NQ; q += 2) {
        V_ISSUE(bufB, b0, b1, bg);
        V_LOAD(q + 2, ri, rw, cs, chx, ct, cg);
        V_FINISH(bufA, aw, as, ah, at, ag);
        V_EXPAND(0, ri, rw, a0, a1, aw); as = cs; ah = chx; at = ct; ag = cg;
        V_ISSUE(bufA, a0, a1, ag);
        V_LOAD(q + 3, ri, rw, cs, chx, ct, cg);
        V_FINISH(bufB, bw, bs, bh, bt, bg);
        V_EXPAND(1, ri, rw, b0, b1, bw); bs = cs; bh = chx; bt = ct; bg = cg;
    }
#undef V_LOAD
#undef V_EXPAND
#undef V_ISSUE
#undef V_FINISH
}
__device__ __forceinline__ void final_load(v4u (&z)[4], v4u (&h)[4], const bf16* Z, const bf16* H1B, size_t tok, int lane) {
#pragma unroll
    for (int j = 0; j < 4; ++j) { z[j] = __builtin_nontemporal_load((const GAS v4u*)(Z + tok * D + j * 512 + lane * 8)); h[j] = __builtin_nontemporal_load((const GAS v4u*)(H1B + tok * D + j * 512 + lane * 8)); }
}
__device__ __forceinline__ void final_finish(const v4u (&z)[4], const v4u (&h)[4], const float* fg, float* out, size_t tok, int lane) {
    float v[4][8]; float ss = 0.f;
#pragma unroll
    for (int j = 0; j < 4; ++j)
#pragma unroll
        for (int k = 0; k < 4; ++k) { v[j][2 * k] = blo(z[j][k]) + blo(h[j][k]); v[j][2 * k + 1] = bhi(z[j][k]) + bhi(h[j][k]); ss += v[j][2 * k] * v[j][2 * k] + v[j][2 * k + 1] * v[j][2 * k + 1]; }
    ss = sum64(ss);
    const float rf = 1.0f / sqrtf(ss * (1.0f / D) + EPS);
#pragma unroll
    for (int j = 0; j < 4; ++j) {
        const f32x4 ga = *(const GAS f32x4*)(fg + j * 512 + lane * 8), gb = *(const GAS f32x4*)(fg + j * 512 + lane * 8 + 4);
        __builtin_nontemporal_store((f32x4){v[j][0] * rf * ga.x, v[j][1] * rf * ga.y, v[j][2] * rf * ga.z, v[j][3] * rf * ga.w}, (GAS f32x4*)(out + tok * D + j * 512 + lane * 8));
        __builtin_nontemporal_store((f32x4){v[j][4] * rf * gb.x, v[j][5] * rf * gb.y, v[j][6] * rf * gb.z, v[j][7] * rf * gb.w}, (GAS f32x4*)(out + tok * D + j * 512 + lane * 8 + 4));
    }
}
}

struct Frame {
    LAS unsigned char* lds;
    volatile LAS unsigned* MISC;
    gu32* ctl;
    int tid, lane, wave, vcu, G;
};
__device__ __forceinline__ float wave_sum(float v) { return sum64(v); }
__device__ __forceinline__ void p0_transpose_item(const float* W, int K, int N, bf16* WT, const float* g0, const float* g1, int ksplit, LAS float* scr, int item, int lane) {
    const int nblk = N / 32, kb = item / nblk, nb = item % nblk, k0 = 64 * kb, n0 = 32 * nb;
    f32x4 v[8];
#pragma unroll
    for (int i = 0; i < 8; ++i) v[i] = __builtin_nontemporal_load((const GAS f32x4*)(W + (size_t)(k0 + 8 * i + (lane >> 3)) * N + n0 + (lane & 7) * 4));
#pragma unroll
    for (int i = 0; i < 8; ++i) { const int kk = 8 * i + (lane >> 3), kg = k0 + kk; const float gv = kg < ksplit ? g0[kg] : g1[kg - ksplit];
        LAS float* d = scr + kk * 33 + (lane & 7) * 4; d[0] = v[i].x * gv; d[1] = v[i].y * gv; d[2] = v[i].z * gv; d[3] = v[i].w * gv; }
    LDS_WAIT(); asm volatile("" ::: "memory");
    const int c = lane & 7;
#pragma unroll
    for (int j = 0; j < 4; ++j) { const int n = (lane >> 3) + 8 * j; const LAS float* s = scr + (8 * c) * 33 + n;
        v4u o; o.x = pk2(s[0 * 33], s[1 * 33]); o.y = pk2(s[2 * 33], s[3 * 33]); o.z = pk2(s[4 * 33], s[5 * 33]); o.w = pk2(s[6 * 33], s[7 * 33]);
        *(GAS v4u*)(WT + (size_t)(n0 + n) * K + k0 + 8 * c) = o; }
    LDS_WAIT(); asm volatile("" ::: "memory");
}
__device__ __forceinline__ void p0_row_load(f32x4 (&v)[8], const float* xrow, int lane) {
    const GAS f32x4* xr = (const GAS f32x4*)xrow + lane;
#pragma unroll
    for (int j = 0; j < 8; ++j) v[j] = __builtin_nontemporal_load(xr + 64 * j);
}
__device__ __forceinline__ void p0_row_finish(const f32x4 (&v)[8], bf16* orow, float* rstd_out, int lane) {
    float s = 0.f;
#pragma unroll
    for (int j = 0; j < 8; ++j) s += (v[j].x * v[j].x + v[j].y * v[j].y) + (v[j].z * v[j].z + v[j].w * v[j].w);
    s = wave_sum(s);
    GAS unsigned long long* o8 = (GAS unsigned long long*)orow + lane;
#pragma unroll
    for (int j = 0; j < 8; ++j) o8[64 * j] = (unsigned long long)pk2(v[j].x, v[j].y) | ((unsigned long long)pk2(v[j].z, v[j].w) << 32);
    if (lane == 0) *rstd_out = 1.0f / sqrtf(s * (1.0f / D) + EPS);
}
__device__ __forceinline__ void p0_cvt8(const float* src, bf16* dst, const float* gcol, size_t idx8) {
    const f32x4 a = *(const GAS f32x4*)(src + idx8 * 8), b = *(const GAS f32x4*)(src + idx8 * 8 + 4);
    f32x4 ga = {1.f, 1.f, 1.f, 1.f}, gb = {1.f, 1.f, 1.f, 1.f};
    if (gcol) { const int c = (int)((idx8 * 8) & (D - 1)); ga = *(const GAS f32x4*)(gcol + c); gb = *(const GAS f32x4*)(gcol + c + 4); }
    v4u o; o.x = pk2(a.x * ga.x, a.y * ga.y); o.y = pk2(a.z * ga.z, a.w * ga.w); o.z = pk2(b.x * gb.x, b.y * gb.y); o.w = pk2(b.z * gb.z, b.w * gb.w);
    *(GAS v4u*)(dst + idx8 * 8) = o;
}

struct Args { const float* in[22]; float* out; unsigned char* ws; int ph_lo, ph_hi, rep_mask, pad; };

__global__ void __launch_bounds__(NWAVES * 64, 2) fwd(Args args) {
    extern __shared__ __attribute__((aligned(16))) unsigned char lds[];
    Frame F;
    F.lds = (LAS unsigned char*)lds;
    F.MISC = (volatile LAS unsigned*)(F.lds + MISC_OFF);
    F.tid = threadIdx.x; F.lane = F.tid & 63; F.wave = __builtin_amdgcn_readfirstlane(F.tid >> 6);
    F.G = gridDim.x; { const int bx = blockIdx.x; F.vcu = (F.G % 8 == 0) ? (bx % 8) * (F.G / 8) + bx / 8 : bx; }
    unsigned char* ws = args.ws;
    F.ctl = (gu32*)(ws + WS_CTL);
    for (int u = F.tid; u < (LDS_BYTES - LDSCTL_OFF) / 4; u += NWAVES * 64) ((LAS unsigned*)(F.lds + LDSCTL_OFF))[u] = 0u;
    __syncthreads();
    XcdBarrier bar = xcd_barrier_post((unsigned*)(F.ctl + CW_BAR), F.MISC + 8);
    const int lo = args.ph_lo, hi = args.ph_hi;
#define IN(k) (lo <= (k) && (k) < hi)
#define BOTH(k) (IN(k) && IN((k) + 1))
#ifndef PROBE_PH
#define PROBE_PH (-1)
#endif
#define REP(k) for (int rep_ = 0; rep_ < ((k) == PROBE_PH ? 2 : 1); ++rep_)
#define STAMP(i) do { if (PROBE_PH >= 100 && blockIdx.x == 0 && F.tid == 0) ((volatile LAS unsigned long long*)(F.lds + LDSCTL_OFF + 640))[i] = __builtin_amdgcn_s_memrealtime(); } while (0)

    const float* x = args.in[0]; const float* meta = args.in[1]; const float* norm_mix_g = args.in[2]; const float* w_in = args.in[3]; const float* b_in = args.in[4];
    const float* gn_attn_g = args.in[13]; const float* gn_lru_g = args.in[14]; const float* w_out = args.in[15]; const float* norm_ffn_g = args.in[16];
    const float* peer_wq = args.in[17]; const float* sub_keys = args.in[18]; const float* peer_u = args.in[19]; const float* peer_v = args.in[20];
    bf16* W1T = (bf16*)(ws + WS_W1T); bf16* W2T = (bf16*)(ws + WS_W2T); bf16* W3T = (bf16*)(ws + WS_W3T); bf16* SKB = (bf16*)(ws + WS_SKB);
    float* RSTD1 = (float*)(ws + WS_RSTD1);
    unsigned char* U8 = ws + WS_U8; unsigned char* V8 = ws + WS_V8; unsigned char* X8 = ws + WS_X8; float* SX = (float*)(ws + WS_SX); float* SCU = (float*)(ws + WS_SCU); float* SCV = (float*)(ws + WS_SCV);
    bf16* A1 = (bf16*)(ws + WS_A1);
    bf16* QB = (bf16*)(ws + WS_Q); bf16* KVB = (bf16*)(ws + WS_KV); bf16* XBB = (bf16*)(ws + WS_XB); bf16* GTB = (bf16*)(ws + WS_GT);

    STAMP(0);
    if (IN(0)) { REP(0) {
        LAS float* scr = (LAS float*)(F.lds + RING_OFF + F.wave * 16384);
        const int gw = F.vcu * NWAVES + F.wave, NGW = F.G * NWAVES;
        constexpr int I_1 = (D / 64) * (IND / 32), I_2 = (D / 64) * (D / 32), I_3 = I_2;
        for (int it = gw; it < I_1 + I_2 + I_3; it += NGW) {
            int r = it;
            if (r < I_1) { p0_transpose_item(w_in, D, IND, W1T, norm_mix_g, norm_mix_g, D, scr, r, F.lane); continue; } r -= I_1;
            if (r < I_2) { p0_transpose_item(w_out, D, D, W2T, gn_attn_g, gn_lru_g, 1024, scr, r, F.lane); continue; } r -= I_2;
            p0_transpose_item(peer_wq, D, D, W3T, norm_ffn_g, norm_ffn_g, D, scr, r, F.lane);
        }
        {
            f32x4 r0[8], r1[8], r2[8];
            const int NR = MREAL + NMETA;
#define P0_XSRC(m_) ((m_) < MREAL ? x + (size_t)(m_) * D : meta + (size_t)((m_) - MREAL) * D)
            if (gw < NR) p0_row_load(r0, P0_XSRC(gw), F.lane);
            if (gw + NGW < NR) p0_row_load(r1, P0_XSRC(gw + NGW), F.lane);
            for (int m = gw; m < NR; m += 3 * NGW) {
                if (m + 2 * NGW < NR) p0_row_load(r2, P0_XSRC(m + 2 * NGW), F.lane);
                p0_row_finish(r0, A1 + (size_t)m * D, RSTD1 + m, F.lane);
                if (m + NGW < NR) {
                    if (m + 3 * NGW < NR) p0_row_load(r0, P0_XSRC(m + 3 * NGW), F.lane);
                    p0_row_finish(r1, A1 + (size_t)(m + NGW) * D, RSTD1 + m + NGW, F.lane);
                }
                if (m + 2 * NGW < NR) {
                    if (m + 4 * NGW < NR) p0_row_load(r1, P0_XSRC(m + 4 * NGW), F.lane);
                    p0_row_finish(r2, A1 + (size_t)(m + 2 * NGW) * D, RSTD1 + m + 2 * NGW, F.lane);
                }
            }
#undef P0_XSRC
        }
        {
            const size_t gt = (size_t)gw * 64 + F.lane, NT = (size_t)NGW * 64;
            for (size_t i = gt; i < (size_t)(8 * 2 * 128 * 128) / 8; i += NT) p0_cvt8(sub_keys, SKB, nullptr, i);
            {
                f32x4 r0[8], r1[8], r2[8];
                constexpr int QV0 = 6144, NR = 16384;
                const int b0 = QV0 + gw;
                if (b0 < NR) p6::qrow_load(r0, peer_v, (size_t)b0, F.lane);
                if (b0 + NGW < NR) p6::qrow_load(r1, peer_v, (size_t)(b0 + NGW), F.lane);
                for (int rj = b0; rj < NR; rj += 3 * NGW) {
                    if (rj + 2 * NGW < NR) p6::qrow_load(r2, peer_v, (size_t)(rj + 2 * NGW), F.lane);
                    p6::qrow_finish(r0, nullptr, V8, SCV, (size_t)rj, F.lane);
                    if (rj + NGW < NR) {
                        if (rj + 3 * NGW < NR) p6::qrow_load(r0, peer_v, (size_t)(rj + 3 * NGW), F.lane);
                        p6::qrow_finish(r1, nullptr, V8, SCV, (size_t)(rj + NGW), F.lane);
                    }
                    if (rj + 2 * NGW < NR) {
                        if (rj + 4 * NGW < NR) p6::qrow_load(r1, peer_v, (size_t)(rj + 4 * NGW), F.lane);
                        p6::qrow_finish(r2, nullptr, V8, SCV, (size_t)(rj + 2 * NGW), F.lane);
                    }
                }
            }
        } }
        if (BOTH(0)) xcd_barrier(bar);
        STAMP(1);
    }
    if (IN(1)) {
        pg8::Gemm g{A1, W1T, MPAD, IND, D};
        pg8::Order1 S{F.G, (int)blockIdx.x};
        pg8::Epi1 E{QB, KVB, XBB, GTB, RSTD1, b_in};
        REP(1) pg8::gemm_phase<pg8::Epi1, pg8::Order1, true, true>(F.lds + RING_OFF, g, S, E);
        {
            volatile LAS int* qb = (volatile LAS int*)(F.lds + LDSCTL_OFF + 512);
            for (;;) {
                __syncthreads();
                if (F.tid == 0) qb[0] = (int)__hip_atomic_fetch_add((unsigned*)(F.ctl + CW_QROW), 32u, __ATOMIC_RELAXED, __HIP_MEMORY_SCOPE_AGENT);
                __syncthreads();
                const int base = qb[0];
                if (base >= 16384 + 6144) break;
                f32x4 r0[8], r1[8], r2[8], r3[8];
                const bool isu = base < 16384;
                const float* src = isu ? peer_u : peer_v; const float* gc = isu ? norm_ffn_g : nullptr; unsigned char* dst = isu ? U8 : V8; float* sc = isu ? SCU : SCV;
                const size_t e0 = (size_t)(isu ? base : base - 16384) + F.wave * 4;
                p6::qrow_load(r0, src, e0, F.lane); p6::qrow_load(r1, src, e0 + 1, F.lane); p6::qrow_load(r2, src, e0 + 2, F.lane); p6::qrow_load(r3, src, e0 + 3, F.lane);
                p6::qrow_finish(r0, gc, dst, sc, e0, F.lane); p6::qrow_finish(r1, gc, dst, sc, e0 + 1, F.lane);
                p6::qrow_finish(r2, gc, dst, sc, e0 + 2, F.lane); p6::qrow_finish(r3, gc, dst, sc, e0 + 3, F.lane);
            }
        }
        if (BOTH(1)) xcd_barrier(bar);
        STAMP(2);
    }
    if (IN(2)) {
        bf16* MIX = (bf16*)(ws + WS_Z); float* SSA = (float*)(ws + WS_SSA); float* SSL = (float*)(ws + WS_SSL);
        const p2::LruP LP{args.in[6], args.in[7], args.in[8], args.in[9], args.in[10], args.in[11], args.in[12]};
        {
        REP(20) for (int u = (int)blockIdx.x; u < 256; u += F.G) p2::lru_unit(F.lds + RING_OFF, F.lds + LDSCTL_OFF + 5120, u >> 5, (u >> 1) & 15, u & 1, XBB, GTB, LP, MIX, SSL, F.tid);
        REP(21) for (int a = (int)blockIdx.x; a < 256; a += F.G) p2::attn_unit(F.lds + RING_OFF, a >> 5, (a >> 1) & 15, a & 1, QB, KVB, args.in[5], MIX, SSA, F.tid);
        }
        if (BOTH(2)) xcd_barrier(bar);
        STAMP(3);
    }
    if (IN(3)) {
        bf16* MIX = (bf16*)(ws + WS_Z); const float* SSA = (const float*)(ws + WS_SSA); const float* SSL = (const float*)(ws + WS_SSL);
        bf16* H1B = (bf16*)(ws + WS_H1); float* SS2 = (float*)(ws + WS_SS2);
        pg8::Order2 S{F.G, (int)blockIdx.x};
        LAS float* tbl = (LAS float*)(F.lds + LDSCTL_OFF + 1024);
        pg8::Unit u0{0, 0};
        for (int i = 0; i < 2; ++i) {
            pg8::Unit u; if (!S.next(i, u)) break; if (i == 0) u0 = u;
            if (F.tid < 256) {
                const size_t row = (size_t)u.pm * 256 + F.tid; float sa = 0.f, sl = 0.f;
#pragma unroll
                for (int k = 0; k < 4; ++k) { const f32x4 v = *(const GAS f32x4*)(SSA + row * 16 + 4 * k); sa += (v.x + v.y) + (v.z + v.w); }
#pragma unroll
                for (int k = 0; k < 8; ++k) { const f32x4 v = *(const GAS f32x4*)(SSL + row * 32 + 4 * k); sl += (v.x + v.y) + (v.z + v.w); }
                const float ra = 1.0f / sqrtf(sa * (1.0f / 1024) + EPS), rl = 1.0f / sqrtf(sl * (1.0f / 1024) + EPS);
                tbl[(i * 256 + F.tid) * 4] = ra / rl; tbl[(i * 256 + F.tid) * 4 + 1] = rl; tbl[(i * 256 + F.tid) * 4 + 2] = 1.0f / ra;
            }
        }
        __syncthreads();
        pg8::Gemm g{MIX, W2T, MREAL, D, D};
        pg8::Epi2 E{H1B, A1, SS2, (const LAS float*)tbl, u0.pm};
        REP(3) pg8::gemm_phase<pg8::Epi2, pg8::Order2, true, true>(F.lds + RING_OFF, g, S, E);
        if (BOTH(3)) xcd_barrier(bar);
        STAMP(4);
    }
    if (IN(4)) {
        bf16* H1B = (bf16*)(ws + WS_H1); bf16* QPB = (bf16*)(ws + WS_A1);
        pg8::Order2 S{F.G, (int)blockIdx.x};
        {
            const float* SS2 = (const float*)(ws + WS_SS2); float* RSTD2 = (float*)(ws + WS_RSTD2);
            pg8::Unit u; if (S.next(0, u) && F.tid < 256) {
                const size_t row = (size_t)u.pm * 256 + F.tid; float ssq = 0.f;
#pragma unroll
                for (int k = 0; k < 8; ++k) { const f32x4 v = *(const GAS f32x4*)(SS2 + row * 32 + 4 * k); ssq += (v.x + v.y) + (v.z + v.w); }
                RSTD2[row] = 1.0f / sqrtf(ssq * (1.0f / D) + EPS);
            }
        }
        pg8::Gemm g{H1B, W3T, MREAL, D, D};
        pg8::Epi3 E{QPB};
        REP(4) pg8::gemm_phase<pg8::Epi3, pg8::Order2, true, true>(F.lds + RING_OFF, g, S, E);
        if (BOTH(4)) { asm volatile("s_waitcnt vmcnt(0)" ::: "memory"); __syncthreads();
            if (F.tid == 0) { __builtin_amdgcn_fence(__ATOMIC_ACQUIRE, "agent"); asm volatile("s_waitcnt vmcnt(0)" ::: "memory"); }
            __syncthreads(); }
        STAMP(5);
    }
    if (IN(5)) {
        const bf16* QPB = (const bf16*)(ws + WS_A1);
        unsigned short* IDS = (unsigned short*)(ws + WS_IDS); float* GW = (float*)(ws + WS_GW); float* RSTD2 = (float*)(ws + WS_RSTD2);
        const bf16* H1B = (const bf16*)(ws + WS_H1);
        const pg8::Order2 S5{F.G, (int)blockIdx.x};
        REP(5) for (int ui = 0; ; ++ui) {
            pg8::Unit un; if (!S5.next(ui, un)) break;
            const int uh = un.pn, utg = un.pm;
            v4u xq[4][4]; const size_t tb = (size_t)utg * 256 + F.wave * 32 + uh;
            p5::retr_unit(F.lds + RING_OFF, uh, utg, QPB, SKB, IDS, GW, RSTD2, F.tid);
#pragma unroll
            for (int k = 0; k < 4; ++k) p6::qx_load(xq[k], H1B, tb + 8 * k, F.lane);
#pragma unroll
            for (int k = 0; k < 4; ++k) p6::qx_finish(xq[k], X8, SX, tb + 8 * k, F.lane);
        }
        if (BOTH(5)) xcd_barrier(bar);
        STAMP(6);
    }
    {
        const bf16* H1B = (const bf16*)(ws + WS_H1); const unsigned short* IDS = (const unsigned short*)(ws + WS_IDS); const float* GW = (const float*)(ws + WS_GW);
        const float* RSTD2 = (const float*)(ws + WS_RSTD2); bf16* PART = (bf16*)(ws + WS_PART); unsigned char* W8 = ws + WS_W; float* WS8 = (float*)(ws + WS_WSUM); bf16* ZB = (bf16*)(ws + WS_Z);
        const int slot = (int)blockIdx.x & 7, rank = (int)blockIdx.x >> 3, nrank = (F.G - slot + 7) >> 3;
        const int gw = F.vcu * NWAVES + F.wave, NGW = F.G * NWAVES;
        if (IN(6)) { REP(6) p6::usweep(X8, SX, U8, IDS, PART, F.lds + RING_OFF, slot, rank, nrank, F.wave, F.lane); if (BOTH(6)) xcd_barrier(bar); STAMP(7); }
        if (IN(7)) { REP(7) p6::wreduce(PART, GW, RSTD2, IDS, SCU, SCV, W8, WS8, (size_t)gw * 64 + F.lane, (size_t)NGW * 64); if (BOTH(7)) xcd_barrier(bar); STAMP(8); }
        if (IN(8)) { REP(8) p6::vsweep(H1B, V8, IDS, W8, WS8, ZB, F.lds + RING_OFF, slot, rank, nrank, F.wave, F.lane); if (BOTH(8)) xcd_barrier(bar); STAMP(9); }
        if (PROBE_PH == 30) { for (int k = 0; k < 16; ++k) xcd_barrier(bar); }
        if (IN(9)) { REP(9) {
            v4u zc[4], zn[4], hc[4], hn[4];
            if (gw < MREAL) p6::final_load(zc, hc, ZB, H1B, (size_t)gw, F.lane);
            for (int t = gw; t < MREAL; t += NGW) {
                if (t + NGW < MREAL) p6::final_load(zn, hn, ZB, H1B, (size_t)(t + NGW), F.lane);
                p6::final_finish(zc, hc, args.in[21], args.out, (size_t)t, F.lane);
#pragma unroll
                for (int j = 0; j < 4; ++j) { zc[j] = zn[j]; hc[j] = hn[j]; }
            } } }
        if (PROBE_PH >= 100) {
            asm volatile("s_waitcnt vmcnt(0)" ::: "memory"); __syncthreads(); STAMP(10);
            if (blockIdx.x == 0 && F.tid == 0) {
                volatile LAS unsigned long long* ts = (volatile LAS unsigned long long*)(F.lds + LDSCTL_OFF + 640);
                const unsigned long long span = ts[PROBE_PH - 100 + 1] - ts[PROBE_PH - 100], t0 = __builtin_amdgcn_s_memrealtime();
                while (__builtin_amdgcn_s_memrealtime() - t0 < span) __builtin_amdgcn_s_sleep(8);
            }
        }
    }
#undef IN
#undef BOTH
}

extern "C" void kernel_launch(void* const* d_in, const int* in_sizes, int n_in, void* d_out, int out_size, void* d_ws, size_t ws_size, hipStream_t stream) {
    static int grid = 0;
    if (grid == 0) {
        int dev = 0, cus = 0;
        if (hipGetDevice(&dev) != hipSuccess || hipDeviceGetAttribute(&cus, hipDeviceAttributeMultiprocessorCount, dev) != hipSuccess) { fprintf(stderr, "kernel_launch: device query failed\n"); grid = -1; return; }
        if (hipFuncSetAttribute((const void*)fwd, hipFuncAttributeMaxDynamicSharedMemorySize, LDS_BYTES) != hipSuccess) { fprintf(stderr, "kernel_launch: hipFuncSetAttribute failed\n"); grid = -1; return; }
        int per_cu = 0;
        if (hipOccupancyMaxActiveBlocksPerMultiprocessor(&per_cu, (const void*)fwd, NWAVES * 64, LDS_BYTES) != hipSuccess || per_cu < 1) fprintf(stderr, "kernel_launch: occupancy query says %d\n", per_cu);
        (void)hipGetLastError();
        grid = cus;
        if (cus != 256) { fprintf(stderr, "kernel_launch: built for a 256-CU device (tile-to-workgroup maps of the GEMM phases), found %d CUs; nothing launched\n", cus); grid = -1; return; }
        if (ws_size < WS_END) { fprintf(stderr, "kernel_launch: ws too small %zu\n", ws_size); grid = -1; return; }
    }
    if (grid < 0) return;
    (void)hipMemsetAsync((char*)d_ws + WS_CTL, 0, CTL_ZERO_BYTES, stream);
    Args a{};
    for (int i = 0; i < 22; ++i) a.in[i] = (const float*)d_in[i];
    a.out = (float*)d_out; a.ws = (unsigned char*)d_ws; a.ph_lo = 0; a.ph_hi = 10;
    hipLaunchKernelGGL(fwd, dim3(grid), dim3(NWAVES * 64), LDS_BYTES, stream, a);
}
```

```cpp
#include <hip/hip_runtime.h>
#include <cstdio>
#include <cstdint>
#include <math.h>

#define D 2048
#define NB 8
#define SEQ 2048
#define NMETA 16
#define TT (SEQ + NMETA)
#define MR (NB * TT)
#define MREAL (NB * SEQ)
#define MPAD (MREAL + 256)
#define QD 1024
#define KVD 128
#define LW 1024
#define IND 3328
#define EPS 1e-6f
#define QSCALE (0.125f * 1.4426950408889634f)
#define GAS __attribute__((address_space(1)))
#define LAS __attribute__((address_space(3)))

#define DPP_I(x, ctrl) __builtin_amdgcn_update_dpp(0, (x), (ctrl), 0xf, 0xf, true)
__device__ __forceinline__ int dpp_x1(int x) { return DPP_I(x, 0xB1); }
__device__ __forceinline__ int dpp_x2(int x) { return DPP_I(x, 0x4E); }
__device__ __forceinline__ int dpp_hm(int x) { return DPP_I(x, 0x141); }
__device__ __forceinline__ int dpp_rm(int x) { return DPP_I(x, 0x140); }
__device__ __forceinline__ int dpp_r8(int x) { return DPP_I(x, 0x128); }
__device__ __forceinline__ float fdpp_x1(float x) { return __builtin_bit_cast(float, dpp_x1(__builtin_bit_cast(int, x))); }
__device__ __forceinline__ float fdpp_x2(float x) { return __builtin_bit_cast(float, dpp_x2(__builtin_bit_cast(int, x))); }
__device__ __forceinline__ float fdpp_hm(float x) { return __builtin_bit_cast(float, dpp_hm(__builtin_bit_cast(int, x))); }
__device__ __forceinline__ float fdpp_rm(float x) { return __builtin_bit_cast(float, dpp_rm(__builtin_bit_cast(int, x))); }
__device__ __forceinline__ float max16(float v) { v = fmaxf(v, fdpp_x1(v)); v = fmaxf(v, fdpp_x2(v)); v = fmaxf(v, fdpp_hm(v)); return fmaxf(v, fdpp_rm(v)); }
__device__ __forceinline__ float sum64(float v) {
    v += fdpp_x1(v); v += fdpp_x2(v); v += fdpp_hm(v); v += fdpp_rm(v);
    return (__builtin_bit_cast(float, __builtin_amdgcn_readlane(__builtin_bit_cast(int, v), 0)) + __builtin_bit_cast(float, __builtin_amdgcn_readlane(__builtin_bit_cast(int, v), 16)))
         + (__builtin_bit_cast(float, __builtin_amdgcn_readlane(__builtin_bit_cast(int, v), 32)) + __builtin_bit_cast(float, __builtin_amdgcn_readlane(__builtin_bit_cast(int, v), 48)));
}
__device__ __forceinline__ float max64(float v) {
    v = max16(v);
    return fmaxf(fmaxf(__builtin_bit_cast(float, __builtin_amdgcn_readlane(__builtin_bit_cast(int, v), 0)), __builtin_bit_cast(float, __builtin_amdgcn_readlane(__builtin_bit_cast(int, v), 16))),
                 fmaxf(__builtin_bit_cast(float, __builtin_amdgcn_readlane(__builtin_bit_cast(int, v), 32)), __builtin_bit_cast(float, __builtin_amdgcn_readlane(__builtin_bit_cast(int, v), 48))));
}
__device__ __forceinline__ float sum8(float v) { v += fdpp_x1(v); v += fdpp_x2(v); return v + fdpp_hm(v); }
__device__ __forceinline__ float sum4(float v) { v += fdpp_x1(v); return v + fdpp_x2(v); }
__device__ __forceinline__ float sum_x32(float v) { return v + __shfl_xor(v, 32); }
__device__ __forceinline__ float max_x32(float v) { return fmaxf(v, __shfl_xor(v, 32)); }
__device__ __forceinline__ float sum_x16(float v) { return v + __shfl_xor(v, 16); }
namespace pg8 {
#define PG8_LAS __attribute__((address_space(3)))
typedef unsigned short bf16_t;
typedef short bf16x8 __attribute__((ext_vector_type(8)));
typedef float f32x4 __attribute__((ext_vector_type(4)));
typedef unsigned u32x4 __attribute__((ext_vector_type(4)));
constexpr int BM = 256, BK = 64, HALF = 128, HTB = HALF * BK * 2  , STAGE_BYTES = 8 * HTB, NXCD = 8, WGM = 8;

__host__ __device__ __forceinline__ int lds_byte(int r, int c) { const int st = (r >> 4) * 2 + (c >> 5), rr = r & 15, cc = c & 31, ob = rr * 64 + cc * 2; return st * 1024 + (ob ^ (((ob >> 9) & 1) << 5)); }
__host__ __device__ __forceinline__ void stage_rc(int b, int& R, int& C) { const int st = b / 1024, sb = b % 1024, swz = sb ^ (((sb >> 9) & 1) << 5); R = (st >> 1) * 16 + swz / 64; C = (st & 1) * 32 + (swz % 64) / 2; }
__host__ __device__ __forceinline__ int perm32(int rho) { const int n = rho >> 4, i = rho & 15; return 8 * (i >> 2) + 4 * n + (i & 3); }

struct Unit { int pm, pn; };
struct Gemm { const bf16_t* A; const bf16_t* Bt; int M, N, K; };

struct StaticOrder {
    int nM, nN, nwg, G, c;
    __host__ __device__ void init(int M, int N, int G_, int c_) { nM = M / BM; nN = N / BM; nwg = nM * nN; G = G_; c = c_; }
    __host__ __device__ bool next(int i, Unit& u) const {
        const long L = (long)i * G + c; if (L >= nwg) return false;
        int wgid = (int)L; { const int q = nwg / NXCD, r = nwg % NXCD, xcd = wgid % NXCD, off = wgid / NXCD; wgid = (xcd < r ? xcd * (q + 1) : r * (q + 1) + (xcd - r) * q) + off; }
        const int nig = WGM * nN, gid = wgid / nig, fm = gid * WGM, gsz = (nM - fm) < WGM ? (nM - fm) : WGM;
        u.pm = fm + ((wgid % nig) % gsz); u.pn = (wgid % nig) / gsz; return true;
    }
    __device__ __forceinline__ void a_ready(const Unit&) const {}
    __device__ __forceinline__ void done(const Unit&) const {}
};

__device__ __forceinline__ unsigned cvt_pk_bf16(float lo, float hi) { unsigned r; asm volatile("v_cvt_pk_bf16_f32 %0, %1, %2" : "=v"(r) : "v"(lo), "v"(hi)); return r; }
typedef unsigned u32x2 __attribute__((ext_vector_type(2)));
struct Order1 {
    int G, c;
    __device__ __forceinline__ bool next(int i, Unit& u) const {
        const int L = i * G + c; if (L >= 837) return false;
        if (L >= 832) { u.pm = 64; u.pn = 4 + (L - 832); return true; }
        const int nwg = 832, nN = 13;
        int wgid = L; { const int q = nwg / NXCD, xcd = wgid % NXCD, off = wgid / NXCD; wgid = xcd * q + off; }
        const int nig = WGM * nN, gid = wgid / nig, fm = gid * WGM;
        u.pm = fm + ((wgid % nig) % WGM); u.pn = (wgid % nig) / WGM; return true;
    }
    __device__ __forceinline__ void a_ready(const Unit&) const {}
    __device__ __forceinline__ void done(const Unit&) const {}
};
struct Order2 {
    int G, c;
    __device__ __forceinline__ bool next(int i, Unit& u) const {
        const int L = i * G + c; if (L >= 512) return false;
        const int nwg = 512, nN = 8;
        int wgid = L; { const int q = nwg / NXCD, xcd = wgid % NXCD, off = wgid / NXCD; wgid = xcd * q + off; }
        const int nig = WGM * nN, gid = wgid / nig, fm = gid * WGM;
        u.pm = fm + ((wgid % nig) % WGM); u.pn = (wgid % nig) / WGM; return true;
    }
    __device__ __forceinline__ void a_ready(const Unit&) const {}
    __device__ __forceinline__ void done(const Unit&) const {}
};

struct Epi1 {
    static constexpr bool PERM = true, AFTER_DRAIN = false, MIDK = false, INIT = false;
    bf16_t *Q, *KV, *XB, *GT; const float* rstd; const float* bias;
    __device__ __forceinline__ void midk(f32x4 (&acc)[2][2][4][2], const Unit& u, int wr, int wc, int fr, int fq) const {}
    __device__ __forceinline__ void operator()(const f32x4 (&acc)[2][2][4][2], const Unit& u, int wr, int wc, int fr, int fq) const {
        const int row0 = u.pm * BM + wr * 64 + fr;
        bf16_t* base; int ldc, colb; float sc = 1.f;
        if (u.pn < 4) { base = Q; ldc = 1024; colb = u.pn * BM; sc = QSCALE; }
        else if (u.pn == 4) { base = KV; ldc = 256; colb = 0; }
        else if (u.pn < 9) { base = XB; ldc = 1024; colb = (u.pn - 5) * BM; }
        else { base = GT; ldc = 1024; colb = (u.pn - 9) * BM; }
        const int col0 = colb + wc * 32 + 8 * fq, bcol0 = u.pn * BM + wc * 32 + 8 * fq;
        f32x4 bv[2][2];
#pragma unroll
        for (int bj = 0; bj < 2; ++bj)
#pragma unroll
            for (int n = 0; n < 2; ++n) bv[bj][n] = *(const f32x4*)(bias + bcol0 + bj * HALF + 4 * n);
#pragma unroll
        for (int ai = 0; ai < 2; ++ai)
#pragma unroll
            for (int m = 0; m < 4; ++m) {
                const int row = row0 + ai * HALF + m * 16; const float rs = rstd[row];
                bf16_t* rowp = base + (size_t)row * ldc + col0;
#pragma unroll
                for (int bj = 0; bj < 2; ++bj) {
                    f32x4 v0 = (acc[ai][bj][m][0] * rs + bv[bj][0]) * sc, v1 = (acc[ai][bj][m][1] * rs + bv[bj][1]) * sc;
                    u32x4 w; w.x = cvt_pk_bf16(v0[0], v0[1]); w.y = cvt_pk_bf16(v0[2], v0[3]); w.z = cvt_pk_bf16(v1[0], v1[1]); w.w = cvt_pk_bf16(v1[2], v1[3]);
                    *(u32x4*)(rowp + bj * HALF) = w; } }
    }
};
struct Epi2 {
    static constexpr bool PERM = true, AFTER_DRAIN = false, MIDK = true, INIT = true;
    bf16_t* H1; const bf16_t* xb; float* SS2; const LAS float* tbl; int pm0;
    __device__ __forceinline__ void init(f32x4 (&acc)[2][2][4][2], const Unit& u, int wr, int wc, int fr, int fq) const {
        const LAS float* t = tbl + (u.pm == pm0 ? 0 : 1024);
        const int col0 = u.pn * BM + wc * 32 + 8 * fq;
#pragma unroll
        for (int ai = 0; ai < 2; ++ai)
#pragma unroll
            for (int m = 0; m < 4; ++m) {
                const int rl = ai * HALF + wr * 64 + m * 16 + fr; const size_t row = (size_t)u.pm * BM + rl; const float ia = t[rl * 4 + 2];
#pragma unroll
                for (int bj = 0; bj < 2; ++bj) {
                    const u32x4 xw = *(const u32x4*)(xb + row * 2048 + col0 + bj * HALF);
                    acc[ai][bj][m][0] = (f32x4){__builtin_bit_cast(float, xw.x << 16), __builtin_bit_cast(float, xw.x & 0xffff0000u), __builtin_bit_cast(float, xw.y << 16), __builtin_bit_cast(float, xw.y & 0xffff0000u)} * ia;
                    acc[ai][bj][m][1] = (f32x4){__builtin_bit_cast(float, xw.z << 16), __builtin_bit_cast(float, xw.z & 0xffff0000u), __builtin_bit_cast(float, xw.w << 16), __builtin_bit_cast(float, xw.w & 0xffff0000u)} * ia; }
            }
    }
    __device__ __forceinline__ void midk(f32x4 (&acc)[2][2][4][2], const Unit& u, int wr, int wc, int fr, int fq) const {
        const LAS float* t = tbl + (u.pm == pm0 ? 0 : 1024);
#pragma unroll
        for (int ai = 0; ai < 2; ++ai)
#pragma unroll
            for (int m = 0; m < 4; ++m) { const float ra = t[(ai * HALF + wr * 64 + m * 16 + fr) * 4];
#pragma unroll
                for (int bj = 0; bj < 2; ++bj)
#pragma unroll
                    for (int n = 0; n < 2; ++n) acc[ai][bj][m][n] = acc[ai][bj][m][n] * ra; }
    }
    __device__ __forceinline__ void operator()(const f32x4 (&acc)[2][2][4][2], const Unit& u, int wr, int wc, int fr, int fq) const {
        const LAS float* t = tbl + (u.pm == pm0 ? 0 : 1024);
        const int col0 = u.pn * BM + wc * 32 + 8 * fq;
#pragma unroll
        for (int ai = 0; ai < 2; ++ai)
#pragma unroll
            for (int m = 0; m < 4; ++m) {
                const int rl = ai * HALF + wr * 64 + m * 16 + fr; const size_t row = (size_t)u.pm * BM + rl; const float rs = t[rl * 4 + 1];
                float ss = 0.f;
#pragma unroll
                for (int bj = 0; bj < 2; ++bj) {
                    const f32x4 v0 = acc[ai][bj][m][0] * rs, v1 = acc[ai][bj][m][1] * rs;
                    ss += (v0[0] * v0[0] + v0[1] * v0[1]) + (v0[2] * v0[2] + v0[3] * v0[3]) + (v1[0] * v1[0] + v1[1] * v1[1]) + (v1[2] * v1[2] + v1[3] * v1[3]);
                    u32x4 w; w.x = cvt_pk_bf16(v0[0], v0[1]); w.y = cvt_pk_bf16(v0[2], v0[3]); w.z = cvt_pk_bf16(v1[0], v1[1]); w.w = cvt_pk_bf16(v1[2], v1[3]);
                    *(u32x4*)(H1 + row * 2048 + col0 + bj * HALF) = w; }
                ss = sum_x32(sum_x16(ss));
                if (fq == 0) SS2[row * 32 + u.pn * 4 + wc] = ss;
            }
    }
};
struct Epi3 {
    static constexpr bool PERM = true, AFTER_DRAIN = false, MIDK = false, INIT = false;
    bf16_t* O;
    __device__ __forceinline__ void midk(f32x4 (&acc)[2][2][4][2], const Unit& u, int wr, int wc, int fr, int fq) const {}
    __device__ __forceinline__ void operator()(const f32x4 (&acc)[2][2][4][2], const Unit& u, int wr, int wc, int fr, int fq) const {
        const int col0 = u.pn * BM + wc * 32 + 8 * fq;
#pragma unroll
        for (int ai = 0; ai < 2; ++ai)
#pragma unroll
            for (int m = 0; m < 4; ++m) { const size_t row = (size_t)u.pm * BM + ai * HALF + wr * 64 + m * 16 + fr;
#pragma unroll
                for (int bj = 0; bj < 2; ++bj) { const f32x4 v0 = acc[ai][bj][m][0], v1 = acc[ai][bj][m][1];
                    u32x4 w; w.x = cvt_pk_bf16(v0[0], v0[1]); w.y = cvt_pk_bf16(v0[2], v0[3]); w.z = cvt_pk_bf16(v1[0], v1[1]); w.w = cvt_pk_bf16(v1[2], v1[3]);
                    *(u32x4*)(O + row * 2048 + col0 + bj * HALF) = w; } }
    }
};
template <class Epi, class Sched, bool ALIGN_EPI = false, bool SP2 = false>
__device__ __forceinline__ void gemm_phase(PG8_LAS unsigned char* lds, const Gemm g, const Sched& S, const Epi& E) {
    const int tid = threadIdx.x, wid = __builtin_amdgcn_readfirstlane(tid >> 6), lane = tid & 63, wr = wid >> 2, wc = wid & 3, fr = lane & 15, fq = lane >> 4;
    const int K = g.K, nt = K / BK;
    unsigned voffA[2], voffB[2];
#pragma unroll
    for (int i = 0; i < 2; ++i) { int R, C; stage_rc(tid * 16 + i * 8192, R, C); const int Rb = Epi::PERM ? ((R & ~31) + perm32(R & 31)) : R;
        voffA[i] = (unsigned)(R * K + C) * 2u; voffB[i] = (unsigned)(Rb * K + C) * 2u; }
    const size_t kstep = (size_t)(BK * 2);
    const size_t hstep = (size_t)HALF * K * 2;
    const size_t tstep = 2 * hstep;
    const unsigned ldsw = (unsigned)wid * 1024u;
    const int aoff = lds_byte(wr * 64 + fr, fq * 8), boff = lds_byte(wc * 32 + fr, fq * 8);
#define PG8_SA(b, h) (((b) * 2 + (h)) * HTB)
#define PG8_SB(b, h) ((4 + (b) * 2 + (h)) * HTB)
#define PG8_STAGE(bufoff, gbase, voff) do { _Pragma("unroll") for (int _i = 0; _i < 2; ++_i) \
        __builtin_amdgcn_global_load_lds((const unsigned*)((const char*)(gbase) + (voff)[_i]), (PG8_LAS unsigned*)(lds + (bufoff) + ldsw + _i * 8192), 16, 0, 0); } while (0)
#define PG8_LDA(dst, b, h) do { _Pragma("unroll") for (int m = 0; m < 4; ++m) _Pragma("unroll") for (int k = 0; k < 2; ++k) dst[m][k] = *(const PG8_LAS bf16x8*)(lds + PG8_SA(b, h) + aoff + m * 2048 + k * 1024); } while (0)
#define PG8_LDB(dst, b, h) do { _Pragma("unroll") for (int n = 0; n < 2; ++n) _Pragma("unroll") for (int k = 0; k < 2; ++k) dst[n][k] = *(const PG8_LAS bf16x8*)(lds + PG8_SB(b, h) + boff + n * 2048 + k * 1024); } while (0)
#define PG8_MMA(ai, bj, At, Bt) do { __builtin_amdgcn_s_setprio(1); _Pragma("unroll") for (int m = 0; m < 4; ++m) _Pragma("unroll") for (int n = 0; n < 2; ++n) _Pragma("unroll") for (int k = 0; k < 2; ++k) \
        acc[ai][bj][m][n] = __builtin_amdgcn_mfma_f32_16x16x32_bf16(Bt[n][k], At[m][k], acc[ai][bj][m][n], 0, 0, 0); __builtin_amdgcn_s_setprio(0); } while (0)
#define PG8_WAIT_V(n) asm volatile("s_waitcnt vmcnt(" #n ")" ::: "memory")
#define PG8_WAIT_L(n) asm volatile("s_waitcnt lgkmcnt(" #n ")" ::: "memory")
#define PG8_BAR __builtin_amdgcn_s_barrier()
#define PG8_SCHED __builtin_amdgcn_sched_barrier(0)
    Unit cur, nxt; int ui = 0;
    if (!S.next(0, cur)) return;
    f32x4 acc[2][2][4][2];
    if constexpr (Epi::INIT) E.init(acc, cur, wr, wc, fr, fq);
    else {
#pragma unroll
    for (int a = 0; a < 2; ++a)
#pragma unroll
        for (int b = 0; b < 2; ++b)
#pragma unroll
            for (int m = 0; m < 4; ++m)
#pragma unroll
                for (int n = 0; n < 2; ++n) acc[a][b][m][n] = (f32x4){0.f, 0.f, 0.f, 0.f};
    }
    bf16x8 At[4][2], B0[2][2], B1[2][2];
    const char* cA = (const char*)g.A + (size_t)cur.pm * tstep; const char* cB = (const char*)g.Bt + (size_t)cur.pn * tstep;
    S.a_ready(cur);
    if constexpr (SP2) {
        PG8_STAGE(PG8_SB(0, 0), cB, voffB); PG8_STAGE(PG8_SB(0, 1), cB + hstep, voffB); PG8_STAGE(PG8_SA(0, 0), cA, voffA); PG8_STAGE(PG8_SA(0, 1), cA + hstep, voffA);
        if (wr == 1) PG8_BAR;
        PG8_WAIT_V(2); PG8_BAR;
        PG8_STAGE(PG8_SB(1, 0), cB + kstep, voffB); PG8_STAGE(PG8_SA(1, 0), cA + kstep, voffA); PG8_STAGE(PG8_SB(1, 1), cB + hstep + kstep, voffB);
        PG8_WAIT_V(6); PG8_BAR;
    } else {
        PG8_STAGE(PG8_SB(0, 0), cB, voffB); PG8_STAGE(PG8_SA(0, 0), cA, voffA); PG8_STAGE(PG8_SB(0, 1), cB + hstep, voffB); PG8_STAGE(PG8_SA(0, 1), cA + hstep, voffA);
        if (wr == 1) PG8_BAR;
        PG8_WAIT_V(4); PG8_BAR;
        PG8_STAGE(PG8_SB(1, 0), cB + kstep, voffB); PG8_STAGE(PG8_SA(1, 0), cA + kstep, voffA); PG8_STAGE(PG8_SB(1, 1), cB + hstep + kstep, voffB);
        PG8_WAIT_V(6); PG8_BAR;
    }
    for (;;) {
        const bool has_next = S.next(ui + 1, nxt);
        const char* nA = has_next ? (const char*)g.A + (size_t)nxt.pm * tstep : cA; const char* nB = has_next ? (const char*)g.Bt + (size_t)nxt.pn * tstep : cB;
        for (int t = 0; t < nt; t += 2) {
            if constexpr (Epi::MIDK) { if (t == nt / 2) E.midk(acc, cur, wr, wc, fr, fq); }
            const bool last = (t == nt - 2);
            const char* a1 = cA + (size_t)(t + 1) * kstep;
            const char* a2 = last ? nA : cA + (size_t)(t + 2) * kstep; const char* b2 = last ? nB : cB + (size_t)(t + 2) * kstep;
            const char* a3 = a2 + kstep; const char* b3 = b2 + kstep;
            if (last && has_next) S.a_ready(nxt);
            if constexpr (SP2) {
            PG8_LDB(B0, 0, 0); PG8_LDB(B1, 0, 1); PG8_SCHED; PG8_LDA(At, 0, 0); PG8_STAGE(PG8_SA(1, 1), a1 + hstep, voffA);
            PG8_WAIT_V(8); PG8_WAIT_L(0); PG8_BAR; PG8_MMA(0, 0, At, B0); PG8_MMA(0, 1, At, B1); PG8_BAR; PG8_SCHED;
            PG8_LDA(At, 0, 1); PG8_STAGE(PG8_SB(0, 0), b2, voffB); PG8_STAGE(PG8_SB(0, 1), b2 + hstep, voffB); PG8_STAGE(PG8_SA(0, 0), a2, voffA);
            PG8_WAIT_V(8); PG8_WAIT_L(0); PG8_BAR; PG8_MMA(1, 0, At, B0); PG8_MMA(1, 1, At, B1); PG8_BAR; PG8_SCHED;
            PG8_LDB(B0, 1, 0); PG8_LDB(B1, 1, 1); PG8_SCHED; PG8_LDA(At, 1, 0); PG8_STAGE(PG8_SA(0, 1), a2 + hstep, voffA);
            PG8_WAIT_V(8); PG8_WAIT_L(0); PG8_BAR; PG8_MMA(0, 0, At, B0); PG8_MMA(0, 1, At, B1); PG8_BAR; PG8_SCHED;
            PG8_LDA(At, 1, 1); PG8_STAGE(PG8_SB(1, 0), b3, voffB); PG8_STAGE(PG8_SB(1, 1), b3 + hstep, voffB); PG8_STAGE(PG8_SA(1, 0), a3, voffA);
            PG8_WAIT_V(8); PG8_WAIT_L(0); PG8_BAR; PG8_MMA(1, 0, At, B0); PG8_MMA(1, 1, At, B1); PG8_BAR; PG8_SCHED;
            } else {
            PG8_LDB(B0, 0, 0); PG8_SCHED; PG8_LDA(At, 0, 0); PG8_STAGE(PG8_SA(1, 1), a1 + hstep, voffA);
            PG8_WAIT_L(8); PG8_BAR; PG8_WAIT_L(0); PG8_MMA(0, 0, At, B0); PG8_BAR; PG8_SCHED;
            PG8_LDB(B1, 0, 1); PG8_STAGE(PG8_SB(0, 0), b2, voffB);
            PG8_BAR; PG8_WAIT_L(0); PG8_MMA(0, 1, At, B1); PG8_BAR;
            PG8_LDA(At, 0, 1); PG8_STAGE(PG8_SA(0, 0), a2, voffA);
            PG8_BAR; PG8_WAIT_L(0); PG8_MMA(1, 0, At, B0); PG8_BAR; PG8_SCHED;
            PG8_STAGE(PG8_SB(0, 1), b2 + hstep, voffB);
            PG8_WAIT_V(6); PG8_BAR; PG8_MMA(1, 1, At, B1); PG8_BAR;
            PG8_LDB(B0, 1, 0); PG8_SCHED; PG8_LDA(At, 1, 0); PG8_STAGE(PG8_SA(0, 1), a2 + hstep, voffA);
            PG8_WAIT_L(8); PG8_BAR; PG8_WAIT_L(0); PG8_MMA(0, 0, At, B0); PG8_BAR; PG8_SCHED;
            PG8_LDB(B1, 1, 1); PG8_STAGE(PG8_SB(1, 0), b3, voffB);
            PG8_BAR; PG8_WAIT_L(0); PG8_MMA(0, 1, At, B1); PG8_BAR;
            PG8_LDA(At, 1, 1); PG8_STAGE(PG8_SA(1, 0), a3, voffA);
            PG8_BAR; PG8_WAIT_L(0); PG8_MMA(1, 0, At, B0); PG8_BAR; PG8_SCHED;
            PG8_STAGE(PG8_SB(1, 1), b3 + hstep, voffB);
            PG8_WAIT_V(6); PG8_BAR; PG8_MMA(1, 1, At, B1); PG8_BAR;
            }
        }
        if constexpr (ALIGN_EPI) { if (wr == 0) PG8_BAR; }
        if constexpr (!Epi::AFTER_DRAIN) { E(acc, cur, wr, wc, fr, fq); S.done(cur); }
        if (!has_next) break;
        if constexpr (Epi::INIT) E.init(acc, nxt, wr, wc, fr, fq);
        else {
#pragma unroll
        for (int a = 0; a < 2; ++a)
#pragma unroll
            for (int b = 0; b < 2; ++b)
#pragma unroll
                for (int m = 0; m < 4; ++m)
#pragma unroll
                    for (int n = 0; n < 2; ++n) acc[a][b][m][n] = (f32x4){0.f, 0.f, 0.f, 0.f};
        }
        cur = nxt; cA = nA; cB = nB; ++ui;
        if constexpr (ALIGN_EPI) { if (wr == 1) PG8_BAR; }
    }
    PG8_WAIT_V(0);
    if constexpr (!ALIGN_EPI) { if (wr == 0) PG8_BAR; }
    PG8_BAR;
    if constexpr (Epi::AFTER_DRAIN) { E.fused(acc, cur, wr, wc, fr, fq, lds, wid, lane); S.done(cur); }
#undef PG8_SA
#undef PG8_SB
#undef PG8_STAGE
#undef PG8_LDA
#undef PG8_LDB
#undef PG8_MMA
#undef PG8_WAIT_V
#undef PG8_WAIT_L
#undef PG8_BAR
#undef PG8_SCHED
}
}
#define XB_TMO      128
#define XB_XCNT(j)  (256  + 64 * (j))
#define XB_XSUB(j)  (1280 + 64 * (j))
#define XB_XGEN(j)  (2304 + 64 * (j))
#define XB_TOP      3328
#define XB_TOPGEN   3392
#define XCD_BAR_WORDS 3456
#define XB_SPIN_CAP (1u << 18)

__device__ __forceinline__ unsigned xb_ld(unsigned* p)              { return __hip_atomic_load(p, __ATOMIC_RELAXED, __HIP_MEMORY_SCOPE_AGENT); }
__device__ __forceinline__ unsigned xb_add(unsigned* p, unsigned v) { return __hip_atomic_fetch_add(p, v, __ATOMIC_RELAXED, __HIP_MEMORY_SCOPE_AGENT); }
__device__ __forceinline__ unsigned xb_xcc_id() { return (unsigned)__builtin_amdgcn_s_getreg((3 << 11) | 20) & 0xFu; }
#define XB_SPIN(cond, bar) do { unsigned _sp = 0; while (cond) { __builtin_amdgcn_s_sleep(1); \
    if ((++_sp & 255u) == 0u) { if (xb_ld(&(bar)[XB_TMO])) break; if (_sp > XB_SPIN_CAP) { atomicAdd(&(bar)[XB_TMO], 1u); break; } } } } while (0)

struct XcdBarrier {
    unsigned* bar; unsigned x;
    volatile LAS unsigned* st;
};

__device__ __forceinline__ XcdBarrier xcd_barrier_post(unsigned* bar, volatile LAS unsigned* st) {
    XcdBarrier b; b.bar = bar; b.x = xb_xcc_id(); b.st = st;
    if (threadIdx.x == 0) (void)xb_add(&bar[XB_XCNT(b.x)], 1u);
    return b;
}
__device__ __forceinline__ void xcd_barrier_complete(unsigned* bar, unsigned x, unsigned& nloc, unsigned& nx) {
    const unsigned G = gridDim.x * gridDim.y * gridDim.z;
    unsigned sum, cnt, mine, sp = 0u;
    for (;;) {
        sum = 0u; cnt = 0u; mine = 0u;
#pragma unroll
        for (unsigned j = 0; j < 16; ++j) { const unsigned c = xb_ld(&bar[XB_XCNT(j)]); sum += c; cnt += (c > 0u) ? 1u : 0u; mine = (j == x) ? c : mine; }
        if (sum == G) break;
        __builtin_amdgcn_s_sleep(1);
        if ((++sp & 255u) == 0u) { if (xb_ld(&bar[XB_TMO])) break; if (sp > XB_SPIN_CAP) { atomicAdd(&bar[XB_TMO], 1u); break; } }
    }
    nloc = mine > 0u ? mine : 1u; nx = cnt > 0u ? cnt : 1u;
}

__device__ __forceinline__ void xcd_barrier(const XcdBarrier& b) {
    asm volatile("s_waitcnt vmcnt(0)" ::: "memory");
    __syncthreads();
    if (threadIdx.x == 0) {
        unsigned* bar = b.bar;
        __builtin_amdgcn_s_waitcnt(0);
        unsigned nloc = b.st[0], nx = b.st[1];
        if (nloc == 0u) { xcd_barrier_complete(bar, b.x, nloc, nx); b.st[0] = nloc; b.st[1] = nx; }
        const unsigned old = xb_add(&bar[XB_XSUB(b.x)], 1u);
        const unsigned gen = old / nloc;
        if (old + 1u == (gen + 1u) * nloc) {
            __builtin_amdgcn_fence(__ATOMIC_RELEASE, "agent");
            asm volatile("s_waitcnt vmcnt(0)" ::: "memory");
            const unsigned og = xb_add(&bar[XB_TOP], 1u);
            const unsigned tg = og / nx;
            if (og + 1u == (tg + 1u) * nx) xb_add(&bar[XB_TOPGEN], 1u);
            else XB_SPIN(xb_ld(&bar[XB_TOPGEN]) == tg, bar);
            __builtin_amdgcn_fence(__ATOMIC_ACQUIRE, "agent");
            xb_add(&bar[XB_XGEN(b.x)], 1u);
            asm volatile("s_waitcnt vmcnt(0)" ::: "memory");
        } else {
            XB_SPIN(xb_ld(&bar[XB_XGEN(b.x)]) == gen, bar);
            __builtin_amdgcn_fence(__ATOMIC_ACQUIRE, "agent");
            asm volatile("s_waitcnt vmcnt(0)" ::: "memory");
        }
    }
    __syncthreads();
}

constexpr int NWAVES = 8;
constexpr size_t MiB = 1u << 20;
constexpr size_t WS_CTL = 0, CTL_ZERO_BYTES = 1 * MiB;
constexpr size_t WS_W1T = 2 * MiB;
constexpr size_t WS_W2T = 16 * MiB;
constexpr size_t WS_W3T = 24 * MiB;
constexpr size_t WS_SKB = 32 * MiB;
constexpr size_t WS_RSTD1 = 33 * MiB;
constexpr size_t WS_SSA = 34 * MiB;
constexpr size_t WS_SSL = 35 * MiB;
constexpr size_t WS_SS2 = 37 * MiB;
constexpr size_t WS_RSTD2 = 39 * MiB;
constexpr size_t WS_IDS = 40 * MiB;
constexpr size_t WS_GW = 48 * MiB;
constexpr size_t WS_U8 = 64 * MiB;
constexpr size_t WS_V8 = 96 * MiB;
constexpr size_t WS_X8 = 128 * MiB;
constexpr size_t WS_SX = 160 * MiB;
constexpr size_t WS_SCU = 162 * MiB;
constexpr size_t WS_SCV = 163 * MiB;
constexpr size_t WS_WSUM = 164 * MiB;
constexpr size_t WS_A1 = 192 * MiB;
constexpr size_t WS_Q = 258 * MiB;
constexpr size_t WS_KV = 290 * MiB;
constexpr size_t WS_XB = 299 * MiB;
constexpr size_t WS_GT = 332 * MiB;
constexpr size_t WS_H1 = 364 * MiB;
constexpr size_t WS_PART = 192 * MiB;
constexpr size_t WS_W = 56 * MiB;
constexpr size_t WS_Z = 428 * MiB;
constexpr size_t WS_END = 492 * MiB;
constexpr int CW_QROW = 2048;
constexpr int CW_BAR = 4096;

constexpr int RING_OFF = 0, RING_BYTES = 131072;
constexpr int LDSCTL_OFF = RING_BYTES, MISC_OFF = LDSCTL_OFF + 320;
constexpr int LDS_BYTES = 147456;

typedef unsigned short bf16;
typedef unsigned v4u __attribute__((ext_vector_type(4)));
typedef float f32x4 __attribute__((ext_vector_type(4)));
typedef short bf16x8 __attribute__((ext_vector_type(8)));
typedef GAS unsigned gu32;
#define RLX_AGENT __ATOMIC_RELAXED, __HIP_MEMORY_SCOPE_AGENT
#define LDS_WAIT() asm volatile("s_waitcnt lgkmcnt(0)" ::: "memory")
#define VM_WAIT() asm volatile("s_waitcnt vmcnt(0)" ::: "memory")
__device__ __forceinline__ unsigned f2bf(float f) { unsigned u = __builtin_bit_cast(unsigned, f); return (u + 0x7fffu + ((u >> 16) & 1u)) >> 16; }
__device__ __forceinline__ unsigned pk2(float lo, float hi) { return f2bf(lo) | (f2bf(hi) << 16); }
__device__ __forceinline__ float bf2f(unsigned short b) { return __builtin_bit_cast(float, (unsigned)b << 16); }


namespace p2 {
typedef float f32x16 __attribute__((ext_vector_type(16)));
typedef unsigned u32x2 __attribute__((ext_vector_type(2)));
constexpr float LOG2E = 1.4426950408889634f;
constexpr float NEGBIG = -1e30f;
__device__ __forceinline__ int crow(int r, int hi) { return (r & 3) + 8 * (r >> 2) + 4 * hi; }
__device__ __forceinline__ unsigned cvtpk(float lo, float hi) { unsigned r; asm volatile("v_cvt_pk_bf16_f32 %0, %1, %2" : "=v"(r) : "v"(lo), "v"(hi)); return r; }
__device__ __forceinline__ float ex2(float x) { return __builtin_amdgcn_exp2f(x); }
__device__ __forceinline__ float rcp(float x) { return __builtin_amdgcn_rcpf(x); }
__device__ __forceinline__ float gelu_fast(float x) { return x * rcp(1.0f + ex2(x * (-2.302208198f - 0.102943240f * (x * x)))); }

constexpr int A_KS = 0, A_KSP = 144, A_VT = 288 * 144, A_VTP = 584, A_ST = A_VT + 64 * 584, A_END = A_ST + 8 * 4096;
__device__ __forceinline__ void attn_unit(LAS unsigned char* lds, int b, int qblk, int kvh, const bf16* QB, const bf16* KVB, const float* sinks, bf16* MIX, float* SSA, int tid) {
    const int lane = tid & 63, wave = __builtin_amdgcn_readfirstlane(tid >> 6), r = lane & 31, hi = lane >> 5;
    const int q0 = qblk * 128, hq = kvh * 8 + wave;
    for (int it = 0; it < 5; ++it) {
        const int cid = it * 512 + tid;
        if (cid < 288 * 8) {
            const int key = cid >> 3, ch = cid & 7;
            bool valid; size_t row = 0;
            if (key < 256) { const int pos = q0 - 128 + key; valid = pos >= 0; row = (size_t)b * SEQ + pos; }
            else if (key < 272) { valid = true; row = (size_t)MREAL + (key - 256); }
            else valid = false;
            v4u kv = {0u, 0u, 0u, 0u}, vv = {0u, 0u, 0u, 0u};
            if (valid) { kv = *(const GAS v4u*)(KVB + row * 256 + kvh * 64 + ch * 8); vv = *(const GAS v4u*)(KVB + row * 256 + 128 + kvh * 64 + ch * 8); }
            *(LAS v4u*)(lds + A_KS + key * A_KSP + ch * 16) = kv;
            LAS unsigned short* vt = (LAS unsigned short*)(lds + A_VT);
#pragma unroll
            for (int j = 0; j < 8; ++j) { const unsigned wv = vv[j >> 1]; vt[(ch * 8 + j) * (A_VTP / 2) + key] = (unsigned short)((j & 1) ? (wv >> 16) : (wv & 0xffffu)); }
        }
    }
    __syncthreads();
    const float sink2 = sinks[hq] * LOG2E;
    bf16x8 qf[4];
#pragma unroll
    for (int ks = 0; ks < 4; ++ks) qf[ks] = *(const GAS bf16x8*)(QB + ((size_t)b * SEQ + q0 + r) * 1024 + hq * 64 + ks * 16 + hi * 8);
    for (int qg = 0; qg < 4; ++qg) {
        f32x16 s[6];
#pragma unroll
        for (int t = 0; t < 6; ++t) {
            const int kbase = t < 5 ? 32 * (qg + t) : 256;
            f32x16 acc = {0.f, 0.f, 0.f, 0.f, 0.f, 0.f, 0.f, 0.f, 0.f, 0.f, 0.f, 0.f, 0.f, 0.f, 0.f, 0.f};
#pragma unroll
            for (int ks = 0; ks < 4; ++ks) {
                const bf16x8 kf = *(const LAS bf16x8*)(lds + A_KS + (kbase + r) * A_KSP + ks * 32 + hi * 16);
                acc = __builtin_amdgcn_mfma_f32_32x32x16_bf16(kf, qf[ks], acc, 0, 0, 0);
            }
            s[t] = acc;
        }
        if (qg + 1 < 4) {
#pragma unroll
            for (int ks = 0; ks < 4; ++ks) qf[ks] = *(const GAS bf16x8*)(QB + ((size_t)b * SEQ + q0 + 32 * (qg + 1) + r) * 1024 + hq * 64 + ks * 16 + hi * 8);
        }
        const bool blk0 = (qblk == 0);
#pragma unroll
        for (int reg = 0; reg < 16; ++reg) {
            const int j = crow(reg, hi);
            s[0][reg] = (j > r) ? s[0][reg] : NEGBIG;
            s[4][reg] = (j <= r) ? s[4][reg] : NEGBIG;
            if (reg >= 8) s[5][reg] = NEGBIG;
        }
#pragma unroll
        for (int t = 0; t < 4; ++t) if (blk0 && (qg + t < 4)) {
#pragma unroll
            for (int reg = 0; reg < 16; ++reg) s[t][reg] = NEGBIG;
        }
        float m = sink2;
#pragma unroll
        for (int t = 0; t < 6; ++t)
#pragma unroll
            for (int reg = 0; reg < (t == 5 ? 8 : 16); ++reg) m = fmaxf(m, s[t][reg]);
        m = max_x32(m);
        float l = 0.f;
#pragma unroll
        for (int t = 0; t < 6; ++t)
#pragma unroll
            for (int reg = 0; reg < (t == 5 ? 8 : 16); ++reg) { const float p = ex2(s[t][reg] - m); s[t][reg] = p; l += p; }
        l = sum_x32(l);
        l += ex2(sink2 - m);
        const float linv = 1.0f / l;
        f32x16 o0 = {0.f, 0.f, 0.f, 0.f, 0.f, 0.f, 0.f, 0.f, 0.f, 0.f, 0.f, 0.f, 0.f, 0.f, 0.f, 0.f}, o1 = o0;
#pragma unroll
        for (int t = 0; t < 6; ++t) {
            const int kbase = t < 5 ? 32 * (qg + t) : 256;
#pragma unroll
            for (int ss = 0; ss < (t == 5 ? 1 : 2); ++ss) {
                v4u pw; pw.x = cvtpk(s[t][8 * ss + 0], s[t][8 * ss + 1]); pw.y = cvtpk(s[t][8 * ss + 2], s[t][8 * ss + 3]);
                pw.z = cvtpk(s[t][8 * ss + 4], s[t][8 * ss + 5]); pw.w = cvtpk(s[t][8 * ss + 6], s[t][8 * ss + 7]);
                const bf16x8 pa = __builtin_bit_cast(bf16x8, pw);
                const int ko = (kbase + 16 * ss + 4 * hi) * 2;
                {   const u32x2 lo = *(const LAS u32x2*)(lds + A_VT + r * A_VTP + ko), h2 = *(const LAS u32x2*)(lds + A_VT + r * A_VTP + ko + 16);
                    v4u vw; vw.x = lo.x; vw.y = lo.y; vw.z = h2.x; vw.w = h2.y;
                    o0 = __builtin_amdgcn_mfma_f32_32x32x16_bf16(pa, __builtin_bit_cast(bf16x8, vw), o0, 0, 0, 0); }
                {   const u32x2 lo = *(const LAS u32x2*)(lds + A_VT + (32 + r) * A_VTP + ko), h2 = *(const LAS u32x2*)(lds + A_VT + (32 + r) * A_VTP + ko + 16);
                    v4u vw; vw.x = lo.x; vw.y = lo.y; vw.z = h2.x; vw.w = h2.y;
                    o1 = __builtin_amdgcn_mfma_f32_32x32x16_bf16(pa, __builtin_bit_cast(bf16x8, vw), o1, 0, 0, 0); }
            }
        }
        LAS unsigned short* stg = (LAS unsigned short*)(lds + A_ST + wave * 4096);
#pragma unroll
        for (int reg = 0; reg < 16; ++reg) {
            const int qr = crow(reg, hi); const float li = __shfl(linv, qr);
            stg[qr * 64 + r] = (unsigned short)f2bf(o0[reg] * li);
            stg[qr * 64 + 32 + r] = (unsigned short)f2bf(o1[reg] * li);
        }
        asm volatile("s_waitcnt lgkmcnt(0)" ::: "memory");
#pragma unroll
        for (int i = 0; i < 4; ++i) {
            const int row = i * 8 + (lane >> 3), ch = lane & 7;
            const v4u v = *(const LAS v4u*)(stg + row * 64 + ch * 8);
            float ss = 0.f;
#pragma unroll
            for (int k = 0; k < 4; ++k) { const float a = __builtin_bit_cast(float, v[k] << 16), c = __builtin_bit_cast(float, v[k] & 0xffff0000u); ss += a * a + c * c; }
            ss = sum8(ss);
            const size_t orow = (size_t)b * SEQ + q0 + 32 * qg + row;
            *(GAS v4u*)(MIX + orow * D + hq * 64 + ch * 8) = v;
            if (ch == 0) SSA[orow * 16 + hq] = ss;
        }
        asm volatile("s_waitcnt lgkmcnt(0)" ::: "memory");
    }
    __syncthreads();
}

constexpr int LW_XS = 0, LW_GS = 4608, LW_XC = LW_GS + 2048, LW_XCF = LW_XC + 4608, LW_BYTES = LW_XCF + 4096 + 128;
constexpr int L_CT = 8 * LW_BYTES, L_END = L_CT + 2 * 2048;
static_assert(L_END <= 131072, "lru lds");
struct LruP { const float *conv_w, *conv_b, *w_r, *b_r, *w_i, *b_i, *lam; };
__device__ __forceinline__ void lru_unit(LAS unsigned char* lds, LAS unsigned char* ldsw  , int b, int nb, int cg, const bf16* XBB, const bf16* GTB, const LruP P, bf16* MIX, float* SSL, int tid) {
    const int lane = tid & 63, wave = __builtin_amdgcn_readfirstlane(tid >> 6), r = lane & 31, hi = lane >> 5;
    LAS unsigned char* lw = lds + wave * LW_BYTES;
    {
        LAS unsigned short* wt = (LAS unsigned short*)ldsw;
#pragma unroll
        for (int i = 0; i < 4; ++i) {
            const int e = tid + 512 * i, c = e >> 5, dl = e & 31;
            const size_t gi = (size_t)(nb * 64 + c) * 64 + 32 * cg + dl;
            wt[dl * 72 + c] = (unsigned short)f2bf(-LOG2E * P.w_r[gi]);
            wt[32 * 72 + dl * 72 + c] = (unsigned short)f2bf(-LOG2E * P.w_i[gi]);
        }
    }
    const int cc = lane, chc = nb * 64 + cc;
    const float cw0 = P.conv_w[0 * LW + chc], cw1 = P.conv_w[1 * LW + chc], cw2 = P.conv_w[2 * LW + chc], cw3 = P.conv_w[3 * LW + chc], cbv = P.conv_b[chc];
    const int chd = nb * 64 + 32 * cg + r;
    const float br = -LOG2E * P.b_r[chd], bi = -LOG2E * P.b_i[chd];
    const float ls8 = -8.0f * log1pf(expf(-P.lam[chd])) * LOG2E;
    float state = 0.f;
    v4u px[5], pg[2];
#define LRU_PREFETCH(tl) do { \
        _Pragma("unroll") for (int it = 0; it < 5; ++it) { const int cid = it * 64 + lane; px[it] = (v4u){0u, 0u, 0u, 0u}; \
            if (cid < 35 * 8) { const int j = cid >> 3, ch = cid & 7, t = 32 * wave + j - 3; bool valid; size_t row = 0; \
                if ((tl) == 0) { valid = (t >= 0 && t < NMETA); row = (size_t)MREAL + t; } \
                else if ((tl) == 1 && t < 0) { valid = true; row = (size_t)MREAL + NMETA + t; } \
                else { valid = true; row = (size_t)b * SEQ + 256 * ((tl) - 1) + t; } \
                if (valid) px[it] = *(const GAS v4u*)(XBB + row * 1024 + nb * 64 + ch * 8); } } \
        if ((tl) > 0) { _Pragma("unroll") for (int it = 0; it < 2; ++it) { const int cid = it * 64 + lane, t = 32 * wave + (cid >> 2), ch = cid & 3; \
            pg[it] = *(const GAS v4u*)(GTB + ((size_t)b * SEQ + 256 * ((tl) - 1) + t) * 1024 + nb * 64 + 32 * cg + ch * 8); } } } while (0)
    LRU_PREFETCH(0);
    __syncthreads();
    for (int tile = 0; tile < 9; ++tile) {
#pragma unroll
        for (int it = 0; it < 5; ++it) { const int cid = it * 64 + lane; if (cid < 35 * 8) *(LAS v4u*)(lw + LW_XS + (cid >> 3) * 128 + (cid & 7) * 16) = px[it]; }
        if (tile > 0) {
#pragma unroll
            for (int it = 0; it < 2; ++it) { const int cid = it * 64 + lane; *(LAS v4u*)(lw + LW_GS + (cid >> 2) * 64 + (cid & 3) * 16) = pg[it]; }
        }
        asm volatile("s_waitcnt lgkmcnt(0)" ::: "memory");
        if (tile + 1 < 9) LRU_PREFETCH(tile + 1);
        {
            const LAS unsigned short* xs = (const LAS unsigned short*)(lw + LW_XS);
            LAS unsigned short* xc = (LAS unsigned short*)(lw + LW_XC);
            LAS float* xcf = (LAS float*)(lw + LW_XCF);
            const bool own = (cc >> 5) == cg; const int xoff = own ? (cc & 31) : 32 * 32 + (cc & 31);
            float x0 = bf2f(xs[0 * 64 + cc]), x1 = bf2f(xs[1 * 64 + cc]), x2 = bf2f(xs[2 * 64 + cc]);
#pragma unroll 8
            for (int k = 0; k < 32; ++k) {
                const float x3 = bf2f(xs[(k + 3) * 64 + cc]);
                const float v = cbv + cw0 * x0 + cw1 * x1 + cw2 * x2 + cw3 * x3;
                xc[k * 72 + cc] = (unsigned short)cvtpk(v, v);
                xcf[(own ? k * 32 : 0) + xoff] = v;
                x0 = x1; x1 = x2; x2 = x3;
            }
        }
        asm volatile("s_waitcnt lgkmcnt(0)" ::: "memory");
        f32x16 aR = {br, br, br, br, br, br, br, br, br, br, br, br, br, br, br, br}, aI = {bi, bi, bi, bi, bi, bi, bi, bi, bi, bi, bi, bi, bi, bi, bi, bi};
#pragma unroll
        for (int ks = 0; ks < 4; ++ks) {
            const bf16x8 xa = *(const LAS bf16x8*)(lw + LW_XC + r * 144 + ks * 32 + hi * 16);
            const bf16x8 wr_ = *(const LAS bf16x8*)(ldsw + r * 144 + ks * 32 + hi * 16);
            const bf16x8 wi_ = *(const LAS bf16x8*)(ldsw + 32 * 144 + r * 144 + ks * 32 + hi * 16);
            aR = __builtin_amdgcn_mfma_f32_32x32x16_bf16(xa, wr_, aR, 0, 0, 0);
            aI = __builtin_amdgcn_mfma_f32_32x32x16_bf16(xa, wi_, aI, 0, 0, 0);
        }
        float Av[16], Bv[16];
        {
            const LAS float* xcf = (const LAS float*)(lw + LW_XCF);
#pragma unroll
            for (int reg = 0; reg < 16; ++reg) {
                const int tl = crow(reg, hi), t = 32 * wave + tl;
                const bool valid = (tile > 0) || (t < NMETA);
                const float rg = rcp(1.0f + ex2(aR[reg]));
                const float ig = rcp(1.0f + ex2(aI[reg]));
                const float a = ex2(rg * ls8);
                const float mult = __builtin_amdgcn_sqrtf(fmaxf(1.0f - a * a, 0.f));
                const float bx = mult * ig * xcf[tl * 32 + r];
                Av[reg] = valid ? a : 1.0f; Bv[reg] = valid ? bx : 0.0f;
            }
        }
#pragma unroll
        for (int g = 0; g < 4; ++g) {
#pragma unroll
            for (int k = 1; k < 4; ++k) { Bv[4 * g + k] = Av[4 * g + k] * Bv[4 * g + k - 1] + Bv[4 * g + k]; Av[4 * g + k] = Av[4 * g + k] * Av[4 * g + k - 1]; }
        }
        float myCz[4], myCp[4], PW, HW;
        {
            float cz = 0.f, cp = 1.f;
#pragma unroll
            for (int g = 0; g < 4; ++g) {
                const float mP = Av[4 * g + 3], mH = Bv[4 * g + 3];
                const float oP = __shfl_xor(mP, 32), oH = __shfl_xor(mH, 32);
                const float eP = hi ? oP : mP, eH = hi ? oH : mH, dP = hi ? mP : oP, dH = hi ? mH : oH;
                const float cz0 = cz, cp0 = cp;
                cz = eP * cz + eH; cp = cp * eP;
                myCz[g] = hi ? cz : cz0; myCp[g] = hi ? cp : cp0;
                cz = dP * cz + dH; cp = cp * dP;
            }
            PW = cp; HW = cz;
        }
        LAS float* ct = (LAS float*)(lds + L_CT + (tile & 1) * 2048);
        if (hi == 0) { ct[(wave * 32 + r) * 2] = PW; ct[(wave * 32 + r) * 2 + 1] = HW; }
        __syncthreads();
        float cin = 0.f;
        {
            float c = state;
#pragma unroll
            for (int w2 = 0; w2 < 8; ++w2) { if (w2 == wave) cin = c; c = ct[(w2 * 32 + r) * 2] * c + ct[(w2 * 32 + r) * 2 + 1]; }
            state = c;
        }
        if (tile > 0) {
            const LAS unsigned short* gs = (const LAS unsigned short*)(lw + LW_GS);
            LAS unsigned short* os = (LAS unsigned short*)(lw + LW_XS);
#pragma unroll
            for (int reg = 0; reg < 16; ++reg) {
                const int g = reg >> 2, tl = crow(reg, hi);
                const float h = Bv[reg] + Av[reg] * (myCz[g] + myCp[g] * cin);
                const float gt = bf2f(gs[tl * 32 + r]);
                { const float ov = gelu_fast(gt) * h; os[tl * 32 + r] = (unsigned short)cvtpk(ov, ov); }
            }
            asm volatile("s_waitcnt lgkmcnt(0)" ::: "memory");
#pragma unroll
            for (int it = 0; it < 2; ++it) {
                const int cid = it * 64 + lane, tl = cid >> 2, ch = cid & 3;
                const v4u v = *(const LAS v4u*)(lw + LW_XS + tl * 64 + ch * 16);
                float ss = 0.f;
#pragma unroll
                for (int k = 0; k < 4; ++k) { const float a = __builtin_bit_cast(float, v[k] << 16), c = __builtin_bit_cast(float, v[k] & 0xffff0000u); ss += a * a + c * c; }
                ss = sum4(ss);
                const size_t row = (size_t)b * SEQ + 256 * (tile - 1) + 32 * wave + tl;
                *(GAS v4u*)(MIX + row * D + 1024 + nb * 64 + 32 * cg + ch * 8) = v;
                if (ch == 0) SSL[row * 32 + nb * 2 + cg] = ss;
            }
            asm volatile("s_waitcnt lgkmcnt(0)" ::: "memory");
        }
    }
#undef LRU_PREFETCH
    __syncthreads();
}
}

namespace p5 {
typedef float f32x16 __attribute__((ext_vector_type(16)));
constexpr int KP = 272;
constexpr int R_KEYS = 0, R_IDX = 256 * KP, R_END = R_IDX + 8 * 1024;
__device__ __forceinline__ int crow(int r, int hi) { return (r & 3) + 8 * (r >> 2) + 4 * hi; }
__device__ __forceinline__ float fkey(float s, int mask, int payload) { return __builtin_bit_cast(float, (__builtin_bit_cast(int, s) & mask) | payload); }
__device__ __forceinline__ int fbits(float f) { return __builtin_bit_cast(int, f); }
__device__ __forceinline__ float fval(float f, int mask) { return __builtin_bit_cast(float, __builtin_bit_cast(int, f) & mask); }
__device__ __forceinline__ void ins16(float (&L)[16], float v) {
#pragma unroll
    for (int k = 15; k >= 1; --k) L[k] = __builtin_amdgcn_fmed3f(L[k - 1], L[k], v);
    L[0] = fmaxf(L[0], v);
}
#define P5_CE(a, b) do { const float hi_ = fmaxf(a, b), lo_ = fminf(a, b); a = hi_; b = lo_; } while (0)
#define P5_SORT16(X) do { P5_CE(X[0], X[1]); P5_CE(X[2], X[3]); P5_CE(X[0], X[2]); P5_CE(X[1], X[3]); P5_CE(X[1], X[2]); P5_CE(X[4], X[5]); P5_CE(X[6], X[7]); P5_CE(X[4], X[6]); P5_CE(X[5], X[7]); P5_CE(X[5], X[6]); P5_CE(X[0], X[4]); P5_CE(X[2], X[6]); P5_CE(X[2], X[4]); P5_CE(X[1], X[5]); P5_CE(X[3], X[7]); P5_CE(X[3], X[5]); P5_CE(X[1], X[2]); P5_CE(X[3], X[4]); P5_CE(X[5], X[6]); P5_CE(X[8], X[9]); P5_CE(X[10], X[11]); P5_CE(X[8], X[10]); P5_CE(X[9], X[11]); P5_CE(X[9], X[10]); P5_CE(X[12], X[13]); P5_CE(X[14], X[15]); P5_CE(X[12], X[14]); P5_CE(X[13], X[15]); P5_CE(X[13], X[14]); P5_CE(X[8], X[12]); P5_CE(X[10], X[14]); P5_CE(X[10], X[12]); P5_CE(X[9], X[13]); P5_CE(X[11], X[15]); P5_CE(X[11], X[13]); P5_CE(X[9], X[10]); P5_CE(X[11], X[12]); P5_CE(X[13], X[14]); P5_CE(X[0], X[8]); P5_CE(X[4], X[12]); P5_CE(X[4], X[8]); P5_CE(X[2], X[10]); P5_CE(X[6], X[14]); P5_CE(X[6], X[10]); P5_CE(X[2], X[4]); P5_CE(X[6], X[8]); P5_CE(X[10], X[12]); P5_CE(X[1], X[9]); P5_CE(X[5], X[13]); P5_CE(X[5], X[9]); P5_CE(X[3], X[11]); P5_CE(X[7], X[15]); P5_CE(X[7], X[11]); P5_CE(X[3], X[5]); P5_CE(X[7], X[9]); P5_CE(X[11], X[13]); P5_CE(X[1], X[2]); P5_CE(X[3], X[4]); P5_CE(X[5], X[6]); P5_CE(X[7], X[8]); P5_CE(X[9], X[10]); P5_CE(X[11], X[12]); P5_CE(X[13], X[14]); } while (0)
#define P5_BMERGE16(X) do { P5_CE(X[0], X[8]); P5_CE(X[1], X[9]); P5_CE(X[2], X[10]); P5_CE(X[3], X[11]); P5_CE(X[4], X[12]); P5_CE(X[5], X[13]); P5_CE(X[6], X[14]); P5_CE(X[7], X[15]); P5_CE(X[0], X[4]); P5_CE(X[1], X[5]); P5_CE(X[2], X[6]); P5_CE(X[3], X[7]); P5_CE(X[8], X[12]); P5_CE(X[9], X[13]); P5_CE(X[10], X[14]); P5_CE(X[11], X[15]); P5_CE(X[0], X[2]); P5_CE(X[1], X[3]); P5_CE(X[4], X[6]); P5_CE(X[5], X[7]); P5_CE(X[8], X[10]); P5_CE(X[9], X[11]); P5_CE(X[12], X[14]); P5_CE(X[13], X[15]); P5_CE(X[0], X[1]); P5_CE(X[2], X[3]); P5_CE(X[4], X[5]); P5_CE(X[6], X[7]); P5_CE(X[8], X[9]); P5_CE(X[10], X[11]); P5_CE(X[12], X[13]); P5_CE(X[14], X[15]); } while (0)
#define P5_TOP16(A, B) do { _Pragma("unroll") for (int i_ = 0; i_ < 16; ++i_) A[i_] = fmaxf(A[i_], B[15 - i_]); P5_BMERGE16(A); } while (0)
#define P5_KEYS(G, ACC, KT) do { _Pragma("unroll") for (int reg = 0; reg < 16; ++reg) G[reg] = fkey(ACC[reg], (int)0xffffff80, (127 - 32 * (KT) - (reg & 3) - 8 * (reg >> 2)) - h4); } while (0)
__device__ __forceinline__ void score_tile(f32x16& acc, const LAS unsigned char* keys, const bf16x8 (&qf)[8], int kt, int r, int hi) {
    acc = (f32x16){0.f, 0.f, 0.f, 0.f, 0.f, 0.f, 0.f, 0.f, 0.f, 0.f, 0.f, 0.f, 0.f, 0.f, 0.f, 0.f};
#pragma unroll
    for (int ks = 0; ks < 8; ++ks) {
        const bf16x8 kf = *(const LAS bf16x8*)(keys + (kt * 32 + r) * KP + ks * 32 + hi * 16);
        acc = __builtin_amdgcn_mfma_f32_32x32x16_bf16(kf, qf[ks], acc, 0, 0, 0);
    }
}
__device__ __forceinline__ void half_top16(const LAS unsigned char* keys, const bf16x8 (&qf)[8], int r, int hi, float (&T)[16]) {
    const int h4 = 4 * hi;
    f32x16 acc;
    float A[16], B[16];
    score_tile(acc, keys, qf, 0, r, hi); P5_KEYS(A, acc, 0); P5_SORT16(A);
    score_tile(acc, keys, qf, 1, r, hi); P5_KEYS(B, acc, 1); P5_SORT16(B);
    P5_TOP16(A, B);
    float C[16];
    score_tile(acc, keys, qf, 2, r, hi); P5_KEYS(C, acc, 2); P5_SORT16(C);
    score_tile(acc, keys, qf, 3, r, hi); P5_KEYS(B, acc, 3); P5_SORT16(B);
    P5_TOP16(C, B);
    P5_TOP16(A, C);
#pragma unroll
    for (int i = 0; i < 16; ++i) B[i] = __shfl_xor(A[15 - i], 32);
#pragma unroll
    for (int i = 0; i < 16; ++i) A[i] = fmaxf(A[i], B[i]);
    P5_BMERGE16(A);
#pragma unroll
    for (int i = 0; i < 16; ++i) T[i] = A[i];
}

__device__ __forceinline__ void retr_unit(LAS unsigned char* lds, int h, int tg, const bf16* QPB, const bf16* SKB, unsigned short* IDS, float* GW, const float* RSTD2, int tid) {
    const int lane = tid & 63, wave = __builtin_amdgcn_readfirstlane(tid >> 6), r = lane & 31, hi = lane >> 5;
#pragma unroll
    for (int it = 0; it < 8; ++it) {
        const int cid = it * 512 + tid, row = cid >> 4, ch = cid & 15;
        *(LAS v4u*)(lds + R_KEYS + row * KP + ch * 16) = *(const GAS v4u*)(SKB + ((size_t)h * 256 + row) * 128 + ch * 8);
    }
    const size_t tok = (size_t)tg * 256 + wave * 32 + r;
    bf16x8 qa[8], qb[8];
#pragma unroll
    for (int ks = 0; ks < 8; ++ks) { qa[ks] = *(const GAS bf16x8*)(QPB + tok * D + h * 256 + ks * 16 + hi * 8); qb[ks] = *(const GAS bf16x8*)(QPB + tok * D + h * 256 + 128 + ks * 16 + hi * 8); }
    const float rs = RSTD2[tok];
    __syncthreads();
    float TA[16], TB[16];
    half_top16(lds + R_KEYS, qa, r, hi, TA);
    half_top16(lds + R_KEYS + 128 * KP, qb, r, hi, TB);
    LAS unsigned char* sc = lds + R_IDX + wave * 1024 + r * 32;
    const int hm = -hi;
    {
        v4u w;
#pragma unroll
        for (int q = 0; q < 4; ++q) { unsigned x = 0;
#pragma unroll
            for (int k = 0; k < 4; ++k) { const int t = (fbits(TB[4 * q + k]) & hm) | (fbits(TA[4 * q + k]) & ~hm); x |= (unsigned)(127 - (t & 0x7f)) << (8 * k); }
            w[q] = x; }
        *(LAS v4u*)(sc + hi * 16) = w;
    }
    float sA[16], sB[16];
#pragma unroll
    for (int i = 0; i < 16; ++i) { sA[i] = fval(TA[i], (int)0xffffff80); sB[i] = fval(TB[i], (int)0xffffff80); }
#define P5_K(i, j) fkey(sA[i] + sB[j], (int)0xffffff00, 255 - ((i) * 16 + (j)))
    float L[16], X[16];
#pragma unroll
    for (int j = 0; j < 16; ++j) L[j] = P5_K(0, j);
#pragma unroll
    for (int j = 0; j < 8; ++j) { X[j] = P5_K(1, j); X[8 + j] = P5_K(15 - j, 0); }
    P5_BMERGE16(X);
    P5_TOP16(L, X);
    X[0] = P5_K(2, 0); X[1] = P5_K(2, 1); X[2] = P5_K(2, 2); X[3] = P5_K(2, 3); X[4] = P5_K(2, 4);
    X[5] = P5_K(3, 0); X[6] = P5_K(3, 1); X[7] = P5_K(3, 2); X[8] = P5_K(3, 3);
    X[9] = P5_K(4, 0); X[10] = P5_K(4, 1); X[11] = P5_K(4, 2);
    X[12] = P5_K(5, 0); X[13] = P5_K(5, 1); X[14] = P5_K(6, 0); X[15] = P5_K(6, 1);
    P5_SORT16(X);
    P5_TOP16(L, X);
    ins16(L, P5_K(7, 0)); ins16(L, P5_K(7, 1));
#undef P5_K
    const float v0 = fval(L[0], (int)0xffffff00);
    asm volatile("s_waitcnt lgkmcnt(0)" ::: "memory");
    int ex[8]; float ew[8]; float esum = 0.f;
#pragma unroll
    for (int k = 0; k < 8; ++k) {
        const int t = (fbits(L[8 + k]) & hm) | (fbits(L[k]) & ~hm);
        const int c = 255 - (t & 0xff);
        const int ia = sc[c >> 4], ib = sc[16 + (c & 15)];
        ex[k] = ia * 128 + ib;
        const float e = __builtin_amdgcn_exp2f((__builtin_bit_cast(float, t & (int)0xffffff00) - v0) * rs * 1.4426950408889634f);
        ew[k] = e; esum += e;
    }
    esum = sum_x32(esum);
    const float inv = 1.0f / esum;
    unsigned short* ip = IDS + tok * 128 + h * 16 + hi * 8; float* gp = GW + tok * 128 + h * 16 + hi * 8;
    *(GAS v4u*)(ip) = (v4u){(unsigned)ex[0] | ((unsigned)ex[1] << 16), (unsigned)ex[2] | ((unsigned)ex[3] << 16), (unsigned)ex[4] | ((unsigned)ex[5] << 16), (unsigned)ex[6] | ((unsigned)ex[7] << 16)};
    *(GAS f32x4*)(gp) = (f32x4){ew[0] * inv, ew[1] * inv, ew[2] * inv, ew[3] * inv};
    *(GAS f32x4*)(gp + 4) = (f32x4){ew[4] * inv, ew[5] * inv, ew[6] * inv, ew[7] * inv};
    __syncthreads();
}
}

namespace p6 {
__device__ __forceinline__ float blo(unsigned w) { return __builtin_bit_cast(float, w << 16); }
__device__ __forceinline__ float bhi(unsigned w) { return __builtin_bit_cast(float, w & 0xffff0000u); }
__device__ __forceinline__ float gelu_fast(float x) { return x * __builtin_amdgcn_rcpf(1.0f + __builtin_amdgcn_exp2f(-2.302208198f * x * (1.0f + 0.044715f * x * x))); }
__device__ __forceinline__ unsigned idw(const v4u& a, const v4u& b, int g) { const unsigned w = g < 8 ? a[(g & 7) >> 1] : b[(g & 7) >> 1]; return (g & 1) ? (w >> 16) : (w & 0xffffu); }
__device__ __forceinline__ unsigned q4(float a, float b, float c, float d, float inv, int bias) {
    const int qa = (int)rintf(a * inv) + bias, qb = (int)rintf(b * inv) + bias, qc = (int)rintf(c * inv) + bias, qd = (int)rintf(d * inv) + bias;
    return (unsigned)(qa & 0xff) | ((unsigned)(qb & 0xff) << 8) | ((unsigned)(qc & 0xff) << 16) | ((unsigned)(qd & 0xff) << 24);
}
__device__ __forceinline__ void qrow_load(f32x4 (&v)[8], const float* src, size_t e, int lane) {
#pragma unroll
    for (int j = 0; j < 8; ++j) v[j] = __builtin_nontemporal_load((const GAS f32x4*)(src + e * D + j * 256 + lane * 4));
}
__device__ __forceinline__ void qrow_finish(f32x4 (&v)[8], const float* gcol, unsigned char* dst, float* scale_out, size_t e, int lane) {
    float am = 0.f;
#pragma unroll
    for (int j = 0; j < 8; ++j) {
        if (gcol) { const f32x4 g = *(const GAS f32x4*)(gcol + j * 256 + lane * 4); v[j] = v[j] * g; }
        am = fmaxf(am, fmaxf(fmaxf(fabsf(v[j].x), fabsf(v[j].y)), fmaxf(fabsf(v[j].z), fabsf(v[j].w))));
    }
    am = max64(am);
    const float inv = am > 0.f ? 127.0f / am : 0.f;
#pragma unroll
    for (int j = 0; j < 8; ++j)
        *(GAS unsigned*)(dst + ((size_t)(2 * j + (lane >> 5)) * 16384 + e) * 128 + (lane & 31) * 4) = q4(v[j].x, v[j].y, v[j].z, v[j].w, inv, 0);
    if (lane == 0) scale_out[e] = am * (1.0f / 127.0f);
}
__device__ __forceinline__ void qx_load(v4u (&x)[4], const bf16* H1B, size_t tok, int lane) {
#pragma unroll
    for (int j = 0; j < 4; ++j) x[j] = *(const GAS v4u*)(H1B + tok * D + j * 512 + lane * 8);
}
__device__ __forceinline__ void qx_finish(const v4u (&x)[4], unsigned char* X8, float* SX, size_t tok, int lane) {
#pragma unroll
    for (int j = 0; j < 4; ++j) {
        float f[8]; float am = 0.f;
#pragma unroll
        for (int k = 0; k < 4; ++k) { f[2 * k] = blo(x[j][k]); f[2 * k + 1] = bhi(x[j][k]); am = fmaxf(am, fmaxf(fabsf(f[2 * k]), fabsf(f[2 * k + 1]))); }
        am = max16(am);
        const float inv = am > 0.f ? 127.0f / am : 0.f;
        typedef unsigned u32x2v __attribute__((ext_vector_type(2)));
        u32x2v o; o.x = q4(f[0], f[1], f[2], f[3], inv, 0); o.y = q4(f[4], f[5], f[6], f[7], inv, 0);
        *(GAS u32x2v*)(X8 + tok * D + j * 512 + lane * 8) = o;
        if ((lane & 15) == 0) SX[tok * 16 + 4 * j + (lane >> 4)] = am * (1.0f / 127.0f);
    }
}

typedef int i32x16 __attribute__((ext_vector_type(16)));
typedef float f32x16v __attribute__((ext_vector_type(16)));
__device__ __forceinline__ int seli(int m, int a, int b) { return (a & m) | (b & ~m); }
__device__ __forceinline__ float self(int m, float a, float b) { return __builtin_bit_cast(float, seli(m, __builtin_bit_cast(int, a), __builtin_bit_cast(int, b))); }
__device__ __forceinline__ void usweep(const unsigned char* X8, const float* SX, const unsigned char* U8, const unsigned short* IDS, bf16* PART, LAS unsigned char* lds, int slot, int rank, int nrank, int wave, int lane) {
    const int ps = lane >> 3, ch = lane & 7;
    const int first = rank * 8 + wave, stride = nrank * 8;
    const int n = first < MREAL ? (MREAL - first + stride - 1) / stride : 0, NQ = 2 * n;
    if (NQ == 0) return;
    const int m4 = -((lane >> 2) & 1), m2 = -((lane >> 1) & 1), m1 = -(lane & 1);
    LAS unsigned char* sl = lds + wave * 1024;
#define U_LOAD(q_, RI, RX, SX_, T_, SG_) do { const int qq_ = (q_) < NQ ? (q_) : NQ - 1; const int rd_ = qq_ >= n ? 1 : 0; T_ = first + (qq_ - rd_ * n) * stride; SG_ = rd_ * 8 + slot; \
        RI = *(const GAS unsigned*)(IDS + (size_t)T_ * 128 + lane * 2); RX = *(const GAS unsigned*)(X8 + (size_t)T_ * D + SG_ * 128 + (lane & 31) * 4); SX_ = SX[(size_t)T_ * 16 + SG_]; } while (0)
#define U_EXPAND(SLOT, RI, RX, I0, I1, XV) do { LAS unsigned char* s_ = sl + (SLOT) * 512; \
        *(LAS unsigned*)(s_ + lane * 4) = RI; if (lane < 32) *(LAS unsigned*)(s_ + 256 + lane * 4) = RX; \
        asm volatile("s_waitcnt lgkmcnt(0)" ::: "memory"); \
        I0 = *(const LAS v4u*)(s_ + ps * 32); I1 = *(const LAS v4u*)(s_ + ps * 32 + 16); XV = *(const LAS v4u*)(s_ + 256 + ch * 16); } while (0)
#define U_ISSUE(BUF, I0, I1, SG_) do { const unsigned char* tab_ = U8 + (size_t)(SG_) * 16384 * 128 + ch * 16; \
        _Pragma("unroll") for (int g = 0; g < 16; ++g) BUF[g] = *(const GAS v4u*)(tab_ + (size_t)idw(I0, I1, g) * 128); } while (0)
#define U_FINISH(BUF, XV, SX_, T_, SG_) do { i32x16 d; \
        _Pragma("unroll") for (int g = 0; g < 16; ++g) { int a_ = __builtin_amdgcn_sdot4((int)BUF[g][0], (int)XV[0], 0, false); a_ = __builtin_amdgcn_sdot4((int)BUF[g][1], (int)XV[1], a_, false); \
            a_ = __builtin_amdgcn_sdot4((int)BUF[g][2], (int)XV[2], a_, false); a_ = __builtin_amdgcn_sdot4((int)BUF[g][3], (int)XV[3], a_, false); d[g] = a_; } \
        int r8[8], r4[4], r2[2]; \
        _Pragma("unroll") for (int k = 0; k < 8; ++k) r8[k] = seli(m4, d[8 + k], d[k]) + dpp_hm(seli(m4, d[k], d[8 + k])); \
        _Pragma("unroll") for (int k = 0; k < 4; ++k) r4[k] = seli(m2, r8[4 + k], r8[k]) + dpp_x2(seli(m2, r8[k], r8[4 + k])); \
        _Pragma("unroll") for (int k = 0; k < 2; ++k) r2[k] = seli(m1, r4[2 + k], r4[k]) + dpp_x1(seli(m1, r4[k], r4[2 + k])); \
        *(GAS unsigned*)(PART + ((size_t)(SG_) * MREAL + T_) * 128 + ps * 16 + 2 * ch) = pk2((float)r2[0] * SX_, (float)r2[1] * SX_); } while (0)
    v4u bufA[16], bufB[16];
    v4u a0, a1, ax, b0, b1, bx; unsigned ri, rx; float as, bs, cs; int at, bt, ct, ag, bg, cg;
    U_LOAD(0, ri, rx, as, at, ag); U_EXPAND(0, ri, rx, a0, a1, ax);
    U_LOAD(1, ri, rx, bs, bt, bg); U_EXPAND(1, ri, rx, b0, b1, bx);
    U_ISSUE(bufA, a0, a1, ag);
    for (int q = 0; q < NQ; q += 2) {
        U_ISSUE(bufB, b0, b1, bg);
        U_LOAD(q + 2, ri, rx, cs, ct, cg);
        U_FINISH(bufA, ax, as, at, ag);
        U_EXPAND(0, ri, rx, a0, a1, ax); as = cs; at = ct; ag = cg;
        U_ISSUE(bufA, a0, a1, ag);
        U_LOAD(q + 3, ri, rx, cs, ct, cg);
        U_FINISH(bufB, bx, bs, bt, bg);
        U_EXPAND(1, ri, rx, b0, b1, bx); bs = cs; bt = ct; bg = cg;
    }
#undef U_LOAD
#undef U_EXPAND
#undef U_ISSUE
#undef U_FINISH
}
__device__ __forceinline__ void wreduce(const bf16* PART, const float* GW, const float* RSTD2, const unsigned short* IDS, const float* SCU, const float* SCV, unsigned char* W8, float* WS8, size_t gt, size_t NT) {
    for (size_t i8 = gt; i8 < (size_t)MREAL * 128 / 8; i8 += NT) {
        float s[8];
#pragma unroll
        for (int k = 0; k < 8; ++k) s[k] = 0.f;
#pragma unroll 8
        for (int sg = 0; sg < 16; ++sg) {
            const v4u p = *(const GAS v4u*)(PART + (size_t)sg * MREAL * 128 + i8 * 8);
#pragma unroll
            for (int k = 0; k < 4; ++k) { s[2 * k] += blo(p[k]); s[2 * k + 1] += bhi(p[k]); }
        }
        const float rs = RSTD2[i8 >> 4];
        const v4u idv = *(const GAS v4u*)(IDS + i8 * 8);
        const f32x4 g0 = *(const GAS f32x4*)(GW + i8 * 8), g1 = *(const GAS f32x4*)(GW + i8 * 8 + 4);
        float w[8]; float am = 0.f;
#pragma unroll
        for (int k = 0; k < 8; ++k) {
            const unsigned e = (k & 1) ? (idv[k >> 1] >> 16) : (idv[k >> 1] & 0xffffu);
            const float g = k < 4 ? g0[k & 3] : g1[k & 3];
            w[k] = g * gelu_fast(rs * SCU[e] * s[k]) * SCV[e]; am = fmaxf(am, fabsf(w[k]));
        }
        am = max16(am);
        const float inv = am > 0.f ? 127.0f / am : 0.f;
        typedef unsigned u32x2v __attribute__((ext_vector_type(2)));
        u32x2v o; o.x = q4(w[0], w[1], w[2], w[3], inv, 0); o.y = q4(w[4], w[5], w[6], w[7], inv, 0);
        *(GAS u32x2v*)(W8 + i8 * 8) = o;
        if ((i8 & 15) == 0) WS8[i8 >> 4] = am * (1.0f / 127.0f);
    }
}
__device__ __forceinline__ void vsweep(const bf16* H1B, const unsigned char* V8, const unsigned short* IDS, const unsigned char* W8, const float* WS8, bf16* Z, LAS unsigned char* lds, int slot, int rank, int nrank, int wave, int lane) {
    const int ps = lane >> 3, ch = lane & 7;
    const int first = rank * 8 + wave, stride = nrank * 8;
    const int n = first < MREAL ? (MREAL - first + stride - 1) / stride : 0, NQ = 2 * n;
    if (NQ == 0) return;
    const int m8 = -((lane >> 3) & 1);
    LAS unsigned char* sl = lds + wave * 1024;
#define V_LOAD(q_, RI, RW, WSC, HX, T_, SG_) do { const int qq_ = (q_) < NQ ? (q_) : NQ - 1; const int rd_ = qq_ >= n ? 1 : 0; T_ = first + (qq_ - rd_ * n) * stride; SG_ = rd_ * 8 + slot; \
        RI = *(const GAS unsigned*)(IDS + (size_t)T_ * 128 + lane * 2); RW = *(const GAS unsigned*)(W8 + (size_t)T_ * 128 + (lane & 31) * 4); WSC = WS8[T_]; \
        HX = 0u; } while (0)
#define V_EXPAND(SLOT, RI, RW, I0, I1, WQ) do { LAS unsigned char* s_ = sl + (SLOT) * 512; \
        *(LAS unsigned*)(s_ + lane * 4) = RI; if (lane < 32) *(LAS unsigned*)(s_ + 256 + lane * 4) = RW; \
        asm volatile("s_waitcnt lgkmcnt(0)" ::: "memory"); \
        I0 = *(const LAS v4u*)(s_ + ps * 32); I1 = *(const LAS v4u*)(s_ + ps * 32 + 16); WQ = *(const LAS v4u*)(s_ + 256 + ps * 16); } while (0)
#define V_ISSUE(BUF, I0, I1, SG_) do { const unsigned char* tab_ = V8 + (size_t)(SG_) * 16384 * 128 + ch * 16; \
        _Pragma("unroll") for (int g = 0; g < 16; ++g) BUF[g] = *(const GAS v4u*)(tab_ + (size_t)idw(I0, I1, g) * 128); } while (0)
#define V_FINISH(BUF, WQ, WSC, HX, T_, SG_) do { i32x16 acc = {0, 0, 0, 0, 0, 0, 0, 0, 0, 0, 0, 0, 0, 0, 0, 0}; const unsigned hx_ = HX; \
        _Pragma("unroll") for (int j = 0; j < 4; ++j) { const int wq_ = (int)WQ[j]; \
            _Pragma("unroll") for (int k = 0; k < 4; ++k) { \
                const unsigned d0_ = BUF[4 * j][k], d1_ = BUF[4 * j + 1][k], d2_ = BUF[4 * j + 2][k], d3_ = BUF[4 * j + 3][k]; \
                const unsigned p0_ = __builtin_amdgcn_perm(d1_, d0_, 0x05010400u), p1_ = __builtin_amdgcn_perm(d1_, d0_, 0x07030602u); \
                const unsigned q0_ = __builtin_amdgcn_perm(d3_, d2_, 0x05010400u), q1_ = __builtin_amdgcn_perm(d3_, d2_, 0x07030602u); \
                acc[4 * k + 0] = __builtin_amdgcn_sdot4((int)__builtin_amdgcn_perm(q0_, p0_, 0x05040100u), wq_, acc[4 * k + 0], false); \
                acc[4 * k + 1] = __builtin_amdgcn_sdot4((int)__builtin_amdgcn_perm(q0_, p0_, 0x07060302u), wq_, acc[4 * k + 1], false); \
                acc[4 * k + 2] = __builtin_amdgcn_sdot4((int)__builtin_amdgcn_perm(q1_, p1_, 0x05040100u), wq_, acc[4 * k + 2], false); \
                acc[4 * k + 3] = __builtin_amdgcn_sdot4((int)__builtin_amdgcn_perm(q1_, p1_, 0x07060302u), wq_, acc[4 * k + 3], false); } } \
        int r8[8], r4[4], r2[2]; \
        _Pragma("unroll") for (int k = 0; k < 8; ++k) { const auto rr_ = __builtin_amdgcn_permlane32_swap((unsigned)acc[k], (unsigned)acc[8 + k], false, false); r8[k] = (int)rr_[0] + (int)rr_[1]; } \
        _Pragma("unroll") for (int k = 0; k < 4; ++k) { const auto rr_ = __builtin_amdgcn_permlane16_swap((unsigned)r8[k], (unsigned)r8[4 + k], false, false); r4[k] = (int)rr_[0] + (int)rr_[1]; } \
        _Pragma("unroll") for (int k = 0; k < 2; ++k) r2[k] = seli(m8, r4[2 + k], r4[k]) + dpp_r8(seli(m8, r4[k], r4[2 + k])); \
        const float z0_ = (float)r2[0] * WSC + blo(hx_), z1_ = (float)r2[1] * WSC + bhi(hx_); \
        *(GAS unsigned*)(Z + (size_t)T_ * D + (SG_) * 128 + ch * 16 + 2 * ps) = pk2(z0_, z1_); } while (0)
    v4u bufA[16], bufB[16];
    v4u a0, a1, aw, b0, b1, bw; unsigned ri, rw, ah, bh, chx; float as, bs, cs; int at, bt, ct, ag, bg, cg;
    V_LOAD(0, ri, rw, as, ah, at, ag); V_EXPAND(0, ri, rw, a0, a1, aw);
    V_LOAD(1, ri, rw, bs, bh, bt, bg); V_EXPAND(1, ri, rw, b0, b1, bw);
    V_ISSUE(bufA, a0, a1, ag);
    for (int q = 0; q < NQ; q += 2) {
        V_ISSUE(bufB, b0, b1, bg);
        V_LOAD(q + 2, ri, rw, cs, chx, ct, cg);
        V_FINISH(bufA, aw, as, ah, at, ag);
        V_EXPAND(0, ri, rw, a0, a1, aw); as = cs; ah = chx; at = ct; ag = cg;
        V_ISSUE(bufA, a0, a1, ag);
        V_LOAD(q + 3, ri, rw, cs, chx, ct, cg);
        V_FINISH(bufB, bw, bs, bh, bt, bg);
        V_EXPAND(1, ri, rw, b0, b1, bw); bs = cs; bh = chx; bt = ct; bg = cg;
    }
#undef V_LOAD
#undef V_EXPAND
#undef V_ISSUE
#undef V_FINISH
}
__device__ __forceinline__ void final_load(v4u (&z)[4], v4u (&h)[4], const bf16* Z, const bf16* H1B, size_t tok, int lane) {
#pragma unroll
    for (int j = 0; j < 4; ++j) { z[j] = __builtin_nontemporal_load((const GAS v4u*)(Z + tok * D + j * 512 + lane * 8)); h[j] = __builtin_nontemporal_load((const GAS v4u*)(H1B + tok * D + j * 512 + lane * 8)); }
}
__device__ __forceinline__ void final_finish(const v4u (&z)[4], const v4u (&h)[4], const float* fg, float* out, size_t tok, int lane) {
    float v[4][8]; float ss = 0.f;
#pragma unroll
    for (int j = 0; j < 4; ++j)
#pragma unroll
        for (int k = 0; k < 4; ++k) { v[j][2 * k] = blo(z[j][k]) + blo(h[j][k]); v[j][2 * k + 1] = bhi(z[j][k]) + bhi(h[j][k]); ss += v[j][2 * k] * v[j][2 * k] + v[j][2 * k + 1] * v[j][2 * k + 1]; }
    ss = sum64(ss);
    const float rf = 1.0f / sqrtf(ss * (1.0f / D) + EPS);
#pragma unroll
    for (int j = 0; j < 4; ++j) {
        const f32x4 ga = *(const GAS f32x4*)(fg + j * 512 + lane * 8), gb = *(const GAS f32x4*)(fg + j * 512 + lane * 8 + 4);
        __builtin_nontemporal_store((f32x4){v[j][0] * rf * ga.x, v[j][1] * rf * ga.y, v[j][2] * rf * ga.z, v[j][3] * rf * ga.w}, (GAS f32x4*)(out + tok * D + j * 512 + lane * 8));
        __builtin_nontemporal_store((f32x4){v[j][4] * rf * gb.x, v[j][5] * rf * gb.y, v[j][6] * rf * gb.z, v[j][7] * rf * gb.w}, (GAS f32x4*)(out + tok * D + j * 512 + lane * 8 + 4));
    }
}
}

struct Frame {
    LAS unsigned char* lds;
    volatile LAS unsigned* MISC;
    gu32* ctl;
    int tid, lane, wave, vcu, G;
};
__device__ __forceinline__ float wave_sum(float v) { return sum64(v); }
__device__ __forceinline__ void p0_transpose_item(const float* W, int K, int N, bf16* WT, const float* g0, const float* g1, int ksplit, LAS float* scr, int item, int lane) {
    const int nblk = N / 32, kb = item / nblk, nb = item % nblk, k0 = 64 * kb, n0 = 32 * nb;
    f32x4 v[8];
#pragma unroll
    for (int i = 0; i < 8; ++i) v[i] = __builtin_nontemporal_load((const GAS f32x4*)(W + (size_t)(k0 + 8 * i + (lane >> 3)) * N + n0 + (lane & 7) * 4));
#pragma unroll
    for (int i = 0; i < 8; ++i) { const int kk = 8 * i + (lane >> 3), kg = k0 + kk; const float gv = kg < ksplit ? g0[kg] : g1[kg - ksplit];
        LAS float* d = scr + kk * 33 + (lane & 7) * 4; d[0] = v[i].x * gv; d[1] = v[i].y * gv; d[2] = v[i].z * gv; d[3] = v[i].w * gv; }
    LDS_WAIT(); asm volatile("" ::: "memory");
    const int c = lane & 7;
#pragma unroll
    for (int j = 0; j < 4; ++j) { const int n = (lane >> 3) + 8 * j; const LAS float* s = scr + (8 * c) * 33 + n;
        v4u o; o.x = pk2(s[0 * 33], s[1 * 33]); o.y = pk2(s[2 * 33], s[3 * 33]); o.z = pk2(s[4 * 33], s[5 * 33]); o.w = pk2(s[6 * 33], s[7 * 33]);
        *(GAS v4u*)(WT + (size_t)(n0 + n) * K + k0 + 8 * c) = o; }
    LDS_WAIT(); asm volatile("" ::: "memory");
}
__device__ __forceinline__ void p0_row_load(f32x4 (&v)[8], const float* xrow, int lane) {
    const GAS f32x4* xr = (const GAS f32x4*)xrow + lane;
#pragma unroll
    for (int j = 0; j < 8; ++j) v[j] = __builtin_nontemporal_load(xr + 64 * j);
}
__device__ __forceinline__ void p0_row_finish(const f32x4 (&v)[8], bf16* orow, float* rstd_out, int lane) {
    float s = 0.f;
#pragma unroll
    for (int j = 0; j < 8; ++j) s += (v[j].x * v[j].x + v[j].y * v[j].y) + (v[j].z * v[j].z + v[j].w * v[j].w);
    s = wave_sum(s);
    GAS unsigned long long* o8 = (GAS unsigned long long*)orow + lane;
#pragma unroll
    for (int j = 0; j < 8; ++j) o8[64 * j] = (unsigned long long)pk2(v[j].x, v[j].y) | ((unsigned long long)pk2(v[j].z, v[j].w) << 32);
    if (lane == 0) *rstd_out = 1.0f / sqrtf(s * (1.0f / D) + EPS);
}
__device__ __forceinline__ void p0_cvt8(const float* src, bf16* dst, const float* gcol, size_t idx8) {
    const f32x4 a = *(const GAS f32x4*)(src + idx8 * 8), b = *(const GAS f32x4*)(src + idx8 * 8 + 4);
    f32x4 ga = {1.f, 1.f, 1.f, 1.f}, gb = {1.f, 1.f, 1.f, 1.f};
    if (gcol) { const int c = (int)((idx8 * 8) & (D - 1)); ga = *(const GAS f32x4*)(gcol + c); gb = *(const GAS f32x4*)(gcol + c + 4); }
    v4u o; o.x = pk2(a.x * ga.x, a.y * ga.y); o.y = pk2(a.z * ga.z, a.w * ga.w); o.z = pk2(b.x * gb.x, b.y * gb.y); o.w = pk2(b.z * gb.z, b.w * gb.w);
    *(GAS v4u*)(dst + idx8 * 8) = o;
}

struct Args { const float* in[22]; float* out; unsigned char* ws; int ph_lo, ph_hi, rep_mask, pad; };

__global__ void __launch_bounds__(NWAVES * 64, 2) fwd(Args args) {
    extern __shared__ __attribute__((aligned(16))) unsigned char lds[];
    Frame F;
    F.lds = (LAS unsigned char*)lds;
    F.MISC = (volatile LAS unsigned*)(F.lds + MISC_OFF);
    F.tid = threadIdx.x; F.lane = F.tid & 63; F.wave = __builtin_amdgcn_readfirstlane(F.tid >> 6);
    F.G = gridDim.x; { const int bx = blockIdx.x; F.vcu = (F.G % 8 == 0) ? (bx % 8) * (F.G / 8) + bx / 8 : bx; }
    unsigned char* ws = args.ws;
    F.ctl = (gu32*)(ws + WS_CTL);
    for (int u = F.tid; u < (LDS_BYTES - LDSCTL_OFF) / 4; u += NWAVES * 64) ((LAS unsigned*)(F.lds + LDSCTL_OFF))[u] = 0u;
    __syncthreads();
    XcdBarrier bar = xcd_barrier_post((unsigned*)(F.ctl + CW_BAR), F.MISC + 8);
    const int lo = args.ph_lo, hi = args.ph_hi;
#define IN(k) (lo <= (k) && (k) < hi)
#define BOTH(k) (IN(k) && IN((k) + 1))
#ifndef PROBE_PH
#define PROBE_PH (-1)
#endif
#define REP(k) for (int rep_ = 0; rep_ < ((k) == PROBE_PH ? 2 : 1); ++rep_)
#define STAMP(i) do { if (PROBE_PH >= 100 && blockIdx.x == 0 && F.tid == 0) ((volatile LAS unsigned long long*)(F.lds + LDSCTL_OFF + 640))[i] = __builtin_amdgcn_s_memrealtime(); } while (0)

    const float* x = args.in[0]; const float* meta = args.in[1]; const float* norm_mix_g = args.in[2]; const float* w_in = args.in[3]; const float* b_in = args.in[4];
    const float* gn_attn_g = args.in[13]; const float* gn_lru_g = args.in[14]; const float* w_out = args.in[15]; const float* norm_ffn_g = args.in[16];
    const float* peer_wq = args.in[17]; const float* sub_keys = args.in[18]; const float* peer_u = args.in[19]; const float* peer_v = args.in[20];
    bf16* W1T = (bf16*)(ws + WS_W1T); bf16* W2T = (bf16*)(ws + WS_W2T); bf16* W3T = (bf16*)(ws + WS_W3T); bf16* SKB = (bf16*)(ws + WS_SKB);
    float* RSTD1 = (float*)(ws + WS_RSTD1);
    unsigned char* U8 = ws + WS_U8; unsigned char* V8 = ws + WS_V8; unsigned char* X8 = ws + WS_X8; float* SX = (float*)(ws + WS_SX); float* SCU = (float*)(ws + WS_SCU); float* SCV = (float*)(ws + WS_SCV);
    bf16* A1 = (bf16*)(ws + WS_A1);
    bf16* QB = (bf16*)(ws + WS_Q); bf16* KVB = (bf16*)(ws + WS_KV); bf16* XBB = (bf16*)(ws + WS_XB); bf16* GTB = (bf16*)(ws + WS_GT);

    STAMP(0);
    if (IN(0)) { REP(0) {
        LAS float* scr = (LAS float*)(F.lds + RING_OFF + F.wave * 16384);
        const int gw = F.vcu * NWAVES + F.wave, NGW = F.G * NWAVES;
        constexpr int I_1 = (D / 64) * (IND / 32);
        for (int it = gw; it < I_1; it += NGW) p0_transpose_item(w_in, D, IND, W1T, norm_mix_g, norm_mix_g, D, scr, it, F.lane);
        {
            f32x4 r0[8], r1[8], r2[8];
            const int NR = MREAL + NMETA;
#define P0_XSRC(m_) ((m_) < MREAL ? x + (size_t)(m_) * D : meta + (size_t)((m_) - MREAL) * D)
            if (gw < NR) p0_row_load(r0, P0_XSRC(gw), F.lane);
            if (gw + NGW < NR) p0_row_load(r1, P0_XSRC(gw + NGW), F.lane);
            for (int m = gw; m < NR; m += 3 * NGW) {
                if (m + 2 * NGW < NR) p0_row_load(r2, P0_XSRC(m + 2 * NGW), F.lane);
                p0_row_finish(r0, A1 + (size_t)m * D, RSTD1 + m, F.lane);
                if (m + NGW < NR) {
                    if (m + 3 * NGW < NR) p0_row_load(r0, P0_XSRC(m + 3 * NGW), F.lane);
                    p0_row_finish(r1, A1 + (size_t)(m + NGW) * D, RSTD1 + m + NGW, F.lane);
                }
                if (m + 2 * NGW < NR) {
                    if (m + 4 * NGW < NR) p0_row_load(r1, P0_XSRC(m + 4 * NGW), F.lane);
                    p0_row_finish(r2, A1 + (size_t)(m + 2 * NGW) * D, RSTD1 + m + 2 * NGW, F.lane);
                }
            }
#undef P0_XSRC
        }
        {
            const size_t gt = (size_t)gw * 64 + F.lane, NT = (size_t)NGW * 64;
            for (size_t i = gt; i < (size_t)(8 * 2 * 128 * 128) / 8; i += NT) p0_cvt8(sub_keys, SKB, nullptr, i);
        } }
        if (BOTH(0)) xcd_barrier(bar);
        STAMP(1);
    }
    if (IN(1)) {
        constexpr int NG1 = 210;
        if ((int)blockIdx.x < NG1) {
            pg8::Gemm g{A1, W1T, MPAD, IND, D};
            pg8::Order1 S{NG1, (int)blockIdx.x};
            pg8::Epi1 E{QB, KVB, XBB, GTB, RSTD1, b_in};
            REP(1) pg8::gemm_phase<pg8::Epi1, pg8::Order1, true, true>(F.lds + RING_OFF, g, S, E);
        }
        {
            volatile LAS int* qb = (volatile LAS int*)(F.lds + LDSCTL_OFF + 512);
            for (;;) {
                __syncthreads();
                if (F.tid == 0) qb[0] = (int)__hip_atomic_fetch_add((unsigned*)(F.ctl + CW_QROW), 32u, __ATOMIC_RELAXED, __HIP_MEMORY_SCOPE_AGENT);
                __syncthreads();
                const int base = qb[0];
                if (base >= 32768 + 256 * 32) break;
                if (base >= 32768) {
                    constexpr int I_2 = (D / 64) * (D / 32);
                    LAS float* scr = (LAS float*)(F.lds + RING_OFF + F.wave * 16384);
#pragma unroll 1
                    for (int j = 0; j < 2; ++j) {
                        const int item = ((base - 32768) >> 5) * 16 + F.wave * 2 + j;
                        if (item < I_2) p0_transpose_item(w_out, D, D, W2T, gn_attn_g, gn_lru_g, 1024, scr, item, F.lane);
                        else p0_transpose_item(peer_wq, D, D, W3T, norm_ffn_g, norm_ffn_g, D, scr, item - I_2, F.lane);
                    }
                    continue;
                }
                f32x4 r0[8], r1[8], r2[8], r3[8];
                const bool isu = base < 16384;
                const float* src = isu ? peer_u : peer_v; const float* gc = isu ? norm_ffn_g : nullptr; unsigned char* dst = isu ? U8 : V8; float* sc = isu ? SCU : SCV;
                const size_t e0 = (size_t)(isu ? base : base - 16384) + F.wave * 4;
                p6::qrow_load(r0, src, e0, F.lane); p6::qrow_load(r1, src, e0 + 1, F.lane); p6::qrow_load(r2, src, e0 + 2, F.lane); p6::qrow_load(r3, src, e0 + 3, F.lane);
                p6::qrow_finish(r0, gc, dst, sc, e0, F.lane); p6::qrow_finish(r1, gc, dst, sc, e0 + 1, F.lane);
                p6::qrow_finish(r2, gc, dst, sc, e0 + 2, F.lane); p6::qrow_finish(r3, gc, dst, sc, e0 + 3, F.lane);
            }
        }
        if (BOTH(1)) xcd_barrier(bar);
        STAMP(2);
    }
    if (IN(2)) {
        bf16* MIX = (bf16*)(ws + WS_Z); float* SSA = (float*)(ws + WS_SSA); float* SSL = (float*)(ws + WS_SSL);
        const p2::LruP LP{args.in[6], args.in[7], args.in[8], args.in[9], args.in[10], args.in[11], args.in[12]};
        {
        REP(20) for (int u = (int)blockIdx.x; u < 256; u += F.G) p2::lru_unit(F.lds + RING_OFF, F.lds + LDSCTL_OFF + 5120, u >> 5, (u >> 1) & 15, u & 1, XBB, GTB, LP, MIX, SSL, F.tid);
        REP(21) for (int a = (int)blockIdx.x; a < 256; a += F.G) p2::attn_unit(F.lds + RING_OFF, a >> 5, (a >> 1) & 15, a & 1, QB, KVB, args.in[5], MIX, SSA, F.tid);
        }
        if (BOTH(2)) xcd_barrier(bar);
        STAMP(3);
    }
    if (IN(3)) {
        bf16* MIX = (bf16*)(ws + WS_Z); const float* SSA = (const float*)(ws + WS_SSA); const float* SSL = (const float*)(ws + WS_SSL);
        bf16* H1B = (bf16*)(ws + WS_H1); float* SS2 = (float*)(ws + WS_SS2);
        pg8::Order2 S{F.G, (int)blockIdx.x};
        LAS float* tbl = (LAS float*)(F.lds + LDSCTL_OFF + 1024);
        pg8::Unit u0{0, 0};
        for (int i = 0; i < 2; ++i) {
            pg8::Unit u; if (!S.next(i, u)) break; if (i == 0) u0 = u;
            if (F.tid < 256) {
                const size_t row = (size_t)u.pm * 256 + F.tid; float sa = 0.f, sl = 0.f;
#pragma unroll
                for (int k = 0; k < 4; ++k) { const f32x4 v = *(const GAS f32x4*)(SSA + row * 16 + 4 * k); sa += (v.x + v.y) + (v.z + v.w); }
#pragma unroll
                for (int k = 0; k < 8; ++k) { const f32x4 v = *(const GAS f32x4*)(SSL + row * 32 + 4 * k); sl += (v.x + v.y) + (v.z + v.w); }
                const float ra = 1.0f / sqrtf(sa * (1.0f / 1024) + EPS), rl = 1.0f / sqrtf(sl * (1.0f / 1024) + EPS);
                tbl[(i * 256 + F.tid) * 4] = ra / rl; tbl[(i * 256 + F.tid) * 4 + 1] = rl; tbl[(i * 256 + F.tid) * 4 + 2] = 1.0f / ra;
            }
        }
        __syncthreads();
        pg8::Gemm g{MIX, W2T, MREAL, D, D};
        pg8::Epi2 E{H1B, A1, SS2, (const LAS float*)tbl, u0.pm};
        REP(3) pg8::gemm_phase<pg8::Epi2, pg8::Order2, true, true>(F.lds + RING_OFF, g, S, E);
        if (BOTH(3)) xcd_barrier(bar);
        STAMP(4);
    }
    if (IN(4)) {
        bf16* H1B = (bf16*)(ws + WS_H1); bf16* QPB = (bf16*)(ws + WS_A1);
        pg8::Order2 S{F.G, (int)blockIdx.x};
        {
            const float* SS2 = (const float*)(ws + WS_SS2); float* RSTD2 = (float*)(ws + WS_RSTD2);
            pg8::Unit u; if (S.next(0, u) && F.tid < 256) {
                const size_t row = (size_t)u.pm * 256 + F.tid; float ssq = 0.f;
#pragma unroll
                for (int k = 0; k < 8; ++k) { const f32x4 v = *(const GAS f32x4*)(SS2 + row * 32 + 4 * k); ssq += (v.x + v.y) + (v.z + v.w); }
                RSTD2[row] = 1.0f / sqrtf(ssq * (1.0f / D) + EPS);
            }
        }
        pg8::Gemm g{H1B, W3T, MREAL, D, D};
        pg8::Epi3 E{QPB};
        REP(4) pg8::gemm_phase<pg8::Epi3, pg8::Order2, true, true>(F.lds + RING_OFF, g, S, E);
        if (BOTH(4)) { asm volatile("s_waitcnt vmcnt(0)" ::: "memory"); __syncthreads();
            if (F.tid == 0) { __builtin_amdgcn_fence(__ATOMIC_ACQUIRE, "agent"); asm volatile("s_waitcnt vmcnt(0)" ::: "memory"); }
            __syncthreads(); }
        STAMP(5);
    }
    if (IN(5)) {
        const bf16* QPB = (const bf16*)(ws + WS_A1);
        unsigned short* IDS = (unsigned short*)(ws + WS_IDS); float* GW = (float*)(ws + WS_GW); float* RSTD2 = (float*)(ws + WS_RSTD2);
        const bf16* H1B = (const bf16*)(ws + WS_H1);
        const pg8::Order2 S5{F.G, (int)blockIdx.x};
        REP(5) for (int ui = 0; ; ++ui) {
            pg8::Unit un; if (!S5.next(ui, un)) break;
            const int uh = un.pn, utg = un.pm;
            v4u xq[4][4]; const size_t tb = (size_t)utg * 256 + F.wave * 32 + uh;
            p5::retr_unit(F.lds + RING_OFF, uh, utg, QPB, SKB, IDS, GW, RSTD2, F.tid);
#pragma unroll
            for (int k = 0; k < 4; ++k) p6::qx_load(xq[k], H1B, tb + 8 * k, F.lane);
#pragma unroll
            for (int k = 0; k < 4; ++k) p6::qx_finish(xq[k], X8, SX, tb + 8 * k, F.lane);
        }
        if (BOTH(5)) xcd_barrier(bar);
        STAMP(6);
    }
    {
        const bf16* H1B = (const bf16*)(ws + WS_H1); const unsigned short* IDS = (const unsigned short*)(ws + WS_IDS); const float* GW = (const float*)(ws + WS_GW);
        const float* RSTD2 = (const float*)(ws + WS_RSTD2); bf16* PART = (bf16*)(ws + WS_PART); unsigned char* W8 = ws + WS_W; float* WS8 = (float*)(ws + WS_WSUM); bf16* ZB = (bf16*)(ws + WS_Z);
        const int slot = (int)blockIdx.x & 7, rank = (int)blockIdx.x >> 3, nrank = (F.G - slot + 7) >> 3;
        const int gw = F.vcu * NWAVES + F.wave, NGW = F.G * NWAVES;
        if (IN(6)) { REP(6) p6::usweep(X8, SX, U8, IDS, PART, F.lds + RING_OFF, slot, rank, nrank, F.wave, F.lane); if (BOTH(6)) xcd_barrier(bar); STAMP(7); }
        if (IN(7)) { REP(7) p6::wreduce(PART, GW, RSTD2, IDS, SCU, SCV, W8, WS8, (size_t)gw * 64 + F.lane, (size_t)NGW * 64); if (BOTH(7)) xcd_barrier(bar); STAMP(8); }
        if (IN(8)) { REP(8) p6::vsweep(H1B, V8, IDS, W8, WS8, ZB, F.lds + RING_OFF, slot, rank, nrank, F.wave, F.lane); if (BOTH(8)) xcd_barrier(bar); STAMP(9); }
        if (PROBE_PH == 30) { for (int k = 0; k < 16; ++k) xcd_barrier(bar); }
        if (IN(9)) { REP(9) {
            v4u zc[4], zn[4], hc[4], hn[4];
            if (gw < MREAL) p6::final_load(zc, hc, ZB, H1B, (size_t)gw, F.lane);
            for (int t = gw; t < MREAL; t += NGW) {
                if (t + NGW < MREAL) p6::final_load(zn, hn, ZB, H1B, (size_t)(t + NGW), F.lane);
                p6::final_finish(zc, hc, args.in[21], args.out, (size_t)t, F.lane);
#pragma unroll
                for (int j = 0; j < 4; ++j) { zc[j] = zn[j]; hc[j] = hn[j]; }
            } } }
        if (PROBE_PH >= 100) {
            asm volatile("s_waitcnt vmcnt(0)" ::: "memory"); __syncthreads(); STAMP(10);
            if (blockIdx.x == 0 && F.tid == 0) {
                volatile LAS unsigned long long* ts = (volatile LAS unsigned long long*)(F.lds + LDSCTL_OFF + 640);
                const unsigned long long span = ts[PROBE_PH - 100 + 1] - ts[PROBE_PH - 100], t0 = __builtin_amdgcn_s_memrealtime();
                while (__builtin_amdgcn_s_memrealtime() - t0 < span) __builtin_amdgcn_s_sleep(8);
            }
        }
    }
#undef IN
#undef BOTH
}

extern "C" void kernel_launch(void* const* d_in, const int* in_sizes, int n_in, void* d_out, int out_size, void* d_ws, size_t ws_size, hipStream_t stream) {
    static int grid = 0;
    if (grid == 0) {
        int dev = 0, cus = 0;
        if (hipGetDevice(&dev) != hipSuccess || hipDeviceGetAttribute(&cus, hipDeviceAttributeMultiprocessorCount, dev) != hipSuccess) { fprintf(stderr, "kernel_launch: device query failed\n"); grid = -1; return; }
        if (hipFuncSetAttribute((const void*)fwd, hipFuncAttributeMaxDynamicSharedMemorySize, LDS_BYTES) != hipSuccess) { fprintf(stderr, "kernel_launch: hipFuncSetAttribute failed\n"); grid = -1; return; }
        int per_cu = 0;
        if (hipOccupancyMaxActiveBlocksPerMultiprocessor(&per_cu, (const void*)fwd, NWAVES * 64, LDS_BYTES) != hipSuccess || per_cu < 1) fprintf(stderr, "kernel_launch: occupancy query says %d\n", per_cu);
        (void)hipGetLastError();
        grid = cus;
        if (cus != 256) { fprintf(stderr, "kernel_launch: built for a 256-CU device (tile-to-workgroup maps of the GEMM phases), found %d CUs; nothing launched\n", cus); grid = -1; return; }
        if (ws_size < WS_END) { fprintf(stderr, "kernel_launch: ws too small %zu\n", ws_size); grid = -1; return; }
    }
    if (grid < 0) return;
    (void)hipMemsetAsync((char*)d_ws + WS_CTL, 0, CTL_ZERO_BYTES, stream);
    Args a{};
    for (int i = 0; i < 22; ++i) a.in[i] = (const float*)d_in[i];
    a.out = (float*)d_out; a.ws = (unsigned char*)d_ws; a.ph_lo = 0; a.ph_hi = 10;
    hipLaunchKernelGGL(fwd, dim3(grid), dim3(NWAVES * 64), LDS_BYTES, stream, a);
}
```

```cpp
#include <hip/hip_runtime.h>
#include <cstdio>
#include <cstdint>
#include <math.h>

#define D 2048
#define NB 8
#define SEQ 2048
#define NMETA 16
#define TT (SEQ + NMETA)
#define MR (NB * TT)
#define MREAL (NB * SEQ)
#define MPAD (MREAL + 256)
#define QD 1024
#define KVD 128
#define LW 1024
#define IND 3328
#define EPS 1e-6f
#define QSCALE (0.125f * 1.4426950408889634f)
#define GAS __attribute__((address_space(1)))
#define LAS __attribute__((address_space(3)))

#define DPP_I(x, ctrl) __builtin_amdgcn_update_dpp(0, (x), (ctrl), 0xf, 0xf, true)
__device__ __forceinline__ int dpp_x1(int x) { return DPP_I(x, 0xB1); }
__device__ __forceinline__ int dpp_x2(int x) { return DPP_I(x, 0x4E); }
__device__ __forceinline__ int dpp_hm(int x) { return DPP_I(x, 0x141); }
__device__ __forceinline__ int dpp_rm(int x) { return DPP_I(x, 0x140); }
__device__ __forceinline__ int dpp_r8(int x) { return DPP_I(x, 0x128); }
__device__ __forceinline__ float fdpp_x1(float x) { return __builtin_bit_cast(float, dpp_x1(__builtin_bit_cast(int, x))); }
__device__ __forceinline__ float fdpp_x2(float x) { return __builtin_bit_cast(float, dpp_x2(__builtin_bit_cast(int, x))); }
__device__ __forceinline__ float fdpp_hm(float x) { return __builtin_bit_cast(float, dpp_hm(__builtin_bit_cast(int, x))); }
__device__ __forceinline__ float fdpp_rm(float x) { return __builtin_bit_cast(float, dpp_rm(__builtin_bit_cast(int, x))); }
__device__ __forceinline__ float max16(float v) { v = fmaxf(v, fdpp_x1(v)); v = fmaxf(v, fdpp_x2(v)); v = fmaxf(v, fdpp_hm(v)); return fmaxf(v, fdpp_rm(v)); }
__device__ __forceinline__ float sum64(float v) {
    v += fdpp_x1(v); v += fdpp_x2(v); v += fdpp_hm(v); v += fdpp_rm(v);
    return (__builtin_bit_cast(float, __builtin_amdgcn_readlane(__builtin_bit_cast(int, v), 0)) + __builtin_bit_cast(float, __builtin_amdgcn_readlane(__builtin_bit_cast(int, v), 16)))
         + (__builtin_bit_cast(float, __builtin_amdgcn_readlane(__builtin_bit_cast(int, v), 32)) + __builtin_bit_cast(float, __builtin_amdgcn_readlane(__builtin_bit_cast(int, v), 48)));
}
__device__ __forceinline__ float max64(float v) {
    v = max16(v);
    return fmaxf(fmaxf(__builtin_bit_cast(float, __builtin_amdgcn_readlane(__builtin_bit_cast(int, v), 0)), __builtin_bit_cast(float, __builtin_amdgcn_readlane(__builtin_bit_cast(int, v), 16))),
                 fmaxf(__builtin_bit_cast(float, __builtin_amdgcn_readlane(__builtin_bit_cast(int, v), 32)), __builtin_bit_cast(float, __builtin_amdgcn_readlane(__builtin_bit_cast(int, v), 48))));
}
__device__ __forceinline__ float sum8(float v) { v += fdpp_x1(v); v += fdpp_x2(v); return v + fdpp_hm(v); }
__device__ __forceinline__ float sum4(float v) { v += fdpp_x1(v); return v + fdpp_x2(v); }
__device__ __forceinline__ float sum_x32(float v) { return v + __shfl_xor(v, 32); }
__device__ __forceinline__ float max_x32(float v) { return fmaxf(v, __shfl_xor(v, 32)); }
__device__ __forceinline__ float sum_x16(float v) { return v + __shfl_xor(v, 16); }
namespace pg8 {
#define PG8_LAS __attribute__((address_space(3)))
typedef unsigned short bf16_t;
typedef short bf16x8 __attribute__((ext_vector_type(8)));
typedef float f32x4 __attribute__((ext_vector_type(4)));
typedef unsigned u32x4 __attribute__((ext_vector_type(4)));
constexpr int BM = 256, BK = 64, HALF = 128, HTB = HALF * BK * 2  , STAGE_BYTES = 8 * HTB, NXCD = 8, WGM = 8;

__host__ __device__ __forceinline__ int lds_byte(int r, int c) { const int st = (r >> 4) * 2 + (c >> 5), rr = r & 15, cc = c & 31, ob = rr * 64 + cc * 2; return st * 1024 + (ob ^ (((ob >> 9) & 1) << 5)); }
__host__ __device__ __forceinline__ void stage_rc(int b, int& R, int& C) { const int st = b / 1024, sb = b % 1024, swz = sb ^ (((sb >> 9) & 1) << 5); R = (st >> 1) * 16 + swz / 64; C = (st & 1) * 32 + (swz % 64) / 2; }
__host__ __device__ __forceinline__ int perm32(int rho) { const int n = rho >> 4, i = rho & 15; return 8 * (i >> 2) + 4 * n + (i & 3); }

struct Unit { int pm, pn; };
struct Gemm { const bf16_t* A; const bf16_t* Bt; int M, N, K; };

struct StaticOrder {
    int nM, nN, nwg, G, c;
    __host__ __device__ void init(int M, int N, int G_, int c_) { nM = M / BM; nN = N / BM; nwg = nM * nN; G = G_; c = c_; }
    __host__ __device__ bool next(int i, Unit& u) const {
        const long L = (long)i * G + c; if (L >= nwg) return false;
        int wgid = (int)L; { const int q = nwg / NXCD, r = nwg % NXCD, xcd = wgid % NXCD, off = wgid / NXCD; wgid = (xcd < r ? xcd * (q + 1) : r * (q + 1) + (xcd - r) * q) + off; }
        const int nig = WGM * nN, gid = wgid / nig, fm = gid * WGM, gsz = (nM - fm) < WGM ? (nM - fm) : WGM;
        u.pm = fm + ((wgid % nig) % gsz); u.pn = (wgid % nig) / gsz; return true;
    }
    __device__ __forceinline__ void a_ready(const Unit&) const {}
    __device__ __forceinline__ void done(const Unit&) const {}
};

__device__ __forceinline__ unsigned cvt_pk_bf16(float lo, float hi) { unsigned r; asm volatile("v_cvt_pk_bf16_f32 %0, %1, %2" : "=v"(r) : "v"(lo), "v"(hi)); return r; }
typedef unsigned u32x2 __attribute__((ext_vector_type(2)));
struct Order1 {
    int G, c;
    __device__ __forceinline__ bool next(int i, Unit& u) const {
        if (c >= 208) { if (i > 0 || c >= 213) return false; u.pm = 64; u.pn = 4 + (c - 208); return true; }
        if (i >= 4) return false;
        const int nN = 13;
        const int wgid = (c & 7) * 104 + i * 26 + (c >> 3);
        const int nig = WGM * nN, gid = wgid / nig, fm = gid * WGM;
        u.pm = fm + ((wgid % nig) % WGM); u.pn = (wgid % nig) / WGM; return true;
    }
    __device__ __forceinline__ void a_ready(const Unit&) const {}
    __device__ __forceinline__ void done(const Unit&) const {}
};
struct Order2 {
    int G, c;
    __device__ __forceinline__ bool next(int i, Unit& u) const {
        const int L = i * G + c; if (L >= 512) return false;
        const int nwg = 512, nN = 8;
        int wgid = L; { const int q = nwg / NXCD, xcd = wgid % NXCD, off = wgid / NXCD; wgid = xcd * q + off; }
        const int nig = WGM * nN, gid = wgid / nig, fm = gid * WGM;
        u.pm = fm + ((wgid % nig) % WGM); u.pn = (wgid % nig) / WGM; return true;
    }
    __device__ __forceinline__ void a_ready(const Unit&) const {}
    __device__ __forceinline__ void done(const Unit&) const {}
};

struct Epi1 {
    static constexpr bool PERM = true, AFTER_DRAIN = false, MIDK = false, INIT = false;
    bf16_t *Q, *KV, *XB, *GT; const float* rstd; const float* bias;
    __device__ __forceinline__ void midk(f32x4 (&acc)[2][2][4][2], const Unit& u, int wr, int wc, int fr, int fq) const {}
    __device__ __forceinline__ void operator()(const f32x4 (&acc)[2][2][4][2], const Unit& u, int wr, int wc, int fr, int fq) const {
        const int row0 = u.pm * BM + wr * 64 + fr;
        bf16_t* base; int ldc, colb; float sc = 1.f;
        if (u.pn < 4) { base = Q; ldc = 1024; colb = u.pn * BM; sc = QSCALE; }
        else if (u.pn == 4) { base = KV; ldc = 256; colb = 0; }
        else if (u.pn < 9) { base = XB; ldc = 1024; colb = (u.pn - 5) * BM; }
        else { base = GT; ldc = 1024; colb = (u.pn - 9) * BM; }
        const int col0 = colb + wc * 32 + 8 * fq, bcol0 = u.pn * BM + wc * 32 + 8 * fq;
        f32x4 bv[2][2];
#pragma unroll
        for (int bj = 0; bj < 2; ++bj)
#pragma unroll
            for (int n = 0; n < 2; ++n) bv[bj][n] = *(const f32x4*)(bias + bcol0 + bj * HALF + 4 * n);
#pragma unroll
        for (int ai = 0; ai < 2; ++ai)
#pragma unroll
            for (int m = 0; m < 4; ++m) {
                const int row = row0 + ai * HALF + m * 16; const float rs = rstd[row];
                bf16_t* rowp = base + (size_t)row * ldc + col0;
#pragma unroll
                for (int bj = 0; bj < 2; ++bj) {
                    f32x4 v0 = (acc[ai][bj][m][0] * rs + bv[bj][0]) * sc, v1 = (acc[ai][bj][m][1] * rs + bv[bj][1]) * sc;
                    u32x4 w; w.x = cvt_pk_bf16(v0[0], v0[1]); w.y = cvt_pk_bf16(v0[2], v0[3]); w.z = cvt_pk_bf16(v1[0], v1[1]); w.w = cvt_pk_bf16(v1[2], v1[3]);
                    *(u32x4*)(rowp + bj * HALF) = w; } }
    }
};
struct Epi2 {
    static constexpr bool PERM = true, AFTER_DRAIN = false, MIDK = true, INIT = true;
    bf16_t* H1; const bf16_t* xb; float* SS2; const LAS float* tbl; int pm0;
    __device__ __forceinline__ void init(f32x4 (&acc)[2][2][4][2], const Unit& u, int wr, int wc, int fr, int fq) const {
        const LAS float* t = tbl + (u.pm == pm0 ? 0 : 1024);
        const int col0 = u.pn * BM + wc * 32 + 8 * fq;
#pragma unroll
        for (int ai = 0; ai < 2; ++ai)
#pragma unroll
            for (int m = 0; m < 4; ++m) {
                const int rl = ai * HALF + wr * 64 + m * 16 + fr; const size_t row = (size_t)u.pm * BM + rl; const float ia = t[rl * 4 + 2];
#pragma unroll
                for (int bj = 0; bj < 2; ++bj) {
                    const u32x4 xw = *(const u32x4*)(xb + row * 2048 + col0 + bj * HALF);
                    acc[ai][bj][m][0] = (f32x4){__builtin_bit_cast(float, xw.x << 16), __builtin_bit_cast(float, xw.x & 0xffff0000u), __builtin_bit_cast(float, xw.y << 16), __builtin_bit_cast(float, xw.y & 0xffff0000u)} * ia;
                    acc[ai][bj][m][1] = (f32x4){__builtin_bit_cast(float, xw.z << 16), __builtin_bit_cast(float, xw.z & 0xffff0000u), __builtin_bit_cast(float, xw.w << 16), __builtin_bit_cast(float, xw.w & 0xffff0000u)} * ia; }
            }
    }
    __device__ __forceinline__ void midk(f32x4 (&acc)[2][2][4][2], const Unit& u, int wr, int wc, int fr, int fq) const {
        const LAS float* t = tbl + (u.pm == pm0 ? 0 : 1024);
#pragma unroll
        for (int ai = 0; ai < 2; ++ai)
#pragma unroll
            for (int m = 0; m < 4; ++m) { const float ra = t[(ai * HALF + wr * 64 + m * 16 + fr) * 4];
#pragma unroll
                for (int bj = 0; bj < 2; ++bj)
#pragma unroll
                    for (int n = 0; n < 2; ++n) acc[ai][bj][m][n] = acc[ai][bj][m][n] * ra; }
    }
    __device__ __forceinline__ void operator()(const f32x4 (&acc)[2][2][4][2], const Unit& u, int wr, int wc, int fr, int fq) const {
        const LAS float* t = tbl + (u.pm == pm0 ? 0 : 1024);
        const int col0 = u.pn * BM + wc * 32 + 8 * fq;
#pragma unroll
        for (int ai = 0; ai < 2; ++ai)
#pragma unroll
            for (int m = 0; m < 4; ++m) {
                const int rl = ai * HALF + wr * 64 + m * 16 + fr; const size_t row = (size_t)u.pm * BM + rl; const float rs = t[rl * 4 + 1];
                float ss = 0.f;
#pragma unroll
                for (int bj = 0; bj < 2; ++bj) {
                    const f32x4 v0 = acc[ai][bj][m][0] * rs, v1 = acc[ai][bj][m][1] * rs;
                    ss += (v0[0] * v0[0] + v0[1] * v0[1]) + (v0[2] * v0[2] + v0[3] * v0[3]) + (v1[0] * v1[0] + v1[1] * v1[1]) + (v1[2] * v1[2] + v1[3] * v1[3]);
                    u32x4 w; w.x = cvt_pk_bf16(v0[0], v0[1]); w.y = cvt_pk_bf16(v0[2], v0[3]); w.z = cvt_pk_bf16(v1[0], v1[1]); w.w = cvt_pk_bf16(v1[2], v1[3]);
                    *(u32x4*)(H1 + row * 2048 + col0 + bj * HALF) = w; }
                ss = sum_x32(sum_x16(ss));
                if (fq == 0) SS2[row * 32 + u.pn * 4 + wc] = ss;
            }
    }
};
struct Epi3 {
    static constexpr bool PERM = true, AFTER_DRAIN = false, MIDK = false, INIT = false;
    bf16_t* O;
    __device__ __forceinline__ void midk(f32x4 (&acc)[2][2][4][2], const Unit& u, int wr, int wc, int fr, int fq) const {}
    __device__ __forceinline__ void operator()(const f32x4 (&acc)[2][2][4][2], const Unit& u, int wr, int wc, int fr, int fq) const {
        const int col0 = u.pn * BM + wc * 32 + 8 * fq;
#pragma unroll
        for (int ai = 0; ai < 2; ++ai)
#pragma unroll
            for (int m = 0; m < 4; ++m) { const size_t row = (size_t)u.pm * BM + ai * HALF + wr * 64 + m * 16 + fr;
#pragma unroll
                for (int bj = 0; bj < 2; ++bj) { const f32x4 v0 = acc[ai][bj][m][0], v1 = acc[ai][bj][m][1];
                    u32x4 w; w.x = cvt_pk_bf16(v0[0], v0[1]); w.y = cvt_pk_bf16(v0[2], v0[3]); w.z = cvt_pk_bf16(v1[0], v1[1]); w.w = cvt_pk_bf16(v1[2], v1[3]);
                    *(u32x4*)(O + row * 2048 + col0 + bj * HALF) = w; } }
    }
};
template <class Epi, class Sched, bool ALIGN_EPI = false, bool SP2 = false>
__device__ __forceinline__ void gemm_phase(PG8_LAS unsigned char* lds, const Gemm g, const Sched& S, const Epi& E) {
    const int tid = threadIdx.x, wid = __builtin_amdgcn_readfirstlane(tid >> 6), lane = tid & 63, wr = wid >> 2, wc = wid & 3, fr = lane & 15, fq = lane >> 4;
    const int K = g.K, nt = K / BK;
    unsigned voffA[2], voffB[2];
#pragma unroll
    for (int i = 0; i < 2; ++i) { int R, C; stage_rc(tid * 16 + i * 8192, R, C); const int Rb = Epi::PERM ? ((R & ~31) + perm32(R & 31)) : R;
        voffA[i] = (unsigned)(R * K + C) * 2u; voffB[i] = (unsigned)(Rb * K + C) * 2u; }
    const size_t kstep = (size_t)(BK * 2);
    const size_t hstep = (size_t)HALF * K * 2;
    const size_t tstep = 2 * hstep;
    const unsigned ldsw = (unsigned)wid * 1024u;
    const int aoff = lds_byte(wr * 64 + fr, fq * 8), boff = lds_byte(wc * 32 + fr, fq * 8);
#define PG8_SA(b, h) (((b) * 2 + (h)) * HTB)
#define PG8_SB(b, h) ((4 + (b) * 2 + (h)) * HTB)
#define PG8_STAGE(bufoff, gbase, voff) do { _Pragma("unroll") for (int _i = 0; _i < 2; ++_i) \
        __builtin_amdgcn_global_load_lds((const unsigned*)((const char*)(gbase) + (voff)[_i]), (PG8_LAS unsigned*)(lds + (bufoff) + ldsw + _i * 8192), 16, 0, 0); } while (0)
#define PG8_LDA(dst, b, h) do { _Pragma("unroll") for (int m = 0; m < 4; ++m) _Pragma("unroll") for (int k = 0; k < 2; ++k) dst[m][k] = *(const PG8_LAS bf16x8*)(lds + PG8_SA(b, h) + aoff + m * 2048 + k * 1024); } while (0)
#define PG8_LDB(dst, b, h) do { _Pragma("unroll") for (int n = 0; n < 2; ++n) _Pragma("unroll") for (int k = 0; k < 2; ++k) dst[n][k] = *(const PG8_LAS bf16x8*)(lds + PG8_SB(b, h) + boff + n * 2048 + k * 1024); } while (0)
#define PG8_MMA(ai, bj, At, Bt) do { __builtin_amdgcn_s_setprio(1); _Pragma("unroll") for (int m = 0; m < 4; ++m) _Pragma("unroll") for (int n = 0; n < 2; ++n) _Pragma("unroll") for (int k = 0; k < 2; ++k) \
        acc[ai][bj][m][n] = __builtin_amdgcn_mfma_f32_16x16x32_bf16(Bt[n][k], At[m][k], acc[ai][bj][m][n], 0, 0, 0); __builtin_amdgcn_s_setprio(0); } while (0)
#define PG8_WAIT_V(n) asm volatile("s_waitcnt vmcnt(" #n ")" ::: "memory")
#define PG8_WAIT_L(n) asm volatile("s_waitcnt lgkmcnt(" #n ")" ::: "memory")
#define PG8_BAR __builtin_amdgcn_s_barrier()
#define PG8_SCHED __builtin_amdgcn_sched_barrier(0)
    Unit cur, nxt; int ui = 0;
    if (!S.next(0, cur)) return;
    f32x4 acc[2][2][4][2];
    if constexpr (Epi::INIT) E.init(acc, cur, wr, wc, fr, fq);
    else {
#pragma unroll
    for (int a = 0; a < 2; ++a)
#pragma unroll
        for (int b = 0; b < 2; ++b)
#pragma unroll
            for (int m = 0; m < 4; ++m)
#pragma unroll
                for (int n = 0; n < 2; ++n) acc[a][b][m][n] = (f32x4){0.f, 0.f, 0.f, 0.f};
    }
    bf16x8 At[4][2], B0[2][2], B1[2][2];
    const char* cA = (const char*)g.A + (size_t)cur.pm * tstep; const char* cB = (const char*)g.Bt + (size_t)cur.pn * tstep;
    S.a_ready(cur);
    if constexpr (SP2) {
        PG8_STAGE(PG8_SB(0, 0), cB, voffB); PG8_STAGE(PG8_SB(0, 1), cB + hstep, voffB); PG8_STAGE(PG8_SA(0, 0), cA, voffA); PG8_STAGE(PG8_SA(0, 1), cA + hstep, voffA);
        if (wr == 1) PG8_BAR;
        PG8_WAIT_V(2); PG8_BAR;
        PG8_STAGE(PG8_SB(1, 0), cB + kstep, voffB); PG8_STAGE(PG8_SA(1, 0), cA + kstep, voffA); PG8_STAGE(PG8_SB(1, 1), cB + hstep + kstep, voffB);
        PG8_WAIT_V(6); PG8_BAR;
    } else {
        PG8_STAGE(PG8_SB(0, 0), cB, voffB); PG8_STAGE(PG8_SA(0, 0), cA, voffA); PG8_STAGE(PG8_SB(0, 1), cB + hstep, voffB); PG8_STAGE(PG8_SA(0, 1), cA + hstep, voffA);
        if (wr == 1) PG8_BAR;
        PG8_WAIT_V(4); PG8_BAR;
        PG8_STAGE(PG8_SB(1, 0), cB + kstep, voffB); PG8_STAGE(PG8_SA(1, 0), cA + kstep, voffA); PG8_STAGE(PG8_SB(1, 1), cB + hstep + kstep, voffB);
        PG8_WAIT_V(6); PG8_BAR;
    }
    for (;;) {
        const bool has_next = S.next(ui + 1, nxt);
        const char* nA = has_next ? (const char*)g.A + (size_t)nxt.pm * tstep : cA; const char* nB = has_next ? (const char*)g.Bt + (size_t)nxt.pn * tstep : cB;
        for (int t = 0; t < nt; t += 2) {
            if constexpr (Epi::MIDK) { if (t == nt / 2) E.midk(acc, cur, wr, wc, fr, fq); }
            const bool last = (t == nt - 2);
            const char* a1 = cA + (size_t)(t + 1) * kstep;
            const char* a2 = last ? nA : cA + (size_t)(t + 2) * kstep; const char* b2 = last ? nB : cB + (size_t)(t + 2) * kstep;
            const char* a3 = a2 + kstep; const char* b3 = b2 + kstep;
            if (last && has_next) S.a_ready(nxt);
            if constexpr (SP2) {
            PG8_LDB(B0, 0, 0); PG8_LDB(B1, 0, 1); PG8_SCHED; PG8_LDA(At, 0, 0); PG8_STAGE(PG8_SA(1, 1), a1 + hstep, voffA);
            PG8_WAIT_V(8); PG8_WAIT_L(0); PG8_BAR; PG8_MMA(0, 0, At, B0); PG8_MMA(0, 1, At, B1); PG8_BAR; PG8_SCHED;
            PG8_LDA(At, 0, 1); PG8_STAGE(PG8_SB(0, 0), b2, voffB); PG8_STAGE(PG8_SB(0, 1), b2 + hstep, voffB); PG8_STAGE(PG8_SA(0, 0), a2, voffA);
            PG8_WAIT_V(8); PG8_WAIT_L(0); PG8_BAR; PG8_MMA(1, 0, At, B0); PG8_MMA(1, 1, At, B1); PG8_BAR; PG8_SCHED;
            PG8_LDB(B0, 1, 0); PG8_LDB(B1, 1, 1); PG8_SCHED; PG8_LDA(At, 1, 0); PG8_STAGE(PG8_SA(0, 1), a2 + hstep, voffA);
            PG8_WAIT_V(8); PG8_WAIT_L(0); PG8_BAR; PG8_MMA(0, 0, At, B0); PG8_MMA(0, 1, At, B1); PG8_BAR; PG8_SCHED;
            PG8_LDA(At, 1, 1); PG8_STAGE(PG8_SB(1, 0), b3, voffB); PG8_STAGE(PG8_SB(1, 1), b3 + hstep, voffB); PG8_STAGE(PG8_SA(1, 0), a3, voffA);
            PG8_WAIT_V(8); PG8_WAIT_L(0); PG8_BAR; PG8_MMA(1, 0, At, B0); PG8_MMA(1, 1, At, B1); PG8_BAR; PG8_SCHED;
            } else {
            PG8_LDB(B0, 0, 0); PG8_SCHED; PG8_LDA(At, 0, 0); PG8_STAGE(PG8_SA(1, 1), a1 + hstep, voffA);
            PG8_WAIT_L(8); PG8_BAR; PG8_WAIT_L(0); PG8_MMA(0, 0, At, B0); PG8_BAR; PG8_SCHED;
            PG8_LDB(B1, 0, 1); PG8_STAGE(PG8_SB(0, 0), b2, voffB);
            PG8_BAR; PG8_WAIT_L(0); PG8_MMA(0, 1, At, B1); PG8_BAR;
            PG8_LDA(At, 0, 1); PG8_STAGE(PG8_SA(0, 0), a2, voffA);
            PG8_BAR; PG8_WAIT_L(0); PG8_MMA(1, 0, At, B0); PG8_BAR; PG8_SCHED;
            PG8_STAGE(PG8_SB(0, 1), b2 + hstep, voffB);
            PG8_WAIT_V(6); PG8_BAR; PG8_MMA(1, 1, At, B1); PG8_BAR;
            PG8_LDB(B0, 1, 0); PG8_SCHED; PG8_LDA(At, 1, 0); PG8_STAGE(PG8_SA(0, 1), a2 + hstep, voffA);
            PG8_WAIT_L(8); PG8_BAR; PG8_WAIT_L(0); PG8_MMA(0, 0, At, B0); PG8_BAR; PG8_SCHED;
            PG8_LDB(B1, 1, 1); PG8_STAGE(PG8_SB(1, 0), b3, voffB);
            PG8_BAR; PG8_WAIT_L(0); PG8_MMA(0, 1, At, B1); PG8_BAR;
            PG8_LDA(At, 1, 1); PG8_STAGE(PG8_SA(1, 0), a3, voffA);
            PG8_BAR; PG8_WAIT_L(0); PG8_MMA(1, 0, At, B0); PG8_BAR; PG8_SCHED;
            PG8_STAGE(PG8_SB(1, 1), b3 + hstep, voffB);
            PG8_WAIT_V(6); PG8_BAR; PG8_MMA(1, 1, At, B1); PG8_BAR;
            }
        }
        if constexpr (ALIGN_EPI) { if (wr == 0) PG8_BAR; }
        if constexpr (!Epi::AFTER_DRAIN) { E(acc, cur, wr, wc, fr, fq); S.done(cur); }
        if (!has_next) break;
        if constexpr (Epi::INIT) E.init(acc, nxt, wr, wc, fr, fq);
        else {
#pragma unroll
        for (int a = 0; a < 2; ++a)
#pragma unroll
            for (int b = 0; b < 2; ++b)
#pragma unroll
                for (int m = 0; m < 4; ++m)
#pragma unroll
                    for (int n = 0; n < 2; ++n) acc[a][b][m][n] = (f32x4){0.f, 0.f, 0.f, 0.f};
        }
        cur = nxt; cA = nA; cB = nB; ++ui;
        if constexpr (ALIGN_EPI) { if (wr == 1) PG8_BAR; }
    }
    PG8_WAIT_V(0);
    if constexpr (!ALIGN_EPI) { if (wr == 0) PG8_BAR; }
    PG8_BAR;
    if constexpr (Epi::AFTER_DRAIN) { E.fused(acc, cur, wr, wc, fr, fq, lds, wid, lane); S.done(cur); }
#undef PG8_SA
#undef PG8_SB
#undef PG8_STAGE
#undef PG8_LDA
#undef PG8_LDB
#undef PG8_MMA
#undef PG8_WAIT_V
#undef PG8_WAIT_L
#undef PG8_BAR
#undef PG8_SCHED
}
}
#define XB_TMO      128
#define XB_XCNT(j)  (256  + 64 * (j))
#define XB_XSUB(j)  (1280 + 64 * (j))
#define XB_XGEN(j)  (2304 + 64 * (j))
#define XB_TOP      3328
#define XB_TOPGEN   3392
#define XCD_BAR_WORDS 3456
#define XB_SPIN_CAP (1u << 18)

__device__ __forceinline__ unsigned xb_ld(unsigned* p)              { return __hip_atomic_load(p, __ATOMIC_RELAXED, __HIP_MEMORY_SCOPE_AGENT); }
__device__ __forceinline__ unsigned xb_add(unsigned* p, unsigned v) { return __hip_atomic_fetch_add(p, v, __ATOMIC_RELAXED, __HIP_MEMORY_SCOPE_AGENT); }
__device__ __forceinline__ unsigned xb_xcc_id() { return (unsigned)__builtin_amdgcn_s_getreg((3 << 11) | 20) & 0xFu; }
#define XB_SPIN(cond, bar) do { unsigned _sp = 0; while (cond) { __builtin_amdgcn_s_sleep(1); \
    if ((++_sp & 255u) == 0u) { if (xb_ld(&(bar)[XB_TMO])) break; if (_sp > XB_SPIN_CAP) { atomicAdd(&(bar)[XB_TMO], 1u); break; } } } } while (0)

struct XcdBarrier {
    unsigned* bar; unsigned x;
    volatile LAS unsigned* st;
};

__device__ __forceinline__ XcdBarrier xcd_barrier_post(unsigned* bar, volatile LAS unsigned* st) {
    XcdBarrier b; b.bar = bar; b.x = xb_xcc_id(); b.st = st;
    if (threadIdx.x == 0) (void)xb_add(&bar[XB_XCNT(b.x)], 1u);
    return b;
}
__device__ __forceinline__ void xcd_barrier_complete(unsigned* bar, unsigned x, unsigned& nloc, unsigned& nx) {
    const unsigned G = gridDim.x * gridDim.y * gridDim.z;
    unsigned sum, cnt, mine, sp = 0u;
    for (;;) {
        sum = 0u; cnt = 0u; mine = 0u;
#pragma unroll
        for (unsigned j = 0; j < 16; ++j) { const unsigned c = xb_ld(&bar[XB_XCNT(j)]); sum += c; cnt += (c > 0u) ? 1u : 0u; mine = (j == x) ? c : mine; }
        if (sum == G) break;
        __builtin_amdgcn_s_sleep(1);
        if ((++sp & 255u) == 0u) { if (xb_ld(&bar[XB_TMO])) break; if (sp > XB_SPIN_CAP) { atomicAdd(&bar[XB_TMO], 1u); break; } }
    }
    nloc = mine > 0u ? mine : 1u; nx = cnt > 0u ? cnt : 1u;
}

__device__ __forceinline__ void xcd_barrier(const XcdBarrier& b) {
    asm volatile("s_waitcnt vmcnt(0)" ::: "memory");
    __syncthreads();
    if (threadIdx.x == 0) {
        unsigned* bar = b.bar;
        __builtin_amdgcn_s_waitcnt(0);
        unsigned nloc = b.st[0], nx = b.st[1];
        if (nloc == 0u) { xcd_barrier_complete(bar, b.x, nloc, nx); b.st[0] = nloc; b.st[1] = nx; }
        const unsigned old = xb_add(&bar[XB_XSUB(b.x)], 1u);
        const unsigned gen = old / nloc;
        if (old + 1u == (gen + 1u) * nloc) {
            __builtin_amdgcn_fence(__ATOMIC_RELEASE, "agent");
            asm volatile("s_waitcnt vmcnt(0)" ::: "memory");
            const unsigned og = xb_add(&bar[XB_TOP], 1u);
            const unsigned tg = og / nx;
            if (og + 1u == (tg + 1u) * nx) xb_add(&bar[XB_TOPGEN], 1u);
            else XB_SPIN(xb_ld(&bar[XB_TOPGEN]) == tg, bar);
            __builtin_amdgcn_fence(__ATOMIC_ACQUIRE, "agent");
            xb_add(&bar[XB_XGEN(b.x)], 1u);
            asm volatile("s_waitcnt vmcnt(0)" ::: "memory");
        } else {
            XB_SPIN(xb_ld(&bar[XB_XGEN(b.x)]) == gen, bar);
            __builtin_amdgcn_fence(__ATOMIC_ACQUIRE, "agent");
            asm volatile("s_waitcnt vmcnt(0)" ::: "memory");
        }
    }
    __syncthreads();
}

constexpr int NWAVES = 8;
constexpr size_t MiB = 1u << 20;
constexpr size_t WS_CTL = 0, CTL_ZERO_BYTES = 1 * MiB;
constexpr size_t WS_W1T = 2 * MiB;
constexpr size_t WS_W2T = 16 * MiB;
constexpr size_t WS_W3T = 24 * MiB;
constexpr size_t WS_SKB = 32 * MiB;
constexpr size_t WS_RSTD1 = 33 * MiB;
constexpr size_t WS_SSA = 34 * MiB;
constexpr size_t WS_SSL = 35 * MiB;
constexpr size_t WS_SS2 = 37 * MiB;
constexpr size_t WS_RSTD2 = 39 * MiB;
constexpr size_t WS_IDS = 40 * MiB;
constexpr size_t WS_GW = 48 * MiB;
constexpr size_t WS_U8 = 64 * MiB;
constexpr size_t WS_V8 = 96 * MiB;
constexpr size_t WS_X8 = 128 * MiB;
constexpr size_t WS_SX = 160 * MiB;
constexpr size_t WS_SCU = 162 * MiB;
constexpr size_t WS_SCV = 163 * MiB;
constexpr size_t WS_WSUM = 164 * MiB;
constexpr size_t WS_A1 = 192 * MiB;
constexpr size_t WS_Q = 258 * MiB;
constexpr size_t WS_KV = 290 * MiB;
constexpr size_t WS_XB = 299 * MiB;
constexpr size_t WS_GT = 332 * MiB;
constexpr size_t WS_H1 = 364 * MiB;
constexpr size_t WS_PART = 192 * MiB;
constexpr size_t WS_W = 56 * MiB;
constexpr size_t WS_Z = 428 * MiB;
constexpr size_t WS_END = 492 * MiB;
constexpr int CW_QROW = 2048;
constexpr int CW_BAR = 4096;

constexpr int RING_OFF = 0, RING_BYTES = 131072;
constexpr int LDSCTL_OFF = RING_BYTES, MISC_OFF = LDSCTL_OFF + 320;
constexpr int LDS_BYTES = 147456;

typedef unsigned short bf16;
typedef unsigned v4u __attribute__((ext_vector_type(4)));
typedef float f32x4 __attribute__((ext_vector_type(4)));
typedef short bf16x8 __attribute__((ext_vector_type(8)));
typedef GAS unsigned gu32;
#define RLX_AGENT __ATOMIC_RELAXED, __HIP_MEMORY_SCOPE_AGENT
#define LDS_WAIT() asm volatile("s_waitcnt lgkmcnt(0)" ::: "memory")
#define VM_WAIT() asm volatile("s_waitcnt vmcnt(0)" ::: "memory")
__device__ __forceinline__ unsigned f2bf(float f) { unsigned u = __builtin_bit_cast(unsigned, f); return (u + 0x7fffu + ((u >> 16) & 1u)) >> 16; }
__device__ __forceinline__ unsigned pk2(float lo, float hi) { return f2bf(lo) | (f2bf(hi) << 16); }
__device__ __forceinline__ float bf2f(unsigned short b) { return __builtin_bit_cast(float, (unsigned)b << 16); }


namespace p2 {
typedef float f32x16 __attribute__((ext_vector_type(16)));
typedef unsigned u32x2 __attribute__((ext_vector_type(2)));
constexpr float LOG2E = 1.4426950408889634f;
constexpr float NEGBIG = -1e30f;
__device__ __forceinline__ int crow(int r, int hi) { return (r & 3) + 8 * (r >> 2) + 4 * hi; }
__device__ __forceinline__ unsigned cvtpk(float lo, float hi) { unsigned r; asm volatile("v_cvt_pk_bf16_f32 %0, %1, %2" : "=v"(r) : "v"(lo), "v"(hi)); return r; }
__device__ __forceinline__ float ex2(float x) { return __builtin_amdgcn_exp2f(x); }
__device__ __forceinline__ float rcp(float x) { return __builtin_amdgcn_rcpf(x); }
__device__ __forceinline__ float gelu_fast(float x) { return x * rcp(1.0f + ex2(x * (-2.302208198f - 0.102943240f * (x * x)))); }

constexpr int A_KS = 0, A_KSP = 144, A_VT = 288 * 144, A_VTP = 584, A_ST = A_VT + 64 * 584, A_END = A_ST + 8 * 4096;
__device__ __forceinline__ void attn_unit(LAS unsigned char* lds, int b, int qblk, int kvh, const bf16* QB, const bf16* KVB, const float* sinks, bf16* MIX, float* SSA, int tid) {
    const int lane = tid & 63, wave = __builtin_amdgcn_readfirstlane(tid >> 6), r = lane & 31, hi = lane >> 5;
    const int q0 = qblk * 128, hq = kvh * 8 + wave;
    for (int it = 0; it < 5; ++it) {
        const int cid = it * 512 + tid;
        if (cid < 288 * 8) {
            const int key = cid >> 3, ch = cid & 7;
            bool valid; size_t row = 0;
            if (key < 256) { const int pos = q0 - 128 + key; valid = pos >= 0; row = (size_t)b * SEQ + pos; }
            else if (key < 272) { valid = true; row = (size_t)MREAL + (key - 256); }
            else valid = false;
            v4u kv = {0u, 0u, 0u, 0u}, vv = {0u, 0u, 0u, 0u};
            if (valid) { kv = *(const GAS v4u*)(KVB + row * 256 + kvh * 64 + ch * 8); vv = *(const GAS v4u*)(KVB + row * 256 + 128 + kvh * 64 + ch * 8); }
            *(LAS v4u*)(lds + A_KS + key * A_KSP + ch * 16) = kv;
            LAS unsigned short* vt = (LAS unsigned short*)(lds + A_VT);
#pragma unroll
            for (int j = 0; j < 8; ++j) { const unsigned wv = vv[j >> 1]; vt[(ch * 8 + j) * (A_VTP / 2) + key] = (unsigned short)((j & 1) ? (wv >> 16) : (wv & 0xffffu)); }
        }
    }
    __syncthreads();
    const float sink2 = sinks[hq] * LOG2E;
    bf16x8 qf[4];
#pragma unroll
    for (int ks = 0; ks < 4; ++ks) qf[ks] = *(const GAS bf16x8*)(QB + ((size_t)b * SEQ + q0 + r) * 1024 + hq * 64 + ks * 16 + hi * 8);
    for (int qg = 0; qg < 4; ++qg) {
        f32x16 s[6];
#pragma unroll
        for (int t = 0; t < 6; ++t) {
            const int kbase = t < 5 ? 32 * (qg + t) : 256;
            f32x16 acc = {0.f, 0.f, 0.f, 0.f, 0.f, 0.f, 0.f, 0.f, 0.f, 0.f, 0.f, 0.f, 0.f, 0.f, 0.f, 0.f};
#pragma unroll
            for (int ks = 0; ks < 4; ++ks) {
                const bf16x8 kf = *(const LAS bf16x8*)(lds + A_KS + (kbase + r) * A_KSP + ks * 32 + hi * 16);
                acc = __builtin_amdgcn_mfma_f32_32x32x16_bf16(kf, qf[ks], acc, 0, 0, 0);
            }
            s[t] = acc;
        }
        if (qg + 1 < 4) {
#pragma unroll
            for (int ks = 0; ks < 4; ++ks) qf[ks] = *(const GAS bf16x8*)(QB + ((size_t)b * SEQ + q0 + 32 * (qg + 1) + r) * 1024 + hq * 64 + ks * 16 + hi * 8);
        }
        const bool blk0 = (qblk == 0);
#pragma unroll
        for (int reg = 0; reg < 16; ++reg) {
            const int j = crow(reg, hi);
            s[0][reg] = (j > r) ? s[0][reg] : NEGBIG;
            s[4][reg] = (j <= r) ? s[4][reg] : NEGBIG;
            if (reg >= 8) s[5][reg] = NEGBIG;
        }
#pragma unroll
        for (int t = 0; t < 4; ++t) if (blk0 && (qg + t < 4)) {
#pragma unroll
            for (int reg = 0; reg < 16; ++reg) s[t][reg] = NEGBIG;
        }
        float m = sink2;
#pragma unroll
        for (int t = 0; t < 6; ++t)
#pragma unroll
            for (int reg = 0; reg < (t == 5 ? 8 : 16); ++reg) m = fmaxf(m, s[t][reg]);
        m = max_x32(m);
        float l = 0.f;
#pragma unroll
        for (int t = 0; t < 6; ++t)
#pragma unroll
            for (int reg = 0; reg < (t == 5 ? 8 : 16); ++reg) { const float p = ex2(s[t][reg] - m); s[t][reg] = p; l += p; }
        l = sum_x32(l);
        l += ex2(sink2 - m);
        const float linv = 1.0f / l;
        f32x16 o0 = {0.f, 0.f, 0.f, 0.f, 0.f, 0.f, 0.f, 0.f, 0.f, 0.f, 0.f, 0.f, 0.f, 0.f, 0.f, 0.f}, o1 = o0;
#pragma unroll
        for (int t = 0; t < 6; ++t) {
            const int kbase = t < 5 ? 32 * (qg + t) : 256;
#pragma unroll
            for (int ss = 0; ss < (t == 5 ? 1 : 2); ++ss) {
                v4u pw; pw.x = cvtpk(s[t][8 * ss + 0], s[t][8 * ss + 1]); pw.y = cvtpk(s[t][8 * ss + 2], s[t][8 * ss + 3]);
                pw.z = cvtpk(s[t][8 * ss + 4], s[t][8 * ss + 5]); pw.w = cvtpk(s[t][8 * ss + 6], s[t][8 * ss + 7]);
                const bf16x8 pa = __builtin_bit_cast(bf16x8, pw);
                const int ko = (kbase + 16 * ss + 4 * hi) * 2;
                {   const u32x2 lo = *(const LAS u32x2*)(lds + A_VT + r * A_VTP + ko), h2 = *(const LAS u32x2*)(lds + A_VT + r * A_VTP + ko + 16);
                    v4u vw; vw.x = lo.x; vw.y = lo.y; vw.z = h2.x; vw.w = h2.y;
                    o0 = __builtin_amdgcn_mfma_f32_32x32x16_bf16(pa, __builtin_bit_cast(bf16x8, vw), o0, 0, 0, 0); }
                {   const u32x2 lo = *(const LAS u32x2*)(lds + A_VT + (32 + r) * A_VTP + ko), h2 = *(const LAS u32x2*)(lds + A_VT + (32 + r) * A_VTP + ko + 16);
                    v4u vw; vw.x = lo.x; vw.y = lo.y; vw.z = h2.x; vw.w = h2.y;
                    o1 = __builtin_amdgcn_mfma_f32_32x32x16_bf16(pa, __builtin_bit_cast(bf16x8, vw), o1, 0, 0, 0); }
            }
        }
        LAS unsigned short* stg = (LAS unsigned short*)(lds + A_ST + wave * 4096);
#pragma unroll
        for (int reg = 0; reg < 16; ++reg) {
            const int qr = crow(reg, hi); const float li = __shfl(linv, qr);
            stg[qr * 64 + r] = (unsigned short)f2bf(o0[reg] * li);
            stg[qr * 64 + 32 + r] = (unsigned short)f2bf(o1[reg] * li);
        }
        asm volatile("s_waitcnt lgkmcnt(0)" ::: "memory");
#pragma unroll
        for (int i = 0; i < 4; ++i) {
            const int row = i * 8 + (lane >> 3), ch = lane & 7;
            const v4u v = *(const LAS v4u*)(stg + row * 64 + ch * 8);
            float ss = 0.f;
#pragma unroll
            for (int k = 0; k < 4; ++k) { const float a = __builtin_bit_cast(float, v[k] << 16), c = __builtin_bit_cast(float, v[k] & 0xffff0000u); ss += a * a + c * c; }
            ss = sum8(ss);
            const size_t orow = (size_t)b * SEQ + q0 + 32 * qg + row;
            *(GAS v4u*)(MIX + orow * D + hq * 64 + ch * 8) = v;
            if (ch == 0) SSA[orow * 16 + hq] = ss;
        }
        asm volatile("s_waitcnt lgkmcnt(0)" ::: "memory");
    }
    __syncthreads();
}

constexpr int LW_XS = 0, LW_GS = 4608, LW_XC = LW_GS + 2048, LW_XCF = LW_XC + 4608, LW_BYTES = LW_XCF + 4096 + 128;
constexpr int L_CT = 8 * LW_BYTES, L_END = L_CT + 2 * 2048;
static_assert(L_END <= 131072, "lru lds");
struct LruP { const float *conv_w, *conv_b, *w_r, *b_r, *w_i, *b_i, *lam; };
__device__ __forceinline__ void lru_unit(LAS unsigned char* lds, LAS unsigned char* ldsw  , int b, int nb, int cg, const bf16* XBB, const bf16* GTB, const LruP P, bf16* MIX, float* SSL, int tid) {
    const int lane = tid & 63, wave = __builtin_amdgcn_readfirstlane(tid >> 6), r = lane & 31, hi = lane >> 5;
    LAS unsigned char* lw = lds + wave * LW_BYTES;
    {
        LAS unsigned short* wt = (LAS unsigned short*)ldsw;
#pragma unroll
        for (int i = 0; i < 4; ++i) {
            const int e = tid + 512 * i, c = e >> 5, dl = e & 31;
            const size_t gi = (size_t)(nb * 64 + c) * 64 + 32 * cg + dl;
            wt[dl * 72 + c] = (unsigned short)f2bf(-LOG2E * P.w_r[gi]);
            wt[32 * 72 + dl * 72 + c] = (unsigned short)f2bf(-LOG2E * P.w_i[gi]);
        }
    }
    const int cc = lane, chc = nb * 64 + cc;
    const float cw0 = P.conv_w[0 * LW + chc], cw1 = P.conv_w[1 * LW + chc], cw2 = P.conv_w[2 * LW + chc], cw3 = P.conv_w[3 * LW + chc], cbv = P.conv_b[chc];
    const int chd = nb * 64 + 32 * cg + r;
    const float br = -LOG2E * P.b_r[chd], bi = -LOG2E * P.b_i[chd];
    const float ls8 = -8.0f * log1pf(expf(-P.lam[chd])) * LOG2E;
    float state = 0.f;
    v4u px[5], pg[2];
#define LRU_PREFETCH(tl) do { \
        _Pragma("unroll") for (int it = 0; it < 5; ++it) { const int cid = it * 64 + lane; px[it] = (v4u){0u, 0u, 0u, 0u}; \
            if (cid < 35 * 8) { const int j = cid >> 3, ch = cid & 7, t = 32 * wave + j - 3; bool valid; size_t row = 0; \
                if ((tl) == 0) { valid = (t >= 0 && t < NMETA); row = (size_t)MREAL + t; } \
                else if ((tl) == 1 && t < 0) { valid = true; row = (size_t)MREAL + NMETA + t; } \
                else { valid = true; row = (size_t)b * SEQ + 256 * ((tl) - 1) + t; } \
                if (valid) px[it] = *(const GAS v4u*)(XBB + row * 1024 + nb * 64 + ch * 8); } } \
        if ((tl) > 0) { _Pragma("unroll") for (int it = 0; it < 2; ++it) { const int cid = it * 64 + lane, t = 32 * wave + (cid >> 2), ch = cid & 3; \
            pg[it] = *(const GAS v4u*)(GTB + ((size_t)b * SEQ + 256 * ((tl) - 1) + t) * 1024 + nb * 64 + 32 * cg + ch * 8); } } } while (0)
    LRU_PREFETCH(0);
    __syncthreads();
    for (int tile = 0; tile < 9; ++tile) {
#pragma unroll
        for (int it = 0; it < 5; ++it) { const int cid = it * 64 + lane; if (cid < 35 * 8) *(LAS v4u*)(lw + LW_XS + (cid >> 3) * 128 + (cid & 7) * 16) = px[it]; }
        if (tile > 0) {
#pragma unroll
            for (int it = 0; it < 2; ++it) { const int cid = it * 64 + lane; *(LAS v4u*)(lw + LW_GS + (cid >> 2) * 64 + (cid & 3) * 16) = pg[it]; }
        }
        asm volatile("s_waitcnt lgkmcnt(0)" ::: "memory");
        if (tile + 1 < 9) LRU_PREFETCH(tile + 1);
        {
            const LAS unsigned short* xs = (const LAS unsigned short*)(lw + LW_XS);
            LAS unsigned short* xc = (LAS unsigned short*)(lw + LW_XC);
            LAS float* xcf = (LAS float*)(lw + LW_XCF);
            const bool own = (cc >> 5) == cg; const int xoff = own ? (cc & 31) : 32 * 32 + (cc & 31);
            float x0 = bf2f(xs[0 * 64 + cc]), x1 = bf2f(xs[1 * 64 + cc]), x2 = bf2f(xs[2 * 64 + cc]);
#pragma unroll 8
            for (int k = 0; k < 32; ++k) {
                const float x3 = bf2f(xs[(k + 3) * 64 + cc]);
                const float v = cbv + cw0 * x0 + cw1 * x1 + cw2 * x2 + cw3 * x3;
                xc[k * 72 + cc] = (unsigned short)cvtpk(v, v);
                xcf[(own ? k * 32 : 0) + xoff] = v;
                x0 = x1; x1 = x2; x2 = x3;
            }
        }
        asm volatile("s_waitcnt lgkmcnt(0)" ::: "memory");
        f32x16 aR = {br, br, br, br, br, br, br, br, br, br, br, br, br, br, br, br}, aI = {bi, bi, bi, bi, bi, bi, bi, bi, bi, bi, bi, bi, bi, bi, bi, bi};
#pragma unroll
        for (int ks = 0; ks < 4; ++ks) {
            const bf16x8 xa = *(const LAS bf16x8*)(lw + LW_XC + r * 144 + ks * 32 + hi * 16);
            const bf16x8 wr_ = *(const LAS bf16x8*)(ldsw + r * 144 + ks * 32 + hi * 16);
            const bf16x8 wi_ = *(const LAS bf16x8*)(ldsw + 32 * 144 + r * 144 + ks * 32 + hi * 16);
            aR = __builtin_amdgcn_mfma_f32_32x32x16_bf16(xa, wr_, aR, 0, 0, 0);
            aI = __builtin_amdgcn_mfma_f32_32x32x16_bf16(xa, wi_, aI, 0, 0, 0);
        }
        float Av[16], Bv[16];
        {
            const LAS float* xcf = (const LAS float*)(lw + LW_XCF);
#pragma unroll
            for (int reg = 0; reg < 16; ++reg) {
                const int tl = crow(reg, hi), t = 32 * wave + tl;
                const bool valid = (tile > 0) || (t < NMETA);
                const float rg = rcp(1.0f + ex2(aR[reg]));
                const float ig = rcp(1.0f + ex2(aI[reg]));
                const float a = ex2(rg * ls8);
                const float mult = __builtin_amdgcn_sqrtf(fmaxf(1.0f - a * a, 0.f));
                const float bx = mult * ig * xcf[tl * 32 + r];
                Av[reg] = valid ? a : 1.0f; Bv[reg] = valid ? bx : 0.0f;
            }
        }
#pragma unroll
        for (int g = 0; g < 4; ++g) {
#pragma unroll
            for (int k = 1; k < 4; ++k) { Bv[4 * g + k] = Av[4 * g + k] * Bv[4 * g + k - 1] + Bv[4 * g + k]; Av[4 * g + k] = Av[4 * g + k] * Av[4 * g + k - 1]; }
        }
        float myCz[4], myCp[4], PW, HW;
        {
            float cz = 0.f, cp = 1.f;
#pragma unroll
            for (int g = 0; g < 4; ++g) {
                const float mP = Av[4 * g + 3], mH = Bv[4 * g + 3];
                const float oP = __shfl_xor(mP, 32), oH = __shfl_xor(mH, 32);
                const float eP = hi ? oP : mP, eH = hi ? oH : mH, dP = hi ? mP : oP, dH = hi ? mH : oH;
                const float cz0 = cz, cp0 = cp;
                cz = eP * cz + eH; cp = cp * eP;
                myCz[g] = hi ? cz : cz0; myCp[g] = hi ? cp : cp0;
                cz = dP * cz + dH; cp = cp * dP;
            }
            PW = cp; HW = cz;
        }
        LAS float* ct = (LAS float*)(lds + L_CT + (tile & 1) * 2048);
        if (hi == 0) { ct[(wave * 32 + r) * 2] = PW; ct[(wave * 32 + r) * 2 + 1] = HW; }
        __syncthreads();
        float cin = 0.f;
        {
            float c = state;
#pragma unroll
            for (int w2 = 0; w2 < 8; ++w2) { if (w2 == wave) cin = c; c = ct[(w2 * 32 + r) * 2] * c + ct[(w2 * 32 + r) * 2 + 1]; }
            state = c;
        }
        if (tile > 0) {
            const LAS unsigned short* gs = (const LAS unsigned short*)(lw + LW_GS);
            LAS unsigned short* os = (LAS unsigned short*)(lw + LW_XS);
#pragma unroll
            for (int reg = 0; reg < 16; ++reg) {
                const int g = reg >> 2, tl = crow(reg, hi);
                const float h = Bv[reg] + Av[reg] * (myCz[g] + myCp[g] * cin);
                const float gt = bf2f(gs[tl * 32 + r]);
                { const float ov = gelu_fast(gt) * h; os[tl * 32 + r] = (unsigned short)cvtpk(ov, ov); }
            }
            asm volatile("s_waitcnt lgkmcnt(0)" ::: "memory");
#pragma unroll
            for (int it = 0; it < 2; ++it) {
                const int cid = it * 64 + lane, tl = cid >> 2, ch = cid & 3;
                const v4u v = *(const LAS v4u*)(lw + LW_XS + tl * 64 + ch * 16);
                float ss = 0.f;
#pragma unroll
                for (int k = 0; k < 4; ++k) { const float a = __builtin_bit_cast(float, v[k] << 16), c = __builtin_bit_cast(float, v[k] & 0xffff0000u); ss += a * a + c * c; }
                ss = sum4(ss);
                const size_t row = (size_t)b * SEQ + 256 * (tile - 1) + 32 * wave + tl;
                *(GAS v4u*)(MIX + row * D + 1024 + nb * 64 + 32 * cg + ch * 8) = v;
                if (ch == 0) SSL[row * 32 + nb * 2 + cg] = ss;
            }
            asm volatile("s_waitcnt lgkmcnt(0)" ::: "memory");
        }
    }
#undef LRU_PREFETCH
    __syncthreads();
}
}

namespace p5 {
typedef float f32x16 __attribute__((ext_vector_type(16)));
constexpr int KP = 272;
constexpr int R_KEYS = 0, R_IDX = 256 * KP, R_END = R_IDX + 8 * 1024;
__device__ __forceinline__ int crow(int r, int hi) { return (r & 3) + 8 * (r >> 2) + 4 * hi; }
__device__ __forceinline__ float fkey(float s, int mask, int payload) { return __builtin_bit_cast(float, (__builtin_bit_cast(int, s) & mask) | payload); }
__device__ __forceinline__ int fbits(float f) { return __builtin_bit_cast(int, f); }
__device__ __forceinline__ float fval(float f, int mask) { return __builtin_bit_cast(float, __builtin_bit_cast(int, f) & mask); }
__device__ __forceinline__ void ins16(float (&L)[16], float v) {
#pragma unroll
    for (int k = 15; k >= 1; --k) L[k] = __builtin_amdgcn_fmed3f(L[k - 1], L[k], v);
    L[0] = fmaxf(L[0], v);
}
#define P5_CE(a, b) do { const float hi_ = fmaxf(a, b), lo_ = fminf(a, b); a = hi_; b = lo_; } while (0)
#define P5_SORT16(X) do { P5_CE(X[0], X[1]); P5_CE(X[2], X[3]); P5_CE(X[0], X[2]); P5_CE(X[1], X[3]); P5_CE(X[1], X[2]); P5_CE(X[4], X[5]); P5_CE(X[6], X[7]); P5_CE(X[4], X[6]); P5_CE(X[5], X[7]); P5_CE(X[5], X[6]); P5_CE(X[0], X[4]); P5_CE(X[2], X[6]); P5_CE(X[2], X[4]); P5_CE(X[1], X[5]); P5_CE(X[3], X[7]); P5_CE(X[3], X[5]); P5_CE(X[1], X[2]); P5_CE(X[3], X[4]); P5_CE(X[5], X[6]); P5_CE(X[8], X[9]); P5_CE(X[10], X[11]); P5_CE(X[8], X[10]); P5_CE(X[9], X[11]); P5_CE(X[9], X[10]); P5_CE(X[12], X[13]); P5_CE(X[14], X[15]); P5_CE(X[12], X[14]); P5_CE(X[13], X[15]); P5_CE(X[13], X[14]); P5_CE(X[8], X[12]); P5_CE(X[10], X[14]); P5_CE(X[10], X[12]); P5_CE(X[9], X[13]); P5_CE(X[11], X[15]); P5_CE(X[11], X[13]); P5_CE(X[9], X[10]); P5_CE(X[11], X[12]); P5_CE(X[13], X[14]); P5_CE(X[0], X[8]); P5_CE(X[4], X[12]); P5_CE(X[4], X[8]); P5_CE(X[2], X[10]); P5_CE(X[6], X[14]); P5_CE(X[6], X[10]); P5_CE(X[2], X[4]); P5_CE(X[6], X[8]); P5_CE(X[10], X[12]); P5_CE(X[1], X[9]); P5_CE(X[5], X[13]); P5_CE(X[5], X[9]); P5_CE(X[3], X[11]); P5_CE(X[7], X[15]); P5_CE(X[7], X[11]); P5_CE(X[3], X[5]); P5_CE(X[7], X[9]); P5_CE(X[11], X[13]); P5_CE(X[1], X[2]); P5_CE(X[3], X[4]); P5_CE(X[5], X[6]); P5_CE(X[7], X[8]); P5_CE(X[9], X[10]); P5_CE(X[11], X[12]); P5_CE(X[13], X[14]); } while (0)
#define P5_BMERGE16(X) do { P5_CE(X[0], X[8]); P5_CE(X[1], X[9]); P5_CE(X[2], X[10]); P5_CE(X[3], X[11]); P5_CE(X[4], X[12]); P5_CE(X[5], X[13]); P5_CE(X[6], X[14]); P5_CE(X[7], X[15]); P5_CE(X[0], X[4]); P5_CE(X[1], X[5]); P5_CE(X[2], X[6]); P5_CE(X[3], X[7]); P5_CE(X[8], X[12]); P5_CE(X[9], X[13]); P5_CE(X[10], X[14]); P5_CE(X[11], X[15]); P5_CE(X[0], X[2]); P5_CE(X[1], X[3]); P5_CE(X[4], X[6]); P5_CE(X[5], X[7]); P5_CE(X[8], X[10]); P5_CE(X[9], X[11]); P5_CE(X[12], X[14]); P5_CE(X[13], X[15]); P5_CE(X[0], X[1]); P5_CE(X[2], X[3]); P5_CE(X[4], X[5]); P5_CE(X[6], X[7]); P5_CE(X[8], X[9]); P5_CE(X[10], X[11]); P5_CE(X[12], X[13]); P5_CE(X[14], X[15]); } while (0)
#define P5_TOP16(A, B) do { _Pragma("unroll") for (int i_ = 0; i_ < 16; ++i_) A[i_] = fmaxf(A[i_], B[15 - i_]); P5_BMERGE16(A); } while (0)
#define P5_KEYS(G, ACC, KT) do { _Pragma("unroll") for (int reg = 0; reg < 16; ++reg) G[reg] = fkey(ACC[reg], (int)0xffffff80, (127 - 32 * (KT) - (reg & 3) - 8 * (reg >> 2)) - h4); } while (0)
__device__ __forceinline__ void score_tile(f32x16& acc, const LAS unsigned char* keys, const bf16x8 (&qf)[8], int kt, int r, int hi) {
    acc = (f32x16){0.f, 0.f, 0.f, 0.f, 0.f, 0.f, 0.f, 0.f, 0.f, 0.f, 0.f, 0.f, 0.f, 0.f, 0.f, 0.f};
#pragma unroll
    for (int ks = 0; ks < 8; ++ks) {
        const bf16x8 kf = *(const LAS bf16x8*)(keys + (kt * 32 + r) * KP + ks * 32 + hi * 16);
        acc = __builtin_amdgcn_mfma_f32_32x32x16_bf16(kf, qf[ks], acc, 0, 0, 0);
    }
}
__device__ __forceinline__ void half_top16(const LAS unsigned char* keys, const bf16x8 (&qf)[8], int r, int hi, float (&T)[16]) {
    const int h4 = 4 * hi;
    f32x16 acc;
    float A[16], B[16];
    score_tile(acc, keys, qf, 0, r, hi); P5_KEYS(A, acc, 0); P5_SORT16(A);
    score_tile(acc, keys, qf, 1, r, hi); P5_KEYS(B, acc, 1); P5_SORT16(B);
    P5_TOP16(A, B);
    float C[16];
    score_tile(acc, keys, qf, 2, r, hi); P5_KEYS(C, acc, 2); P5_SORT16(C);
    score_tile(acc, keys, qf, 3, r, hi); P5_KEYS(B, acc, 3); P5_SORT16(B);
    P5_TOP16(C, B);
    P5_TOP16(A, C);
#pragma unroll
    for (int i = 0; i < 16; ++i) B[i] = __shfl_xor(A[15 - i], 32);
#pragma unroll
    for (int i = 0; i < 16; ++i) A[i] = fmaxf(A[i], B[i]);
    P5_BMERGE16(A);
#pragma unroll
    for (int i = 0; i < 16; ++i) T[i] = A[i];
}

__device__ __forceinline__ void retr_unit(LAS unsigned char* lds, int h, int tg, const bf16* QPB, const bf16* SKB, unsigned short* IDS, float* GW, const float* RSTD2, int tid) {
    const int lane = tid & 63, wave = __builtin_amdgcn_readfirstlane(tid >> 6), r = lane & 31, hi = lane >> 5;
#pragma unroll
    for (int it = 0; it < 8; ++it) {
        const int cid = it * 512 + tid, row = cid >> 4, ch = cid & 15;
        *(LAS v4u*)(lds + R_KEYS + row * KP + ch * 16) = *(const GAS v4u*)(SKB + ((size_t)h * 256 + row) * 128 + ch * 8);
    }
    const size_t tok = (size_t)tg * 256 + wave * 32 + r;
    bf16x8 qa[8], qb[8];
#pragma unroll
    for (int ks = 0; ks < 8; ++ks) { qa[ks] = *(const GAS bf16x8*)(QPB + tok * D + h * 256 + ks * 16 + hi * 8); qb[ks] = *(const GAS bf16x8*)(QPB + tok * D + h * 256 + 128 + ks * 16 + hi * 8); }
    const float rs = RSTD2[tok];
    __syncthreads();
    float TA[16], TB[16];
    half_top16(lds + R_KEYS, qa, r, hi, TA);
    half_top16(lds + R_KEYS + 128 * KP, qb, r, hi, TB);
    LAS unsigned char* sc = lds + R_IDX + wave * 1024 + r * 32;
    const int hm = -hi;
    {
        v4u w;
#pragma unroll
        for (int q = 0; q < 4; ++q) { unsigned x = 0;
#pragma unroll
            for (int k = 0; k < 4; ++k) { const int t = (fbits(TB[4 * q + k]) & hm) | (fbits(TA[4 * q + k]) & ~hm); x |= (unsigned)(127 - (t & 0x7f)) << (8 * k); }
            w[q] = x; }
        *(LAS v4u*)(sc + hi * 16) = w;
    }
    float sA[16], sB[16];
#pragma unroll
    for (int i = 0; i < 16; ++i) { sA[i] = fval(TA[i], (int)0xffffff80); sB[i] = fval(TB[i], (int)0xffffff80); }
#define P5_K(i, j) fkey(sA[i] + sB[j], (int)0xffffff00, 255 - ((i) * 16 + (j)))
    float L[16], X[16];
#pragma unroll
    for (int j = 0; j < 16; ++j) L[j] = P5_K(0, j);
#pragma unroll
    for (int j = 0; j < 8; ++j) { X[j] = P5_K(1, j); X[8 + j] = P5_K(15 - j, 0); }
    P5_BMERGE16(X);
    P5_TOP16(L, X);
    X[0] = P5_K(2, 0); X[1] = P5_K(2, 1); X[2] = P5_K(2, 2); X[3] = P5_K(2, 3); X[4] = P5_K(2, 4);
    X[5] = P5_K(3, 0); X[6] = P5_K(3, 1); X[7] = P5_K(3, 2); X[8] = P5_K(3, 3);
    X[9] = P5_K(4, 0); X[10] = P5_K(4, 1); X[11] = P5_K(4, 2);
    X[12] = P5_K(5, 0); X[13] = P5_K(5, 1); X[14] = P5_K(6, 0); X[15] = P5_K(6, 1);
    P5_SORT16(X);
    P5_TOP16(L, X);
    ins16(L, P5_K(7, 0)); ins16(L, P5_K(7, 1));
#undef P5_K
    const float v0 = fval(L[0], (int)0xffffff00);
    asm volatile("s_waitcnt lgkmcnt(0)" ::: "memory");
    int ex[8]; float ew[8]; float esum = 0.f;
#pragma unroll
    for (int k = 0; k < 8; ++k) {
        const int t = (fbits(L[8 + k]) & hm) | (fbits(L[k]) & ~hm);
        const int c = 255 - (t & 0xff);
        const int ia = sc[c >> 4], ib = sc[16 + (c & 15)];
        ex[k] = ia * 128 + ib;
        const float e = __builtin_amdgcn_exp2f((__builtin_bit_cast(float, t & (int)0xffffff00) - v0) * rs * 1.4426950408889634f);
        ew[k] = e; esum += e;
    }
    esum = sum_x32(esum);
    const float inv = 1.0f / esum;
    unsigned short* ip = IDS + tok * 128 + h * 16 + hi * 8; float* gp = GW + tok * 128 + h * 16 + hi * 8;
    *(GAS v4u*)(ip) = (v4u){(unsigned)ex[0] | ((unsigned)ex[1] << 16), (unsigned)ex[2] | ((unsigned)ex[3] << 16), (unsigned)ex[4] | ((unsigned)ex[5] << 16), (unsigned)ex[6] | ((unsigned)ex[7] << 16)};
    *(GAS f32x4*)(gp) = (f32x4){ew[0] * inv, ew[1] * inv, ew[2] * inv, ew[3] * inv};
    *(GAS f32x4*)(gp + 4) = (f32x4){ew[4] * inv, ew[5] * inv, ew[6] * inv, ew[7] * inv};
    __syncthreads();
}
}

namespace p6 {
__device__ __forceinline__ float blo(unsigned w) { return __builtin_bit_cast(float, w << 16); }
__device__ __forceinline__ float bhi(unsigned w) { return __builtin_bit_cast(float, w & 0xffff0000u); }
__device__ __forceinline__ float gelu_fast(float x) { return x * __builtin_amdgcn_rcpf(1.0f + __builtin_amdgcn_exp2f(-2.302208198f * x * (1.0f + 0.044715f * x * x))); }
__device__ __forceinline__ unsigned idw(const v4u& a, const v4u& b, int g) { const unsigned w = g < 8 ? a[(g & 7) >> 1] : b[(g & 7) >> 1]; return (g & 1) ? (w >> 16) : (w & 0xffffu); }
__device__ __forceinline__ unsigned q4(float a, float b, float c, float d, float inv, int bias) {
    const int qa = (int)rintf(a * inv) + bias, qb = (int)rintf(b * inv) + bias, qc = (int)rintf(c * inv) + bias, qd = (int)rintf(d * inv) + bias;
    return (unsigned)(qa & 0xff) | ((unsigned)(qb & 0xff) << 8) | ((unsigned)(qc & 0xff) << 16) | ((unsigned)(qd & 0xff) << 24);
}
__device__ __forceinline__ void qrow_load(f32x4 (&v)[8], const float* src, size_t e, int lane) {
#pragma unroll
    for (int j = 0; j < 8; ++j) v[j] = __builtin_nontemporal_load((const GAS f32x4*)(src + e * D + j * 256 + lane * 4));
}
__device__ __forceinline__ void qrow_finish(f32x4 (&v)[8], const float* gcol, unsigned char* dst, float* scale_out, size_t e, int lane) {
    float am = 0.f;
#pragma unroll
    for (int j = 0; j < 8; ++j) {
        if (gcol) { const f32x4 g = *(const GAS f32x4*)(gcol + j * 256 + lane * 4); v[j] = v[j] * g; }
        am = fmaxf(am, fmaxf(fmaxf(fabsf(v[j].x), fabsf(v[j].y)), fmaxf(fabsf(v[j].z), fabsf(v[j].w))));
    }
    am = max64(am);
    const float inv = am > 0.f ? 127.0f / am : 0.f;
#pragma unroll
    for (int j = 0; j < 8; ++j)
        *(GAS unsigned*)(dst + ((size_t)(2 * j + (lane >> 5)) * 16384 + e) * 128 + (lane & 31) * 4) = q4(v[j].x, v[j].y, v[j].z, v[j].w, inv, 0);
    if (lane == 0) scale_out[e] = am * (1.0f / 127.0f);
}
__device__ __forceinline__ void qx_load(v4u (&x)[4], const bf16* H1B, size_t tok, int lane) {
#pragma unroll
    for (int j = 0; j < 4; ++j) x[j] = *(const GAS v4u*)(H1B + tok * D + j * 512 + lane * 8);
}
__device__ __forceinline__ void qx_finish(const v4u (&x)[4], unsigned char* X8, float* SX, size_t tok, int lane) {
#pragma unroll
    for (int j = 0; j < 4; ++j) {
        float f[8]; float am = 0.f;
#pragma unroll
        for (int k = 0; k < 4; ++k) { f[2 * k] = blo(x[j][k]); f[2 * k + 1] = bhi(x[j][k]); am = fmaxf(am, fmaxf(fabsf(f[2 * k]), fabsf(f[2 * k + 1]))); }
        am = max16(am);
        const float inv = am > 0.f ? 127.0f / am : 0.f;
        typedef unsigned u32x2v __attribute__((ext_vector_type(2)));
        u32x2v o; o.x = q4(f[0], f[1], f[2], f[3], inv, 0); o.y = q4(f[4], f[5], f[6], f[7], inv, 0);
        *(GAS u32x2v*)(X8 + tok * D + j * 512 + lane * 8) = o;
        if ((lane & 15) == 0) SX[tok * 16 + 4 * j + (lane >> 4)] = am * (1.0f / 127.0f);
    }
}

typedef int i32x16 __attribute__((ext_vector_type(16)));
typedef float f32x16v __attribute__((ext_vector_type(16)));
__device__ __forceinline__ int seli(int m, int a, int b) { return (a & m) | (b & ~m); }
__device__ __forceinline__ float self(int m, float a, float b) { return __builtin_bit_cast(float, seli(m, __builtin_bit_cast(int, a), __builtin_bit_cast(int, b))); }
__device__ __forceinline__ void usweep(const unsigned char* X8, const float* SX, const unsigned char* U8, const unsigned short* IDS, bf16* PART, LAS unsigned char* lds, int slot, int rank, int nrank, int wave, int lane) {
    const int ps = lane >> 3, ch = lane & 7;
    const int first = rank * 8 + wave, stride = nrank * 8;
    const int n = first < MREAL ? (MREAL - first + stride - 1) / stride : 0, NQ = 2 * n;
    if (NQ == 0) return;
    const int m4 = -((lane >> 2) & 1), m2 = -((lane >> 1) & 1), m1 = -(lane & 1);
    LAS unsigned char* sl = lds + wave * 1024;
#define U_LOAD(q_, RI, RX, SX_, T_, SG_) do { const int qq_ = (q_) < NQ ? (q_) : NQ - 1; const int rd_ = qq_ >= n ? 1 : 0; T_ = first + (qq_ - rd_ * n) * stride; SG_ = rd_ * 8 + slot; \
        RI = *(const GAS unsigned*)(IDS + (size_t)T_ * 128 + lane * 2); RX = *(const GAS unsigned*)(X8 + (size_t)T_ * D + SG_ * 128 + (lane & 31) * 4); SX_ = SX[(size_t)T_ * 16 + SG_]; } while (0)
#define U_EXPAND(SLOT, RI, RX, I0, I1, XV) do { LAS unsigned char* s_ = sl + (SLOT) * 512; \
        *(LAS unsigned*)(s_ + lane * 4) = RI; if (lane < 32) *(LAS unsigned*)(s_ + 256 + lane * 4) = RX; \
        asm volatile("s_waitcnt lgkmcnt(0)" ::: "memory"); \
        I0 = *(const LAS v4u*)(s_ + ps * 32); I1 = *(const LAS v4u*)(s_ + ps * 32 + 16); XV = *(const LAS v4u*)(s_ + 256 + ch * 16); } while (0)
#define U_ISSUE(BUF, I0, I1, SG_) do { const unsigned char* tab_ = U8 + (size_t)(SG_) * 16384 * 128 + ch * 16; \
        _Pragma("unroll") for (int g = 0; g < 16; ++g) BUF[g] = *(const GAS v4u*)(tab_ + (size_t)idw(I0, I1, g) * 128); } while (0)
#define U_FINISH(BUF, XV, SX_, T_, SG_) do { i32x16 d; \
        _Pragma("unroll") for (int g = 0; g < 16; ++g) { int a_ = __builtin_amdgcn_sdot4((int)BUF[g][0], (int)XV[0], 0, false); a_ = __builtin_amdgcn_sdot4((int)BUF[g][1], (int)XV[1], a_, false); \
            a_ = __builtin_amdgcn_sdot4((int)BUF[g][2], (int)XV[2], a_, false); a_ = __builtin_amdgcn_sdot4((int)BUF[g][3], (int)XV[3], a_, false); d[g] = a_; } \
        int r8[8], r4[4], r2[2]; \
        _Pragma("unroll") for (int k = 0; k < 8; ++k) r8[k] = seli(m4, d[8 + k], d[k]) + dpp_hm(seli(m4, d[k], d[8 + k])); \
        _Pragma("unroll") for (int k = 0; k < 4; ++k) r4[k] = seli(m2, r8[4 + k], r8[k]) + dpp_x2(seli(m2, r8[k], r8[4 + k])); \
        _Pragma("unroll") for (int k = 0; k < 2; ++k) r2[k] = seli(m1, r4[2 + k], r4[k]) + dpp_x1(seli(m1, r4[k], r4[2 + k])); \
        *(GAS unsigned*)(PART + ((size_t)(SG_) * MREAL + T_) * 128 + ps * 16 + 2 * ch) = pk2((float)r2[0] * SX_, (float)r2[1] * SX_); } while (0)
    v4u bufA[16], bufB[16];
    v4u a0, a1, ax, b0, b1, bx; unsigned ri, rx; float as, bs, cs; int at, bt, ct, ag, bg, cg;
    U_LOAD(0, ri, rx, as, at, ag); U_EXPAND(0, ri, rx, a0, a1, ax);
    U_LOAD(1, ri, rx, bs, bt, bg); U_EXPAND(1, ri, rx, b0, b1, bx);
    U_ISSUE(bufA, a0, a1, ag);
    for (int q = 0; q < NQ; q += 2) {
        U_ISSUE(bufB, b0, b1, bg);
        U_LOAD(q + 2, ri, rx, cs, ct, cg);
        U_FINISH(bufA, ax, as, at, ag);
        U_EXPAND(0, ri, rx, a0, a1, ax); as = cs; at = ct; ag = cg;
        U_ISSUE(bufA, a0, a1, ag);
        U_LOAD(q + 3, ri, rx, cs, ct, cg);
        U_FINISH(bufB, bx, bs, bt, bg);
        U_EXPAND(1, ri, rx, b0, b1, bx); bs = cs; bt = ct; bg = cg;
    }
#undef U_LOAD
#undef U_EXPAND
#undef U_ISSUE
#undef U_FINISH
}
__device__ __forceinline__ void wreduce(const bf16* PART, const float* GW, const float* RSTD2, const unsigned short* IDS, const float* SCU, const float* SCV, unsigned char* W8, float* WS8, size_t gt, size_t NT) {
    for (size_t i8 = gt; i8 < (size_t)MREAL * 128 / 8; i8 += NT) {
        float s[8];
#pragma unroll
        for (int k = 0; k < 8; ++k) s[k] = 0.f;
#pragma unroll 8
        for (int sg = 0; sg < 16; ++sg) {
            const v4u p = *(const GAS v4u*)(PART + (size_t)sg * MREAL * 128 + i8 * 8);
#pragma unroll
            for (int k = 0; k < 4; ++k) { s[2 * k] += blo(p[k]); s[2 * k + 1] += bhi(p[k]); }
        }
        const float rs = RSTD2[i8 >> 4];
        const v4u idv = *(const GAS v4u*)(IDS + i8 * 8);
        const f32x4 g0 = *(const GAS f32x4*)(GW + i8 * 8), g1 = *(const GAS f32x4*)(GW + i8 * 8 + 4);
        float w[8]; float am = 0.f;
#pragma unroll
        for (int k = 0; k < 8; ++k) {
            const unsigned e = (k & 1) ? (idv[k >> 1] >> 16) : (idv[k >> 1] & 0xffffu);
            const float g = k < 4 ? g0[k & 3] : g1[k & 3];
            w[k] = g * gelu_fast(rs * SCU[e] * s[k]) * SCV[e]; am = fmaxf(am, fabsf(w[k]));
        }
        am = max16(am);
        const float inv = am > 0.f ? 127.0f / am : 0.f;
        typedef unsigned u32x2v __attribute__((ext_vector_type(2)));
        u32x2v o; o.x = q4(w[0], w[1], w[2], w[3], inv, 0); o.y = q4(w[4], w[5], w[6], w[7], inv, 0);
        *(GAS u32x2v*)(W8 + i8 * 8) = o;
        if ((i8 & 15) == 0) WS8[i8 >> 4] = am * (1.0f / 127.0f);
    }
}
__device__ __forceinline__ void vsweep(const bf16* H1B, const unsigned char* V8, const unsigned short* IDS, const unsigned char* W8, const float* WS8, bf16* Z, LAS unsigned char* lds, int slot, int rank, int nrank, int wave, int lane) {
    const int ps = lane >> 3, ch = lane & 7;
    const int first = rank * 8 + wave, stride = nrank * 8;
    const int n = first < MREAL ? (MREAL - first + stride - 1) / stride : 0, NQ = 2 * n;
    if (NQ == 0) return;
    const int m8 = -((lane >> 3) & 1);
    LAS unsigned char* sl = lds + wave * 1024;
#define V_LOAD(q_, RI, RW, WSC, HX, T_, SG_) do { const int qq_ = (q_) < NQ ? (q_) : NQ - 1; const int rd_ = qq_ >= n ? 1 : 0; T_ = first + (qq_ - rd_ * n) * stride; SG_ = rd_ * 8 + slot; \
        RI = *(const GAS unsigned*)(IDS + (size_t)T_ * 128 + lane * 2); RW = *(const GAS unsigned*)(W8 + (size_t)T_ * 128 + (lane & 31) * 4); WSC = WS8[T_]; \
        HX = 0u; } while (0)
#define V_EXPAND(SLOT, RI, RW, I0, I1, WQ) do { LAS unsigned char* s_ = sl + (SLOT) * 512; \
        *(LAS unsigned*)(s_ + lane * 4) = RI; if (lane < 32) *(LAS unsigned*)(s_ + 256 + lane * 4) = RW; \
        asm volatile("s_waitcnt lgkmcnt(0)" ::: "memory"); \
        I0 = *(const LAS v4u*)(s_ + ps * 32); I1 = *(const LAS v4u*)(s_ + ps * 32 + 16); WQ = *(const LAS v4u*)(s_ + 256 + ps * 16); } while (0)
#define V_ISSUE(BUF, I0, I1, SG_) do { const unsigned char* tab_ = V8 + (size_t)(SG_) * 16384 * 128 + ch * 16; \
        _Pragma("unroll") for (int g = 0; g < 16; ++g) BUF[g] = *(const GAS v4u*)(tab_ + (size_t)idw(I0, I1, g) * 128); } while (0)
#define V_FINISH(BUF, WQ, WSC, HX, T_, SG_) do { i32x16 acc = {0, 0, 0, 0, 0, 0, 0, 0, 0, 0, 0, 0, 0, 0, 0, 0}; const unsigned hx_ = HX; \
        _Pragma("unroll") for (int j = 0; j < 4; ++j) { const int wq_ = (int)WQ[j]; \
            _Pragma("unroll") for (int k = 0; k < 4; ++k) { \
                const unsigned d0_ = BUF[4 * j][k], d1_ = BUF[4 * j + 1][k], d2_ = BUF[4 * j + 2][k], d3_ = BUF[4 * j + 3][k]; \
                const unsigned p0_ = __builtin_amdgcn_perm(d1_, d0_, 0x05010400u), p1_ = __builtin_amdgcn_perm(d1_, d0_, 0x07030602u); \
                const unsigned q0_ = __builtin_amdgcn_perm(d3_, d2_, 0x05010400u), q1_ = __builtin_amdgcn_perm(d3_, d2_, 0x07030602u); \
                acc[4 * k + 0] = __builtin_amdgcn_sdot4((int)__builtin_amdgcn_perm(q0_, p0_, 0x05040100u), wq_, acc[4 * k + 0], false); \
                acc[4 * k + 1] = __builtin_amdgcn_sdot4((int)__builtin_amdgcn_perm(q0_, p0_, 0x07060302u), wq_, acc[4 * k + 1], false); \
                acc[4 * k + 2] = __builtin_amdgcn_sdot4((int)__builtin_amdgcn_perm(q1_, p1_, 0x05040100u), wq_, acc[4 * k + 2], false); \
                acc[4 * k + 3] = __builtin_amdgcn_sdot4((int)__builtin_amdgcn_perm(q1_, p1_, 0x07060302u), wq_, acc[4 * k + 3], false); } } \
        int r8[8], r4[4], r2[2]; \
        _Pragma("unroll") for (int k = 0; k < 8; ++k) { const auto rr_ = __builtin_amdgcn_permlane32_swap((unsigned)acc[k], (unsigned)acc[8 + k], false, false); r8[k] = (int)rr_[0] + (int)rr_[1]; } \
        _Pragma("unroll") for (int k = 0; k < 4; ++k) { const auto rr_ = __builtin_amdgcn_permlane16_swap((unsigned)r8[k], (unsigned)r8[4 + k], false, false); r4[k] = (int)rr_[0] + (int)rr_[1]; } \
        _Pragma("unroll") for (int k = 0; k < 2; ++k) r2[k] = seli(m8, r4[2 + k], r4[k]) + dpp_r8(seli(m8, r4[k], r4[2 + k])); \
        const float z0_ = (float)r2[0] * WSC + blo(hx_), z1_ = (float)r2[1] * WSC + bhi(hx_); \
        *(GAS unsigned*)(Z + (size_t)T_ * D + (SG_) * 128 + ch * 16 + 2 * ps) = pk2(z0_, z1_); } while (0)
    v4u bufA[16], bufB[16];
    v4u a0, a1, aw, b0, b1, bw; unsigned ri, rw, ah, bh, chx; float as, bs, cs; int at, bt, ct, ag, bg, cg;
    V_LOAD(0, ri, rw, as, ah, at, ag); V_EXPAND(0, ri, rw, a0, a1, aw);
    V_LOAD(1, ri, rw, bs, bh, bt, bg); V_EXPAND(1, ri, rw, b0, b1, bw);
    V_ISSUE(bufA, a0, a1, ag);
    for (int q = 0; q < NQ; q += 2) {
        V_ISSUE(bufB, b0, b1, bg);
        V_LOAD(q + 2, ri, rw, cs, chx, ct, cg);
        V_FINISH(bufA, aw, as, ah, at, ag);
        V_EXPAND(0, ri, rw, a0, a1, aw); as = cs; ah = chx; at = ct; ag = cg;
        V_ISSUE(bufA, a0, a1, ag);
        V_LOAD(q + 3, ri, rw, cs, chx, ct, cg);
        V_FINISH(bufB, bw, bs, bh, bt, bg);
        V_EXPAND(1, ri, rw, b0, b1, bw); bs = cs; bh = chx; bt = ct; bg = cg;
    }
#undef V_LOAD
#undef V_EXPAND
#undef V_ISSUE
#undef V_FINISH
}
__device__ __forceinline__ void final_load(v4u (&z)[4], v4u (&h)[4], const bf16* Z, const bf16* H1B, size_t tok, int lane) {
#pragma unroll
    for (int j = 0; j < 4; ++j) { z[j] = __builtin_nontemporal_load((const GAS v4u*)(Z + tok * D + j * 512 + lane * 8)); h[j] = __builtin_nontemporal_load((const GAS v4u*)(H1B + tok * D + j * 512 + lane * 8)); }
}
__device__ __forceinline__ void final_finish(const v4u (&z)[4], const v4u (&h)[4], const float* fg, float* out, size_t tok, int lane) {
    float v[4][8]; float ss = 0.f;
#pragma unroll
    for (int j = 0; j < 4; ++j)
#pragma unroll
        for (int k = 0; k < 4; ++k) { v[j][2 * k] = blo(z[j][k]) + blo(h[j][k]); v[j][2 * k + 1] = bhi(z[j][k]) + bhi(h[j][k]); ss += v[j][2 * k] * v[j][2 * k] + v[j][2 * k + 1] * v[j][2 * k + 1]; }
    ss = sum64(ss);
    const float rf = 1.0f / sqrtf(ss * (1.0f / D) + EPS);
#pragma unroll
    for (int j = 0; j < 4; ++j) {
        const f32x4 ga = *(const GAS f32x4*)(fg + j * 512 + lane * 8), gb = *(const GAS f32x4*)(fg + j * 512 + lane * 8 + 4);
        __builtin_nontemporal_store((f32x4){v[j][0] * rf * ga.x, v[j][1] * rf * ga.y, v[j][2] * rf * ga.z, v[j][3] * rf * ga.w}, (GAS f32x4*)(out + tok * D + j * 512 + lane * 8));
        __builtin_nontemporal_store((f32x4){v[j][4] * rf * gb.x, v[j][5] * rf * gb.y, v[j][6] * rf * gb.z, v[j][7] * rf * gb.w}, (GAS f32x4*)(out + tok * D + j * 512 + lane * 8 + 4));
    }
}
}

struct Frame {
    LAS unsigned char* lds;
    volatile LAS unsigned* MISC;
    gu32* ctl;
    int tid, lane, wave, vcu, G;
};
__device__ __forceinline__ float wave_sum(float v) { return sum64(v); }
__device__ __forceinline__ void p0_transpose_item(const float* W, int K, int N, bf16* WT, const float* g0, const float* g1, int ksplit, LAS float* scr, int item, int lane) {
    const int nblk = N / 32, kb = item / nblk, nb = item % nblk, k0 = 64 * kb, n0 = 32 * nb;
    f32x4 v[8];
#pragma unroll
    for (int i = 0; i < 8; ++i) v[i] = __builtin_nontemporal_load((const GAS f32x4*)(W + (size_t)(k0 + 8 * i + (lane >> 3)) * N + n0 + (lane & 7) * 4));
#pragma unroll
    for (int i = 0; i < 8; ++i) { const int kk = 8 * i + (lane >> 3), kg = k0 + kk; const float gv = kg < ksplit ? g0[kg] : g1[kg - ksplit];
        LAS float* d = scr + kk * 33 + (lane & 7) * 4; d[0] = v[i].x * gv; d[1] = v[i].y * gv; d[2] = v[i].z * gv; d[3] = v[i].w * gv; }
    LDS_WAIT(); asm volatile("" ::: "memory");
    const int c = lane & 7;
#pragma unroll
    for (int j = 0; j < 4; ++j) { const int n = (lane >> 3) + 8 * j; const LAS float* s = scr + (8 * c) * 33 + n;
        v4u o; o.x = pk2(s[0 * 33], s[1 * 33]); o.y = pk2(s[2 * 33], s[3 * 33]); o.z = pk2(s[4 * 33], s[5 * 33]); o.w = pk2(s[6 * 33], s[7 * 33]);
        *(GAS v4u*)(WT + (size_t)(n0 + n) * K + k0 + 8 * c) = o; }
    LDS_WAIT(); asm volatile("" ::: "memory");
}
__device__ __forceinline__ void p0_row_load(f32x4 (&v)[8], const float* xrow, int lane) {
    const GAS f32x4* xr = (const GAS f32x4*)xrow + lane;
#pragma unroll
    for (int j = 0; j < 8; ++j) v[j] = __builtin_nontemporal_load(xr + 64 * j);
}
__device__ __forceinline__ void p0_row_finish(const f32x4 (&v)[8], bf16* orow, float* rstd_out, int lane) {
    float s = 0.f;
#pragma unroll
    for (int j = 0; j < 8; ++j) s += (v[j].x * v[j].x + v[j].y * v[j].y) + (v[j].z * v[j].z + v[j].w * v[j].w);
    s = wave_sum(s);
    GAS unsigned long long* o8 = (GAS unsigned long long*)orow + lane;
#pragma unroll
    for (int j = 0; j < 8; ++j) o8[64 * j] = (unsigned long long)pk2(v[j].x, v[j].y) | ((unsigned long long)pk2(v[j].z, v[j].w) << 32);
    if (lane == 0) *rstd_out = 1.0f / sqrtf(s * (1.0f / D) + EPS);
}
__device__ __forceinline__ void p0_cvt8(const float* src, bf16* dst, const float* gcol, size_t idx8) {
    const f32x4 a = *(const GAS f32x4*)(src + idx8 * 8), b = *(const GAS f32x4*)(src + idx8 * 8 + 4);
    f32x4 ga = {1.f, 1.f, 1.f, 1.f}, gb = {1.f, 1.f, 1.f, 1.f};
    if (gcol) { const int c = (int)((idx8 * 8) & (D - 1)); ga = *(const GAS f32x4*)(gcol + c); gb = *(const GAS f32x4*)(gcol + c + 4); }
    v4u o; o.x = pk2(a.x * ga.x, a.y * ga.y); o.y = pk2(a.z * ga.z, a.w * ga.w); o.z = pk2(b.x * gb.x, b.y * gb.y); o.w = pk2(b.z * gb.z, b.w * gb.w);
    *(GAS v4u*)(dst + idx8 * 8) = o;
}

struct Args { const float* in[22]; float* out; unsigned char* ws; int ph_lo, ph_hi, rep_mask, pad; };

__global__ void __launch_bounds__(NWAVES * 64, 2) fwd(Args args) {
    extern __shared__ __attribute__((aligned(16))) unsigned char lds[];
    Frame F;
    F.lds = (LAS unsigned char*)lds;
    F.MISC = (volatile LAS unsigned*)(F.lds + MISC_OFF);
    F.tid = threadIdx.x; F.lane = F.tid & 63; F.wave = __builtin_amdgcn_readfirstlane(F.tid >> 6);
    F.G = gridDim.x; { const int bx = blockIdx.x; F.vcu = (F.G % 8 == 0) ? (bx % 8) * (F.G / 8) + bx / 8 : bx; }
    unsigned char* ws = args.ws;
    F.ctl = (gu32*)(ws + WS_CTL);
    for (int u = F.tid; u < (LDS_BYTES - LDSCTL_OFF) / 4; u += NWAVES * 64) ((LAS unsigned*)(F.lds + LDSCTL_OFF))[u] = 0u;
    __syncthreads();
    XcdBarrier bar = xcd_barrier_post((unsigned*)(F.ctl + CW_BAR), F.MISC + 8);
    const int lo = args.ph_lo, hi = args.ph_hi;
#define IN(k) (lo <= (k) && (k) < hi)
#define BOTH(k) (IN(k) && IN((k) + 1))
#ifndef PROBE_PH
#define PROBE_PH (-1)
#endif
#define REP(k) for (int rep_ = 0; rep_ < ((k) == PROBE_PH ? 2 : 1); ++rep_)
#define STAMP(i) do { if (PROBE_PH >= 100 && blockIdx.x == 0 && F.tid == 0) ((volatile LAS unsigned long long*)(F.lds + LDSCTL_OFF + 640))[i] = __builtin_amdgcn_s_memrealtime(); } while (0)

    const float* x = args.in[0]; const float* meta = args.in[1]; const float* norm_mix_g = args.in[2]; const float* w_in = args.in[3]; const float* b_in = args.in[4];
    const float* gn_attn_g = args.in[13]; const float* gn_lru_g = args.in[14]; const float* w_out = args.in[15]; const float* norm_ffn_g = args.in[16];
    const float* peer_wq = args.in[17]; const float* sub_keys = args.in[18]; const float* peer_u = args.in[19]; const float* peer_v = args.in[20];
    bf16* W1T = (bf16*)(ws + WS_W1T); bf16* W2T = (bf16*)(ws + WS_W2T); bf16* W3T = (bf16*)(ws + WS_W3T); bf16* SKB = (bf16*)(ws + WS_SKB);
    float* RSTD1 = (float*)(ws + WS_RSTD1);
    unsigned char* U8 = ws + WS_U8; unsigned char* V8 = ws + WS_V8; unsigned char* X8 = ws + WS_X8; float* SX = (float*)(ws + WS_SX); float* SCU = (float*)(ws + WS_SCU); float* SCV = (float*)(ws + WS_SCV);
    bf16* A1 = (bf16*)(ws + WS_A1);
    bf16* QB = (bf16*)(ws + WS_Q); bf16* KVB = (bf16*)(ws + WS_KV); bf16* XBB = (bf16*)(ws + WS_XB); bf16* GTB = (bf16*)(ws + WS_GT);

    STAMP(0);
    if (IN(0)) { REP(0) {
        LAS float* scr = (LAS float*)(F.lds + RING_OFF + F.wave * 16384);
        const int gw = F.vcu * NWAVES + F.wave, NGW = F.G * NWAVES;
        constexpr int I_1 = (D / 64) * (IND / 32);
        for (int it = gw; it < I_1; it += NGW) p0_transpose_item(w_in, D, IND, W1T, norm_mix_g, norm_mix_g, D, scr, it, F.lane);
        {
            f32x4 r0[8], r1[8], r2[8];
            const int NR = MREAL + NMETA;
#define P0_XSRC(m_) ((m_) < MREAL ? x + (size_t)(m_) * D : meta + (size_t)((m_) - MREAL) * D)
            if (gw < NR) p0_row_load(r0, P0_XSRC(gw), F.lane);
            if (gw + NGW < NR) p0_row_load(r1, P0_XSRC(gw + NGW), F.lane);
            for (int m = gw; m < NR; m += 3 * NGW) {
                if (m + 2 * NGW < NR) p0_row_load(r2, P0_XSRC(m + 2 * NGW), F.lane);
                p0_row_finish(r0, A1 + (size_t)m * D, RSTD1 + m, F.lane);
                if (m + NGW < NR) {
                    if (m + 3 * NGW < NR) p0_row_load(r0, P0_XSRC(m + 3 * NGW), F.lane);
                    p0_row_finish(r1, A1 + (size_t)(m + NGW) * D, RSTD1 + m + NGW, F.lane);
                }
                if (m + 2 * NGW < NR) {
                    if (m + 4 * NGW < NR) p0_row_load(r1, P0_XSRC(m + 4 * NGW), F.lane);
                    p0_row_finish(r2, A1 + (size_t)(m + 2 * NGW) * D, RSTD1 + m + 2 * NGW, F.lane);
                }
            }
#undef P0_XSRC
        }
        {
            const size_t gt = (size_t)gw * 64 + F.lane, NT = (size_t)NGW * 64;
            for (size_t i = gt; i < (size_t)(8 * 2 * 128 * 128) / 8; i += NT) p0_cvt8(sub_keys, SKB, nullptr, i);
        } }
        if (BOTH(0)) xcd_barrier(bar);
        STAMP(1);
    }
    if (IN(1)) {
        constexpr int NG1 = 213;
        if ((int)blockIdx.x < NG1) {
            pg8::Gemm g{A1, W1T, MPAD, IND, D};
            pg8::Order1 S{NG1, (int)blockIdx.x};
            pg8::Epi1 E{QB, KVB, XBB, GTB, RSTD1, b_in};
            REP(1) pg8::gemm_phase<pg8::Epi1, pg8::Order1, true, true>(F.lds + RING_OFF, g, S, E);
        }
        {
            volatile LAS int* qb = (volatile LAS int*)(F.lds + LDSCTL_OFF + 512);
            for (;;) {
                __syncthreads();
                if (F.tid == 0) qb[0] = (int)__hip_atomic_fetch_add((unsigned*)(F.ctl + CW_QROW), 32u, __ATOMIC_RELAXED, __HIP_MEMORY_SCOPE_AGENT);
                __syncthreads();
                const int base = qb[0];
                if (base >= 32768 + 256 * 32) break;
                if (base >= 32768) {
                    constexpr int I_2 = (D / 64) * (D / 32);
                    LAS float* scr = (LAS float*)(F.lds + RING_OFF + F.wave * 16384);
#pragma unroll 1
                    for (int j = 0; j < 2; ++j) {
                        const int item = ((base - 32768) >> 5) * 16 + F.wave * 2 + j;
                        if (item < I_2) p0_transpose_item(w_out, D, D, W2T, gn_attn_g, gn_lru_g, 1024, scr, item, F.lane);
                        else p0_transpose_item(peer_wq, D, D, W3T, norm_ffn_g, norm_ffn_g, D, scr, item - I_2, F.lane);
                    }
                    continue;
                }
                f32x4 r0[8], r1[8], r2[8], r3[8];
                const bool isu = base < 16384;
                const float* src = isu ? peer_u : peer_v; const float* gc = isu ? norm_ffn_g : nullptr; unsigned char* dst = isu ? U8 : V8; float* sc = isu ? SCU : SCV;
                const size_t e0 = (size_t)(isu ? base : base - 16384) + F.wave * 4;
                p6::qrow_load(r0, src, e0, F.lane); p6::qrow_load(r1, src, e0 + 1, F.lane); p6::qrow_load(r2, src, e0 + 2, F.lane); p6::qrow_load(r3, src, e0 + 3, F.lane);
                p6::qrow_finish(r0, gc, dst, sc, e0, F.lane); p6::qrow_finish(r1, gc, dst, sc, e0 + 1, F.lane);
                p6::qrow_finish(r2, gc, dst, sc, e0 + 2, F.lane); p6::qrow_finish(r3, gc, dst, sc, e0 + 3, F.lane);
            }
        }
        if (BOTH(1)) xcd_barrier(bar);
        STAMP(2);
    }
    if (IN(2)) {
        bf16* MIX = (bf16*)(ws + WS_Z); float* SSA = (float*)(ws + WS_SSA); float* SSL = (float*)(ws + WS_SSL);
        const p2::LruP LP{args.in[6], args.in[7], args.in[8], args.in[9], args.in[10], args.in[11], args.in[12]};
        {
        REP(20) for (int u = (int)blockIdx.x; u < 256; u += F.G) p2::lru_unit(F.lds + RING_OFF, F.lds + LDSCTL_OFF + 5120, u >> 5, (u >> 1) & 15, u & 1, XBB, GTB, LP, MIX, SSL, F.tid);
        REP(21) for (int a = (int)blockIdx.x; a < 256; a += F.G) p2::attn_unit(F.lds + RING_OFF, a >> 5, (a >> 1) & 15, a & 1, QB, KVB, args.in[5], MIX, SSA, F.tid);
        }
        if (BOTH(2)) xcd_barrier(bar);
        STAMP(3);
    }
    if (IN(3)) {
        bf16* MIX = (bf16*)(ws + WS_Z); const float* SSA = (const float*)(ws + WS_SSA); const float* SSL = (const float*)(ws + WS_SSL);
        bf16* H1B = (bf16*)(ws + WS_H1); float* SS2 = (float*)(ws + WS_SS2);
        pg8::Order2 S{F.G, (int)blockIdx.x};
        LAS float* tbl = (LAS float*)(F.lds + LDSCTL_OFF + 1024);
        pg8::Unit u0{0, 0};
        for (int i = 0; i < 2; ++i) {
            pg8::Unit u; if (!S.next(i, u)) break; if (i == 0) u0 = u;
            if (F.tid < 256) {
                const size_t row = (size_t)u.pm * 256 + F.tid; float sa = 0.f, sl = 0.f;
#pragma unroll
                for (int k = 0; k < 4; ++k) { const f32x4 v = *(const GAS f32x4*)(SSA + row * 16 + 4 * k); sa += (v.x + v.y) + (v.z + v.w); }
#pragma unroll
                for (int k = 0; k < 8; ++k) { const f32x4 v = *(const GAS f32x4*)(SSL + row * 32 + 4 * k); sl += (v.x + v.y) + (v.z + v.w); }
                const float ra = 1.0f / sqrtf(sa * (1.0f / 1024) + EPS), rl = 1.0f / sqrtf(sl * (1.0f / 1024) + EPS);
                tbl[(i * 256 + F.tid) * 4] = ra / rl; tbl[(i * 256 + F.tid) * 4 + 1] = rl; tbl[(i * 256 + F.tid) * 4 + 2] = 1.0f / ra;
            }
        }
        __syncthreads();
        pg8::Gemm g{MIX, W2T, MREAL, D, D};
        pg8::Epi2 E{H1B, A1, SS2, (const LAS float*)tbl, u0.pm};
        REP(3) pg8::gemm_phase<pg8::Epi2, pg8::Order2, true, true>(F.lds + RING_OFF, g, S, E);
        if (BOTH(3)) xcd_barrier(bar);
        STAMP(4);
    }
    if (IN(4)) {
        bf16* H1B = (bf16*)(ws + WS_H1); bf16* QPB = (bf16*)(ws + WS_A1);
        pg8::Order2 S{F.G, (int)blockIdx.x};
        {
            const float* SS2 = (const float*)(ws + WS_SS2); float* RSTD2 = (float*)(ws + WS_RSTD2);
            pg8::Unit u; if (S.next(0, u) && F.tid < 256) {
                const size_t row = (size_t)u.pm * 256 + F.tid; float ssq = 0.f;
#pragma unroll
                for (int k = 0; k < 8; ++k) { const f32x4 v = *(const GAS f32x4*)(SS2 + row * 32 + 4 * k); ssq += (v.x + v.y) + (v.z + v.w); }
                RSTD2[row] = 1.0f / sqrtf(ssq * (1.0f / D) + EPS);
            }
        }
        pg8::Gemm g{H1B, W3T, MREAL, D, D};
        pg8::Epi3 E{QPB};
        REP(4) pg8::gemm_phase<pg8::Epi3, pg8::Order2, true, true>(F.lds + RING_OFF, g, S, E);
        if (BOTH(4)) { asm volatile("s_waitcnt vmcnt(0)" ::: "memory"); __syncthreads();
            if (F.tid == 0) { __builtin_amdgcn_fence(__ATOMIC_ACQUIRE, "agent"); asm volatile("s_waitcnt vmcnt(0)" ::: "memory"); }
            __syncthreads(); }
        STAMP(5);
    }
    if (IN(5)) {
        const bf16* QPB = (const bf16*)(ws + WS_A1);
        unsigned short* IDS = (unsigned short*)(ws + WS_IDS); float* GW = (float*)(ws + WS_GW); float* RSTD2 = (float*)(ws + WS_RSTD2);
        const bf16* H1B = (const bf16*)(ws + WS_H1);
        const pg8::Order2 S5{F.G, (int)blockIdx.x};
        REP(5) for (int ui = 0; ; ++ui) {
            pg8::Unit un; if (!S5.next(ui, un)) break;
            const int uh = un.pn, utg = un.pm;
            v4u xq[4][4]; const size_t tb = (size_t)utg * 256 + F.wave * 32 + uh;
            p5::retr_unit(F.lds + RING_OFF, uh, utg, QPB, SKB, IDS, GW, RSTD2, F.tid);
#pragma unroll
            for (int k = 0; k < 4; ++k) p6::qx_load(xq[k], H1B, tb + 8 * k, F.lane);
#pragma unroll
            for (int k = 0; k < 4; ++k) p6::qx_finish(xq[k], X8, SX, tb + 8 * k, F.lane);
        }
        if (BOTH(5)) xcd_barrier(bar);
        STAMP(6);
    }
    {
        const bf16* H1B = (const bf16*)(ws + WS_H1); const unsigned short* IDS = (const unsigned short*)(ws + WS_IDS); const float* GW = (const float*)(ws + WS_GW);
        const float* RSTD2 = (const float*)(ws + WS_RSTD2); bf16* PART = (bf16*)(ws + WS_PART); unsigned char* W8 = ws + WS_W; float* WS8 = (float*)(ws + WS_WSUM); bf16* ZB = (bf16*)(ws + WS_Z);
        const int slot = (int)blockIdx.x & 7, rank = (int)blockIdx.x >> 3, nrank = (F.G - slot + 7) >> 3;
        const int gw = F.vcu * NWAVES + F.wave, NGW = F.G * NWAVES;
        if (IN(6)) { REP(6) p6::usweep(X8, SX, U8, IDS, PART, F.lds + RING_OFF, slot, rank, nrank, F.wave, F.lane); if (BOTH(6)) xcd_barrier(bar); STAMP(7); }
        if (IN(7)) { REP(7) p6::wreduce(PART, GW, RSTD2, IDS, SCU, SCV, W8, WS8, (size_t)gw * 64 + F.lane, (size_t)NGW * 64); if (BOTH(7)) xcd_barrier(bar); STAMP(8); }
        if (IN(8)) { REP(8) p6::vsweep(H1B, V8, IDS, W8, WS8, ZB, F.lds + RING_OFF, slot, rank, nrank, F.wave, F.lane); if (BOTH(8)) xcd_barrier(bar); STAMP(9); }
        if (PROBE_PH == 30) { for (int k = 0; k < 16; ++k) xcd_barrier(bar); }
        if (IN(9)) { REP(9) {
            v4u zc[4], zn[4], hc[4], hn[4];
            if (gw < MREAL) p6::final_load(zc, hc, ZB, H1B, (size_t)gw, F.lane);
            for (int t = gw; t < MREAL; t += NGW) {
                if (t + NGW < MREAL) p6::final_load(zn, hn, ZB, H1B, (size_t)(t + NGW), F.lane);
                p6::final_finish(zc, hc, args.in[21], args.out, (size_t)t, F.lane);
#pragma unroll
                for (int j = 0; j < 4; ++j) { zc[j] = zn[j]; hc[j] = hn[j]; }
            } } }
        if (PROBE_PH >= 100) {
            asm volatile("s_waitcnt vmcnt(0)" ::: "memory"); __syncthreads(); STAMP(10);
            if (blockIdx.x == 0 && F.tid == 0) {
                volatile LAS unsigned long long* ts = (volatile LAS unsigned long long*)(F.lds + LDSCTL_OFF + 640);
                const unsigned long long span = ts[PROBE_PH - 100 + 1] - ts[PROBE_PH - 100], t0 = __builtin_amdgcn_s_memrealtime();
                while (__builtin_amdgcn_s_memrealtime() - t0 < span) __builtin_amdgcn_s_sleep(8);
            }
        }
    }
#undef IN
#undef BOTH
}

extern "C" void kernel_launch(void* const* d_in, const int* in_sizes, int n_in, void* d_out, int out_size, void* d_ws, size_t ws_size, hipStream_t stream) {
    static int grid = 0;
    if (grid == 0) {
        int dev = 0, cus = 0;
        if (hipGetDevice(&dev) != hipSuccess || hipDeviceGetAttribute(&cus, hipDeviceAttributeMultiprocessorCount, dev) != hipSuccess) { fprintf(stderr, "kernel_launch: device query failed\n"); grid = -1; return; }
        if (hipFuncSetAttribute((const void*)fwd, hipFuncAttributeMaxDynamicSharedMemorySize, LDS_BYTES) != hipSuccess) { fprintf(stderr, "kernel_launch: hipFuncSetAttribute failed\n"); grid = -1; return; }
        int per_cu = 0;
        if (hipOccupancyMaxActiveBlocksPerMultiprocessor(&per_cu, (const void*)fwd, NWAVES * 64, LDS_BYTES) != hipSuccess || per_cu < 1) fprintf(stderr, "kernel_launch: occupancy query says %d\n", per_cu);
        (void)hipGetLastError();
        grid = cus;
        if (cus != 256) { fprintf(stderr, "kernel_launch: built for a 256-CU device (tile-to-workgroup maps of the GEMM phases), found %d CUs; nothing launched\n", cus); grid = -1; return; }
        if (ws_size < WS_END) { fprintf(stderr, "kernel_launch: ws too small %zu\n", ws_size); grid = -1; return; }
    }
    if (grid < 0) return;
    (void)hipMemsetAsync((char*)d_ws + WS_CTL, 0, CTL_ZERO_BYTES, stream);
    Args a{};
    for (int i = 0; i < 22; ++i) a.in[i] = (const float*)d_in[i];
    a.out = (float*)d_out; a.ws = (unsigned char*)d_ws; a.ph_lo = 0; a.ph_hi = 10;
    hipLaunchKernelGGL(fwd, dim3(grid), dim3(NWAVES * 64), LDS_BYTES, stream, a);
}
```
